# Optimizing an MI355X kernel written in HIP

```python
import functools
import jax, jax.numpy as jnp
from jax import lax
import numpy as np

D_MODEL = 1024
BATCH = 32
SEQ = 256
DEPTH = 4
DEC_BATCH = 2
DEC_SEQ = 1024
PAST_LEN = 256

GRID_W = 64
HEAD_DIM = 64
RWKV_HEADS = 4
NAT_HEADS = 4
HGRN_HEADS = 4
SWA_HEADS = 4
SWA_KV_HEADS = 2
RWKV_W = RWKV_HEADS * HEAD_DIM
NAT_W = NAT_HEADS * HEAD_DIM
HGRN_W = HGRN_HEADS * HEAD_DIM
SWA_W = SWA_HEADS * HEAD_DIM
SWA_KV_W = SWA_KV_HEADS * HEAD_DIM
D_MIX = RWKV_W + NAT_W + HGRN_W + SWA_W
RWKV_LORA_RANK = 64
RWKV_GATE_RANK = 128
RWKV_DECAY_SCALE = 0.6065306597126334
RWKV_LN_EPS = 64e-5
NAT_KH = 8
NAT_KW = 16
NAT_QCOLS = 16
NAT_KCOLS = 32
HGRN_CHUNK = 64
SWA_WINDOW = 128
SWA_BLOCK = 128
CTX_QBLOCK = 128
ROPE_BASE = 10000.0
FFN_HIDDEN = 4 * D_MODEL
NORM_EPS = 1e-6
MASK_VALUE = -1e30
N_MOD = 6
ATTN_SCALE = HEAD_DIM ** -0.5
IN_SPLITS = (RWKV_W, RWKV_W, RWKV_W, RWKV_GATE_RANK, RWKV_LORA_RANK, RWKV_LORA_RANK, RWKV_LORA_RANK, RWKV_LORA_RANK,
             NAT_W, NAT_W, NAT_W,
             HGRN_W, HGRN_W, HGRN_W, HGRN_W, HGRN_W,
             SWA_W, SWA_KV_W, SWA_KV_W)
D_IN = 3 * RWKV_W + RWKV_GATE_RANK + 4 * RWKV_LORA_RANK + 3 * NAT_W + 5 * HGRN_W + SWA_W + 2 * SWA_KV_W

kernel_name = 'hybrid_rwkv7_nat_hgrn2_swa_dit_step'


def _rms(x, gain):
    xf = x.astype(jnp.float32)
    y = xf * lax.rsqrt(jnp.mean(xf * xf, axis=-1, keepdims=True) + NORM_EPS)
    return y.astype(x.dtype) * gain


def _modulation(cond, w, b):
    m = jax.nn.silu(cond) @ w + b
    return m.reshape(cond.shape[0], N_MOD, D_MODEL)


def _split_cols(p):
    cuts, acc = [], 0
    for s in IN_SPLITS[:-1]:
        acc += s
        cuts.append(acc)
    return jnp.split(p, cuts, axis=-1)


def _heads(x, n):
    return x.reshape(x.shape[0], x.shape[1], n, HEAD_DIM)


def _shift_lerp(x, mu):
    prev = jnp.pad(x[:, :-1], ((0, 0), (1, 0), (0, 0)))
    return x + (prev - x) * mu


def _axial_rope(x):
    T = x.shape[1]
    t = jnp.arange(T)
    row = (t // GRID_W).astype(jnp.float32)
    col = (t % GRID_W).astype(jnp.float32)
    half = HEAD_DIM // 2
    nf = half // 2
    inv = 1.0 / (ROPE_BASE ** (jnp.arange(nf, dtype=jnp.float32) / nf))

    def rot(xa, pos):
        ang = pos[:, None] * inv[None, :]
        cs = jnp.cos(ang)[None, :, None, :].astype(x.dtype)
        sn = jnp.sin(ang)[None, :, None, :].astype(x.dtype)
        x1, x2 = xa[..., :nf], xa[..., nf:]
        return jnp.concatenate([x1 * cs - x2 * sn, x2 * cs + x1 * sn], axis=-1)

    return jnp.concatenate([rot(x[..., :half], row), rot(x[..., half:], col)], axis=-1)


def _ctx_attention(q, k, v, sink):
    B, L, H, dh = q.shape
    KV = k.shape[2]
    G = H // KV
    nb = L // CTX_QBLOCK
    qb = jnp.moveaxis((q * ATTN_SCALE).reshape(B, nb, CTX_QBLOCK, KV, G, dh), 1, 0)

    def one_block(qi):
        s = jnp.einsum('bqkgd,blkd->bkgql', qi, k).astype(jnp.float32)
        if sink is not None:
            col = jnp.broadcast_to(sink.reshape(KV, G)[None, :, :, None, None].astype(jnp.float32), s.shape[:-1] + (1,))
            s = jnp.concatenate([s, col], axis=-1)
        p = jax.nn.softmax(s, axis=-1)[..., :L]
        return jnp.einsum('bkgql,blkd->bqkgd', p.astype(v.dtype), v)

    o = lax.map(one_block, qb)
    return jnp.moveaxis(o, 0, 1).reshape(B, L, H * dh)


def _nat_latent(q, k, v, ck, cv, rpb):
    B, T, H, dh = q.shape
    dt = q.dtype
    rows = T // GRID_W
    kh = min(NAT_KH, rows)
    ncb = GRID_W // NAT_QCOLS
    row_start = jnp.clip(jnp.arange(rows) - kh // 2, 0, rows - kh)
    row_idx = row_start[:, None] + jnp.arange(kh)[None, :]
    qcol = jnp.arange(GRID_W).reshape(ncb, NAT_QCOLS)
    win_start = jnp.clip(qcol - NAT_KW // 2, 0, GRID_W - NAT_KW)
    kcol_start = jnp.clip(jnp.arange(ncb) * NAT_QCOLS - NAT_KW // 2, 0, GRID_W - NAT_KCOLS)
    col_idx = kcol_start[:, None] + jnp.arange(NAT_KCOLS)[None, :]
    kc = col_idx[:, None, :]
    col_ok = (kc >= win_start[..., None]) & (kc < win_start[..., None] + NAT_KW)
    roff = row_idx - jnp.arange(rows)[:, None] + NAT_KH - 1
    coff = jnp.clip(kc - qcol[..., None], -(NAT_KW - 1), NAT_KW - 1) + NAT_KW - 1
    bias = rpb[:, roff[:, None, None, :, None], coff[None, :, :, None, :]].astype(jnp.float32)
    kg = k.reshape(B, rows, GRID_W, H, dh)
    vg = v.reshape(B, rows, GRID_W, H, dh)
    ri = row_idx[:, :, None, None]
    ci = col_idx[None, None, :, :]
    kb = kg[:, ri, ci]
    vb = vg[:, ri, ci]
    qg = (q * ATTN_SCALE).reshape(B, rows, ncb, NAT_QCOLS, H, dh)
    s_loc = jnp.einsum('brcqhd,brackhd->bhrcqak', qg, kb).astype(jnp.float32) + bias
    s_loc = jnp.where(col_ok[None, :, :, None, :], s_loc, MASK_VALUE)
    nloc = kh * NAT_KCOLS
    s_loc = s_loc.reshape(B, H, rows, ncb, NAT_QCOLS, nloc)
    s_ctx = jnp.einsum('brcqhd,blhd->bhrcql', qg, ck).astype(jnp.float32)
    p = jax.nn.softmax(jnp.concatenate([s_loc, s_ctx], axis=-1), axis=-1)
    p_loc = p[..., :nloc].reshape(B, H, rows, ncb, NAT_QCOLS, kh, NAT_KCOLS).astype(dt)
    p_ctx = p[..., nloc:].astype(dt)
    o = jnp.einsum('bhrcqak,brackhd->brcqhd', p_loc, vb) + jnp.einsum('bhrcql,blhd->brcqhd', p_ctx, cv)
    return o.reshape(B, T, H * dh)


def _swa_latent(q, k, v, ck, cv, sink):
    B, T, H, dh = q.shape
    dt = q.dtype
    KV = k.shape[2]
    G = H // KV
    L = ck.shape[1]
    nb = T // SWA_BLOCK
    pad = ((0, 0), (SWA_BLOCK, SWA_BLOCK), (0, 0), (0, 0))
    kp, vp = jnp.pad(k, pad), jnp.pad(v, pad)
    idx = jnp.arange(nb)[:, None] * SWA_BLOCK + jnp.arange(3 * SWA_BLOCK)[None, :]
    kb, vb = kp[:, idx], vp[:, idx]
    qb = (q * ATTN_SCALE).reshape(B, nb, SWA_BLOCK, KV, G, dh)
    qpos = jnp.arange(nb)[:, None] * SWA_BLOCK + jnp.arange(SWA_BLOCK)[None, :]
    kpos = (idx - SWA_BLOCK)[:, None, :]
    ok = (jnp.abs(kpos - qpos[:, :, None]) <= SWA_WINDOW) & (kpos >= 0) & (kpos < T)
    s_loc = jnp.einsum('bnqkgd,bnskd->bnkgqs', qb, kb).astype(jnp.float32)
    s_loc = jnp.where(ok[None, :, None, None], s_loc, MASK_VALUE)
    s_ctx = jnp.einsum('bnqkgd,blkd->bnkgql', qb, ck).astype(jnp.float32)
    s_sink = jnp.broadcast_to(sink.reshape(KV, G)[None, None, :, :, None, None].astype(jnp.float32), s_loc.shape[:-1] + (1,))
    p = jax.nn.softmax(jnp.concatenate([s_loc, s_ctx, s_sink], axis=-1), axis=-1)
    nloc = 3 * SWA_BLOCK
    o = (jnp.einsum('bnkgqs,bnskd->bnqkgd', p[..., :nloc].astype(dt), vb)
         + jnp.einsum('bnkgql,blkd->bnqkgd', p[..., nloc:nloc + L].astype(dt), cv))
    return o.reshape(B, T, H * dh)


def _rwkv_direction(r, k, v, wh, ah, mu_rkv, mu_lora, w0, w2, a0, a2, k_k, k_a, r_k, s0):
    B, T, _ = r.shape
    dt = r.dtype
    r = _shift_lerp(r, mu_rkv[0])
    k = _shift_lerp(k, mu_rkv[1])
    v = _shift_lerp(v, mu_rkv[2])
    wh = _shift_lerp(wh, mu_lora[0])
    ah = _shift_lerp(ah, mu_lora[1])
    log_w = -RWKV_DECAY_SCALE * jax.nn.sigmoid((w0 + jnp.tanh(wh) @ w2).astype(jnp.float32))
    a = jax.nn.sigmoid((a0 + ah @ a2).astype(jnp.float32))
    hd = lambda t: t.reshape(B, T, RWKV_HEADS, HEAD_DIM).astype(jnp.float32)
    r, k, v, w, a = hd(r), hd(k), hd(v), hd(jnp.exp(log_w)), hd(a)
    kk = k * k_k.reshape(RWKV_HEADS, HEAD_DIM)
    kk = kk / jnp.maximum(jnp.sqrt(jnp.sum(kk * kk, axis=-1, keepdims=True)), 1e-12)
    k = k * (1.0 + (a - 1.0) * k_a.reshape(RWKV_HEADS, HEAD_DIM))

    def step(S, inp):
        r_t, w_t, k_t, v_t, kk_t, a_t = inp
        sa = jnp.einsum('bhvk,bhk->bhv', S, -kk_t)
        S = S * w_t[:, :, None, :] + sa[..., None] * (kk_t * a_t)[:, :, None, :] + v_t[..., None] * k_t[:, :, None, :]
        return S, jnp.einsum('bhvk,bhk->bhv', S, r_t)

    tm = lambda t: jnp.moveaxis(t, 1, 0)
    s_fin, y = lax.scan(step, s0.astype(jnp.float32), (tm(r), tm(w), tm(k), tm(v), tm(kk), tm(a)))
    y = jnp.moveaxis(y, 0, 1)
    bonus = jnp.sum(r * k * r_k, axis=-1, keepdims=True) * v
    return y, bonus, s_fin.astype(dt)


def _rwkv_mixer(r, k, v, gh, whf, ahf, whb, ahb, lw, s_f, s_b):
    B, T, _ = r.shape
    dt = r.dtype

    def direction(d, r_, k_, v_, wh_, ah_, s0):
        return _rwkv_direction(r_, k_, v_, wh_, ah_, lw['rw_mu_rkv'][d], lw['rw_mu_lora'][d], lw['rw_w0'][d],
                               lw['rw_w2'][d], lw['rw_a0'][d], lw['rw_a2'][d], lw['rw_kk'], lw['rw_ka'],
                               lw['rw_rk'], s0)

    rev = lambda t: t[:, ::-1]
    yf, bf, sf = direction(0, r, k, v, whf, ahf, s_f)
    yb, bb, sb = direction(1, rev(r), rev(k), rev(v), rev(whb), rev(ahb), s_b)
    y = yf + rev(yb)
    mu = jnp.mean(y, axis=-1, keepdims=True)
    var = jnp.mean(jnp.square(y - mu), axis=-1, keepdims=True)
    y = ((y - mu) * lax.rsqrt(var + RWKV_LN_EPS)).reshape(B, T, RWKV_W) * lw['rw_lnx_w'] + lw['rw_lnx_b']
    y = y + (bf + rev(bb)).reshape(B, T, RWKV_W)
    g = jax.nn.sigmoid(gh) @ lw['rw_g2']
    return y.astype(dt) * g, sf, sb


def _hgrn_direction(q, v, f_raw, lb, s0):
    B, T, H, N = q.shape
    dt = q.dtype
    C = HGRN_CHUNK
    nc = T // C
    f_raw = f_raw.astype(jnp.float32)
    f = lb + (1.0 - lb) * jax.nn.sigmoid(f_raw)
    log_f = jnp.log(f)
    k = (1.0 - lb) * jax.nn.sigmoid(-f_raw)
    chunks = lambda t: jnp.moveaxis(t.astype(jnp.float32).reshape(B, nc, C, H, N), 1, 0)
    causal = jnp.tril(jnp.ones((C, C), dtype=bool))[None, :, :, None, None]

    def step(S, inp):
        qc, kc, vc, lfc = inp
        b = jnp.cumsum(lfc, axis=1)
        o_inter = jnp.einsum('bthk,bhkv->bthv', qc * jnp.exp(b), S)
        diff = b[:, :, None] - b[:, None, :]
        dec = jnp.where(causal, jnp.exp(jnp.where(causal, diff, 0.0)), 0.0)
        att = jnp.einsum('bthk,bshk,btshk->bhts', qc, kc, dec)
        o_intra = jnp.einsum('bhts,bshv->bthv', att, vc)
        b_end = b[:, -1]
        S = S * jnp.exp(b_end)[..., None] + jnp.einsum('bshk,bshv->bhkv', kc * jnp.exp(b_end[:, None] - b), vc)
        return S, o_inter + o_intra

    s_fin, o = lax.scan(step, s0.astype(jnp.float32), (chunks(q), chunks(k), chunks(v), chunks(log_f)))
    o = jnp.moveaxis(o, 0, 1).reshape(B, T, H, N)
    return o.astype(dt), s_fin.astype(dt)


def _hgrn_mixer(q, i, g, f_f, f_b, lw, s_f, s_b):
    B, T, _ = q.shape
    dt = q.dtype
    q4 = _heads(jax.nn.silu(q), HGRN_HEADS)
    v4 = _heads(i, HGRN_HEADS)
    lb = lw['hg_lb'].reshape(2, HGRN_HEADS, HEAD_DIM)
    rev = lambda t: t[:, ::-1]
    of, sf = _hgrn_direction(q4, v4, _heads(f_f, HGRN_HEADS), lb[0], s_f)
    ob, sb = _hgrn_direction(rev(q4), rev(v4), rev(_heads(f_b, HGRN_HEADS)), lb[1], s_b)
    o = (of + rev(ob)).astype(jnp.float32)
    o = o * lax.rsqrt(jnp.mean(o * o, axis=-1, keepdims=True) + NORM_EPS)
    o = o.reshape(B, T, HGRN_W).astype(dt) * lw['hg_norm'] * jax.nn.sigmoid(g)
    return o, sf, sb


def _mix_context(h, lw):
    (r, k, v, gh, whf, ahf, whb, ahb, nq, nk, nv, hq, hi, hg, hff, hfb, sq, sk, sv) = _split_cols(h @ lw['w_in'])
    B = h.shape[0]
    z = jnp.zeros((B, RWKV_HEADS, HEAD_DIM, HEAD_DIM), h.dtype)
    ya, rs_f, rs_b = _rwkv_mixer(r, k, v, gh, whf, ahf, whb, ahb, lw, z, z)
    nk4, nv4 = _heads(nk, NAT_HEADS), _heads(nv, NAT_HEADS)
    yb = _ctx_attention(_heads(nq, NAT_HEADS), nk4, nv4, None)
    zh = jnp.zeros((B, HGRN_HEADS, HEAD_DIM, HEAD_DIM), h.dtype)
    yc, hs_f, hs_b = _hgrn_mixer(hq, hi, hg, hff, hfb, lw, zh, zh)
    sk4, sv4 = _heads(sk, SWA_KV_HEADS), _heads(sv, SWA_KV_HEADS)
    yd = _ctx_attention(_heads(sq, SWA_HEADS), sk4, sv4, lw['swa_sink'])
    y = jnp.concatenate([ya, yb, yc, yd], axis=-1)
    new = (jnp.stack([nk4, nv4], axis=1), jnp.stack([sk4, sv4], axis=1),
           jnp.stack([rs_f, rs_b], axis=1), jnp.stack([hs_f, hs_b], axis=1))
    return y, new


def _mix_latent(h, lw, nat_kv, swa_kv, rw_s, hg_s):
    (r, k, v, gh, whf, ahf, whb, ahb, nq, nk, nv, hq, hi, hg, hff, hfb, sq, sk, sv) = _split_cols(h @ lw['w_in'])
    ya, _, _ = _rwkv_mixer(r, k, v, gh, whf, ahf, whb, ahb, lw, rw_s[:, 0], rw_s[:, 1])
    yb = _nat_latent(_heads(nq, NAT_HEADS), _heads(nk, NAT_HEADS), _heads(nv, NAT_HEADS),
                     nat_kv[:, 0], nat_kv[:, 1], lw['nat_rpb'])
    yc, _, _ = _hgrn_mixer(hq, hi, hg, hff, hfb, lw, hg_s[:, 0], hg_s[:, 1])
    yd = _swa_latent(_axial_rope(_heads(sq, SWA_HEADS)), _axial_rope(_heads(sk, SWA_KV_HEADS)),
                     _heads(sv, SWA_KV_HEADS), swa_kv[:, 0], swa_kv[:, 1], lw['swa_sink'])
    return jnp.concatenate([ya, yb, yc, yd], axis=-1), None


def _block(x, mod, lw, mix):
    g = lw['norm_g']
    h = _rms(x, g[0]) * (1 + mod[:, None, 1]) + mod[:, None, 0]
    y, aux = mix(h)
    x = x + mod[:, None, 2] * _rms(y @ lw['w_out'], g[1])
    h = _rms(x, g[2]) * (1 + mod[:, None, 4]) + mod[:, None, 3]
    f = jnp.square(jax.nn.relu(h @ lw['ffn_w1'])) @ lw['ffn_w2']
    x = x + mod[:, None, 5] * _rms(f, g[3])
    return x, aux


def setup_inputs(seed: int = 0) -> dict:
    key = jax.random.key(seed)
    ks = jax.random.split(key, 32)
    nrm = lambda i, shape, s: s * jax.random.normal(ks[i], shape, jnp.float32)
    uni = lambda i, shape: jax.random.uniform(ks[i], shape, jnp.float32)
    R = RWKV_LORA_RANK
    return {
        'x_prompt': nrm(0, (BATCH, SEQ, D_MODEL), 1.0),
        'x_sample': nrm(1, (DEC_BATCH, DEC_SEQ, D_MODEL), 1.0),
        'cache_nat_kv': nrm(2, (DEC_BATCH, DEPTH, 2, PAST_LEN, NAT_HEADS, HEAD_DIM), 1.0),
        'cache_swa_kv': nrm(3, (DEC_BATCH, DEPTH, 2, PAST_LEN, SWA_KV_HEADS, HEAD_DIM), 1.0),
        'state_rwkv': nrm(4, (DEC_BATCH, DEPTH, 2, RWKV_HEADS, HEAD_DIM, HEAD_DIM), 0.3),
        'state_hgrn': nrm(5, (DEC_BATCH, DEPTH, 2, HGRN_HEADS, HEAD_DIM, HEAD_DIM), 0.3),
        'c': nrm(6, (DEC_BATCH, D_MODEL), 1.0),
        'c_ctx': nrm(7, (D_MODEL,), 1.0),
        'norm_g': 1.0 + nrm(8, (DEPTH, 4, D_MODEL), 0.05),
        'mod_w': nrm(9, (DEPTH, D_MODEL, N_MOD * D_MODEL), 0.5 * D_MODEL ** -0.5),
        'mod_b': nrm(10, (DEPTH, N_MOD * D_MODEL), 0.02),
        'w_in': nrm(11, (DEPTH, D_MODEL, D_IN), D_MODEL ** -0.5),
        'w_out': nrm(12, (DEPTH, D_MIX, D_MODEL), D_MIX ** -0.5),
        'rw_mu_rkv': uni(13, (DEPTH, 2, 3, RWKV_W)),
        'rw_mu_lora': uni(14, (DEPTH, 2, 2, R)),
        'rw_w0': nrm(15, (DEPTH, 2, RWKV_W), 0.5),
        'rw_w2': nrm(16, (DEPTH, 2, R, RWKV_W), 0.1),
        'rw_a0': nrm(17, (DEPTH, 2, RWKV_W), 0.1),
        'rw_a2': nrm(18, (DEPTH, 2, R, RWKV_W), 0.5 * R ** -0.5),
        'rw_g2': nrm(19, (DEPTH, RWKV_GATE_RANK, RWKV_W), RWKV_GATE_RANK ** -0.5),
        'rw_kk': 0.85 + nrm(20, (DEPTH, RWKV_W), 0.05),
        'rw_ka': 1.0 + nrm(21, (DEPTH, RWKV_W), 0.05),
        'rw_rk': nrm(22, (DEPTH, RWKV_HEADS, HEAD_DIM), 0.1),
        'rw_lnx_w': 1.0 + nrm(23, (DEPTH, RWKV_W), 0.05),
        'rw_lnx_b': nrm(24, (DEPTH, RWKV_W), 0.02),
        'nat_rpb': nrm(25, (DEPTH, NAT_HEADS, 2 * NAT_KH - 1, 2 * NAT_KW - 1), 0.2),
        'hg_lb_logits': nrm(26, (2, DEPTH, HGRN_W), 0.1),
        'hg_norm': 1.0 + nrm(27, (DEPTH, HGRN_W), 0.05),
        'swa_sink': nrm(28, (DEPTH, SWA_HEADS), 0.5),
        'ffn_w1': nrm(29, (DEPTH, D_MODEL, FFN_HIDDEN), D_MODEL ** -0.5),
        'ffn_w2': nrm(30, (DEPTH, FFN_HIDDEN, D_MODEL), FFN_HIDDEN ** -0.5),
    }


def reference(x_prompt, x_sample, cache_nat_kv, cache_swa_kv, state_rwkv, state_hgrn, c, c_ctx,
              norm_g, mod_w, mod_b, w_in, w_out, rw_mu_rkv, rw_mu_lora, rw_w0, rw_w2, rw_a0, rw_a2,
              rw_g2, rw_kk, rw_ka, rw_rk, rw_lnx_w, rw_lnx_b, nat_rpb, hg_lb_logits, hg_norm,
              swa_sink, ffn_w1, ffn_w2):
    lb_sm = jax.nn.softmax(hg_lb_logits.astype(jnp.float32), axis=1)
    hg_lb = jnp.cumsum(lb_sm, axis=1) - lb_sm[:, :1]
    xp, xs = x_prompt, x_sample
    nat_out, swa_out, rw_out, hg_out = [], [], [], []
    for l in range(DEPTH):
        lw = {
            'norm_g': norm_g[l], 'w_in': w_in[l], 'w_out': w_out[l], 'ffn_w1': ffn_w1[l], 'ffn_w2': ffn_w2[l],
            'rw_mu_rkv': rw_mu_rkv[l], 'rw_mu_lora': rw_mu_lora[l], 'rw_w0': rw_w0[l], 'rw_w2': rw_w2[l],
            'rw_a0': rw_a0[l], 'rw_a2': rw_a2[l], 'rw_g2': rw_g2[l], 'rw_kk': rw_kk[l], 'rw_ka': rw_ka[l],
            'rw_rk': rw_rk[l], 'rw_lnx_w': rw_lnx_w[l], 'rw_lnx_b': rw_lnx_b[l], 'nat_rpb': nat_rpb[l],
            'hg_lb': hg_lb[:, l], 'hg_norm': hg_norm[l], 'swa_sink': swa_sink[l],
        }
        mod_p = _modulation(c_ctx[None, :], mod_w[l], mod_b[l])
        xp, (nkv, skv, rws, hgs) = _block(xp, mod_p, lw, functools.partial(_mix_context, lw=lw))
        nat_out.append(nkv)
        swa_out.append(skv)
        rw_out.append(rws)
        hg_out.append(hgs)
        mod_s = _modulation(c, mod_w[l], mod_b[l])
        xs, _ = _block(xs, mod_s, lw, functools.partial(
            _mix_latent, lw=lw, nat_kv=cache_nat_kv[:, l], swa_kv=cache_swa_kv[:, l],
            rw_s=state_rwkv[:, l], hg_s=state_hgrn[:, l]))
    new_cache_nat_kv = jnp.stack(nat_out, axis=1)
    new_cache_swa_kv = jnp.stack(swa_out, axis=1)
    new_state_rwkv = jnp.stack(rw_out, axis=1)
    new_state_hgrn = jnp.stack(hg_out, axis=1)
    return (xp, xs, new_cache_nat_kv, new_cache_swa_kv, new_state_rwkv, new_state_hgrn)
```

```cpp
#include <hip/hip_runtime.h>
#include <hip/hip_cooperative_groups.h>
#include <cstdio>
#include <cstdint>
namespace cg = cooperative_groups;

#ifndef ONE_LAUNCH
#define ONE_LAUNCH 1
#endif

#define DEV __device__ __forceinline__
typedef unsigned short bf16_t;
typedef short bf16x8 __attribute__((ext_vector_type(8)));
typedef float f32x16 __attribute__((ext_vector_type(16)));
typedef __bf16 bf2_t __attribute__((ext_vector_type(2)));
typedef float f2_t __attribute__((ext_vector_type(2)));

constexpr int D = 1024, DIN = 3712, FF = 4096, NCTX = 8192, MT = 10240;
constexpr int NPH = 38;
constexpr int C_R = 0, C_K = 256, C_V = 512, C_GH = 768, C_WHF = 896, C_WHB = 1024;
constexpr int C_NQ = 1152, C_NK = 1408, C_NV = 1664;
constexpr int C_HQ = 1920, C_HI = 2176, C_HG = 2432, C_HFF = 2688, C_HFB = 2944;
constexpr int C_SQ = 3200, C_SK = 3456, C_SV = 3584;
constexpr size_t O_NAT = 10485760, O_SWA = 27262976, O_RW = 35651584, O_HG = 39845888;
constexpr size_t ARRF = (size_t)MT * 256;
constexpr size_t ARR = ARRF * 4;
constexpr size_t OFF_WIN = 0;
constexpr size_t OFF_WOUT = OFF_WIN + (size_t)4 * DIN * D * 2;
constexpr size_t OFF_W1 = OFF_WOUT + (size_t)4 * D * D * 2;
constexpr size_t OFF_W2 = OFF_W1 + (size_t)4 * FF * D * 2;
constexpr size_t OFF_MOD = OFF_W2 + (size_t)4 * FF * D * 2;
constexpr size_t OFF_HGLB = OFF_MOD + (size_t)4 * 3 * 6144 * 4;
constexpr size_t OFF_P = OFF_HGLB + 8192;
constexpr size_t OFF_R1 = OFF_P + (size_t)MT * DIN * 2;
constexpr size_t OFF_H = OFF_R1;
constexpr size_t OFF_HID = OFF_H + (size_t)MT * D * 2;
constexpr size_t OFF_U = OFF_HID + (size_t)MT * FF * 2;
constexpr size_t OFF_PREP = OFF_R1;
constexpr size_t OFF_YDIR = OFF_PREP + 12 * ARR;
constexpr size_t OFF_BONUS = OFF_R1 + 14 * ARR;
constexpr size_t OFF_HDIR = OFF_BONUS + ARR;
constexpr size_t OFF_YMIX = OFF_HDIR + 2 * ARR;
constexpr size_t WS_TOTAL = OFF_YMIX + (size_t)MT * D * 2;
static_assert(OFF_U + (size_t)MT * D * 4 == OFF_BONUS, "R1 layout");

struct Params {
  const float* in[31];
  float* out;
  char* ws;
};
enum { I_XP = 0, I_XS, I_CNAT, I_CSWA, I_SRW, I_SHG, I_C, I_CCTX, I_NORMG, I_MODW, I_MODB, I_WIN, I_WOUT, I_MURKV, I_MULORA,
       I_W0, I_W2, I_A0, I_A2, I_G2, I_KK, I_KA, I_RK, I_LNW, I_LNB, I_RPB, I_HGLB, I_HGN, I_SINK, I_FW1, I_FW2 };

DEV bf16_t f2bf(float f) { unsigned u = __float_as_uint(f); u += 0x7fffu + ((u >> 16) & 1u); return (bf16_t)(u >> 16); }
DEV float bf2f(bf16_t h) { return __uint_as_float(((unsigned)h) << 16); }
DEV unsigned pk2(float a, float b) { f2_t v = {a, b}; bf2_t r = __builtin_convertvector(v, bf2_t); return __builtin_bit_cast(unsigned, r); }
DEV float bflo(unsigned u) { return __uint_as_float(u << 16); }
DEV float bfhi(unsigned u) { return __uint_as_float(u & 0xffff0000u); }
DEV float sigmoidf_(float x) { return 1.0f / (1.0f + __expf(-x)); }
DEV float tanhf_(float x) { return 1.0f - 2.0f / (1.0f + __expf(2.0f * x)); }
template <int CTRL> DEV float dppf(float x) { return __int_as_float(__builtin_amdgcn_update_dpp(0, __float_as_int(x), CTRL, 0xF, 0xF, false)); }
DEV float row16_sum(float x) { x += dppf<0xB1>(x); x += dppf<0x4E>(x); x += dppf<0x141>(x); x += dppf<0x140>(x); return x; }
DEV float wave_sum(float x) { x = row16_sum(x); x += __shfl_xor(x, 16); x += __shfl_xor(x, 32); return x; }
DEV int clampi(int v, int lo, int hi) { return v < lo ? lo : (v > hi ? hi : v); }
#define MFMA32(a, b, c) __builtin_amdgcn_mfma_f32_32x32x16_bf16((a), (b), (c), 0, 0, 0)

DEV int tid() { int z; asm volatile("v_mov_b32 %0, 0" : "=v"(z)); return (int)threadIdx.x + z; }
DEV void transpose_item(const float* W, bf16_t* WT, int K, int N, int kt, int nt, char* lds) {
  bf16_t* s = (bf16_t*)lds;
  const int t = tid();
#pragma unroll
  for (int i = 0; i < 4; ++i) {
    const int k = (t >> 4) + 16 * i, n4 = (t & 15) * 4;
    const float4 v = *(const float4*)(W + (size_t)(kt * 64 + k) * N + nt * 64 + n4);
    s[(n4 + 0) * 72 + k] = f2bf(v.x); s[(n4 + 1) * 72 + k] = f2bf(v.y);
    s[(n4 + 2) * 72 + k] = f2bf(v.z); s[(n4 + 3) * 72 + k] = f2bf(v.w);
  }
  __syncthreads();
#pragma unroll
  for (int i = 0; i < 2; ++i) {
    const int n = (t >> 3) + 32 * i, kc = t & 7;
    const uint4 v = *(const uint4*)(s + n * 72 + kc * 8);
    *(uint4*)(WT + (size_t)(nt * 64 + n) * K + kt * 64 + kc * 8) = v;
  }
  __syncthreads();
}

DEV void mod_item(const Params& p, int l, int jb, char* lds) {
  float* sc = (float*)lds;
  float* red = (float*)(lds + 12288);
  const int t = tid();
  for (int i = t; i < 3072; i += 256) {
    const int c = i >> 10, k = i & 1023;
    const float x = (c == 0) ? p.in[I_CCTX][k] : p.in[I_C][(c - 1) * 1024 + k];
    sc[i] = x / (1.0f + __expf(-x));
  }
  __syncthreads();
  const int cg4 = t & 63, ks = t >> 6;
  const float* wp = p.in[I_MODW] + ((size_t)l * 1024 + ks * 256) * 6144 + jb * 256 + cg4 * 4;
  float a00 = 0, a01 = 0, a02 = 0, a03 = 0, a10 = 0, a11 = 0, a12 = 0, a13 = 0, a20 = 0, a21 = 0, a22 = 0, a23 = 0;
#pragma unroll 8
  for (int ii = 0; ii < 256; ++ii) {
    const float4 w = *(const float4*)(wp + (size_t)ii * 6144);
    const int k = ks * 256 + ii;
    const float s0 = sc[k], s1 = sc[1024 + k], s2 = sc[2048 + k];
    a00 += s0 * w.x; a01 += s0 * w.y; a02 += s0 * w.z; a03 += s0 * w.w;
    a10 += s1 * w.x; a11 += s1 * w.y; a12 += s1 * w.z; a13 += s1 * w.w;
    a20 += s2 * w.x; a21 += s2 * w.y; a22 += s2 * w.z; a23 += s2 * w.w;
  }
  float* r0 = red + (ks * 3 + 0) * 256 + cg4 * 4; r0[0] = a00; r0[1] = a01; r0[2] = a02; r0[3] = a03;
  float* r1 = red + (ks * 3 + 1) * 256 + cg4 * 4; r1[0] = a10; r1[1] = a11; r1[2] = a12; r1[3] = a13;
  float* r2 = red + (ks * 3 + 2) * 256 + cg4 * 4; r2[0] = a20; r2[1] = a21; r2[2] = a22; r2[3] = a23;
  __syncthreads();
  float* MOD = (float*)(p.ws + OFF_MOD);
  const float bias = p.in[I_MODB][l * 6144 + jb * 256 + t];
#pragma unroll
  for (int c = 0; c < 3; ++c) {
    float v = bias;
#pragma unroll
    for (int k2 = 0; k2 < 4; ++k2) v += red[(k2 * 3 + c) * 256 + t];
    MOD[(size_t)(l * 3 + c) * 6144 + jb * 256 + t] = v;
  }
  __syncthreads();
}

DEV void hglb_item(const Params& p) {
  const int c = tid();
  float* HGLB = (float*)(p.ws + OFF_HGLB);
  for (int dir = 0; dir < 2; ++dir) {
    float x[4], mx = -1e30f;
    for (int l = 0; l < 4; ++l) { x[l] = p.in[I_HGLB][(dir * 4 + l) * 256 + c]; mx = fmaxf(mx, x[l]); }
    float s = 0;
    for (int l = 0; l < 4; ++l) { x[l] = __expf(x[l] - mx); s += x[l]; }
    float cum = 0; const float s0 = x[0] / s;
    for (int l = 0; l < 4; ++l) { cum += x[l] / s; HGLB[(l * 2 + dir) * 256 + c] = cum - s0; }
  }
}

DEV void phase0(const Params& p, char* lds) {
  const int NT_WIN = 4 * 16 * 58, NT_WOUT = 4 * 16 * 16, NT_W1 = 4 * 16 * 64, NT_W2 = 4 * 64 * 16;
  const int nitems = 97 + NT_WIN + NT_WOUT + NT_W1 + NT_W2;
  for (int it = blockIdx.x; it < nitems; it += gridDim.x) {
    if (it < 96) { mod_item(p, it / 24, it % 24, lds); continue; }
    if (it == 96) { hglb_item(p); continue; }
    int j = it - 97;
    if (j < NT_WIN) { const int l = j / 928, r = j % 928;
      transpose_item(p.in[I_WIN] + (size_t)l * D * DIN, (bf16_t*)(p.ws + OFF_WIN) + (size_t)l * DIN * D, D, DIN, r / 58, r % 58, lds); continue; }
    j -= NT_WIN;
    if (j < NT_WOUT) { const int l = j / 256, r = j % 256;
      transpose_item(p.in[I_WOUT] + (size_t)l * D * D, (bf16_t*)(p.ws + OFF_WOUT) + (size_t)l * D * D, D, D, r / 16, r % 16, lds); continue; }
    j -= NT_WOUT;
    if (j < NT_W1) { const int l = j / 1024, r = j % 1024;
      transpose_item(p.in[I_FW1] + (size_t)l * D * FF, (bf16_t*)(p.ws + OFF_W1) + (size_t)l * FF * D, D, FF, r / 64, r % 64, lds); continue; }
    j -= NT_W1;
    { const int l = j / 1024, r = j % 1024;
      transpose_item(p.in[I_FW2] + (size_t)l * FF * D, (bf16_t*)(p.ws + OFF_W2) + (size_t)l * D * FF, FF, D, r / 16, r % 16, lds); }
  }
}

DEV void row_phase(const Params& p, int mode, int l) {
  const int lane = tid() & 63;
  const int nw = gridDim.x * 4;
  const float* MOD = (const float*)(p.ws + OFF_MOD);
  const float* NG = p.in[I_NORMG];
  const float* U = (const float*)(p.ws + OFF_U);
  bf16_t* H = (bf16_t*)(p.ws + OFF_H);
  for (int row = blockIdx.x * 4 + (tid() >> 6); row < MT; row += nw) {
    const int cond = row < NCTX ? 0 : 1 + ((row - NCTX) >> 10);
    float4 x[4];
    float* xo = p.out + (size_t)row * D;
    if (mode == 0) {
      const float* src = row < NCTX ? p.in[I_XP] + (size_t)row * D : p.in[I_XS] + (size_t)(row - NCTX) * D;
#pragma unroll
      for (int i = 0; i < 4; ++i) x[i] = *(const float4*)(src + i * 256 + lane * 4);
    } else {
      float4 u[4]; float ss = 0;
#pragma unroll
      for (int i = 0; i < 4; ++i) {
        x[i] = *(const float4*)(xo + i * 256 + lane * 4);
        u[i] = *(const float4*)(U + (size_t)row * D + i * 256 + lane * 4);
        ss += u[i].x * u[i].x + u[i].y * u[i].y + u[i].z * u[i].z + u[i].w * u[i].w;
      }
      ss = wave_sum(ss);
      const float r = rsqrtf(ss * (1.0f / 1024.0f) + 1e-6f);
      const float* gate = MOD + (size_t)(l * 3 + cond) * 6144 + (mode == 1 ? 2 : 5) * 1024;
      const float* ga = NG + (size_t)(l * 4 + (mode == 1 ? 1 : 3)) * 1024;
#pragma unroll
      for (int i = 0; i < 4; ++i) {
        const float4 g4 = *(const float4*)(gate + i * 256 + lane * 4);
        const float4 a4 = *(const float4*)(ga + i * 256 + lane * 4);
        x[i].x += g4.x * (u[i].x * r * a4.x); x[i].y += g4.y * (u[i].y * r * a4.y);
        x[i].z += g4.z * (u[i].z * r * a4.z); x[i].w += g4.w * (u[i].w * r * a4.w);
      }
    }
#pragma unroll
    for (int i = 0; i < 4; ++i) *(float4*)(xo + i * 256 + lane * 4) = x[i];
    if (mode == 2 && l == 3) continue;
    const int ln = (mode == 0) ? 0 : (mode == 1 ? l : l + 1);
    const int gi = (mode == 1) ? 2 : 0, shi = (mode == 1) ? 3 : 0, sci = (mode == 1) ? 4 : 1;
    float ss = 0;
#pragma unroll
    for (int i = 0; i < 4; ++i) ss += x[i].x * x[i].x + x[i].y * x[i].y + x[i].z * x[i].z + x[i].w * x[i].w;
    ss = wave_sum(ss);
    const float r2 = rsqrtf(ss * (1.0f / 1024.0f) + 1e-6f);
    const float* gb = NG + (size_t)(ln * 4 + gi) * 1024;
    const float* sh = MOD + (size_t)(ln * 3 + cond) * 6144 + shi * 1024;
    const float* sc = MOD + (size_t)(ln * 3 + cond) * 6144 + sci * 1024;
#pragma unroll
    for (int i = 0; i < 4; ++i) {
      const float4 g4 = *(const float4*)(gb + i * 256 + lane * 4);
      const float4 s4 = *(const float4*)(sc + i * 256 + lane * 4);
      const float4 h4 = *(const float4*)(sh + i * 256 + lane * 4);
      const float h0 = x[i].x * r2 * g4.x * (1.0f + s4.x) + h4.x;
      const float h1 = x[i].y * r2 * g4.y * (1.0f + s4.y) + h4.y;
      const float h2 = x[i].z * r2 * g4.z * (1.0f + s4.z) + h4.z;
      const float h3 = x[i].w * r2 * g4.w * (1.0f + s4.w) + h4.w;
      uint2 o; o.x = pk2(h0, h1); o.y = pk2(h2, h3);
      *(uint2*)(H + (size_t)row * D + i * 256 + lane * 4) = o;
    }
  }
}

template <int EPI>
DEV void gemm_tile(const Params& p, int l, const bf16_t* __restrict__ A, int lda, const bf16_t* __restrict__ BT, int K, int mt, int nt, char* lds) {
  const int t = tid(), lane = t & 63, w = t >> 6, wm = w >> 1, wn = w & 1, l31 = lane & 31, hh = lane >> 5;
  char* sA = lds; char* sB = lds + 32768;
  const int lrow = t >> 3, lc = t & 7;
  const int loff = lrow * 128 + ((lc ^ ((lrow >> 1) & 7)) << 4);
  const bf16_t* gA = A + (size_t)(mt * 128 + lrow) * lda + lc * 8;
  const bf16_t* gB = BT + (size_t)(nt * 128 + lrow) * K + lc * 8;
  uint4 ra[4], rb[4];
  f32x16 acc[2][2];
#pragma unroll
  for (int i = 0; i < 2; ++i)
#pragma unroll
    for (int j = 0; j < 2; ++j)
#pragma unroll
      for (int r = 0; r < 16; ++r) acc[i][j][r] = 0.f;
  const int nk = K >> 6;
#pragma unroll
  for (int i = 0; i < 4; ++i) { ra[i] = *(const uint4*)(gA + (size_t)(32 * i) * lda); rb[i] = *(const uint4*)(gB + (size_t)(32 * i) * K); }
#pragma unroll
  for (int i = 0; i < 4; ++i) { *(uint4*)(sA + loff + i * 4096) = ra[i]; *(uint4*)(sB + loff + i * 4096) = rb[i]; }
  __syncthreads();
  int offA[2], offB[2];
#pragma unroll
  for (int i = 0; i < 2; ++i) { offA[i] = (wm * 64 + i * 32 + l31) * 128; offB[i] = (wn * 64 + i * 32 + l31) * 128; }
  const int swzA = (l31 >> 1) & 7;
  for (int kt = 0; kt < nk; ++kt) {
    const int cur = kt & 1;
    if (kt + 1 < nk) {
#pragma unroll
      for (int i = 0; i < 4; ++i) { ra[i] = *(const uint4*)(gA + (size_t)(32 * i) * lda + (kt + 1) * 64); rb[i] = *(const uint4*)(gB + (size_t)(32 * i) * K + (kt + 1) * 64); }
    }
    const char* a0 = sA + cur * 16384; const char* b0 = sB + cur * 16384;
#pragma unroll
    for (int s = 0; s < 4; ++s) {
      const int co = (((s * 2 + hh) ^ swzA) << 4);
      bf16x8 af[2], bfr[2];
#pragma unroll
      for (int i = 0; i < 2; ++i) { af[i] = *(const bf16x8*)(a0 + offA[i] + co); bfr[i] = *(const bf16x8*)(b0 + offB[i] + co); }
#pragma unroll
      for (int i = 0; i < 2; ++i)
#pragma unroll
        for (int j = 0; j < 2; ++j) acc[i][j] = MFMA32(af[i], bfr[j], acc[i][j]);
    }
    if (kt + 1 < nk) {
      char* a1 = sA + (cur ^ 1) * 16384; char* b1 = sB + (cur ^ 1) * 16384;
#pragma unroll
      for (int i = 0; i < 4; ++i) { *(uint4*)(a1 + loff + i * 4096) = ra[i]; *(uint4*)(b1 + loff + i * 4096) = rb[i]; }
    }
    __syncthreads();
  }
#pragma unroll
  for (int i = 0; i < 2; ++i)
#pragma unroll
    for (int j = 0; j < 2; ++j) {
      const int cg0 = nt * 128 + wn * 64 + j * 32;
      const int col = cg0 + l31;
#pragma unroll
      for (int r = 0; r < 16; ++r) {
        const int row = mt * 128 + wm * 64 + i * 32 + (r & 3) + 8 * (r >> 2) + 4 * hh;
        const float v = acc[i][j][r];
        if (EPI == 0) {
          ((bf16_t*)(p.ws + OFF_P))[(size_t)row * DIN + col] = f2bf(v);
          if (row < NCTX) {
            if (cg0 >= C_NK && cg0 < C_HQ) {
              const int kv = cg0 >= C_NV;
              p.out[O_NAT + (size_t)(((row >> 8) * 4 + l) * 2 + kv) * 65536 + (row & 255) * 256 + (col - (kv ? C_NV : C_NK))] = v;
            } else if (cg0 >= C_SK) {
              const int kv = cg0 >= C_SV;
              p.out[O_SWA + (size_t)(((row >> 8) * 4 + l) * 2 + kv) * 32768 + (row & 255) * 128 + (col - (kv ? C_SV : C_SK))] = v;
            }
          }
        } else if (EPI == 1) {
          ((float*)(p.ws + OFF_U))[(size_t)row * D + col] = v;
        } else {
          const float rl = fmaxf(v, 0.f);
          ((bf16_t*)(p.ws + OFF_HID))[(size_t)row * FF + col] = f2bf(rl * rl);
        }
      }
    }
}

template <int EPI>
DEV void gemm_phase(const Params& p, int l, const bf16_t* A, int lda, const bf16_t* BT, int K, int N, char* lds) {
  const int ntn = N / 128, ntiles = (MT / 128) * ntn;
  for (int tile = blockIdx.x; tile < ntiles; tile += gridDim.x) gemm_tile<EPI>(p, l, A, lda, BT, K, tile / ntn, tile % ntn, lds);
}

DEV void prep_item(const Params& p, int l, int tile, char* lds) {
  const int t = tid(), r0 = tile * 16, c = t;
  int T, seq0;
  if (r0 < NCTX) { T = 256; seq0 = r0 & ~255; } else { T = 1024; seq0 = NCTX + ((r0 - NCTX) & ~1023); }
  float* sT = (float*)lds;
  float* swl = sT + 2048;
  float* sal = swl + 4096;
  const bf16_t* P = (const bf16_t*)(p.ws + OFF_P);
  float* PREP = (float*)(p.ws + OFF_PREP);
  float* BON = (float*)(p.ws + OFF_BONUS);
  for (int dir = 0; dir < 2; ++dir) {
    __syncthreads();
#pragma unroll
    for (int i = 0; i < 8; ++i) {
      const int e = t + 256 * i, tk = e >> 7, j = e & 127, which = j >> 6, jj = j & 63;
      const int row = r0 + tk, prow = dir ? row + 1 : row - 1;
      const bool pv = dir ? (row + 1 < seq0 + T) : (row > seq0);
      const int col = (dir ? C_WHB : C_WHF) + which * 64 + jj;
      const float cur = bf2f(P[(size_t)row * DIN + col]);
      const float prev = pv ? bf2f(P[(size_t)prow * DIN + col]) : 0.f;
      const float mu = p.in[I_MULORA][((l * 2 + dir) * 2 + which) * 64 + jj];
      float val = cur + (prev - cur) * mu;
      if (which == 0) val = tanhf_(val);
      sT[j * 16 + tk] = val;
    }
    __syncthreads();
    {
      const float* w2p = p.in[I_W2] + (size_t)(l * 2 + dir) * 64 * 256 + c;
      const float* a2p = p.in[I_A2] + (size_t)(l * 2 + dir) * 64 * 256 + c;
      float aw[16], aa[16];
#pragma unroll
      for (int k = 0; k < 16; ++k) { aw[k] = 0.f; aa[k] = 0.f; }
#pragma unroll 4
      for (int j = 0; j < 64; ++j) {
        const float w2j = w2p[j * 256], a2j = a2p[j * 256];
#pragma unroll
        for (int k4 = 0; k4 < 4; ++k4) {
          const float4 th4 = *(const float4*)(sT + j * 16 + k4 * 4);
          const float4 ah4 = *(const float4*)(sT + (64 + j) * 16 + k4 * 4);
          aw[k4 * 4 + 0] += th4.x * w2j; aw[k4 * 4 + 1] += th4.y * w2j; aw[k4 * 4 + 2] += th4.z * w2j; aw[k4 * 4 + 3] += th4.w * w2j;
          aa[k4 * 4 + 0] += ah4.x * a2j; aa[k4 * 4 + 1] += ah4.y * a2j; aa[k4 * 4 + 2] += ah4.z * a2j; aa[k4 * 4 + 3] += ah4.w * a2j;
        }
      }
#pragma unroll
      for (int k = 0; k < 16; ++k) { swl[k * 256 + c] = aw[k]; sal[k * 256 + c] = aa[k]; }
    }
    const float w0v = p.in[I_W0][(l * 2 + dir) * 256 + c], a0v = p.in[I_A0][(l * 2 + dir) * 256 + c];
    const float kkv = p.in[I_KK][l * 256 + c], kav = p.in[I_KA][l * 256 + c], rkv = p.in[I_RK][l * 256 + c];
    const float mur = p.in[I_MURKV][((l * 2 + dir) * 3 + 0) * 256 + c], muk = p.in[I_MURKV][((l * 2 + dir) * 3 + 1) * 256 + c],
                muv = p.in[I_MURKV][((l * 2 + dir) * 3 + 2) * 256 + c];
    float* pr = PREP + (size_t)dir * 6 * ARRF;
#pragma unroll 1
    for (int tk = 0; tk < 16; ++tk) {
      const int row = r0 + tk, prow = dir ? row + 1 : row - 1;
      const bool pv = dir ? (row + 1 < seq0 + T) : (row > seq0);
      const bf16_t* pc = P + (size_t)row * DIN + c;
      const bf16_t* pp = P + (size_t)prow * DIN + c;
      const float rc = bf2f(pc[C_R]), kc = bf2f(pc[C_K]), vc = bf2f(pc[C_V]);
      const float rp = pv ? bf2f(pp[C_R]) : 0.f, kp0 = pv ? bf2f(pp[C_K]) : 0.f, vp = pv ? bf2f(pp[C_V]) : 0.f;
      const float rs = rc + (rp - rc) * mur, ks = kc + (kp0 - kc) * muk, vs = vc + (vp - vc) * muv;
      const float wl = w0v + swl[tk * 256 + c], al = a0v + sal[tk * 256 + c];
      const float wv = __expf(-0.6065306597126334f * sigmoidf_(wl));
      const float av = sigmoidf_(al);
      const float kkr = ks * kkv;
      const float n2 = wave_sum(kkr * kkr);
      const float kk = kkr / fmaxf(sqrtf(n2), 1e-12f);
      const float kp = ks * (1.0f + (av - 1.0f) * kav);
      const float bs = wave_sum(rs * kp * rkv);
      const float bon = bs * vs;
      const size_t idx = (size_t)row * 256 + c;
      pr[idx] = rs; pr[ARRF + idx] = wv; pr[2 * ARRF + idx] = kp; pr[3 * ARRF + idx] = vs; pr[4 * ARRF + idx] = kk; pr[5 * ARRF + idx] = kk * av;
      if (dir == 0) BON[idx] = bon; else BON[idx] += bon;
    }
  }
  __syncthreads();
}

DEV void rope_item(const Params& p, int item) {
  bf16_t* P = (bf16_t*)(p.ws + OFF_P);
  const int t = tid();
  for (int e = t; e < 64 * 192; e += 256) {
    const int tk = e / 192, r = e % 192, hs = r >> 5, pi = r & 31;
    const int lt = item * 64 + tk;
    const int tt = lt & 1023;
    const int grow = tt >> 6, gcol = tt & 63;
    const int fi = pi & 15;
    const float pos = (pi < 16) ? (float)grow : (float)gcol;
    const float inv = exp2f(-(float)fi * (13.287712379549449f / 16.0f));
    const float ang = pos * inv;
    const float cs = __cosf(ang), sn = __sinf(ang);
    const int d1 = (pi < 16) ? fi : 32 + fi;
    bf16_t* base = P + (size_t)(NCTX + lt) * DIN + C_SQ + hs * 64;
    const float x1 = bf2f(base[d1]), x2 = bf2f(base[d1 + 16]);
    base[d1] = f2bf(x1 * cs - x2 * sn);
    base[d1 + 16] = f2bf(x2 * cs + x1 * sn);
  }
}

DEV void rwkv_scan(const Params& p, int l, int seq, int head, int dir, int rg, char* lds) {
  const int t = tid(), rl = t >> 4, ks = t & 15;
  const int T = seq < 32 ? 256 : 1024;
  const int row0 = seq < 32 ? seq * 256 : NCTX + (seq - 32) * 1024;
  const float* prep = (const float*)(p.ws + OFF_PREP) + (size_t)dir * 6 * ARRF;
  float* ydir = (float*)(p.ws + OFF_YDIR) + (size_t)dir * ARRF;
  float4* sbuf = (float4*)lds;
  float* vbuf = (float*)(lds + 20480);
  float* ybuf = vbuf + 256;
  float4 S = make_float4(0.f, 0.f, 0.f, 0.f);
  if (seq >= 32) S = *(const float4*)(p.in[I_SRW] + ((((size_t)(seq - 32) * 4 + l) * 2 + dir) * 4 + head) * 4096 + (rg * 16 + rl) * 64 + ks * 4);
  const int nch = T >> 4;
  float4 pre0, pre1, pre2, pre3, pre4; float prev;
  {
    const int s = rl; const int tok = dir ? (T - 1 - s) : s;
    const size_t base = (size_t)(row0 + tok) * 256 + head * 64;
    pre0 = *(const float4*)(prep + base + ks * 4);
    pre1 = *(const float4*)(prep + ARRF + base + ks * 4);
    pre2 = *(const float4*)(prep + 2 * ARRF + base + ks * 4);
    pre3 = *(const float4*)(prep + 4 * ARRF + base + ks * 4);
    pre4 = *(const float4*)(prep + 5 * ARRF + base + ks * 4);
    prev = prep[3 * ARRF + base + rg * 16 + ks];
  }
  for (int c = 0; c < nch; ++c) {
    __syncthreads();
    sbuf[(0 * 16 + rl) * 16 + ks] = pre0; sbuf[(1 * 16 + rl) * 16 + ks] = pre1; sbuf[(2 * 16 + rl) * 16 + ks] = pre2;
    sbuf[(3 * 16 + rl) * 16 + ks] = pre3; sbuf[(4 * 16 + rl) * 16 + ks] = pre4;
    vbuf[rl * 16 + ks] = prev;
    __syncthreads();
    if (c + 1 < nch) {
      const int s = (c + 1) * 16 + rl; const int tok = dir ? (T - 1 - s) : s;
      const size_t base = (size_t)(row0 + tok) * 256 + head * 64;
      pre0 = *(const float4*)(prep + base + ks * 4);
      pre1 = *(const float4*)(prep + ARRF + base + ks * 4);
      pre2 = *(const float4*)(prep + 2 * ARRF + base + ks * 4);
      pre3 = *(const float4*)(prep + 4 * ARRF + base + ks * 4);
      pre4 = *(const float4*)(prep + 5 * ARRF + base + ks * 4);
      prev = prep[3 * ARRF + base + rg * 16 + ks];
    }
#pragma unroll 4
    for (int i = 0; i < 16; ++i) {
      const float4 r = sbuf[(0 * 16 + i) * 16 + ks], wv = sbuf[(1 * 16 + i) * 16 + ks], kv = sbuf[(2 * 16 + i) * 16 + ks],
                   kk = sbuf[(3 * 16 + i) * 16 + ks], ka = sbuf[(4 * 16 + i) * 16 + ks];
      const float v = vbuf[i * 16 + rl];
      float sa = S.x * kk.x + S.y * kk.y + S.z * kk.z + S.w * kk.w;
      sa = -row16_sum(sa);
      S.x = S.x * wv.x + sa * ka.x + v * kv.x;
      S.y = S.y * wv.y + sa * ka.y + v * kv.y;
      S.z = S.z * wv.z + sa * ka.z + v * kv.z;
      S.w = S.w * wv.w + sa * ka.w + v * kv.w;
      float y = S.x * r.x + S.y * r.y + S.z * r.z + S.w * r.w;
      y = row16_sum(y);
      if (ks == 0) ybuf[i * 16 + rl] = y;
    }
    __syncthreads();
    {
      const int s = c * 16 + rl; const int tok = dir ? (T - 1 - s) : s;
      ydir[(size_t)(row0 + tok) * 256 + head * 64 + rg * 16 + ks] = ybuf[rl * 16 + ks];
    }
  }
  if (seq < 32) *(float4*)(p.out + O_RW + ((((size_t)seq * 4 + l) * 2 + dir) * 4 + head) * 4096 + (rg * 16 + rl) * 64 + ks * 4) = S;
  __syncthreads();
}

DEV void hgrn_scan(const Params& p, int l, int seq, int head, int dir, int rg, char* lds) {
  const int t = tid(), rl = t >> 4, ks = t & 15;
  const int T = seq < 32 ? 256 : 1024;
  const int row0 = seq < 32 ? seq * 256 : NCTX + (seq - 32) * 1024;
  const bf16_t* P = (const bf16_t*)(p.ws + OFF_P);
  float* odir = (float*)(p.ws + OFF_HDIR) + (size_t)dir * ARRF;
  float4* sbuf = (float4*)lds;
  float* vbuf = (float*)(lds + 20480);
  float* ybuf = vbuf + 256;
  const float4 lb4 = *(const float4*)((const float*)(p.ws + OFF_HGLB) + (l * 2 + dir) * 256 + head * 64 + ks * 4);
  const int vrow = rg * 16 + rl;
  float4 S = make_float4(0.f, 0.f, 0.f, 0.f);
  if (seq >= 32) {
    const float* sp = p.in[I_SHG] + ((((size_t)(seq - 32) * 4 + l) * 2 + dir) * 4 + head) * 4096;
    S.x = sp[(ks * 4 + 0) * 64 + vrow]; S.y = sp[(ks * 4 + 1) * 64 + vrow]; S.z = sp[(ks * 4 + 2) * 64 + vrow]; S.w = sp[(ks * 4 + 3) * 64 + vrow];
  }
  const int nch = T >> 4;
  const int fcol = (dir ? C_HFB : C_HFF) + head * 64;
  uint2 pq, pf; bf16_t pvv;
  {
    const int s = rl; const int tok = dir ? (T - 1 - s) : s;
    const bf16_t* pr = P + (size_t)(row0 + tok) * DIN;
    pq = *(const uint2*)(pr + C_HQ + head * 64 + ks * 4);
    pf = *(const uint2*)(pr + fcol + ks * 4);
    pvv = pr[C_HI + head * 64 + rg * 16 + ks];
  }
  for (int c = 0; c < nch; ++c) {
    __syncthreads();
    {
      float4 q, f, k;
      float a;
      a = bflo(pq.x); q.x = a * sigmoidf_(a); a = bfhi(pq.x); q.y = a * sigmoidf_(a);
      a = bflo(pq.y); q.z = a * sigmoidf_(a); a = bfhi(pq.y); q.w = a * sigmoidf_(a);
      float sg;
      sg = sigmoidf_(bflo(pf.x)); f.x = lb4.x + (1.f - lb4.x) * sg; k.x = (1.f - lb4.x) * (1.f - sg);
      sg = sigmoidf_(bfhi(pf.x)); f.y = lb4.y + (1.f - lb4.y) * sg; k.y = (1.f - lb4.y) * (1.f - sg);
      sg = sigmoidf_(bflo(pf.y)); f.z = lb4.z + (1.f - lb4.z) * sg; k.z = (1.f - lb4.z) * (1.f - sg);
      sg = sigmoidf_(bfhi(pf.y)); f.w = lb4.w + (1.f - lb4.w) * sg; k.w = (1.f - lb4.w) * (1.f - sg);
      sbuf[(0 * 16 + rl) * 16 + ks] = q; sbuf[(1 * 16 + rl) * 16 + ks] = f; sbuf[(2 * 16 + rl) * 16 + ks] = k;
      vbuf[rl * 16 + ks] = bf2f(pvv);
    }
    __syncthreads();
    if (c + 1 < nch) {
      const int s = (c + 1) * 16 + rl; const int tok = dir ? (T - 1 - s) : s;
      const bf16_t* pr = P + (size_t)(row0 + tok) * DIN;
      pq = *(const uint2*)(pr + C_HQ + head * 64 + ks * 4);
      pf = *(const uint2*)(pr + fcol + ks * 4);
      pvv = pr[C_HI + head * 64 + rg * 16 + ks];
    }
#pragma unroll 4
    for (int i = 0; i < 16; ++i) {
      const float4 q = sbuf[(0 * 16 + i) * 16 + ks], f = sbuf[(1 * 16 + i) * 16 + ks], k = sbuf[(2 * 16 + i) * 16 + ks];
      const float v = vbuf[i * 16 + rl];
      S.x = S.x * f.x + k.x * v; S.y = S.y * f.y + k.y * v; S.z = S.z * f.z + k.z * v; S.w = S.w * f.w + k.w * v;
      float y = S.x * q.x + S.y * q.y + S.z * q.z + S.w * q.w;
      y = row16_sum(y);
      if (ks == 0) ybuf[i * 16 + rl] = y;
    }
    __syncthreads();
    {
      const int s = c * 16 + rl; const int tok = dir ? (T - 1 - s) : s;
      odir[(size_t)(row0 + tok) * 256 + head * 64 + rg * 16 + ks] = ybuf[rl * 16 + ks];
    }
  }
  if (seq < 32) {
    float* sp = p.out + O_HG + ((((size_t)seq * 4 + l) * 2 + dir) * 4 + head) * 4096;
    sp[(ks * 4 + 0) * 64 + vrow] = S.x; sp[(ks * 4 + 1) * 64 + vrow] = S.y; sp[(ks * 4 + 2) * 64 + vrow] = S.z; sp[(ks * 4 + 3) * 64 + vrow] = S.w;
  }
  __syncthreads();
}

template <int MODE>
DEV void attn_item(const Params& p, int l, int item, char* lds) {
  const int t = tid(), lane = t & 63, w = t >> 6, q = lane & 31, hh = lane >> 5;
  const bf16_t* P = (const bf16_t*)(p.ws + OFF_P);
  bf16_t* Y = (bf16_t*)(p.ws + OFF_YMIX);
  char* sK = lds;
  char* sV = lds + 8192;
  float* sBias = (float*)(lds + 8192 + 8704);
  int head, qrow, qcol, kcol, vcol, ocol, nloc, nt, rowbaseP;
  int qr = 0, qc = 0, rlo = 0, qpos = 0, lo = 0, rsq = 0, wsq = 0;
  float sink = 0.f;
  const float* cache = nullptr; int cH = 1, cHead = 0;
  if (MODE == 0 || MODE == 1) {
    const int b = item >> 3; head = (item >> 1) & 3; const int half = item & 1;
    rowbaseP = b * 256; qrow = rowbaseP + half * 128 + w * 32 + q; nloc = 4; nt = 4;
  } else {
    const int b = item >> 5; head = (item >> 3) & 3; const int sub = item & 7;
    rowbaseP = NCTX + b * 1024;
    if (MODE == 2) {
      qr = 2 * sub + (w >> 1); qc = (w & 1) * 32 + q; qrow = rowbaseP + qr * 64 + qc;
      rlo = clampi(2 * sub - 4, 0, 8); const int rhi = clampi(2 * sub - 3, 0, 8) + 7; nloc = rhi - rlo + 1; nt = nloc + 4;
      rsq = clampi(qr - 4, 0, 8); wsq = clampi(qc - 8, 0, 48);
      cache = p.in[I_CNAT] + (size_t)((b * 4 + l) * 2) * 256 * 256; cH = 4; cHead = head;
      for (int i = t; i < 465; i += 256) sBias[i] = p.in[I_RPB][(size_t)(l * 4 + head) * 465 + i];
    } else {
      qpos = sub * 128 + w * 32 + q; qrow = rowbaseP + qpos;
      lo = (sub - 1) * 128; if (lo < 0) lo = 0; int hi = (sub + 2) * 128; if (hi > 1024) hi = 1024;
      nloc = (hi - lo) >> 6; nt = nloc + 4;
      cache = p.in[I_CSWA] + (size_t)((b * 4 + l) * 2) * 256 * 128; cH = 2; cHead = head >> 1;
    }
  }
  if (MODE == 0 || MODE == 2) { qcol = C_NQ + head * 64; kcol = C_NK + head * 64; vcol = C_NV + head * 64; ocol = 256 + head * 64; }
  else { qcol = C_SQ + head * 64; kcol = C_SK + (head >> 1) * 64; vcol = C_SV + (head >> 1) * 64; ocol = 768 + head * 64; sink = p.in[I_SINK][l * 4 + head]; }

  bf16x8 bq[4];
#pragma unroll
  for (int s = 0; s < 4; ++s) bq[s] = *(const bf16x8*)(P + (size_t)qrow * DIN + qcol + 16 * s + 8 * hh);
  f32x16 oacc[2];
#pragma unroll
  for (int r = 0; r < 16; ++r) { oacc[0][r] = 0.f; oacc[1][r] = 0.f; }
  float m_run = -1e30f, l_run = 0.f;
  const int key = t >> 2, dq = t & 3;
  const int kswz = (key >> 1) & 7;
  for (int j = 0; j < nt; ++j) {
    uint4 kr[2], vr[2];
    const bool isP = j < nloc;
    int keybase = 0;
    if (isP) {
      if (MODE == 0 || MODE == 1) keybase = rowbaseP + j * 64;
      else if (MODE == 2) keybase = rowbaseP + (rlo + j) * 64;
      else keybase = rowbaseP + lo + j * 64;
      const bf16_t* kp = P + (size_t)(keybase + key) * DIN + kcol + dq * 16;
      const bf16_t* vp = P + (size_t)(keybase + key) * DIN + vcol + dq * 16;
      kr[0] = *(const uint4*)kp; kr[1] = *(const uint4*)(kp + 8);
      vr[0] = *(const uint4*)vp; vr[1] = *(const uint4*)(vp + 8);
    } else {
      const int ct = (j - nloc) * 64 + key;
      const float* kp = cache + ((size_t)ct * cH + cHead) * 64 + dq * 16;
      const float* vp = kp + (size_t)256 * cH * 64;
      const float4 k0 = *(const float4*)kp, k1 = *(const float4*)(kp + 4), k2 = *(const float4*)(kp + 8), k3 = *(const float4*)(kp + 12);
      const float4 v0 = *(const float4*)vp, v1 = *(const float4*)(vp + 4), v2 = *(const float4*)(vp + 8), v3 = *(const float4*)(vp + 12);
      kr[0].x = pk2(k0.x, k0.y); kr[0].y = pk2(k0.z, k0.w); kr[0].z = pk2(k1.x, k1.y); kr[0].w = pk2(k1.z, k1.w);
      kr[1].x = pk2(k2.x, k2.y); kr[1].y = pk2(k2.z, k2.w); kr[1].z = pk2(k3.x, k3.y); kr[1].w = pk2(k3.z, k3.w);
      vr[0].x = pk2(v0.x, v0.y); vr[0].y = pk2(v0.z, v0.w); vr[0].z = pk2(v1.x, v1.y); vr[0].w = pk2(v1.z, v1.w);
      vr[1].x = pk2(v2.x, v2.y); vr[1].y = pk2(v2.z, v2.w); vr[1].z = pk2(v3.x, v3.y); vr[1].w = pk2(v3.z, v3.w);
    }
    __syncthreads();
    *(uint4*)(sK + key * 128 + (((dq * 2 + 0) ^ kswz) << 4)) = kr[0];
    *(uint4*)(sK + key * 128 + (((dq * 2 + 1) ^ kswz) << 4)) = kr[1];
    {
      bf16_t* vt = (bf16_t*)sV;
      const unsigned vv[8] = {vr[0].x, vr[0].y, vr[0].z, vr[0].w, vr[1].x, vr[1].y, vr[1].z, vr[1].w};
#pragma unroll
      for (int e = 0; e < 8; ++e) {
        vt[(dq * 16 + 2 * e) * 68 + key] = (bf16_t)(vv[e] & 0xffffu);
        vt[(dq * 16 + 2 * e + 1) * 68 + key] = (bf16_t)(vv[e] >> 16);
      }
    }
    __syncthreads();
    f32x16 sacc[2];
#pragma unroll
    for (int r = 0; r < 16; ++r) { sacc[0][r] = 0.f; sacc[1][r] = 0.f; }
    const int qswz = (q >> 1) & 7;
#pragma unroll
    for (int s = 0; s < 4; ++s) {
      const int co = (((s * 2 + hh) ^ qswz) << 4);
      const bf16x8 a0 = *(const bf16x8*)(sK + q * 128 + co);
      const bf16x8 a1 = *(const bf16x8*)(sK + (32 + q) * 128 + co);
      sacc[0] = MFMA32(a0, bq[s], sacc[0]);
      sacc[1] = MFMA32(a1, bq[s], sacc[1]);
    }
    float mx = -1e30f;
#pragma unroll
    for (int sub = 0; sub < 2; ++sub)
#pragma unroll
      for (int r = 0; r < 16; ++r) {
        const int kidx = sub * 32 + (r & 3) + 8 * (r >> 2) + 4 * hh;
        float v = sacc[sub][r] * 0.125f;
        bool ok = true;
        if (MODE == 2 && isP) {
          const int kr_ = rlo + j, kc_ = kidx;
          ok = (kr_ >= rsq) && (kr_ < rsq + 8) && (kc_ >= wsq) && (kc_ < wsq + 16);
          const int bi = ok ? ((kr_ - qr + 7) * 31 + (kc_ - qc + 15)) : 0;
          v += sBias[bi];
        }
        if (MODE == 3 && isP) {
          const int dlt = lo + j * 64 + kidx - qpos;
          ok = (dlt <= 128) && (dlt >= -128);
        }
        v = ok ? v : -1e30f;
        sacc[sub][r] = v;
        mx = fmaxf(mx, v);
      }
    mx = fmaxf(mx, __shfl_xor(mx, 32));
    const float m_new = fmaxf(m_run, mx);
    const float alpha = __expf(m_run - m_new);
    float rsum = 0.f;
#pragma unroll
    for (int sub = 0; sub < 2; ++sub)
#pragma unroll
      for (int r = 0; r < 16; ++r) {
        const float v = sacc[sub][r];
        const float pv = (v > -1e29f) ? __expf(v - m_new) : 0.f;
        sacc[sub][r] = pv; rsum += pv;
      }
    rsum += __shfl_xor(rsum, 32);
    l_run = l_run * alpha + rsum; m_run = m_new;
#pragma unroll
    for (int r = 0; r < 16; ++r) { oacc[0][r] *= alpha; oacc[1][r] *= alpha; }
#pragma unroll
    for (int k4 = 0; k4 < 4; ++k4) {
      const int sub = k4 >> 1, s2 = k4 & 1;
      uint4 pbu;
      pbu.x = pk2(sacc[sub][8 * s2 + 0], sacc[sub][8 * s2 + 1]); pbu.y = pk2(sacc[sub][8 * s2 + 2], sacc[sub][8 * s2 + 3]);
      pbu.z = pk2(sacc[sub][8 * s2 + 4], sacc[sub][8 * s2 + 5]); pbu.w = pk2(sacc[sub][8 * s2 + 6], sacc[sub][8 * s2 + 7]);
      const bf16x8 pb = __builtin_bit_cast(bf16x8, pbu);
#pragma unroll
      for (int dt = 0; dt < 2; ++dt) {
        const char* vp = sV + (dt * 32 + q) * 136 + (16 * k4 + 4 * hh) * 2;
        const uint2 lo8 = *(const uint2*)vp, hi8 = *(const uint2*)(vp + 16);
        uint4 avu; avu.x = lo8.x; avu.y = lo8.y; avu.z = hi8.x; avu.w = hi8.y;
        oacc[dt] = MFMA32(__builtin_bit_cast(bf16x8, avu), pb, oacc[dt]);
      }
    }
  }
  float scale;
  if (MODE == 1 || MODE == 3) {
    const float m_f = fmaxf(m_run, sink);
    const float e = __expf(m_run - m_f);
    scale = e / (l_run * e + __expf(sink - m_f));
  } else scale = 1.0f / l_run;
#pragma unroll
  for (int dt = 0; dt < 2; ++dt)
#pragma unroll
    for (int g4 = 0; g4 < 4; ++g4) {
      const int d = dt * 32 + 8 * g4 + 4 * hh;
      uint2 o; o.x = pk2(oacc[dt][4 * g4] * scale, oacc[dt][4 * g4 + 1] * scale); o.y = pk2(oacc[dt][4 * g4 + 2] * scale, oacc[dt][4 * g4 + 3] * scale);
      *(uint2*)(Y + (size_t)qrow * D + ocol + d) = o;
    }
  __syncthreads();
}

DEV void post_item(const Params& p, int l, int tile, char* lds) {
  const int t = tid(), r0 = tile * 16, c = t;
  float* sT = (float*)lds;
  float* sgo = sT + 2048;
  const bf16_t* P = (const bf16_t*)(p.ws + OFF_P);
  bf16_t* Y = (bf16_t*)(p.ws + OFF_YMIX);
  const float* Y0 = (const float*)(p.ws + OFF_YDIR); const float* Y1 = Y0 + ARRF;
  const float* H0 = (const float*)(p.ws + OFF_HDIR); const float* H1 = H0 + ARRF;
  const float* BON = (const float*)(p.ws + OFF_BONUS);
  __syncthreads();
#pragma unroll
  for (int i = 0; i < 8; ++i) {
    const int e = t + 256 * i, tk = e >> 7, j = e & 127;
    sT[j * 16 + tk] = sigmoidf_(bf2f(P[(size_t)(r0 + tk) * DIN + C_GH + j]));
  }
  __syncthreads();
  {
    const float* g2p = p.in[I_G2] + (size_t)l * 128 * 256 + c;
    float ag[16];
#pragma unroll
    for (int k = 0; k < 16; ++k) ag[k] = 0.f;
#pragma unroll 4
    for (int j = 0; j < 128; ++j) {
      const float gj = g2p[j * 256];
#pragma unroll
      for (int k4 = 0; k4 < 4; ++k4) {
        const float4 s4 = *(const float4*)(sT + j * 16 + k4 * 4);
        ag[k4 * 4 + 0] += s4.x * gj; ag[k4 * 4 + 1] += s4.y * gj; ag[k4 * 4 + 2] += s4.z * gj; ag[k4 * 4 + 3] += s4.w * gj;
      }
    }
#pragma unroll
    for (int k = 0; k < 16; ++k) sgo[k * 256 + c] = ag[k];
  }
  const float lnw = p.in[I_LNW][l * 256 + c], lnb = p.in[I_LNB][l * 256 + c], hgn = p.in[I_HGN][l * 256 + c];
#pragma unroll 1
  for (int tk = 0; tk < 16; ++tk) {
    const int row = r0 + tk;
    const size_t idx = (size_t)row * 256 + c;
    const float y = Y0[idx] + Y1[idx];
    const float mu = wave_sum(y) * (1.0f / 64.0f);
    const float dy = y - mu;
    const float var = wave_sum(dy * dy) * (1.0f / 64.0f);
    const float yn = dy * rsqrtf(var + 64e-5f) * lnw + lnb + BON[idx];
    const float g = sgo[tk * 256 + c];
    Y[(size_t)row * D + c] = f2bf(yn * g);
    const float o = H0[idx] + H1[idx];
    const float ms = wave_sum(o * o) * (1.0f / 64.0f);
    const float gt = sigmoidf_(bf2f(P[(size_t)row * DIN + C_HG + c]));
    Y[(size_t)row * D + 512 + c] = f2bf(o * rsqrtf(ms + 1e-6f) * hgn * gt);
  }
  __syncthreads();
}

DEV void mixer_phase(const Params& p, int l, char* lds) {
  const int nitems = 256 + 2048 + 512;
  for (int it = blockIdx.x; it < nitems; it += gridDim.x) {
    int kind, idx;
    if (it < 64) { kind = 0; idx = 1024 + it; }
    else if (it < 128) { kind = 1; idx = 1024 + it - 64; }
    else if (it < 192) { kind = 5; idx = it - 128; }
    else if (it < 256) { kind = 4; idx = it - 192; }
    else if (it < 1280) { kind = 0; idx = it - 256; }
    else if (it < 2304) { kind = 1; idx = it - 1280; }
    else if (it < 2560) { kind = 2; idx = it - 2304; }
    else { kind = 3; idx = it - 2560; }
    if (kind < 2) {
      const int seq = idx >> 5, rem = idx & 31;
      if (kind == 0) rwkv_scan(p, l, seq, rem >> 3, (rem >> 2) & 1, rem & 3, lds);
      else hgrn_scan(p, l, seq, rem >> 3, (rem >> 2) & 1, rem & 3, lds);
    } else if (kind == 2) attn_item<0>(p, l, idx, lds);
    else if (kind == 3) attn_item<1>(p, l, idx, lds);
    else if (kind == 4) attn_item<2>(p, l, idx, lds);
    else attn_item<3>(p, l, idx, lds);
  }
}

DEV void run_phase(const Params& p, int ph, char* lds) {
  if (ph == 0) { phase0(p, lds); return; }
  if (ph == 1) { row_phase(p, 0, 0); return; }
  const int l = (ph - 2) / 9, s = (ph - 2) % 9;
  const bf16_t* H = (const bf16_t*)(p.ws + OFF_H);
  switch (s) {
    case 0: gemm_phase<0>(p, l, H, D, (const bf16_t*)(p.ws + OFF_WIN) + (size_t)l * DIN * D, D, DIN, lds); break;
    case 1:
      for (int it = blockIdx.x; it < 640 + 32; it += gridDim.x) { if (it < 640) prep_item(p, l, it, lds); else rope_item(p, it - 640); }
      break;
    case 2: mixer_phase(p, l, lds); break;
    case 3: for (int it = blockIdx.x; it < 640; it += gridDim.x) post_item(p, l, it, lds); break;
    case 4: gemm_phase<1>(p, l, (const bf16_t*)(p.ws + OFF_YMIX), D, (const bf16_t*)(p.ws + OFF_WOUT) + (size_t)l * D * D, D, D, lds); break;
    case 5: row_phase(p, 1, l); break;
    case 6: gemm_phase<2>(p, l, H, D, (const bf16_t*)(p.ws + OFF_W1) + (size_t)l * FF * D, D, FF, lds); break;
    case 7: gemm_phase<1>(p, l, (const bf16_t*)(p.ws + OFF_HID), FF, (const bf16_t*)(p.ws + OFF_W2) + (size_t)l * D * FF, FF, D, lds); break;
    case 8: row_phase(p, 2, l); break;
  }
}

__global__ void __launch_bounds__(256, 2) mega(Params p, int ph_lo, int ph_hi) {
  __shared__ __attribute__((aligned(16))) char lds[65536];
  for (int ph = ph_lo; ph < ph_hi; ++ph) {
    run_phase(p, ph, lds);
    if (ph + 1 < ph_hi) cg::this_grid().sync();
  }
}

extern "C" void kernel_launch(void* const* d_in, const int* in_sizes, int n_in, void* d_out, int out_size, void* d_ws, size_t ws_size,
                              hipStream_t stream) {
  static int grid_blocks = 0;
  if (!grid_blocks) {
    int dev = 0, cus = 0, per_cu = 0;
    hipGetDevice(&dev);
    hipDeviceGetAttribute(&cus, hipDeviceAttributeMultiprocessorCount, dev);
    hipOccupancyMaxActiveBlocksPerMultiprocessor(&per_cu, mega, 256, 0);
    if (per_cu > 2) per_cu = 2;
    if (per_cu < 1) per_cu = 1;
    grid_blocks = cus * per_cu;
  }
  if (ws_size < WS_TOTAL) { fprintf(stderr, "workspace too small: %zu < %zu\n", ws_size, (size_t)WS_TOTAL); return; }
  Params p{};
  for (int i = 0; i < 31; ++i) p.in[i] = (const float*)d_in[i];
  p.out = (float*)d_out;
  p.ws = (char*)d_ws;
#if ONE_LAUNCH
  int lo = 0, hi = NPH;
  void* args[] = {&p, &lo, &hi};
  hipError_t e = hipLaunchCooperativeKernel((void*)mega, dim3(grid_blocks), dim3(256), args, 0, stream);
  if (e != hipSuccess) fprintf(stderr, "cooperative launch failed: %s (grid %d)\n", hipGetErrorString(e), grid_blocks);
#else
  for (int ph = 0; ph < NPH; ++ph) mega<<<dim3(grid_blocks), dim3(256), 0, stream>>>(p, ph, ph + 1);
#endif
}
```

```cpp
#include <hip/hip_runtime.h>
#include <hip/hip_cooperative_groups.h>
#include <cstdio>
#include <cstdint>
namespace cg = cooperative_groups;

#ifndef ONE_LAUNCH
#define ONE_LAUNCH 1
#endif
#define PROBE_KIND -1

#define DEV __device__ __forceinline__
typedef unsigned short bf16_t;
typedef short bf16x8 __attribute__((ext_vector_type(8)));
typedef float f32x16 __attribute__((ext_vector_type(16)));
typedef __bf16 bf2_t __attribute__((ext_vector_type(2)));
typedef float f2_t __attribute__((ext_vector_type(2)));

constexpr int D = 1024, DIN = 3712, FF = 4096, NCTX = 8192, MT = 10240;
constexpr int NPH = 38;
constexpr int C_R = 0, C_K = 256, C_V = 512, C_GH = 768, C_WHF = 896, C_WHB = 1024;
constexpr int C_NQ = 1152, C_NK = 1408, C_NV = 1664;
constexpr int C_HQ = 1920, C_HI = 2176, C_HG = 2432, C_HFF = 2688, C_HFB = 2944;
constexpr int C_SQ = 3200, C_SK = 3456, C_SV = 3584;
constexpr size_t O_NAT = 10485760, O_SWA = 27262976, O_RW = 35651584, O_HG = 39845888;
constexpr size_t ARRF = (size_t)MT * 256;
constexpr size_t ARR = ARRF * 4;
constexpr size_t OFF_WIN = 0;
constexpr size_t OFF_WOUT = OFF_WIN + (size_t)4 * DIN * D * 2;
constexpr size_t OFF_W1 = OFF_WOUT + (size_t)4 * D * D * 2;
constexpr size_t OFF_W2 = OFF_W1 + (size_t)4 * FF * D * 2;
constexpr size_t OFF_MOD = OFF_W2 + (size_t)4 * FF * D * 2;
constexpr size_t OFF_HGLB = OFF_MOD + (size_t)4 * 3 * 6144 * 4;
constexpr size_t OFF_P = OFF_HGLB + 8192;
constexpr size_t OFF_R1 = OFF_P + (size_t)MT * DIN * 2;
constexpr size_t OFF_H = OFF_R1;
constexpr size_t OFF_HID = OFF_H + (size_t)MT * D * 2;
constexpr size_t OFF_U = OFF_HID + (size_t)MT * FF * 2;
constexpr size_t OFF_PREP = OFF_R1;
constexpr size_t OFF_YDIR = OFF_PREP + 12 * ARR;
constexpr size_t OFF_BONUS = OFF_R1 + 14 * ARR;
constexpr size_t OFF_HDIR = OFF_BONUS + ARR;
constexpr size_t OFF_YMIX = OFF_HDIR + 2 * ARR;
constexpr size_t OFF_BAR = OFF_YMIX + (size_t)MT * D * 2;
constexpr size_t WS_TOTAL = OFF_BAR + 16384;
static_assert(OFF_U + (size_t)MT * D * 4 == OFF_BONUS, "R1 layout");

struct Params {
  const float* in[31];
  float* out;
  char* ws;
};
enum { I_XP = 0, I_XS, I_CNAT, I_CSWA, I_SRW, I_SHG, I_C, I_CCTX, I_NORMG, I_MODW, I_MODB, I_WIN, I_WOUT, I_MURKV, I_MULORA,
       I_W0, I_W2, I_A0, I_A2, I_G2, I_KK, I_KA, I_RK, I_LNW, I_LNB, I_RPB, I_HGLB, I_HGN, I_SINK, I_FW1, I_FW2 };

DEV bf16_t f2bf(float f) { unsigned u = __float_as_uint(f); u += 0x7fffu + ((u >> 16) & 1u); return (bf16_t)(u >> 16); }
DEV float bf2f(bf16_t h) { return __uint_as_float(((unsigned)h) << 16); }
DEV unsigned pk2(float a, float b) { f2_t v = {a, b}; bf2_t r = __builtin_convertvector(v, bf2_t); return __builtin_bit_cast(unsigned, r); }
DEV float bflo(unsigned u) { return __uint_as_float(u << 16); }
DEV float bfhi(unsigned u) { return __uint_as_float(u & 0xffff0000u); }
DEV float sigmoidf_(float x) { return 1.0f / (1.0f + __expf(-x)); }
DEV float tanhf_(float x) { return 1.0f - 2.0f / (1.0f + __expf(2.0f * x)); }
template <int CTRL> DEV float dppf(float x) { return __int_as_float(__builtin_amdgcn_update_dpp(0, __float_as_int(x), CTRL, 0xF, 0xF, false)); }
DEV float row16_sum(float x) { x += dppf<0xB1>(x); x += dppf<0x4E>(x); x += dppf<0x141>(x); x += dppf<0x140>(x); return x; }
DEV float wave_sum(float x) { x = row16_sum(x); x += __shfl_xor(x, 16); x += __shfl_xor(x, 32); return x; }
DEV int clampi(int v, int lo, int hi) { return v < lo ? lo : (v > hi ? hi : v); }
#define MFMA32(a, b, c) __builtin_amdgcn_mfma_f32_32x32x16_bf16((a), (b), (c), 0, 0, 0)

DEV int tid() { int z; asm volatile("v_mov_b32 %0, 0" : "=v"(z)); return (int)threadIdx.x + z; }
DEV void transpose_item(const float* W, bf16_t* WT, int K, int N, int kt, int nt, char* lds) {
  bf16_t* s = (bf16_t*)lds;
  const int t = tid();
#pragma unroll
  for (int i = 0; i < 4; ++i) {
    const int k = (t >> 4) + 16 * i, n4 = (t & 15) * 4;
    const float4 v = *(const float4*)(W + (size_t)(kt * 64 + k) * N + nt * 64 + n4);
    s[(n4 + 0) * 72 + k] = f2bf(v.x); s[(n4 + 1) * 72 + k] = f2bf(v.y);
    s[(n4 + 2) * 72 + k] = f2bf(v.z); s[(n4 + 3) * 72 + k] = f2bf(v.w);
  }
  __syncthreads();
#pragma unroll
  for (int i = 0; i < 2; ++i) {
    const int n = (t >> 3) + 32 * i, kc = t & 7;
    const uint4 v = *(const uint4*)(s + n * 72 + kc * 8);
    *(uint4*)(WT + (size_t)(nt * 64 + n) * K + kt * 64 + kc * 8) = v;
  }
  __syncthreads();
}

DEV void mod_item(const Params& p, int l, int jb, char* lds) {
  float* sc = (float*)lds;
  float* red = (float*)(lds + 12288);
  const int t = tid();
  for (int i = t; i < 3072; i += 256) {
    const int c = i >> 10, k = i & 1023;
    const float x = (c == 0) ? p.in[I_CCTX][k] : p.in[I_C][(c - 1) * 1024 + k];
    sc[i] = x / (1.0f + __expf(-x));
  }
  __syncthreads();
  const int cg4 = t & 63, ks = t >> 6;
  const float* wp = p.in[I_MODW] + ((size_t)l * 1024 + ks * 256) * 6144 + jb * 256 + cg4 * 4;
  float a00 = 0, a01 = 0, a02 = 0, a03 = 0, a10 = 0, a11 = 0, a12 = 0, a13 = 0, a20 = 0, a21 = 0, a22 = 0, a23 = 0;
#pragma unroll 8
  for (int ii = 0; ii < 256; ++ii) {
    const float4 w = *(const float4*)(wp + (size_t)ii * 6144);
    const int k = ks * 256 + ii;
    const float s0 = sc[k], s1 = sc[1024 + k], s2 = sc[2048 + k];
    a00 += s0 * w.x; a01 += s0 * w.y; a02 += s0 * w.z; a03 += s0 * w.w;
    a10 += s1 * w.x; a11 += s1 * w.y; a12 += s1 * w.z; a13 += s1 * w.w;
    a20 += s2 * w.x; a21 += s2 * w.y; a22 += s2 * w.z; a23 += s2 * w.w;
  }
  float* r0 = red + (ks * 3 + 0) * 256 + cg4 * 4; r0[0] = a00; r0[1] = a01; r0[2] = a02; r0[3] = a03;
  float* r1 = red + (ks * 3 + 1) * 256 + cg4 * 4; r1[0] = a10; r1[1] = a11; r1[2] = a12; r1[3] = a13;
  float* r2 = red + (ks * 3 + 2) * 256 + cg4 * 4; r2[0] = a20; r2[1] = a21; r2[2] = a22; r2[3] = a23;
  __syncthreads();
  float* MOD = (float*)(p.ws + OFF_MOD);
  const float bias = p.in[I_MODB][l * 6144 + jb * 256 + t];
#pragma unroll
  for (int c = 0; c < 3; ++c) {
    float v = bias;
#pragma unroll
    for (int k2 = 0; k2 < 4; ++k2) v += red[(k2 * 3 + c) * 256 + t];
    MOD[(size_t)(l * 3 + c) * 6144 + jb * 256 + t] = v;
  }
  __syncthreads();
}

DEV void hglb_item(const Params& p) {
  const int c = tid();
  float* HGLB = (float*)(p.ws + OFF_HGLB);
  for (int dir = 0; dir < 2; ++dir) {
    float x[4], mx = -1e30f;
    for (int l = 0; l < 4; ++l) { x[l] = p.in[I_HGLB][(dir * 4 + l) * 256 + c]; mx = fmaxf(mx, x[l]); }
    float s = 0;
    for (int l = 0; l < 4; ++l) { x[l] = __expf(x[l] - mx); s += x[l]; }
    float cum = 0; const float s0 = x[0] / s;
    for (int l = 0; l < 4; ++l) { cum += x[l] / s; HGLB[(l * 2 + dir) * 256 + c] = cum - s0; }
  }
}

DEV void phase0(const Params& p, char* lds) {
  const int NT_WIN = 4 * 16 * 58, NT_WOUT = 4 * 16 * 16, NT_W1 = 4 * 16 * 64, NT_W2 = 4 * 64 * 16;
  const int nitems = 97 + NT_WIN + NT_WOUT + NT_W1 + NT_W2;
  for (int it = blockIdx.x; it < nitems; it += gridDim.x) {
    if (it < 96) { mod_item(p, it / 24, it % 24, lds); continue; }
    if (it == 96) { hglb_item(p); continue; }
    int j = it - 97;
    if (j < NT_WIN) { const int l = j / 928, r = j % 928;
      transpose_item(p.in[I_WIN] + (size_t)l * D * DIN, (bf16_t*)(p.ws + OFF_WIN) + (size_t)l * DIN * D, D, DIN, r / 58, r % 58, lds); continue; }
    j -= NT_WIN;
    if (j < NT_WOUT) { const int l = j / 256, r = j % 256;
      transpose_item(p.in[I_WOUT] + (size_t)l * D * D, (bf16_t*)(p.ws + OFF_WOUT) + (size_t)l * D * D, D, D, r / 16, r % 16, lds); continue; }
    j -= NT_WOUT;
    if (j < NT_W1) { const int l = j / 1024, r = j % 1024;
      transpose_item(p.in[I_FW1] + (size_t)l * D * FF, (bf16_t*)(p.ws + OFF_W1) + (size_t)l * FF * D, D, FF, r / 64, r % 64, lds); continue; }
    j -= NT_W1;
    { const int l = j / 1024, r = j % 1024;
      transpose_item(p.in[I_FW2] + (size_t)l * FF * D, (bf16_t*)(p.ws + OFF_W2) + (size_t)l * D * FF, FF, D, r / 16, r % 16, lds); }
  }
}

DEV void row_phase(const Params& p, int mode, int l) {
  const int lane = tid() & 63;
  const int nw = gridDim.x * 4;
  const float* MOD = (const float*)(p.ws + OFF_MOD);
  const float* NG = p.in[I_NORMG];
  const float* U = (const float*)(p.ws + OFF_U);
  bf16_t* H = (bf16_t*)(p.ws + OFF_H);
  for (int row = blockIdx.x * 4 + (tid() >> 6); row < MT; row += nw) {
    const int cond = row < NCTX ? 0 : 1 + ((row - NCTX) >> 10);
    float4 x[4];
    float* xo = p.out + (size_t)row * D;
    if (mode == 0) {
      const float* src = row < NCTX ? p.in[I_XP] + (size_t)row * D : p.in[I_XS] + (size_t)(row - NCTX) * D;
#pragma unroll
      for (int i = 0; i < 4; ++i) x[i] = *(const float4*)(src + i * 256 + lane * 4);
    } else {
      float4 u[4]; float ss = 0;
#pragma unroll
      for (int i = 0; i < 4; ++i) {
        x[i] = *(const float4*)(xo + i * 256 + lane * 4);
        u[i] = *(const float4*)(U + (size_t)row * D + i * 256 + lane * 4);
        ss += u[i].x * u[i].x + u[i].y * u[i].y + u[i].z * u[i].z + u[i].w * u[i].w;
      }
      ss = wave_sum(ss);
      const float r = rsqrtf(ss * (1.0f / 1024.0f) + 1e-6f);
      const float* gate = MOD + (size_t)(l * 3 + cond) * 6144 + (mode == 1 ? 2 : 5) * 1024;
      const float* ga = NG + (size_t)(l * 4 + (mode == 1 ? 1 : 3)) * 1024;
#pragma unroll
      for (int i = 0; i < 4; ++i) {
        const float4 g4 = *(const float4*)(gate + i * 256 + lane * 4);
        const float4 a4 = *(const float4*)(ga + i * 256 + lane * 4);
        x[i].x += g4.x * (u[i].x * r * a4.x); x[i].y += g4.y * (u[i].y * r * a4.y);
        x[i].z += g4.z * (u[i].z * r * a4.z); x[i].w += g4.w * (u[i].w * r * a4.w);
      }
    }
#pragma unroll
    for (int i = 0; i < 4; ++i) *(float4*)(xo + i * 256 + lane * 4) = x[i];
    if (mode == 2 && l == 3) continue;
    const int ln = (mode == 0) ? 0 : (mode == 1 ? l : l + 1);
    const int gi = (mode == 1) ? 2 : 0, shi = (mode == 1) ? 3 : 0, sci = (mode == 1) ? 4 : 1;
    float ss = 0;
#pragma unroll
    for (int i = 0; i < 4; ++i) ss += x[i].x * x[i].x + x[i].y * x[i].y + x[i].z * x[i].z + x[i].w * x[i].w;
    ss = wave_sum(ss);
    const float r2 = rsqrtf(ss * (1.0f / 1024.0f) + 1e-6f);
    const float* gb = NG + (size_t)(ln * 4 + gi) * 1024;
    const float* sh = MOD + (size_t)(ln * 3 + cond) * 6144 + shi * 1024;
    const float* sc = MOD + (size_t)(ln * 3 + cond) * 6144 + sci * 1024;
#pragma unroll
    for (int i = 0; i < 4; ++i) {
      const float4 g4 = *(const float4*)(gb + i * 256 + lane * 4);
      const float4 s4 = *(const float4*)(sc + i * 256 + lane * 4);
      const float4 h4 = *(const float4*)(sh + i * 256 + lane * 4);
      const float h0 = x[i].x * r2 * g4.x * (1.0f + s4.x) + h4.x;
      const float h1 = x[i].y * r2 * g4.y * (1.0f + s4.y) + h4.y;
      const float h2 = x[i].z * r2 * g4.z * (1.0f + s4.z) + h4.z;
      const float h3 = x[i].w * r2 * g4.w * (1.0f + s4.w) + h4.w;
      uint2 o; o.x = pk2(h0, h1); o.y = pk2(h2, h3);
      *(uint2*)(H + (size_t)row * D + i * 256 + lane * 4) = o;
    }
  }
}

template <int EPI>
DEV void gemm_tile(const Params& p, int l, const bf16_t* __restrict__ A, int lda, const bf16_t* __restrict__ BT, int K, int mt, int nt, char* lds) {
  const int t = tid(), lane = t & 63, w = t >> 6, wm = w >> 1, wn = w & 1, l31 = lane & 31, hh = lane >> 5;
  char* sA = lds; char* sB = lds + 32768;
  const int lrow = t >> 3, lc = t & 7;
  const int loff = lrow * 128 + ((lc ^ ((lrow >> 1) & 7)) << 4);
  const bf16_t* gA = A + (size_t)(mt * 128 + lrow) * lda + lc * 8;
  const bf16_t* gB = BT + (size_t)(nt * 128 + lrow) * K + lc * 8;
  uint4 ra[4], rb[4];
  f32x16 acc[2][2];
#pragma unroll
  for (int i = 0; i < 2; ++i)
#pragma unroll
    for (int j = 0; j < 2; ++j)
#pragma unroll
      for (int r = 0; r < 16; ++r) acc[i][j][r] = 0.f;
  const int nk = K >> 6;
#pragma unroll
  for (int i = 0; i < 4; ++i) { ra[i] = *(const uint4*)(gA + (size_t)(32 * i) * lda); rb[i] = *(const uint4*)(gB + (size_t)(32 * i) * K); }
#pragma unroll
  for (int i = 0; i < 4; ++i) { *(uint4*)(sA + loff + i * 4096) = ra[i]; *(uint4*)(sB + loff + i * 4096) = rb[i]; }
  __syncthreads();
  int offA[2], offB[2];
#pragma unroll
  for (int i = 0; i < 2; ++i) { offA[i] = (wm * 64 + i * 32 + l31) * 128; offB[i] = (wn * 64 + i * 32 + l31) * 128; }
  const int swzA = (l31 >> 1) & 7;
  for (int kt = 0; kt < nk; ++kt) {
    const int cur = kt & 1;
    if (kt + 1 < nk) {
#pragma unroll
      for (int i = 0; i < 4; ++i) { ra[i] = *(const uint4*)(gA + (size_t)(32 * i) * lda + (kt + 1) * 64); rb[i] = *(const uint4*)(gB + (size_t)(32 * i) * K + (kt + 1) * 64); }
    }
    const char* a0 = sA + cur * 16384; const char* b0 = sB + cur * 16384;
#pragma unroll
    for (int s = 0; s < 4; ++s) {
      const int co = (((s * 2 + hh) ^ swzA) << 4);
      bf16x8 af[2], bfr[2];
#pragma unroll
      for (int i = 0; i < 2; ++i) { af[i] = *(const bf16x8*)(a0 + offA[i] + co); bfr[i] = *(const bf16x8*)(b0 + offB[i] + co); }
#pragma unroll
      for (int i = 0; i < 2; ++i)
#pragma unroll
        for (int j = 0; j < 2; ++j) acc[i][j] = MFMA32(af[i], bfr[j], acc[i][j]);
    }
    if (kt + 1 < nk) {
      char* a1 = sA + (cur ^ 1) * 16384; char* b1 = sB + (cur ^ 1) * 16384;
#pragma unroll
      for (int i = 0; i < 4; ++i) { *(uint4*)(a1 + loff + i * 4096) = ra[i]; *(uint4*)(b1 + loff + i * 4096) = rb[i]; }
    }
    __syncthreads();
  }
#pragma unroll
  for (int i = 0; i < 2; ++i)
#pragma unroll
    for (int j = 0; j < 2; ++j) {
      const int cg0 = nt * 128 + wn * 64 + j * 32;
      const int col = cg0 + l31;
#pragma unroll
      for (int r = 0; r < 16; ++r) {
        const int row = mt * 128 + wm * 64 + i * 32 + (r & 3) + 8 * (r >> 2) + 4 * hh;
        const float v = acc[i][j][r];
        if (EPI == 0) {
          ((bf16_t*)(p.ws + OFF_P))[(size_t)row * DIN + col] = f2bf(v);
          if (row < NCTX) {
            if (cg0 >= C_NK && cg0 < C_HQ) {
              const int kv = cg0 >= C_NV;
              p.out[O_NAT + (size_t)(((row >> 8) * 4 + l) * 2 + kv) * 65536 + (row & 255) * 256 + (col - (kv ? C_NV : C_NK))] = v;
            } else if (cg0 >= C_SK) {
              const int kv = cg0 >= C_SV;
              p.out[O_SWA + (size_t)(((row >> 8) * 4 + l) * 2 + kv) * 32768 + (row & 255) * 128 + (col - (kv ? C_SV : C_SK))] = v;
            }
          }
        } else if (EPI == 1) {
          ((float*)(p.ws + OFF_U))[(size_t)row * D + col] = v;
        } else {
          const float rl = fmaxf(v, 0.f);
          ((bf16_t*)(p.ws + OFF_HID))[(size_t)row * FF + col] = f2bf(rl * rl);
        }
      }
    }
}

template <int EPI>
DEV void gemm_phase(const Params& p, int l, const bf16_t* A, int lda, const bf16_t* BT, int K, int N, char* lds) {
  const int ntn = N / 128, ntiles = (MT / 128) * ntn;
  for (int tile = blockIdx.x; tile < ntiles; tile += gridDim.x) gemm_tile<EPI>(p, l, A, lda, BT, K, tile / ntn, tile % ntn, lds);
}

DEV void prep_item(const Params& p, int l, int tile, char* lds) {
  const int t = tid(), r0 = tile * 16, c = t;
  int T, seq0;
  if (r0 < NCTX) { T = 256; seq0 = r0 & ~255; } else { T = 1024; seq0 = NCTX + ((r0 - NCTX) & ~1023); }
  float* sT = (float*)lds;
  float* swl = sT + 2048;
  float* sal = swl + 4096;
  const bf16_t* P = (const bf16_t*)(p.ws + OFF_P);
  float* PREP = (float*)(p.ws + OFF_PREP);
  float* BON = (float*)(p.ws + OFF_BONUS);
  for (int dir = 0; dir < 2; ++dir) {
    __syncthreads();
#pragma unroll
    for (int i = 0; i < 8; ++i) {
      const int e = t + 256 * i, tk = e >> 7, j = e & 127, which = j >> 6, jj = j & 63;
      const int row = r0 + tk, prow = dir ? row + 1 : row - 1;
      const bool pv = dir ? (row + 1 < seq0 + T) : (row > seq0);
      const int col = (dir ? C_WHB : C_WHF) + which * 64 + jj;
      const float cur = bf2f(P[(size_t)row * DIN + col]);
      const float prev = pv ? bf2f(P[(size_t)prow * DIN + col]) : 0.f;
      const float mu = p.in[I_MULORA][((l * 2 + dir) * 2 + which) * 64 + jj];
      float val = cur + (prev - cur) * mu;
      if (which == 0) val = tanhf_(val);
      sT[j * 16 + tk] = val;
    }
    __syncthreads();
    {
      const float* w2p = p.in[I_W2] + (size_t)(l * 2 + dir) * 64 * 256 + c;
      const float* a2p = p.in[I_A2] + (size_t)(l * 2 + dir) * 64 * 256 + c;
      float aw[16], aa[16];
#pragma unroll
      for (int k = 0; k < 16; ++k) { aw[k] = 0.f; aa[k] = 0.f; }
#pragma unroll 4
      for (int j = 0; j < 64; ++j) {
        const float w2j = w2p[j * 256], a2j = a2p[j * 256];
#pragma unroll
        for (int k4 = 0; k4 < 4; ++k4) {
          const float4 th4 = *(const float4*)(sT + j * 16 + k4 * 4);
          const float4 ah4 = *(const float4*)(sT + (64 + j) * 16 + k4 * 4);
          aw[k4 * 4 + 0] += th4.x * w2j; aw[k4 * 4 + 1] += th4.y * w2j; aw[k4 * 4 + 2] += th4.z * w2j; aw[k4 * 4 + 3] += th4.w * w2j;
          aa[k4 * 4 + 0] += ah4.x * a2j; aa[k4 * 4 + 1] += ah4.y * a2j; aa[k4 * 4 + 2] += ah4.z * a2j; aa[k4 * 4 + 3] += ah4.w * a2j;
        }
      }
#pragma unroll
      for (int k = 0; k < 16; ++k) { swl[k * 256 + c] = aw[k]; sal[k * 256 + c] = aa[k]; }
    }
    const float w0v = p.in[I_W0][(l * 2 + dir) * 256 + c], a0v = p.in[I_A0][(l * 2 + dir) * 256 + c];
    const float kkv = p.in[I_KK][l * 256 + c], kav = p.in[I_KA][l * 256 + c], rkv = p.in[I_RK][l * 256 + c];
    const float mur = p.in[I_MURKV][((l * 2 + dir) * 3 + 0) * 256 + c], muk = p.in[I_MURKV][((l * 2 + dir) * 3 + 1) * 256 + c],
                muv = p.in[I_MURKV][((l * 2 + dir) * 3 + 2) * 256 + c];
    float* pr = PREP + (size_t)dir * 6 * ARRF;
#pragma unroll 1
    for (int tk = 0; tk < 16; ++tk) {
      const int row = r0 + tk, prow = dir ? row + 1 : row - 1;
      const bool pv = dir ? (row + 1 < seq0 + T) : (row > seq0);
      const bf16_t* pc = P + (size_t)row * DIN + c;
      const bf16_t* pp = P + (size_t)prow * DIN + c;
      const float rc = bf2f(pc[C_R]), kc = bf2f(pc[C_K]), vc = bf2f(pc[C_V]);
      const float rp = pv ? bf2f(pp[C_R]) : 0.f, kp0 = pv ? bf2f(pp[C_K]) : 0.f, vp = pv ? bf2f(pp[C_V]) : 0.f;
      const float rs = rc + (rp - rc) * mur, ks = kc + (kp0 - kc) * muk, vs = vc + (vp - vc) * muv;
      const float wl = w0v + swl[tk * 256 + c], al = a0v + sal[tk * 256 + c];
      const float wv = __expf(-0.6065306597126334f * sigmoidf_(wl));
      const float av = sigmoidf_(al);
      const float kkr = ks * kkv;
      const float n2 = wave_sum(kkr * kkr);
      const float kk = kkr / fmaxf(sqrtf(n2), 1e-12f);
      const float kp = ks * (1.0f + (av - 1.0f) * kav);
      const float bs = wave_sum(rs * kp * rkv);
      const float bon = bs * vs;
      const size_t idx = (size_t)row * 256 + c;
      pr[idx] = rs; pr[ARRF + idx] = wv; pr[2 * ARRF + idx] = kp; pr[3 * ARRF + idx] = vs; pr[4 * ARRF + idx] = kk; pr[5 * ARRF + idx] = kk * av;
      if (dir == 0) BON[idx] = bon; else BON[idx] += bon;
    }
  }
  __syncthreads();
}

DEV void rope_item(const Params& p, int item) {
  bf16_t* P = (bf16_t*)(p.ws + OFF_P);
  const int t = tid();
  for (int e = t; e < 64 * 192; e += 256) {
    const int tk = e / 192, r = e % 192, hs = r >> 5, pi = r & 31;
    const int lt = item * 64 + tk;
    const int tt = lt & 1023;
    const int grow = tt >> 6, gcol = tt & 63;
    const int fi = pi & 15;
    const float pos = (pi < 16) ? (float)grow : (float)gcol;
    const float inv = exp2f(-(float)fi * (13.287712379549449f / 16.0f));
    const float ang = pos * inv;
    const float cs = __cosf(ang), sn = __sinf(ang);
    const int d1 = (pi < 16) ? fi : 32 + fi;
    bf16_t* base = P + (size_t)(NCTX + lt) * DIN + C_SQ + hs * 64;
    const float x1 = bf2f(base[d1]), x2 = bf2f(base[d1 + 16]);
    base[d1] = f2bf(x1 * cs - x2 * sn);
    base[d1 + 16] = f2bf(x2 * cs + x1 * sn);
  }
}

DEV void rwkv_scan(const Params& p, int l, int seq, int head, int dir, int rg, char* lds) {
  const int t = tid(), rl = t >> 4, ks = t & 15;
  const int T = seq < 32 ? 256 : 1024;
  const int row0 = seq < 32 ? seq * 256 : NCTX + (seq - 32) * 1024;
  const float* prep = (const float*)(p.ws + OFF_PREP) + (size_t)dir * 6 * ARRF;
  float* ydir = (float*)(p.ws + OFF_YDIR) + (size_t)dir * ARRF;
  float4* sbuf = (float4*)lds;
  float* vbuf = (float*)(lds + 20480);
  float* ybuf = vbuf + 256;
  float4 S = make_float4(0.f, 0.f, 0.f, 0.f);
  if (seq >= 32) S = *(const float4*)(p.in[I_SRW] + ((((size_t)(seq - 32) * 4 + l) * 2 + dir) * 4 + head) * 4096 + (rg * 16 + rl) * 64 + ks * 4);
  const int nch = T >> 4;
  float4 pre0, pre1, pre2, pre3, pre4; float prev;
  {
    const int s = rl; const int tok = dir ? (T - 1 - s) : s;
    const size_t base = (size_t)(row0 + tok) * 256 + head * 64;
    pre0 = *(const float4*)(prep + base + ks * 4);
    pre1 = *(const float4*)(prep + ARRF + base + ks * 4);
    pre2 = *(const float4*)(prep + 2 * ARRF + base + ks * 4);
    pre3 = *(const float4*)(prep + 4 * ARRF + base + ks * 4);
    pre4 = *(const float4*)(prep + 5 * ARRF + base + ks * 4);
    prev = prep[3 * ARRF + base + rg * 16 + ks];
  }
  for (int c = 0; c < nch; ++c) {
    __syncthreads();
    sbuf[(0 * 16 + rl) * 16 + ks] = pre0; sbuf[(1 * 16 + rl) * 16 + ks] = pre1; sbuf[(2 * 16 + rl) * 16 + ks] = pre2;
    sbuf[(3 * 16 + rl) * 16 + ks] = pre3; sbuf[(4 * 16 + rl) * 16 + ks] = pre4;
    vbuf[rl * 16 + ks] = prev;
    __syncthreads();
    if (c + 1 < nch) {
      const int s = (c + 1) * 16 + rl; const int tok = dir ? (T - 1 - s) : s;
      const size_t base = (size_t)(row0 + tok) * 256 + head * 64;
      pre0 = *(const float4*)(prep + base + ks * 4);
      pre1 = *(const float4*)(prep + ARRF + base + ks * 4);
      pre2 = *(const float4*)(prep + 2 * ARRF + base + ks * 4);
      pre3 = *(const float4*)(prep + 4 * ARRF + base + ks * 4);
      pre4 = *(const float4*)(prep + 5 * ARRF + base + ks * 4);
      prev = prep[3 * ARRF + base + rg * 16 + ks];
    }
#pragma unroll 4
    for (int i = 0; i < 16; ++i) {
      const float4 r = sbuf[(0 * 16 + i) * 16 + ks], wv = sbuf[(1 * 16 + i) * 16 + ks], kv = sbuf[(2 * 16 + i) * 16 + ks],
                   kk = sbuf[(3 * 16 + i) * 16 + ks], ka = sbuf[(4 * 16 + i) * 16 + ks];
      const float v = vbuf[i * 16 + rl];
      float sa = S.x * kk.x + S.y * kk.y + S.z * kk.z + S.w * kk.w;
      sa = -row16_sum(sa);
      S.x = S.x * wv.x + sa * ka.x + v * kv.x;
      S.y = S.y * wv.y + sa * ka.y + v * kv.y;
      S.z = S.z * wv.z + sa * ka.z + v * kv.z;
      S.w = S.w * wv.w + sa * ka.w + v * kv.w;
      float y = S.x * r.x + S.y * r.y + S.z * r.z + S.w * r.w;
      y = row16_sum(y);
      if (ks == 0) ybuf[i * 16 + rl] = y;
    }
    __syncthreads();
    {
      const int s = c * 16 + rl; const int tok = dir ? (T - 1 - s) : s;
      ydir[(size_t)(row0 + tok) * 256 + head * 64 + rg * 16 + ks] = ybuf[rl * 16 + ks];
    }
  }
  if (seq < 32) *(float4*)(p.out + O_RW + ((((size_t)seq * 4 + l) * 2 + dir) * 4 + head) * 4096 + (rg * 16 + rl) * 64 + ks * 4) = S;
  __syncthreads();
}

DEV void hgrn_scan(const Params& p, int l, int seq, int head, int dir, int rg, char* lds) {
  const int t = tid(), rl = t >> 4, ks = t & 15;
  const int T = seq < 32 ? 256 : 1024;
  const int row0 = seq < 32 ? seq * 256 : NCTX + (seq - 32) * 1024;
  const bf16_t* P = (const bf16_t*)(p.ws + OFF_P);
  float* odir = (float*)(p.ws + OFF_HDIR) + (size_t)dir * ARRF;
  float4* sbuf = (float4*)lds;
  float* vbuf = (float*)(lds + 20480);
  float* ybuf = vbuf + 256;
  const float4 lb4 = *(const float4*)((const float*)(p.ws + OFF_HGLB) + (l * 2 + dir) * 256 + head * 64 + ks * 4);
  const int vrow = rg * 16 + rl;
  float4 S = make_float4(0.f, 0.f, 0.f, 0.f);
  if (seq >= 32) {
    const float* sp = p.in[I_SHG] + ((((size_t)(seq - 32) * 4 + l) * 2 + dir) * 4 + head) * 4096;
    S.x = sp[(ks * 4 + 0) * 64 + vrow]; S.y = sp[(ks * 4 + 1) * 64 + vrow]; S.z = sp[(ks * 4 + 2) * 64 + vrow]; S.w = sp[(ks * 4 + 3) * 64 + vrow];
  }
  const int nch = T >> 4;
  const int fcol = (dir ? C_HFB : C_HFF) + head * 64;
  uint2 pq, pf; bf16_t pvv;
  {
    const int s = rl; const int tok = dir ? (T - 1 - s) : s;
    const bf16_t* pr = P + (size_t)(row0 + tok) * DIN;
    pq = *(const uint2*)(pr + C_HQ + head * 64 + ks * 4);
    pf = *(const uint2*)(pr + fcol + ks * 4);
    pvv = pr[C_HI + head * 64 + rg * 16 + ks];
  }
  for (int c = 0; c < nch; ++c) {
    __syncthreads();
    {
      float4 q, f, k;
      float a;
      a = bflo(pq.x); q.x = a * sigmoidf_(a); a = bfhi(pq.x); q.y = a * sigmoidf_(a);
      a = bflo(pq.y); q.z = a * sigmoidf_(a); a = bfhi(pq.y); q.w = a * sigmoidf_(a);
      float sg;
      sg = sigmoidf_(bflo(pf.x)); f.x = lb4.x + (1.f - lb4.x) * sg; k.x = (1.f - lb4.x) * (1.f - sg);
      sg = sigmoidf_(bfhi(pf.x)); f.y = lb4.y + (1.f - lb4.y) * sg; k.y = (1.f - lb4.y) * (1.f - sg);
      sg = sigmoidf_(bflo(pf.y)); f.z = lb4.z + (1.f - lb4.z) * sg; k.z = (1.f - lb4.z) * (1.f - sg);
      sg = sigmoidf_(bfhi(pf.y)); f.w = lb4.w + (1.f - lb4.w) * sg; k.w = (1.f - lb4.w) * (1.f - sg);
      sbuf[(0 * 16 + rl) * 16 + ks] = q; sbuf[(1 * 16 + rl) * 16 + ks] = f; sbuf[(2 * 16 + rl) * 16 + ks] = k;
      vbuf[rl * 16 + ks] = bf2f(pvv);
    }
    __syncthreads();
    if (c + 1 < nch) {
      const int s = (c + 1) * 16 + rl; const int tok = dir ? (T - 1 - s) : s;
      const bf16_t* pr = P + (size_t)(row0 + tok) * DIN;
      pq = *(const uint2*)(pr + C_HQ + head * 64 + ks * 4);
      pf = *(const uint2*)(pr + fcol + ks * 4);
      pvv = pr[C_HI + head * 64 + rg * 16 + ks];
    }
#pragma unroll 4
    for (int i = 0; i < 16; ++i) {
      const float4 q = sbuf[(0 * 16 + i) * 16 + ks], f = sbuf[(1 * 16 + i) * 16 + ks], k = sbuf[(2 * 16 + i) * 16 + ks];
      const float v = vbuf[i * 16 + rl];
      S.x = S.x * f.x + k.x * v; S.y = S.y * f.y + k.y * v; S.z = S.z * f.z + k.z * v; S.w = S.w * f.w + k.w * v;
      float y = S.x * q.x + S.y * q.y + S.z * q.z + S.w * q.w;
      y = row16_sum(y);
      if (ks == 0) ybuf[i * 16 + rl] = y;
    }
    __syncthreads();
    {
      const int s = c * 16 + rl; const int tok = dir ? (T - 1 - s) : s;
      odir[(size_t)(row0 + tok) * 256 + head * 64 + rg * 16 + ks] = ybuf[rl * 16 + ks];
    }
  }
  if (seq < 32) {
    float* sp = p.out + O_HG + ((((size_t)seq * 4 + l) * 2 + dir) * 4 + head) * 4096;
    sp[(ks * 4 + 0) * 64 + vrow] = S.x; sp[(ks * 4 + 1) * 64 + vrow] = S.y; sp[(ks * 4 + 2) * 64 + vrow] = S.z; sp[(ks * 4 + 3) * 64 + vrow] = S.w;
  }
  __syncthreads();
}

template <int MODE>
DEV void attn_item(const Params& p, int l, int item, char* lds) {
  const int t = tid(), lane = t & 63, w = t >> 6, q = lane & 31, hh = lane >> 5;
  const bf16_t* P = (const bf16_t*)(p.ws + OFF_P);
  bf16_t* Y = (bf16_t*)(p.ws + OFF_YMIX);
  char* sK = lds;
  char* sV = lds + 8192;
  float* sBias = (float*)(lds + 8192 + 8704);
  int head, qrow, qcol, kcol, vcol, ocol, nloc, nt, rowbaseP;
  int qr = 0, qc = 0, rlo = 0, qpos = 0, lo = 0, rsq = 0, wsq = 0;
  float sink = 0.f;
  const float* cache = nullptr; int cH = 1, cHead = 0;
  if (MODE == 0 || MODE == 1) {
    const int b = item >> 3; head = (item >> 1) & 3; const int half = item & 1;
    rowbaseP = b * 256; qrow = rowbaseP + half * 128 + w * 32 + q; nloc = 4; nt = 4;
  } else {
    const int b = item >> 5; head = (item >> 3) & 3; const int sub = item & 7;
    rowbaseP = NCTX + b * 1024;
    if (MODE == 2) {
      qr = 2 * sub + (w >> 1); qc = (w & 1) * 32 + q; qrow = rowbaseP + qr * 64 + qc;
      rlo = clampi(2 * sub - 4, 0, 8); const int rhi = clampi(2 * sub - 3, 0, 8) + 7; nloc = rhi - rlo + 1; nt = nloc + 4;
      rsq = clampi(qr - 4, 0, 8); wsq = clampi(qc - 8, 0, 48);
      cache = p.in[I_CNAT] + (size_t)((b * 4 + l) * 2) * 256 * 256; cH = 4; cHead = head;
      for (int i = t; i < 465; i += 256) sBias[i] = p.in[I_RPB][(size_t)(l * 4 + head) * 465 + i];
    } else {
      qpos = sub * 128 + w * 32 + q; qrow = rowbaseP + qpos;
      lo = (sub - 1) * 128; if (lo < 0) lo = 0; int hi = (sub + 2) * 128; if (hi > 1024) hi = 1024;
      nloc = (hi - lo) >> 6; nt = nloc + 4;
      cache = p.in[I_CSWA] + (size_t)((b * 4 + l) * 2) * 256 * 128; cH = 2; cHead = head >> 1;
    }
  }
  if (MODE == 0 || MODE == 2) { qcol = C_NQ + head * 64; kcol = C_NK + head * 64; vcol = C_NV + head * 64; ocol = 256 + head * 64; }
  else { qcol = C_SQ + head * 64; kcol = C_SK + (head >> 1) * 64; vcol = C_SV + (head >> 1) * 64; ocol = 768 + head * 64; sink = p.in[I_SINK][l * 4 + head]; }

  bf16x8 bq[4];
#pragma unroll
  for (int s = 0; s < 4; ++s) bq[s] = *(const bf16x8*)(P + (size_t)qrow * DIN + qcol + 16 * s + 8 * hh);
  f32x16 oacc[2];
#pragma unroll
  for (int r = 0; r < 16; ++r) { oacc[0][r] = 0.f; oacc[1][r] = 0.f; }
  float m_run = -1e30f, l_run = 0.f;
  const int key = t >> 2, dq = t & 3;
  const int kswz = (key >> 1) & 7;
  for (int j = 0; j < nt; ++j) {
    uint4 kr[2], vr[2];
    const bool isP = j < nloc;
    int keybase = 0;
    if (isP) {
      if (MODE == 0 || MODE == 1) keybase = rowbaseP + j * 64;
      else if (MODE == 2) keybase = rowbaseP + (rlo + j) * 64;
      else keybase = rowbaseP + lo + j * 64;
      const bf16_t* kp = P + (size_t)(keybase + key) * DIN + kcol + dq * 16;
      const bf16_t* vp = P + (size_t)(keybase + key) * DIN + vcol + dq * 16;
      kr[0] = *(const uint4*)kp; kr[1] = *(const uint4*)(kp + 8);
      vr[0] = *(const uint4*)vp; vr[1] = *(const uint4*)(vp + 8);
    } else {
      const int ct = (j - nloc) * 64 + key;
      const float* kp = cache + ((size_t)ct * cH + cHead) * 64 + dq * 16;
      const float* vp = kp + (size_t)256 * cH * 64;
      const float4 k0 = *(const float4*)kp, k1 = *(const float4*)(kp + 4), k2 = *(const float4*)(kp + 8), k3 = *(const float4*)(kp + 12);
      const float4 v0 = *(const float4*)vp, v1 = *(const float4*)(vp + 4), v2 = *(const float4*)(vp + 8), v3 = *(const float4*)(vp + 12);
      kr[0].x = pk2(k0.x, k0.y); kr[0].y = pk2(k0.z, k0.w); kr[0].z = pk2(k1.x, k1.y); kr[0].w = pk2(k1.z, k1.w);
      kr[1].x = pk2(k2.x, k2.y); kr[1].y = pk2(k2.z, k2.w); kr[1].z = pk2(k3.x, k3.y); kr[1].w = pk2(k3.z, k3.w);
      vr[0].x = pk2(v0.x, v0.y); vr[0].y = pk2(v0.z, v0.w); vr[0].z = pk2(v1.x, v1.y); vr[0].w = pk2(v1.z, v1.w);
      vr[1].x = pk2(v2.x, v2.y); vr[1].y = pk2(v2.z, v2.w); vr[1].z = pk2(v3.x, v3.y); vr[1].w = pk2(v3.z, v3.w);
    }
    __syncthreads();
    *(uint4*)(sK + key * 128 + (((dq * 2 + 0) ^ kswz) << 4)) = kr[0];
    *(uint4*)(sK + key * 128 + (((dq * 2 + 1) ^ kswz) << 4)) = kr[1];
    {
      bf16_t* vt = (bf16_t*)sV;
      const unsigned vv[8] = {vr[0].x, vr[0].y, vr[0].z, vr[0].w, vr[1].x, vr[1].y, vr[1].z, vr[1].w};
#pragma unroll
      for (int e = 0; e < 8; ++e) {
        vt[(dq * 16 + 2 * e) * 68 + key] = (bf16_t)(vv[e] & 0xffffu);
        vt[(dq * 16 + 2 * e + 1) * 68 + key] = (bf16_t)(vv[e] >> 16);
      }
    }
    __syncthreads();
    f32x16 sacc[2];
#pragma unroll
    for (int r = 0; r < 16; ++r) { sacc[0][r] = 0.f; sacc[1][r] = 0.f; }
    const int qswz = (q >> 1) & 7;
#pragma unroll
    for (int s = 0; s < 4; ++s) {
      const int co = (((s * 2 + hh) ^ qswz) << 4);
      const bf16x8 a0 = *(const bf16x8*)(sK + q * 128 + co);
      const bf16x8 a1 = *(const bf16x8*)(sK + (32 + q) * 128 + co);
      sacc[0] = MFMA32(a0, bq[s], sacc[0]);
      sacc[1] = MFMA32(a1, bq[s], sacc[1]);
    }
    float mx = -1e30f;
#pragma unroll
    for (int sub = 0; sub < 2; ++sub)
#pragma unroll
      for (int r = 0; r < 16; ++r) {
        const int kidx = sub * 32 + (r & 3) + 8 * (r >> 2) + 4 * hh;
        float v = sacc[sub][r] * 0.125f;
        bool ok = true;
        if (MODE == 2 && isP) {
          const int kr_ = rlo + j, kc_ = kidx;
          ok = (kr_ >= rsq) && (kr_ < rsq + 8) && (kc_ >= wsq) && (kc_ < wsq + 16);
          const int bi = ok ? ((kr_ - qr + 7) * 31 + (kc_ - qc + 15)) : 0;
          v += sBias[bi];
        }
        if (MODE == 3 && isP) {
          const int dlt = lo + j * 64 + kidx - qpos;
          ok = (dlt <= 128) && (dlt >= -128);
        }
        v = ok ? v : -1e30f;
        sacc[sub][r] = v;
        mx = fmaxf(mx, v);
      }
    mx = fmaxf(mx, __shfl_xor(mx, 32));
    const float m_new = fmaxf(m_run, mx);
    const float alpha = __expf(m_run - m_new);
    float rsum = 0.f;
#pragma unroll
    for (int sub = 0; sub < 2; ++sub)
#pragma unroll
      for (int r = 0; r < 16; ++r) {
        const float v = sacc[sub][r];
        const float pv = (v > -1e29f) ? __expf(v - m_new) : 0.f;
        sacc[sub][r] = pv; rsum += pv;
      }
    rsum += __shfl_xor(rsum, 32);
    l_run = l_run * alpha + rsum; m_run = m_new;
#pragma unroll
    for (int r = 0; r < 16; ++r) { oacc[0][r] *= alpha; oacc[1][r] *= alpha; }
#pragma unroll
    for (int k4 = 0; k4 < 4; ++k4) {
      const int sub = k4 >> 1, s2 = k4 & 1;
      uint4 pbu;
      pbu.x = pk2(sacc[sub][8 * s2 + 0], sacc[sub][8 * s2 + 1]); pbu.y = pk2(sacc[sub][8 * s2 + 2], sacc[sub][8 * s2 + 3]);
      pbu.z = pk2(sacc[sub][8 * s2 + 4], sacc[sub][8 * s2 + 5]); pbu.w = pk2(sacc[sub][8 * s2 + 6], sacc[sub][8 * s2 + 7]);
      const bf16x8 pb = __builtin_bit_cast(bf16x8, pbu);
#pragma unroll
      for (int dt = 0; dt < 2; ++dt) {
        const char* vp = sV + (dt * 32 + q) * 136 + (16 * k4 + 4 * hh) * 2;
        const uint2 lo8 = *(const uint2*)vp, hi8 = *(const uint2*)(vp + 16);
        uint4 avu; avu.x = lo8.x; avu.y = lo8.y; avu.z = hi8.x; avu.w = hi8.y;
        oacc[dt] = MFMA32(__builtin_bit_cast(bf16x8, avu), pb, oacc[dt]);
      }
    }
  }
  float scale;
  if (MODE == 1 || MODE == 3) {
    const float m_f = fmaxf(m_run, sink);
    const float e = __expf(m_run - m_f);
    scale = e / (l_run * e + __expf(sink - m_f));
  } else scale = 1.0f / l_run;
#pragma unroll
  for (int dt = 0; dt < 2; ++dt)
#pragma unroll
    for (int g4 = 0; g4 < 4; ++g4) {
      const int d = dt * 32 + 8 * g4 + 4 * hh;
      uint2 o; o.x = pk2(oacc[dt][4 * g4] * scale, oacc[dt][4 * g4 + 1] * scale); o.y = pk2(oacc[dt][4 * g4 + 2] * scale, oacc[dt][4 * g4 + 3] * scale);
      *(uint2*)(Y + (size_t)qrow * D + ocol + d) = o;
    }
  __syncthreads();
}

DEV void post_item(const Params& p, int l, int tile, char* lds) {
  const int t = tid(), r0 = tile * 16, c = t;
  float* sT = (float*)lds;
  float* sgo = sT + 2048;
  const bf16_t* P = (const bf16_t*)(p.ws + OFF_P);
  bf16_t* Y = (bf16_t*)(p.ws + OFF_YMIX);
  const float* Y0 = (const float*)(p.ws + OFF_YDIR); const float* Y1 = Y0 + ARRF;
  const float* H0 = (const float*)(p.ws + OFF_HDIR); const float* H1 = H0 + ARRF;
  const float* BON = (const float*)(p.ws + OFF_BONUS);
  __syncthreads();
#pragma unroll
  for (int i = 0; i < 8; ++i) {
    const int e = t + 256 * i, tk = e >> 7, j = e & 127;
    sT[j * 16 + tk] = sigmoidf_(bf2f(P[(size_t)(r0 + tk) * DIN + C_GH + j]));
  }
  __syncthreads();
  {
    const float* g2p = p.in[I_G2] + (size_t)l * 128 * 256 + c;
    float ag[16];
#pragma unroll
    for (int k = 0; k < 16; ++k) ag[k] = 0.f;
#pragma unroll 4
    for (int j = 0; j < 128; ++j) {
      const float gj = g2p[j * 256];
#pragma unroll
      for (int k4 = 0; k4 < 4; ++k4) {
        const float4 s4 = *(const float4*)(sT + j * 16 + k4 * 4);
        ag[k4 * 4 + 0] += s4.x * gj; ag[k4 * 4 + 1] += s4.y * gj; ag[k4 * 4 + 2] += s4.z * gj; ag[k4 * 4 + 3] += s4.w * gj;
      }
    }
#pragma unroll
    for (int k = 0; k < 16; ++k) sgo[k * 256 + c] = ag[k];
  }
  const float lnw = p.in[I_LNW][l * 256 + c], lnb = p.in[I_LNB][l * 256 + c], hgn = p.in[I_HGN][l * 256 + c];
#pragma unroll 1
  for (int tk = 0; tk < 16; ++tk) {
    const int row = r0 + tk;
    const size_t idx = (size_t)row * 256 + c;
    const float y = Y0[idx] + Y1[idx];
    const float mu = wave_sum(y) * (1.0f / 64.0f);
    const float dy = y - mu;
    const float var = wave_sum(dy * dy) * (1.0f / 64.0f);
    const float yn = dy * rsqrtf(var + 64e-5f) * lnw + lnb + BON[idx];
    const float g = sgo[tk * 256 + c];
    Y[(size_t)row * D + c] = f2bf(yn * g);
    const float o = H0[idx] + H1[idx];
    const float ms = wave_sum(o * o) * (1.0f / 64.0f);
    const float gt = sigmoidf_(bf2f(P[(size_t)row * DIN + C_HG + c]));
    Y[(size_t)row * D + 512 + c] = f2bf(o * rsqrtf(ms + 1e-6f) * hgn * gt);
  }
  __syncthreads();
}

DEV void mixer_phase(const Params& p, int l, char* lds) {
  const int nitems = 256 + 2048 + 512;
  for (int it = blockIdx.x; it < nitems; it += gridDim.x) {
    int kind, idx;
    if (it < 64) { kind = 0; idx = 1024 + it; }
    else if (it < 128) { kind = 1; idx = 1024 + it - 64; }
    else if (it < 192) { kind = 5; idx = it - 128; }
    else if (it < 256) { kind = 4; idx = it - 192; }
    else if (it < 1280) { kind = 0; idx = it - 256; }
    else if (it < 2304) { kind = 1; idx = it - 1280; }
    else if (it < 2560) { kind = 2; idx = it - 2304; }
    else { kind = 3; idx = it - 2560; }
    if (kind < 2) {
      const int seq = idx >> 5, rem = idx & 31;
      if (kind == 0) rwkv_scan(p, l, seq, rem >> 3, (rem >> 2) & 1, rem & 3, lds);
      else hgrn_scan(p, l, seq, rem >> 3, (rem >> 2) & 1, rem & 3, lds);
    } else if (kind == 2) attn_item<0>(p, l, idx, lds);
    else if (kind == 3) attn_item<1>(p, l, idx, lds);
    else if (kind == 4) attn_item<2>(p, l, idx, lds);
    else attn_item<3>(p, l, idx, lds);
  }
}

DEV void run_phase(const Params& p, int ph, char* lds, bool rerun) {
  if (ph == 0) { phase0(p, lds); return; }
  if (ph == 1) { row_phase(p, 0, 0); return; }
  const int l = (ph - 2) / 9, s = (ph - 2) % 9;
  const bf16_t* H = (const bf16_t*)(p.ws + OFF_H);
  switch (s) {
    case 0: gemm_phase<0>(p, l, H, D, (const bf16_t*)(p.ws + OFF_WIN) + (size_t)l * DIN * D, D, DIN, lds); break;
    case 1:
      for (int it = blockIdx.x; it < 640 + 32; it += gridDim.x) { if (it < 640) prep_item(p, l, it, lds); else if (!rerun) rope_item(p, it - 640); }
      break;
    case 2: mixer_phase(p, l, lds); break;
    case 3: for (int it = blockIdx.x; it < 640; it += gridDim.x) post_item(p, l, it, lds); break;
    case 4: gemm_phase<1>(p, l, (const bf16_t*)(p.ws + OFF_YMIX), D, (const bf16_t*)(p.ws + OFF_WOUT) + (size_t)l * D * D, D, D, lds); break;
    case 5: row_phase(p, 1, l); break;
    case 6: gemm_phase<2>(p, l, H, D, (const bf16_t*)(p.ws + OFF_W1) + (size_t)l * FF * D, D, FF, lds); break;
    case 7: gemm_phase<1>(p, l, (const bf16_t*)(p.ws + OFF_HID), FF, (const bf16_t*)(p.ws + OFF_W2) + (size_t)l * D * FF, FF, D, lds); break;
    case 8: row_phase(p, 2, l); break;
  }
}

#define XB_TMO      128
#define XB_XCNT(j)  (256  + 64 * (j))
#define XB_XSUB(j)  (1280 + 64 * (j))
#define XB_XGEN(j)  (2304 + 64 * (j))
#define XB_TOP      3328
#define XB_TOPGEN   3392
#define XCD_BAR_WORDS 3456
#define XB_SPIN_CAP (1u << 18)
#define LAS __attribute__((address_space(3)))
DEV unsigned xb_ld(unsigned* p) { return __hip_atomic_load(p, __ATOMIC_RELAXED, __HIP_MEMORY_SCOPE_AGENT); }
DEV unsigned xb_add(unsigned* p, unsigned v) { return __hip_atomic_fetch_add(p, v, __ATOMIC_RELAXED, __HIP_MEMORY_SCOPE_AGENT); }
DEV unsigned xb_xcc_id() { return (unsigned)__builtin_amdgcn_s_getreg((3 << 11) | 20) & 0xFu; }
#define XB_SPIN(cond, bar) do { unsigned _sp = 0; while (cond) { __builtin_amdgcn_s_sleep(1); \
    if ((++_sp & 255u) == 0u) { if (xb_ld(&(bar)[XB_TMO])) break; if (_sp > XB_SPIN_CAP) { atomicAdd(&(bar)[XB_TMO], 1u); break; } } } } while (0)
struct XcdBarrier { unsigned* bar; unsigned x; volatile LAS unsigned* st; };
DEV XcdBarrier xcd_barrier_post(unsigned* bar, volatile LAS unsigned* st) {
  XcdBarrier b; b.bar = bar; b.x = xb_xcc_id(); b.st = st;
  if (threadIdx.x == 0) (void)xb_add(&bar[XB_XCNT(b.x)], 1u);
  return b;
}
DEV void xcd_barrier_complete(unsigned* bar, unsigned x, unsigned& nloc, unsigned& nx) {
  const unsigned G = gridDim.x * gridDim.y * gridDim.z;
  unsigned sum, cnt, mine, sp = 0u;
  for (;;) {
    sum = 0u; cnt = 0u; mine = 0u;
#pragma unroll
    for (unsigned j = 0; j < 16; ++j) { const unsigned c = xb_ld(&bar[XB_XCNT(j)]); sum += c; cnt += (c > 0u) ? 1u : 0u; mine = (j == x) ? c : mine; }
    if (sum == G) break;
    __builtin_amdgcn_s_sleep(1);
    if ((++sp & 255u) == 0u) { if (xb_ld(&bar[XB_TMO])) break; if (sp > XB_SPIN_CAP) { atomicAdd(&bar[XB_TMO], 1u); break; } }
  }
  nloc = mine > 0u ? mine : 1u; nx = cnt > 0u ? cnt : 1u;
}
DEV void xcd_barrier(const XcdBarrier& b) {
  asm volatile("s_waitcnt vmcnt(0)" ::: "memory");
  __syncthreads();
  if (threadIdx.x == 0) {
    unsigned* bar = b.bar;
    __builtin_amdgcn_s_waitcnt(0);
    unsigned nloc = b.st[0], nx = b.st[1];
    if (nloc == 0u) { xcd_barrier_complete(bar, b.x, nloc, nx); b.st[0] = nloc; b.st[1] = nx; }
    const unsigned old = xb_add(&bar[XB_XSUB(b.x)], 1u);
    const unsigned gen = old / nloc;
    if (old + 1u == (gen + 1u) * nloc) {
      __builtin_amdgcn_fence(__ATOMIC_RELEASE, "agent");
      asm volatile("s_waitcnt vmcnt(0)" ::: "memory");
      const unsigned og = xb_add(&bar[XB_TOP], 1u);
      const unsigned tg = og / nx;
      if (og + 1u == (tg + 1u) * nx) xb_add(&bar[XB_TOPGEN], 1u);
      else XB_SPIN(xb_ld(&bar[XB_TOPGEN]) == tg, bar);
      __builtin_amdgcn_fence(__ATOMIC_ACQUIRE, "agent");
      xb_add(&bar[XB_XGEN(b.x)], 1u);
      asm volatile("s_waitcnt vmcnt(0)" ::: "memory");
    } else {
      XB_SPIN(xb_ld(&bar[XB_XGEN(b.x)]) == gen, bar);
      __builtin_amdgcn_fence(__ATOMIC_ACQUIRE, "agent");
      asm volatile("s_waitcnt vmcnt(0)" ::: "memory");
    }
  }
  __syncthreads();
}

DEV int phase_kind(int ph) {
  if (ph == 0) return 0;
  if (ph == 1) return 1;
  const int s = (ph - 2) % 9;
  return s == 0 ? 2 : s == 1 ? 3 : s == 2 ? 4 : s == 3 ? 5 : s == 4 ? 6 : s == 5 ? 1 : s == 6 ? 7 : s == 7 ? 8 : 1;
}

__global__ void __launch_bounds__(256, 2) mega(Params p, int ph_lo, int ph_hi) {
  __shared__ __attribute__((aligned(16))) char lds[65536];
  __shared__ uint4 xb_words;
  if (threadIdx.x == 0) xb_words = make_uint4(0u, 0u, 0u, 0u);
  __syncthreads();
  XcdBarrier xb = xcd_barrier_post((unsigned*)(p.ws + OFF_BAR), (volatile LAS unsigned*)&xb_words);
  if (ph_hi < 0) cg::this_grid().sync();
  for (int ph = ph_lo; ph < ph_hi; ++ph) {
    run_phase(p, ph, lds, false);
    if (PROBE_KIND >= 0 && (PROBE_KIND == 9 || phase_kind(ph) == PROBE_KIND)) {
      xcd_barrier(xb);
      if (PROBE_KIND != 9) run_phase(p, ph, lds, true);
    }
    if (ph + 1 < ph_hi) xcd_barrier(xb);
  }
}

extern "C" void kernel_launch(void* const* d_in, const int* in_sizes, int n_in, void* d_out, int out_size, void* d_ws, size_t ws_size,
                              hipStream_t stream) {
  static int grid_blocks = 0;
  if (!grid_blocks) {
    int dev = 0, cus = 0, per_cu = 0;
    hipGetDevice(&dev);
    hipDeviceGetAttribute(&cus, hipDeviceAttributeMultiprocessorCount, dev);
    hipOccupancyMaxActiveBlocksPerMultiprocessor(&per_cu, mega, 256, 0);
    if (per_cu > 2) per_cu = 2;
    if (per_cu < 1) per_cu = 1;
    grid_blocks = cus * per_cu;
  }
  if (ws_size < WS_TOTAL) { fprintf(stderr, "workspace too small: %zu < %zu\n", ws_size, (size_t)WS_TOTAL); return; }
  Params p{};
  for (int i = 0; i < 31; ++i) p.in[i] = (const float*)d_in[i];
  p.out = (float*)d_out;
  p.ws = (char*)d_ws;
  hipMemsetAsync((char*)d_ws + OFF_BAR, 0, 16384, stream);
#if ONE_LAUNCH
  int lo = 0, hi = NPH;
  void* args[] = {&p, &lo, &hi};
  hipError_t e = hipLaunchCooperativeKernel((void*)mega, dim3(grid_blocks), dim3(256), args, 0, stream);
  if (e != hipSuccess) fprintf(stderr, "cooperative launch failed: %s (grid %d)\n", hipGetErrorString(e), grid_blocks);
#else
  for (int ph = 0; ph < NPH; ++ph) mega<<<dim3(grid_blocks), dim3(256), 0, stream>>>(p, ph, ph + 1);
#endif
}
```

```cpp
#include <hip/hip_runtime.h>
#include <hip/hip_cooperative_groups.h>
#include <cstdio>
#include <cstdint>
namespace cg = cooperative_groups;

#ifndef ONE_LAUNCH
#define ONE_LAUNCH 1
#endif
#define PROBE_KIND -1

#define DEV __device__ __forceinline__
typedef unsigned short bf16_t;
typedef short bf16x8 __attribute__((ext_vector_type(8)));
typedef float f32x16 __attribute__((ext_vector_type(16)));
typedef __bf16 bf2_t __attribute__((ext_vector_type(2)));
typedef float f2_t __attribute__((ext_vector_type(2)));

constexpr int D = 1024, DIN = 3712, FF = 4096, NCTX = 8192, MT = 10240;
constexpr int NPH = 38;
constexpr int DINP = 3840;
constexpr int C_R = 0, C_K = 256, C_V = 512, C_GH = 768, C_WHF = 896, C_WHB = 1024;
constexpr int C_NQ = 1152, C_NK = 1408, C_NV = 1664;
constexpr int C_HQ = 1920, C_HI = 2176, C_HG = 2432, C_HFF = 2688, C_HFB = 2944;
constexpr int C_SQ = 3200, C_SK = 3456, C_SV = 3584;
constexpr size_t O_NAT = 10485760, O_SWA = 27262976, O_RW = 35651584, O_HG = 39845888;
constexpr size_t ARRF = (size_t)MT * 256;
constexpr size_t ARR = ARRF * 4;
constexpr size_t OFF_WIN = 0;
constexpr size_t OFF_WOUT = OFF_WIN + (size_t)4 * DINP * D * 2;
constexpr size_t OFF_W1 = OFF_WOUT + (size_t)4 * D * D * 2;
constexpr size_t OFF_W2 = OFF_W1 + (size_t)4 * FF * D * 2;
constexpr size_t OFF_MOD = OFF_W2 + (size_t)4 * FF * D * 2;
constexpr size_t OFF_HGLB = OFF_MOD + (size_t)4 * 3 * 6144 * 4;
constexpr size_t OFF_P = OFF_HGLB + 8192;
constexpr size_t OFF_R1 = OFF_P + (size_t)MT * DIN * 2;
constexpr size_t OFF_H = OFF_R1;
constexpr size_t OFF_HID = OFF_H + (size_t)MT * D * 2;
constexpr size_t OFF_U = OFF_HID + (size_t)MT * FF * 2;
constexpr size_t OFF_PREP = OFF_R1;
constexpr size_t OFF_YDIR = OFF_PREP + 12 * ARR;
constexpr size_t OFF_BONUS = OFF_R1 + 14 * ARR;
constexpr size_t OFF_HDIR = OFF_BONUS + ARR;
constexpr size_t OFF_YMIX = OFF_HDIR + 2 * ARR;
constexpr size_t OFF_BAR = OFF_YMIX + (size_t)MT * D * 2;
constexpr size_t WS_TOTAL = OFF_BAR + 16384;
static_assert(OFF_U + (size_t)MT * D * 4 == OFF_BONUS, "R1 layout");

struct Params {
  const float* in[31];
  float* out;
  char* ws;
};
enum { I_XP = 0, I_XS, I_CNAT, I_CSWA, I_SRW, I_SHG, I_C, I_CCTX, I_NORMG, I_MODW, I_MODB, I_WIN, I_WOUT, I_MURKV, I_MULORA,
       I_W0, I_W2, I_A0, I_A2, I_G2, I_KK, I_KA, I_RK, I_LNW, I_LNB, I_RPB, I_HGLB, I_HGN, I_SINK, I_FW1, I_FW2 };

DEV bf16_t f2bf(float f) { unsigned u = __float_as_uint(f); u += 0x7fffu + ((u >> 16) & 1u); return (bf16_t)(u >> 16); }
DEV float bf2f(bf16_t h) { return __uint_as_float(((unsigned)h) << 16); }
DEV unsigned pk2(float a, float b) { f2_t v = {a, b}; bf2_t r = __builtin_convertvector(v, bf2_t); return __builtin_bit_cast(unsigned, r); }
DEV float bflo(unsigned u) { return __uint_as_float(u << 16); }
DEV float bfhi(unsigned u) { return __uint_as_float(u & 0xffff0000u); }
DEV float sigmoidf_(float x) { return 1.0f / (1.0f + __expf(-x)); }
DEV float tanhf_(float x) { return 1.0f - 2.0f / (1.0f + __expf(2.0f * x)); }
template <int CTRL> DEV float dppf(float x) { return __int_as_float(__builtin_amdgcn_update_dpp(0, __float_as_int(x), CTRL, 0xF, 0xF, false)); }
DEV float row16_sum(float x) { x += dppf<0xB1>(x); x += dppf<0x4E>(x); x += dppf<0x141>(x); x += dppf<0x140>(x); return x; }
DEV float wave_sum(float x) { x = row16_sum(x); x += __shfl_xor(x, 16); x += __shfl_xor(x, 32); return x; }
DEV int clampi(int v, int lo, int hi) { return v < lo ? lo : (v > hi ? hi : v); }
#define MFMA32(a, b, c) __builtin_amdgcn_mfma_f32_32x32x16_bf16((a), (b), (c), 0, 0, 0)

DEV int tid() { int z; asm volatile("v_mov_b32 %0, 0" : "=v"(z)); return (int)(threadIdx.x & 255u) + z; }
DEV int half_id() { return __builtin_amdgcn_readfirstlane((int)(threadIdx.x >> 8)); }
DEV void transpose_item(const float* W, bf16_t* WT, int K, int N, int kt, int nt, char* lds) {
  bf16_t* s = (bf16_t*)lds;
  const int t = tid();
#pragma unroll
  for (int i = 0; i < 4; ++i) {
    const int k = (t >> 4) + 16 * i, n4 = (t & 15) * 4;
    const float4 v = *(const float4*)(W + (size_t)(kt * 64 + k) * N + nt * 64 + n4);
    s[(n4 + 0) * 72 + k] = f2bf(v.x); s[(n4 + 1) * 72 + k] = f2bf(v.y);
    s[(n4 + 2) * 72 + k] = f2bf(v.z); s[(n4 + 3) * 72 + k] = f2bf(v.w);
  }
  __syncthreads();
#pragma unroll
  for (int i = 0; i < 2; ++i) {
    const int n = (t >> 3) + 32 * i, kc = t & 7;
    const uint4 v = *(const uint4*)(s + n * 72 + kc * 8);
    *(uint4*)(WT + (size_t)(nt * 64 + n) * K + kt * 64 + kc * 8) = v;
  }
  __syncthreads();
}

DEV void mod_item(const Params& p, int l, int jb, char* lds) {
  float* sc = (float*)lds;
  float* red = (float*)(lds + 12288);
  const int t = tid();
  for (int i = t; i < 3072; i += 256) {
    const int c = i >> 10, k = i & 1023;
    const float x = (c == 0) ? p.in[I_CCTX][k] : p.in[I_C][(c - 1) * 1024 + k];
    sc[i] = x / (1.0f + __expf(-x));
  }
  __syncthreads();
  const int cg4 = t & 63, ks = t >> 6;
  const float* wp = p.in[I_MODW] + ((size_t)l * 1024 + ks * 256) * 6144 + jb * 256 + cg4 * 4;
  float a00 = 0, a01 = 0, a02 = 0, a03 = 0, a10 = 0, a11 = 0, a12 = 0, a13 = 0, a20 = 0, a21 = 0, a22 = 0, a23 = 0;
#pragma unroll 8
  for (int ii = 0; ii < 256; ++ii) {
    const float4 w = *(const float4*)(wp + (size_t)ii * 6144);
    const int k = ks * 256 + ii;
    const float s0 = sc[k], s1 = sc[1024 + k], s2 = sc[2048 + k];
    a00 += s0 * w.x; a01 += s0 * w.y; a02 += s0 * w.z; a03 += s0 * w.w;
    a10 += s1 * w.x; a11 += s1 * w.y; a12 += s1 * w.z; a13 += s1 * w.w;
    a20 += s2 * w.x; a21 += s2 * w.y; a22 += s2 * w.z; a23 += s2 * w.w;
  }
  float* r0 = red + (ks * 3 + 0) * 256 + cg4 * 4; r0[0] = a00; r0[1] = a01; r0[2] = a02; r0[3] = a03;
  float* r1 = red + (ks * 3 + 1) * 256 + cg4 * 4; r1[0] = a10; r1[1] = a11; r1[2] = a12; r1[3] = a13;
  float* r2 = red + (ks * 3 + 2) * 256 + cg4 * 4; r2[0] = a20; r2[1] = a21; r2[2] = a22; r2[3] = a23;
  __syncthreads();
  float* MOD = (float*)(p.ws + OFF_MOD);
  const float bias = p.in[I_MODB][l * 6144 + jb * 256 + t];
#pragma unroll
  for (int c = 0; c < 3; ++c) {
    float v = bias;
#pragma unroll
    for (int k2 = 0; k2 < 4; ++k2) v += red[(k2 * 3 + c) * 256 + t];
    MOD[(size_t)(l * 3 + c) * 6144 + jb * 256 + t] = v;
  }
  __syncthreads();
}

DEV void hglb_item(const Params& p) {
  const int c = tid();
  float* HGLB = (float*)(p.ws + OFF_HGLB);
  for (int dir = 0; dir < 2; ++dir) {
    float x[4], mx = -1e30f;
    for (int l = 0; l < 4; ++l) { x[l] = p.in[I_HGLB][(dir * 4 + l) * 256 + c]; mx = fmaxf(mx, x[l]); }
    float s = 0;
    for (int l = 0; l < 4; ++l) { x[l] = __expf(x[l] - mx); s += x[l]; }
    float cum = 0; const float s0 = x[0] / s;
    for (int l = 0; l < 4; ++l) { cum += x[l] / s; HGLB[(l * 2 + dir) * 256 + c] = cum - s0; }
  }
}

DEV void phase0(const Params& p, char* lds0) {
  const int hf = half_id(); char* lds = lds0 + hf * 65536;
  const int NT_WIN = 4 * 16 * 58, NT_WOUT = 4 * 16 * 16, NT_W1 = 4 * 16 * 64, NT_W2 = 4 * 64 * 16;
  const int nitems = 98 + NT_WIN + NT_WOUT + NT_W1 + NT_W2 + 4;
  for (int it = blockIdx.x * 2 + hf; it < nitems; it += gridDim.x * 2) {
    if (it < 96) { mod_item(p, it / 24, it % 24, lds); continue; }
    if (it == 96) { hglb_item(p); continue; }
    if (it == 97) continue;
    int j = it - 98;
    if (j < NT_WIN) { const int l = j / 928, r = j % 928;
      transpose_item(p.in[I_WIN] + (size_t)l * D * DIN, (bf16_t*)(p.ws + OFF_WIN) + (size_t)l * DINP * D, D, DIN, r / 58, r % 58, lds); continue; }
    j -= NT_WIN;
    if (j < NT_WOUT) { const int l = j / 256, r = j % 256;
      transpose_item(p.in[I_WOUT] + (size_t)l * D * D, (bf16_t*)(p.ws + OFF_WOUT) + (size_t)l * D * D, D, D, r / 16, r % 16, lds); continue; }
    j -= NT_WOUT;
    if (j < NT_W1) { const int l = j / 1024, r = j % 1024;
      transpose_item(p.in[I_FW1] + (size_t)l * D * FF, (bf16_t*)(p.ws + OFF_W1) + (size_t)l * FF * D, D, FF, r / 64, r % 64, lds); continue; }
    j -= NT_W1;
    if (j < NT_W2) { const int l = j / 1024, r = j % 1024;
      transpose_item(p.in[I_FW2] + (size_t)l * FF * D, (bf16_t*)(p.ws + OFF_W2) + (size_t)l * D * FF, FF, D, r / 16, r % 16, lds); continue; }
    j -= NT_W2;
    {
      uint4* z = (uint4*)((bf16_t*)(p.ws + OFF_WIN) + ((size_t)j * DINP + DIN) * D);
      const int t = tid();
      for (int i = t; i < 128 * D * 2 / 16; i += 256) z[i] = make_uint4(0u, 0u, 0u, 0u);
    }
  }
}

DEV void row_phase(const Params& p, int mode, int l) {
  const int lane = tid() & 63;
  const int nw = gridDim.x * 8;
  const float* MOD = (const float*)(p.ws + OFF_MOD);
  const float* NG = p.in[I_NORMG];
  const float* U = (const float*)(p.ws + OFF_U);
  bf16_t* H = (bf16_t*)(p.ws + OFF_H);
  for (int row = blockIdx.x * 8 + half_id() * 4 + (tid() >> 6); row < MT; row += nw) {
    const int cond = row < NCTX ? 0 : 1 + ((row - NCTX) >> 10);
    float4 x[4];
    float* xo = p.out + (size_t)row * D;
    if (mode == 0) {
      const float* src = row < NCTX ? p.in[I_XP] + (size_t)row * D : p.in[I_XS] + (size_t)(row - NCTX) * D;
#pragma unroll
      for (int i = 0; i < 4; ++i) x[i] = *(const float4*)(src + i * 256 + lane * 4);
    } else {
      float4 u[4]; float ss = 0;
#pragma unroll
      for (int i = 0; i < 4; ++i) {
        x[i] = *(const float4*)(xo + i * 256 + lane * 4);
        u[i] = *(const float4*)(U + (size_t)row * D + i * 256 + lane * 4);
        ss += u[i].x * u[i].x + u[i].y * u[i].y + u[i].z * u[i].z + u[i].w * u[i].w;
      }
      ss = wave_sum(ss);
      const float r = rsqrtf(ss * (1.0f / 1024.0f) + 1e-6f);
      const float* gate = MOD + (size_t)(l * 3 + cond) * 6144 + (mode == 1 ? 2 : 5) * 1024;
      const float* ga = NG + (size_t)(l * 4 + (mode == 1 ? 1 : 3)) * 1024;
#pragma unroll
      for (int i = 0; i < 4; ++i) {
        const float4 g4 = *(const float4*)(gate + i * 256 + lane * 4);
        const float4 a4 = *(const float4*)(ga + i * 256 + lane * 4);
        x[i].x += g4.x * (u[i].x * r * a4.x); x[i].y += g4.y * (u[i].y * r * a4.y);
        x[i].z += g4.z * (u[i].z * r * a4.z); x[i].w += g4.w * (u[i].w * r * a4.w);
      }
    }
#pragma unroll
    for (int i = 0; i < 4; ++i) *(float4*)(xo + i * 256 + lane * 4) = x[i];
    if (mode == 2 && l == 3) continue;
    const int ln = (mode == 0) ? 0 : (mode == 1 ? l : l + 1);
    const int gi = (mode == 1) ? 2 : 0, shi = (mode == 1) ? 3 : 0, sci = (mode == 1) ? 4 : 1;
    float ss = 0;
#pragma unroll
    for (int i = 0; i < 4; ++i) ss += x[i].x * x[i].x + x[i].y * x[i].y + x[i].z * x[i].z + x[i].w * x[i].w;
    ss = wave_sum(ss);
    const float r2 = rsqrtf(ss * (1.0f / 1024.0f) + 1e-6f);
    const float* gb = NG + (size_t)(ln * 4 + gi) * 1024;
    const float* sh = MOD + (size_t)(ln * 3 + cond) * 6144 + shi * 1024;
    const float* sc = MOD + (size_t)(ln * 3 + cond) * 6144 + sci * 1024;
#pragma unroll
    for (int i = 0; i < 4; ++i) {
      const float4 g4 = *(const float4*)(gb + i * 256 + lane * 4);
      const float4 s4 = *(const float4*)(sc + i * 256 + lane * 4);
      const float4 h4 = *(const float4*)(sh + i * 256 + lane * 4);
      const float h0 = x[i].x * r2 * g4.x * (1.0f + s4.x) + h4.x;
      const float h1 = x[i].y * r2 * g4.y * (1.0f + s4.y) + h4.y;
      const float h2 = x[i].z * r2 * g4.z * (1.0f + s4.z) + h4.z;
      const float h3 = x[i].w * r2 * g4.w * (1.0f + s4.w) + h4.w;
      uint2 o; o.x = pk2(h0, h1); o.y = pk2(h2, h3);
      *(uint2*)(H + (size_t)row * D + i * 256 + lane * 4) = o;
    }
  }
}

namespace pg8 {
#define PG8_LAS __attribute__((address_space(3)))
typedef unsigned short bf16_t;
typedef short bf16x8 __attribute__((ext_vector_type(8)));
typedef float f32x4 __attribute__((ext_vector_type(4)));
typedef unsigned u32x4 __attribute__((ext_vector_type(4)));
constexpr int BM = 256, BK = 64, HALF = 128, HTB = HALF * BK * 2  , STAGE_BYTES = 8 * HTB, NXCD = 8, WGM = 8;

__host__ __device__ __forceinline__ int lds_byte(int r, int c) { const int st = (r >> 4) * 2 + (c >> 5), rr = r & 15, cc = c & 31, ob = rr * 64 + cc * 2; return st * 1024 + (ob ^ (((ob >> 9) & 1) << 5)); }
__host__ __device__ __forceinline__ void stage_rc(int b, int& R, int& C) { const int st = b / 1024, sb = b % 1024, swz = sb ^ (((sb >> 9) & 1) << 5); R = (st >> 1) * 16 + swz / 64; C = (st & 1) * 32 + (swz % 64) / 2; }
__host__ __device__ __forceinline__ int perm32(int rho) { const int n = rho >> 4, i = rho & 15; return 8 * (i >> 2) + 4 * n + (i & 3); }

struct Unit { int pm, pn; };
struct Gemm { const bf16_t* A; const bf16_t* Bt; int M, N, K; };

struct StaticOrder {
    int nM, nN, nwg, G, c;
    __host__ __device__ void init(int M, int N, int G_, int c_) { nM = M / BM; nN = N / BM; nwg = nM * nN; G = G_; c = c_; }
    __host__ __device__ bool next(int i, Unit& u) const {
        const long L = (long)i * G + c; if (L >= nwg) return false;
        int wgid = (int)L; { const int q = nwg / NXCD, r = nwg % NXCD, xcd = wgid % NXCD, off = wgid / NXCD; wgid = (xcd < r ? xcd * (q + 1) : r * (q + 1) + (xcd - r) * q) + off; }
        const int nig = WGM * nN, gid = wgid / nig, fm = gid * WGM, gsz = (nM - fm) < WGM ? (nM - fm) : WGM;
        u.pm = fm + ((wgid % nig) % gsz); u.pn = (wgid % nig) / gsz; return true;
    }
    __device__ __forceinline__ void a_ready(const Unit&) const {}
    __device__ __forceinline__ void done(const Unit&) const {}
};

template <class Epi, class Sched, bool ALIGN_EPI = false, bool SP2 = false>
__device__ __forceinline__ void gemm_phase(PG8_LAS unsigned char* lds, const Gemm g, const Sched& S, const Epi& E) {
    int tid_z; asm volatile("v_mov_b32 %0, 0" : "=v"(tid_z)); const int tid = (int)threadIdx.x + tid_z, wid = __builtin_amdgcn_readfirstlane(tid >> 6), lane = tid & 63, wr = wid >> 2, wc = wid & 3, fr = lane & 15, fq = lane >> 4;
    const int K = g.K, nt = K / BK;
    unsigned voffA[2], voffB[2];
#pragma unroll
    for (int i = 0; i < 2; ++i) { int R, C; stage_rc(tid * 16 + i * 8192, R, C); const int Rb = Epi::PERM ? ((R & ~31) + perm32(R & 31)) : R;
        voffA[i] = (unsigned)(R * K + C) * 2u; voffB[i] = (unsigned)(Rb * K + C) * 2u; }
    const size_t kstep = (size_t)(BK * 2);
    const size_t hstep = (size_t)HALF * K * 2;
    const size_t tstep = 2 * hstep;
    const unsigned ldsw = (unsigned)wid * 1024u;
    const int aoff = lds_byte(wr * 64 + fr, fq * 8), boff = lds_byte(wc * 32 + fr, fq * 8);
#define PG8_SA(b, h) (((b) * 2 + (h)) * HTB)
#define PG8_SB(b, h) ((4 + (b) * 2 + (h)) * HTB)
#define PG8_STAGE(bufoff, gbase, voff) do { _Pragma("unroll") for (int _i = 0; _i < 2; ++_i) \
        __builtin_amdgcn_global_load_lds((const unsigned*)((const char*)(gbase) + (voff)[_i]), (PG8_LAS unsigned*)(lds + (bufoff) + ldsw + _i * 8192), 16, 0, 0); } while (0)
#define PG8_LDA(dst, b, h) do { _Pragma("unroll") for (int m = 0; m < 4; ++m) _Pragma("unroll") for (int k = 0; k < 2; ++k) dst[m][k] = *(const PG8_LAS bf16x8*)(lds + PG8_SA(b, h) + aoff + m * 2048 + k * 1024); } while (0)
#define PG8_LDB(dst, b, h) do { _Pragma("unroll") for (int n = 0; n < 2; ++n) _Pragma("unroll") for (int k = 0; k < 2; ++k) dst[n][k] = *(const PG8_LAS bf16x8*)(lds + PG8_SB(b, h) + boff + n * 2048 + k * 1024); } while (0)
#define PG8_MMA(ai, bj, At, Bt) do { __builtin_amdgcn_s_setprio(1); _Pragma("unroll") for (int m = 0; m < 4; ++m) _Pragma("unroll") for (int n = 0; n < 2; ++n) _Pragma("unroll") for (int k = 0; k < 2; ++k) \
        acc[ai][bj][m][n] = __builtin_amdgcn_mfma_f32_16x16x32_bf16(Bt[n][k], At[m][k], acc[ai][bj][m][n], 0, 0, 0); __builtin_amdgcn_s_setprio(0); } while (0)
#define PG8_WAIT_V(n) asm volatile("s_waitcnt vmcnt(" #n ")" ::: "memory")
#define PG8_WAIT_L(n) asm volatile("s_waitcnt lgkmcnt(" #n ")" ::: "memory")
#define PG8_BAR __builtin_amdgcn_s_barrier()
#define PG8_SCHED __builtin_amdgcn_sched_barrier(0)
    Unit cur, nxt; int ui = 0;
    if (!S.next(0, cur)) return;
    f32x4 acc[2][2][4][2];
#pragma unroll
    for (int a = 0; a < 2; ++a)
#pragma unroll
        for (int b = 0; b < 2; ++b)
#pragma unroll
            for (int m = 0; m < 4; ++m)
#pragma unroll
                for (int n = 0; n < 2; ++n) acc[a][b][m][n] = (f32x4){0.f, 0.f, 0.f, 0.f};
    bf16x8 At[4][2], B0[2][2], B1[2][2];
    const char* cA = (const char*)g.A + (size_t)cur.pm * tstep; const char* cB = (const char*)g.Bt + (size_t)cur.pn * tstep;
    S.a_ready(cur);
    if constexpr (SP2) {
        PG8_STAGE(PG8_SB(0, 0), cB, voffB); PG8_STAGE(PG8_SB(0, 1), cB + hstep, voffB); PG8_STAGE(PG8_SA(0, 0), cA, voffA); PG8_STAGE(PG8_SA(0, 1), cA + hstep, voffA);
        if (wr == 1) PG8_BAR;
        PG8_WAIT_V(2); PG8_BAR;
        PG8_STAGE(PG8_SB(1, 0), cB + kstep, voffB); PG8_STAGE(PG8_SA(1, 0), cA + kstep, voffA); PG8_STAGE(PG8_SB(1, 1), cB + hstep + kstep, voffB);
        PG8_WAIT_V(6); PG8_BAR;
    } else {
        PG8_STAGE(PG8_SB(0, 0), cB, voffB); PG8_STAGE(PG8_SA(0, 0), cA, voffA); PG8_STAGE(PG8_SB(0, 1), cB + hstep, voffB); PG8_STAGE(PG8_SA(0, 1), cA + hstep, voffA);
        if (wr == 1) PG8_BAR;
        PG8_WAIT_V(4); PG8_BAR;
        PG8_STAGE(PG8_SB(1, 0), cB + kstep, voffB); PG8_STAGE(PG8_SA(1, 0), cA + kstep, voffA); PG8_STAGE(PG8_SB(1, 1), cB + hstep + kstep, voffB);
        PG8_WAIT_V(6); PG8_BAR;
    }
    for (;;) {
        const bool has_next = S.next(ui + 1, nxt);
        const char* nA = has_next ? (const char*)g.A + (size_t)nxt.pm * tstep : cA; const char* nB = has_next ? (const char*)g.Bt + (size_t)nxt.pn * tstep : cB;
        for (int t = 0; t < nt; t += 2) {
            const bool last = (t == nt - 2);
            const char* a1 = cA + (size_t)(t + 1) * kstep;
            const char* a2 = last ? nA : cA + (size_t)(t + 2) * kstep; const char* b2 = last ? nB : cB + (size_t)(t + 2) * kstep;
            const char* a3 = a2 + kstep; const char* b3 = b2 + kstep;
            if (last && has_next) S.a_ready(nxt);
            if constexpr (SP2) {
            PG8_LDB(B0, 0, 0); PG8_LDB(B1, 0, 1); PG8_SCHED; PG8_LDA(At, 0, 0); PG8_STAGE(PG8_SA(1, 1), a1 + hstep, voffA);
            PG8_WAIT_V(8); PG8_WAIT_L(0); PG8_BAR; PG8_MMA(0, 0, At, B0); PG8_MMA(0, 1, At, B1); PG8_BAR; PG8_SCHED;
            PG8_LDA(At, 0, 1); PG8_STAGE(PG8_SB(0, 0), b2, voffB); PG8_STAGE(PG8_SB(0, 1), b2 + hstep, voffB); PG8_STAGE(PG8_SA(0, 0), a2, voffA);
            PG8_WAIT_V(8); PG8_WAIT_L(0); PG8_BAR; PG8_MMA(1, 0, At, B0); PG8_MMA(1, 1, At, B1); PG8_BAR; PG8_SCHED;
            PG8_LDB(B0, 1, 0); PG8_LDB(B1, 1, 1); PG8_SCHED; PG8_LDA(At, 1, 0); PG8_STAGE(PG8_SA(0, 1), a2 + hstep, voffA);
            PG8_WAIT_V(8); PG8_WAIT_L(0); PG8_BAR; PG8_MMA(0, 0, At, B0); PG8_MMA(0, 1, At, B1); PG8_BAR; PG8_SCHED;
            PG8_LDA(At, 1, 1); PG8_STAGE(PG8_SB(1, 0), b3, voffB); PG8_STAGE(PG8_SB(1, 1), b3 + hstep, voffB); PG8_STAGE(PG8_SA(1, 0), a3, voffA);
            PG8_WAIT_V(8); PG8_WAIT_L(0); PG8_BAR; PG8_MMA(1, 0, At, B0); PG8_MMA(1, 1, At, B1); PG8_BAR; PG8_SCHED;
            } else {
            PG8_LDB(B0, 0, 0); PG8_SCHED; PG8_LDA(At, 0, 0); PG8_STAGE(PG8_SA(1, 1), a1 + hstep, voffA);
            PG8_WAIT_L(8); PG8_BAR; PG8_WAIT_L(0); PG8_MMA(0, 0, At, B0); PG8_BAR; PG8_SCHED;
            PG8_LDB(B1, 0, 1); PG8_STAGE(PG8_SB(0, 0), b2, voffB);
            PG8_BAR; PG8_WAIT_L(0); PG8_MMA(0, 1, At, B1); PG8_BAR;
            PG8_LDA(At, 0, 1); PG8_STAGE(PG8_SA(0, 0), a2, voffA);
            PG8_BAR; PG8_WAIT_L(0); PG8_MMA(1, 0, At, B0); PG8_BAR; PG8_SCHED;
            PG8_STAGE(PG8_SB(0, 1), b2 + hstep, voffB);
            PG8_WAIT_V(6); PG8_BAR; PG8_MMA(1, 1, At, B1); PG8_BAR;
            PG8_LDB(B0, 1, 0); PG8_SCHED; PG8_LDA(At, 1, 0); PG8_STAGE(PG8_SA(0, 1), a2 + hstep, voffA);
            PG8_WAIT_L(8); PG8_BAR; PG8_WAIT_L(0); PG8_MMA(0, 0, At, B0); PG8_BAR; PG8_SCHED;
            PG8_LDB(B1, 1, 1); PG8_STAGE(PG8_SB(1, 0), b3, voffB);
            PG8_BAR; PG8_WAIT_L(0); PG8_MMA(0, 1, At, B1); PG8_BAR;
            PG8_LDA(At, 1, 1); PG8_STAGE(PG8_SA(1, 0), a3, voffA);
            PG8_BAR; PG8_WAIT_L(0); PG8_MMA(1, 0, At, B0); PG8_BAR; PG8_SCHED;
            PG8_STAGE(PG8_SB(1, 1), b3 + hstep, voffB);
            PG8_WAIT_V(6); PG8_BAR; PG8_MMA(1, 1, At, B1); PG8_BAR;
            }
        }
        if constexpr (ALIGN_EPI) { if (wr == 0) PG8_BAR; }
        if constexpr (!Epi::AFTER_DRAIN) { E(acc, cur, wr, wc, fr, fq); S.done(cur); }
        if (!has_next) break;
#pragma unroll
        for (int a = 0; a < 2; ++a)
#pragma unroll
            for (int b = 0; b < 2; ++b)
#pragma unroll
                for (int m = 0; m < 4; ++m)
#pragma unroll
                    for (int n = 0; n < 2; ++n) acc[a][b][m][n] = (f32x4){0.f, 0.f, 0.f, 0.f};
        cur = nxt; cA = nA; cB = nB; ++ui;
        if constexpr (ALIGN_EPI) { if (wr == 1) PG8_BAR; }
    }
    PG8_WAIT_V(0);
    if constexpr (!ALIGN_EPI) { if (wr == 0) PG8_BAR; }
    PG8_BAR;
    if constexpr (Epi::AFTER_DRAIN) { E.fused(acc, cur, wr, wc, fr, fq, lds, wid, lane); S.done(cur); }
#undef PG8_SA
#undef PG8_SB
#undef PG8_STAGE
#undef PG8_LDA
#undef PG8_LDB
#undef PG8_MMA
#undef PG8_WAIT_V
#undef PG8_WAIT_L
#undef PG8_BAR
#undef PG8_SCHED
}
}

template <int MODE> struct EpiMK {
  static constexpr bool PERM = false, AFTER_DRAIN = false;
  const Params* pp; int l;
  DEV void operator()(const pg8::f32x4 (&acc)[2][2][4][2], const pg8::Unit& u, int wr, int wc, int fr, int fq) const {
    const Params& p = *pp;
#pragma unroll
    for (int ai = 0; ai < 2; ++ai)
#pragma unroll
      for (int m = 0; m < 4; ++m) {
        const int row = u.pm * 256 + ai * 128 + wr * 64 + m * 16 + fr;
#pragma unroll
        for (int bj = 0; bj < 2; ++bj)
#pragma unroll
          for (int n = 0; n < 2; ++n) {
            const int col = u.pn * 256 + bj * 128 + wc * 32 + n * 16 + fq * 4;
            const pg8::f32x4 v = acc[ai][bj][m][n];
            if (MODE == 0) {
              if (col < DIN) {
                uint2 o; o.x = pk2(v[0], v[1]); o.y = pk2(v[2], v[3]);
                *(uint2*)((bf16_t*)(p.ws + OFF_P) + (size_t)row * DIN + col) = o;
                if (row < NCTX) {
                  if (col >= C_NK && col < C_HQ) {
                    const int kv = col >= C_NV;
                    *(pg8::f32x4*)(p.out + O_NAT + (size_t)(((row >> 8) * 4 + l) * 2 + kv) * 65536 + (row & 255) * 256 + (col - (kv ? C_NV : C_NK))) = v;
                  } else if (col >= C_SK) {
                    const int kv = col >= C_SV;
                    *(pg8::f32x4*)(p.out + O_SWA + (size_t)(((row >> 8) * 4 + l) * 2 + kv) * 32768 + (row & 255) * 128 + (col - (kv ? C_SV : C_SK))) = v;
                  }
                }
              }
            } else if (MODE == 1) {
              *(pg8::f32x4*)((float*)(p.ws + OFF_U) + (size_t)row * D + col) = v;
            } else {
              const float r0 = fmaxf(v[0], 0.f), r1 = fmaxf(v[1], 0.f), r2 = fmaxf(v[2], 0.f), r3 = fmaxf(v[3], 0.f);
              uint2 o; o.x = pk2(r0 * r0, r1 * r1); o.y = pk2(r2 * r2, r3 * r3);
              *(uint2*)((bf16_t*)(p.ws + OFF_HID) + (size_t)row * FF + col) = o;
            }
          }
      }
  }
};

template <int MODE>
DEV void gemm_run(const Params& p, int l, const bf16_t* A, const bf16_t* BT, int K, int N, char* lds) {
  pg8::Gemm g{A, BT, MT, N, K};
  pg8::StaticOrder S; S.init(MT, N, (int)gridDim.x, (int)blockIdx.x);
  EpiMK<MODE> E{&p, l};
  pg8::gemm_phase<EpiMK<MODE>, pg8::StaticOrder, true, true>((PG8_LAS unsigned char*)lds, g, S, E);
}

DEV void prep_item(const Params& p, int l, int tile, char* lds) {
  const int t = tid(), r0 = tile * 16, c = t;
  int T, seq0;
  if (r0 < NCTX) { T = 256; seq0 = r0 & ~255; } else { T = 1024; seq0 = NCTX + ((r0 - NCTX) & ~1023); }
  float* sT = (float*)lds;
  float* swl = sT + 2048;
  float* sal = swl + 4096;
  const bf16_t* P = (const bf16_t*)(p.ws + OFF_P);
  float* PREP = (float*)(p.ws + OFF_PREP);
  float* BON = (float*)(p.ws + OFF_BONUS);
  for (int dir = 0; dir < 2; ++dir) {
    __syncthreads();
#pragma unroll
    for (int i = 0; i < 8; ++i) {
      const int e = t + 256 * i, tk = e >> 7, j = e & 127, which = j >> 6, jj = j & 63;
      const int row = r0 + tk, prow = dir ? row + 1 : row - 1;
      const bool pv = dir ? (row + 1 < seq0 + T) : (row > seq0);
      const int col = (dir ? C_WHB : C_WHF) + which * 64 + jj;
      const float cur = bf2f(P[(size_t)row * DIN + col]);
      const float prev = pv ? bf2f(P[(size_t)prow * DIN + col]) : 0.f;
      const float mu = p.in[I_MULORA][((l * 2 + dir) * 2 + which) * 64 + jj];
      float val = cur + (prev - cur) * mu;
      if (which == 0) val = tanhf_(val);
      sT[j * 16 + tk] = val;
    }
    __syncthreads();
    {
      const float* w2p = p.in[I_W2] + (size_t)(l * 2 + dir) * 64 * 256 + c;
      const float* a2p = p.in[I_A2] + (size_t)(l * 2 + dir) * 64 * 256 + c;
      float aw[16], aa[16];
#pragma unroll
      for (int k = 0; k < 16; ++k) { aw[k] = 0.f; aa[k] = 0.f; }
#pragma unroll 4
      for (int j = 0; j < 64; ++j) {
        const float w2j = w2p[j * 256], a2j = a2p[j * 256];
#pragma unroll
        for (int k4 = 0; k4 < 4; ++k4) {
          const float4 th4 = *(const float4*)(sT + j * 16 + k4 * 4);
          const float4 ah4 = *(const float4*)(sT + (64 + j) * 16 + k4 * 4);
          aw[k4 * 4 + 0] += th4.x * w2j; aw[k4 * 4 + 1] += th4.y * w2j; aw[k4 * 4 + 2] += th4.z * w2j; aw[k4 * 4 + 3] += th4.w * w2j;
          aa[k4 * 4 + 0] += ah4.x * a2j; aa[k4 * 4 + 1] += ah4.y * a2j; aa[k4 * 4 + 2] += ah4.z * a2j; aa[k4 * 4 + 3] += ah4.w * a2j;
        }
      }
#pragma unroll
      for (int k = 0; k < 16; ++k) { swl[k * 256 + c] = aw[k]; sal[k * 256 + c] = aa[k]; }
    }
    const float w0v = p.in[I_W0][(l * 2 + dir) * 256 + c], a0v = p.in[I_A0][(l * 2 + dir) * 256 + c];
    const float kkv = p.in[I_KK][l * 256 + c], kav = p.in[I_KA][l * 256 + c], rkv = p.in[I_RK][l * 256 + c];
    const float mur = p.in[I_MURKV][((l * 2 + dir) * 3 + 0) * 256 + c], muk = p.in[I_MURKV][((l * 2 + dir) * 3 + 1) * 256 + c],
                muv = p.in[I_MURKV][((l * 2 + dir) * 3 + 2) * 256 + c];
    float* pr = PREP + (size_t)dir * 6 * ARRF;
#pragma unroll 1
    for (int tk = 0; tk < 16; ++tk) {
      const int row = r0 + tk, prow = dir ? row + 1 : row - 1;
      const bool pv = dir ? (row + 1 < seq0 + T) : (row > seq0);
      const bf16_t* pc = P + (size_t)row * DIN + c;
      const bf16_t* pp = P + (size_t)prow * DIN + c;
      const float rc = bf2f(pc[C_R]), kc = bf2f(pc[C_K]), vc = bf2f(pc[C_V]);
      const float rp = pv ? bf2f(pp[C_R]) : 0.f, kp0 = pv ? bf2f(pp[C_K]) : 0.f, vp = pv ? bf2f(pp[C_V]) : 0.f;
      const float rs = rc + (rp - rc) * mur, ks = kc + (kp0 - kc) * muk, vs = vc + (vp - vc) * muv;
      const float wl = w0v + swl[tk * 256 + c], al = a0v + sal[tk * 256 + c];
      const float wv = __expf(-0.6065306597126334f * sigmoidf_(wl));
      const float av = sigmoidf_(al);
      const float kkr = ks * kkv;
      const float n2 = wave_sum(kkr * kkr);
      const float kk = kkr / fmaxf(sqrtf(n2), 1e-12f);
      const float kp = ks * (1.0f + (av - 1.0f) * kav);
      const float bs = wave_sum(rs * kp * rkv);
      const float bon = bs * vs;
      const size_t idx = (size_t)row * 256 + c;
      pr[idx] = rs; pr[ARRF + idx] = wv; pr[2 * ARRF + idx] = kp; pr[3 * ARRF + idx] = vs; pr[4 * ARRF + idx] = kk; pr[5 * ARRF + idx] = kk * av;
      if (dir == 0) BON[idx] = bon; else BON[idx] += bon;
    }
  }
  __syncthreads();
}

DEV void rope_item(const Params& p, int item) {
  bf16_t* P = (bf16_t*)(p.ws + OFF_P);
  const int t = tid();
  for (int e = t; e < 64 * 192; e += 256) {
    const int tk = e / 192, r = e % 192, hs = r >> 5, pi = r & 31;
    const int lt = item * 64 + tk;
    const int tt = lt & 1023;
    const int grow = tt >> 6, gcol = tt & 63;
    const int fi = pi & 15;
    const float pos = (pi < 16) ? (float)grow : (float)gcol;
    const float inv = exp2f(-(float)fi * (13.287712379549449f / 16.0f));
    const float ang = pos * inv;
    const float cs = __cosf(ang), sn = __sinf(ang);
    const int d1 = (pi < 16) ? fi : 32 + fi;
    bf16_t* base = P + (size_t)(NCTX + lt) * DIN + C_SQ + hs * 64;
    const float x1 = bf2f(base[d1]), x2 = bf2f(base[d1 + 16]);
    base[d1] = f2bf(x1 * cs - x2 * sn);
    base[d1 + 16] = f2bf(x2 * cs + x1 * sn);
  }
}

DEV void rwkv_scan(const Params& p, int l, int seq, int head, int dir, int rg, char* lds) {
  const int t = tid(), rl = t >> 4, ks = t & 15;
  const int T = seq < 32 ? 256 : 1024;
  const int row0 = seq < 32 ? seq * 256 : NCTX + (seq - 32) * 1024;
  const float* prep = (const float*)(p.ws + OFF_PREP) + (size_t)dir * 6 * ARRF;
  float* ydir = (float*)(p.ws + OFF_YDIR) + (size_t)dir * ARRF;
  float4* sbuf = (float4*)lds;
  float* vbuf = (float*)(lds + 20480);
  float* ybuf = vbuf + 256;
  float4 S = make_float4(0.f, 0.f, 0.f, 0.f);
  if (seq >= 32) S = *(const float4*)(p.in[I_SRW] + ((((size_t)(seq - 32) * 4 + l) * 2 + dir) * 4 + head) * 4096 + (rg * 16 + rl) * 64 + ks * 4);
  const int nch = T >> 4;
  float4 pre0, pre1, pre2, pre3, pre4; float prev;
  {
    const int s = rl; const int tok = dir ? (T - 1 - s) : s;
    const size_t base = (size_t)(row0 + tok) * 256 + head * 64;
    pre0 = *(const float4*)(prep + base + ks * 4);
    pre1 = *(const float4*)(prep + ARRF + base + ks * 4);
    pre2 = *(const float4*)(prep + 2 * ARRF + base + ks * 4);
    pre3 = *(const float4*)(prep + 4 * ARRF + base + ks * 4);
    pre4 = *(const float4*)(prep + 5 * ARRF + base + ks * 4);
    prev = prep[3 * ARRF + base + rg * 16 + ks];
  }
  for (int c = 0; c < nch; ++c) {
    __syncthreads();
    sbuf[(0 * 16 + rl) * 16 + ks] = pre0; sbuf[(1 * 16 + rl) * 16 + ks] = pre1; sbuf[(2 * 16 + rl) * 16 + ks] = pre2;
    sbuf[(3 * 16 + rl) * 16 + ks] = pre3; sbuf[(4 * 16 + rl) * 16 + ks] = pre4;
    vbuf[rl * 16 + ks] = prev;
    __syncthreads();
    if (c + 1 < nch) {
      const int s = (c + 1) * 16 + rl; const int tok = dir ? (T - 1 - s) : s;
      const size_t base = (size_t)(row0 + tok) * 256 + head * 64;
      pre0 = *(const float4*)(prep + base + ks * 4);
      pre1 = *(const float4*)(prep + ARRF + base + ks * 4);
      pre2 = *(const float4*)(prep + 2 * ARRF + base + ks * 4);
      pre3 = *(const float4*)(prep + 4 * ARRF + base + ks * 4);
      pre4 = *(const float4*)(prep + 5 * ARRF + base + ks * 4);
      prev = prep[3 * ARRF + base + rg * 16 + ks];
    }
#pragma unroll 4
    for (int i = 0; i < 16; ++i) {
      const float4 r = sbuf[(0 * 16 + i) * 16 + ks], wv = sbuf[(1 * 16 + i) * 16 + ks], kv = sbuf[(2 * 16 + i) * 16 + ks],
                   kk = sbuf[(3 * 16 + i) * 16 + ks], ka = sbuf[(4 * 16 + i) * 16 + ks];
      const float v = vbuf[i * 16 + rl];
      float sa = S.x * kk.x + S.y * kk.y + S.z * kk.z + S.w * kk.w;
      sa = -row16_sum(sa);
      S.x = S.x * wv.x + sa * ka.x + v * kv.x;
      S.y = S.y * wv.y + sa * ka.y + v * kv.y;
      S.z = S.z * wv.z + sa * ka.z + v * kv.z;
      S.w = S.w * wv.w + sa * ka.w + v * kv.w;
      float y = S.x * r.x + S.y * r.y + S.z * r.z + S.w * r.w;
      y = row16_sum(y);
      if (ks == 0) ybuf[i * 16 + rl] = y;
    }
    __syncthreads();
    {
      const int s = c * 16 + rl; const int tok = dir ? (T - 1 - s) : s;
      ydir[(size_t)(row0 + tok) * 256 + head * 64 + rg * 16 + ks] = ybuf[rl * 16 + ks];
    }
  }
  if (seq < 32) *(float4*)(p.out + O_RW + ((((size_t)seq * 4 + l) * 2 + dir) * 4 + head) * 4096 + (rg * 16 + rl) * 64 + ks * 4) = S;
  __syncthreads();
}

DEV void hgrn_scan(const Params& p, int l, int seq, int head, int dir, int rg, char* lds) {
  const int t = tid(), rl = t >> 4, ks = t & 15;
  const int T = seq < 32 ? 256 : 1024;
  const int row0 = seq < 32 ? seq * 256 : NCTX + (seq - 32) * 1024;
  const bf16_t* P = (const bf16_t*)(p.ws + OFF_P);
  float* odir = (float*)(p.ws + OFF_HDIR) + (size_t)dir * ARRF;
  float4* sbuf = (float4*)lds;
  float* vbuf = (float*)(lds + 20480);
  float* ybuf = vbuf + 256;
  const float4 lb4 = *(const float4*)((const float*)(p.ws + OFF_HGLB) + (l * 2 + dir) * 256 + head * 64 + ks * 4);
  const int vrow = rg * 16 + rl;
  float4 S = make_float4(0.f, 0.f, 0.f, 0.f);
  if (seq >= 32) {
    const float* sp = p.in[I_SHG] + ((((size_t)(seq - 32) * 4 + l) * 2 + dir) * 4 + head) * 4096;
    S.x = sp[(ks * 4 + 0) * 64 + vrow]; S.y = sp[(ks * 4 + 1) * 64 + vrow]; S.z = sp[(ks * 4 + 2) * 64 + vrow]; S.w = sp[(ks * 4 + 3) * 64 + vrow];
  }
  const int nch = T >> 4;
  const int fcol = (dir ? C_HFB : C_HFF) + head * 64;
  uint2 pq, pf; bf16_t pvv;
  {
    const int s = rl; const int tok = dir ? (T - 1 - s) : s;
    const bf16_t* pr = P + (size_t)(row0 + tok) * DIN;
    pq = *(const uint2*)(pr + C_HQ + head * 64 + ks * 4);
    pf = *(const uint2*)(pr + fcol + ks * 4);
    pvv = pr[C_HI + head * 64 + rg * 16 + ks];
  }
  for (int c = 0; c < nch; ++c) {
    __syncthreads();
    {
      float4 q, f, k;
      float a;
      a = bflo(pq.x); q.x = a * sigmoidf_(a); a = bfhi(pq.x); q.y = a * sigmoidf_(a);
      a = bflo(pq.y); q.z = a * sigmoidf_(a); a = bfhi(pq.y); q.w = a * sigmoidf_(a);
      float sg;
      sg = sigmoidf_(bflo(pf.x)); f.x = lb4.x + (1.f - lb4.x) * sg; k.x = (1.f - lb4.x) * (1.f - sg);
      sg = sigmoidf_(bfhi(pf.x)); f.y = lb4.y + (1.f - lb4.y) * sg; k.y = (1.f - lb4.y) * (1.f - sg);
      sg = sigmoidf_(bflo(pf.y)); f.z = lb4.z + (1.f - lb4.z) * sg; k.z = (1.f - lb4.z) * (1.f - sg);
      sg = sigmoidf_(bfhi(pf.y)); f.w = lb4.w + (1.f - lb4.w) * sg; k.w = (1.f - lb4.w) * (1.f - sg);
      sbuf[(0 * 16 + rl) * 16 + ks] = q; sbuf[(1 * 16 + rl) * 16 + ks] = f; sbuf[(2 * 16 + rl) * 16 + ks] = k;
      vbuf[rl * 16 + ks] = bf2f(pvv);
    }
    __syncthreads();
    if (c + 1 < nch) {
      const int s = (c + 1) * 16 + rl; const int tok = dir ? (T - 1 - s) : s;
      const bf16_t* pr = P + (size_t)(row0 + tok) * DIN;
      pq = *(const uint2*)(pr + C_HQ + head * 64 + ks * 4);
      pf = *(const uint2*)(pr + fcol + ks * 4);
      pvv = pr[C_HI + head * 64 + rg * 16 + ks];
    }
#pragma unroll 4
    for (int i = 0; i < 16; ++i) {
      const float4 q = sbuf[(0 * 16 + i) * 16 + ks], f = sbuf[(1 * 16 + i) * 16 + ks], k = sbuf[(2 * 16 + i) * 16 + ks];
      const float v = vbuf[i * 16 + rl];
      S.x = S.x * f.x + k.x * v; S.y = S.y * f.y + k.y * v; S.z = S.z * f.z + k.z * v; S.w = S.w * f.w + k.w * v;
      float y = S.x * q.x + S.y * q.y + S.z * q.z + S.w * q.w;
      y = row16_sum(y);
      if (ks == 0) ybuf[i * 16 + rl] = y;
    }
    __syncthreads();
    {
      const int s = c * 16 + rl; const int tok = dir ? (T - 1 - s) : s;
      odir[(size_t)(row0 + tok) * 256 + head * 64 + rg * 16 + ks] = ybuf[rl * 16 + ks];
    }
  }
  if (seq < 32) {
    float* sp = p.out + O_HG + ((((size_t)seq * 4 + l) * 2 + dir) * 4 + head) * 4096;
    sp[(ks * 4 + 0) * 64 + vrow] = S.x; sp[(ks * 4 + 1) * 64 + vrow] = S.y; sp[(ks * 4 + 2) * 64 + vrow] = S.z; sp[(ks * 4 + 3) * 64 + vrow] = S.w;
  }
  __syncthreads();
}

template <int MODE>
DEV void attn_item(const Params& p, int l, int item, char* lds) {
  const int t = tid(), lane = t & 63, w = t >> 6, q = lane & 31, hh = lane >> 5;
  const bf16_t* P = (const bf16_t*)(p.ws + OFF_P);
  bf16_t* Y = (bf16_t*)(p.ws + OFF_YMIX);
  char* sK = lds;
  char* sV = lds + 8192;
  float* sBias = (float*)(lds + 8192 + 8704);
  int head, qrow, qcol, kcol, vcol, ocol, nloc, nt, rowbaseP;
  int qr = 0, qc = 0, rlo = 0, qpos = 0, lo = 0, rsq = 0, wsq = 0;
  float sink = 0.f;
  const float* cache = nullptr; int cH = 1, cHead = 0;
  if (MODE == 0 || MODE == 1) {
    const int b = item >> 3; head = (item >> 1) & 3; const int half = item & 1;
    rowbaseP = b * 256; qrow = rowbaseP + half * 128 + w * 32 + q; nloc = 4; nt = 4;
  } else {
    const int b = item >> 5; head = (item >> 3) & 3; const int sub = item & 7;
    rowbaseP = NCTX + b * 1024;
    if (MODE == 2) {
      qr = 2 * sub + (w >> 1); qc = (w & 1) * 32 + q; qrow = rowbaseP + qr * 64 + qc;
      rlo = clampi(2 * sub - 4, 0, 8); const int rhi = clampi(2 * sub - 3, 0, 8) + 7; nloc = rhi - rlo + 1; nt = nloc + 4;
      rsq = clampi(qr - 4, 0, 8); wsq = clampi(qc - 8, 0, 48);
      cache = p.in[I_CNAT] + (size_t)((b * 4 + l) * 2) * 256 * 256; cH = 4; cHead = head;
      for (int i = t; i < 465; i += 256) sBias[i] = p.in[I_RPB][(size_t)(l * 4 + head) * 465 + i];
    } else {
      qpos = sub * 128 + w * 32 + q; qrow = rowbaseP + qpos;
      lo = (sub - 1) * 128;
      nloc = 6; nt = nloc + 4;
      cache = p.in[I_CSWA] + (size_t)((b * 4 + l) * 2) * 256 * 128; cH = 2; cHead = head >> 1;
    }
  }
  if (MODE == 0 || MODE == 2) { qcol = C_NQ + head * 64; kcol = C_NK + head * 64; vcol = C_NV + head * 64; ocol = 256 + head * 64; }
  else { qcol = C_SQ + head * 64; kcol = C_SK + (head >> 1) * 64; vcol = C_SV + (head >> 1) * 64; ocol = 768 + head * 64; sink = p.in[I_SINK][l * 4 + head]; }

  bf16x8 bq[4];
#pragma unroll
  for (int s = 0; s < 4; ++s) bq[s] = *(const bf16x8*)(P + (size_t)qrow * DIN + qcol + 16 * s + 8 * hh);
  f32x16 oacc[2];
#pragma unroll
  for (int r = 0; r < 16; ++r) { oacc[0][r] = 0.f; oacc[1][r] = 0.f; }
  float m_run = -1e30f, l_run = 0.f;
  const int key = t >> 2, dq = t & 3;
  const int kswz = (key >> 1) & 7;
  for (int j = 0; j < nt; ++j) {
    uint4 kr[2], vr[2];
    const bool isP = j < nloc;
    int keybase = 0;
    if (isP) {
      if (MODE == 0 || MODE == 1) keybase = rowbaseP + j * 64;
      else if (MODE == 2) keybase = rowbaseP + (rlo + j) * 64;
      else keybase = rowbaseP + lo + j * 64;
      int krow = keybase + key;
      if (MODE == 3) krow = rowbaseP + clampi(lo + j * 64 + key, 0, 1023);
      const bf16_t* kp = P + (size_t)krow * DIN + kcol + dq * 16;
      const bf16_t* vp = P + (size_t)krow * DIN + vcol + dq * 16;
      kr[0] = *(const uint4*)kp; kr[1] = *(const uint4*)(kp + 8);
      vr[0] = *(const uint4*)vp; vr[1] = *(const uint4*)(vp + 8);
    } else {
      const int ct = (j - nloc) * 64 + key;
      const float* kp = cache + ((size_t)ct * cH + cHead) * 64 + dq * 16;
      const float* vp = kp + (size_t)256 * cH * 64;
      const float4 k0 = *(const float4*)kp, k1 = *(const float4*)(kp + 4), k2 = *(const float4*)(kp + 8), k3 = *(const float4*)(kp + 12);
      const float4 v0 = *(const float4*)vp, v1 = *(const float4*)(vp + 4), v2 = *(const float4*)(vp + 8), v3 = *(const float4*)(vp + 12);
      kr[0].x = pk2(k0.x, k0.y); kr[0].y = pk2(k0.z, k0.w); kr[0].z = pk2(k1.x, k1.y); kr[0].w = pk2(k1.z, k1.w);
      kr[1].x = pk2(k2.x, k2.y); kr[1].y = pk2(k2.z, k2.w); kr[1].z = pk2(k3.x, k3.y); kr[1].w = pk2(k3.z, k3.w);
      vr[0].x = pk2(v0.x, v0.y); vr[0].y = pk2(v0.z, v0.w); vr[0].z = pk2(v1.x, v1.y); vr[0].w = pk2(v1.z, v1.w);
      vr[1].x = pk2(v2.x, v2.y); vr[1].y = pk2(v2.z, v2.w); vr[1].z = pk2(v3.x, v3.y); vr[1].w = pk2(v3.z, v3.w);
    }
    __syncthreads();
    *(uint4*)(sK + key * 128 + (((dq * 2 + 0) ^ kswz) << 4)) = kr[0];
    *(uint4*)(sK + key * 128 + (((dq * 2 + 1) ^ kswz) << 4)) = kr[1];
    {
      bf16_t* vt = (bf16_t*)sV;
      const unsigned vv[8] = {vr[0].x, vr[0].y, vr[0].z, vr[0].w, vr[1].x, vr[1].y, vr[1].z, vr[1].w};
#pragma unroll
      for (int e = 0; e < 8; ++e) {
        vt[(dq * 16 + 2 * e) * 68 + key] = (bf16_t)(vv[e] & 0xffffu);
        vt[(dq * 16 + 2 * e + 1) * 68 + key] = (bf16_t)(vv[e] >> 16);
      }
    }
    __syncthreads();
    f32x16 sacc[2];
#pragma unroll
    for (int r = 0; r < 16; ++r) { sacc[0][r] = 0.f; sacc[1][r] = 0.f; }
    const int qswz = (q >> 1) & 7;
#pragma unroll
    for (int s = 0; s < 4; ++s) {
      const int co = (((s * 2 + hh) ^ qswz) << 4);
      const bf16x8 a0 = *(const bf16x8*)(sK + q * 128 + co);
      const bf16x8 a1 = *(const bf16x8*)(sK + (32 + q) * 128 + co);
      sacc[0] = MFMA32(a0, bq[s], sacc[0]);
      sacc[1] = MFMA32(a1, bq[s], sacc[1]);
    }
    float mx = -1e30f;
#pragma unroll
    for (int sub = 0; sub < 2; ++sub)
#pragma unroll
      for (int r = 0; r < 16; ++r) {
        const int kidx = sub * 32 + (r & 3) + 8 * (r >> 2) + 4 * hh;
        float v = sacc[sub][r] * 0.125f;
        bool ok = true;
        if (MODE == 2 && isP) {
          const int kr_ = rlo + j, kc_ = kidx;
          ok = (kr_ >= rsq) && (kr_ < rsq + 8) && (kc_ >= wsq) && (kc_ < wsq + 16);
          const int bi = ok ? ((kr_ - qr + 7) * 31 + (kc_ - qc + 15)) : 0;
          v += sBias[bi];
        }
        if (MODE == 3 && isP) {
          const int kpos = lo + j * 64 + kidx, dlt = kpos - qpos;
          ok = (dlt <= 128) && (dlt >= -128) && (kpos >= 0) && (kpos < 1024);
        }
        v = ok ? v : -1e30f;
        sacc[sub][r] = v;
        mx = fmaxf(mx, v);
      }
    mx = fmaxf(mx, __shfl_xor(mx, 32));
    const float m_new = fmaxf(m_run, mx);
    const float alpha = __expf(m_run - m_new);
    float rsum = 0.f;
#pragma unroll
    for (int sub = 0; sub < 2; ++sub)
#pragma unroll
      for (int r = 0; r < 16; ++r) {
        const float v = sacc[sub][r];
        const float pv = (v > -1e29f) ? __expf(v - m_new) : 0.f;
        sacc[sub][r] = pv; rsum += pv;
      }
    rsum += __shfl_xor(rsum, 32);
    l_run = l_run * alpha + rsum; m_run = m_new;
#pragma unroll
    for (int r = 0; r < 16; ++r) { oacc[0][r] *= alpha; oacc[1][r] *= alpha; }
#pragma unroll
    for (int k4 = 0; k4 < 4; ++k4) {
      const int sub = k4 >> 1, s2 = k4 & 1;
      uint4 pbu;
      pbu.x = pk2(sacc[sub][8 * s2 + 0], sacc[sub][8 * s2 + 1]); pbu.y = pk2(sacc[sub][8 * s2 + 2], sacc[sub][8 * s2 + 3]);
      pbu.z = pk2(sacc[sub][8 * s2 + 4], sacc[sub][8 * s2 + 5]); pbu.w = pk2(sacc[sub][8 * s2 + 6], sacc[sub][8 * s2 + 7]);
      const bf16x8 pb = __builtin_bit_cast(bf16x8, pbu);
#pragma unroll
      for (int dt = 0; dt < 2; ++dt) {
        const char* vp = sV + (dt * 32 + q) * 136 + (16 * k4 + 4 * hh) * 2;
        const uint2 lo8 = *(const uint2*)vp, hi8 = *(const uint2*)(vp + 16);
        uint4 avu; avu.x = lo8.x; avu.y = lo8.y; avu.z = hi8.x; avu.w = hi8.y;
        oacc[dt] = MFMA32(__builtin_bit_cast(bf16x8, avu), pb, oacc[dt]);
      }
    }
  }
  float scale;
  if (MODE == 1 || MODE == 3) {
    const float m_f = fmaxf(m_run, sink);
    const float e = __expf(m_run - m_f);
    scale = e / (l_run * e + __expf(sink - m_f));
  } else scale = 1.0f / l_run;
#pragma unroll
  for (int dt = 0; dt < 2; ++dt)
#pragma unroll
    for (int g4 = 0; g4 < 4; ++g4) {
      const int d = dt * 32 + 8 * g4 + 4 * hh;
      uint2 o; o.x = pk2(oacc[dt][4 * g4] * scale, oacc[dt][4 * g4 + 1] * scale); o.y = pk2(oacc[dt][4 * g4 + 2] * scale, oacc[dt][4 * g4 + 3] * scale);
      *(uint2*)(Y + (size_t)qrow * D + ocol + d) = o;
    }
  __syncthreads();
}

DEV void post_item(const Params& p, int l, int tile, char* lds) {
  const int t = tid(), r0 = tile * 16, c = t;
  float* sT = (float*)lds;
  float* sgo = sT + 2048;
  const bf16_t* P = (const bf16_t*)(p.ws + OFF_P);
  bf16_t* Y = (bf16_t*)(p.ws + OFF_YMIX);
  const float* Y0 = (const float*)(p.ws + OFF_YDIR); const float* Y1 = Y0 + ARRF;
  const float* H0 = (const float*)(p.ws + OFF_HDIR); const float* H1 = H0 + ARRF;
  const float* BON = (const float*)(p.ws + OFF_BONUS);
  __syncthreads();
#pragma unroll
  for (int i = 0; i < 8; ++i) {
    const int e = t + 256 * i, tk = e >> 7, j = e & 127;
    sT[j * 16 + tk] = sigmoidf_(bf2f(P[(size_t)(r0 + tk) * DIN + C_GH + j]));
  }
  __syncthreads();
  {
    const float* g2p = p.in[I_G2] + (size_t)l * 128 * 256 + c;
    float ag[16];
#pragma unroll
    for (int k = 0; k < 16; ++k) ag[k] = 0.f;
#pragma unroll 4
    for (int j = 0; j < 128; ++j) {
      const float gj = g2p[j * 256];
#pragma unroll
      for (int k4 = 0; k4 < 4; ++k4) {
        const float4 s4 = *(const float4*)(sT + j * 16 + k4 * 4);
        ag[k4 * 4 + 0] += s4.x * gj; ag[k4 * 4 + 1] += s4.y * gj; ag[k4 * 4 + 2] += s4.z * gj; ag[k4 * 4 + 3] += s4.w * gj;
      }
    }
#pragma unroll
    for (int k = 0; k < 16; ++k) sgo[k * 256 + c] = ag[k];
  }
  const float lnw = p.in[I_LNW][l * 256 + c], lnb = p.in[I_LNB][l * 256 + c], hgn = p.in[I_HGN][l * 256 + c];
#pragma unroll 1
  for (int tk = 0; tk < 16; ++tk) {
    const int row = r0 + tk;
    const size_t idx = (size_t)row * 256 + c;
    const float y = Y0[idx] + Y1[idx];
    const float mu = wave_sum(y) * (1.0f / 64.0f);
    const float dy = y - mu;
    const float var = wave_sum(dy * dy) * (1.0f / 64.0f);
    const float yn = dy * rsqrtf(var + 64e-5f) * lnw + lnb + BON[idx];
    const float g = sgo[tk * 256 + c];
    Y[(size_t)row * D + c] = f2bf(yn * g);
    const float o = H0[idx] + H1[idx];
    const float ms = wave_sum(o * o) * (1.0f / 64.0f);
    const float gt = sigmoidf_(bf2f(P[(size_t)row * DIN + C_HG + c]));
    Y[(size_t)row * D + 512 + c] = f2bf(o * rsqrtf(ms + 1e-6f) * hgn * gt);
  }
  __syncthreads();
}

DEV void mixer_phase(const Params& p, int l, char* lds0) {
  const int hf = half_id(); char* lds = lds0 + hf * 65536;
  const int nitems = 256 + 2048 + 512;
  for (int it = blockIdx.x * 2 + hf; it < nitems; it += gridDim.x * 2) {
    int kind, idx;
    if (it < 64) { kind = 0; idx = 1024 + it; }
    else if (it < 128) { kind = 1; idx = 1024 + it - 64; }
    else if (it < 192) { kind = 5; idx = it - 128; }
    else if (it < 256) { kind = 4; idx = it - 192; }
    else if (it < 1280) { kind = 0; idx = it - 256; }
    else if (it < 2304) { kind = 1; idx = it - 1280; }
    else if (it < 2560) { kind = 2; idx = it - 2304; }
    else { kind = 3; idx = it - 2560; }
    if (kind < 2) {
      const int seq = idx >> 5, rem = idx & 31;
      if (kind == 0) rwkv_scan(p, l, seq, rem >> 3, (rem >> 2) & 1, rem & 3, lds);
      else hgrn_scan(p, l, seq, rem >> 3, (rem >> 2) & 1, rem & 3, lds);
    } else if (kind == 2) attn_item<0>(p, l, idx, lds);
    else if (kind == 3) attn_item<1>(p, l, idx, lds);
    else if (kind == 4) attn_item<2>(p, l, idx, lds);
    else attn_item<3>(p, l, idx, lds);
  }
}

DEV void run_phase(const Params& p, int ph, char* lds, bool rerun) {
  if (ph == 0) { phase0(p, lds); return; }
  if (ph == 1) { row_phase(p, 0, 0); return; }
  const int l = (ph - 2) / 9, s = (ph - 2) % 9;
  const bf16_t* H = (const bf16_t*)(p.ws + OFF_H);
  const int hf = half_id(); char* ldsh = lds + hf * 65536;
  switch (s) {
    case 0: gemm_run<0>(p, l, H, (const bf16_t*)(p.ws + OFF_WIN) + (size_t)l * DINP * D, D, DINP, lds); break;
    case 1:
      for (int it = blockIdx.x * 2 + hf; it < 640 + 32; it += gridDim.x * 2) { if (it < 640) prep_item(p, l, it, ldsh); else if (!rerun) rope_item(p, it - 640); }
      break;
    case 2: mixer_phase(p, l, lds); break;
    case 3: for (int it = blockIdx.x * 2 + hf; it < 640; it += gridDim.x * 2) post_item(p, l, it, ldsh); break;
    case 4: gemm_run<1>(p, l, (const bf16_t*)(p.ws + OFF_YMIX), (const bf16_t*)(p.ws + OFF_WOUT) + (size_t)l * D * D, D, D, lds); break;
    case 5: row_phase(p, 1, l); break;
    case 6: gemm_run<2>(p, l, H, (const bf16_t*)(p.ws + OFF_W1) + (size_t)l * FF * D, D, FF, lds); break;
    case 7: gemm_run<1>(p, l, (const bf16_t*)(p.ws + OFF_HID), (const bf16_t*)(p.ws + OFF_W2) + (size_t)l * D * FF, FF, D, lds); break;
    case 8: row_phase(p, 2, l); break;
  }
}

#define XB_TMO      128
#define XB_XCNT(j)  (256  + 64 * (j))
#define XB_XSUB(j)  (1280 + 64 * (j))
#define XB_XGEN(j)  (2304 + 64 * (j))
#define XB_TOP      3328
#define XB_TOPGEN   3392
#define XCD_BAR_WORDS 3456
#define XB_SPIN_CAP (1u << 18)
#define LAS __attribute__((address_space(3)))
DEV unsigned xb_ld(unsigned* p) { return __hip_atomic_load(p, __ATOMIC_RELAXED, __HIP_MEMORY_SCOPE_AGENT); }
DEV unsigned xb_add(unsigned* p, unsigned v) { return __hip_atomic_fetch_add(p, v, __ATOMIC_RELAXED, __HIP_MEMORY_SCOPE_AGENT); }
DEV unsigned xb_xcc_id() { return (unsigned)__builtin_amdgcn_s_getreg((3 << 11) | 20) & 0xFu; }
#define XB_SPIN(cond, bar) do { unsigned _sp = 0; while (cond) { __builtin_amdgcn_s_sleep(1); \
    if ((++_sp & 255u) == 0u) { if (xb_ld(&(bar)[XB_TMO])) break; if (_sp > XB_SPIN_CAP) { atomicAdd(&(bar)[XB_TMO], 1u); break; } } } } while (0)
struct XcdBarrier { unsigned* bar; unsigned x; volatile LAS unsigned* st; };
DEV XcdBarrier xcd_barrier_post(unsigned* bar, volatile LAS unsigned* st) {
  XcdBarrier b; b.bar = bar; b.x = xb_xcc_id(); b.st = st;
  if (threadIdx.x == 0) (void)xb_add(&bar[XB_XCNT(b.x)], 1u);
  return b;
}
DEV void xcd_barrier_complete(unsigned* bar, unsigned x, unsigned& nloc, unsigned& nx) {
  const unsigned G = gridDim.x * gridDim.y * gridDim.z;
  unsigned sum, cnt, mine, sp = 0u;
  for (;;) {
    sum = 0u; cnt = 0u; mine = 0u;
#pragma unroll
    for (unsigned j = 0; j < 16; ++j) { const unsigned c = xb_ld(&bar[XB_XCNT(j)]); sum += c; cnt += (c > 0u) ? 1u : 0u; mine = (j == x) ? c : mine; }
    if (sum == G) break;
    __builtin_amdgcn_s_sleep(1);
    if ((++sp & 255u) == 0u) { if (xb_ld(&bar[XB_TMO])) break; if (sp > XB_SPIN_CAP) { atomicAdd(&bar[XB_TMO], 1u); break; } }
  }
  nloc = mine > 0u ? mine : 1u; nx = cnt > 0u ? cnt : 1u;
}
DEV void xcd_barrier(const XcdBarrier& b) {
  asm volatile("s_waitcnt vmcnt(0)" ::: "memory");
  __syncthreads();
  if (threadIdx.x == 0) {
    unsigned* bar = b.bar;
    __builtin_amdgcn_s_waitcnt(0);
    unsigned nloc = b.st[0], nx = b.st[1];
    if (nloc == 0u) { xcd_barrier_complete(bar, b.x, nloc, nx); b.st[0] = nloc; b.st[1] = nx; }
    const unsigned old = xb_add(&bar[XB_XSUB(b.x)], 1u);
    const unsigned gen = old / nloc;
    if (old + 1u == (gen + 1u) * nloc) {
      __builtin_amdgcn_fence(__ATOMIC_RELEASE, "agent");
      asm volatile("s_waitcnt vmcnt(0)" ::: "memory");
      const unsigned og = xb_add(&bar[XB_TOP], 1u);
      const unsigned tg = og / nx;
      if (og + 1u == (tg + 1u) * nx) xb_add(&bar[XB_TOPGEN], 1u);
      else XB_SPIN(xb_ld(&bar[XB_TOPGEN]) == tg, bar);
      __builtin_amdgcn_fence(__ATOMIC_ACQUIRE, "agent");
      xb_add(&bar[XB_XGEN(b.x)], 1u);
      asm volatile("s_waitcnt vmcnt(0)" ::: "memory");
    } else {
      XB_SPIN(xb_ld(&bar[XB_XGEN(b.x)]) == gen, bar);
      __builtin_amdgcn_fence(__ATOMIC_ACQUIRE, "agent");
      asm volatile("s_waitcnt vmcnt(0)" ::: "memory");
    }
  }
  __syncthreads();
}

DEV int phase_kind(int ph) {
  if (ph == 0) return 0;
  if (ph == 1) return 1;
  const int s = (ph - 2) % 9;
  return s == 0 ? 2 : s == 1 ? 3 : s == 2 ? 4 : s == 3 ? 5 : s == 4 ? 6 : s == 5 ? 1 : s == 6 ? 7 : s == 7 ? 8 : 1;
}

constexpr int LDS_BYTES = 131072 + 64;

__global__ void __launch_bounds__(512, 2) mega(Params p, int ph_lo, int ph_hi) {
  extern __shared__ __attribute__((aligned(16))) unsigned char smem[];
  char* lds = (char*)smem;
  volatile LAS unsigned* st = (volatile LAS unsigned*)((LAS unsigned char*)smem + 131072);
  if (threadIdx.x == 0) { st[0] = 0u; st[1] = 0u; }
  __syncthreads();
  XcdBarrier xb = xcd_barrier_post((unsigned*)(p.ws + OFF_BAR), st);
  if (ph_hi < 0) cg::this_grid().sync();
  for (int ph = ph_lo; ph < ph_hi; ++ph) {
    run_phase(p, ph, lds, false);
    if (PROBE_KIND >= 0 && (PROBE_KIND == 9 || phase_kind(ph) == PROBE_KIND)) {
      xcd_barrier(xb);
      if (PROBE_KIND != 9) run_phase(p, ph, lds, true);
    }
    if (ph + 1 < ph_hi) xcd_barrier(xb);
  }
}

extern "C" void kernel_launch(void* const* d_in, const int* in_sizes, int n_in, void* d_out, int out_size, void* d_ws, size_t ws_size,
                              hipStream_t stream) {
  static int grid_blocks = 0;
  if (!grid_blocks) {
    int dev = 0, cus = 0, per_cu = 0;
    (void)hipGetDevice(&dev);
    (void)hipDeviceGetAttribute(&cus, hipDeviceAttributeMultiprocessorCount, dev);
    if (hipFuncSetAttribute((const void*)mega, hipFuncAttributeMaxDynamicSharedMemorySize, LDS_BYTES) != hipSuccess) fprintf(stderr, "hipFuncSetAttribute failed\n");
    (void)hipOccupancyMaxActiveBlocksPerMultiprocessor(&per_cu, mega, 512, LDS_BYTES);
    if (per_cu < 1) fprintf(stderr, "occupancy query reports %d blocks per CU\n", per_cu);
    (void)hipGetLastError();
    grid_blocks = cus;
  }
  if (ws_size < WS_TOTAL) { fprintf(stderr, "workspace too small: %zu < %zu\n", ws_size, (size_t)WS_TOTAL); return; }
  Params p{};
  for (int i = 0; i < 31; ++i) p.in[i] = (const float*)d_in[i];
  p.out = (float*)d_out;
  p.ws = (char*)d_ws;
  (void)hipMemsetAsync((char*)d_ws + OFF_BAR, 0, 16384, stream);
  int lo = 0, hi = NPH;
  void* args[] = {&p, &lo, &hi};
  hipError_t e = hipLaunchCooperativeKernel((void*)mega, dim3(grid_blocks), dim3(512), args, LDS_BYTES, stream);
  if (e != hipSuccess) fprintf(stderr, "cooperative launch failed: %s (grid %d)\n", hipGetErrorString(e), grid_blocks);
}
```

```cpp
#include <hip/hip_runtime.h>
#include <hip/hip_cooperative_groups.h>
#include <cstdio>
#include <cstdint>
namespace cg = cooperative_groups;

#ifndef ONE_LAUNCH
#define ONE_LAUNCH 1
#endif
#define PROBE_KIND -1

#define DEV __device__ __forceinline__
typedef unsigned short bf16_t;
typedef short bf16x8 __attribute__((ext_vector_type(8)));
typedef float f32x16 __attribute__((ext_vector_type(16)));
typedef __bf16 bf2_t __attribute__((ext_vector_type(2)));
typedef float f2_t __attribute__((ext_vector_type(2)));

constexpr int D = 1024, DIN = 3712, FF = 4096, NCTX = 8192, MT = 10240;
constexpr int NPH = 38;
constexpr int DINP = 3840;
constexpr int C_R = 0, C_K = 256, C_V = 512, C_GH = 768, C_WHF = 896, C_WHB = 1024;
constexpr int C_NQ = 1152, C_NK = 1408, C_NV = 1664;
constexpr int C_HQ = 1920, C_HI = 2176, C_HG = 2432, C_HFF = 2688, C_HFB = 2944;
constexpr int C_SQ = 3200, C_SK = 3456, C_SV = 3584;
constexpr size_t O_NAT = 10485760, O_SWA = 27262976, O_RW = 35651584, O_HG = 39845888;
constexpr size_t ARRF = (size_t)MT * 256;
constexpr size_t ARR = ARRF * 4;
constexpr size_t OFF_WIN = 0;
constexpr size_t OFF_WOUT = OFF_WIN + (size_t)4 * DINP * D * 2;
constexpr size_t OFF_W1 = OFF_WOUT + (size_t)4 * D * D * 2;
constexpr size_t OFF_W2 = OFF_W1 + (size_t)4 * FF * D * 2;
constexpr size_t OFF_MOD = OFF_W2 + (size_t)4 * FF * D * 2;
constexpr size_t OFF_HGLB = OFF_MOD + (size_t)4 * 3 * 6144 * 4;
constexpr size_t OFF_P = OFF_HGLB + 8192;
constexpr size_t OFF_R1 = OFF_P + (size_t)MT * DIN * 2;
constexpr size_t OFF_H = OFF_R1;
constexpr size_t OFF_HID = OFF_H + (size_t)MT * D * 2;
constexpr size_t OFF_U = OFF_HID + (size_t)MT * FF * 2;
constexpr size_t OFF_PREP = OFF_R1;
constexpr size_t OFF_YDIR = OFF_PREP + 12 * ARR;
constexpr size_t OFF_BONUS = OFF_R1 + 14 * ARR;
constexpr size_t OFF_HDIR = OFF_BONUS + ARR;
constexpr size_t OFF_YMIX = OFF_HDIR + 2 * ARR;
constexpr size_t OFF_BAR = OFF_YMIX + (size_t)MT * D * 2;
constexpr size_t WS_TOTAL = OFF_BAR + 16384;
static_assert(OFF_U + (size_t)MT * D * 4 == OFF_BONUS, "R1 layout");

struct Params {
  const float* in[31];
  float* out;
  char* ws;
};
enum { I_XP = 0, I_XS, I_CNAT, I_CSWA, I_SRW, I_SHG, I_C, I_CCTX, I_NORMG, I_MODW, I_MODB, I_WIN, I_WOUT, I_MURKV, I_MULORA,
       I_W0, I_W2, I_A0, I_A2, I_G2, I_KK, I_KA, I_RK, I_LNW, I_LNB, I_RPB, I_HGLB, I_HGN, I_SINK, I_FW1, I_FW2 };

DEV bf16_t f2bf(float f) { unsigned u = __float_as_uint(f); u += 0x7fffu + ((u >> 16) & 1u); return (bf16_t)(u >> 16); }
DEV float bf2f(bf16_t h) { return __uint_as_float(((unsigned)h) << 16); }
DEV unsigned pk2(float a, float b) { f2_t v = {a, b}; bf2_t r = __builtin_convertvector(v, bf2_t); return __builtin_bit_cast(unsigned, r); }
DEV float bflo(unsigned u) { return __uint_as_float(u << 16); }
DEV float bfhi(unsigned u) { return __uint_as_float(u & 0xffff0000u); }
DEV float sigmoidf_(float x) { return 1.0f / (1.0f + __expf(-x)); }
DEV float tanhf_(float x) { return 1.0f - 2.0f / (1.0f + __expf(2.0f * x)); }
template <int CTRL> DEV float dppf(float x) { return __int_as_float(__builtin_amdgcn_update_dpp(0, __float_as_int(x), CTRL, 0xF, 0xF, false)); }
DEV float row16_sum(float x) { x += dppf<0xB1>(x); x += dppf<0x4E>(x); x += dppf<0x141>(x); x += dppf<0x140>(x); return x; }
DEV float wave_sum(float x) { x = row16_sum(x); x += __shfl_xor(x, 16); x += __shfl_xor(x, 32); return x; }
DEV int clampi(int v, int lo, int hi) { return v < lo ? lo : (v > hi ? hi : v); }
#define MFMA32(a, b, c) __builtin_amdgcn_mfma_f32_32x32x16_bf16((a), (b), (c), 0, 0, 0)

DEV int tid() { int z; asm volatile("v_mov_b32 %0, 0" : "=v"(z)); return (int)(threadIdx.x & 255u) + z; }
DEV int half_id() { return __builtin_amdgcn_readfirstlane((int)(threadIdx.x >> 8)); }
DEV void transpose_item(const float* W, bf16_t* WT, int K, int N, int kt, int nt, char* lds) {
  bf16_t* s = (bf16_t*)lds;
  const int t = tid();
#pragma unroll
  for (int i = 0; i < 4; ++i) {
    const int k = (t >> 4) + 16 * i, n4 = (t & 15) * 4;
    const float4 v = *(const float4*)(W + (size_t)(kt * 64 + k) * N + nt * 64 + n4);
    s[(n4 + 0) * 72 + k] = f2bf(v.x); s[(n4 + 1) * 72 + k] = f2bf(v.y);
    s[(n4 + 2) * 72 + k] = f2bf(v.z); s[(n4 + 3) * 72 + k] = f2bf(v.w);
  }
  __syncthreads();
#pragma unroll
  for (int i = 0; i < 2; ++i) {
    const int n = (t >> 3) + 32 * i, kc = t & 7;
    const uint4 v = *(const uint4*)(s + n * 72 + kc * 8);
    *(uint4*)(WT + (size_t)(nt * 64 + n) * K + kt * 64 + kc * 8) = v;
  }
  __syncthreads();
}

DEV void mod_item(const Params& p, int l, int jb, char* lds) {
  float* sc = (float*)lds;
  float* red = (float*)(lds + 12288);
  const int t = tid();
  for (int i = t; i < 3072; i += 256) {
    const int c = i >> 10, k = i & 1023;
    const float x = (c == 0) ? p.in[I_CCTX][k] : p.in[I_C][(c - 1) * 1024 + k];
    sc[i] = x / (1.0f + __expf(-x));
  }
  __syncthreads();
  const int cg4 = t & 63, ks = t >> 6;
  const float* wp = p.in[I_MODW] + ((size_t)l * 1024 + ks * 256) * 6144 + jb * 256 + cg4 * 4;
  float a00 = 0, a01 = 0, a02 = 0, a03 = 0, a10 = 0, a11 = 0, a12 = 0, a13 = 0, a20 = 0, a21 = 0, a22 = 0, a23 = 0;
#pragma unroll 8
  for (int ii = 0; ii < 256; ++ii) {
    const float4 w = *(const float4*)(wp + (size_t)ii * 6144);
    const int k = ks * 256 + ii;
    const float s0 = sc[k], s1 = sc[1024 + k], s2 = sc[2048 + k];
    a00 += s0 * w.x; a01 += s0 * w.y; a02 += s0 * w.z; a03 += s0 * w.w;
    a10 += s1 * w.x; a11 += s1 * w.y; a12 += s1 * w.z; a13 += s1 * w.w;
    a20 += s2 * w.x; a21 += s2 * w.y; a22 += s2 * w.z; a23 += s2 * w.w;
  }
  float* r0 = red + (ks * 3 + 0) * 256 + cg4 * 4; r0[0] = a00; r0[1] = a01; r0[2] = a02; r0[3] = a03;
  float* r1 = red + (ks * 3 + 1) * 256 + cg4 * 4; r1[0] = a10; r1[1] = a11; r1[2] = a12; r1[3] = a13;
  float* r2 = red + (ks * 3 + 2) * 256 + cg4 * 4; r2[0] = a20; r2[1] = a21; r2[2] = a22; r2[3] = a23;
  __syncthreads();
  float* MOD = (float*)(p.ws + OFF_MOD);
  const float bias = p.in[I_MODB][l * 6144 + jb * 256 + t];
#pragma unroll
  for (int c = 0; c < 3; ++c) {
    float v = bias;
#pragma unroll
    for (int k2 = 0; k2 < 4; ++k2) v += red[(k2 * 3 + c) * 256 + t];
    MOD[(size_t)(l * 3 + c) * 6144 + jb * 256 + t] = v;
  }
  __syncthreads();
}

DEV void hglb_item(const Params& p) {
  const int c = tid();
  float* HGLB = (float*)(p.ws + OFF_HGLB);
  for (int dir = 0; dir < 2; ++dir) {
    float x[4], mx = -1e30f;
    for (int l = 0; l < 4; ++l) { x[l] = p.in[I_HGLB][(dir * 4 + l) * 256 + c]; mx = fmaxf(mx, x[l]); }
    float s = 0;
    for (int l = 0; l < 4; ++l) { x[l] = __expf(x[l] - mx); s += x[l]; }
    float cum = 0; const float s0 = x[0] / s;
    for (int l = 0; l < 4; ++l) { cum += x[l] / s; HGLB[(l * 2 + dir) * 256 + c] = cum - s0; }
  }
}

DEV void phase0(const Params& p, char* lds0) {
  const int hf = half_id(); char* lds = lds0 + hf * 65536;
  const int NT_WIN = 4 * 16 * 58, NT_WOUT = 4 * 16 * 16, NT_W1 = 4 * 16 * 64, NT_W2 = 4 * 64 * 16;
  const int nitems = 98 + NT_WIN + NT_WOUT + NT_W1 + NT_W2 + 4;
  for (int it = blockIdx.x * 2 + hf; it < nitems; it += gridDim.x * 2) {
    if (it < 96) { mod_item(p, it / 24, it % 24, lds); continue; }
    if (it == 96) { hglb_item(p); continue; }
    if (it == 97) continue;
    int j = it - 98;
    if (j < NT_WIN) { const int l = j / 928, r = j % 928;
      transpose_item(p.in[I_WIN] + (size_t)l * D * DIN, (bf16_t*)(p.ws + OFF_WIN) + (size_t)l * DINP * D, D, DIN, r / 58, r % 58, lds); continue; }
    j -= NT_WIN;
    if (j < NT_WOUT) { const int l = j / 256, r = j % 256;
      transpose_item(p.in[I_WOUT] + (size_t)l * D * D, (bf16_t*)(p.ws + OFF_WOUT) + (size_t)l * D * D, D, D, r / 16, r % 16, lds); continue; }
    j -= NT_WOUT;
    if (j < NT_W1) { const int l = j / 1024, r = j % 1024;
      transpose_item(p.in[I_FW1] + (size_t)l * D * FF, (bf16_t*)(p.ws + OFF_W1) + (size_t)l * FF * D, D, FF, r / 64, r % 64, lds); continue; }
    j -= NT_W1;
    if (j < NT_W2) { const int l = j / 1024, r = j % 1024;
      transpose_item(p.in[I_FW2] + (size_t)l * FF * D, (bf16_t*)(p.ws + OFF_W2) + (size_t)l * D * FF, FF, D, r / 16, r % 16, lds); continue; }
    j -= NT_W2;
    {
      uint4* z = (uint4*)((bf16_t*)(p.ws + OFF_WIN) + ((size_t)j * DINP + DIN) * D);
      const int t = tid();
      for (int i = t; i < 128 * D * 2 / 16; i += 256) z[i] = make_uint4(0u, 0u, 0u, 0u);
    }
  }
}

DEV void row_phase(const Params& p, int mode, int l) {
  const int lane = tid() & 63;
  const int nw = gridDim.x * 8;
  const float* MOD = (const float*)(p.ws + OFF_MOD);
  const float* NG = p.in[I_NORMG];
  const float* U = (const float*)(p.ws + OFF_U);
  bf16_t* H = (bf16_t*)(p.ws + OFF_H);
  const bool has_next = !(mode == 2 && l == 3);
  const int ln = (mode == 0) ? 0 : (mode == 1 ? l : l + 1);
  const int gi = (mode == 1) ? 2 : 0, shi = (mode == 1) ? 3 : 0, sci = (mode == 1) ? 4 : 1;
  const float* ga = NG + (size_t)(l * 4 + (mode == 1 ? 1 : 3)) * 1024;
  const float* gb = NG + (size_t)((has_next ? ln : 0) * 4 + gi) * 1024;
  for (int rowa = blockIdx.x * 8 + half_id() * 4 + (tid() >> 6); rowa < MT; rowa += 2 * nw) {
    float4 x[2][4], u[2][4];
    int rows[2]; bool ok[2];
#pragma unroll
    for (int q = 0; q < 2; ++q) {
      rows[q] = rowa + q * nw; ok[q] = rows[q] < MT;
      const int row = ok[q] ? rows[q] : rowa;
      if (mode == 0) {
        const float* src = row < NCTX ? p.in[I_XP] + (size_t)row * D : p.in[I_XS] + (size_t)(row - NCTX) * D;
#pragma unroll
        for (int i = 0; i < 4; ++i) x[q][i] = *(const float4*)(src + i * 256 + lane * 4);
      } else {
#pragma unroll
        for (int i = 0; i < 4; ++i) {
          x[q][i] = *(const float4*)(p.out + (size_t)row * D + i * 256 + lane * 4);
          u[q][i] = *(const float4*)(U + (size_t)row * D + i * 256 + lane * 4);
        }
      }
    }
#pragma unroll
    for (int q = 0; q < 2; ++q) {
      const int row = ok[q] ? rows[q] : rowa;
      const int cond = row < NCTX ? 0 : 1 + ((row - NCTX) >> 10);
      if (mode != 0) {
        float ss = 0;
#pragma unroll
        for (int i = 0; i < 4; ++i) ss += u[q][i].x * u[q][i].x + u[q][i].y * u[q][i].y + u[q][i].z * u[q][i].z + u[q][i].w * u[q][i].w;
        ss = wave_sum(ss);
        const float r = rsqrtf(ss * (1.0f / 1024.0f) + 1e-6f);
        const float* gate = MOD + (size_t)(l * 3 + cond) * 6144 + (mode == 1 ? 2 : 5) * 1024;
#pragma unroll
        for (int i = 0; i < 4; ++i) {
          const float4 g4 = *(const float4*)(gate + i * 256 + lane * 4);
          const float4 a4 = *(const float4*)(ga + i * 256 + lane * 4);
          x[q][i].x += g4.x * (u[q][i].x * r * a4.x); x[q][i].y += g4.y * (u[q][i].y * r * a4.y);
          x[q][i].z += g4.z * (u[q][i].z * r * a4.z); x[q][i].w += g4.w * (u[q][i].w * r * a4.w);
        }
      }
      if (ok[q]) {
#pragma unroll
        for (int i = 0; i < 4; ++i) *(float4*)(p.out + (size_t)row * D + i * 256 + lane * 4) = x[q][i];
      }
      if (has_next) {
        float ss = 0;
#pragma unroll
        for (int i = 0; i < 4; ++i) ss += x[q][i].x * x[q][i].x + x[q][i].y * x[q][i].y + x[q][i].z * x[q][i].z + x[q][i].w * x[q][i].w;
        ss = wave_sum(ss);
        const float r2 = rsqrtf(ss * (1.0f / 1024.0f) + 1e-6f);
        const float* sh = MOD + (size_t)(ln * 3 + cond) * 6144 + shi * 1024;
        const float* sc = MOD + (size_t)(ln * 3 + cond) * 6144 + sci * 1024;
        if (ok[q]) {
#pragma unroll
          for (int i = 0; i < 4; ++i) {
            const float4 g4 = *(const float4*)(gb + i * 256 + lane * 4);
            const float4 s4 = *(const float4*)(sc + i * 256 + lane * 4);
            const float4 h4 = *(const float4*)(sh + i * 256 + lane * 4);
            const float h0 = x[q][i].x * r2 * g4.x * (1.0f + s4.x) + h4.x;
            const float h1 = x[q][i].y * r2 * g4.y * (1.0f + s4.y) + h4.y;
            const float h2 = x[q][i].z * r2 * g4.z * (1.0f + s4.z) + h4.z;
            const float h3 = x[q][i].w * r2 * g4.w * (1.0f + s4.w) + h4.w;
            uint2 o; o.x = pk2(h0, h1); o.y = pk2(h2, h3);
            *(uint2*)(H + (size_t)row * D + i * 256 + lane * 4) = o;
          }
        }
      }
    }
  }
}

namespace pg8 {
#define PG8_LAS __attribute__((address_space(3)))
typedef unsigned short bf16_t;
typedef short bf16x8 __attribute__((ext_vector_type(8)));
typedef float f32x4 __attribute__((ext_vector_type(4)));
typedef unsigned u32x4 __attribute__((ext_vector_type(4)));
constexpr int BM = 256, BK = 64, HALF = 128, HTB = HALF * BK * 2  , STAGE_BYTES = 8 * HTB, NXCD = 8, WGM = 8;

__host__ __device__ __forceinline__ int lds_byte(int r, int c) { const int st = (r >> 4) * 2 + (c >> 5), rr = r & 15, cc = c & 31, ob = rr * 64 + cc * 2; return st * 1024 + (ob ^ (((ob >> 9) & 1) << 5)); }
__host__ __device__ __forceinline__ void stage_rc(int b, int& R, int& C) { const int st = b / 1024, sb = b % 1024, swz = sb ^ (((sb >> 9) & 1) << 5); R = (st >> 1) * 16 + swz / 64; C = (st & 1) * 32 + (swz % 64) / 2; }
__host__ __device__ __forceinline__ int perm32(int rho) { const int n = rho >> 4, i = rho & 15; return 8 * (i >> 2) + 4 * n + (i & 3); }

struct Unit { int pm, pn; };
struct Gemm { const bf16_t* A; const bf16_t* Bt; int M, N, K; };

struct StaticOrder {
    int nM, nN, nwg, G, c;
    __host__ __device__ void init(int M, int N, int G_, int c_) { nM = M / BM; nN = N / BM; nwg = nM * nN; G = G_; c = c_; }
    __host__ __device__ bool next(int i, Unit& u) const {
        const long L = (long)i * G + c; if (L >= nwg) return false;
        int wgid = (int)L; { const int q = nwg / NXCD, r = nwg % NXCD, xcd = wgid % NXCD, off = wgid / NXCD; wgid = (xcd < r ? xcd * (q + 1) : r * (q + 1) + (xcd - r) * q) + off; }
        const int nig = WGM * nN, gid = wgid / nig, fm = gid * WGM, gsz = (nM - fm) < WGM ? (nM - fm) : WGM;
        u.pm = fm + ((wgid % nig) % gsz); u.pn = (wgid % nig) / gsz; return true;
    }
    __device__ __forceinline__ void a_ready(const Unit&) const {}
    __device__ __forceinline__ void done(const Unit&) const {}
};

template <class Epi, class Sched, bool ALIGN_EPI = false, bool SP2 = false>
__device__ __forceinline__ void gemm_phase(PG8_LAS unsigned char* lds, const Gemm g, const Sched& S, const Epi& E) {
    int tid_z; asm volatile("v_mov_b32 %0, 0" : "=v"(tid_z)); const int tid = (int)threadIdx.x + tid_z, wid = __builtin_amdgcn_readfirstlane(tid >> 6), lane = tid & 63, wr = wid >> 2, wc = wid & 3, fr = lane & 15, fq = lane >> 4;
    const int K = g.K, nt = K / BK;
    unsigned voffA[2], voffB[2];
#pragma unroll
    for (int i = 0; i < 2; ++i) { int R, C; stage_rc(tid * 16 + i * 8192, R, C); const int Rb = Epi::PERM ? ((R & ~31) + perm32(R & 31)) : R;
        voffA[i] = (unsigned)(R * K + C) * 2u; voffB[i] = (unsigned)(Rb * K + C) * 2u; }
    const size_t kstep = (size_t)(BK * 2);
    const size_t hstep = (size_t)HALF * K * 2;
    const size_t tstep = 2 * hstep;
    const unsigned ldsw = (unsigned)wid * 1024u;
    const int aoff = lds_byte(wr * 64 + fr, fq * 8), boff = lds_byte(wc * 32 + fr, fq * 8);
#define PG8_SA(b, h) (((b) * 2 + (h)) * HTB)
#define PG8_SB(b, h) ((4 + (b) * 2 + (h)) * HTB)
#define PG8_STAGE(bufoff, gbase, voff) do { _Pragma("unroll") for (int _i = 0; _i < 2; ++_i) \
        __builtin_amdgcn_global_load_lds((const unsigned*)((const char*)(gbase) + (voff)[_i]), (PG8_LAS unsigned*)(lds + (bufoff) + ldsw + _i * 8192), 16, 0, 0); } while (0)
#define PG8_LDA(dst, b, h) do { _Pragma("unroll") for (int m = 0; m < 4; ++m) _Pragma("unroll") for (int k = 0; k < 2; ++k) dst[m][k] = *(const PG8_LAS bf16x8*)(lds + PG8_SA(b, h) + aoff + m * 2048 + k * 1024); } while (0)
#define PG8_LDB(dst, b, h) do { _Pragma("unroll") for (int n = 0; n < 2; ++n) _Pragma("unroll") for (int k = 0; k < 2; ++k) dst[n][k] = *(const PG8_LAS bf16x8*)(lds + PG8_SB(b, h) + boff + n * 2048 + k * 1024); } while (0)
#define PG8_MMA(ai, bj, At, Bt) do { __builtin_amdgcn_s_setprio(1); _Pragma("unroll") for (int m = 0; m < 4; ++m) _Pragma("unroll") for (int n = 0; n < 2; ++n) _Pragma("unroll") for (int k = 0; k < 2; ++k) \
        acc[ai][bj][m][n] = __builtin_amdgcn_mfma_f32_16x16x32_bf16(Bt[n][k], At[m][k], acc[ai][bj][m][n], 0, 0, 0); __builtin_amdgcn_s_setprio(0); } while (0)
#define PG8_WAIT_V(n) asm volatile("s_waitcnt vmcnt(" #n ")" ::: "memory")
#define PG8_WAIT_L(n) asm volatile("s_waitcnt lgkmcnt(" #n ")" ::: "memory")
#define PG8_BAR __builtin_amdgcn_s_barrier()
#define PG8_SCHED __builtin_amdgcn_sched_barrier(0)
    Unit cur, nxt; int ui = 0;
    if (!S.next(0, cur)) return;
    f32x4 acc[2][2][4][2];
#pragma unroll
    for (int a = 0; a < 2; ++a)
#pragma unroll
        for (int b = 0; b < 2; ++b)
#pragma unroll
            for (int m = 0; m < 4; ++m)
#pragma unroll
                for (int n = 0; n < 2; ++n) acc[a][b][m][n] = (f32x4){0.f, 0.f, 0.f, 0.f};
    bf16x8 At[4][2], B0[2][2], B1[2][2];
    const char* cA = (const char*)g.A + (size_t)cur.pm * tstep; const char* cB = (const char*)g.Bt + (size_t)cur.pn * tstep;
    S.a_ready(cur);
    if constexpr (SP2) {
        PG8_STAGE(PG8_SB(0, 0), cB, voffB); PG8_STAGE(PG8_SB(0, 1), cB + hstep, voffB); PG8_STAGE(PG8_SA(0, 0), cA, voffA); PG8_STAGE(PG8_SA(0, 1), cA + hstep, voffA);
        if (wr == 1) PG8_BAR;
        PG8_WAIT_V(2); PG8_BAR;
        PG8_STAGE(PG8_SB(1, 0), cB + kstep, voffB); PG8_STAGE(PG8_SA(1, 0), cA + kstep, voffA); PG8_STAGE(PG8_SB(1, 1), cB + hstep + kstep, voffB);
        PG8_WAIT_V(6); PG8_BAR;
    } else {
        PG8_STAGE(PG8_SB(0, 0), cB, voffB); PG8_STAGE(PG8_SA(0, 0), cA, voffA); PG8_STAGE(PG8_SB(0, 1), cB + hstep, voffB); PG8_STAGE(PG8_SA(0, 1), cA + hstep, voffA);
        if (wr == 1) PG8_BAR;
        PG8_WAIT_V(4); PG8_BAR;
        PG8_STAGE(PG8_SB(1, 0), cB + kstep, voffB); PG8_STAGE(PG8_SA(1, 0), cA + kstep, voffA); PG8_STAGE(PG8_SB(1, 1), cB + hstep + kstep, voffB);
        PG8_WAIT_V(6); PG8_BAR;
    }
    for (;;) {
        const bool has_next = S.next(ui + 1, nxt);
        const char* nA = has_next ? (const char*)g.A + (size_t)nxt.pm * tstep : cA; const char* nB = has_next ? (const char*)g.Bt + (size_t)nxt.pn * tstep : cB;
        for (int t = 0; t < nt; t += 2) {
            const bool last = (t == nt - 2);
            const char* a1 = cA + (size_t)(t + 1) * kstep;
            const char* a2 = last ? nA : cA + (size_t)(t + 2) * kstep; const char* b2 = last ? nB : cB + (size_t)(t + 2) * kstep;
            const char* a3 = a2 + kstep; const char* b3 = b2 + kstep;
            if (last && has_next) S.a_ready(nxt);
            if constexpr (SP2) {
            PG8_LDB(B0, 0, 0); PG8_LDB(B1, 0, 1); PG8_SCHED; PG8_LDA(At, 0, 0); PG8_STAGE(PG8_SA(1, 1), a1 + hstep, voffA);
            PG8_WAIT_V(8); PG8_WAIT_L(0); PG8_BAR; PG8_MMA(0, 0, At, B0); PG8_MMA(0, 1, At, B1); PG8_BAR; PG8_SCHED;
            PG8_LDA(At, 0, 1); PG8_STAGE(PG8_SB(0, 0), b2, voffB); PG8_STAGE(PG8_SB(0, 1), b2 + hstep, voffB); PG8_STAGE(PG8_SA(0, 0), a2, voffA);
            PG8_WAIT_V(8); PG8_WAIT_L(0); PG8_BAR; PG8_MMA(1, 0, At, B0); PG8_MMA(1, 1, At, B1); PG8_BAR; PG8_SCHED;
            PG8_LDB(B0, 1, 0); PG8_LDB(B1, 1, 1); PG8_SCHED; PG8_LDA(At, 1, 0); PG8_STAGE(PG8_SA(0, 1), a2 + hstep, voffA);
            PG8_WAIT_V(8); PG8_WAIT_L(0); PG8_BAR; PG8_MMA(0, 0, At, B0); PG8_MMA(0, 1, At, B1); PG8_BAR; PG8_SCHED;
            PG8_LDA(At, 1, 1); PG8_STAGE(PG8_SB(1, 0), b3, voffB); PG8_STAGE(PG8_SB(1, 1), b3 + hstep, voffB); PG8_STAGE(PG8_SA(1, 0), a3, voffA);
            PG8_WAIT_V(8); PG8_WAIT_L(0); PG8_BAR; PG8_MMA(1, 0, At, B0); PG8_MMA(1, 1, At, B1); PG8_BAR; PG8_SCHED;
            } else {
            PG8_LDB(B0, 0, 0); PG8_SCHED; PG8_LDA(At, 0, 0); PG8_STAGE(PG8_SA(1, 1), a1 + hstep, voffA);
            PG8_WAIT_L(8); PG8_BAR; PG8_WAIT_L(0); PG8_MMA(0, 0, At, B0); PG8_BAR; PG8_SCHED;
            PG8_LDB(B1, 0, 1); PG8_STAGE(PG8_SB(0, 0), b2, voffB);
            PG8_BAR; PG8_WAIT_L(0); PG8_MMA(0, 1, At, B1); PG8_BAR;
            PG8_LDA(At, 0, 1); PG8_STAGE(PG8_SA(0, 0), a2, voffA);
            PG8_BAR; PG8_WAIT_L(0); PG8_MMA(1, 0, At, B0); PG8_BAR; PG8_SCHED;
            PG8_STAGE(PG8_SB(0, 1), b2 + hstep, voffB);
            PG8_WAIT_V(6); PG8_BAR; PG8_MMA(1, 1, At, B1); PG8_BAR;
            PG8_LDB(B0, 1, 0); PG8_SCHED; PG8_LDA(At, 1, 0); PG8_STAGE(PG8_SA(0, 1), a2 + hstep, voffA);
            PG8_WAIT_L(8); PG8_BAR; PG8_WAIT_L(0); PG8_MMA(0, 0, At, B0); PG8_BAR; PG8_SCHED;
            PG8_LDB(B1, 1, 1); PG8_STAGE(PG8_SB(1, 0), b3, voffB);
            PG8_BAR; PG8_WAIT_L(0); PG8_MMA(0, 1, At, B1); PG8_BAR;
            PG8_LDA(At, 1, 1); PG8_STAGE(PG8_SA(1, 0), a3, voffA);
            PG8_BAR; PG8_WAIT_L(0); PG8_MMA(1, 0, At, B0); PG8_BAR; PG8_SCHED;
            PG8_STAGE(PG8_SB(1, 1), b3 + hstep, voffB);
            PG8_WAIT_V(6); PG8_BAR; PG8_MMA(1, 1, At, B1); PG8_BAR;
            }
        }
        if constexpr (ALIGN_EPI) { if (wr == 0) PG8_BAR; }
        if constexpr (!Epi::AFTER_DRAIN) { E(acc, cur, wr, wc, fr, fq); S.done(cur); }
        if (!has_next) break;
#pragma unroll
        for (int a = 0; a < 2; ++a)
#pragma unroll
            for (int b = 0; b < 2; ++b)
#pragma unroll
                for (int m = 0; m < 4; ++m)
#pragma unroll
                    for (int n = 0; n < 2; ++n) acc[a][b][m][n] = (f32x4){0.f, 0.f, 0.f, 0.f};
        cur = nxt; cA = nA; cB = nB; ++ui;
        if constexpr (ALIGN_EPI) { if (wr == 1) PG8_BAR; }
    }
    PG8_WAIT_V(0);
    if constexpr (!ALIGN_EPI) { if (wr == 0) PG8_BAR; }
    PG8_BAR;
    if constexpr (Epi::AFTER_DRAIN) { E.fused(acc, cur, wr, wc, fr, fq, lds, wid, lane); S.done(cur); }
#undef PG8_SA
#undef PG8_SB
#undef PG8_STAGE
#undef PG8_LDA
#undef PG8_LDB
#undef PG8_MMA
#undef PG8_WAIT_V
#undef PG8_WAIT_L
#undef PG8_BAR
#undef PG8_SCHED
}
}

template <int MODE> struct EpiMK {
  static constexpr bool PERM = false, AFTER_DRAIN = false;
  const Params* pp; int l;
  DEV void operator()(const pg8::f32x4 (&acc)[2][2][4][2], const pg8::Unit& u, int wr, int wc, int fr, int fq) const {
    const Params& p = *pp;
#pragma unroll
    for (int ai = 0; ai < 2; ++ai)
#pragma unroll
      for (int m = 0; m < 4; ++m) {
        const int row = u.pm * 256 + ai * 128 + wr * 64 + m * 16 + fr;
#pragma unroll
        for (int bj = 0; bj < 2; ++bj)
#pragma unroll
          for (int n = 0; n < 2; ++n) {
            const int col = u.pn * 256 + bj * 128 + wc * 32 + n * 16 + fq * 4;
            const pg8::f32x4 v = acc[ai][bj][m][n];
            if (MODE == 0) {
              if (col < DIN) {
                uint2 o; o.x = pk2(v[0], v[1]); o.y = pk2(v[2], v[3]);
                *(uint2*)((bf16_t*)(p.ws + OFF_P) + (size_t)row * DIN + col) = o;
                if (row < NCTX) {
                  if (col >= C_NK && col < C_HQ) {
                    const int kv = col >= C_NV;
                    *(pg8::f32x4*)(p.out + O_NAT + (size_t)(((row >> 8) * 4 + l) * 2 + kv) * 65536 + (row & 255) * 256 + (col - (kv ? C_NV : C_NK))) = v;
                  } else if (col >= C_SK) {
                    const int kv = col >= C_SV;
                    *(pg8::f32x4*)(p.out + O_SWA + (size_t)(((row >> 8) * 4 + l) * 2 + kv) * 32768 + (row & 255) * 128 + (col - (kv ? C_SV : C_SK))) = v;
                  }
                }
              }
            } else if (MODE == 1) {
              *(pg8::f32x4*)((float*)(p.ws + OFF_U) + (size_t)row * D + col) = v;
            } else {
              const float r0 = fmaxf(v[0], 0.f), r1 = fmaxf(v[1], 0.f), r2 = fmaxf(v[2], 0.f), r3 = fmaxf(v[3], 0.f);
              uint2 o; o.x = pk2(r0 * r0, r1 * r1); o.y = pk2(r2 * r2, r3 * r3);
              *(uint2*)((bf16_t*)(p.ws + OFF_HID) + (size_t)row * FF + col) = o;
            }
          }
      }
  }
};

template <int MODE>
DEV void gemm_run(const Params& p, int l, const bf16_t* A, const bf16_t* BT, int K, int N, char* lds) {
  pg8::Gemm g{A, BT, MT, N, K};
  pg8::StaticOrder S; S.init(MT, N, (int)gridDim.x, (int)blockIdx.x);
  EpiMK<MODE> E{&p, l};
  pg8::gemm_phase<EpiMK<MODE>, pg8::StaticOrder, true, true>((PG8_LAS unsigned char*)lds, g, S, E);
}

constexpr int TOKT = 20;
DEV void prep_item(const Params& p, int l, int tile, char* lds) {
  const int t = tid(), r0 = tile * TOKT, c = t;
  float* sT = (float*)lds;
  float* swl = sT + 128 * TOKT;
  float* sal = swl + TOKT * 256;
  const bf16_t* P = (const bf16_t*)(p.ws + OFF_P);
  float* PREP = (float*)(p.ws + OFF_PREP);
  float* BON = (float*)(p.ws + OFF_BONUS);
  for (int dir = 0; dir < 2; ++dir) {
    __syncthreads();
#pragma unroll
    for (int i = 0; i < TOKT / 2; ++i) {
      const int e = t + 256 * i, tk = e >> 7, j = e & 127, which = j >> 6, jj = j & 63;
      const int row = r0 + tk, prow = dir ? row + 1 : row - 1;
      const int tis = row < NCTX ? (row & 255) : ((row - NCTX) & 1023), Tm1 = row < NCTX ? 255 : 1023;
      const bool pv = dir ? (tis < Tm1) : (tis > 0);
      const int col = (dir ? C_WHB : C_WHF) + which * 64 + jj;
      const float cur = bf2f(P[(size_t)row * DIN + col]);
      const float prev = pv ? bf2f(P[(size_t)prow * DIN + col]) : 0.f;
      const float mu = p.in[I_MULORA][((l * 2 + dir) * 2 + which) * 64 + jj];
      float val = cur + (prev - cur) * mu;
      if (which == 0) val = tanhf_(val);
      sT[j * TOKT + tk] = val;
    }
    __syncthreads();
    {
      const float* w2p = p.in[I_W2] + (size_t)(l * 2 + dir) * 64 * 256 + c;
      const float* a2p = p.in[I_A2] + (size_t)(l * 2 + dir) * 64 * 256 + c;
      float aw[TOKT], aa[TOKT];
#pragma unroll
      for (int k = 0; k < TOKT; ++k) { aw[k] = 0.f; aa[k] = 0.f; }
#pragma unroll 4
      for (int j = 0; j < 64; ++j) {
        const float w2j = w2p[j * 256], a2j = a2p[j * 256];
#pragma unroll
        for (int k4 = 0; k4 < TOKT / 4; ++k4) {
          const float4 th4 = *(const float4*)(sT + j * TOKT + k4 * 4);
          const float4 ah4 = *(const float4*)(sT + (64 + j) * TOKT + k4 * 4);
          aw[k4 * 4 + 0] += th4.x * w2j; aw[k4 * 4 + 1] += th4.y * w2j; aw[k4 * 4 + 2] += th4.z * w2j; aw[k4 * 4 + 3] += th4.w * w2j;
          aa[k4 * 4 + 0] += ah4.x * a2j; aa[k4 * 4 + 1] += ah4.y * a2j; aa[k4 * 4 + 2] += ah4.z * a2j; aa[k4 * 4 + 3] += ah4.w * a2j;
        }
      }
#pragma unroll
      for (int k = 0; k < TOKT; ++k) { swl[k * 256 + c] = aw[k]; sal[k * 256 + c] = aa[k]; }
    }
    const float w0v = p.in[I_W0][(l * 2 + dir) * 256 + c], a0v = p.in[I_A0][(l * 2 + dir) * 256 + c];
    const float kkv = p.in[I_KK][l * 256 + c], kav = p.in[I_KA][l * 256 + c], rkv = p.in[I_RK][l * 256 + c];
    const float mur = p.in[I_MURKV][((l * 2 + dir) * 3 + 0) * 256 + c], muk = p.in[I_MURKV][((l * 2 + dir) * 3 + 1) * 256 + c],
                muv = p.in[I_MURKV][((l * 2 + dir) * 3 + 2) * 256 + c];
    float* pr = PREP + (size_t)dir * 6 * ARRF;
#pragma unroll 4
    for (int tk = 0; tk < TOKT; ++tk) {
      const int row = r0 + tk, prow = dir ? row + 1 : row - 1;
      const int tis = row < NCTX ? (row & 255) : ((row - NCTX) & 1023), Tm1 = row < NCTX ? 255 : 1023;
      const bool pv = dir ? (tis < Tm1) : (tis > 0);
      const bf16_t* pc = P + (size_t)row * DIN + c;
      const bf16_t* pp = P + (size_t)(pv ? prow : row) * DIN + c;
      const float rc = bf2f(pc[C_R]), kc = bf2f(pc[C_K]), vc = bf2f(pc[C_V]);
      const float rp = pv ? bf2f(pp[C_R]) : 0.f, kp0 = pv ? bf2f(pp[C_K]) : 0.f, vp = pv ? bf2f(pp[C_V]) : 0.f;
      const float rs = rc + (rp - rc) * mur, ks = kc + (kp0 - kc) * muk, vs = vc + (vp - vc) * muv;
      const float wl = w0v + swl[tk * 256 + c], al = a0v + sal[tk * 256 + c];
      const float wv = __expf(-0.6065306597126334f * sigmoidf_(wl));
      const float av = sigmoidf_(al);
      const float kkr = ks * kkv;
      const float n2 = wave_sum(kkr * kkr);
      const float kk = kkr / fmaxf(sqrtf(n2), 1e-12f);
      const float kp = ks * (1.0f + (av - 1.0f) * kav);
      const float bs = wave_sum(rs * kp * rkv);
      const float bon = bs * vs;
      const size_t idx = (size_t)row * 256 + c;
      pr[idx] = rs; pr[ARRF + idx] = wv; pr[2 * ARRF + idx] = kp; pr[3 * ARRF + idx] = vs; pr[4 * ARRF + idx] = kk; pr[5 * ARRF + idx] = kk * av;
      if (dir == 0) BON[idx] = bon; else BON[idx] += bon;
    }
  }
  __syncthreads();
}

DEV void rope_item(const Params& p, int item) {
  bf16_t* P = (bf16_t*)(p.ws + OFF_P);
  const int t = tid();
  for (int e = t; e < 64 * 192; e += 256) {
    const int tk = e / 192, r = e % 192, hs = r >> 5, pi = r & 31;
    const int lt = item * 64 + tk;
    const int tt = lt & 1023;
    const int grow = tt >> 6, gcol = tt & 63;
    const int fi = pi & 15;
    const float pos = (pi < 16) ? (float)grow : (float)gcol;
    const float inv = exp2f(-(float)fi * (13.287712379549449f / 16.0f));
    const float ang = pos * inv;
    const float cs = __cosf(ang), sn = __sinf(ang);
    const int d1 = (pi < 16) ? fi : 32 + fi;
    bf16_t* base = P + (size_t)(NCTX + lt) * DIN + C_SQ + hs * 64;
    const float x1 = bf2f(base[d1]), x2 = bf2f(base[d1 + 16]);
    base[d1] = f2bf(x1 * cs - x2 * sn);
    base[d1 + 16] = f2bf(x2 * cs + x1 * sn);
  }
}

DEV void rwkv_scan(const Params& p, int l, int seq, int head, int dir, int rg, char* lds) {
  const int t = tid(), rl = t >> 4, ks = t & 15;
  const int T = seq < 32 ? 256 : 1024;
  const int row0 = seq < 32 ? seq * 256 : NCTX + (seq - 32) * 1024;
  const float* prep = (const float*)(p.ws + OFF_PREP) + (size_t)dir * 6 * ARRF;
  float* ydir = (float*)(p.ws + OFF_YDIR) + (size_t)dir * ARRF;
  float4* sbuf = (float4*)lds;
  float* vbuf = (float*)(lds + 20480);
  float* ybuf = vbuf + 256;
  float4 S = make_float4(0.f, 0.f, 0.f, 0.f);
  if (seq >= 32) S = *(const float4*)(p.in[I_SRW] + ((((size_t)(seq - 32) * 4 + l) * 2 + dir) * 4 + head) * 4096 + (rg * 16 + rl) * 64 + ks * 4);
  const int nch = T >> 4;
  float4 pre0, pre1, pre2, pre3, pre4; float prev;
  {
    const int s = rl; const int tok = dir ? (T - 1 - s) : s;
    const size_t base = (size_t)(row0 + tok) * 256 + head * 64;
    pre0 = *(const float4*)(prep + base + ks * 4);
    pre1 = *(const float4*)(prep + ARRF + base + ks * 4);
    pre2 = *(const float4*)(prep + 2 * ARRF + base + ks * 4);
    pre3 = *(const float4*)(prep + 4 * ARRF + base + ks * 4);
    pre4 = *(const float4*)(prep + 5 * ARRF + base + ks * 4);
    prev = prep[3 * ARRF + base + rg * 16 + ks];
  }
  for (int c = 0; c < nch; ++c) {
    __syncthreads();
    sbuf[(0 * 16 + rl) * 16 + ks] = pre0; sbuf[(1 * 16 + rl) * 16 + ks] = pre1; sbuf[(2 * 16 + rl) * 16 + ks] = pre2;
    sbuf[(3 * 16 + rl) * 16 + ks] = pre3; sbuf[(4 * 16 + rl) * 16 + ks] = pre4;
    vbuf[rl * 16 + ks] = prev;
    __syncthreads();
    if (c + 1 < nch) {
      const int s = (c + 1) * 16 + rl; const int tok = dir ? (T - 1 - s) : s;
      const size_t base = (size_t)(row0 + tok) * 256 + head * 64;
      pre0 = *(const float4*)(prep + base + ks * 4);
      pre1 = *(const float4*)(prep + ARRF + base + ks * 4);
      pre2 = *(const float4*)(prep + 2 * ARRF + base + ks * 4);
      pre3 = *(const float4*)(prep + 4 * ARRF + base + ks * 4);
      pre4 = *(const float4*)(prep + 5 * ARRF + base + ks * 4);
      prev = prep[3 * ARRF + base + rg * 16 + ks];
    }
#pragma unroll 4
    for (int i = 0; i < 16; ++i) {
      const float4 r = sbuf[(0 * 16 + i) * 16 + ks], wv = sbuf[(1 * 16 + i) * 16 + ks], kv = sbuf[(2 * 16 + i) * 16 + ks],
                   kk = sbuf[(3 * 16 + i) * 16 + ks], ka = sbuf[(4 * 16 + i) * 16 + ks];
      const float v = vbuf[i * 16 + rl];
      float sa = S.x * kk.x + S.y * kk.y + S.z * kk.z + S.w * kk.w;
      sa = -row16_sum(sa);
      S.x = S.x * wv.x + sa * ka.x + v * kv.x;
      S.y = S.y * wv.y + sa * ka.y + v * kv.y;
      S.z = S.z * wv.z + sa * ka.z + v * kv.z;
      S.w = S.w * wv.w + sa * ka.w + v * kv.w;
      float y = S.x * r.x + S.y * r.y + S.z * r.z + S.w * r.w;
      y = row16_sum(y);
      if (ks == 0) ybuf[i * 16 + rl] = y;
    }
    __syncthreads();
    {
      const int s = c * 16 + rl; const int tok = dir ? (T - 1 - s) : s;
      ydir[(size_t)(row0 + tok) * 256 + head * 64 + rg * 16 + ks] = ybuf[rl * 16 + ks];
    }
  }
  if (seq < 32) *(float4*)(p.out + O_RW + ((((size_t)seq * 4 + l) * 2 + dir) * 4 + head) * 4096 + (rg * 16 + rl) * 64 + ks * 4) = S;
  __syncthreads();
}

DEV void hgrn_scan(const Params& p, int l, int seq, int head, int dir, int rg, char* lds) {
  const int t = tid(), rl = t >> 4, ks = t & 15;
  const int T = seq < 32 ? 256 : 1024;
  const int row0 = seq < 32 ? seq * 256 : NCTX + (seq - 32) * 1024;
  const bf16_t* P = (const bf16_t*)(p.ws + OFF_P);
  float* odir = (float*)(p.ws + OFF_HDIR) + (size_t)dir * ARRF;
  float4* sbuf = (float4*)lds;
  float* vbuf = (float*)(lds + 20480);
  float* ybuf = vbuf + 256;
  const float4 lb4 = *(const float4*)((const float*)(p.ws + OFF_HGLB) + (l * 2 + dir) * 256 + head * 64 + ks * 4);
  const int vrow = rg * 16 + rl;
  float4 S = make_float4(0.f, 0.f, 0.f, 0.f);
  if (seq >= 32) {
    const float* sp = p.in[I_SHG] + ((((size_t)(seq - 32) * 4 + l) * 2 + dir) * 4 + head) * 4096;
    S.x = sp[(ks * 4 + 0) * 64 + vrow]; S.y = sp[(ks * 4 + 1) * 64 + vrow]; S.z = sp[(ks * 4 + 2) * 64 + vrow]; S.w = sp[(ks * 4 + 3) * 64 + vrow];
  }
  const int nch = T >> 4;
  const int fcol = (dir ? C_HFB : C_HFF) + head * 64;
  uint2 pq, pf; bf16_t pvv;
  {
    const int s = rl; const int tok = dir ? (T - 1 - s) : s;
    const bf16_t* pr = P + (size_t)(row0 + tok) * DIN;
    pq = *(const uint2*)(pr + C_HQ + head * 64 + ks * 4);
    pf = *(const uint2*)(pr + fcol + ks * 4);
    pvv = pr[C_HI + head * 64 + rg * 16 + ks];
  }
  for (int c = 0; c < nch; ++c) {
    __syncthreads();
    {
      float4 q, f, k;
      float a;
      a = bflo(pq.x); q.x = a * sigmoidf_(a); a = bfhi(pq.x); q.y = a * sigmoidf_(a);
      a = bflo(pq.y); q.z = a * sigmoidf_(a); a = bfhi(pq.y); q.w = a * sigmoidf_(a);
      float sg;
      sg = sigmoidf_(bflo(pf.x)); f.x = lb4.x + (1.f - lb4.x) * sg; k.x = (1.f - lb4.x) * (1.f - sg);
      sg = sigmoidf_(bfhi(pf.x)); f.y = lb4.y + (1.f - lb4.y) * sg; k.y = (1.f - lb4.y) * (1.f - sg);
      sg = sigmoidf_(bflo(pf.y)); f.z = lb4.z + (1.f - lb4.z) * sg; k.z = (1.f - lb4.z) * (1.f - sg);
      sg = sigmoidf_(bfhi(pf.y)); f.w = lb4.w + (1.f - lb4.w) * sg; k.w = (1.f - lb4.w) * (1.f - sg);
      sbuf[(0 * 16 + rl) * 16 + ks] = q; sbuf[(1 * 16 + rl) * 16 + ks] = f; sbuf[(2 * 16 + rl) * 16 + ks] = k;
      vbuf[rl * 16 + ks] = bf2f(pvv);
    }
    __syncthreads();
    if (c + 1 < nch) {
      const int s = (c + 1) * 16 + rl; const int tok = dir ? (T - 1 - s) : s;
      const bf16_t* pr = P + (size_t)(row0 + tok) * DIN;
      pq = *(const uint2*)(pr + C_HQ + head * 64 + ks * 4);
      pf = *(const uint2*)(pr + fcol + ks * 4);
      pvv = pr[C_HI + head * 64 + rg * 16 + ks];
    }
#pragma unroll 4
    for (int i = 0; i < 16; ++i) {
      const float4 q = sbuf[(0 * 16 + i) * 16 + ks], f = sbuf[(1 * 16 + i) * 16 + ks], k = sbuf[(2 * 16 + i) * 16 + ks];
      const float v = vbuf[i * 16 + rl];
      S.x = S.x * f.x + k.x * v; S.y = S.y * f.y + k.y * v; S.z = S.z * f.z + k.z * v; S.w = S.w * f.w + k.w * v;
      float y = S.x * q.x + S.y * q.y + S.z * q.z + S.w * q.w;
      y = row16_sum(y);
      if (ks == 0) ybuf[i * 16 + rl] = y;
    }
    __syncthreads();
    {
      const int s = c * 16 + rl; const int tok = dir ? (T - 1 - s) : s;
      odir[(size_t)(row0 + tok) * 256 + head * 64 + rg * 16 + ks] = ybuf[rl * 16 + ks];
    }
  }
  if (seq < 32) {
    float* sp = p.out + O_HG + ((((size_t)seq * 4 + l) * 2 + dir) * 4 + head) * 4096;
    sp[(ks * 4 + 0) * 64 + vrow] = S.x; sp[(ks * 4 + 1) * 64 + vrow] = S.y; sp[(ks * 4 + 2) * 64 + vrow] = S.z; sp[(ks * 4 + 3) * 64 + vrow] = S.w;
  }
  __syncthreads();
}

template <int MODE>
DEV void attn_item(const Params& p, int l, int item, char* lds) {
  const int t = tid(), lane = t & 63, w = t >> 6, q = lane & 31, hh = lane >> 5;
  const bf16_t* P = (const bf16_t*)(p.ws + OFF_P);
  bf16_t* Y = (bf16_t*)(p.ws + OFF_YMIX);
  char* sK = lds;
  char* sV = lds + 8192;
  float* sBias = (float*)(lds + 8192 + 8704);
  int head, qrow, qcol, kcol, vcol, ocol, nloc, nt, rowbaseP;
  int qr = 0, qc = 0, rlo = 0, qpos = 0, lo = 0, rsq = 0, wsq = 0;
  float sink = 0.f;
  const float* cache = nullptr; int cH = 1, cHead = 0;
  if (MODE == 0 || MODE == 1) {
    const int b = item >> 3; head = (item >> 1) & 3; const int half = item & 1;
    rowbaseP = b * 256; qrow = rowbaseP + half * 128 + w * 32 + q; nloc = 4; nt = 4;
  } else {
    const int b = item >> 5; head = (item >> 3) & 3; const int sub = item & 7;
    rowbaseP = NCTX + b * 1024;
    if (MODE == 2) {
      qr = 2 * sub + (w >> 1); qc = (w & 1) * 32 + q; qrow = rowbaseP + qr * 64 + qc;
      rlo = clampi(2 * sub - 4, 0, 8); const int rhi = clampi(2 * sub - 3, 0, 8) + 7; nloc = rhi - rlo + 1; nt = nloc + 4;
      rsq = clampi(qr - 4, 0, 8); wsq = clampi(qc - 8, 0, 48);
      cache = p.in[I_CNAT] + (size_t)((b * 4 + l) * 2) * 256 * 256; cH = 4; cHead = head;
      for (int i = t; i < 465; i += 256) sBias[i] = p.in[I_RPB][(size_t)(l * 4 + head) * 465 + i];
    } else {
      qpos = sub * 128 + w * 32 + q; qrow = rowbaseP + qpos;
      lo = (sub - 1) * 128;
      nloc = 6; nt = nloc + 4;
      cache = p.in[I_CSWA] + (size_t)((b * 4 + l) * 2) * 256 * 128; cH = 2; cHead = head >> 1;
    }
  }
  if (MODE == 0 || MODE == 2) { qcol = C_NQ + head * 64; kcol = C_NK + head * 64; vcol = C_NV + head * 64; ocol = 256 + head * 64; }
  else { qcol = C_SQ + head * 64; kcol = C_SK + (head >> 1) * 64; vcol = C_SV + (head >> 1) * 64; ocol = 768 + head * 64; sink = p.in[I_SINK][l * 4 + head]; }

  bf16x8 bq[4];
#pragma unroll
  for (int s = 0; s < 4; ++s) bq[s] = *(const bf16x8*)(P + (size_t)qrow * DIN + qcol + 16 * s + 8 * hh);
  f32x16 oacc[2];
#pragma unroll
  for (int r = 0; r < 16; ++r) { oacc[0][r] = 0.f; oacc[1][r] = 0.f; }
  float m_run = -1e30f, l_run = 0.f;
  const int key = t >> 2, dq = t & 3;
  const int kswz = (key >> 1) & 7;
  for (int j = 0; j < nt; ++j) {
    uint4 kr[2], vr[2];
    const bool isP = j < nloc;
    int keybase = 0;
    if (isP) {
      if (MODE == 0 || MODE == 1) keybase = rowbaseP + j * 64;
      else if (MODE == 2) keybase = rowbaseP + (rlo + j) * 64;
      else keybase = rowbaseP + lo + j * 64;
      int krow = keybase + key;
      if (MODE == 3) krow = rowbaseP + clampi(lo + j * 64 + key, 0, 1023);
      const bf16_t* kp = P + (size_t)krow * DIN + kcol + dq * 16;
      const bf16_t* vp = P + (size_t)krow * DIN + vcol + dq * 16;
      kr[0] = *(const uint4*)kp; kr[1] = *(const uint4*)(kp + 8);
      vr[0] = *(const uint4*)vp; vr[1] = *(const uint4*)(vp + 8);
    } else {
      const int ct = (j - nloc) * 64 + key;
      const float* kp = cache + ((size_t)ct * cH + cHead) * 64 + dq * 16;
      const float* vp = kp + (size_t)256 * cH * 64;
      const float4 k0 = *(const float4*)kp, k1 = *(const float4*)(kp + 4), k2 = *(const float4*)(kp + 8), k3 = *(const float4*)(kp + 12);
      const float4 v0 = *(const float4*)vp, v1 = *(const float4*)(vp + 4), v2 = *(const float4*)(vp + 8), v3 = *(const float4*)(vp + 12);
      kr[0].x = pk2(k0.x, k0.y); kr[0].y = pk2(k0.z, k0.w); kr[0].z = pk2(k1.x, k1.y); kr[0].w = pk2(k1.z, k1.w);
      kr[1].x = pk2(k2.x, k2.y); kr[1].y = pk2(k2.z, k2.w); kr[1].z = pk2(k3.x, k3.y); kr[1].w = pk2(k3.z, k3.w);
      vr[0].x = pk2(v0.x, v0.y); vr[0].y = pk2(v0.z, v0.w); vr[0].z = pk2(v1.x, v1.y); vr[0].w = pk2(v1.z, v1.w);
      vr[1].x = pk2(v2.x, v2.y); vr[1].y = pk2(v2.z, v2.w); vr[1].z = pk2(v3.x, v3.y); vr[1].w = pk2(v3.z, v3.w);
    }
    __syncthreads();
    *(uint4*)(sK + key * 128 + (((dq * 2 + 0) ^ kswz) << 4)) = kr[0];
    *(uint4*)(sK + key * 128 + (((dq * 2 + 1) ^ kswz) << 4)) = kr[1];
    {
      bf16_t* vt = (bf16_t*)sV;
      const unsigned vv[8] = {vr[0].x, vr[0].y, vr[0].z, vr[0].w, vr[1].x, vr[1].y, vr[1].z, vr[1].w};
#pragma unroll
      for (int e = 0; e < 8; ++e) {
        vt[(dq * 16 + 2 * e) * 68 + key] = (bf16_t)(vv[e] & 0xffffu);
        vt[(dq * 16 + 2 * e + 1) * 68 + key] = (bf16_t)(vv[e] >> 16);
      }
    }
    __syncthreads();
    f32x16 sacc[2];
#pragma unroll
    for (int r = 0; r < 16; ++r) { sacc[0][r] = 0.f; sacc[1][r] = 0.f; }
    const int qswz = (q >> 1) & 7;
#pragma unroll
    for (int s = 0; s < 4; ++s) {
      const int co = (((s * 2 + hh) ^ qswz) << 4);
      const bf16x8 a0 = *(const bf16x8*)(sK + q * 128 + co);
      const bf16x8 a1 = *(const bf16x8*)(sK + (32 + q) * 128 + co);
      sacc[0] = MFMA32(a0, bq[s], sacc[0]);
      sacc[1] = MFMA32(a1, bq[s], sacc[1]);
    }
    float mx = -1e30f;
#pragma unroll
    for (int sub = 0; sub < 2; ++sub)
#pragma unroll
      for (int r = 0; r < 16; ++r) {
        const int kidx = sub * 32 + (r & 3) + 8 * (r >> 2) + 4 * hh;
        float v = sacc[sub][r] * 0.125f;
        bool ok = true;
        if (MODE == 2 && isP) {
          const int kr_ = rlo + j, kc_ = kidx;
          ok = (kr_ >= rsq) && (kr_ < rsq + 8) && (kc_ >= wsq) && (kc_ < wsq + 16);
          const int bi = ok ? ((kr_ - qr + 7) * 31 + (kc_ - qc + 15)) : 0;
          v += sBias[bi];
        }
        if (MODE == 3 && isP) {
          const int kpos = lo + j * 64 + kidx, dlt = kpos - qpos;
          ok = (dlt <= 128) && (dlt >= -128) && (kpos >= 0) && (kpos < 1024);
        }
        v = ok ? v : -1e30f;
        sacc[sub][r] = v;
        mx = fmaxf(mx, v);
      }
    mx = fmaxf(mx, __shfl_xor(mx, 32));
    const float m_new = fmaxf(m_run, mx);
    const float alpha = __expf(m_run - m_new);
    float rsum = 0.f;
#pragma unroll
    for (int sub = 0; sub < 2; ++sub)
#pragma unroll
      for (int r = 0; r < 16; ++r) {
        const float v = sacc[sub][r];
        const float pv = (v > -1e29f) ? __expf(v - m_new) : 0.f;
        sacc[sub][r] = pv; rsum += pv;
      }
    rsum += __shfl_xor(rsum, 32);
    l_run = l_run * alpha + rsum; m_run = m_new;
#pragma unroll
    for (int r = 0; r < 16; ++r) { oacc[0][r] *= alpha; oacc[1][r] *= alpha; }
#pragma unroll
    for (int k4 = 0; k4 < 4; ++k4) {
      const int sub = k4 >> 1, s2 = k4 & 1;
      uint4 pbu;
      pbu.x = pk2(sacc[sub][8 * s2 + 0], sacc[sub][8 * s2 + 1]); pbu.y = pk2(sacc[sub][8 * s2 + 2], sacc[sub][8 * s2 + 3]);
      pbu.z = pk2(sacc[sub][8 * s2 + 4], sacc[sub][8 * s2 + 5]); pbu.w = pk2(sacc[sub][8 * s2 + 6], sacc[sub][8 * s2 + 7]);
      const bf16x8 pb = __builtin_bit_cast(bf16x8, pbu);
#pragma unroll
      for (int dt = 0; dt < 2; ++dt) {
        const char* vp = sV + (dt * 32 + q) * 136 + (16 * k4 + 4 * hh) * 2;
        const uint2 lo8 = *(const uint2*)vp, hi8 = *(const uint2*)(vp + 16);
        uint4 avu; avu.x = lo8.x; avu.y = lo8.y; avu.z = hi8.x; avu.w = hi8.y;
        oacc[dt] = MFMA32(__builtin_bit_cast(bf16x8, avu), pb, oacc[dt]);
      }
    }
  }
  float scale;
  if (MODE == 1 || MODE == 3) {
    const float m_f = fmaxf(m_run, sink);
    const float e = __expf(m_run - m_f);
    scale = e / (l_run * e + __expf(sink - m_f));
  } else scale = 1.0f / l_run;
#pragma unroll
  for (int dt = 0; dt < 2; ++dt)
#pragma unroll
    for (int g4 = 0; g4 < 4; ++g4) {
      const int d = dt * 32 + 8 * g4 + 4 * hh;
      uint2 o; o.x = pk2(oacc[dt][4 * g4] * scale, oacc[dt][4 * g4 + 1] * scale); o.y = pk2(oacc[dt][4 * g4 + 2] * scale, oacc[dt][4 * g4 + 3] * scale);
      *(uint2*)(Y + (size_t)qrow * D + ocol + d) = o;
    }
  __syncthreads();
}

DEV void post_item(const Params& p, int l, int tile, char* lds) {
  const int t = tid(), r0 = tile * TOKT, c = t;
  float* sT = (float*)lds;
  float* sgo = sT + 128 * TOKT;
  const bf16_t* P = (const bf16_t*)(p.ws + OFF_P);
  bf16_t* Y = (bf16_t*)(p.ws + OFF_YMIX);
  const float* Y0 = (const float*)(p.ws + OFF_YDIR); const float* Y1 = Y0 + ARRF;
  const float* H0 = (const float*)(p.ws + OFF_HDIR); const float* H1 = H0 + ARRF;
  const float* BON = (const float*)(p.ws + OFF_BONUS);
  __syncthreads();
#pragma unroll
  for (int i = 0; i < TOKT / 2; ++i) {
    const int e = t + 256 * i, tk = e >> 7, j = e & 127;
    sT[j * TOKT + tk] = sigmoidf_(bf2f(P[(size_t)(r0 + tk) * DIN + C_GH + j]));
  }
  __syncthreads();
  {
    const float* g2p = p.in[I_G2] + (size_t)l * 128 * 256 + c;
    float ag[TOKT];
#pragma unroll
    for (int k = 0; k < TOKT; ++k) ag[k] = 0.f;
#pragma unroll 4
    for (int j = 0; j < 128; ++j) {
      const float gj = g2p[j * 256];
#pragma unroll
      for (int k4 = 0; k4 < TOKT / 4; ++k4) {
        const float4 s4 = *(const float4*)(sT + j * TOKT + k4 * 4);
        ag[k4 * 4 + 0] += s4.x * gj; ag[k4 * 4 + 1] += s4.y * gj; ag[k4 * 4 + 2] += s4.z * gj; ag[k4 * 4 + 3] += s4.w * gj;
      }
    }
#pragma unroll
    for (int k = 0; k < TOKT; ++k) sgo[k * 256 + c] = ag[k];
  }
  const float lnw = p.in[I_LNW][l * 256 + c], lnb = p.in[I_LNB][l * 256 + c], hgn = p.in[I_HGN][l * 256 + c];
#pragma unroll 4
  for (int tk = 0; tk < TOKT; ++tk) {
    const int row = r0 + tk;
    const size_t idx = (size_t)row * 256 + c;
    const float y = Y0[idx] + Y1[idx];
    const float mu = wave_sum(y) * (1.0f / 64.0f);
    const float dy = y - mu;
    const float var = wave_sum(dy * dy) * (1.0f / 64.0f);
    const float yn = dy * rsqrtf(var + 64e-5f) * lnw + lnb + BON[idx];
    const float g = sgo[tk * 256 + c];
    Y[(size_t)row * D + c] = f2bf(yn * g);
    const float o = H0[idx] + H1[idx];
    const float ms = wave_sum(o * o) * (1.0f / 64.0f);
    const float gt = sigmoidf_(bf2f(P[(size_t)row * DIN + C_HG + c]));
    Y[(size_t)row * D + 512 + c] = f2bf(o * rsqrtf(ms + 1e-6f) * hgn * gt);
  }
  __syncthreads();
}

DEV void mixer_phase(const Params& p, int l, char* lds0) {
  const int hf = half_id(); char* lds = lds0 + hf * 65536;
  const int nitems = 256 + 2048 + 512;
  for (int it = blockIdx.x * 2 + hf; it < nitems; it += gridDim.x * 2) {
    int kind, idx;
    if (it < 64) { kind = 0; idx = 1024 + it; }
    else if (it < 128) { kind = 1; idx = 1024 + it - 64; }
    else if (it < 192) { kind = 5; idx = it - 128; }
    else if (it < 256) { kind = 4; idx = it - 192; }
    else if (it < 1280) { kind = 0; idx = it - 256; }
    else if (it < 2304) { kind = 1; idx = it - 1280; }
    else if (it < 2560) { kind = 2; idx = it - 2304; }
    else { kind = 3; idx = it - 2560; }
    if (kind < 2) {
      const int seq = idx >> 5, rem = idx & 31;
      if (kind == 0) rwkv_scan(p, l, seq, rem >> 3, (rem >> 2) & 1, rem & 3, lds);
      else hgrn_scan(p, l, seq, rem >> 3, (rem >> 2) & 1, rem & 3, lds);
    } else if (kind == 2) attn_item<0>(p, l, idx, lds);
    else if (kind == 3) attn_item<1>(p, l, idx, lds);
    else if (kind == 4) attn_item<2>(p, l, idx, lds);
    else attn_item<3>(p, l, idx, lds);
  }
}

DEV void run_phase(const Params& p, int ph, char* lds, bool rerun) {
  if (ph == 0) { phase0(p, lds); return; }
  if (ph == 1) { row_phase(p, 0, 0); return; }
  const int l = (ph - 2) / 9, s = (ph - 2) % 9;
  const bf16_t* H = (const bf16_t*)(p.ws + OFF_H);
  const int hf = half_id(); char* ldsh = lds + hf * 65536;
  switch (s) {
    case 0: gemm_run<0>(p, l, H, (const bf16_t*)(p.ws + OFF_WIN) + (size_t)l * DINP * D, D, DINP, lds); break;
    case 1:
      for (int it = blockIdx.x * 2 + hf; it < 512 + 32; it += gridDim.x * 2) { if (it < 512) prep_item(p, l, it, ldsh); else if (!rerun) rope_item(p, it - 512); }
      break;
    case 2: mixer_phase(p, l, lds); break;
    case 3: for (int it = blockIdx.x * 2 + hf; it < 512; it += gridDim.x * 2) post_item(p, l, it, ldsh); break;
    case 4: gemm_run<1>(p, l, (const bf16_t*)(p.ws + OFF_YMIX), (const bf16_t*)(p.ws + OFF_WOUT) + (size_t)l * D * D, D, D, lds); break;
    case 5: row_phase(p, 1, l); break;
    case 6: gemm_run<2>(p, l, H, (const bf16_t*)(p.ws + OFF_W1) + (size_t)l * FF * D, D, FF, lds); break;
    case 7: gemm_run<1>(p, l, (const bf16_t*)(p.ws + OFF_HID), (const bf16_t*)(p.ws + OFF_W2) + (size_t)l * D * FF, FF, D, lds); break;
    case 8: row_phase(p, 2, l); break;
  }
}

#define XB_TMO      128
#define XB_XCNT(j)  (256  + 64 * (j))
#define XB_XSUB(j)  (1280 + 64 * (j))
#define XB_XGEN(j)  (2304 + 64 * (j))
#define XB_TOP      3328
#define XB_TOPGEN   3392
#define XCD_BAR_WORDS 3456
#define XB_SPIN_CAP (1u << 18)
#define LAS __attribute__((address_space(3)))
DEV unsigned xb_ld(unsigned* p) { return __hip_atomic_load(p, __ATOMIC_RELAXED, __HIP_MEMORY_SCOPE_AGENT); }
DEV unsigned xb_add(unsigned* p, unsigned v) { return __hip_atomic_fetch_add(p, v, __ATOMIC_RELAXED, __HIP_MEMORY_SCOPE_AGENT); }
DEV unsigned xb_xcc_id() { return (unsigned)__builtin_amdgcn_s_getreg((3 << 11) | 20) & 0xFu; }
#define XB_SPIN(cond, bar) do { unsigned _sp = 0; while (cond) { __builtin_amdgcn_s_sleep(1); \
    if ((++_sp & 255u) == 0u) { if (xb_ld(&(bar)[XB_TMO])) break; if (_sp > XB_SPIN_CAP) { atomicAdd(&(bar)[XB_TMO], 1u); break; } } } } while (0)
struct XcdBarrier { unsigned* bar; unsigned x; volatile LAS unsigned* st; };
DEV XcdBarrier xcd_barrier_post(unsigned* bar, volatile LAS unsigned* st) {
  XcdBarrier b; b.bar = bar; b.x = xb_xcc_id(); b.st = st;
  if (threadIdx.x == 0) (void)xb_add(&bar[XB_XCNT(b.x)], 1u);
  return b;
}
DEV void xcd_barrier_complete(unsigned* bar, unsigned x, unsigned& nloc, unsigned& nx) {
  const unsigned G = gridDim.x * gridDim.y * gridDim.z;
  unsigned sum, cnt, mine, sp = 0u;
  for (;;) {
    sum = 0u; cnt = 0u; mine = 0u;
#pragma unroll
    for (unsigned j = 0; j < 16; ++j) { const unsigned c = xb_ld(&bar[XB_XCNT(j)]); sum += c; cnt += (c > 0u) ? 1u : 0u; mine = (j == x) ? c : mine; }
    if (sum == G) break;
    __builtin_amdgcn_s_sleep(1);
    if ((++sp & 255u) == 0u) { if (xb_ld(&bar[XB_TMO])) break; if (sp > XB_SPIN_CAP) { atomicAdd(&bar[XB_TMO], 1u); break; } }
  }
  nloc = mine > 0u ? mine : 1u; nx = cnt > 0u ? cnt : 1u;
}
DEV void xcd_barrier(const XcdBarrier& b) {
  asm volatile("s_waitcnt vmcnt(0)" ::: "memory");
  __syncthreads();
  if (threadIdx.x == 0) {
    unsigned* bar = b.bar;
    __builtin_amdgcn_s_waitcnt(0);
    unsigned nloc = b.st[0], nx = b.st[1];
    if (nloc == 0u) { xcd_barrier_complete(bar, b.x, nloc, nx); b.st[0] = nloc; b.st[1] = nx; }
    const unsigned old = xb_add(&bar[XB_XSUB(b.x)], 1u);
    const unsigned gen = old / nloc;
    if (old + 1u == (gen + 1u) * nloc) {
      __builtin_amdgcn_fence(__ATOMIC_RELEASE, "agent");
      asm volatile("s_waitcnt vmcnt(0)" ::: "memory");
      const unsigned og = xb_add(&bar[XB_TOP], 1u);
      const unsigned tg = og / nx;
      if (og + 1u == (tg + 1u) * nx) xb_add(&bar[XB_TOPGEN], 1u);
      else XB_SPIN(xb_ld(&bar[XB_TOPGEN]) == tg, bar);
      __builtin_amdgcn_fence(__ATOMIC_ACQUIRE, "agent");
      xb_add(&bar[XB_XGEN(b.x)], 1u);
      asm volatile("s_waitcnt vmcnt(0)" ::: "memory");
    } else {
      XB_SPIN(xb_ld(&bar[XB_XGEN(b.x)]) == gen, bar);
      __builtin_amdgcn_fence(__ATOMIC_ACQUIRE, "agent");
      asm volatile("s_waitcnt vmcnt(0)" ::: "memory");
    }
  }
  __syncthreads();
}

DEV int phase_kind(int ph) {
  if (ph == 0) return 0;
  if (ph == 1) return 1;
  const int s = (ph - 2) % 9;
  return s == 0 ? 2 : s == 1 ? 3 : s == 2 ? 4 : s == 3 ? 5 : s == 4 ? 6 : s == 5 ? 1 : s == 6 ? 7 : s == 7 ? 8 : 1;
}

constexpr int LDS_BYTES = 131072 + 64;

__global__ void __launch_bounds__(512, 2) mega(Params p, int ph_lo, int ph_hi) {
  extern __shared__ __attribute__((aligned(16))) unsigned char smem[];
  char* lds = (char*)smem;
  volatile LAS unsigned* st = (volatile LAS unsigned*)((LAS unsigned char*)smem + 131072);
  if (threadIdx.x == 0) { st[0] = 0u; st[1] = 0u; }
  __syncthreads();
  XcdBarrier xb = xcd_barrier_post((unsigned*)(p.ws + OFF_BAR), st);
  if (ph_hi < 0) cg::this_grid().sync();
  for (int ph = ph_lo; ph < ph_hi; ++ph) {
    run_phase(p, ph, lds, false);
    if (PROBE_KIND >= 0 && (PROBE_KIND == 9 || phase_kind(ph) == PROBE_KIND)) {
      xcd_barrier(xb);
      if (PROBE_KIND != 9) run_phase(p, ph, lds, true);
    }
    if (ph + 1 < ph_hi) xcd_barrier(xb);
  }
}

extern "C" void kernel_launch(void* const* d_in, const int* in_sizes, int n_in, void* d_out, int out_size, void* d_ws, size_t ws_size,
                              hipStream_t stream) {
  static int grid_blocks = 0;
  if (!grid_blocks) {
    int dev = 0, cus = 0, per_cu = 0;
    (void)hipGetDevice(&dev);
    (void)hipDeviceGetAttribute(&cus, hipDeviceAttributeMultiprocessorCount, dev);
    if (hipFuncSetAttribute((const void*)mega, hipFuncAttributeMaxDynamicSharedMemorySize, LDS_BYTES) != hipSuccess) fprintf(stderr, "hipFuncSetAttribute failed\n");
    (void)hipOccupancyMaxActiveBlocksPerMultiprocessor(&per_cu, mega, 512, LDS_BYTES);
    if (per_cu < 1) fprintf(stderr, "occupancy query reports %d blocks per CU\n", per_cu);
    (void)hipGetLastError();
    grid_blocks = cus;
  }
  if (ws_size < WS_TOTAL) { fprintf(stderr, "workspace too small: %zu < %zu\n", ws_size, (size_t)WS_TOTAL); return; }
  Params p{};
  for (int i = 0; i < 31; ++i) p.in[i] = (const float*)d_in[i];
  p.out = (float*)d_out;
  p.ws = (char*)d_ws;
  (void)hipMemsetAsync((char*)d_ws + OFF_BAR, 0, 16384, stream);
  int lo = 0, hi = NPH;
  void* args[] = {&p, &lo, &hi};
  hipError_t e = hipLaunchCooperativeKernel((void*)mega, dim3(grid_blocks), dim3(512), args, LDS_BYTES, stream);
  if (e != hipSuccess) fprintf(stderr, "cooperative launch failed: %s (grid %d)\n", hipGetErrorString(e), grid_blocks);
}
```

```cpp
#include <hip/hip_runtime.h>
#include <hip/hip_cooperative_groups.h>
#include <cstdio>
#include <cstdint>
namespace cg = cooperative_groups;

#ifndef ONE_LAUNCH
#define ONE_LAUNCH 1
#endif
#define PROBE_KIND -1

#define DEV __device__ __forceinline__
#define LAS __attribute__((address_space(3)))
typedef unsigned short bf16_t;
typedef short bf16x8 __attribute__((ext_vector_type(8)));
typedef float f32x16 __attribute__((ext_vector_type(16)));
typedef __bf16 bf2_t __attribute__((ext_vector_type(2)));
typedef float f2_t __attribute__((ext_vector_type(2)));

constexpr int D = 1024, DIN = 3712, FF = 4096, NCTX = 8192, MT = 10240;
constexpr int NPH = 38;
constexpr int DINP = 3840;
constexpr int C_R = 0, C_K = 256, C_V = 512, C_GH = 768, C_WHF = 896, C_WHB = 1024;
constexpr int C_NQ = 1152, C_NK = 1408, C_NV = 1664;
constexpr int C_HQ = 1920, C_HI = 2176, C_HG = 2432, C_HFF = 2688, C_HFB = 2944;
constexpr int C_SQ = 3200, C_SK = 3456, C_SV = 3584;
constexpr size_t O_NAT = 10485760, O_SWA = 27262976, O_RW = 35651584, O_HG = 39845888;
constexpr size_t ARRF = (size_t)MT * 256;
constexpr size_t ARR = ARRF * 4;
constexpr size_t OFF_WIN = 0;
constexpr size_t OFF_WOUT = OFF_WIN + (size_t)4 * DINP * D * 2;
constexpr size_t OFF_W1 = OFF_WOUT + (size_t)4 * D * D * 2;
constexpr size_t OFF_W2 = OFF_W1 + (size_t)4 * FF * D * 2;
constexpr size_t OFF_MOD = OFF_W2 + (size_t)4 * FF * D * 2;
constexpr size_t OFF_HGLB = OFF_MOD + (size_t)4 * 3 * 6144 * 4;
constexpr size_t OFF_P = OFF_HGLB + 8192;
constexpr size_t OFF_R1 = OFF_P + (size_t)MT * DIN * 2;
constexpr size_t OFF_H = OFF_R1;
constexpr size_t OFF_HID = OFF_H + (size_t)MT * D * 2;
constexpr size_t OFF_U = OFF_HID + (size_t)MT * FF * 2;
constexpr size_t OFF_PREP = OFF_R1;
constexpr size_t OFF_YDIR = OFF_PREP + 12 * ARR;
constexpr size_t OFF_BONUS = OFF_R1 + 14 * ARR;
constexpr size_t OFF_HDIR = OFF_BONUS + ARR;
constexpr size_t OFF_YMIX = OFF_HDIR + 2 * ARR;
constexpr size_t OFF_BAR = OFF_YMIX + (size_t)MT * D * 2;
constexpr size_t WS_TOTAL = OFF_BAR + 16384;
static_assert(OFF_U + (size_t)MT * D * 4 == OFF_BONUS, "R1 layout");

struct Params {
  const float* in[31];
  float* out;
  char* ws;
};
enum { I_XP = 0, I_XS, I_CNAT, I_CSWA, I_SRW, I_SHG, I_C, I_CCTX, I_NORMG, I_MODW, I_MODB, I_WIN, I_WOUT, I_MURKV, I_MULORA,
       I_W0, I_W2, I_A0, I_A2, I_G2, I_KK, I_KA, I_RK, I_LNW, I_LNB, I_RPB, I_HGLB, I_HGN, I_SINK, I_FW1, I_FW2 };

DEV bf16_t f2bf(float f) { unsigned u = __float_as_uint(f); u += 0x7fffu + ((u >> 16) & 1u); return (bf16_t)(u >> 16); }
DEV float bf2f(bf16_t h) { return __uint_as_float(((unsigned)h) << 16); }
DEV unsigned pk2(float a, float b) { f2_t v = {a, b}; bf2_t r = __builtin_convertvector(v, bf2_t); return __builtin_bit_cast(unsigned, r); }
DEV float bflo(unsigned u) { return __uint_as_float(u << 16); }
DEV float bfhi(unsigned u) { return __uint_as_float(u & 0xffff0000u); }
DEV float sigmoidf_(float x) { return 1.0f / (1.0f + __expf(-x)); }
DEV float tanhf_(float x) { return 1.0f - 2.0f / (1.0f + __expf(2.0f * x)); }
template <int CTRL> DEV float dppf(float x) { return __int_as_float(__builtin_amdgcn_update_dpp(0, __float_as_int(x), CTRL, 0xF, 0xF, false)); }
DEV float row16_sum(float x) { x += dppf<0xB1>(x); x += dppf<0x4E>(x); x += dppf<0x141>(x); x += dppf<0x140>(x); return x; }
DEV float wave_sum(float x) { x = row16_sum(x); x += __shfl_xor(x, 16); x += __shfl_xor(x, 32); return x; }
DEV int clampi(int v, int lo, int hi) { return v < lo ? lo : (v > hi ? hi : v); }
#define MFMA32(a, b, c) __builtin_amdgcn_mfma_f32_32x32x16_bf16((a), (b), (c), 0, 0, 0)

DEV int tid() { int z; asm volatile("v_mov_b32 %0, 0" : "=v"(z)); return (int)(threadIdx.x & 255u) + z; }
DEV int half_id() { return __builtin_amdgcn_readfirstlane((int)(threadIdx.x >> 8)); }
DEV void transpose_item(const float* W, bf16_t* WT, int K, int N, int kt, int nt, char* lds) {
  bf16_t* s = (bf16_t*)lds;
  const int t = tid();
#pragma unroll
  for (int i = 0; i < 4; ++i) {
    const int k = (t >> 4) + 16 * i, n4 = (t & 15) * 4;
    const float4 v = *(const float4*)(W + (size_t)(kt * 64 + k) * N + nt * 64 + n4);
    s[(n4 + 0) * 72 + k] = f2bf(v.x); s[(n4 + 1) * 72 + k] = f2bf(v.y);
    s[(n4 + 2) * 72 + k] = f2bf(v.z); s[(n4 + 3) * 72 + k] = f2bf(v.w);
  }
  __syncthreads();
#pragma unroll
  for (int i = 0; i < 2; ++i) {
    const int n = (t >> 3) + 32 * i, kc = t & 7;
    const uint4 v = *(const uint4*)(s + n * 72 + kc * 8);
    *(uint4*)(WT + (size_t)(nt * 64 + n) * K + kt * 64 + kc * 8) = v;
  }
  __syncthreads();
}

DEV void mod_item(const Params& p, int l, int jb, char* lds) {
  float* sc = (float*)lds;
  float* red = (float*)(lds + 12288);
  const int t = tid();
  for (int i = t; i < 3072; i += 256) {
    const int c = i >> 10, k = i & 1023;
    const float x = (c == 0) ? p.in[I_CCTX][k] : p.in[I_C][(c - 1) * 1024 + k];
    sc[i] = x / (1.0f + __expf(-x));
  }
  __syncthreads();
  const int cg4 = t & 63, ks = t >> 6;
  const float* wp = p.in[I_MODW] + ((size_t)l * 1024 + ks * 256) * 6144 + jb * 256 + cg4 * 4;
  float a00 = 0, a01 = 0, a02 = 0, a03 = 0, a10 = 0, a11 = 0, a12 = 0, a13 = 0, a20 = 0, a21 = 0, a22 = 0, a23 = 0;
#pragma unroll 8
  for (int ii = 0; ii < 256; ++ii) {
    const float4 w = *(const float4*)(wp + (size_t)ii * 6144);
    const int k = ks * 256 + ii;
    const float s0 = sc[k], s1 = sc[1024 + k], s2 = sc[2048 + k];
    a00 += s0 * w.x; a01 += s0 * w.y; a02 += s0 * w.z; a03 += s0 * w.w;
    a10 += s1 * w.x; a11 += s1 * w.y; a12 += s1 * w.z; a13 += s1 * w.w;
    a20 += s2 * w.x; a21 += s2 * w.y; a22 += s2 * w.z; a23 += s2 * w.w;
  }
  float* r0 = red + (ks * 3 + 0) * 256 + cg4 * 4; r0[0] = a00; r0[1] = a01; r0[2] = a02; r0[3] = a03;
  float* r1 = red + (ks * 3 + 1) * 256 + cg4 * 4; r1[0] = a10; r1[1] = a11; r1[2] = a12; r1[3] = a13;
  float* r2 = red + (ks * 3 + 2) * 256 + cg4 * 4; r2[0] = a20; r2[1] = a21; r2[2] = a22; r2[3] = a23;
  __syncthreads();
  float* MOD = (float*)(p.ws + OFF_MOD);
  const float bias = p.in[I_MODB][l * 6144 + jb * 256 + t];
#pragma unroll
  for (int c = 0; c < 3; ++c) {
    float v = bias;
#pragma unroll
    for (int k2 = 0; k2 < 4; ++k2) v += red[(k2 * 3 + c) * 256 + t];
    MOD[(size_t)(l * 3 + c) * 6144 + jb * 256 + t] = v;
  }
  __syncthreads();
}

DEV void hglb_item(const Params& p) {
  const int c = tid();
  float* HGLB = (float*)(p.ws + OFF_HGLB);
  for (int dir = 0; dir < 2; ++dir) {
    float x[4], mx = -1e30f;
    for (int l = 0; l < 4; ++l) { x[l] = p.in[I_HGLB][(dir * 4 + l) * 256 + c]; mx = fmaxf(mx, x[l]); }
    float s = 0;
    for (int l = 0; l < 4; ++l) { x[l] = __expf(x[l] - mx); s += x[l]; }
    float cum = 0; const float s0 = x[0] / s;
    for (int l = 0; l < 4; ++l) { cum += x[l] / s; HGLB[(l * 2 + dir) * 256 + c] = cum - s0; }
  }
}

DEV void phase0(const Params& p, char* lds0) {
  const int hf = half_id(); char* lds = lds0 + hf * 65536;
  const int NT_WIN = 4 * 16 * 58, NT_WOUT = 4 * 16 * 16, NT_W1 = 4 * 16 * 64, NT_W2 = 4 * 64 * 16;
  const int nitems = 98 + NT_WIN + NT_WOUT + NT_W1 + NT_W2 + 4;
  for (int it = blockIdx.x * 2 + hf; it < nitems; it += gridDim.x * 2) {
    if (it < 96) { mod_item(p, it / 24, it % 24, lds); continue; }
    if (it == 96) { hglb_item(p); continue; }
    if (it == 97) continue;
    int j = it - 98;
    if (j < NT_WIN) { const int l = j / 928, r = j % 928;
      transpose_item(p.in[I_WIN] + (size_t)l * D * DIN, (bf16_t*)(p.ws + OFF_WIN) + (size_t)l * DINP * D, D, DIN, r / 58, r % 58, lds); continue; }
    j -= NT_WIN;
    if (j < NT_WOUT) { const int l = j / 256, r = j % 256;
      transpose_item(p.in[I_WOUT] + (size_t)l * D * D, (bf16_t*)(p.ws + OFF_WOUT) + (size_t)l * D * D, D, D, r / 16, r % 16, lds); continue; }
    j -= NT_WOUT;
    if (j < NT_W1) { const int l = j / 1024, r = j % 1024;
      transpose_item(p.in[I_FW1] + (size_t)l * D * FF, (bf16_t*)(p.ws + OFF_W1) + (size_t)l * FF * D, D, FF, r / 64, r % 64, lds); continue; }
    j -= NT_W1;
    if (j < NT_W2) { const int l = j / 1024, r = j % 1024;
      transpose_item(p.in[I_FW2] + (size_t)l * FF * D, (bf16_t*)(p.ws + OFF_W2) + (size_t)l * D * FF, FF, D, r / 16, r % 16, lds); continue; }
    j -= NT_W2;
    {
      uint4* z = (uint4*)((bf16_t*)(p.ws + OFF_WIN) + ((size_t)j * DINP + DIN) * D);
      const int t = tid();
      for (int i = t; i < 128 * D * 2 / 16; i += 256) z[i] = make_uint4(0u, 0u, 0u, 0u);
    }
  }
}

DEV void row_phase(const Params& p, int mode, int l) {
  const int lane = tid() & 63;
  const int nw = gridDim.x * 8;
  const float* MOD = (const float*)(p.ws + OFF_MOD);
  const float* NG = p.in[I_NORMG];
  const float* U = (const float*)(p.ws + OFF_U);
  bf16_t* H = (bf16_t*)(p.ws + OFF_H);
  const bool has_next = !(mode == 2 && l == 3);
  const int ln = (mode == 0) ? 0 : (mode == 1 ? l : l + 1);
  const int gi = (mode == 1) ? 2 : 0, shi = (mode == 1) ? 3 : 0, sci = (mode == 1) ? 4 : 1;
  const float* ga = NG + (size_t)(l * 4 + (mode == 1 ? 1 : 3)) * 1024;
  const float* gb = NG + (size_t)((has_next ? ln : 0) * 4 + gi) * 1024;
  for (int rowa = blockIdx.x * 8 + half_id() * 4 + (tid() >> 6); rowa < MT; rowa += 2 * nw) {
    float4 x[2][4], u[2][4];
    int rows[2]; bool ok[2];
#pragma unroll
    for (int q = 0; q < 2; ++q) {
      rows[q] = rowa + q * nw; ok[q] = rows[q] < MT;
      const int row = ok[q] ? rows[q] : rowa;
      if (mode == 0) {
        const float* src = row < NCTX ? p.in[I_XP] + (size_t)row * D : p.in[I_XS] + (size_t)(row - NCTX) * D;
#pragma unroll
        for (int i = 0; i < 4; ++i) x[q][i] = *(const float4*)(src + i * 256 + lane * 4);
      } else {
#pragma unroll
        for (int i = 0; i < 4; ++i) {
          x[q][i] = *(const float4*)(p.out + (size_t)row * D + i * 256 + lane * 4);
          u[q][i] = *(const float4*)(U + (size_t)row * D + i * 256 + lane * 4);
        }
      }
    }
#pragma unroll
    for (int q = 0; q < 2; ++q) {
      const int row = ok[q] ? rows[q] : rowa;
      const int cond = row < NCTX ? 0 : 1 + ((row - NCTX) >> 10);
      if (mode != 0) {
        float ss = 0;
#pragma unroll
        for (int i = 0; i < 4; ++i) ss += u[q][i].x * u[q][i].x + u[q][i].y * u[q][i].y + u[q][i].z * u[q][i].z + u[q][i].w * u[q][i].w;
        ss = wave_sum(ss);
        const float r = rsqrtf(ss * (1.0f / 1024.0f) + 1e-6f);
        const float* gate = MOD + (size_t)(l * 3 + cond) * 6144 + (mode == 1 ? 2 : 5) * 1024;
#pragma unroll
        for (int i = 0; i < 4; ++i) {
          const float4 g4 = *(const float4*)(gate + i * 256 + lane * 4);
          const float4 a4 = *(const float4*)(ga + i * 256 + lane * 4);
          x[q][i].x += g4.x * (u[q][i].x * r * a4.x); x[q][i].y += g4.y * (u[q][i].y * r * a4.y);
          x[q][i].z += g4.z * (u[q][i].z * r * a4.z); x[q][i].w += g4.w * (u[q][i].w * r * a4.w);
        }
      }
      if (ok[q]) {
#pragma unroll
        for (int i = 0; i < 4; ++i) *(float4*)(p.out + (size_t)row * D + i * 256 + lane * 4) = x[q][i];
      }
      if (has_next) {
        float ss = 0;
#pragma unroll
        for (int i = 0; i < 4; ++i) ss += x[q][i].x * x[q][i].x + x[q][i].y * x[q][i].y + x[q][i].z * x[q][i].z + x[q][i].w * x[q][i].w;
        ss = wave_sum(ss);
        const float r2 = rsqrtf(ss * (1.0f / 1024.0f) + 1e-6f);
        const float* sh = MOD + (size_t)(ln * 3 + cond) * 6144 + shi * 1024;
        const float* sc = MOD + (size_t)(ln * 3 + cond) * 6144 + sci * 1024;
        if (ok[q]) {
#pragma unroll
          for (int i = 0; i < 4; ++i) {
            const float4 g4 = *(const float4*)(gb + i * 256 + lane * 4);
            const float4 s4 = *(const float4*)(sc + i * 256 + lane * 4);
            const float4 h4 = *(const float4*)(sh + i * 256 + lane * 4);
            const float h0 = x[q][i].x * r2 * g4.x * (1.0f + s4.x) + h4.x;
            const float h1 = x[q][i].y * r2 * g4.y * (1.0f + s4.y) + h4.y;
            const float h2 = x[q][i].z * r2 * g4.z * (1.0f + s4.z) + h4.z;
            const float h3 = x[q][i].w * r2 * g4.w * (1.0f + s4.w) + h4.w;
            uint2 o; o.x = pk2(h0, h1); o.y = pk2(h2, h3);
            *(uint2*)(H + (size_t)row * D + i * 256 + lane * 4) = o;
          }
        }
      }
    }
  }
}

namespace pg8 {
#define PG8_LAS __attribute__((address_space(3)))
typedef unsigned short bf16_t;
typedef short bf16x8 __attribute__((ext_vector_type(8)));
typedef float f32x4 __attribute__((ext_vector_type(4)));
typedef unsigned u32x4 __attribute__((ext_vector_type(4)));
constexpr int BM = 256, BK = 64, HALF = 128, HTB = HALF * BK * 2  , STAGE_BYTES = 8 * HTB, NXCD = 8, WGM = 8;

__host__ __device__ __forceinline__ int lds_byte(int r, int c) { const int st = (r >> 4) * 2 + (c >> 5), rr = r & 15, cc = c & 31, ob = rr * 64 + cc * 2; return st * 1024 + (ob ^ (((ob >> 9) & 1) << 5)); }
__host__ __device__ __forceinline__ void stage_rc(int b, int& R, int& C) { const int st = b / 1024, sb = b % 1024, swz = sb ^ (((sb >> 9) & 1) << 5); R = (st >> 1) * 16 + swz / 64; C = (st & 1) * 32 + (swz % 64) / 2; }
__host__ __device__ __forceinline__ int perm32(int rho) { const int n = rho >> 4, i = rho & 15; return 8 * (i >> 2) + 4 * n + (i & 3); }

struct Unit { int pm, pn; };
struct Gemm { const bf16_t* A; const bf16_t* Bt; int M, N, K; };

struct StaticOrder {
    int nM, nN, nwg, G, c;
    __host__ __device__ void init(int M, int N, int G_, int c_) { nM = M / BM; nN = N / BM; nwg = nM * nN; G = G_; c = c_; }
    __host__ __device__ bool next(int i, Unit& u) const {
        const long L = (long)i * G + c; if (L >= nwg) return false;
        int wgid = (int)L; { const int q = nwg / NXCD, r = nwg % NXCD, xcd = wgid % NXCD, off = wgid / NXCD; wgid = (xcd < r ? xcd * (q + 1) : r * (q + 1) + (xcd - r) * q) + off; }
        const int nig = WGM * nN, gid = wgid / nig, fm = gid * WGM, gsz = (nM - fm) < WGM ? (nM - fm) : WGM;
        u.pm = fm + ((wgid % nig) % gsz); u.pn = (wgid % nig) / gsz; return true;
    }
    __device__ __forceinline__ void a_ready(const Unit&) const {}
    __device__ __forceinline__ void done(const Unit&) const {}
};

template <class Epi, class Sched, bool ALIGN_EPI = false, bool SP2 = false>
__device__ __forceinline__ void gemm_phase(PG8_LAS unsigned char* lds, const Gemm g, const Sched& S, const Epi& E) {
    int tid_z; asm volatile("v_mov_b32 %0, 0" : "=v"(tid_z)); const int tid = (int)threadIdx.x + tid_z, wid = __builtin_amdgcn_readfirstlane(tid >> 6), lane = tid & 63, wr = wid >> 2, wc = wid & 3, fr = lane & 15, fq = lane >> 4;
    const int K = g.K, nt = K / BK;
    unsigned voffA[2], voffB[2];
#pragma unroll
    for (int i = 0; i < 2; ++i) { int R, C; stage_rc(tid * 16 + i * 8192, R, C); const int Rb = Epi::PERM ? ((R & ~31) + perm32(R & 31)) : R;
        voffA[i] = (unsigned)(R * K + C) * 2u; voffB[i] = (unsigned)(Rb * K + C) * 2u; }
    const size_t kstep = (size_t)(BK * 2);
    const size_t hstep = (size_t)HALF * K * 2;
    const size_t tstep = 2 * hstep;
    const unsigned ldsw = (unsigned)wid * 1024u;
    const int aoff = lds_byte(wr * 64 + fr, fq * 8), boff = lds_byte(wc * 32 + fr, fq * 8);
#define PG8_SA(b, h) (((b) * 2 + (h)) * HTB)
#define PG8_SB(b, h) ((4 + (b) * 2 + (h)) * HTB)
#define PG8_STAGE(bufoff, gbase, voff) do { _Pragma("unroll") for (int _i = 0; _i < 2; ++_i) \
        __builtin_amdgcn_global_load_lds((const unsigned*)((const char*)(gbase) + (voff)[_i]), (PG8_LAS unsigned*)(lds + (bufoff) + ldsw + _i * 8192), 16, 0, 0); } while (0)
#define PG8_LDA(dst, b, h) do { _Pragma("unroll") for (int m = 0; m < 4; ++m) _Pragma("unroll") for (int k = 0; k < 2; ++k) dst[m][k] = *(const PG8_LAS bf16x8*)(lds + PG8_SA(b, h) + aoff + m * 2048 + k * 1024); } while (0)
#define PG8_LDB(dst, b, h) do { _Pragma("unroll") for (int n = 0; n < 2; ++n) _Pragma("unroll") for (int k = 0; k < 2; ++k) dst[n][k] = *(const PG8_LAS bf16x8*)(lds + PG8_SB(b, h) + boff + n * 2048 + k * 1024); } while (0)
#define PG8_MMA(ai, bj, At, Bt) do { __builtin_amdgcn_s_setprio(1); _Pragma("unroll") for (int m = 0; m < 4; ++m) _Pragma("unroll") for (int n = 0; n < 2; ++n) _Pragma("unroll") for (int k = 0; k < 2; ++k) \
        acc[ai][bj][m][n] = __builtin_amdgcn_mfma_f32_16x16x32_bf16(Bt[n][k], At[m][k], acc[ai][bj][m][n], 0, 0, 0); __builtin_amdgcn_s_setprio(0); } while (0)
#define PG8_WAIT_V(n) asm volatile("s_waitcnt vmcnt(" #n ")" ::: "memory")
#define PG8_WAIT_L(n) asm volatile("s_waitcnt lgkmcnt(" #n ")" ::: "memory")
#define PG8_BAR __builtin_amdgcn_s_barrier()
#define PG8_SCHED __builtin_amdgcn_sched_barrier(0)
    Unit cur, nxt; int ui = 0;
    if (!S.next(0, cur)) return;
    f32x4 acc[2][2][4][2];
#pragma unroll
    for (int a = 0; a < 2; ++a)
#pragma unroll
        for (int b = 0; b < 2; ++b)
#pragma unroll
            for (int m = 0; m < 4; ++m)
#pragma unroll
                for (int n = 0; n < 2; ++n) acc[a][b][m][n] = (f32x4){0.f, 0.f, 0.f, 0.f};
    bf16x8 At[4][2], B0[2][2], B1[2][2];
    const char* cA = (const char*)g.A + (size_t)cur.pm * tstep; const char* cB = (const char*)g.Bt + (size_t)cur.pn * tstep;
    S.a_ready(cur);
    if constexpr (SP2) {
        PG8_STAGE(PG8_SB(0, 0), cB, voffB); PG8_STAGE(PG8_SB(0, 1), cB + hstep, voffB); PG8_STAGE(PG8_SA(0, 0), cA, voffA); PG8_STAGE(PG8_SA(0, 1), cA + hstep, voffA);
        if (wr == 1) PG8_BAR;
        PG8_WAIT_V(2); PG8_BAR;
        PG8_STAGE(PG8_SB(1, 0), cB + kstep, voffB); PG8_STAGE(PG8_SA(1, 0), cA + kstep, voffA); PG8_STAGE(PG8_SB(1, 1), cB + hstep + kstep, voffB);
        PG8_WAIT_V(6); PG8_BAR;
    } else {
        PG8_STAGE(PG8_SB(0, 0), cB, voffB); PG8_STAGE(PG8_SA(0, 0), cA, voffA); PG8_STAGE(PG8_SB(0, 1), cB + hstep, voffB); PG8_STAGE(PG8_SA(0, 1), cA + hstep, voffA);
        if (wr == 1) PG8_BAR;
        PG8_WAIT_V(4); PG8_BAR;
        PG8_STAGE(PG8_SB(1, 0), cB + kstep, voffB); PG8_STAGE(PG8_SA(1, 0), cA + kstep, voffA); PG8_STAGE(PG8_SB(1, 1), cB + hstep + kstep, voffB);
        PG8_WAIT_V(6); PG8_BAR;
    }
    for (;;) {
        const bool has_next = S.next(ui + 1, nxt);
        const char* nA = has_next ? (const char*)g.A + (size_t)nxt.pm * tstep : cA; const char* nB = has_next ? (const char*)g.Bt + (size_t)nxt.pn * tstep : cB;
        for (int t = 0; t < nt; t += 2) {
            const bool last = (t == nt - 2);
            const char* a1 = cA + (size_t)(t + 1) * kstep;
            const char* a2 = last ? nA : cA + (size_t)(t + 2) * kstep; const char* b2 = last ? nB : cB + (size_t)(t + 2) * kstep;
            const char* a3 = a2 + kstep; const char* b3 = b2 + kstep;
            if (last && has_next) S.a_ready(nxt);
            if constexpr (SP2) {
            PG8_LDB(B0, 0, 0); PG8_LDB(B1, 0, 1); PG8_SCHED; PG8_LDA(At, 0, 0); PG8_STAGE(PG8_SA(1, 1), a1 + hstep, voffA);
            PG8_WAIT_V(8); PG8_WAIT_L(0); PG8_BAR; PG8_MMA(0, 0, At, B0); PG8_MMA(0, 1, At, B1); PG8_BAR; PG8_SCHED;
            PG8_LDA(At, 0, 1); PG8_STAGE(PG8_SB(0, 0), b2, voffB); PG8_STAGE(PG8_SB(0, 1), b2 + hstep, voffB); PG8_STAGE(PG8_SA(0, 0), a2, voffA);
            PG8_WAIT_V(8); PG8_WAIT_L(0); PG8_BAR; PG8_MMA(1, 0, At, B0); PG8_MMA(1, 1, At, B1); PG8_BAR; PG8_SCHED;
            PG8_LDB(B0, 1, 0); PG8_LDB(B1, 1, 1); PG8_SCHED; PG8_LDA(At, 1, 0); PG8_STAGE(PG8_SA(0, 1), a2 + hstep, voffA);
            PG8_WAIT_V(8); PG8_WAIT_L(0); PG8_BAR; PG8_MMA(0, 0, At, B0); PG8_MMA(0, 1, At, B1); PG8_BAR; PG8_SCHED;
            PG8_LDA(At, 1, 1); PG8_STAGE(PG8_SB(1, 0), b3, voffB); PG8_STAGE(PG8_SB(1, 1), b3 + hstep, voffB); PG8_STAGE(PG8_SA(1, 0), a3, voffA);
            PG8_WAIT_V(8); PG8_WAIT_L(0); PG8_BAR; PG8_MMA(1, 0, At, B0); PG8_MMA(1, 1, At, B1); PG8_BAR; PG8_SCHED;
            } else {
            PG8_LDB(B0, 0, 0); PG8_SCHED; PG8_LDA(At, 0, 0); PG8_STAGE(PG8_SA(1, 1), a1 + hstep, voffA);
            PG8_WAIT_L(8); PG8_BAR; PG8_WAIT_L(0); PG8_MMA(0, 0, At, B0); PG8_BAR; PG8_SCHED;
            PG8_LDB(B1, 0, 1); PG8_STAGE(PG8_SB(0, 0), b2, voffB);
            PG8_BAR; PG8_WAIT_L(0); PG8_MMA(0, 1, At, B1); PG8_BAR;
            PG8_LDA(At, 0, 1); PG8_STAGE(PG8_SA(0, 0), a2, voffA);
            PG8_BAR; PG8_WAIT_L(0); PG8_MMA(1, 0, At, B0); PG8_BAR; PG8_SCHED;
            PG8_STAGE(PG8_SB(0, 1), b2 + hstep, voffB);
            PG8_WAIT_V(6); PG8_BAR; PG8_MMA(1, 1, At, B1); PG8_BAR;
            PG8_LDB(B0, 1, 0); PG8_SCHED; PG8_LDA(At, 1, 0); PG8_STAGE(PG8_SA(0, 1), a2 + hstep, voffA);
            PG8_WAIT_L(8); PG8_BAR; PG8_WAIT_L(0); PG8_MMA(0, 0, At, B0); PG8_BAR; PG8_SCHED;
            PG8_LDB(B1, 1, 1); PG8_STAGE(PG8_SB(1, 0), b3, voffB);
            PG8_BAR; PG8_WAIT_L(0); PG8_MMA(0, 1, At, B1); PG8_BAR;
            PG8_LDA(At, 1, 1); PG8_STAGE(PG8_SA(1, 0), a3, voffA);
            PG8_BAR; PG8_WAIT_L(0); PG8_MMA(1, 0, At, B0); PG8_BAR; PG8_SCHED;
            PG8_STAGE(PG8_SB(1, 1), b3 + hstep, voffB);
            PG8_WAIT_V(6); PG8_BAR; PG8_MMA(1, 1, At, B1); PG8_BAR;
            }
        }
        if constexpr (ALIGN_EPI) { if (wr == 0) PG8_BAR; }
        if constexpr (!Epi::AFTER_DRAIN) { E(acc, cur, wr, wc, fr, fq); S.done(cur); }
        if (!has_next) break;
#pragma unroll
        for (int a = 0; a < 2; ++a)
#pragma unroll
            for (int b = 0; b < 2; ++b)
#pragma unroll
                for (int m = 0; m < 4; ++m)
#pragma unroll
                    for (int n = 0; n < 2; ++n) acc[a][b][m][n] = (f32x4){0.f, 0.f, 0.f, 0.f};
        cur = nxt; cA = nA; cB = nB; ++ui;
        if constexpr (ALIGN_EPI) { if (wr == 1) PG8_BAR; }
    }
    PG8_WAIT_V(0);
    if constexpr (!ALIGN_EPI) { if (wr == 0) PG8_BAR; }
    PG8_BAR;
    if constexpr (Epi::AFTER_DRAIN) { E.fused(acc, cur, wr, wc, fr, fq, lds, wid, lane); S.done(cur); }
#undef PG8_SA
#undef PG8_SB
#undef PG8_STAGE
#undef PG8_LDA
#undef PG8_LDB
#undef PG8_MMA
#undef PG8_WAIT_V
#undef PG8_WAIT_L
#undef PG8_BAR
#undef PG8_SCHED
}
}

template <int MODE> struct EpiMK {
  static constexpr bool PERM = false, AFTER_DRAIN = false;
  const Params* pp; int l;
  DEV void operator()(const pg8::f32x4 (&acc)[2][2][4][2], const pg8::Unit& u, int wr, int wc, int fr, int fq) const {
    const Params& p = *pp;
#pragma unroll
    for (int ai = 0; ai < 2; ++ai)
#pragma unroll
      for (int m = 0; m < 4; ++m) {
        const int row = u.pm * 256 + ai * 128 + wr * 64 + m * 16 + fr;
#pragma unroll
        for (int bj = 0; bj < 2; ++bj)
#pragma unroll
          for (int n = 0; n < 2; ++n) {
            const int col = u.pn * 256 + bj * 128 + wc * 32 + n * 16 + fq * 4;
            const pg8::f32x4 v = acc[ai][bj][m][n];
            if (MODE == 0) {
              if (col < DIN) {
                uint2 o; o.x = pk2(v[0], v[1]); o.y = pk2(v[2], v[3]);
                *(uint2*)((bf16_t*)(p.ws + OFF_P) + (size_t)row * DIN + col) = o;
                if (row < NCTX) {
                  if (col >= C_NK && col < C_HQ) {
                    const int kv = col >= C_NV;
                    *(pg8::f32x4*)(p.out + O_NAT + (size_t)(((row >> 8) * 4 + l) * 2 + kv) * 65536 + (row & 255) * 256 + (col - (kv ? C_NV : C_NK))) = v;
                  } else if (col >= C_SK) {
                    const int kv = col >= C_SV;
                    *(pg8::f32x4*)(p.out + O_SWA + (size_t)(((row >> 8) * 4 + l) * 2 + kv) * 32768 + (row & 255) * 128 + (col - (kv ? C_SV : C_SK))) = v;
                  }
                }
              }
            } else if (MODE == 1) {
              *(pg8::f32x4*)((float*)(p.ws + OFF_U) + (size_t)row * D + col) = v;
            } else {
              const float r0 = fmaxf(v[0], 0.f), r1 = fmaxf(v[1], 0.f), r2 = fmaxf(v[2], 0.f), r3 = fmaxf(v[3], 0.f);
              uint2 o; o.x = pk2(r0 * r0, r1 * r1); o.y = pk2(r2 * r2, r3 * r3);
              *(uint2*)((bf16_t*)(p.ws + OFF_HID) + (size_t)row * FF + col) = o;
            }
          }
      }
  }
};

template <int MODE>
DEV void gemm_run(const Params& p, int l, const bf16_t* A, const bf16_t* BT, int K, int N, char* lds) {
  pg8::Gemm g{A, BT, MT, N, K};
  pg8::StaticOrder S; S.init(MT, N, (int)gridDim.x, (int)blockIdx.x);
  EpiMK<MODE> E{&p, l};
  pg8::gemm_phase<EpiMK<MODE>, pg8::StaticOrder, true, true>((PG8_LAS unsigned char*)lds, g, S, E);
}

constexpr int TOKT = 20;
DEV void prep_item(const Params& p, int l, int tile, char* lds) {
  const int t = tid(), r0 = tile * TOKT, c = t;
  float* sT = (float*)lds;
  float* swl = sT + 128 * TOKT;
  float* sal = swl + TOKT * 256;
  const bf16_t* P = (const bf16_t*)(p.ws + OFF_P);
  float* PREP = (float*)(p.ws + OFF_PREP);
  float* BON = (float*)(p.ws + OFF_BONUS);
  for (int dir = 0; dir < 2; ++dir) {
    __syncthreads();
#pragma unroll
    for (int i = 0; i < TOKT / 2; ++i) {
      const int e = t + 256 * i, tk = e >> 7, j = e & 127, which = j >> 6, jj = j & 63;
      const int row = r0 + tk, prow = dir ? row + 1 : row - 1;
      const int tis = row < NCTX ? (row & 255) : ((row - NCTX) & 1023), Tm1 = row < NCTX ? 255 : 1023;
      const bool pv = dir ? (tis < Tm1) : (tis > 0);
      const int col = (dir ? C_WHB : C_WHF) + which * 64 + jj;
      const float cur = bf2f(P[(size_t)row * DIN + col]);
      const float prev = pv ? bf2f(P[(size_t)prow * DIN + col]) : 0.f;
      const float mu = p.in[I_MULORA][((l * 2 + dir) * 2 + which) * 64 + jj];
      float val = cur + (prev - cur) * mu;
      if (which == 0) val = tanhf_(val);
      sT[j * TOKT + tk] = val;
    }
    __syncthreads();
    {
      const float* w2p = p.in[I_W2] + (size_t)(l * 2 + dir) * 64 * 256 + c;
      const float* a2p = p.in[I_A2] + (size_t)(l * 2 + dir) * 64 * 256 + c;
      float aw[TOKT], aa[TOKT];
#pragma unroll
      for (int k = 0; k < TOKT; ++k) { aw[k] = 0.f; aa[k] = 0.f; }
#pragma unroll 4
      for (int j = 0; j < 64; ++j) {
        const float w2j = w2p[j * 256], a2j = a2p[j * 256];
#pragma unroll
        for (int k4 = 0; k4 < TOKT / 4; ++k4) {
          const float4 th4 = *(const float4*)(sT + j * TOKT + k4 * 4);
          const float4 ah4 = *(const float4*)(sT + (64 + j) * TOKT + k4 * 4);
          aw[k4 * 4 + 0] += th4.x * w2j; aw[k4 * 4 + 1] += th4.y * w2j; aw[k4 * 4 + 2] += th4.z * w2j; aw[k4 * 4 + 3] += th4.w * w2j;
          aa[k4 * 4 + 0] += ah4.x * a2j; aa[k4 * 4 + 1] += ah4.y * a2j; aa[k4 * 4 + 2] += ah4.z * a2j; aa[k4 * 4 + 3] += ah4.w * a2j;
        }
      }
#pragma unroll
      for (int k = 0; k < TOKT; ++k) { swl[k * 256 + c] = aw[k]; sal[k * 256 + c] = aa[k]; }
    }
    const float w0v = p.in[I_W0][(l * 2 + dir) * 256 + c], a0v = p.in[I_A0][(l * 2 + dir) * 256 + c];
    const float kkv = p.in[I_KK][l * 256 + c], kav = p.in[I_KA][l * 256 + c], rkv = p.in[I_RK][l * 256 + c];
    const float mur = p.in[I_MURKV][((l * 2 + dir) * 3 + 0) * 256 + c], muk = p.in[I_MURKV][((l * 2 + dir) * 3 + 1) * 256 + c],
                muv = p.in[I_MURKV][((l * 2 + dir) * 3 + 2) * 256 + c];
    float* pr = PREP + (size_t)dir * 6 * ARRF;
#pragma unroll 4
    for (int tk = 0; tk < TOKT; ++tk) {
      const int row = r0 + tk, prow = dir ? row + 1 : row - 1;
      const int tis = row < NCTX ? (row & 255) : ((row - NCTX) & 1023), Tm1 = row < NCTX ? 255 : 1023;
      const bool pv = dir ? (tis < Tm1) : (tis > 0);
      const bf16_t* pc = P + (size_t)row * DIN + c;
      const bf16_t* pp = P + (size_t)(pv ? prow : row) * DIN + c;
      const float rc = bf2f(pc[C_R]), kc = bf2f(pc[C_K]), vc = bf2f(pc[C_V]);
      const float rp = pv ? bf2f(pp[C_R]) : 0.f, kp0 = pv ? bf2f(pp[C_K]) : 0.f, vp = pv ? bf2f(pp[C_V]) : 0.f;
      const float rs = rc + (rp - rc) * mur, ks = kc + (kp0 - kc) * muk, vs = vc + (vp - vc) * muv;
      const float wl = w0v + swl[tk * 256 + c], al = a0v + sal[tk * 256 + c];
      const float wv = __expf(-0.6065306597126334f * sigmoidf_(wl));
      const float av = sigmoidf_(al);
      const float kkr = ks * kkv;
      const float n2 = wave_sum(kkr * kkr);
      const float kk = kkr / fmaxf(sqrtf(n2), 1e-12f);
      const float kp = ks * (1.0f + (av - 1.0f) * kav);
      const float bs = wave_sum(rs * kp * rkv);
      const float bon = bs * vs;
      const size_t idx = (size_t)row * 256 + c;
      pr[idx] = rs; pr[ARRF + idx] = wv; pr[2 * ARRF + idx] = kp; pr[3 * ARRF + idx] = vs; pr[4 * ARRF + idx] = kk; pr[5 * ARRF + idx] = kk * av;
      if (dir == 0) BON[idx] = bon; else BON[idx] += bon;
    }
  }
  __syncthreads();
}

DEV void rope_item(const Params& p, int item) {
  bf16_t* P = (bf16_t*)(p.ws + OFF_P);
  const int t = tid();
  for (int e = t; e < 64 * 192; e += 256) {
    const int tk = e / 192, r = e % 192, hs = r >> 5, pi = r & 31;
    const int lt = item * 64 + tk;
    const int tt = lt & 1023;
    const int grow = tt >> 6, gcol = tt & 63;
    const int fi = pi & 15;
    const float pos = (pi < 16) ? (float)grow : (float)gcol;
    const float inv = exp2f(-(float)fi * (13.287712379549449f / 16.0f));
    const float ang = pos * inv;
    const float cs = __cosf(ang), sn = __sinf(ang);
    const int d1 = (pi < 16) ? fi : 32 + fi;
    bf16_t* base = P + (size_t)(NCTX + lt) * DIN + C_SQ + hs * 64;
    const float x1 = bf2f(base[d1]), x2 = bf2f(base[d1 + 16]);
    base[d1] = f2bf(x1 * cs - x2 * sn);
    base[d1 + 16] = f2bf(x2 * cs + x1 * sn);
  }
}

constexpr int SC_BUF = 20480 + 2048;
DEV float dot4(const float4& a, const float4& b) { return a.x * b.x + a.y * b.y + a.z * b.z + a.w * b.w; }

DEV void rwkv_scan(const Params& p, int l, int seq, int head, int dir, int rp, char* lds) {
  const int t = tid(), rl = t >> 4, ks = t & 15;
  const int T = seq < 32 ? 256 : 1024;
  const int row0 = seq < 32 ? seq * 256 : NCTX + (seq - 32) * 1024;
  const float* prep = (const float*)(p.ws + OFF_PREP) + (size_t)dir * 6 * ARRF;
  float* ydir = (float*)(p.ws + OFF_YDIR) + (size_t)dir * ARRF;
  const int v0 = rp * 32 + rl, v1 = v0 + 16;
  float4 S0 = make_float4(0.f, 0.f, 0.f, 0.f), S1 = S0;
  if (seq >= 32) {
    const float* sp = p.in[I_SRW] + ((((size_t)(seq - 32) * 4 + l) * 2 + dir) * 4 + head) * 4096 + ks * 4;
    S0 = *(const float4*)(sp + v0 * 64); S1 = *(const float4*)(sp + v1 * 64);
  }
  const int nch = T >> 4;
  float4 pre0, pre1, pre2, pre3, pre4; float pv0, pv1;
#define RW_LOAD(cc) do { const int s_ = (cc) * 16 + rl; const int tok_ = dir ? (T - 1 - s_) : s_; \
    const size_t base_ = (size_t)(row0 + tok_) * 256 + head * 64; \
    pre0 = *(const float4*)(prep + base_ + ks * 4); pre1 = *(const float4*)(prep + ARRF + base_ + ks * 4); \
    pre2 = *(const float4*)(prep + 2 * ARRF + base_ + ks * 4); pre3 = *(const float4*)(prep + 4 * ARRF + base_ + ks * 4); \
    pre4 = *(const float4*)(prep + 5 * ARRF + base_ + ks * 4); \
    pv0 = prep[3 * ARRF + base_ + rp * 32 + ks]; pv1 = prep[3 * ARRF + base_ + rp * 32 + 16 + ks]; } while (0)
#define RW_WRITE(bb) do { float4* sb_ = (float4*)(lds + (bb) * SC_BUF); float* vb_ = (float*)(lds + (bb) * SC_BUF + 20480); \
    sb_[(0 * 16 + rl) * 16 + ks] = pre0; sb_[(1 * 16 + rl) * 16 + ks] = pre1; sb_[(2 * 16 + rl) * 16 + ks] = pre2; \
    sb_[(3 * 16 + rl) * 16 + ks] = pre3; sb_[(4 * 16 + rl) * 16 + ks] = pre4; vb_[rl * 32 + ks] = pv0; vb_[rl * 32 + 16 + ks] = pv1; } while (0)
  __syncthreads();
  RW_LOAD(0); RW_WRITE(0);
  __syncthreads();
  for (int c = 0; c < nch; ++c) {
    if (c + 1 < nch) RW_LOAD(c + 1);
    const float4* sbuf = (const float4*)(lds + (c & 1) * SC_BUF);
    const float* vbuf = (const float*)(lds + (c & 1) * SC_BUF + 20480);
    float ym0 = 0.f, ym1 = 0.f;
#pragma unroll
    for (int i = 0; i < 16; ++i) {
      const float4 r = sbuf[(0 * 16 + i) * 16 + ks], wv = sbuf[(1 * 16 + i) * 16 + ks], kv = sbuf[(2 * 16 + i) * 16 + ks],
                   kk = sbuf[(3 * 16 + i) * 16 + ks], ka = sbuf[(4 * 16 + i) * 16 + ks];
      const float va = vbuf[i * 32 + rl], vb = vbuf[i * 32 + 16 + rl];
      const float sa0 = -row16_sum(dot4(S0, kk)), sa1 = -row16_sum(dot4(S1, kk));
      S0.x = S0.x * wv.x + sa0 * ka.x + va * kv.x; S0.y = S0.y * wv.y + sa0 * ka.y + va * kv.y;
      S0.z = S0.z * wv.z + sa0 * ka.z + va * kv.z; S0.w = S0.w * wv.w + sa0 * ka.w + va * kv.w;
      S1.x = S1.x * wv.x + sa1 * ka.x + vb * kv.x; S1.y = S1.y * wv.y + sa1 * ka.y + vb * kv.y;
      S1.z = S1.z * wv.z + sa1 * ka.z + vb * kv.z; S1.w = S1.w * wv.w + sa1 * ka.w + vb * kv.w;
      const float y0 = row16_sum(dot4(S0, r)), y1 = row16_sum(dot4(S1, r));
      ym0 = (ks == i) ? y0 : ym0; ym1 = (ks == i) ? y1 : ym1;
    }
    {
      const int s = c * 16 + ks; const int tok = dir ? (T - 1 - s) : s;
      float* yo = ydir + (size_t)(row0 + tok) * 256 + head * 64;
      yo[v0] = ym0; yo[v1] = ym1;
    }
    if (c + 1 < nch) RW_WRITE((c + 1) & 1);
    __syncthreads();
  }
#undef RW_LOAD
#undef RW_WRITE
  if (seq < 32) {
    float* sp = p.out + O_RW + ((((size_t)seq * 4 + l) * 2 + dir) * 4 + head) * 4096 + ks * 4;
    *(float4*)(sp + v0 * 64) = S0; *(float4*)(sp + v1 * 64) = S1;
  }
}

DEV void hgrn_scan(const Params& p, int l, int seq, int head, int dir, int rp, char* lds) {
  const int t = tid(), rl = t >> 4, ks = t & 15;
  const int T = seq < 32 ? 256 : 1024;
  const int row0 = seq < 32 ? seq * 256 : NCTX + (seq - 32) * 1024;
  const bf16_t* P = (const bf16_t*)(p.ws + OFF_P);
  float* odir = (float*)(p.ws + OFF_HDIR) + (size_t)dir * ARRF;
  const float4 lb4 = *(const float4*)((const float*)(p.ws + OFF_HGLB) + (l * 2 + dir) * 256 + head * 64 + ks * 4);
  const int v0 = rp * 32 + rl, v1 = v0 + 16;
  float4 S0 = make_float4(0.f, 0.f, 0.f, 0.f), S1 = S0;
  if (seq >= 32) {
    const float* sp = p.in[I_SHG] + ((((size_t)(seq - 32) * 4 + l) * 2 + dir) * 4 + head) * 4096;
    S0.x = sp[(ks * 4 + 0) * 64 + v0]; S0.y = sp[(ks * 4 + 1) * 64 + v0]; S0.z = sp[(ks * 4 + 2) * 64 + v0]; S0.w = sp[(ks * 4 + 3) * 64 + v0];
    S1.x = sp[(ks * 4 + 0) * 64 + v1]; S1.y = sp[(ks * 4 + 1) * 64 + v1]; S1.z = sp[(ks * 4 + 2) * 64 + v1]; S1.w = sp[(ks * 4 + 3) * 64 + v1];
  }
  const int nch = T >> 4;
  const int fcol = (dir ? C_HFB : C_HFF) + head * 64;
  uint2 pq, pf; bf16_t pva, pvb;
#define HG_LOAD(cc) do { const int s_ = (cc) * 16 + rl; const int tok_ = dir ? (T - 1 - s_) : s_; \
    const bf16_t* pr_ = P + (size_t)(row0 + tok_) * DIN; \
    pq = *(const uint2*)(pr_ + C_HQ + head * 64 + ks * 4); pf = *(const uint2*)(pr_ + fcol + ks * 4); \
    pva = pr_[C_HI + head * 64 + rp * 32 + ks]; pvb = pr_[C_HI + head * 64 + rp * 32 + 16 + ks]; } while (0)
#define HG_WRITE(bb) do { float4* sb_ = (float4*)(lds + (bb) * SC_BUF); float* vb_ = (float*)(lds + (bb) * SC_BUF + 20480); \
    float4 q_, f_, k_; float a_, sg_; \
    a_ = bflo(pq.x); q_.x = a_ * sigmoidf_(a_); a_ = bfhi(pq.x); q_.y = a_ * sigmoidf_(a_); \
    a_ = bflo(pq.y); q_.z = a_ * sigmoidf_(a_); a_ = bfhi(pq.y); q_.w = a_ * sigmoidf_(a_); \
    sg_ = sigmoidf_(bflo(pf.x)); f_.x = lb4.x + (1.f - lb4.x) * sg_; k_.x = (1.f - lb4.x) * (1.f - sg_); \
    sg_ = sigmoidf_(bfhi(pf.x)); f_.y = lb4.y + (1.f - lb4.y) * sg_; k_.y = (1.f - lb4.y) * (1.f - sg_); \
    sg_ = sigmoidf_(bflo(pf.y)); f_.z = lb4.z + (1.f - lb4.z) * sg_; k_.z = (1.f - lb4.z) * (1.f - sg_); \
    sg_ = sigmoidf_(bfhi(pf.y)); f_.w = lb4.w + (1.f - lb4.w) * sg_; k_.w = (1.f - lb4.w) * (1.f - sg_); \
    sb_[(0 * 16 + rl) * 16 + ks] = q_; sb_[(1 * 16 + rl) * 16 + ks] = f_; sb_[(2 * 16 + rl) * 16 + ks] = k_; \
    vb_[rl * 32 + ks] = bf2f(pva); vb_[rl * 32 + 16 + ks] = bf2f(pvb); } while (0)
  __syncthreads();
  HG_LOAD(0); HG_WRITE(0);
  __syncthreads();
  for (int c = 0; c < nch; ++c) {
    if (c + 1 < nch) HG_LOAD(c + 1);
    const float4* sbuf = (const float4*)(lds + (c & 1) * SC_BUF);
    const float* vbuf = (const float*)(lds + (c & 1) * SC_BUF + 20480);
    float ym0 = 0.f, ym1 = 0.f;
#pragma unroll
    for (int i = 0; i < 16; ++i) {
      const float4 q = sbuf[(0 * 16 + i) * 16 + ks], f = sbuf[(1 * 16 + i) * 16 + ks], k = sbuf[(2 * 16 + i) * 16 + ks];
      const float va = vbuf[i * 32 + rl], vb = vbuf[i * 32 + 16 + rl];
      S0.x = S0.x * f.x + k.x * va; S0.y = S0.y * f.y + k.y * va; S0.z = S0.z * f.z + k.z * va; S0.w = S0.w * f.w + k.w * va;
      S1.x = S1.x * f.x + k.x * vb; S1.y = S1.y * f.y + k.y * vb; S1.z = S1.z * f.z + k.z * vb; S1.w = S1.w * f.w + k.w * vb;
      const float y0 = row16_sum(dot4(S0, q)), y1 = row16_sum(dot4(S1, q));
      ym0 = (ks == i) ? y0 : ym0; ym1 = (ks == i) ? y1 : ym1;
    }
    {
      const int s = c * 16 + ks; const int tok = dir ? (T - 1 - s) : s;
      float* yo = odir + (size_t)(row0 + tok) * 256 + head * 64;
      yo[v0] = ym0; yo[v1] = ym1;
    }
    if (c + 1 < nch) HG_WRITE((c + 1) & 1);
    __syncthreads();
  }
#undef HG_LOAD
#undef HG_WRITE
  if (seq < 32) {
    float* sp = p.out + O_HG + ((((size_t)seq * 4 + l) * 2 + dir) * 4 + head) * 4096;
    sp[(ks * 4 + 0) * 64 + v0] = S0.x; sp[(ks * 4 + 1) * 64 + v0] = S0.y; sp[(ks * 4 + 2) * 64 + v0] = S0.z; sp[(ks * 4 + 3) * 64 + v0] = S0.w;
    sp[(ks * 4 + 0) * 64 + v1] = S1.x; sp[(ks * 4 + 1) * 64 + v1] = S1.y; sp[(ks * 4 + 2) * 64 + v1] = S1.z; sp[(ks * 4 + 3) * 64 + v1] = S1.w;
  }
}

template <int MODE>
DEV void attn_item(const Params& p, int l, int item, char* lds) {
  const int t = tid(), lane = t & 63, w = t >> 6, q = lane & 31, hh = lane >> 5;
  const bf16_t* P = (const bf16_t*)(p.ws + OFF_P);
  bf16_t* Y = (bf16_t*)(p.ws + OFF_YMIX);
  char* sK = lds;
  char* sV = lds + 8192;
  float* sBias = (float*)(lds + 8192 + 8704);
  int head, qrow, qcol, kcol, vcol, ocol, nloc, nt, rowbaseP;
  int qr = 0, qc = 0, rlo = 0, qpos = 0, lo = 0, rsq = 0, wsq = 0;
  float sink = 0.f;
  const float* cache = nullptr; int cH = 1, cHead = 0;
  if (MODE == 0 || MODE == 1) {
    const int b = item >> 3; head = (item >> 1) & 3; const int half = item & 1;
    rowbaseP = b * 256; qrow = rowbaseP + half * 128 + w * 32 + q; nloc = 4; nt = 4;
  } else {
    const int b = item >> 5; head = (item >> 3) & 3; const int sub = item & 7;
    rowbaseP = NCTX + b * 1024;
    if (MODE == 2) {
      qr = 2 * sub + (w >> 1); qc = (w & 1) * 32 + q; qrow = rowbaseP + qr * 64 + qc;
      rlo = clampi(2 * sub - 4, 0, 8); const int rhi = clampi(2 * sub - 3, 0, 8) + 7; nloc = rhi - rlo + 1; nt = nloc + 4;
      rsq = clampi(qr - 4, 0, 8); wsq = clampi(qc - 8, 0, 48);
      cache = p.in[I_CNAT] + (size_t)((b * 4 + l) * 2) * 256 * 256; cH = 4; cHead = head;
      for (int i = t; i < 465; i += 256) sBias[i] = p.in[I_RPB][(size_t)(l * 4 + head) * 465 + i];
    } else {
      qpos = sub * 128 + w * 32 + q; qrow = rowbaseP + qpos;
      lo = (sub - 1) * 128;
      nloc = 6; nt = nloc + 4;
      cache = p.in[I_CSWA] + (size_t)((b * 4 + l) * 2) * 256 * 128; cH = 2; cHead = head >> 1;
    }
  }
  if (MODE == 0 || MODE == 2) { qcol = C_NQ + head * 64; kcol = C_NK + head * 64; vcol = C_NV + head * 64; ocol = 256 + head * 64; }
  else { qcol = C_SQ + head * 64; kcol = C_SK + (head >> 1) * 64; vcol = C_SV + (head >> 1) * 64; ocol = 768 + head * 64; sink = p.in[I_SINK][l * 4 + head]; }

  bf16x8 bq[4];
#pragma unroll
  for (int s = 0; s < 4; ++s) bq[s] = *(const bf16x8*)(P + (size_t)qrow * DIN + qcol + 16 * s + 8 * hh);
  f32x16 oacc[2];
#pragma unroll
  for (int r = 0; r < 16; ++r) { oacc[0][r] = 0.f; oacc[1][r] = 0.f; }
  float m_run = -1e30f, l_run = 0.f;
  const int key = t >> 2, dq = t & 3;
  const int kswz = (key >> 1) & 7;
  for (int j = 0; j < nt; ++j) {
    uint4 kr[2], vr[2];
    const bool isP = j < nloc;
    int keybase = 0;
    if (isP) {
      if (MODE == 0 || MODE == 1) keybase = rowbaseP + j * 64;
      else if (MODE == 2) keybase = rowbaseP + (rlo + j) * 64;
      else keybase = rowbaseP + lo + j * 64;
      int krow = keybase + key;
      if (MODE == 3) krow = rowbaseP + clampi(lo + j * 64 + key, 0, 1023);
      const bf16_t* kp = P + (size_t)krow * DIN + kcol + dq * 16;
      const bf16_t* vp = P + (size_t)krow * DIN + vcol + dq * 16;
      kr[0] = *(const uint4*)kp; kr[1] = *(const uint4*)(kp + 8);
      vr[0] = *(const uint4*)vp; vr[1] = *(const uint4*)(vp + 8);
    } else {
      const int ct = (j - nloc) * 64 + key;
      const float* kp = cache + ((size_t)ct * cH + cHead) * 64 + dq * 16;
      const float* vp = kp + (size_t)256 * cH * 64;
      const float4 k0 = *(const float4*)kp, k1 = *(const float4*)(kp + 4), k2 = *(const float4*)(kp + 8), k3 = *(const float4*)(kp + 12);
      const float4 v0 = *(const float4*)vp, v1 = *(const float4*)(vp + 4), v2 = *(const float4*)(vp + 8), v3 = *(const float4*)(vp + 12);
      kr[0].x = pk2(k0.x, k0.y); kr[0].y = pk2(k0.z, k0.w); kr[0].z = pk2(k1.x, k1.y); kr[0].w = pk2(k1.z, k1.w);
      kr[1].x = pk2(k2.x, k2.y); kr[1].y = pk2(k2.z, k2.w); kr[1].z = pk2(k3.x, k3.y); kr[1].w = pk2(k3.z, k3.w);
      vr[0].x = pk2(v0.x, v0.y); vr[0].y = pk2(v0.z, v0.w); vr[0].z = pk2(v1.x, v1.y); vr[0].w = pk2(v1.z, v1.w);
      vr[1].x = pk2(v2.x, v2.y); vr[1].y = pk2(v2.z, v2.w); vr[1].z = pk2(v3.x, v3.y); vr[1].w = pk2(v3.z, v3.w);
    }
    __syncthreads();
    *(uint4*)(sK + key * 128 + (((dq * 2 + 0) ^ kswz) << 4)) = kr[0];
    *(uint4*)(sK + key * 128 + (((dq * 2 + 1) ^ kswz) << 4)) = kr[1];
    {
      bf16_t* vt = (bf16_t*)sV;
      const unsigned vv[8] = {vr[0].x, vr[0].y, vr[0].z, vr[0].w, vr[1].x, vr[1].y, vr[1].z, vr[1].w};
#pragma unroll
      for (int e = 0; e < 8; ++e) {
        vt[(dq * 16 + 2 * e) * 68 + key] = (bf16_t)(vv[e] & 0xffffu);
        vt[(dq * 16 + 2 * e + 1) * 68 + key] = (bf16_t)(vv[e] >> 16);
      }
    }
    __syncthreads();
    f32x16 sacc[2];
#pragma unroll
    for (int r = 0; r < 16; ++r) { sacc[0][r] = 0.f; sacc[1][r] = 0.f; }
    const int qswz = (q >> 1) & 7;
#pragma unroll
    for (int s = 0; s < 4; ++s) {
      const int co = (((s * 2 + hh) ^ qswz) << 4);
      const bf16x8 a0 = *(const bf16x8*)(sK + q * 128 + co);
      const bf16x8 a1 = *(const bf16x8*)(sK + (32 + q) * 128 + co);
      sacc[0] = MFMA32(a0, bq[s], sacc[0]);
      sacc[1] = MFMA32(a1, bq[s], sacc[1]);
    }
    float mx = -1e30f;
#pragma unroll
    for (int sub = 0; sub < 2; ++sub)
#pragma unroll
      for (int r = 0; r < 16; ++r) {
        const int kidx = sub * 32 + (r & 3) + 8 * (r >> 2) + 4 * hh;
        float v = sacc[sub][r] * 0.125f;
        bool ok = true;
        if (MODE == 2 && isP) {
          const int kr_ = rlo + j, kc_ = kidx;
          ok = (kr_ >= rsq) && (kr_ < rsq + 8) && (kc_ >= wsq) && (kc_ < wsq + 16);
          const int bi = ok ? ((kr_ - qr + 7) * 31 + (kc_ - qc + 15)) : 0;
          v += sBias[bi];
        }
        if (MODE == 3 && isP) {
          const int kpos = lo + j * 64 + kidx, dlt = kpos - qpos;
          ok = (dlt <= 128) && (dlt >= -128) && (kpos >= 0) && (kpos < 1024);
        }
        v = ok ? v : -1e30f;
        sacc[sub][r] = v;
        mx = fmaxf(mx, v);
      }
    mx = fmaxf(mx, __shfl_xor(mx, 32));
    const float m_new = fmaxf(m_run, mx);
    const float alpha = __expf(m_run - m_new);
    float rsum = 0.f;
#pragma unroll
    for (int sub = 0; sub < 2; ++sub)
#pragma unroll
      for (int r = 0; r < 16; ++r) {
        const float v = sacc[sub][r];
        const float pv = (v > -1e29f) ? __expf(v - m_new) : 0.f;
        sacc[sub][r] = pv; rsum += pv;
      }
    rsum += __shfl_xor(rsum, 32);
    l_run = l_run * alpha + rsum; m_run = m_new;
#pragma unroll
    for (int r = 0; r < 16; ++r) { oacc[0][r] *= alpha; oacc[1][r] *= alpha; }
#pragma unroll
    for (int k4 = 0; k4 < 4; ++k4) {
      const int sub = k4 >> 1, s2 = k4 & 1;
      uint4 pbu;
      pbu.x = pk2(sacc[sub][8 * s2 + 0], sacc[sub][8 * s2 + 1]); pbu.y = pk2(sacc[sub][8 * s2 + 2], sacc[sub][8 * s2 + 3]);
      pbu.z = pk2(sacc[sub][8 * s2 + 4], sacc[sub][8 * s2 + 5]); pbu.w = pk2(sacc[sub][8 * s2 + 6], sacc[sub][8 * s2 + 7]);
      const bf16x8 pb = __builtin_bit_cast(bf16x8, pbu);
#pragma unroll
      for (int dt = 0; dt < 2; ++dt) {
        const char* vp = sV + (dt * 32 + q) * 136 + (16 * k4 + 4 * hh) * 2;
        const uint2 lo8 = *(const uint2*)vp, hi8 = *(const uint2*)(vp + 16);
        uint4 avu; avu.x = lo8.x; avu.y = lo8.y; avu.z = hi8.x; avu.w = hi8.y;
        oacc[dt] = MFMA32(__builtin_bit_cast(bf16x8, avu), pb, oacc[dt]);
      }
    }
  }
  float scale;
  if (MODE == 1 || MODE == 3) {
    const float m_f = fmaxf(m_run, sink);
    const float e = __expf(m_run - m_f);
    scale = e / (l_run * e + __expf(sink - m_f));
  } else scale = 1.0f / l_run;
#pragma unroll
  for (int dt = 0; dt < 2; ++dt)
#pragma unroll
    for (int g4 = 0; g4 < 4; ++g4) {
      const int d = dt * 32 + 8 * g4 + 4 * hh;
      uint2 o; o.x = pk2(oacc[dt][4 * g4] * scale, oacc[dt][4 * g4 + 1] * scale); o.y = pk2(oacc[dt][4 * g4 + 2] * scale, oacc[dt][4 * g4 + 3] * scale);
      *(uint2*)(Y + (size_t)qrow * D + ocol + d) = o;
    }
  __syncthreads();
}

DEV void post_item(const Params& p, int l, int tile, char* lds) {
  const int t = tid(), r0 = tile * TOKT, c = t;
  float* sT = (float*)lds;
  float* sgo = sT + 128 * TOKT;
  const bf16_t* P = (const bf16_t*)(p.ws + OFF_P);
  bf16_t* Y = (bf16_t*)(p.ws + OFF_YMIX);
  const float* Y0 = (const float*)(p.ws + OFF_YDIR); const float* Y1 = Y0 + ARRF;
  const float* H0 = (const float*)(p.ws + OFF_HDIR); const float* H1 = H0 + ARRF;
  const float* BON = (const float*)(p.ws + OFF_BONUS);
  __syncthreads();
#pragma unroll
  for (int i = 0; i < TOKT / 2; ++i) {
    const int e = t + 256 * i, tk = e >> 7, j = e & 127;
    sT[j * TOKT + tk] = sigmoidf_(bf2f(P[(size_t)(r0 + tk) * DIN + C_GH + j]));
  }
  __syncthreads();
  {
    const float* g2p = p.in[I_G2] + (size_t)l * 128 * 256 + c;
    float ag[TOKT];
#pragma unroll
    for (int k = 0; k < TOKT; ++k) ag[k] = 0.f;
#pragma unroll 4
    for (int j = 0; j < 128; ++j) {
      const float gj = g2p[j * 256];
#pragma unroll
      for (int k4 = 0; k4 < TOKT / 4; ++k4) {
        const float4 s4 = *(const float4*)(sT + j * TOKT + k4 * 4);
        ag[k4 * 4 + 0] += s4.x * gj; ag[k4 * 4 + 1] += s4.y * gj; ag[k4 * 4 + 2] += s4.z * gj; ag[k4 * 4 + 3] += s4.w * gj;
      }
    }
#pragma unroll
    for (int k = 0; k < TOKT; ++k) sgo[k * 256 + c] = ag[k];
  }
  const float lnw = p.in[I_LNW][l * 256 + c], lnb = p.in[I_LNB][l * 256 + c], hgn = p.in[I_HGN][l * 256 + c];
#pragma unroll 4
  for (int tk = 0; tk < TOKT; ++tk) {
    const int row = r0 + tk;
    const size_t idx = (size_t)row * 256 + c;
    const float y = Y0[idx] + Y1[idx];
    const float mu = wave_sum(y) * (1.0f / 64.0f);
    const float dy = y - mu;
    const float var = wave_sum(dy * dy) * (1.0f / 64.0f);
    const float yn = dy * rsqrtf(var + 64e-5f) * lnw + lnb + BON[idx];
    const float g = sgo[tk * 256 + c];
    Y[(size_t)row * D + c] = f2bf(yn * g);
    const float o = H0[idx] + H1[idx];
    const float ms = wave_sum(o * o) * (1.0f / 64.0f);
    const float gt = sigmoidf_(bf2f(P[(size_t)row * DIN + C_HG + c]));
    Y[(size_t)row * D + 512 + c] = f2bf(o * rsqrtf(ms + 1e-6f) * hgn * gt);
  }
  __syncthreads();
}

constexpr int OFF_CTR_WORD = 3600;
DEV void mixer_phase(const Params& p, int l, char* lds0, volatile LAS unsigned* st) {
  const int hf = half_id(); char* lds = lds0 + hf * 65536;
  const int npairs = (192 + 1024 + 512) / 2;
  unsigned* ctr = (unsigned*)(p.ws + OFF_BAR) + OFF_CTR_WORD + 64 * l;
  for (;;) {
    if (threadIdx.x == 0) st[4] = __hip_atomic_fetch_add(ctr, 1u, __ATOMIC_RELAXED, __HIP_MEMORY_SCOPE_AGENT);
    __syncthreads();
    const int pair = (int)st[4];
    __syncthreads();
    if (pair >= npairs) break;
    const int it = pair * 2 + hf;
    int kind, idx;
    if (it < 32) { kind = 0; idx = 512 + it; }
    else if (it < 64) { kind = 1; idx = 512 + it - 32; }
    else if (it < 128) { kind = 5; idx = it - 64; }
    else if (it < 192) { kind = 4; idx = it - 128; }
    else if (it < 704) { kind = 0; idx = it - 192; }
    else if (it < 1216) { kind = 1; idx = it - 704; }
    else if (it < 1472) { kind = 2; idx = it - 1216; }
    else { kind = 3; idx = it - 1472; }
    if (kind < 2) {
      const int seq = idx >> 4, rem = idx & 15;
      if (kind == 0) rwkv_scan(p, l, seq, rem >> 2, (rem >> 1) & 1, rem & 1, lds);
      else hgrn_scan(p, l, seq, rem >> 2, (rem >> 1) & 1, rem & 1, lds);
    } else if (kind == 2) attn_item<0>(p, l, idx, lds);
    else if (kind == 3) attn_item<1>(p, l, idx, lds);
    else if (kind == 4) attn_item<2>(p, l, idx, lds);
    else attn_item<3>(p, l, idx, lds);
  }
}

DEV void run_phase(const Params& p, int ph, char* lds, bool rerun, volatile LAS unsigned* st) {
  if (ph == 0) { phase0(p, lds); return; }
  if (ph == 1) { row_phase(p, 0, 0); return; }
  const int l = (ph - 2) / 9, s = (ph - 2) % 9;
  const bf16_t* H = (const bf16_t*)(p.ws + OFF_H);
  const int hf = half_id(); char* ldsh = lds + hf * 65536;
  switch (s) {
    case 0: gemm_run<0>(p, l, H, (const bf16_t*)(p.ws + OFF_WIN) + (size_t)l * DINP * D, D, DINP, lds); break;
    case 1:
      for (int it = blockIdx.x * 2 + hf; it < 512 + 32; it += gridDim.x * 2) { if (it < 512) prep_item(p, l, it, ldsh); else if (!rerun) rope_item(p, it - 512); }
      break;
    case 2: mixer_phase(p, l, lds, st); break;
    case 3: for (int it = blockIdx.x * 2 + hf; it < 512; it += gridDim.x * 2) post_item(p, l, it, ldsh); break;
    case 4: gemm_run<1>(p, l, (const bf16_t*)(p.ws + OFF_YMIX), (const bf16_t*)(p.ws + OFF_WOUT) + (size_t)l * D * D, D, D, lds); break;
    case 5: row_phase(p, 1, l); break;
    case 6: gemm_run<2>(p, l, H, (const bf16_t*)(p.ws + OFF_W1) + (size_t)l * FF * D, D, FF, lds); break;
    case 7: gemm_run<1>(p, l, (const bf16_t*)(p.ws + OFF_HID), (const bf16_t*)(p.ws + OFF_W2) + (size_t)l * D * FF, FF, D, lds); break;
    case 8: row_phase(p, 2, l); break;
  }
}

#define XB_TMO      128
#define XB_XCNT(j)  (256  + 64 * (j))
#define XB_XSUB(j)  (1280 + 64 * (j))
#define XB_XGEN(j)  (2304 + 64 * (j))
#define XB_TOP      3328
#define XB_TOPGEN   3392
#define XCD_BAR_WORDS 3456
#define XB_SPIN_CAP (1u << 18)
DEV unsigned xb_ld(unsigned* p) { return __hip_atomic_load(p, __ATOMIC_RELAXED, __HIP_MEMORY_SCOPE_AGENT); }
DEV unsigned xb_add(unsigned* p, unsigned v) { return __hip_atomic_fetch_add(p, v, __ATOMIC_RELAXED, __HIP_MEMORY_SCOPE_AGENT); }
DEV unsigned xb_xcc_id() { return (unsigned)__builtin_amdgcn_s_getreg((3 << 11) | 20) & 0xFu; }
#define XB_SPIN(cond, bar) do { unsigned _sp = 0; while (cond) { __builtin_amdgcn_s_sleep(1); \
    if ((++_sp & 255u) == 0u) { if (xb_ld(&(bar)[XB_TMO])) break; if (_sp > XB_SPIN_CAP) { atomicAdd(&(bar)[XB_TMO], 1u); break; } } } } while (0)
struct XcdBarrier { unsigned* bar; unsigned x; volatile LAS unsigned* st; };
DEV XcdBarrier xcd_barrier_post(unsigned* bar, volatile LAS unsigned* st) {
  XcdBarrier b; b.bar = bar; b.x = xb_xcc_id(); b.st = st;
  if (threadIdx.x == 0) (void)xb_add(&bar[XB_XCNT(b.x)], 1u);
  return b;
}
DEV void xcd_barrier_complete(unsigned* bar, unsigned x, unsigned& nloc, unsigned& nx) {
  const unsigned G = gridDim.x * gridDim.y * gridDim.z;
  unsigned sum, cnt, mine, sp = 0u;
  for (;;) {
    sum = 0u; cnt = 0u; mine = 0u;
#pragma unroll
    for (unsigned j = 0; j < 16; ++j) { const unsigned c = xb_ld(&bar[XB_XCNT(j)]); sum += c; cnt += (c > 0u) ? 1u : 0u; mine = (j == x) ? c : mine; }
    if (sum == G) break;
    __builtin_amdgcn_s_sleep(1);
    if ((++sp & 255u) == 0u) { if (xb_ld(&bar[XB_TMO])) break; if (sp > XB_SPIN_CAP) { atomicAdd(&bar[XB_TMO], 1u); break; } }
  }
  nloc = mine > 0u ? mine : 1u; nx = cnt > 0u ? cnt : 1u;
}
DEV void xcd_barrier(const XcdBarrier& b) {
  asm volatile("s_waitcnt vmcnt(0)" ::: "memory");
  __syncthreads();
  if (threadIdx.x == 0) {
    unsigned* bar = b.bar;
    __builtin_amdgcn_s_waitcnt(0);
    unsigned nloc = b.st[0], nx = b.st[1];
    if (nloc == 0u) { xcd_barrier_complete(bar, b.x, nloc, nx); b.st[0] = nloc; b.st[1] = nx; }
    const unsigned old = xb_add(&bar[XB_XSUB(b.x)], 1u);
    const unsigned gen = old / nloc;
    if (old + 1u == (gen + 1u) * nloc) {
      __builtin_amdgcn_fence(__ATOMIC_RELEASE, "agent");
      asm volatile("s_waitcnt vmcnt(0)" ::: "memory");
      const unsigned og = xb_add(&bar[XB_TOP], 1u);
      const unsigned tg = og / nx;
      if (og + 1u == (tg + 1u) * nx) xb_add(&bar[XB_TOPGEN], 1u);
      else XB_SPIN(xb_ld(&bar[XB_TOPGEN]) == tg, bar);
      __builtin_amdgcn_fence(__ATOMIC_ACQUIRE, "agent");
      xb_add(&bar[XB_XGEN(b.x)], 1u);
      asm volatile("s_waitcnt vmcnt(0)" ::: "memory");
    } else {
      XB_SPIN(xb_ld(&bar[XB_XGEN(b.x)]) == gen, bar);
      __builtin_amdgcn_fence(__ATOMIC_ACQUIRE, "agent");
      asm volatile("s_waitcnt vmcnt(0)" ::: "memory");
    }
  }
  __syncthreads();
}

DEV int phase_kind(int ph) {
  if (ph == 0) return 0;
  if (ph == 1) return 1;
  const int s = (ph - 2) % 9;
  return s == 0 ? 2 : s == 1 ? 3 : s == 2 ? 4 : s == 3 ? 5 : s == 4 ? 6 : s == 5 ? 1 : s == 6 ? 7 : s == 7 ? 8 : 1;
}

constexpr int LDS_BYTES = 131072 + 64;

__global__ void __launch_bounds__(512, 2) mega(Params p, int ph_lo, int ph_hi) {
  extern __shared__ __attribute__((aligned(16))) unsigned char smem[];
  char* lds = (char*)smem;
  volatile LAS unsigned* st = (volatile LAS unsigned*)((LAS unsigned char*)smem + 131072);
  if (threadIdx.x == 0) { st[0] = 0u; st[1] = 0u; }
  __syncthreads();
  XcdBarrier xb = xcd_barrier_post((unsigned*)(p.ws + OFF_BAR), st);
  if (ph_hi < 0) cg::this_grid().sync();
  for (int ph = ph_lo; ph < ph_hi; ++ph) {
    run_phase(p, ph, lds, false, st);
    if (PROBE_KIND >= 0 && (PROBE_KIND == 9 || phase_kind(ph) == PROBE_KIND)) {
      xcd_barrier(xb);
      if (PROBE_KIND != 9) run_phase(p, ph, lds, true, st);
    }
    if (ph + 1 < ph_hi) xcd_barrier(xb);
  }
}

extern "C" void kernel_launch(void* const* d_in, const int* in_sizes, int n_in, void* d_out, int out_size, void* d_ws, size_t ws_size,
                              hipStream_t stream) {
  static int grid_blocks = 0;
  if (!grid_blocks) {
    int dev = 0, cus = 0, per_cu = 0;
    (void)hipGetDevice(&dev);
    (void)hipDeviceGetAttribute(&cus, hipDeviceAttributeMultiprocessorCount, dev);
    if (hipFuncSetAttribute((const void*)mega, hipFuncAttributeMaxDynamicSharedMemorySize, LDS_BYTES) != hipSuccess) fprintf(stderr, "hipFuncSetAttribute failed\n");
    (void)hipOccupancyMaxActiveBlocksPerMultiprocessor(&per_cu, mega, 512, LDS_BYTES);
    if (per_cu < 1) fprintf(stderr, "occupancy query reports %d blocks per CU\n", per_cu);
    (void)hipGetLastError();
    grid_blocks = cus;
  }
  if (ws_size < WS_TOTAL) { fprintf(stderr, "workspace too small: %zu < %zu\n", ws_size, (size_t)WS_TOTAL); return; }
  Params p{};
  for (int i = 0; i < 31; ++i) p.in[i] = (const float*)d_in[i];
  p.out = (float*)d_out;
  p.ws = (char*)d_ws;
  (void)hipMemsetAsync((char*)d_ws + OFF_BAR, 0, 16384, stream);
  int lo = 0, hi = NPH;
  void* args[] = {&p, &lo, &hi};
  hipError_t e = hipLaunchCooperativeKernel((void*)mega, dim3(grid_blocks), dim3(512), args, LDS_BYTES, stream);
  if (e != hipSuccess) fprintf(stderr, "cooperative launch failed: %s (grid %d)\n", hipGetErrorString(e), grid_blocks);
}
```

```cpp
#include <hip/hip_runtime.h>
#include <hip/hip_cooperative_groups.h>
#include <cstdio>
#include <cstdint>
namespace cg = cooperative_groups;

#ifndef ONE_LAUNCH
#define ONE_LAUNCH 1
#endif
#define PROBE_KIND -1
#define PROBE_SUB 0

#define DEV __device__ __forceinline__
#define LAS __attribute__((address_space(3)))
typedef unsigned short bf16_t;
typedef short bf16x8 __attribute__((ext_vector_type(8)));
typedef float f32x16 __attribute__((ext_vector_type(16)));
typedef __bf16 bf2_t __attribute__((ext_vector_type(2)));
typedef float f2_t __attribute__((ext_vector_type(2)));

constexpr int D = 1024, DIN = 3712, FF = 4096, NCTX = 8192, MT = 10240;
constexpr int NPH = 38;
constexpr int DINP = 3840;
constexpr int C_R = 0, C_K = 256, C_V = 512, C_GH = 768, C_WHF = 896, C_WHB = 1024;
constexpr int C_NQ = 1152, C_NK = 1408, C_NV = 1664;
constexpr int C_HQ = 1920, C_HI = 2176, C_HG = 2432, C_HFF = 2688, C_HFB = 2944;
constexpr int C_SQ = 3200, C_SK = 3456, C_SV = 3584;
constexpr size_t O_NAT = 10485760, O_SWA = 27262976, O_RW = 35651584, O_HG = 39845888;
constexpr size_t ARRF = (size_t)MT * 256;
constexpr size_t ARR = ARRF * 4;
constexpr size_t OFF_WIN = 0;
constexpr size_t OFF_WOUT = OFF_WIN + (size_t)4 * DINP * D * 2;
constexpr size_t OFF_W1 = OFF_WOUT + (size_t)4 * D * D * 2;
constexpr size_t OFF_W2 = OFF_W1 + (size_t)4 * FF * D * 2;
constexpr size_t OFF_MOD = OFF_W2 + (size_t)4 * FF * D * 2;
constexpr size_t OFF_HGLB = OFF_MOD + (size_t)4 * 3 * 6144 * 4;
constexpr size_t OFF_P = OFF_HGLB + 8192;
constexpr size_t OFF_R1 = OFF_P + (size_t)MT * DIN * 2;
constexpr size_t OFF_H = OFF_R1;
constexpr size_t OFF_HID = OFF_H + (size_t)MT * D * 2;
constexpr size_t OFF_U = OFF_HID + (size_t)MT * FF * 2;
constexpr size_t OFF_PREP = OFF_R1;
constexpr size_t OFF_YDIR = OFF_PREP + 12 * ARR;
constexpr size_t OFF_BONUS = OFF_R1 + 14 * ARR;
constexpr size_t OFF_HDIR = OFF_BONUS + ARR;
constexpr size_t OFF_YMIX = OFF_HDIR + 2 * ARR;
constexpr size_t OFF_BAR = OFF_YMIX + (size_t)MT * D * 2;
constexpr size_t WS_TOTAL = OFF_BAR + 16384;
static_assert(OFF_U + (size_t)MT * D * 4 == OFF_BONUS, "R1 layout");

struct Params {
  const float* in[31];
  float* out;
  char* ws;
};
enum { I_XP = 0, I_XS, I_CNAT, I_CSWA, I_SRW, I_SHG, I_C, I_CCTX, I_NORMG, I_MODW, I_MODB, I_WIN, I_WOUT, I_MURKV, I_MULORA,
       I_W0, I_W2, I_A0, I_A2, I_G2, I_KK, I_KA, I_RK, I_LNW, I_LNB, I_RPB, I_HGLB, I_HGN, I_SINK, I_FW1, I_FW2 };

DEV bf16_t f2bf(float f) { unsigned u = __float_as_uint(f); u += 0x7fffu + ((u >> 16) & 1u); return (bf16_t)(u >> 16); }
DEV float bf2f(bf16_t h) { return __uint_as_float(((unsigned)h) << 16); }
DEV unsigned pk2(float a, float b) { f2_t v = {a, b}; bf2_t r = __builtin_convertvector(v, bf2_t); return __builtin_bit_cast(unsigned, r); }
DEV float bflo(unsigned u) { return __uint_as_float(u << 16); }
DEV float bfhi(unsigned u) { return __uint_as_float(u & 0xffff0000u); }
DEV float rcpf_(float x) { return __builtin_amdgcn_rcpf(x); }
DEV float sigmoidf_(float x) { return rcpf_(1.0f + __expf(-x)); }
DEV float tanhf_(float x) { return 1.0f - 2.0f * rcpf_(1.0f + __expf(2.0f * x)); }
template <int CTRL> DEV float dppf(float x) { return __int_as_float(__builtin_amdgcn_update_dpp(0, __float_as_int(x), CTRL, 0xF, 0xF, false)); }
DEV float row16_sum(float x) { x += dppf<0xB1>(x); x += dppf<0x4E>(x); x += dppf<0x141>(x); x += dppf<0x140>(x); return x; }
DEV float wave_sum(float x) { x = row16_sum(x); x += __shfl_xor(x, 16); x += __shfl_xor(x, 32); return x; }
DEV int clampi(int v, int lo, int hi) { return v < lo ? lo : (v > hi ? hi : v); }
#define MFMA32(a, b, c) __builtin_amdgcn_mfma_f32_32x32x16_bf16((a), (b), (c), 0, 0, 0)

DEV int tid() { int z; asm volatile("v_mov_b32 %0, 0" : "=v"(z)); return (int)(threadIdx.x & 255u) + z; }
DEV int half_id() { return __builtin_amdgcn_readfirstlane((int)(threadIdx.x >> 8)); }
DEV void transpose_item(const float* W, bf16_t* WT, int K, int N, int kt, int nt, char* lds) {
  bf16_t* s = (bf16_t*)lds;
  const int t = tid();
#pragma unroll
  for (int i = 0; i < 4; ++i) {
    const int k = (t >> 4) + 16 * i, n4 = (t & 15) * 4;
    const float4 v = *(const float4*)(W + (size_t)(kt * 64 + k) * N + nt * 64 + n4);
    s[(n4 + 0) * 72 + k] = f2bf(v.x); s[(n4 + 1) * 72 + k] = f2bf(v.y);
    s[(n4 + 2) * 72 + k] = f2bf(v.z); s[(n4 + 3) * 72 + k] = f2bf(v.w);
  }
  __syncthreads();
#pragma unroll
  for (int i = 0; i < 2; ++i) {
    const int n = (t >> 3) + 32 * i, kc = t & 7;
    const uint4 v = *(const uint4*)(s + n * 72 + kc * 8);
    *(uint4*)(WT + (size_t)(nt * 64 + n) * K + kt * 64 + kc * 8) = v;
  }
  __syncthreads();
}

DEV void mod_item(const Params& p, int l, int jb, char* lds) {
  float* sc = (float*)lds;
  float* red = (float*)(lds + 12288);
  const int t = tid();
  for (int i = t; i < 3072; i += 256) {
    const int c = i >> 10, k = i & 1023;
    const float x = (c == 0) ? p.in[I_CCTX][k] : p.in[I_C][(c - 1) * 1024 + k];
    sc[i] = x * rcpf_(1.0f + __expf(-x));
  }
  __syncthreads();
  const int c4 = t & 15, ks = t >> 4;
  const float* wp = p.in[I_MODW] + ((size_t)l * 1024 + ks * 64) * 6144 + jb * 64 + c4 * 4;
  float a00 = 0, a01 = 0, a02 = 0, a03 = 0, a10 = 0, a11 = 0, a12 = 0, a13 = 0, a20 = 0, a21 = 0, a22 = 0, a23 = 0;
#pragma unroll 16
  for (int ii = 0; ii < 64; ++ii) {
    const float4 w = *(const float4*)(wp + (size_t)ii * 6144);
    const int k = ks * 64 + ii;
    const float s0 = sc[k], s1 = sc[1024 + k], s2 = sc[2048 + k];
    a00 += s0 * w.x; a01 += s0 * w.y; a02 += s0 * w.z; a03 += s0 * w.w;
    a10 += s1 * w.x; a11 += s1 * w.y; a12 += s1 * w.z; a13 += s1 * w.w;
    a20 += s2 * w.x; a21 += s2 * w.y; a22 += s2 * w.z; a23 += s2 * w.w;
  }
  float* r0 = red + (ks * 3 + 0) * 64 + c4 * 4; r0[0] = a00; r0[1] = a01; r0[2] = a02; r0[3] = a03;
  float* r1 = red + (ks * 3 + 1) * 64 + c4 * 4; r1[0] = a10; r1[1] = a11; r1[2] = a12; r1[3] = a13;
  float* r2 = red + (ks * 3 + 2) * 64 + c4 * 4; r2[0] = a20; r2[1] = a21; r2[2] = a22; r2[3] = a23;
  __syncthreads();
  if (t < 192) {
    const int c = t >> 6, col = t & 63;
    float v = p.in[I_MODB][l * 6144 + jb * 64 + col];
#pragma unroll
    for (int k2 = 0; k2 < 16; ++k2) v += red[(k2 * 3 + c) * 64 + col];
    ((float*)(p.ws + OFF_MOD))[(size_t)(l * 3 + c) * 6144 + jb * 64 + col] = v;
  }
  __syncthreads();
}

DEV void hglb_item(const Params& p) {
  const int c = tid();
  float* HGLB = (float*)(p.ws + OFF_HGLB);
  for (int dir = 0; dir < 2; ++dir) {
    float x[4], mx = -1e30f;
    for (int l = 0; l < 4; ++l) { x[l] = p.in[I_HGLB][(dir * 4 + l) * 256 + c]; mx = fmaxf(mx, x[l]); }
    float s = 0;
    for (int l = 0; l < 4; ++l) { x[l] = __expf(x[l] - mx); s += x[l]; }
    float cum = 0; const float s0 = x[0] / s;
    for (int l = 0; l < 4; ++l) { cum += x[l] / s; HGLB[(l * 2 + dir) * 256 + c] = cum - s0; }
  }
}

DEV void phase0(const Params& p, char* lds0) {
  const int hf = half_id(); char* lds = lds0 + hf * 65536;
  const int NT_WIN = 4 * 16 * 58, NT_WOUT = 4 * 16 * 16, NT_W1 = 4 * 16 * 64, NT_W2 = 4 * 64 * 16;
  const int nitems = 386 + NT_WIN + NT_WOUT + NT_W1 + NT_W2 + 4;
  for (int it = blockIdx.x * 2 + hf; it < nitems; it += gridDim.x * 2) {
    if (it < 384) { mod_item(p, it / 96, it % 96, lds); continue; }
    if (it == 384) { hglb_item(p); continue; }
    if (it == 385) continue;
    int j = it - 386;
    if (j < NT_WIN) { const int l = j / 928, r = j % 928;
      transpose_item(p.in[I_WIN] + (size_t)l * D * DIN, (bf16_t*)(p.ws + OFF_WIN) + (size_t)l * DINP * D, D, DIN, r / 58, r % 58, lds); continue; }
    j -= NT_WIN;
    if (j < NT_WOUT) { const int l = j / 256, r = j % 256;
      transpose_item(p.in[I_WOUT] + (size_t)l * D * D, (bf16_t*)(p.ws + OFF_WOUT) + (size_t)l * D * D, D, D, r / 16, r % 16, lds); continue; }
    j -= NT_WOUT;
    if (j < NT_W1) { const int l = j / 1024, r = j % 1024;
      transpose_item(p.in[I_FW1] + (size_t)l * D * FF, (bf16_t*)(p.ws + OFF_W1) + (size_t)l * FF * D, D, FF, r / 64, r % 64, lds); continue; }
    j -= NT_W1;
    if (j < NT_W2) { const int l = j / 1024, r = j % 1024;
      transpose_item(p.in[I_FW2] + (size_t)l * FF * D, (bf16_t*)(p.ws + OFF_W2) + (size_t)l * D * FF, FF, D, r / 16, r % 16, lds); continue; }
    j -= NT_W2;
    {
      uint4* z = (uint4*)((bf16_t*)(p.ws + OFF_WIN) + ((size_t)j * DINP + DIN) * D);
      const int t = tid();
      for (int i = t; i < 128 * D * 2 / 16; i += 256) z[i] = make_uint4(0u, 0u, 0u, 0u);
    }
  }
}

DEV void row_phase(const Params& p, int mode, int l) {
  const int lane = tid() & 63;
  const int nw = gridDim.x * 8;
  const float* MOD = (const float*)(p.ws + OFF_MOD);
  const float* NG = p.in[I_NORMG];
  const float* U = (const float*)(p.ws + OFF_U);
  bf16_t* H = (bf16_t*)(p.ws + OFF_H);
  const bool has_next = !(mode == 2 && l == 3);
  const int ln = (mode == 0) ? 0 : (mode == 1 ? l : l + 1);
  const int gi = (mode == 1) ? 2 : 0, shi = (mode == 1) ? 3 : 0, sci = (mode == 1) ? 4 : 1;
  const float* ga = NG + (size_t)(l * 4 + (mode == 1 ? 1 : 3)) * 1024;
  const float* gb = NG + (size_t)((has_next ? ln : 0) * 4 + gi) * 1024;
  for (int rowa = blockIdx.x * 8 + half_id() * 4 + (tid() >> 6); rowa < MT; rowa += 2 * nw) {
    float4 x[2][4], u[2][4];
    int rows[2]; bool ok[2];
#pragma unroll
    for (int q = 0; q < 2; ++q) {
      rows[q] = rowa + q * nw; ok[q] = rows[q] < MT;
      const int row = ok[q] ? rows[q] : rowa;
      if (mode == 0) {
        const float* src = row < NCTX ? p.in[I_XP] + (size_t)row * D : p.in[I_XS] + (size_t)(row - NCTX) * D;
#pragma unroll
        for (int i = 0; i < 4; ++i) x[q][i] = *(const float4*)(src + i * 256 + lane * 4);
      } else {
#pragma unroll
        for (int i = 0; i < 4; ++i) {
          x[q][i] = *(const float4*)(p.out + (size_t)row * D + i * 256 + lane * 4);
          u[q][i] = *(const float4*)(U + (size_t)row * D + i * 256 + lane * 4);
        }
      }
    }
#pragma unroll
    for (int q = 0; q < 2; ++q) {
      const int row = ok[q] ? rows[q] : rowa;
      const int cond = row < NCTX ? 0 : 1 + ((row - NCTX) >> 10);
      if (mode != 0) {
        float ss = 0;
#pragma unroll
        for (int i = 0; i < 4; ++i) ss += u[q][i].x * u[q][i].x + u[q][i].y * u[q][i].y + u[q][i].z * u[q][i].z + u[q][i].w * u[q][i].w;
        ss = wave_sum(ss);
        const float r = rsqrtf(ss * (1.0f / 1024.0f) + 1e-6f);
        const float* gate = MOD + (size_t)(l * 3 + cond) * 6144 + (mode == 1 ? 2 : 5) * 1024;
#pragma unroll
        for (int i = 0; i < 4; ++i) {
          const float4 g4 = *(const float4*)(gate + i * 256 + lane * 4);
          const float4 a4 = *(const float4*)(ga + i * 256 + lane * 4);
          x[q][i].x += g4.x * (u[q][i].x * r * a4.x); x[q][i].y += g4.y * (u[q][i].y * r * a4.y);
          x[q][i].z += g4.z * (u[q][i].z * r * a4.z); x[q][i].w += g4.w * (u[q][i].w * r * a4.w);
        }
      }
      if (ok[q]) {
#pragma unroll
        for (int i = 0; i < 4; ++i) *(float4*)(p.out + (size_t)row * D + i * 256 + lane * 4) = x[q][i];
      }
      if (has_next) {
        float ss = 0;
#pragma unroll
        for (int i = 0; i < 4; ++i) ss += x[q][i].x * x[q][i].x + x[q][i].y * x[q][i].y + x[q][i].z * x[q][i].z + x[q][i].w * x[q][i].w;
        ss = wave_sum(ss);
        const float r2 = rsqrtf(ss * (1.0f / 1024.0f) + 1e-6f);
        const float* sh = MOD + (size_t)(ln * 3 + cond) * 6144 + shi * 1024;
        const float* sc = MOD + (size_t)(ln * 3 + cond) * 6144 + sci * 1024;
        if (ok[q]) {
#pragma unroll
          for (int i = 0; i < 4; ++i) {
            const float4 g4 = *(const float4*)(gb + i * 256 + lane * 4);
            const float4 s4 = *(const float4*)(sc + i * 256 + lane * 4);
            const float4 h4 = *(const float4*)(sh + i * 256 + lane * 4);
            const float h0 = x[q][i].x * r2 * g4.x * (1.0f + s4.x) + h4.x;
            const float h1 = x[q][i].y * r2 * g4.y * (1.0f + s4.y) + h4.y;
            const float h2 = x[q][i].z * r2 * g4.z * (1.0f + s4.z) + h4.z;
            const float h3 = x[q][i].w * r2 * g4.w * (1.0f + s4.w) + h4.w;
            uint2 o; o.x = pk2(h0, h1); o.y = pk2(h2, h3);
            *(uint2*)(H + (size_t)row * D + i * 256 + lane * 4) = o;
          }
        }
      }
    }
  }
}

namespace pg8 {
#define PG8_LAS __attribute__((address_space(3)))
typedef unsigned short bf16_t;
typedef short bf16x8 __attribute__((ext_vector_type(8)));
typedef float f32x4 __attribute__((ext_vector_type(4)));
typedef unsigned u32x4 __attribute__((ext_vector_type(4)));
constexpr int BM = 256, BK = 64, HALF = 128, HTB = HALF * BK * 2  , STAGE_BYTES = 8 * HTB, NXCD = 8, WGM = 8;

__host__ __device__ __forceinline__ int lds_byte(int r, int c) { const int st = (r >> 4) * 2 + (c >> 5), rr = r & 15, cc = c & 31, ob = rr * 64 + cc * 2; return st * 1024 + (ob ^ (((ob >> 9) & 1) << 5)); }
__host__ __device__ __forceinline__ void stage_rc(int b, int& R, int& C) { const int st = b / 1024, sb = b % 1024, swz = sb ^ (((sb >> 9) & 1) << 5); R = (st >> 1) * 16 + swz / 64; C = (st & 1) * 32 + (swz % 64) / 2; }
__host__ __device__ __forceinline__ int perm32(int rho) { const int n = rho >> 4, i = rho & 15; return 8 * (i >> 2) + 4 * n + (i & 3); }

struct Unit { int pm, pn; };
struct Gemm { const bf16_t* A; const bf16_t* Bt; int M, N, K; };

struct StaticOrder {
    int nM, nN, nwg, G, c;
    __host__ __device__ void init(int M, int N, int G_, int c_) { nM = M / BM; nN = N / BM; nwg = nM * nN; G = G_; c = c_; }
    __host__ __device__ bool next(int i, Unit& u) const {
        const long L = (long)i * G + c; if (L >= nwg) return false;
        int wgid = (int)L; { const int q = nwg / NXCD, r = nwg % NXCD, xcd = wgid % NXCD, off = wgid / NXCD; wgid = (xcd < r ? xcd * (q + 1) : r * (q + 1) + (xcd - r) * q) + off; }
        const int nig = WGM * nN, gid = wgid / nig, fm = gid * WGM, gsz = (nM - fm) < WGM ? (nM - fm) : WGM;
        u.pm = fm + ((wgid % nig) % gsz); u.pn = (wgid % nig) / gsz; return true;
    }
    __device__ __forceinline__ void a_ready(const Unit&) const {}
    __device__ __forceinline__ void done(const Unit&) const {}
};

template <class Epi, class Sched, bool ALIGN_EPI = false, bool SP2 = false>
__device__ __forceinline__ void gemm_phase(PG8_LAS unsigned char* lds, const Gemm g, const Sched& S, const Epi& E) {
    int tid_z; asm volatile("v_mov_b32 %0, 0" : "=v"(tid_z)); const int tid = (int)threadIdx.x + tid_z, wid = __builtin_amdgcn_readfirstlane(tid >> 6), lane = tid & 63, wr = wid >> 2, wc = wid & 3, fr = lane & 15, fq = lane >> 4;
    const int K = g.K, nt = K / BK;
    unsigned voffA[2], voffB[2];
#pragma unroll
    for (int i = 0; i < 2; ++i) { int R, C; stage_rc(tid * 16 + i * 8192, R, C); const int Rb = Epi::PERM ? ((R & ~31) + perm32(R & 31)) : R;
        voffA[i] = (unsigned)(R * K + C) * 2u; voffB[i] = (unsigned)(Rb * K + C) * 2u; }
    const size_t kstep = (size_t)(BK * 2);
    const size_t hstep = (size_t)HALF * K * 2;
    const size_t tstep = 2 * hstep;
    const unsigned ldsw = (unsigned)wid * 1024u;
    const int aoff = lds_byte(wr * 64 + fr, fq * 8), boff = lds_byte(wc * 32 + fr, fq * 8);
#define PG8_SA(b, h) (((b) * 2 + (h)) * HTB)
#define PG8_SB(b, h) ((4 + (b) * 2 + (h)) * HTB)
#define PG8_STAGE(bufoff, gbase, voff) do { _Pragma("unroll") for (int _i = 0; _i < 2; ++_i) \
        __builtin_amdgcn_global_load_lds((const unsigned*)((const char*)(gbase) + (voff)[_i]), (PG8_LAS unsigned*)(lds + (bufoff) + ldsw + _i * 8192), 16, 0, 0); } while (0)
#define PG8_LDA(dst, b, h) do { _Pragma("unroll") for (int m = 0; m < 4; ++m) _Pragma("unroll") for (int k = 0; k < 2; ++k) dst[m][k] = *(const PG8_LAS bf16x8*)(lds + PG8_SA(b, h) + aoff + m * 2048 + k * 1024); } while (0)
#define PG8_LDB(dst, b, h) do { _Pragma("unroll") for (int n = 0; n < 2; ++n) _Pragma("unroll") for (int k = 0; k < 2; ++k) dst[n][k] = *(const PG8_LAS bf16x8*)(lds + PG8_SB(b, h) + boff + n * 2048 + k * 1024); } while (0)
#define PG8_MMA(ai, bj, At, Bt) do { __builtin_amdgcn_s_setprio(1); _Pragma("unroll") for (int m = 0; m < 4; ++m) _Pragma("unroll") for (int n = 0; n < 2; ++n) _Pragma("unroll") for (int k = 0; k < 2; ++k) \
        acc[ai][bj][m][n] = __builtin_amdgcn_mfma_f32_16x16x32_bf16(Bt[n][k], At[m][k], acc[ai][bj][m][n], 0, 0, 0); __builtin_amdgcn_s_setprio(0); } while (0)
#define PG8_WAIT_V(n) asm volatile("s_waitcnt vmcnt(" #n ")" ::: "memory")
#define PG8_WAIT_L(n) asm volatile("s_waitcnt lgkmcnt(" #n ")" ::: "memory")
#define PG8_BAR __builtin_amdgcn_s_barrier()
#define PG8_SCHED __builtin_amdgcn_sched_barrier(0)
    Unit cur, nxt; int ui = 0;
    if (!S.next(0, cur)) return;
    f32x4 acc[2][2][4][2];
#pragma unroll
    for (int a = 0; a < 2; ++a)
#pragma unroll
        for (int b = 0; b < 2; ++b)
#pragma unroll
            for (int m = 0; m < 4; ++m)
#pragma unroll
                for (int n = 0; n < 2; ++n) acc[a][b][m][n] = (f32x4){0.f, 0.f, 0.f, 0.f};
    bf16x8 At[4][2], B0[2][2], B1[2][2];
    const char* cA = (const char*)g.A + (size_t)cur.pm * tstep; const char* cB = (const char*)g.Bt + (size_t)cur.pn * tstep;
    S.a_ready(cur);
    if constexpr (SP2) {
        PG8_STAGE(PG8_SB(0, 0), cB, voffB); PG8_STAGE(PG8_SB(0, 1), cB + hstep, voffB); PG8_STAGE(PG8_SA(0, 0), cA, voffA); PG8_STAGE(PG8_SA(0, 1), cA + hstep, voffA);
        if (wr == 1) PG8_BAR;
        PG8_WAIT_V(2); PG8_BAR;
        PG8_STAGE(PG8_SB(1, 0), cB + kstep, voffB); PG8_STAGE(PG8_SA(1, 0), cA + kstep, voffA); PG8_STAGE(PG8_SB(1, 1), cB + hstep + kstep, voffB);
        PG8_WAIT_V(6); PG8_BAR;
    } else {
        PG8_STAGE(PG8_SB(0, 0), cB, voffB); PG8_STAGE(PG8_SA(0, 0), cA, voffA); PG8_STAGE(PG8_SB(0, 1), cB + hstep, voffB); PG8_STAGE(PG8_SA(0, 1), cA + hstep, voffA);
        if (wr == 1) PG8_BAR;
        PG8_WAIT_V(4); PG8_BAR;
        PG8_STAGE(PG8_SB(1, 0), cB + kstep, voffB); PG8_STAGE(PG8_SA(1, 0), cA + kstep, voffA); PG8_STAGE(PG8_SB(1, 1), cB + hstep + kstep, voffB);
        PG8_WAIT_V(6); PG8_BAR;
    }
    for (;;) {
        const bool has_next = S.next(ui + 1, nxt);
        const char* nA = has_next ? (const char*)g.A + (size_t)nxt.pm * tstep : cA; const char* nB = has_next ? (const char*)g.Bt + (size_t)nxt.pn * tstep : cB;
        for (int t = 0; t < nt; t += 2) {
            const bool last = (t == nt - 2);
            const char* a1 = cA + (size_t)(t + 1) * kstep;
            const char* a2 = last ? nA : cA + (size_t)(t + 2) * kstep; const char* b2 = last ? nB : cB + (size_t)(t + 2) * kstep;
            const char* a3 = a2 + kstep; const char* b3 = b2 + kstep;
            if (last && has_next) S.a_ready(nxt);
            if constexpr (SP2) {
            PG8_LDB(B0, 0, 0); PG8_LDB(B1, 0, 1); PG8_SCHED; PG8_LDA(At, 0, 0); PG8_STAGE(PG8_SA(1, 1), a1 + hstep, voffA);
            PG8_WAIT_V(8); PG8_WAIT_L(0); PG8_BAR; PG8_MMA(0, 0, At, B0); PG8_MMA(0, 1, At, B1); PG8_BAR; PG8_SCHED;
            PG8_LDA(At, 0, 1); PG8_STAGE(PG8_SB(0, 0), b2, voffB); PG8_STAGE(PG8_SB(0, 1), b2 + hstep, voffB); PG8_STAGE(PG8_SA(0, 0), a2, voffA);
            PG8_WAIT_V(8); PG8_WAIT_L(0); PG8_BAR; PG8_MMA(1, 0, At, B0); PG8_MMA(1, 1, At, B1); PG8_BAR; PG8_SCHED;
            PG8_LDB(B0, 1, 0); PG8_LDB(B1, 1, 1); PG8_SCHED; PG8_LDA(At, 1, 0); PG8_STAGE(PG8_SA(0, 1), a2 + hstep, voffA);
            PG8_WAIT_V(8); PG8_WAIT_L(0); PG8_BAR; PG8_MMA(0, 0, At, B0); PG8_MMA(0, 1, At, B1); PG8_BAR; PG8_SCHED;
            PG8_LDA(At, 1, 1); PG8_STAGE(PG8_SB(1, 0), b3, voffB); PG8_STAGE(PG8_SB(1, 1), b3 + hstep, voffB); PG8_STAGE(PG8_SA(1, 0), a3, voffA);
            PG8_WAIT_V(8); PG8_WAIT_L(0); PG8_BAR; PG8_MMA(1, 0, At, B0); PG8_MMA(1, 1, At, B1); PG8_BAR; PG8_SCHED;
            } else {
            PG8_LDB(B0, 0, 0); PG8_SCHED; PG8_LDA(At, 0, 0); PG8_STAGE(PG8_SA(1, 1), a1 + hstep, voffA);
            PG8_WAIT_L(8); PG8_BAR; PG8_WAIT_L(0); PG8_MMA(0, 0, At, B0); PG8_BAR; PG8_SCHED;
            PG8_LDB(B1, 0, 1); PG8_STAGE(PG8_SB(0, 0), b2, voffB);
            PG8_BAR; PG8_WAIT_L(0); PG8_MMA(0, 1, At, B1); PG8_BAR;
            PG8_LDA(At, 0, 1); PG8_STAGE(PG8_SA(0, 0), a2, voffA);
            PG8_BAR; PG8_WAIT_L(0); PG8_MMA(1, 0, At, B0); PG8_BAR; PG8_SCHED;
            PG8_STAGE(PG8_SB(0, 1), b2 + hstep, voffB);
            PG8_WAIT_V(6); PG8_BAR; PG8_MMA(1, 1, At, B1); PG8_BAR;
            PG8_LDB(B0, 1, 0); PG8_SCHED; PG8_LDA(At, 1, 0); PG8_STAGE(PG8_SA(0, 1), a2 + hstep, voffA);
            PG8_WAIT_L(8); PG8_BAR; PG8_WAIT_L(0); PG8_MMA(0, 0, At, B0); PG8_BAR; PG8_SCHED;
            PG8_LDB(B1, 1, 1); PG8_STAGE(PG8_SB(1, 0), b3, voffB);
            PG8_BAR; PG8_WAIT_L(0); PG8_MMA(0, 1, At, B1); PG8_BAR;
            PG8_LDA(At, 1, 1); PG8_STAGE(PG8_SA(1, 0), a3, voffA);
            PG8_BAR; PG8_WAIT_L(0); PG8_MMA(1, 0, At, B0); PG8_BAR; PG8_SCHED;
            PG8_STAGE(PG8_SB(1, 1), b3 + hstep, voffB);
            PG8_WAIT_V(6); PG8_BAR; PG8_MMA(1, 1, At, B1); PG8_BAR;
            }
        }
        if constexpr (ALIGN_EPI) { if (wr == 0) PG8_BAR; }
        if constexpr (!Epi::AFTER_DRAIN) { E(acc, cur, wr, wc, fr, fq); S.done(cur); }
        if (!has_next) break;
#pragma unroll
        for (int a = 0; a < 2; ++a)
#pragma unroll
            for (int b = 0; b < 2; ++b)
#pragma unroll
                for (int m = 0; m < 4; ++m)
#pragma unroll
                    for (int n = 0; n < 2; ++n) acc[a][b][m][n] = (f32x4){0.f, 0.f, 0.f, 0.f};
        cur = nxt; cA = nA; cB = nB; ++ui;
        if constexpr (ALIGN_EPI) { if (wr == 1) PG8_BAR; }
    }
    PG8_WAIT_V(0);
    if constexpr (!ALIGN_EPI) { if (wr == 0) PG8_BAR; }
    PG8_BAR;
    if constexpr (Epi::AFTER_DRAIN) { E.fused(acc, cur, wr, wc, fr, fq, lds, wid, lane); S.done(cur); }
#undef PG8_SA
#undef PG8_SB
#undef PG8_STAGE
#undef PG8_LDA
#undef PG8_LDB
#undef PG8_MMA
#undef PG8_WAIT_V
#undef PG8_WAIT_L
#undef PG8_BAR
#undef PG8_SCHED
}
}

template <int MODE> struct EpiMK {
  static constexpr bool PERM = false, AFTER_DRAIN = false;
  const Params* pp; int l;
  DEV void operator()(const pg8::f32x4 (&acc)[2][2][4][2], const pg8::Unit& u, int wr, int wc, int fr, int fq) const {
    const Params& p = *pp;
#pragma unroll
    for (int ai = 0; ai < 2; ++ai)
#pragma unroll
      for (int m = 0; m < 4; ++m) {
        const int row = u.pm * 256 + ai * 128 + wr * 64 + m * 16 + fr;
#pragma unroll
        for (int bj = 0; bj < 2; ++bj)
#pragma unroll
          for (int n = 0; n < 2; ++n) {
            const int col = u.pn * 256 + bj * 128 + wc * 32 + n * 16 + fq * 4;
            const pg8::f32x4 v = acc[ai][bj][m][n];
            if (MODE == 0) {
              if (col < DIN) {
                uint2 o; o.x = pk2(v[0], v[1]); o.y = pk2(v[2], v[3]);
                *(uint2*)((bf16_t*)(p.ws + OFF_P) + (size_t)row * DIN + col) = o;
                if (row < NCTX) {
                  if (col >= C_NK && col < C_HQ) {
                    const int kv = col >= C_NV;
                    *(pg8::f32x4*)(p.out + O_NAT + (size_t)(((row >> 8) * 4 + l) * 2 + kv) * 65536 + (row & 255) * 256 + (col - (kv ? C_NV : C_NK))) = v;
                  } else if (col >= C_SK) {
                    const int kv = col >= C_SV;
                    *(pg8::f32x4*)(p.out + O_SWA + (size_t)(((row >> 8) * 4 + l) * 2 + kv) * 32768 + (row & 255) * 128 + (col - (kv ? C_SV : C_SK))) = v;
                  }
                }
              }
            } else if (MODE == 1) {
              *(pg8::f32x4*)((float*)(p.ws + OFF_U) + (size_t)row * D + col) = v;
            } else {
              const float r0 = fmaxf(v[0], 0.f), r1 = fmaxf(v[1], 0.f), r2 = fmaxf(v[2], 0.f), r3 = fmaxf(v[3], 0.f);
              uint2 o; o.x = pk2(r0 * r0, r1 * r1); o.y = pk2(r2 * r2, r3 * r3);
              *(uint2*)((bf16_t*)(p.ws + OFF_HID) + (size_t)row * FF + col) = o;
            }
          }
      }
  }
};

template <int MODE>
DEV void gemm_run(const Params& p, int l, const bf16_t* A, const bf16_t* BT, int K, int N, char* lds) {
  pg8::Gemm g{A, BT, MT, N, K};
  pg8::StaticOrder S; S.init(MT, N, (int)gridDim.x, (int)blockIdx.x);
  EpiMK<MODE> E{&p, l};
  pg8::gemm_phase<EpiMK<MODE>, pg8::StaticOrder, true, true>((PG8_LAS unsigned char*)lds, g, S, E);
}

constexpr int TOKT = 20;
DEV void prep_item(const Params& p, int l, int tile, char* lds) {
  const int t = tid(), r0 = tile * TOKT, c = t;
  float* sT = (float*)lds;
  float* swl = sT + 128 * TOKT;
  float* sal = swl + TOKT * 256;
  const bf16_t* P = (const bf16_t*)(p.ws + OFF_P);
  float* PREP = (float*)(p.ws + OFF_PREP);
  float* BON = (float*)(p.ws + OFF_BONUS);
  for (int dir = 0; dir < 2; ++dir) {
    __syncthreads();
#pragma unroll
    for (int i = 0; i < TOKT / 2; ++i) {
      const int e = t + 256 * i, tk = e >> 7, j = e & 127, which = j >> 6, jj = j & 63;
      const int row = r0 + tk, prow = dir ? row + 1 : row - 1;
      const int tis = row < NCTX ? (row & 255) : ((row - NCTX) & 1023), Tm1 = row < NCTX ? 255 : 1023;
      const bool pv = dir ? (tis < Tm1) : (tis > 0);
      const int col = (dir ? C_WHB : C_WHF) + which * 64 + jj;
      const float cur = bf2f(P[(size_t)row * DIN + col]);
      const float prev = bf2f(P[(size_t)(pv ? prow : row) * DIN + col]) * (pv ? 1.f : 0.f);
      const float mu = p.in[I_MULORA][((l * 2 + dir) * 2 + which) * 64 + jj];
      const float val = cur + (prev - cur) * mu;
      sT[j * TOKT + tk] = (which == 0) ? tanhf_(val) : val;
    }
    __syncthreads();
    {
      const float* w2p = p.in[I_W2] + (size_t)(l * 2 + dir) * 64 * 256 + c;
      const float* a2p = p.in[I_A2] + (size_t)(l * 2 + dir) * 64 * 256 + c;
#pragma unroll
      for (int which = 0; which < 2; ++which) {
        float acc[TOKT];
#pragma unroll
        for (int k = 0; k < TOKT; ++k) acc[k] = 0.f;
        float colv[64];
        const float* cp = which ? a2p : w2p;
#pragma unroll
        for (int j = 0; j < 64; ++j) colv[j] = cp[j * 256];
#pragma unroll
        for (int j = 0; j < 64; ++j) {
#pragma unroll
          for (int k4 = 0; k4 < TOKT / 4; ++k4) {
            const float4 x4 = *(const float4*)(sT + (which * 64 + j) * TOKT + k4 * 4);
            acc[k4 * 4 + 0] += x4.x * colv[j]; acc[k4 * 4 + 1] += x4.y * colv[j]; acc[k4 * 4 + 2] += x4.z * colv[j]; acc[k4 * 4 + 3] += x4.w * colv[j];
          }
        }
        float* dst = which ? sal : swl;
#pragma unroll
        for (int k = 0; k < TOKT; ++k) dst[k * 256 + c] = acc[k];
      }
#pragma unroll
      for (int k = 0; k < 1; ++k) {}
    }
    const float w0v = p.in[I_W0][(l * 2 + dir) * 256 + c], a0v = p.in[I_A0][(l * 2 + dir) * 256 + c];
    const float kkv = p.in[I_KK][l * 256 + c], kav = p.in[I_KA][l * 256 + c], rkv = p.in[I_RK][l * 256 + c];
    const float mur = p.in[I_MURKV][((l * 2 + dir) * 3 + 0) * 256 + c], muk = p.in[I_MURKV][((l * 2 + dir) * 3 + 1) * 256 + c],
                muv = p.in[I_MURKV][((l * 2 + dir) * 3 + 2) * 256 + c];
    float* pr = PREP + (size_t)dir * 6 * ARRF;
    for (int tb = 0; tb < TOKT; tb += 5) {
      float rc[5], kc[5], vc[5], rp[5], kq[5], vp[5], wlv[5], alv[5];
#pragma unroll
      for (int u = 0; u < 5; ++u) {
        const int tk = tb + u, row = r0 + tk, prow = dir ? row + 1 : row - 1;
        const int tis = row < NCTX ? (row & 255) : ((row - NCTX) & 1023), Tm1 = row < NCTX ? 255 : 1023;
        const bool pv = dir ? (tis < Tm1) : (tis > 0);
        const float pm = pv ? 1.f : 0.f;
        const bf16_t* pc = P + (size_t)row * DIN + c;
        const bf16_t* pp = P + (size_t)(pv ? prow : row) * DIN + c;
        rc[u] = bf2f(pc[C_R]); kc[u] = bf2f(pc[C_K]); vc[u] = bf2f(pc[C_V]);
        rp[u] = bf2f(pp[C_R]) * pm; kq[u] = bf2f(pp[C_K]) * pm; vp[u] = bf2f(pp[C_V]) * pm;
        wlv[u] = swl[tk * 256 + c]; alv[u] = sal[tk * 256 + c];
      }
      float bprev[5];
#pragma unroll
      for (int u = 0; u < 5; ++u) bprev[u] = (dir == 1) ? BON[(size_t)(r0 + tb + u) * 256 + c] : 0.f;
#pragma unroll
      for (int u = 0; u < 5; ++u) {
        const int row = r0 + tb + u;
        const float rs = rc[u] + (rp[u] - rc[u]) * mur, ks = kc[u] + (kq[u] - kc[u]) * muk, vs = vc[u] + (vp[u] - vc[u]) * muv;
        const float wl = w0v + wlv[u], al = a0v + alv[u];
        const float wv = __expf(-0.6065306597126334f * sigmoidf_(wl));
        const float av = sigmoidf_(al);
        const float kkr = ks * kkv;
        const float n2 = wave_sum(kkr * kkr);
        const float kk = kkr * rcpf_(fmaxf(__builtin_amdgcn_sqrtf(n2), 1e-12f));
        const float kp = ks * (1.0f + (av - 1.0f) * kav);
        const float bs = wave_sum(rs * kp * rkv);
        const float bon = bs * vs;
        const size_t idx = (size_t)row * 256 + c;
        pr[idx] = rs; pr[ARRF + idx] = wv; pr[2 * ARRF + idx] = kp; pr[3 * ARRF + idx] = vs; pr[4 * ARRF + idx] = kk; pr[5 * ARRF + idx] = kk * av;
        BON[idx] = bprev[u] + bon;
      }
    }
  }
  __syncthreads();
}

DEV void rope_item(const Params& p, int item) {
  bf16_t* P = (bf16_t*)(p.ws + OFF_P);
  const int t = tid();
  for (int e = t; e < 64 * 192; e += 256) {
    const int tk = e / 192, r = e % 192, hs = r >> 5, pi = r & 31;
    const int lt = item * 64 + tk;
    const int tt = lt & 1023;
    const int grow = tt >> 6, gcol = tt & 63;
    const int fi = pi & 15;
    const float pos = (pi < 16) ? (float)grow : (float)gcol;
    const float inv = exp2f(-(float)fi * (13.287712379549449f / 16.0f));
    const float ang = pos * inv;
    const float cs = __cosf(ang), sn = __sinf(ang);
    const int d1 = (pi < 16) ? fi : 32 + fi;
    bf16_t* base = P + (size_t)(NCTX + lt) * DIN + C_SQ + hs * 64;
    const float x1 = bf2f(base[d1]), x2 = bf2f(base[d1 + 16]);
    base[d1] = f2bf(x1 * cs - x2 * sn);
    base[d1 + 16] = f2bf(x2 * cs + x1 * sn);
  }
}

constexpr int SC_BUF = 20480 + 4096;
typedef float f2 __attribute__((ext_vector_type(2)));
DEV float red8(float x) { x += dppf<0xB1>(x); x += dppf<0x4E>(x); x += dppf<0x141>(x); return x; }
DEV float dot8(const f2 (&S)[4], const float4& a, const float4& b) {
  f2 acc = S[0] * (f2){a.x, a.y};
  acc += S[1] * (f2){a.z, a.w}; acc += S[2] * (f2){b.x, b.y}; acc += S[3] * (f2){b.z, b.w};
  return acc.x + acc.y;
}

template <int NCH>
DEV void rwkv_scan(const Params& p, int l, int seq, int head, int dir, int rsel, char* lds) {
  const int t = tid(), rr = t >> 3, g = t & 7, rl = t >> 4, ks = t & 15;
  const int T = seq < 32 ? 256 : 1024;
  const int row0 = seq < 32 ? seq * 256 : NCTX + (seq - 32) * 1024;
  const float* prep = (const float*)(p.ws + OFF_PREP) + (size_t)dir * 6 * ARRF;
  float* ydir = (float*)(p.ws + OFF_YDIR) + (size_t)dir * ARRF;
  const int vbase = (NCH == 2) ? 0 : rsel * 32;
  f2 S[NCH][4];
#pragma unroll
  for (int c = 0; c < NCH; ++c)
#pragma unroll
    for (int j = 0; j < 4; ++j) S[c][j] = (f2){0.f, 0.f};
  if (seq >= 32) {
    const float* sp = p.in[I_SRW] + ((((size_t)(seq - 32) * 4 + l) * 2 + dir) * 4 + head) * 4096 + g * 8;
#pragma unroll
    for (int c = 0; c < NCH; ++c) {
      const float4 a = *(const float4*)(sp + (vbase + rr + 32 * c) * 64), b = *(const float4*)(sp + (vbase + rr + 32 * c) * 64 + 4);
      S[c][0] = (f2){a.x, a.y}; S[c][1] = (f2){a.z, a.w}; S[c][2] = (f2){b.x, b.y}; S[c][3] = (f2){b.z, b.w};
    }
  }
  const int nch = T >> 4;
  float4 pre0, pre1, pre2, pre3, pre4, pvv;
#define RW_LOAD(cc) do { const int s_ = (cc) * 16 + rl; const int tok_ = dir ? (T - 1 - s_) : s_; \
    const size_t base_ = (size_t)(row0 + tok_) * 256 + head * 64; \
    pre0 = *(const float4*)(prep + base_ + ks * 4); pre1 = *(const float4*)(prep + ARRF + base_ + ks * 4); \
    pre2 = *(const float4*)(prep + 2 * ARRF + base_ + ks * 4); pre3 = *(const float4*)(prep + 4 * ARRF + base_ + ks * 4); \
    pre4 = *(const float4*)(prep + 5 * ARRF + base_ + ks * 4); \
    if (NCH == 2) pvv = *(const float4*)(prep + 3 * ARRF + base_ + ks * 4); \
    else { const f2 v2_ = *(const f2*)(prep + 3 * ARRF + base_ + vbase + ks * 2); pvv.x = v2_.x; pvv.y = v2_.y; } } while (0)
#define RW_WRITE(bb) do { float4* sb_ = (float4*)(lds + (bb) * SC_BUF); float* vb_ = (float*)(lds + (bb) * SC_BUF + 20480); \
    sb_[(0 * 16 + rl) * 16 + ks] = pre0; sb_[(1 * 16 + rl) * 16 + ks] = pre1; sb_[(2 * 16 + rl) * 16 + ks] = pre2; \
    sb_[(3 * 16 + rl) * 16 + ks] = pre3; sb_[(4 * 16 + rl) * 16 + ks] = pre4; \
    if (NCH == 2) *(float4*)(vb_ + rl * 64 + ks * 4) = pvv; else *(f2*)(vb_ + rl * 64 + ks * 2) = (f2){pvv.x, pvv.y}; } while (0)
  __syncthreads();
  RW_LOAD(0); RW_WRITE(0);
  __syncthreads();
  for (int c = 0; c < nch; ++c) {
    if (c + 1 < nch) RW_LOAD(c + 1);
    const float4* sbuf = (const float4*)(lds + (c & 1) * SC_BUF);
    const float* vbuf = (const float*)(lds + (c & 1) * SC_BUF + 20480);
    float ym[NCH][2];
#pragma unroll
    for (int cc = 0; cc < NCH; ++cc) { ym[cc][0] = 0.f; ym[cc][1] = 0.f; }
#pragma unroll
    for (int i = 0; i < 16; ++i) {
      const float4 ra = sbuf[(0 * 16 + i) * 16 + g * 2], rb = sbuf[(0 * 16 + i) * 16 + g * 2 + 1];
      const float4 wa = sbuf[(1 * 16 + i) * 16 + g * 2], wb = sbuf[(1 * 16 + i) * 16 + g * 2 + 1];
      const float4 ka_ = sbuf[(2 * 16 + i) * 16 + g * 2], kb_ = sbuf[(2 * 16 + i) * 16 + g * 2 + 1];
      const float4 na = sbuf[(3 * 16 + i) * 16 + g * 2], nb = sbuf[(3 * 16 + i) * 16 + g * 2 + 1];
      const float4 aa = sbuf[(4 * 16 + i) * 16 + g * 2], ab = sbuf[(4 * 16 + i) * 16 + g * 2 + 1];
      const f2 w2[4] = {(f2){wa.x, wa.y}, (f2){wa.z, wa.w}, (f2){wb.x, wb.y}, (f2){wb.z, wb.w}};
      const f2 k2[4] = {(f2){ka_.x, ka_.y}, (f2){ka_.z, ka_.w}, (f2){kb_.x, kb_.y}, (f2){kb_.z, kb_.w}};
      const f2 a2[4] = {(f2){aa.x, aa.y}, (f2){aa.z, aa.w}, (f2){ab.x, ab.y}, (f2){ab.z, ab.w}};
#pragma unroll
      for (int cc = 0; cc < NCH; ++cc) {
        const float v = vbuf[i * 64 + rr + 32 * cc];
        const float sa = -red8(dot8(S[cc], na, nb));
#pragma unroll
        for (int j = 0; j < 4; ++j) S[cc][j] = S[cc][j] * w2[j] + a2[j] * sa + k2[j] * v;
        const float y = red8(dot8(S[cc], ra, rb));
        ym[cc][i >> 3] = (g == (i & 7)) ? y : ym[cc][i >> 3];
      }
    }
#pragma unroll
    for (int hh = 0; hh < 2; ++hh) {
      const int s = c * 16 + hh * 8 + g; const int tok = dir ? (T - 1 - s) : s;
      float* yo = ydir + (size_t)(row0 + tok) * 256 + head * 64 + vbase + rr;
#pragma unroll
      for (int cc = 0; cc < NCH; ++cc) yo[32 * cc] = ym[cc][hh];
    }
    if (c + 1 < nch) RW_WRITE((c + 1) & 1);
    __syncthreads();
  }
#undef RW_LOAD
#undef RW_WRITE
  if (seq < 32) {
    float* sp = p.out + O_RW + ((((size_t)seq * 4 + l) * 2 + dir) * 4 + head) * 4096 + g * 8;
#pragma unroll
    for (int c = 0; c < NCH; ++c) {
      *(float4*)(sp + (vbase + rr + 32 * c) * 64) = make_float4(S[c][0].x, S[c][0].y, S[c][1].x, S[c][1].y);
      *(float4*)(sp + (vbase + rr + 32 * c) * 64 + 4) = make_float4(S[c][2].x, S[c][2].y, S[c][3].x, S[c][3].y);
    }
  }
}

template <int NCH>
DEV void hgrn_scan(const Params& p, int l, int seq, int head, int dir, int rsel, char* lds) {
  const int t = tid(), rr = t >> 3, g = t & 7, rl = t >> 4, ks = t & 15;
  const int T = seq < 32 ? 256 : 1024;
  const int row0 = seq < 32 ? seq * 256 : NCTX + (seq - 32) * 1024;
  const bf16_t* P = (const bf16_t*)(p.ws + OFF_P);
  float* odir = (float*)(p.ws + OFF_HDIR) + (size_t)dir * ARRF;
  const float4 lb4 = *(const float4*)((const float*)(p.ws + OFF_HGLB) + (l * 2 + dir) * 256 + head * 64 + ks * 4);
  const int vbase = (NCH == 2) ? 0 : rsel * 32;
  f2 S[NCH][4];
#pragma unroll
  for (int c = 0; c < NCH; ++c)
#pragma unroll
    for (int j = 0; j < 4; ++j) S[c][j] = (f2){0.f, 0.f};
  if (seq >= 32) {
    const float* sp = p.in[I_SHG] + ((((size_t)(seq - 32) * 4 + l) * 2 + dir) * 4 + head) * 4096;
#pragma unroll
    for (int c = 0; c < NCH; ++c)
#pragma unroll
      for (int j = 0; j < 4; ++j) {
        const int v = vbase + rr + 32 * c;
        S[c][j] = (f2){sp[(g * 8 + 2 * j) * 64 + v], sp[(g * 8 + 2 * j + 1) * 64 + v]};
      }
  }
  const int nch = T >> 4;
  const int fcol = (dir ? C_HFB : C_HFF) + head * 64;
  uint2 pq, pf, pv2;
#define HG_LOAD(cc) do { const int s_ = (cc) * 16 + rl; const int tok_ = dir ? (T - 1 - s_) : s_; \
    const bf16_t* pr_ = P + (size_t)(row0 + tok_) * DIN; \
    pq = *(const uint2*)(pr_ + C_HQ + head * 64 + ks * 4); pf = *(const uint2*)(pr_ + fcol + ks * 4); \
    if (NCH == 2) pv2 = *(const uint2*)(pr_ + C_HI + head * 64 + ks * 4); else pv2.x = *(const unsigned*)(pr_ + C_HI + head * 64 + vbase + ks * 2); } while (0)
#define HG_WRITE(bb) do { float4* sb_ = (float4*)(lds + (bb) * SC_BUF); float* vb_ = (float*)(lds + (bb) * SC_BUF + 20480); \
    float4 q_, f_, k_; float a_, sg_; \
    a_ = bflo(pq.x); q_.x = a_ * sigmoidf_(a_); a_ = bfhi(pq.x); q_.y = a_ * sigmoidf_(a_); \
    a_ = bflo(pq.y); q_.z = a_ * sigmoidf_(a_); a_ = bfhi(pq.y); q_.w = a_ * sigmoidf_(a_); \
    sg_ = sigmoidf_(bflo(pf.x)); f_.x = lb4.x + (1.f - lb4.x) * sg_; k_.x = (1.f - lb4.x) * (1.f - sg_); \
    sg_ = sigmoidf_(bfhi(pf.x)); f_.y = lb4.y + (1.f - lb4.y) * sg_; k_.y = (1.f - lb4.y) * (1.f - sg_); \
    sg_ = sigmoidf_(bflo(pf.y)); f_.z = lb4.z + (1.f - lb4.z) * sg_; k_.z = (1.f - lb4.z) * (1.f - sg_); \
    sg_ = sigmoidf_(bfhi(pf.y)); f_.w = lb4.w + (1.f - lb4.w) * sg_; k_.w = (1.f - lb4.w) * (1.f - sg_); \
    sb_[(0 * 16 + rl) * 16 + ks] = q_; sb_[(1 * 16 + rl) * 16 + ks] = f_; sb_[(2 * 16 + rl) * 16 + ks] = k_; \
    if (NCH == 2) *(float4*)(vb_ + rl * 64 + ks * 4) = make_float4(bflo(pv2.x), bfhi(pv2.x), bflo(pv2.y), bfhi(pv2.y)); \
    else *(f2*)(vb_ + rl * 64 + ks * 2) = (f2){bflo(pv2.x), bfhi(pv2.x)}; } while (0)
  __syncthreads();
  HG_LOAD(0); HG_WRITE(0);
  __syncthreads();
  for (int c = 0; c < nch; ++c) {
    if (c + 1 < nch) HG_LOAD(c + 1);
    const float4* sbuf = (const float4*)(lds + (c & 1) * SC_BUF);
    const float* vbuf = (const float*)(lds + (c & 1) * SC_BUF + 20480);
    float ym[NCH][2];
#pragma unroll
    for (int cc = 0; cc < NCH; ++cc) { ym[cc][0] = 0.f; ym[cc][1] = 0.f; }
#pragma unroll
    for (int i = 0; i < 16; ++i) {
      const float4 qa = sbuf[(0 * 16 + i) * 16 + g * 2], qb = sbuf[(0 * 16 + i) * 16 + g * 2 + 1];
      const float4 fa = sbuf[(1 * 16 + i) * 16 + g * 2], fb = sbuf[(1 * 16 + i) * 16 + g * 2 + 1];
      const float4 ka_ = sbuf[(2 * 16 + i) * 16 + g * 2], kb_ = sbuf[(2 * 16 + i) * 16 + g * 2 + 1];
      const f2 f2v[4] = {(f2){fa.x, fa.y}, (f2){fa.z, fa.w}, (f2){fb.x, fb.y}, (f2){fb.z, fb.w}};
      const f2 k2[4] = {(f2){ka_.x, ka_.y}, (f2){ka_.z, ka_.w}, (f2){kb_.x, kb_.y}, (f2){kb_.z, kb_.w}};
#pragma unroll
      for (int cc = 0; cc < NCH; ++cc) {
        const float v = vbuf[i * 64 + rr + 32 * cc];
#pragma unroll
        for (int j = 0; j < 4; ++j) S[cc][j] = S[cc][j] * f2v[j] + k2[j] * v;
        const float y = red8(dot8(S[cc], qa, qb));
        ym[cc][i >> 3] = (g == (i & 7)) ? y : ym[cc][i >> 3];
      }
    }
#pragma unroll
    for (int hh = 0; hh < 2; ++hh) {
      const int s = c * 16 + hh * 8 + g; const int tok = dir ? (T - 1 - s) : s;
      float* yo = odir + (size_t)(row0 + tok) * 256 + head * 64 + vbase + rr;
#pragma unroll
      for (int cc = 0; cc < NCH; ++cc) yo[32 * cc] = ym[cc][hh];
    }
    if (c + 1 < nch) HG_WRITE((c + 1) & 1);
    __syncthreads();
  }
#undef HG_LOAD
#undef HG_WRITE
  if (seq < 32) {
    float* sp = p.out + O_HG + ((((size_t)seq * 4 + l) * 2 + dir) * 4 + head) * 4096;
#pragma unroll
    for (int c = 0; c < NCH; ++c)
#pragma unroll
      for (int j = 0; j < 4; ++j) {
        const int v = vbase + rr + 32 * c;
        sp[(g * 8 + 2 * j) * 64 + v] = S[c][j].x; sp[(g * 8 + 2 * j + 1) * 64 + v] = S[c][j].y;
      }
  }
}

template <int MODE>
DEV void attn_item(const Params& p, int l, int item, char* lds) {
  const int t = tid(), lane = t & 63, w = t >> 6, q = lane & 31, hh = lane >> 5;
  const bf16_t* P = (const bf16_t*)(p.ws + OFF_P);
  bf16_t* Y = (bf16_t*)(p.ws + OFF_YMIX);
  char* sK = lds;
  char* sV = lds + 8192;
  float* sBias = (float*)(lds + 8192 + 8704);
  int head, qrow, qcol, kcol, vcol, ocol, nloc, nt, rowbaseP;
  int qr = 0, qc = 0, rlo = 0, qpos = 0, lo = 0, rsq = 0, wsq = 0;
  float sink = 0.f;
  const float* cache = nullptr; int cH = 1, cHead = 0;
  if (MODE == 0 || MODE == 1) {
    const int b = item >> 3; head = (item >> 1) & 3; const int half = item & 1;
    rowbaseP = b * 256; qrow = rowbaseP + half * 128 + w * 32 + q; nloc = 4; nt = 4;
  } else {
    const int b = item >> 5; head = (item >> 3) & 3; const int sub = item & 7;
    rowbaseP = NCTX + b * 1024;
    if (MODE == 2) {
      qr = 2 * sub + (w >> 1); qc = (w & 1) * 32 + q; qrow = rowbaseP + qr * 64 + qc;
      rlo = clampi(2 * sub - 4, 0, 8); const int rhi = clampi(2 * sub - 3, 0, 8) + 7; nloc = rhi - rlo + 1; nt = nloc + 4;
      rsq = clampi(qr - 4, 0, 8); wsq = clampi(qc - 8, 0, 48);
      cache = p.in[I_CNAT] + (size_t)((b * 4 + l) * 2) * 256 * 256; cH = 4; cHead = head;
      for (int i = t; i < 465; i += 256) sBias[i] = p.in[I_RPB][(size_t)(l * 4 + head) * 465 + i];
    } else {
      qpos = sub * 128 + w * 32 + q; qrow = rowbaseP + qpos;
      lo = (sub - 1) * 128;
      nloc = 6; nt = nloc + 4;
      cache = p.in[I_CSWA] + (size_t)((b * 4 + l) * 2) * 256 * 128; cH = 2; cHead = head >> 1;
    }
  }
  if (MODE == 0 || MODE == 2) { qcol = C_NQ + head * 64; kcol = C_NK + head * 64; vcol = C_NV + head * 64; ocol = 256 + head * 64; }
  else { qcol = C_SQ + head * 64; kcol = C_SK + (head >> 1) * 64; vcol = C_SV + (head >> 1) * 64; ocol = 768 + head * 64; sink = p.in[I_SINK][l * 4 + head]; }

  bf16x8 bq[4];
#pragma unroll
  for (int s = 0; s < 4; ++s) bq[s] = *(const bf16x8*)(P + (size_t)qrow * DIN + qcol + 16 * s + 8 * hh);
  f32x16 oacc[2];
#pragma unroll
  for (int r = 0; r < 16; ++r) { oacc[0][r] = 0.f; oacc[1][r] = 0.f; }
  float m_run = -1e30f, l_run = 0.f;
  const int key = t >> 2, dq = t & 3;
  const int kswz = (key >> 1) & 7;
  for (int j = 0; j < nt; ++j) {
    uint4 kr[2], vr[2];
    const bool isP = j < nloc;
    int keybase = 0;
    if (isP) {
      if (MODE == 0 || MODE == 1) keybase = rowbaseP + j * 64;
      else if (MODE == 2) keybase = rowbaseP + (rlo + j) * 64;
      else keybase = rowbaseP + lo + j * 64;
      int krow = keybase + key;
      if (MODE == 3) krow = rowbaseP + clampi(lo + j * 64 + key, 0, 1023);
      const bf16_t* kp = P + (size_t)krow * DIN + kcol + dq * 16;
      const bf16_t* vp = P + (size_t)krow * DIN + vcol + dq * 16;
      kr[0] = *(const uint4*)kp; kr[1] = *(const uint4*)(kp + 8);
      vr[0] = *(const uint4*)vp; vr[1] = *(const uint4*)(vp + 8);
    } else {
      const int ct = (j - nloc) * 64 + key;
      const float* kp = cache + ((size_t)ct * cH + cHead) * 64 + dq * 16;
      const float* vp = kp + (size_t)256 * cH * 64;
      const float4 k0 = *(const float4*)kp, k1 = *(const float4*)(kp + 4), k2 = *(const float4*)(kp + 8), k3 = *(const float4*)(kp + 12);
      const float4 v0 = *(const float4*)vp, v1 = *(const float4*)(vp + 4), v2 = *(const float4*)(vp + 8), v3 = *(const float4*)(vp + 12);
      kr[0].x = pk2(k0.x, k0.y); kr[0].y = pk2(k0.z, k0.w); kr[0].z = pk2(k1.x, k1.y); kr[0].w = pk2(k1.z, k1.w);
      kr[1].x = pk2(k2.x, k2.y); kr[1].y = pk2(k2.z, k2.w); kr[1].z = pk2(k3.x, k3.y); kr[1].w = pk2(k3.z, k3.w);
      vr[0].x = pk2(v0.x, v0.y); vr[0].y = pk2(v0.z, v0.w); vr[0].z = pk2(v1.x, v1.y); vr[0].w = pk2(v1.z, v1.w);
      vr[1].x = pk2(v2.x, v2.y); vr[1].y = pk2(v2.z, v2.w); vr[1].z = pk2(v3.x, v3.y); vr[1].w = pk2(v3.z, v3.w);
    }
    __syncthreads();
    *(uint4*)(sK + key * 128 + (((dq * 2 + 0) ^ kswz) << 4)) = kr[0];
    *(uint4*)(sK + key * 128 + (((dq * 2 + 1) ^ kswz) << 4)) = kr[1];
    {
      bf16_t* vt = (bf16_t*)sV;
      const unsigned vv[8] = {vr[0].x, vr[0].y, vr[0].z, vr[0].w, vr[1].x, vr[1].y, vr[1].z, vr[1].w};
#pragma unroll
      for (int e = 0; e < 8; ++e) {
        vt[(dq * 16 + 2 * e) * 68 + key] = (bf16_t)(vv[e] & 0xffffu);
        vt[(dq * 16 + 2 * e + 1) * 68 + key] = (bf16_t)(vv[e] >> 16);
      }
    }
    __syncthreads();
    f32x16 sacc[2];
#pragma unroll
    for (int r = 0; r < 16; ++r) { sacc[0][r] = 0.f; sacc[1][r] = 0.f; }
    const int qswz = (q >> 1) & 7;
#pragma unroll
    for (int s = 0; s < 4; ++s) {
      const int co = (((s * 2 + hh) ^ qswz) << 4);
      const bf16x8 a0 = *(const bf16x8*)(sK + q * 128 + co);
      const bf16x8 a1 = *(const bf16x8*)(sK + (32 + q) * 128 + co);
      sacc[0] = MFMA32(a0, bq[s], sacc[0]);
      sacc[1] = MFMA32(a1, bq[s], sacc[1]);
    }
    float mx = -1e30f;
#pragma unroll
    for (int sub = 0; sub < 2; ++sub)
#pragma unroll
      for (int r = 0; r < 16; ++r) {
        const int kidx = sub * 32 + (r & 3) + 8 * (r >> 2) + 4 * hh;
        float v = sacc[sub][r] * 0.125f;
        bool ok = true;
        if (MODE == 2 && isP) {
          const int kr_ = rlo + j, kc_ = kidx;
          ok = (kr_ >= rsq) && (kr_ < rsq + 8) && (kc_ >= wsq) && (kc_ < wsq + 16);
          const int bi = ok ? ((kr_ - qr + 7) * 31 + (kc_ - qc + 15)) : 0;
          v += sBias[bi];
        }
        if (MODE == 3 && isP) {
          const int kpos = lo + j * 64 + kidx, dlt = kpos - qpos;
          ok = (dlt <= 128) && (dlt >= -128) && (kpos >= 0) && (kpos < 1024);
        }
        v = ok ? v : -1e30f;
        sacc[sub][r] = v;
        mx = fmaxf(mx, v);
      }
    mx = fmaxf(mx, __shfl_xor(mx, 32));
    const float m_new = fmaxf(m_run, mx);
    const float alpha = __expf(m_run - m_new);
    float rsum = 0.f;
#pragma unroll
    for (int sub = 0; sub < 2; ++sub)
#pragma unroll
      for (int r = 0; r < 16; ++r) {
        const float v = sacc[sub][r];
        const float pv = (v > -1e29f) ? __expf(v - m_new) : 0.f;
        sacc[sub][r] = pv; rsum += pv;
      }
    rsum += __shfl_xor(rsum, 32);
    l_run = l_run * alpha + rsum; m_run = m_new;
#pragma unroll
    for (int r = 0; r < 16; ++r) { oacc[0][r] *= alpha; oacc[1][r] *= alpha; }
#pragma unroll
    for (int k4 = 0; k4 < 4; ++k4) {
      const int sub = k4 >> 1, s2 = k4 & 1;
      uint4 pbu;
      pbu.x = pk2(sacc[sub][8 * s2 + 0], sacc[sub][8 * s2 + 1]); pbu.y = pk2(sacc[sub][8 * s2 + 2], sacc[sub][8 * s2 + 3]);
      pbu.z = pk2(sacc[sub][8 * s2 + 4], sacc[sub][8 * s2 + 5]); pbu.w = pk2(sacc[sub][8 * s2 + 6], sacc[sub][8 * s2 + 7]);
      const bf16x8 pb = __builtin_bit_cast(bf16x8, pbu);
#pragma unroll
      for (int dt = 0; dt < 2; ++dt) {
        const char* vp = sV + (dt * 32 + q) * 136 + (16 * k4 + 4 * hh) * 2;
        const uint2 lo8 = *(const uint2*)vp, hi8 = *(const uint2*)(vp + 16);
        uint4 avu; avu.x = lo8.x; avu.y = lo8.y; avu.z = hi8.x; avu.w = hi8.y;
        oacc[dt] = MFMA32(__builtin_bit_cast(bf16x8, avu), pb, oacc[dt]);
      }
    }
  }
  float scale;
  if (MODE == 1 || MODE == 3) {
    const float m_f = fmaxf(m_run, sink);
    const float e = __expf(m_run - m_f);
    scale = e / (l_run * e + __expf(sink - m_f));
  } else scale = 1.0f / l_run;
#pragma unroll
  for (int dt = 0; dt < 2; ++dt)
#pragma unroll
    for (int g4 = 0; g4 < 4; ++g4) {
      const int d = dt * 32 + 8 * g4 + 4 * hh;
      uint2 o; o.x = pk2(oacc[dt][4 * g4] * scale, oacc[dt][4 * g4 + 1] * scale); o.y = pk2(oacc[dt][4 * g4 + 2] * scale, oacc[dt][4 * g4 + 3] * scale);
      *(uint2*)(Y + (size_t)qrow * D + ocol + d) = o;
    }
  __syncthreads();
}

DEV void post_item(const Params& p, int l, int tile, char* lds) {
  const int t = tid(), r0 = tile * TOKT, c = t;
  float* sT = (float*)lds;
  float* sgo = sT + 128 * TOKT;
  const bf16_t* P = (const bf16_t*)(p.ws + OFF_P);
  bf16_t* Y = (bf16_t*)(p.ws + OFF_YMIX);
  const float* Y0 = (const float*)(p.ws + OFF_YDIR); const float* Y1 = Y0 + ARRF;
  const float* H0 = (const float*)(p.ws + OFF_HDIR); const float* H1 = H0 + ARRF;
  const float* BON = (const float*)(p.ws + OFF_BONUS);
  __syncthreads();
#pragma unroll
  for (int i = 0; i < TOKT / 2; ++i) {
    const int e = t + 256 * i, tk = e >> 7, j = e & 127;
    sT[j * TOKT + tk] = sigmoidf_(bf2f(P[(size_t)(r0 + tk) * DIN + C_GH + j]));
  }
  __syncthreads();
  {
    const float* g2p = p.in[I_G2] + (size_t)l * 128 * 256 + c;
    float ag[TOKT];
#pragma unroll
    for (int k = 0; k < TOKT; ++k) ag[k] = 0.f;
    float g2c[128];
#pragma unroll
    for (int j = 0; j < 128; ++j) g2c[j] = g2p[j * 256];
#pragma unroll
    for (int j = 0; j < 128; ++j) {
      const float gj = g2c[j];
#pragma unroll
      for (int k4 = 0; k4 < TOKT / 4; ++k4) {
        const float4 s4 = *(const float4*)(sT + j * TOKT + k4 * 4);
        ag[k4 * 4 + 0] += s4.x * gj; ag[k4 * 4 + 1] += s4.y * gj; ag[k4 * 4 + 2] += s4.z * gj; ag[k4 * 4 + 3] += s4.w * gj;
      }
    }
#pragma unroll
    for (int k = 0; k < TOKT; ++k) sgo[k * 256 + c] = ag[k];
  }
  const float lnw = p.in[I_LNW][l * 256 + c], lnb = p.in[I_LNB][l * 256 + c], hgn = p.in[I_HGN][l * 256 + c];
  for (int tb = 0; tb < TOKT; tb += 5) {
    float y[5], o[5], bn[5], gv[5], hg[5];
#pragma unroll
    for (int u = 0; u < 5; ++u) {
      const int row = r0 + tb + u;
      const size_t idx = (size_t)row * 256 + c;
      y[u] = Y0[idx] + Y1[idx]; o[u] = H0[idx] + H1[idx]; bn[u] = BON[idx];
      gv[u] = sgo[(tb + u) * 256 + c]; hg[u] = bf2f(P[(size_t)row * DIN + C_HG + c]);
    }
#pragma unroll
    for (int u = 0; u < 5; ++u) {
      const int row = r0 + tb + u;
      const float mu = wave_sum(y[u]) * (1.0f / 64.0f);
      const float dy = y[u] - mu;
      const float var = wave_sum(dy * dy) * (1.0f / 64.0f);
      const float yn = dy * rsqrtf(var + 64e-5f) * lnw + lnb + bn[u];
      Y[(size_t)row * D + c] = f2bf(yn * gv[u]);
      const float ms = wave_sum(o[u] * o[u]) * (1.0f / 64.0f);
      Y[(size_t)row * D + 512 + c] = f2bf(o[u] * rsqrtf(ms + 1e-6f) * hgn * sigmoidf_(hg[u]));
    }
  }
  __syncthreads();
}

constexpr int OFF_CTR_WORD = 3600;
DEV void mixer_phase(const Params& p, int l, char* lds0, volatile LAS unsigned* st, bool rerun) {
  const int hf = half_id(); char* lds = lds0 + hf * 65536;
  const int npairs = (192 + 512 + 512) / 2;
  unsigned* ctr = (unsigned*)(p.ws + OFF_BAR) + OFF_CTR_WORD + 64 * l + (rerun ? 32 : 0);
  for (;;) {
    if (threadIdx.x == 0) st[4] = __hip_atomic_fetch_add(ctr, 1u, __ATOMIC_RELAXED, __HIP_MEMORY_SCOPE_AGENT);
    __syncthreads();
    const int pair = (int)st[4];
    __syncthreads();
    if (pair >= npairs) break;
    const int it = pair * 2 + hf;
    const bool is_scan = it < 64 || (it >= 192 && it < 704);
    if (rerun && PROBE_SUB == 1 && !is_scan) continue;
    if (rerun && PROBE_SUB == 2 && is_scan) continue;
    if (rerun && PROBE_SUB == 3 && !(it < 64)) continue;
    if (rerun && PROBE_SUB == 4 && !(it >= 192 && it < 704)) continue;
    if (it < 64) {
      const int idx = it >> 1; const int seq = 32 + (idx >> 4), rem = idx & 15;
      if ((it & 1) == 0) rwkv_scan<1>(p, l, seq, rem >> 2, (rem >> 1) & 1, rem & 1, lds);
      else hgrn_scan<1>(p, l, seq, rem >> 2, (rem >> 1) & 1, rem & 1, lds);
    } else if (it < 128) attn_item<3>(p, l, it - 64, lds);
    else if (it < 192) attn_item<2>(p, l, it - 128, lds);
    else if (it < 704) {
      const int idx = (it - 192) & 255; const int seq = idx >> 3, rem = idx & 7;
      if (it < 448) rwkv_scan<2>(p, l, seq, rem >> 1, rem & 1, 0, lds);
      else hgrn_scan<2>(p, l, seq, rem >> 1, rem & 1, 0, lds);
    } else if (it < 960) attn_item<0>(p, l, it - 704, lds);
    else attn_item<1>(p, l, it - 960, lds);
  }
}

DEV void run_phase(const Params& p, int ph, char* lds, bool rerun, volatile LAS unsigned* st) {
  if (ph == 0) { phase0(p, lds); return; }
  if (ph == 1) { row_phase(p, 0, 0); return; }
  const int l = (ph - 2) / 9, s = (ph - 2) % 9;
  const bf16_t* H = (const bf16_t*)(p.ws + OFF_H);
  const int hf = half_id(); char* ldsh = lds + hf * 65536;
  switch (s) {
    case 0: gemm_run<0>(p, l, H, (const bf16_t*)(p.ws + OFF_WIN) + (size_t)l * DINP * D, D, DINP, lds); break;
    case 1:
      for (int it = blockIdx.x * 2 + hf; it < 512 + 32; it += gridDim.x * 2) { if (it < 512) prep_item(p, l, it, ldsh); else if (!rerun) rope_item(p, it - 512); }
      break;
    case 2: mixer_phase(p, l, lds, st, rerun); break;
    case 3: for (int it = blockIdx.x * 2 + hf; it < 512; it += gridDim.x * 2) post_item(p, l, it, ldsh); break;
    case 4: gemm_run<1>(p, l, (const bf16_t*)(p.ws + OFF_YMIX), (const bf16_t*)(p.ws + OFF_WOUT) + (size_t)l * D * D, D, D, lds); break;
    case 5: row_phase(p, 1, l); break;
    case 6: gemm_run<2>(p, l, H, (const bf16_t*)(p.ws + OFF_W1) + (size_t)l * FF * D, D, FF, lds); break;
    case 7: gemm_run<1>(p, l, (const bf16_t*)(p.ws + OFF_HID), (const bf16_t*)(p.ws + OFF_W2) + (size_t)l * D * FF, FF, D, lds); break;
    case 8: row_phase(p, 2, l); break;
  }
}

#define XB_TMO      128
#define XB_XCNT(j)  (256  + 64 * (j))
#define XB_XSUB(j)  (1280 + 64 * (j))
#define XB_XGEN(j)  (2304 + 64 * (j))
#define XB_TOP      3328
#define XB_TOPGEN   3392
#define XCD_BAR_WORDS 3456
#define XB_SPIN_CAP (1u << 18)
DEV unsigned xb_ld(unsigned* p) { return __hip_atomic_load(p, __ATOMIC_RELAXED, __HIP_MEMORY_SCOPE_AGENT); }
DEV unsigned xb_add(unsigned* p, unsigned v) { return __hip_atomic_fetch_add(p, v, __ATOMIC_RELAXED, __HIP_MEMORY_SCOPE_AGENT); }
DEV unsigned xb_xcc_id() { return (unsigned)__builtin_amdgcn_s_getreg((3 << 11) | 20) & 0xFu; }
#define XB_SPIN(cond, bar) do { unsigned _sp = 0; while (cond) { __builtin_amdgcn_s_sleep(1); \
    if ((++_sp & 255u) == 0u) { if (xb_ld(&(bar)[XB_TMO])) break; if (_sp > XB_SPIN_CAP) { atomicAdd(&(bar)[XB_TMO], 1u); break; } } } } while (0)
struct XcdBarrier { unsigned* bar; unsigned x; volatile LAS unsigned* st; };
DEV XcdBarrier xcd_barrier_post(unsigned* bar, volatile LAS unsigned* st) {
  XcdBarrier b; b.bar = bar; b.x = xb_xcc_id(); b.st = st;
  if (threadIdx.x == 0) (void)xb_add(&bar[XB_XCNT(b.x)], 1u);
  return b;
}
DEV void xcd_barrier_complete(unsigned* bar, unsigned x, unsigned& nloc, unsigned& nx) {
  const unsigned G = gridDim.x * gridDim.y * gridDim.z;
  unsigned sum, cnt, mine, sp = 0u;
  for (;;) {
    sum = 0u; cnt = 0u; mine = 0u;
#pragma unroll
    for (unsigned j = 0; j < 16; ++j) { const unsigned c = xb_ld(&bar[XB_XCNT(j)]); sum += c; cnt += (c > 0u) ? 1u : 0u; mine = (j == x) ? c : mine; }
    if (sum == G) break;
    __builtin_amdgcn_s_sleep(1);
    if ((++sp & 255u) == 0u) { if (xb_ld(&bar[XB_TMO])) break; if (sp > XB_SPIN_CAP) { atomicAdd(&bar[XB_TMO], 1u); break; } }
  }
  nloc = mine > 0u ? mine : 1u; nx = cnt > 0u ? cnt : 1u;
}
DEV void xcd_barrier(const XcdBarrier& b) {
  asm volatile("s_waitcnt vmcnt(0)" ::: "memory");
  __syncthreads();
  if (threadIdx.x == 0) {
    unsigned* bar = b.bar;
    { size_t zb_; asm volatile("s_mov_b64 %0, 0" : "=s"(zb_)); bar += zb_; }
    __builtin_amdgcn_s_waitcnt(0);
    unsigned nloc = b.st[0], nx = b.st[1];
    if (nloc == 0u) { xcd_barrier_complete(bar, b.x, nloc, nx); b.st[0] = nloc; b.st[1] = nx; }
    const unsigned old = xb_add(&bar[XB_XSUB(b.x)], 1u);
    const unsigned gen = old / nloc;
    if (old + 1u == (gen + 1u) * nloc) {
      __builtin_amdgcn_fence(__ATOMIC_RELEASE, "agent");
      asm volatile("s_waitcnt vmcnt(0)" ::: "memory");
      const unsigned og = xb_add(&bar[XB_TOP], 1u);
      const unsigned tg = og / nx;
      if (og + 1u == (tg + 1u) * nx) xb_add(&bar[XB_TOPGEN], 1u);
      else XB_SPIN(xb_ld(&bar[XB_TOPGEN]) == tg, bar);
      __builtin_amdgcn_fence(__ATOMIC_ACQUIRE, "agent");
      xb_add(&bar[XB_XGEN(b.x)], 1u);
      asm volatile("s_waitcnt vmcnt(0)" ::: "memory");
    } else {
      XB_SPIN(xb_ld(&bar[XB_XGEN(b.x)]) == gen, bar);
      __builtin_amdgcn_fence(__ATOMIC_ACQUIRE, "agent");
      asm volatile("s_waitcnt vmcnt(0)" ::: "memory");
    }
  }
  __syncthreads();
}

DEV int phase_kind(int ph) {
  if (ph == 0) return 0;
  if (ph == 1) return 1;
  const int s = (ph - 2) % 9;
  return s == 0 ? 2 : s == 1 ? 3 : s == 2 ? 4 : s == 3 ? 5 : s == 4 ? 6 : s == 5 ? 1 : s == 6 ? 7 : s == 7 ? 8 : 1;
}

constexpr int LDS_BYTES = 131072 + 64;

__global__ void __launch_bounds__(512, 2) mega(Params p, int ph_lo, int ph_hi) {
  extern __shared__ __attribute__((aligned(16))) unsigned char smem[];
  char* lds = (char*)smem;
  volatile LAS unsigned* st = (volatile LAS unsigned*)((LAS unsigned char*)smem + 131072);
  if (threadIdx.x == 0) { st[0] = 0u; st[1] = 0u; }
  __syncthreads();
  XcdBarrier xb = xcd_barrier_post((unsigned*)(p.ws + OFF_BAR), st);
  if (ph_hi < 0) cg::this_grid().sync();
  char* const ws0 = p.ws; float* const out0 = p.out;
  for (int ph = ph_lo; ph < ph_hi; ++ph) {
    { size_t z0_; asm volatile("s_mov_b64 %0, 0" : "=s"(z0_)); p.ws = ws0 + z0_; p.out = out0 + z0_; }
    run_phase(p, ph, lds, false, st);
    if (PROBE_KIND >= 0 && (PROBE_KIND == 9 || phase_kind(ph) == PROBE_KIND)) {
      xcd_barrier(xb);
      if (PROBE_KIND != 9) run_phase(p, ph, lds, true, st);
    }
    if (ph + 1 < ph_hi) xcd_barrier(xb);
  }
}

extern "C" void kernel_launch(void* const* d_in, const int* in_sizes, int n_in, void* d_out, int out_size, void* d_ws, size_t ws_size,
                              hipStream_t stream) {
  static int grid_blocks = 0;
  if (!grid_blocks) {
    int dev = 0, cus = 0, per_cu = 0;
    (void)hipGetDevice(&dev);
    (void)hipDeviceGetAttribute(&cus, hipDeviceAttributeMultiprocessorCount, dev);
    if (hipFuncSetAttribute((const void*)mega, hipFuncAttributeMaxDynamicSharedMemorySize, LDS_BYTES) != hipSuccess) fprintf(stderr, "hipFuncSetAttribute failed\n");
    (void)hipOccupancyMaxActiveBlocksPerMultiprocessor(&per_cu, mega, 512, LDS_BYTES);
    if (per_cu < 1) fprintf(stderr, "occupancy query reports %d blocks per CU\n", per_cu);
    (void)hipGetLastError();
    grid_blocks = cus;
  }
  if (ws_size < WS_TOTAL) { fprintf(stderr, "workspace too small: %zu < %zu\n", ws_size, (size_t)WS_TOTAL); return; }
  Params p{};
  for (int i = 0; i < 31; ++i) p.in[i] = (const float*)d_in[i];
  p.out = (float*)d_out;
  p.ws = (char*)d_ws;
  (void)hipMemsetAsync((char*)d_ws + OFF_BAR, 0, 16384, stream);
  int lo = 0, hi = NPH;
  void* args[] = {&p, &lo, &hi};
  hipError_t e = hipLaunchCooperativeKernel((void*)mega, dim3(grid_blocks), dim3(512), args, LDS_BYTES, stream);
  if (e != hipSuccess) fprintf(stderr, "cooperative launch failed: %s (grid %d)\n", hipGetErrorString(e), grid_blocks);
}
```

```cpp
#include <hip/hip_runtime.h>
#include <hip/hip_cooperative_groups.h>
#include <cstdio>
#include <cstdint>
namespace cg = cooperative_groups;

#ifndef ONE_LAUNCH
#define ONE_LAUNCH 1
#endif
#define PROBE_KIND -1
#define PROBE_SUB 0

#define DEV __device__ __forceinline__
#define LAS __attribute__((address_space(3)))
typedef unsigned short bf16_t;
typedef short bf16x8 __attribute__((ext_vector_type(8)));
typedef float f32x16 __attribute__((ext_vector_type(16)));
typedef __bf16 bf2_t __attribute__((ext_vector_type(2)));
typedef float f2_t __attribute__((ext_vector_type(2)));

constexpr int D = 1024, DIN = 3712, FF = 4096, NCTX = 8192, MT = 10240;
constexpr int NPH = 38;
constexpr int DINP = 3840;
constexpr int C_R = 0, C_K = 256, C_V = 512, C_GH = 768, C_WHF = 896, C_WHB = 1024;
constexpr int C_NQ = 1152, C_NK = 1408, C_NV = 1664;
constexpr int C_HQ = 1920, C_HI = 2176, C_HG = 2432, C_HFF = 2688, C_HFB = 2944;
constexpr int C_SQ = 3200, C_SK = 3456, C_SV = 3584;
constexpr size_t O_NAT = 10485760, O_SWA = 27262976, O_RW = 35651584, O_HG = 39845888;
constexpr size_t ARRF = (size_t)MT * 256;
constexpr size_t ARR = ARRF * 4;
constexpr size_t OFF_WIN = 0;
constexpr size_t OFF_WOUT = OFF_WIN + (size_t)4 * DINP * D * 2;
constexpr size_t OFF_W1 = OFF_WOUT + (size_t)4 * D * D * 2;
constexpr size_t OFF_W2 = OFF_W1 + (size_t)4 * FF * D * 2;
constexpr size_t OFF_MOD = OFF_W2 + (size_t)4 * FF * D * 2;
constexpr size_t OFF_HGLB = OFF_MOD + (size_t)4 * 3 * 6144 * 4;
constexpr size_t OFF_P = OFF_HGLB + 8192;
constexpr size_t OFF_R1 = OFF_P + (size_t)MT * DIN * 2;
constexpr size_t OFF_H = OFF_R1;
constexpr size_t OFF_HID = OFF_H + (size_t)MT * D * 2;
constexpr size_t OFF_U = OFF_HID + (size_t)MT * FF * 2;
constexpr size_t OFF_PREP = OFF_R1;
constexpr size_t OFF_YDIR = OFF_PREP + 12 * ARR;
constexpr size_t OFF_BONUS = OFF_R1 + 14 * ARR;
constexpr size_t OFF_HDIR = OFF_BONUS + ARR;
constexpr size_t OFF_YMIX = OFF_HDIR + 2 * ARR;
constexpr size_t OFF_BAR = OFF_YMIX + (size_t)MT * D * 2;
constexpr size_t WS_TOTAL = OFF_BAR + 16384;
static_assert(OFF_U + (size_t)MT * D * 4 == OFF_BONUS, "R1 layout");

struct Params {
  const float* in[31];
  float* out;
  char* ws;
};
enum { I_XP = 0, I_XS, I_CNAT, I_CSWA, I_SRW, I_SHG, I_C, I_CCTX, I_NORMG, I_MODW, I_MODB, I_WIN, I_WOUT, I_MURKV, I_MULORA,
       I_W0, I_W2, I_A0, I_A2, I_G2, I_KK, I_KA, I_RK, I_LNW, I_LNB, I_RPB, I_HGLB, I_HGN, I_SINK, I_FW1, I_FW2 };

DEV bf16_t f2bf(float f) { unsigned u = __float_as_uint(f); u += 0x7fffu + ((u >> 16) & 1u); return (bf16_t)(u >> 16); }
DEV float bf2f(bf16_t h) { return __uint_as_float(((unsigned)h) << 16); }
DEV unsigned pk2(float a, float b) { f2_t v = {a, b}; bf2_t r = __builtin_convertvector(v, bf2_t); return __builtin_bit_cast(unsigned, r); }
DEV float bflo(unsigned u) { return __uint_as_float(u << 16); }
DEV float bfhi(unsigned u) { return __uint_as_float(u & 0xffff0000u); }
DEV float rcpf_(float x) { return __builtin_amdgcn_rcpf(x); }
DEV float sigmoidf_(float x) { return rcpf_(1.0f + __expf(-x)); }
DEV float tanhf_(float x) { return 1.0f - 2.0f * rcpf_(1.0f + __expf(2.0f * x)); }
template <int CTRL> DEV float dppf(float x) { return __int_as_float(__builtin_amdgcn_update_dpp(0, __float_as_int(x), CTRL, 0xF, 0xF, false)); }
DEV float row16_sum(float x) { x += dppf<0xB1>(x); x += dppf<0x4E>(x); x += dppf<0x141>(x); x += dppf<0x140>(x); return x; }
DEV float wave_sum(float x) { x = row16_sum(x); x += __shfl_xor(x, 16); x += __shfl_xor(x, 32); return x; }
DEV int clampi(int v, int lo, int hi) { return v < lo ? lo : (v > hi ? hi : v); }
#define MFMA32(a, b, c) __builtin_amdgcn_mfma_f32_32x32x16_bf16((a), (b), (c), 0, 0, 0)

DEV int tid() { int z; asm volatile("v_mov_b32 %0, 0" : "=v"(z)); return (int)(threadIdx.x & 255u) + z; }
DEV int half_id() { return __builtin_amdgcn_readfirstlane((int)(threadIdx.x >> 8)); }
DEV void transpose_item(const float* W, bf16_t* WT, int K, int N, int kt, int nt, char* lds) {
  bf16_t* s = (bf16_t*)lds;
  const int t = tid();
#pragma unroll
  for (int i = 0; i < 4; ++i) {
    const int k = (t >> 4) + 16 * i, n4 = (t & 15) * 4;
    const float4 v = *(const float4*)(W + (size_t)(kt * 64 + k) * N + nt * 64 + n4);
    s[(n4 + 0) * 72 + k] = f2bf(v.x); s[(n4 + 1) * 72 + k] = f2bf(v.y);
    s[(n4 + 2) * 72 + k] = f2bf(v.z); s[(n4 + 3) * 72 + k] = f2bf(v.w);
  }
  __syncthreads();
#pragma unroll
  for (int i = 0; i < 2; ++i) {
    const int n = (t >> 3) + 32 * i, kc = t & 7;
    const uint4 v = *(const uint4*)(s + n * 72 + kc * 8);
    *(uint4*)(WT + (size_t)(nt * 64 + n) * K + kt * 64 + kc * 8) = v;
  }
  __syncthreads();
}

DEV void mod_item(const Params& p, int l, int jb, char* lds) {
  float* sc = (float*)lds;
  float* red = (float*)(lds + 12288);
  const int t = tid();
  for (int i = t; i < 3072; i += 256) {
    const int c = i >> 10, k = i & 1023;
    const float x = (c == 0) ? p.in[I_CCTX][k] : p.in[I_C][(c - 1) * 1024 + k];
    sc[i] = x * rcpf_(1.0f + __expf(-x));
  }
  __syncthreads();
  const int c4 = t & 15, ks = t >> 4;
  const float* wp = p.in[I_MODW] + ((size_t)l * 1024 + ks * 64) * 6144 + jb * 64 + c4 * 4;
  float a00 = 0, a01 = 0, a02 = 0, a03 = 0, a10 = 0, a11 = 0, a12 = 0, a13 = 0, a20 = 0, a21 = 0, a22 = 0, a23 = 0;
#pragma unroll 16
  for (int ii = 0; ii < 64; ++ii) {
    const float4 w = *(const float4*)(wp + (size_t)ii * 6144);
    const int k = ks * 64 + ii;
    const float s0 = sc[k], s1 = sc[1024 + k], s2 = sc[2048 + k];
    a00 += s0 * w.x; a01 += s0 * w.y; a02 += s0 * w.z; a03 += s0 * w.w;
    a10 += s1 * w.x; a11 += s1 * w.y; a12 += s1 * w.z; a13 += s1 * w.w;
    a20 += s2 * w.x; a21 += s2 * w.y; a22 += s2 * w.z; a23 += s2 * w.w;
  }
  float* r0 = red + (ks * 3 + 0) * 64 + c4 * 4; r0[0] = a00; r0[1] = a01; r0[2] = a02; r0[3] = a03;
  float* r1 = red + (ks * 3 + 1) * 64 + c4 * 4; r1[0] = a10; r1[1] = a11; r1[2] = a12; r1[3] = a13;
  float* r2 = red + (ks * 3 + 2) * 64 + c4 * 4; r2[0] = a20; r2[1] = a21; r2[2] = a22; r2[3] = a23;
  __syncthreads();
  if (t < 192) {
    const int c = t >> 6, col = t & 63;
    float v = p.in[I_MODB][l * 6144 + jb * 64 + col];
#pragma unroll
    for (int k2 = 0; k2 < 16; ++k2) v += red[(k2 * 3 + c) * 64 + col];
    ((float*)(p.ws + OFF_MOD))[(size_t)(l * 3 + c) * 6144 + jb * 64 + col] = v;
  }
  __syncthreads();
}

DEV void hglb_item(const Params& p) {
  const int c = tid();
  float* HGLB = (float*)(p.ws + OFF_HGLB);
  for (int dir = 0; dir < 2; ++dir) {
    float x[4], mx = -1e30f;
    for (int l = 0; l < 4; ++l) { x[l] = p.in[I_HGLB][(dir * 4 + l) * 256 + c]; mx = fmaxf(mx, x[l]); }
    float s = 0;
    for (int l = 0; l < 4; ++l) { x[l] = __expf(x[l] - mx); s += x[l]; }
    float cum = 0; const float s0 = x[0] / s;
    for (int l = 0; l < 4; ++l) { cum += x[l] / s; HGLB[(l * 2 + dir) * 256 + c] = cum - s0; }
  }
}

constexpr int NT_LAYER = 928 + 256 + 1024 + 1024;
struct TileDesc { const float* W; bf16_t* WT; int K, N, kt, nt; };
DEV TileDesc layer_tile_desc(const Params& p, int l, int j) {
  TileDesc d;
  if (j < 928) { d.W = p.in[I_WIN] + (size_t)l * D * DIN; d.WT = (bf16_t*)(p.ws + OFF_WIN) + (size_t)l * DINP * D; d.K = D; d.N = DIN; d.kt = j / 58; d.nt = j % 58; return d; }
  j -= 928;
  if (j < 256) { d.W = p.in[I_WOUT] + (size_t)l * D * D; d.WT = (bf16_t*)(p.ws + OFF_WOUT) + (size_t)l * D * D; d.K = D; d.N = D; d.kt = j / 16; d.nt = j % 16; return d; }
  j -= 256;
  if (j < 1024) { d.W = p.in[I_FW1] + (size_t)l * D * FF; d.WT = (bf16_t*)(p.ws + OFF_W1) + (size_t)l * FF * D; d.K = D; d.N = FF; d.kt = j / 64; d.nt = j % 64; return d; }
  j -= 1024;
  d.W = p.in[I_FW2] + (size_t)l * FF * D; d.WT = (bf16_t*)(p.ws + OFF_W2) + (size_t)l * D * FF; d.K = FF; d.N = D; d.kt = j / 16; d.nt = j % 16; return d;
}
DEV void tile_load(const TileDesc& d, float4 (&v)[4]) {
  const int t = tid();
#pragma unroll
  for (int i = 0; i < 4; ++i) v[i] = *(const float4*)(d.W + (size_t)(d.kt * 64 + (t >> 4) + 16 * i) * d.N + d.nt * 64 + (t & 15) * 4);
}
DEV void tile_store(const TileDesc& d, const float4 (&v)[4], char* lds) {
  bf16_t* s = (bf16_t*)lds;
  const int t = tid();
#pragma unroll
  for (int i = 0; i < 4; ++i) {
    const int k = (t >> 4) + 16 * i, n4 = (t & 15) * 4;
    s[(n4 + 0) * 72 + k] = f2bf(v[i].x); s[(n4 + 1) * 72 + k] = f2bf(v[i].y);
    s[(n4 + 2) * 72 + k] = f2bf(v[i].z); s[(n4 + 3) * 72 + k] = f2bf(v[i].w);
  }
  __syncthreads();
#pragma unroll
  for (int i = 0; i < 2; ++i) {
    const int n = (t >> 3) + 32 * i, kc = t & 7;
    const uint4 o = *(const uint4*)(s + n * 72 + kc * 8);
    *(uint4*)(d.WT + (size_t)(d.nt * 64 + n) * d.K + d.kt * 64 + kc * 8) = o;
  }
  __syncthreads();
}
DEV void layer_tiles(const Params& p, int l, int lo, int hi, int vb, int nvb, char* lds0) {
  const int hf = half_id(); char* lds = lds0 + hf * 65536;
  int it = lo + vb * 2 + hf;
  if (it >= hi) return;
  float4 vn[4];
  TileDesc dn = layer_tile_desc(p, l, it);
  tile_load(dn, vn);
  for (; it < hi; it += nvb * 2) {
    float4 vc[4] = {vn[0], vn[1], vn[2], vn[3]};
    const TileDesc dc = dn;
    if (it + nvb * 2 < hi) { dn = layer_tile_desc(p, l, it + nvb * 2); tile_load(dn, vn); }
    tile_store(dc, vc, lds);
  }
}

DEV void phase0(const Params& p, char* lds0) {
  const int hf = half_id(); char* lds = lds0 + hf * 65536;
  const int nitems = 386 + 4;
  for (int it = blockIdx.x * 2 + hf; it < nitems; it += gridDim.x * 2) {
    if (it < 384) { mod_item(p, it / 96, it % 96, lds); continue; }
    if (it == 384) { hglb_item(p); continue; }
    if (it == 385) continue;
    const int j = it - 386;
    {
      uint4* z = (uint4*)((bf16_t*)(p.ws + OFF_WIN) + ((size_t)j * DINP + DIN) * D);
      const int t = tid();
      for (int i = t; i < 128 * D * 2 / 16; i += 256) z[i] = make_uint4(0u, 0u, 0u, 0u);
    }
  }
  const int vb = ((int)blockIdx.x + (int)gridDim.x - 195 % (int)gridDim.x) % (int)gridDim.x;
  layer_tiles(p, 0, 0, NT_LAYER, vb, (int)gridDim.x, lds0);
}

DEV void row_phase(const Params& p, int mode, int l) {
  const int lane = tid() & 63;
  const int nw = gridDim.x * 8;
  const float* MOD = (const float*)(p.ws + OFF_MOD);
  const float* NG = p.in[I_NORMG];
  const bf16_t* U = (const bf16_t*)(p.ws + OFF_U);
  bf16_t* H = (bf16_t*)(p.ws + OFF_H);
  const bool has_next = !(mode == 2 && l == 3);
  const int ln = (mode == 0) ? 0 : (mode == 1 ? l : l + 1);
  const int gi = (mode == 1) ? 2 : 0, shi = (mode == 1) ? 3 : 0, sci = (mode == 1) ? 4 : 1;
  const float* ga = NG + (size_t)(l * 4 + (mode == 1 ? 1 : 3)) * 1024;
  const float* gb = NG + (size_t)((has_next ? ln : 0) * 4 + gi) * 1024;
  for (int rowa = blockIdx.x * 8 + half_id() * 4 + (tid() >> 6); rowa < MT; rowa += 2 * nw) {
    float4 x[2][4], u[2][4];
    int rows[2]; bool ok[2];
#pragma unroll
    for (int q = 0; q < 2; ++q) {
      rows[q] = rowa + q * nw; ok[q] = rows[q] < MT;
      const int row = ok[q] ? rows[q] : rowa;
      if (mode == 0) {
        const float* src = row < NCTX ? p.in[I_XP] + (size_t)row * D : p.in[I_XS] + (size_t)(row - NCTX) * D;
#pragma unroll
        for (int i = 0; i < 4; ++i) x[q][i] = *(const float4*)(src + i * 256 + lane * 4);
      } else {
#pragma unroll
        for (int i = 0; i < 4; ++i) {
          x[q][i] = *(const float4*)(p.out + (size_t)row * D + i * 256 + lane * 4);
          const uint2 ub = *(const uint2*)(U + (size_t)row * D + i * 256 + lane * 4);
          u[q][i] = make_float4(bflo(ub.x), bfhi(ub.x), bflo(ub.y), bfhi(ub.y));
        }
      }
    }
#pragma unroll
    for (int q = 0; q < 2; ++q) {
      const int row = ok[q] ? rows[q] : rowa;
      const int cond = row < NCTX ? 0 : 1 + ((row - NCTX) >> 10);
      if (mode != 0) {
        float ss = 0;
#pragma unroll
        for (int i = 0; i < 4; ++i) ss += u[q][i].x * u[q][i].x + u[q][i].y * u[q][i].y + u[q][i].z * u[q][i].z + u[q][i].w * u[q][i].w;
        ss = wave_sum(ss);
        const float r = rsqrtf(ss * (1.0f / 1024.0f) + 1e-6f);
        const float* gate = MOD + (size_t)(l * 3 + cond) * 6144 + (mode == 1 ? 2 : 5) * 1024;
#pragma unroll
        for (int i = 0; i < 4; ++i) {
          const float4 g4 = *(const float4*)(gate + i * 256 + lane * 4);
          const float4 a4 = *(const float4*)(ga + i * 256 + lane * 4);
          x[q][i].x += g4.x * (u[q][i].x * r * a4.x); x[q][i].y += g4.y * (u[q][i].y * r * a4.y);
          x[q][i].z += g4.z * (u[q][i].z * r * a4.z); x[q][i].w += g4.w * (u[q][i].w * r * a4.w);
        }
      }
      if (ok[q]) {
#pragma unroll
        for (int i = 0; i < 4; ++i) *(float4*)(p.out + (size_t)row * D + i * 256 + lane * 4) = x[q][i];
      }
      if (has_next) {
        float ss = 0;
#pragma unroll
        for (int i = 0; i < 4; ++i) ss += x[q][i].x * x[q][i].x + x[q][i].y * x[q][i].y + x[q][i].z * x[q][i].z + x[q][i].w * x[q][i].w;
        ss = wave_sum(ss);
        const float r2 = rsqrtf(ss * (1.0f / 1024.0f) + 1e-6f);
        const float* sh = MOD + (size_t)(ln * 3 + cond) * 6144 + shi * 1024;
        const float* sc = MOD + (size_t)(ln * 3 + cond) * 6144 + sci * 1024;
        if (ok[q]) {
#pragma unroll
          for (int i = 0; i < 4; ++i) {
            const float4 g4 = *(const float4*)(gb + i * 256 + lane * 4);
            const float4 s4 = *(const float4*)(sc + i * 256 + lane * 4);
            const float4 h4 = *(const float4*)(sh + i * 256 + lane * 4);
            const float h0 = x[q][i].x * r2 * g4.x * (1.0f + s4.x) + h4.x;
            const float h1 = x[q][i].y * r2 * g4.y * (1.0f + s4.y) + h4.y;
            const float h2 = x[q][i].z * r2 * g4.z * (1.0f + s4.z) + h4.z;
            const float h3 = x[q][i].w * r2 * g4.w * (1.0f + s4.w) + h4.w;
            uint2 o; o.x = pk2(h0, h1); o.y = pk2(h2, h3);
            *(uint2*)(H + (size_t)row * D + i * 256 + lane * 4) = o;
          }
        }
      }
    }
  }
}

namespace pg8 {
#define PG8_LAS __attribute__((address_space(3)))
typedef unsigned short bf16_t;
typedef short bf16x8 __attribute__((ext_vector_type(8)));
typedef float f32x4 __attribute__((ext_vector_type(4)));
typedef unsigned u32x4 __attribute__((ext_vector_type(4)));
constexpr int BM = 256, BK = 64, HALF = 128, HTB = HALF * BK * 2  , STAGE_BYTES = 8 * HTB, NXCD = 8, WGM = 8;

__host__ __device__ __forceinline__ int lds_byte(int r, int c) { const int st = (r >> 4) * 2 + (c >> 5), rr = r & 15, cc = c & 31, ob = rr * 64 + cc * 2; return st * 1024 + (ob ^ (((ob >> 9) & 1) << 5)); }
__host__ __device__ __forceinline__ void stage_rc(int b, int& R, int& C) { const int st = b / 1024, sb = b % 1024, swz = sb ^ (((sb >> 9) & 1) << 5); R = (st >> 1) * 16 + swz / 64; C = (st & 1) * 32 + (swz % 64) / 2; }
__host__ __device__ __forceinline__ int perm32(int rho) { const int n = rho >> 4, i = rho & 15; return 8 * (i >> 2) + 4 * n + (i & 3); }

struct Unit { int pm, pn; };
struct Gemm { const bf16_t* A; const bf16_t* Bt; int M, N, K; };

struct StaticOrder {
    int nM, nN, nwg, G, c;
    __host__ __device__ void init(int M, int N, int G_, int c_) { nM = M / BM; nN = N / BM; nwg = nM * nN; G = G_; c = c_; }
    __host__ __device__ bool next(int i, Unit& u) const {
        const long L = (long)i * G + c; if (L >= nwg) return false;
        int wgid = (int)L; { const int q = nwg / NXCD, r = nwg % NXCD, xcd = wgid % NXCD, off = wgid / NXCD; wgid = (xcd < r ? xcd * (q + 1) : r * (q + 1) + (xcd - r) * q) + off; }
        const int nig = WGM * nN, gid = wgid / nig, fm = gid * WGM, gsz = (nM - fm) < WGM ? (nM - fm) : WGM;
        u.pm = fm + ((wgid % nig) % gsz); u.pn = (wgid % nig) / gsz; return true;
    }
    __device__ __forceinline__ void a_ready(const Unit&) const {}
    __device__ __forceinline__ void done(const Unit&) const {}
};

template <class Epi, class Sched, bool ALIGN_EPI = false, bool SP2 = false>
__device__ __forceinline__ void gemm_phase(PG8_LAS unsigned char* lds, const Gemm g, const Sched& S, const Epi& E) {
    int tid_z; asm volatile("v_mov_b32 %0, 0" : "=v"(tid_z)); const int tid = (int)threadIdx.x + tid_z, wid = __builtin_amdgcn_readfirstlane(tid >> 6), lane = tid & 63, wr = wid >> 2, wc = wid & 3, fr = lane & 15, fq = lane >> 4;
    const int K = g.K, nt = K / BK;
    unsigned voffA[2], voffB[2];
#pragma unroll
    for (int i = 0; i < 2; ++i) { int R, C; stage_rc(tid * 16 + i * 8192, R, C); const int Rb = Epi::PERM ? ((R & ~31) + perm32(R & 31)) : R;
        voffA[i] = (unsigned)(R * K + C) * 2u; voffB[i] = (unsigned)(Rb * K + C) * 2u; }
    const size_t kstep = (size_t)(BK * 2);
    const size_t hstep = (size_t)HALF * K * 2;
    const size_t tstep = 2 * hstep;
    const unsigned ldsw = (unsigned)wid * 1024u;
    const int aoff = lds_byte(wr * 64 + fr, fq * 8), boff = lds_byte(wc * 32 + fr, fq * 8);
#define PG8_SA(b, h) (((b) * 2 + (h)) * HTB)
#define PG8_SB(b, h) ((4 + (b) * 2 + (h)) * HTB)
#define PG8_STAGE(bufoff, gbase, voff) do { _Pragma("unroll") for (int _i = 0; _i < 2; ++_i) \
        __builtin_amdgcn_global_load_lds((const unsigned*)((const char*)(gbase) + (voff)[_i]), (PG8_LAS unsigned*)(lds + (bufoff) + ldsw + _i * 8192), 16, 0, 0); } while (0)
#define PG8_LDA(dst, b, h) do { _Pragma("unroll") for (int m = 0; m < 4; ++m) _Pragma("unroll") for (int k = 0; k < 2; ++k) dst[m][k] = *(const PG8_LAS bf16x8*)(lds + PG8_SA(b, h) + aoff + m * 2048 + k * 1024); } while (0)
#define PG8_LDB(dst, b, h) do { _Pragma("unroll") for (int n = 0; n < 2; ++n) _Pragma("unroll") for (int k = 0; k < 2; ++k) dst[n][k] = *(const PG8_LAS bf16x8*)(lds + PG8_SB(b, h) + boff + n * 2048 + k * 1024); } while (0)
#define PG8_MMA(ai, bj, At, Bt) do { __builtin_amdgcn_s_setprio(1); _Pragma("unroll") for (int m = 0; m < 4; ++m) _Pragma("unroll") for (int n = 0; n < 2; ++n) _Pragma("unroll") for (int k = 0; k < 2; ++k) \
        acc[ai][bj][m][n] = __builtin_amdgcn_mfma_f32_16x16x32_bf16(Bt[n][k], At[m][k], acc[ai][bj][m][n], 0, 0, 0); __builtin_amdgcn_s_setprio(0); } while (0)
#define PG8_WAIT_V(n) asm volatile("s_waitcnt vmcnt(" #n ")" ::: "memory")
#define PG8_WAIT_L(n) asm volatile("s_waitcnt lgkmcnt(" #n ")" ::: "memory")
#define PG8_BAR __builtin_amdgcn_s_barrier()
#define PG8_SCHED __builtin_amdgcn_sched_barrier(0)
    Unit cur, nxt; int ui = 0;
    if (!S.next(0, cur)) return;
    f32x4 acc[2][2][4][2];
#pragma unroll
    for (int a = 0; a < 2; ++a)
#pragma unroll
        for (int b = 0; b < 2; ++b)
#pragma unroll
            for (int m = 0; m < 4; ++m)
#pragma unroll
                for (int n = 0; n < 2; ++n) acc[a][b][m][n] = (f32x4){0.f, 0.f, 0.f, 0.f};
    bf16x8 At[4][2], B0[2][2], B1[2][2];
    const char* cA = (const char*)g.A + (size_t)cur.pm * tstep; const char* cB = (const char*)g.Bt + (size_t)cur.pn * tstep;
    S.a_ready(cur);
    if constexpr (SP2) {
        PG8_STAGE(PG8_SB(0, 0), cB, voffB); PG8_STAGE(PG8_SB(0, 1), cB + hstep, voffB); PG8_STAGE(PG8_SA(0, 0), cA, voffA); PG8_STAGE(PG8_SA(0, 1), cA + hstep, voffA);
        if (wr == 1) PG8_BAR;
        PG8_WAIT_V(2); PG8_BAR;
        PG8_STAGE(PG8_SB(1, 0), cB + kstep, voffB); PG8_STAGE(PG8_SA(1, 0), cA + kstep, voffA); PG8_STAGE(PG8_SB(1, 1), cB + hstep + kstep, voffB);
        PG8_WAIT_V(6); PG8_BAR;
    } else {
        PG8_STAGE(PG8_SB(0, 0), cB, voffB); PG8_STAGE(PG8_SA(0, 0), cA, voffA); PG8_STAGE(PG8_SB(0, 1), cB + hstep, voffB); PG8_STAGE(PG8_SA(0, 1), cA + hstep, voffA);
        if (wr == 1) PG8_BAR;
        PG8_WAIT_V(4); PG8_BAR;
        PG8_STAGE(PG8_SB(1, 0), cB + kstep, voffB); PG8_STAGE(PG8_SA(1, 0), cA + kstep, voffA); PG8_STAGE(PG8_SB(1, 1), cB + hstep + kstep, voffB);
        PG8_WAIT_V(6); PG8_BAR;
    }
    for (;;) {
        const bool has_next = S.next(ui + 1, nxt);
        const char* nA = has_next ? (const char*)g.A + (size_t)nxt.pm * tstep : cA; const char* nB = has_next ? (const char*)g.Bt + (size_t)nxt.pn * tstep : cB;
        for (int t = 0; t < nt; t += 2) {
            const bool last = (t == nt - 2);
            const char* a1 = cA + (size_t)(t + 1) * kstep;
            const char* a2 = last ? nA : cA + (size_t)(t + 2) * kstep; const char* b2 = last ? nB : cB + (size_t)(t + 2) * kstep;
            const char* a3 = a2 + kstep; const char* b3 = b2 + kstep;
            if (last && has_next) S.a_ready(nxt);
            if constexpr (SP2) {
            PG8_LDB(B0, 0, 0); PG8_LDB(B1, 0, 1); PG8_SCHED; PG8_LDA(At, 0, 0); PG8_STAGE(PG8_SA(1, 1), a1 + hstep, voffA);
            PG8_WAIT_V(8); PG8_WAIT_L(0); PG8_BAR; PG8_MMA(0, 0, At, B0); PG8_MMA(0, 1, At, B1); PG8_BAR; PG8_SCHED;
            PG8_LDA(At, 0, 1); PG8_STAGE(PG8_SB(0, 0), b2, voffB); PG8_STAGE(PG8_SB(0, 1), b2 + hstep, voffB); PG8_STAGE(PG8_SA(0, 0), a2, voffA);
            PG8_WAIT_V(8); PG8_WAIT_L(0); PG8_BAR; PG8_MMA(1, 0, At, B0); PG8_MMA(1, 1, At, B1); PG8_BAR; PG8_SCHED;
            PG8_LDB(B0, 1, 0); PG8_LDB(B1, 1, 1); PG8_SCHED; PG8_LDA(At, 1, 0); PG8_STAGE(PG8_SA(0, 1), a2 + hstep, voffA);
            PG8_WAIT_V(8); PG8_WAIT_L(0); PG8_BAR; PG8_MMA(0, 0, At, B0); PG8_MMA(0, 1, At, B1); PG8_BAR; PG8_SCHED;
            PG8_LDA(At, 1, 1); PG8_STAGE(PG8_SB(1, 0), b3, voffB); PG8_STAGE(PG8_SB(1, 1), b3 + hstep, voffB); PG8_STAGE(PG8_SA(1, 0), a3, voffA);
            PG8_WAIT_V(8); PG8_WAIT_L(0); PG8_BAR; PG8_MMA(1, 0, At, B0); PG8_MMA(1, 1, At, B1); PG8_BAR; PG8_SCHED;
            } else {
            PG8_LDB(B0, 0, 0); PG8_SCHED; PG8_LDA(At, 0, 0); PG8_STAGE(PG8_SA(1, 1), a1 + hstep, voffA);
            PG8_WAIT_L(8); PG8_BAR; PG8_WAIT_L(0); PG8_MMA(0, 0, At, B0); PG8_BAR; PG8_SCHED;
            PG8_LDB(B1, 0, 1); PG8_STAGE(PG8_SB(0, 0), b2, voffB);
            PG8_BAR; PG8_WAIT_L(0); PG8_MMA(0, 1, At, B1); PG8_BAR;
            PG8_LDA(At, 0, 1); PG8_STAGE(PG8_SA(0, 0), a2, voffA);
            PG8_BAR; PG8_WAIT_L(0); PG8_MMA(1, 0, At, B0); PG8_BAR; PG8_SCHED;
            PG8_STAGE(PG8_SB(0, 1), b2 + hstep, voffB);
            PG8_WAIT_V(6); PG8_BAR; PG8_MMA(1, 1, At, B1); PG8_BAR;
            PG8_LDB(B0, 1, 0); PG8_SCHED; PG8_LDA(At, 1, 0); PG8_STAGE(PG8_SA(0, 1), a2 + hstep, voffA);
            PG8_WAIT_L(8); PG8_BAR; PG8_WAIT_L(0); PG8_MMA(0, 0, At, B0); PG8_BAR; PG8_SCHED;
            PG8_LDB(B1, 1, 1); PG8_STAGE(PG8_SB(1, 0), b3, voffB);
            PG8_BAR; PG8_WAIT_L(0); PG8_MMA(0, 1, At, B1); PG8_BAR;
            PG8_LDA(At, 1, 1); PG8_STAGE(PG8_SA(1, 0), a3, voffA);
            PG8_BAR; PG8_WAIT_L(0); PG8_MMA(1, 0, At, B0); PG8_BAR; PG8_SCHED;
            PG8_STAGE(PG8_SB(1, 1), b3 + hstep, voffB);
            PG8_WAIT_V(6); PG8_BAR; PG8_MMA(1, 1, At, B1); PG8_BAR;
            }
        }
        if constexpr (ALIGN_EPI) { if (wr == 0) PG8_BAR; }
        if constexpr (!Epi::AFTER_DRAIN) { E(acc, cur, wr, wc, fr, fq); S.done(cur); }
        if (!has_next) break;
#pragma unroll
        for (int a = 0; a < 2; ++a)
#pragma unroll
            for (int b = 0; b < 2; ++b)
#pragma unroll
                for (int m = 0; m < 4; ++m)
#pragma unroll
                    for (int n = 0; n < 2; ++n) acc[a][b][m][n] = (f32x4){0.f, 0.f, 0.f, 0.f};
        cur = nxt; cA = nA; cB = nB; ++ui;
        if constexpr (ALIGN_EPI) { if (wr == 1) PG8_BAR; }
    }
    PG8_WAIT_V(0);
    if constexpr (!ALIGN_EPI) { if (wr == 0) PG8_BAR; }
    PG8_BAR;
    if constexpr (Epi::AFTER_DRAIN) { E.fused(acc, cur, wr, wc, fr, fq, lds, wid, lane); S.done(cur); }
#undef PG8_SA
#undef PG8_SB
#undef PG8_STAGE
#undef PG8_LDA
#undef PG8_LDB
#undef PG8_MMA
#undef PG8_WAIT_V
#undef PG8_WAIT_L
#undef PG8_BAR
#undef PG8_SCHED
}
}

template <int MODE> struct EpiMK {
  static constexpr bool PERM = false, AFTER_DRAIN = false;
  const Params* pp; int l;
  DEV void operator()(const pg8::f32x4 (&acc)[2][2][4][2], const pg8::Unit& u, int wr, int wc, int fr, int fq) const {
    const Params& p = *pp;
#pragma unroll
    for (int ai = 0; ai < 2; ++ai)
#pragma unroll
      for (int m = 0; m < 4; ++m) {
        const int row = u.pm * 256 + ai * 128 + wr * 64 + m * 16 + fr;
#pragma unroll
        for (int bj = 0; bj < 2; ++bj)
#pragma unroll
          for (int n = 0; n < 2; ++n) {
            const int col = u.pn * 256 + bj * 128 + wc * 32 + n * 16 + fq * 4;
            const pg8::f32x4 v = acc[ai][bj][m][n];
            if (MODE == 0) {
              if (col < DIN) {
                uint2 o; o.x = pk2(v[0], v[1]); o.y = pk2(v[2], v[3]);
                *(uint2*)((bf16_t*)(p.ws + OFF_P) + (size_t)row * DIN + col) = o;
                if (row < NCTX) {
                  if (col >= C_NK && col < C_HQ) {
                    const int kv = col >= C_NV;
                    *(pg8::f32x4*)(p.out + O_NAT + (size_t)(((row >> 8) * 4 + l) * 2 + kv) * 65536 + (row & 255) * 256 + (col - (kv ? C_NV : C_NK))) = v;
                  } else if (col >= C_SK) {
                    const int kv = col >= C_SV;
                    *(pg8::f32x4*)(p.out + O_SWA + (size_t)(((row >> 8) * 4 + l) * 2 + kv) * 32768 + (row & 255) * 128 + (col - (kv ? C_SV : C_SK))) = v;
                  }
                }
              }
            } else if (MODE == 1) {
              uint2 o; o.x = pk2(v[0], v[1]); o.y = pk2(v[2], v[3]);
              *(uint2*)((bf16_t*)(p.ws + OFF_U) + (size_t)row * D + col) = o;
            } else {
              const float r0 = fmaxf(v[0], 0.f), r1 = fmaxf(v[1], 0.f), r2 = fmaxf(v[2], 0.f), r3 = fmaxf(v[3], 0.f);
              uint2 o; o.x = pk2(r0 * r0, r1 * r1); o.y = pk2(r2 * r2, r3 * r3);
              *(uint2*)((bf16_t*)(p.ws + OFF_HID) + (size_t)row * FF + col) = o;
            }
          }
      }
  }
};

template <int MODE>
DEV void gemm_run(const Params& p, int l, const bf16_t* A, const bf16_t* BT, int K, int N, char* lds) {
  pg8::Gemm g{A, BT, MT, N, K};
  pg8::StaticOrder S; S.init(MT, N, (int)gridDim.x, (int)blockIdx.x);
  EpiMK<MODE> E{&p, l};
  pg8::gemm_phase<EpiMK<MODE>, pg8::StaticOrder, true, true>((PG8_LAS unsigned char*)lds, g, S, E);
  if (MODE == 1 && l < 3 && (int)gridDim.x > 160 && (int)blockIdx.x >= 160) {
    if (K == D) layer_tiles(p, l + 1, 0, 640, (int)blockIdx.x - 160, (int)gridDim.x - 160, lds);
    else layer_tiles(p, l + 1, 640, NT_LAYER, (int)blockIdx.x - 160, (int)gridDim.x - 160, lds);
  }
}

constexpr int TOKT = 20;
DEV void prep_item(const Params& p, int l, int tile, char* lds) {
  const int t = tid(), r0 = tile * TOKT, c = t;
  float* sT = (float*)lds;
  float* swl = sT + 128 * TOKT;
  float* sal = swl + TOKT * 256;
  const bf16_t* P = (const bf16_t*)(p.ws + OFF_P);
  float* PREP = (float*)(p.ws + OFF_PREP);
  float* BON = (float*)(p.ws + OFF_BONUS);
  for (int dir = 0; dir < 2; ++dir) {
    __syncthreads();
#pragma unroll
    for (int i = 0; i < TOKT / 2; ++i) {
      const int e = t + 256 * i, tk = e >> 7, j = e & 127, which = j >> 6, jj = j & 63;
      const int row = r0 + tk, prow = dir ? row + 1 : row - 1;
      const int tis = row < NCTX ? (row & 255) : ((row - NCTX) & 1023), Tm1 = row < NCTX ? 255 : 1023;
      const bool pv = dir ? (tis < Tm1) : (tis > 0);
      const int col = (dir ? C_WHB : C_WHF) + which * 64 + jj;
      const float cur = bf2f(P[(size_t)row * DIN + col]);
      const float prev = bf2f(P[(size_t)(pv ? prow : row) * DIN + col]) * (pv ? 1.f : 0.f);
      const float mu = p.in[I_MULORA][((l * 2 + dir) * 2 + which) * 64 + jj];
      const float val = cur + (prev - cur) * mu;
      sT[j * TOKT + tk] = (which == 0) ? tanhf_(val) : val;
    }
    __syncthreads();
    {
      const float* w2p = p.in[I_W2] + (size_t)(l * 2 + dir) * 64 * 256 + c;
      const float* a2p = p.in[I_A2] + (size_t)(l * 2 + dir) * 64 * 256 + c;
#pragma unroll
      for (int which = 0; which < 2; ++which) {
        float acc[TOKT];
#pragma unroll
        for (int k = 0; k < TOKT; ++k) acc[k] = 0.f;
        float colv[64];
        const float* cp = which ? a2p : w2p;
#pragma unroll
        for (int j = 0; j < 64; ++j) colv[j] = cp[j * 256];
#pragma unroll
        for (int j = 0; j < 64; ++j) {
#pragma unroll
          for (int k4 = 0; k4 < TOKT / 4; ++k4) {
            const float4 x4 = *(const float4*)(sT + (which * 64 + j) * TOKT + k4 * 4);
            acc[k4 * 4 + 0] += x4.x * colv[j]; acc[k4 * 4 + 1] += x4.y * colv[j]; acc[k4 * 4 + 2] += x4.z * colv[j]; acc[k4 * 4 + 3] += x4.w * colv[j];
          }
        }
        float* dst = which ? sal : swl;
#pragma unroll
        for (int k = 0; k < TOKT; ++k) dst[k * 256 + c] = acc[k];
      }
#pragma unroll
      for (int k = 0; k < 1; ++k) {}
    }
    const float w0v = p.in[I_W0][(l * 2 + dir) * 256 + c], a0v = p.in[I_A0][(l * 2 + dir) * 256 + c];
    const float kkv = p.in[I_KK][l * 256 + c], kav = p.in[I_KA][l * 256 + c], rkv = p.in[I_RK][l * 256 + c];
    const float mur = p.in[I_MURKV][((l * 2 + dir) * 3 + 0) * 256 + c], muk = p.in[I_MURKV][((l * 2 + dir) * 3 + 1) * 256 + c],
                muv = p.in[I_MURKV][((l * 2 + dir) * 3 + 2) * 256 + c];
    float* pr = PREP + (size_t)dir * 6 * ARRF;
    for (int tb = 0; tb < TOKT; tb += 5) {
      float rc[5], kc[5], vc[5], rp[5], kq[5], vp[5], wlv[5], alv[5];
#pragma unroll
      for (int u = 0; u < 5; ++u) {
        const int tk = tb + u, row = r0 + tk, prow = dir ? row + 1 : row - 1;
        const int tis = row < NCTX ? (row & 255) : ((row - NCTX) & 1023), Tm1 = row < NCTX ? 255 : 1023;
        const bool pv = dir ? (tis < Tm1) : (tis > 0);
        const float pm = pv ? 1.f : 0.f;
        const bf16_t* pc = P + (size_t)row * DIN + c;
        const bf16_t* pp = P + (size_t)(pv ? prow : row) * DIN + c;
        rc[u] = bf2f(pc[C_R]); kc[u] = bf2f(pc[C_K]); vc[u] = bf2f(pc[C_V]);
        rp[u] = bf2f(pp[C_R]) * pm; kq[u] = bf2f(pp[C_K]) * pm; vp[u] = bf2f(pp[C_V]) * pm;
        wlv[u] = swl[tk * 256 + c]; alv[u] = sal[tk * 256 + c];
      }
      float bprev[5];
#pragma unroll
      for (int u = 0; u < 5; ++u) bprev[u] = (dir == 1) ? BON[(size_t)(r0 + tb + u) * 256 + c] : 0.f;
#pragma unroll
      for (int u = 0; u < 5; ++u) {
        const int row = r0 + tb + u;
        const float rs = rc[u] + (rp[u] - rc[u]) * mur, ks = kc[u] + (kq[u] - kc[u]) * muk, vs = vc[u] + (vp[u] - vc[u]) * muv;
        const float wl = w0v + wlv[u], al = a0v + alv[u];
        const float wv = __expf(-0.6065306597126334f * sigmoidf_(wl));
        const float av = sigmoidf_(al);
        const float kkr = ks * kkv;
        const float n2 = wave_sum(kkr * kkr);
        const float kk = kkr * rcpf_(fmaxf(__builtin_amdgcn_sqrtf(n2), 1e-12f));
        const float kp = ks * (1.0f + (av - 1.0f) * kav);
        const float bs = wave_sum(rs * kp * rkv);
        const float bon = bs * vs;
        const size_t idx = (size_t)row * 256 + c;
        pr[idx] = rs; pr[ARRF + idx] = wv; pr[2 * ARRF + idx] = kp; pr[3 * ARRF + idx] = vs; pr[4 * ARRF + idx] = kk; pr[5 * ARRF + idx] = kk * av;
        BON[idx] = bprev[u] + bon;
      }
    }
  }
  __syncthreads();
}

DEV void rope_item(const Params& p, int item) {
  bf16_t* P = (bf16_t*)(p.ws + OFF_P);
  const int t = tid();
  for (int e = t; e < 64 * 192; e += 256) {
    const int tk = e / 192, r = e % 192, hs = r >> 5, pi = r & 31;
    const int lt = item * 64 + tk;
    const int tt = lt & 1023;
    const int grow = tt >> 6, gcol = tt & 63;
    const int fi = pi & 15;
    const float pos = (pi < 16) ? (float)grow : (float)gcol;
    const float inv = exp2f(-(float)fi * (13.287712379549449f / 16.0f));
    const float ang = pos * inv;
    const float cs = __cosf(ang), sn = __sinf(ang);
    const int d1 = (pi < 16) ? fi : 32 + fi;
    bf16_t* base = P + (size_t)(NCTX + lt) * DIN + C_SQ + hs * 64;
    const float x1 = bf2f(base[d1]), x2 = bf2f(base[d1 + 16]);
    base[d1] = f2bf(x1 * cs - x2 * sn);
    base[d1 + 16] = f2bf(x2 * cs + x1 * sn);
  }
}

constexpr int SC_BUF = 20480 + 4096;
typedef float f2 __attribute__((ext_vector_type(2)));
DEV float dot4(const float4& a, const float4& b) { return a.x * b.x + a.y * b.y + a.z * b.z + a.w * b.w; }
DEV float red8(float x) { x += dppf<0xB1>(x); x += dppf<0x4E>(x); x += dppf<0x141>(x); return x; }
DEV float dot8(const f2 (&S)[4], const float4& a, const float4& b) {
  f2 acc = S[0] * (f2){a.x, a.y};
  acc += S[1] * (f2){a.z, a.w}; acc += S[2] * (f2){b.x, b.y}; acc += S[3] * (f2){b.z, b.w};
  return acc.x + acc.y;
}

template <int NCH>
DEV void rwkv_scan(const Params& p, int l, int seq, int head, int dir, int rsel, char* lds) {
  const int t = tid(), rr = t >> 3, g = t & 7, rl = t >> 4, ks = t & 15;
  const int T = seq < 32 ? 256 : 1024;
  const int row0 = seq < 32 ? seq * 256 : NCTX + (seq - 32) * 1024;
  const float* prep = (const float*)(p.ws + OFF_PREP) + (size_t)dir * 6 * ARRF;
  float* ydir = (float*)(p.ws + OFF_YDIR) + (size_t)dir * ARRF;
  const int vbase = (NCH == 2) ? 0 : rsel * 32;
  f2 S[NCH][4];
#pragma unroll
  for (int c = 0; c < NCH; ++c)
#pragma unroll
    for (int j = 0; j < 4; ++j) S[c][j] = (f2){0.f, 0.f};
  if (seq >= 32) {
    const float* sp = p.in[I_SRW] + ((((size_t)(seq - 32) * 4 + l) * 2 + dir) * 4 + head) * 4096 + g * 8;
#pragma unroll
    for (int c = 0; c < NCH; ++c) {
      const float4 a = *(const float4*)(sp + (vbase + rr + 32 * c) * 64), b = *(const float4*)(sp + (vbase + rr + 32 * c) * 64 + 4);
      S[c][0] = (f2){a.x, a.y}; S[c][1] = (f2){a.z, a.w}; S[c][2] = (f2){b.x, b.y}; S[c][3] = (f2){b.z, b.w};
    }
  }
  const int nch = T >> 4;
  float4 pre0, pre1, pre2, pre3, pre4, pvv;
#define RW_LOAD(cc) do { const int s_ = (cc) * 16 + rl; const int tok_ = dir ? (T - 1 - s_) : s_; \
    const size_t base_ = (size_t)(row0 + tok_) * 256 + head * 64; \
    pre0 = *(const float4*)(prep + base_ + ks * 4); pre1 = *(const float4*)(prep + ARRF + base_ + ks * 4); \
    pre2 = *(const float4*)(prep + 2 * ARRF + base_ + ks * 4); pre3 = *(const float4*)(prep + 4 * ARRF + base_ + ks * 4); \
    pre4 = *(const float4*)(prep + 5 * ARRF + base_ + ks * 4); \
    if (NCH == 2) pvv = *(const float4*)(prep + 3 * ARRF + base_ + ks * 4); \
    else { const f2 v2_ = *(const f2*)(prep + 3 * ARRF + base_ + vbase + ks * 2); pvv.x = v2_.x; pvv.y = v2_.y; } } while (0)
#define RW_WRITE(bb) do { float4* sb_ = (float4*)(lds + (bb) * SC_BUF); float* vb_ = (float*)(lds + (bb) * SC_BUF + 20480); \
    sb_[(0 * 16 + rl) * 16 + ks] = pre0; sb_[(1 * 16 + rl) * 16 + ks] = pre1; sb_[(2 * 16 + rl) * 16 + ks] = pre2; \
    sb_[(3 * 16 + rl) * 16 + ks] = pre3; sb_[(4 * 16 + rl) * 16 + ks] = pre4; \
    if (NCH == 2) *(float4*)(vb_ + rl * 64 + ks * 4) = pvv; else *(f2*)(vb_ + rl * 64 + ks * 2) = (f2){pvv.x, pvv.y}; } while (0)
  __syncthreads();
  RW_LOAD(0); RW_WRITE(0);
  __syncthreads();
  for (int c = 0; c < nch; ++c) {
    if (c + 1 < nch) RW_LOAD(c + 1);
    const float4* sbuf = (const float4*)(lds + (c & 1) * SC_BUF);
    const float* vbuf = (const float*)(lds + (c & 1) * SC_BUF + 20480);
    float ym[NCH][2];
#pragma unroll
    for (int cc = 0; cc < NCH; ++cc) { ym[cc][0] = 0.f; ym[cc][1] = 0.f; }
#pragma unroll
    for (int i = 0; i < 16; ++i) {
      const float4 ra = sbuf[(0 * 16 + i) * 16 + g * 2], rb = sbuf[(0 * 16 + i) * 16 + g * 2 + 1];
      const float4 wa = sbuf[(1 * 16 + i) * 16 + g * 2], wb = sbuf[(1 * 16 + i) * 16 + g * 2 + 1];
      const float4 ka_ = sbuf[(2 * 16 + i) * 16 + g * 2], kb_ = sbuf[(2 * 16 + i) * 16 + g * 2 + 1];
      const float4 na = sbuf[(3 * 16 + i) * 16 + g * 2], nb = sbuf[(3 * 16 + i) * 16 + g * 2 + 1];
      const float4 aa = sbuf[(4 * 16 + i) * 16 + g * 2], ab = sbuf[(4 * 16 + i) * 16 + g * 2 + 1];
      const f2 w2[4] = {(f2){wa.x, wa.y}, (f2){wa.z, wa.w}, (f2){wb.x, wb.y}, (f2){wb.z, wb.w}};
      const f2 k2[4] = {(f2){ka_.x, ka_.y}, (f2){ka_.z, ka_.w}, (f2){kb_.x, kb_.y}, (f2){kb_.z, kb_.w}};
      const f2 a2[4] = {(f2){aa.x, aa.y}, (f2){aa.z, aa.w}, (f2){ab.x, ab.y}, (f2){ab.z, ab.w}};
#pragma unroll
      for (int cc = 0; cc < NCH; ++cc) {
        const float v = vbuf[i * 64 + rr + 32 * cc];
        const float sa = -red8(dot8(S[cc], na, nb));
#pragma unroll
        for (int j = 0; j < 4; ++j) S[cc][j] = S[cc][j] * w2[j] + a2[j] * sa + k2[j] * v;
        const float y = red8(dot8(S[cc], ra, rb));
        ym[cc][i >> 3] = (g == (i & 7)) ? y : ym[cc][i >> 3];
      }
    }
#pragma unroll
    for (int hh = 0; hh < 2; ++hh) {
      const int s = c * 16 + hh * 8 + g; const int tok = dir ? (T - 1 - s) : s;
      float* yo = ydir + (size_t)(row0 + tok) * 256 + head * 64 + vbase + rr;
#pragma unroll
      for (int cc = 0; cc < NCH; ++cc) yo[32 * cc] = ym[cc][hh];
    }
    if (c + 1 < nch) RW_WRITE((c + 1) & 1);
    __syncthreads();
  }
#undef RW_LOAD
#undef RW_WRITE
  if (seq < 32) {
    float* sp = p.out + O_RW + ((((size_t)seq * 4 + l) * 2 + dir) * 4 + head) * 4096 + g * 8;
#pragma unroll
    for (int c = 0; c < NCH; ++c) {
      *(float4*)(sp + (vbase + rr + 32 * c) * 64) = make_float4(S[c][0].x, S[c][0].y, S[c][1].x, S[c][1].y);
      *(float4*)(sp + (vbase + rr + 32 * c) * 64 + 4) = make_float4(S[c][2].x, S[c][2].y, S[c][3].x, S[c][3].y);
    }
  }
}

template <int NCH>
DEV void hgrn_scan(const Params& p, int l, int seq, int head, int dir, int rsel, char* lds) {
  const int t = tid(), rr = t >> 3, g = t & 7, rl = t >> 4, ks = t & 15;
  const int T = seq < 32 ? 256 : 1024;
  const int row0 = seq < 32 ? seq * 256 : NCTX + (seq - 32) * 1024;
  const bf16_t* P = (const bf16_t*)(p.ws + OFF_P);
  float* odir = (float*)(p.ws + OFF_HDIR) + (size_t)dir * ARRF;
  const float4 lb4 = *(const float4*)((const float*)(p.ws + OFF_HGLB) + (l * 2 + dir) * 256 + head * 64 + ks * 4);
  const int vbase = (NCH == 2) ? 0 : rsel * 32;
  f2 S[NCH][4];
#pragma unroll
  for (int c = 0; c < NCH; ++c)
#pragma unroll
    for (int j = 0; j < 4; ++j) S[c][j] = (f2){0.f, 0.f};
  if (seq >= 32) {
    const float* sp = p.in[I_SHG] + ((((size_t)(seq - 32) * 4 + l) * 2 + dir) * 4 + head) * 4096;
#pragma unroll
    for (int c = 0; c < NCH; ++c)
#pragma unroll
      for (int j = 0; j < 4; ++j) {
        const int v = vbase + rr + 32 * c;
        S[c][j] = (f2){sp[(g * 8 + 2 * j) * 64 + v], sp[(g * 8 + 2 * j + 1) * 64 + v]};
      }
  }
  const int nch = T >> 4;
  const int fcol = (dir ? C_HFB : C_HFF) + head * 64;
  uint2 pq, pf, pv2;
#define HG_LOAD(cc) do { const int s_ = (cc) * 16 + rl; const int tok_ = dir ? (T - 1 - s_) : s_; \
    const bf16_t* pr_ = P + (size_t)(row0 + tok_) * DIN; \
    pq = *(const uint2*)(pr_ + C_HQ + head * 64 + ks * 4); pf = *(const uint2*)(pr_ + fcol + ks * 4); \
    if (NCH == 2) pv2 = *(const uint2*)(pr_ + C_HI + head * 64 + ks * 4); else pv2.x = *(const unsigned*)(pr_ + C_HI + head * 64 + vbase + ks * 2); } while (0)
#define HG_WRITE(bb) do { float4* sb_ = (float4*)(lds + (bb) * SC_BUF); float* vb_ = (float*)(lds + (bb) * SC_BUF + 20480); \
    float4 q_, f_, k_; float a_, sg_; \
    a_ = bflo(pq.x); q_.x = a_ * sigmoidf_(a_); a_ = bfhi(pq.x); q_.y = a_ * sigmoidf_(a_); \
    a_ = bflo(pq.y); q_.z = a_ * sigmoidf_(a_); a_ = bfhi(pq.y); q_.w = a_ * sigmoidf_(a_); \
    sg_ = sigmoidf_(bflo(pf.x)); f_.x = lb4.x + (1.f - lb4.x) * sg_; k_.x = (1.f - lb4.x) * (1.f - sg_); \
    sg_ = sigmoidf_(bfhi(pf.x)); f_.y = lb4.y + (1.f - lb4.y) * sg_; k_.y = (1.f - lb4.y) * (1.f - sg_); \
    sg_ = sigmoidf_(bflo(pf.y)); f_.z = lb4.z + (1.f - lb4.z) * sg_; k_.z = (1.f - lb4.z) * (1.f - sg_); \
    sg_ = sigmoidf_(bfhi(pf.y)); f_.w = lb4.w + (1.f - lb4.w) * sg_; k_.w = (1.f - lb4.w) * (1.f - sg_); \
    sb_[(0 * 16 + rl) * 16 + ks] = q_; sb_[(1 * 16 + rl) * 16 + ks] = f_; sb_[(2 * 16 + rl) * 16 + ks] = k_; \
    if (NCH == 2) *(float4*)(vb_ + rl * 64 + ks * 4) = make_float4(bflo(pv2.x), bfhi(pv2.x), bflo(pv2.y), bfhi(pv2.y)); \
    else *(f2*)(vb_ + rl * 64 + ks * 2) = (f2){bflo(pv2.x), bfhi(pv2.x)}; } while (0)
  __syncthreads();
  HG_LOAD(0); HG_WRITE(0);
  __syncthreads();
  for (int c = 0; c < nch; ++c) {
    if (c + 1 < nch) HG_LOAD(c + 1);
    const float4* sbuf = (const float4*)(lds + (c & 1) * SC_BUF);
    const float* vbuf = (const float*)(lds + (c & 1) * SC_BUF + 20480);
    float ym[NCH][2];
#pragma unroll
    for (int cc = 0; cc < NCH; ++cc) { ym[cc][0] = 0.f; ym[cc][1] = 0.f; }
#pragma unroll
    for (int i = 0; i < 16; ++i) {
      const float4 qa = sbuf[(0 * 16 + i) * 16 + g * 2], qb = sbuf[(0 * 16 + i) * 16 + g * 2 + 1];
      const float4 fa = sbuf[(1 * 16 + i) * 16 + g * 2], fb = sbuf[(1 * 16 + i) * 16 + g * 2 + 1];
      const float4 ka_ = sbuf[(2 * 16 + i) * 16 + g * 2], kb_ = sbuf[(2 * 16 + i) * 16 + g * 2 + 1];
      const f2 f2v[4] = {(f2){fa.x, fa.y}, (f2){fa.z, fa.w}, (f2){fb.x, fb.y}, (f2){fb.z, fb.w}};
      const f2 k2[4] = {(f2){ka_.x, ka_.y}, (f2){ka_.z, ka_.w}, (f2){kb_.x, kb_.y}, (f2){kb_.z, kb_.w}};
#pragma unroll
      for (int cc = 0; cc < NCH; ++cc) {
        const float v = vbuf[i * 64 + rr + 32 * cc];
#pragma unroll
        for (int j = 0; j < 4; ++j) S[cc][j] = S[cc][j] * f2v[j] + k2[j] * v;
        const float y = red8(dot8(S[cc], qa, qb));
        ym[cc][i >> 3] = (g == (i & 7)) ? y : ym[cc][i >> 3];
      }
    }
#pragma unroll
    for (int hh = 0; hh < 2; ++hh) {
      const int s = c * 16 + hh * 8 + g; const int tok = dir ? (T - 1 - s) : s;
      float* yo = odir + (size_t)(row0 + tok) * 256 + head * 64 + vbase + rr;
#pragma unroll
      for (int cc = 0; cc < NCH; ++cc) yo[32 * cc] = ym[cc][hh];
    }
    if (c + 1 < nch) HG_WRITE((c + 1) & 1);
    __syncthreads();
  }
#undef HG_LOAD
#undef HG_WRITE
  if (seq < 32) {
    float* sp = p.out + O_HG + ((((size_t)seq * 4 + l) * 2 + dir) * 4 + head) * 4096;
#pragma unroll
    for (int c = 0; c < NCH; ++c)
#pragma unroll
      for (int j = 0; j < 4; ++j) {
        const int v = vbase + rr + 32 * c;
        sp[(g * 8 + 2 * j) * 64 + v] = S[c][j].x; sp[(g * 8 + 2 * j + 1) * 64 + v] = S[c][j].y;
      }
  }
}

DEV void rwkv_scan16(const Params& p, int l, int seq, int head, int dir, int rg, char* lds) {
  const int t = tid(), rl = t >> 4, ks = t & 15;
  const int T = seq < 32 ? 256 : 1024;
  const int row0 = seq < 32 ? seq * 256 : NCTX + (seq - 32) * 1024;
  const float* prep = (const float*)(p.ws + OFF_PREP) + (size_t)dir * 6 * ARRF;
  float* ydir = (float*)(p.ws + OFF_YDIR) + (size_t)dir * ARRF;
  const int v0 = rg * 16 + rl;
  float4 S0 = make_float4(0.f, 0.f, 0.f, 0.f);
  if (seq >= 32) S0 = *(const float4*)(p.in[I_SRW] + ((((size_t)(seq - 32) * 4 + l) * 2 + dir) * 4 + head) * 4096 + ks * 4 + v0 * 64);
  const int nch = T >> 4;
  float4 pre0, pre1, pre2, pre3, pre4; float pv0;
#define RW_LOAD(cc) do { const int s_ = (cc) * 16 + rl; const int tok_ = dir ? (T - 1 - s_) : s_; \
    const size_t base_ = (size_t)(row0 + tok_) * 256 + head * 64; \
    pre0 = *(const float4*)(prep + base_ + ks * 4); pre1 = *(const float4*)(prep + ARRF + base_ + ks * 4); \
    pre2 = *(const float4*)(prep + 2 * ARRF + base_ + ks * 4); pre3 = *(const float4*)(prep + 4 * ARRF + base_ + ks * 4); \
    pre4 = *(const float4*)(prep + 5 * ARRF + base_ + ks * 4); pv0 = prep[3 * ARRF + base_ + rg * 16 + ks]; } while (0)
#define RW_WRITE(bb) do { float4* sb_ = (float4*)(lds + (bb) * SC_BUF); float* vb_ = (float*)(lds + (bb) * SC_BUF + 20480); \
    sb_[(0 * 16 + rl) * 16 + ks] = pre0; sb_[(1 * 16 + rl) * 16 + ks] = pre1; sb_[(2 * 16 + rl) * 16 + ks] = pre2; \
    sb_[(3 * 16 + rl) * 16 + ks] = pre3; sb_[(4 * 16 + rl) * 16 + ks] = pre4; vb_[rl * 16 + ks] = pv0; } while (0)
  __syncthreads();
  RW_LOAD(0); RW_WRITE(0);
  __syncthreads();
  for (int c = 0; c < nch; ++c) {
    if (c + 1 < nch) RW_LOAD(c + 1);
    const float4* sbuf = (const float4*)(lds + (c & 1) * SC_BUF);
    const float* vbuf = (const float*)(lds + (c & 1) * SC_BUF + 20480);
    float ym0 = 0.f;
#pragma unroll
    for (int i = 0; i < 16; ++i) {
      const float4 r = sbuf[(0 * 16 + i) * 16 + ks], wv = sbuf[(1 * 16 + i) * 16 + ks], kv = sbuf[(2 * 16 + i) * 16 + ks],
                   kk = sbuf[(3 * 16 + i) * 16 + ks], ka = sbuf[(4 * 16 + i) * 16 + ks];
      const float va = vbuf[i * 16 + rl];
      const float sa0 = -row16_sum(dot4(S0, kk));
      S0.x = S0.x * wv.x + sa0 * ka.x + va * kv.x; S0.y = S0.y * wv.y + sa0 * ka.y + va * kv.y;
      S0.z = S0.z * wv.z + sa0 * ka.z + va * kv.z; S0.w = S0.w * wv.w + sa0 * ka.w + va * kv.w;
      const float y0 = row16_sum(dot4(S0, r));
      ym0 = (ks == i) ? y0 : ym0;
    }
    {
      const int s = c * 16 + ks; const int tok = dir ? (T - 1 - s) : s;
      ydir[(size_t)(row0 + tok) * 256 + head * 64 + v0] = ym0;
    }
    if (c + 1 < nch) RW_WRITE((c + 1) & 1);
    __syncthreads();
  }
#undef RW_LOAD
#undef RW_WRITE
  if (seq < 32) *(float4*)(p.out + O_RW + ((((size_t)seq * 4 + l) * 2 + dir) * 4 + head) * 4096 + ks * 4 + v0 * 64) = S0;
}

DEV void hgrn_scan16(const Params& p, int l, int seq, int head, int dir, int rg, char* lds) {
  const int t = tid(), rl = t >> 4, ks = t & 15;
  const int T = seq < 32 ? 256 : 1024;
  const int row0 = seq < 32 ? seq * 256 : NCTX + (seq - 32) * 1024;
  const bf16_t* P = (const bf16_t*)(p.ws + OFF_P);
  float* odir = (float*)(p.ws + OFF_HDIR) + (size_t)dir * ARRF;
  const float4 lb4 = *(const float4*)((const float*)(p.ws + OFF_HGLB) + (l * 2 + dir) * 256 + head * 64 + ks * 4);
  const int v0 = rg * 16 + rl;
  float4 S0 = make_float4(0.f, 0.f, 0.f, 0.f);
  if (seq >= 32) {
    const float* sp = p.in[I_SHG] + ((((size_t)(seq - 32) * 4 + l) * 2 + dir) * 4 + head) * 4096;
    S0.x = sp[(ks * 4 + 0) * 64 + v0]; S0.y = sp[(ks * 4 + 1) * 64 + v0]; S0.z = sp[(ks * 4 + 2) * 64 + v0]; S0.w = sp[(ks * 4 + 3) * 64 + v0];
  }
  const int nch = T >> 4;
  const int fcol = (dir ? C_HFB : C_HFF) + head * 64;
  uint2 pq, pf; bf16_t pva;
#define HG_LOAD(cc) do { const int s_ = (cc) * 16 + rl; const int tok_ = dir ? (T - 1 - s_) : s_; \
    const bf16_t* pr_ = P + (size_t)(row0 + tok_) * DIN; \
    pq = *(const uint2*)(pr_ + C_HQ + head * 64 + ks * 4); pf = *(const uint2*)(pr_ + fcol + ks * 4); \
    pva = pr_[C_HI + head * 64 + rg * 16 + ks]; } while (0)
#define HG_WRITE(bb) do { float4* sb_ = (float4*)(lds + (bb) * SC_BUF); float* vb_ = (float*)(lds + (bb) * SC_BUF + 20480); \
    float4 q_, f_, k_; float a_, sg_; \
    a_ = bflo(pq.x); q_.x = a_ * sigmoidf_(a_); a_ = bfhi(pq.x); q_.y = a_ * sigmoidf_(a_); \
    a_ = bflo(pq.y); q_.z = a_ * sigmoidf_(a_); a_ = bfhi(pq.y); q_.w = a_ * sigmoidf_(a_); \
    sg_ = sigmoidf_(bflo(pf.x)); f_.x = lb4.x + (1.f - lb4.x) * sg_; k_.x = (1.f - lb4.x) * (1.f - sg_); \
    sg_ = sigmoidf_(bfhi(pf.x)); f_.y = lb4.y + (1.f - lb4.y) * sg_; k_.y = (1.f - lb4.y) * (1.f - sg_); \
    sg_ = sigmoidf_(bflo(pf.y)); f_.z = lb4.z + (1.f - lb4.z) * sg_; k_.z = (1.f - lb4.z) * (1.f - sg_); \
    sg_ = sigmoidf_(bfhi(pf.y)); f_.w = lb4.w + (1.f - lb4.w) * sg_; k_.w = (1.f - lb4.w) * (1.f - sg_); \
    sb_[(0 * 16 + rl) * 16 + ks] = q_; sb_[(1 * 16 + rl) * 16 + ks] = f_; sb_[(2 * 16 + rl) * 16 + ks] = k_; \
    vb_[rl * 16 + ks] = bf2f(pva); } while (0)
  __syncthreads();
  HG_LOAD(0); HG_WRITE(0);
  __syncthreads();
  for (int c = 0; c < nch; ++c) {
    if (c + 1 < nch) HG_LOAD(c + 1);
    const float4* sbuf = (const float4*)(lds + (c & 1) * SC_BUF);
    const float* vbuf = (const float*)(lds + (c & 1) * SC_BUF + 20480);
    float ym0 = 0.f;
#pragma unroll
    for (int i = 0; i < 16; ++i) {
      const float4 q = sbuf[(0 * 16 + i) * 16 + ks], f = sbuf[(1 * 16 + i) * 16 + ks], k = sbuf[(2 * 16 + i) * 16 + ks];
      const float va = vbuf[i * 16 + rl];
      S0.x = S0.x * f.x + k.x * va; S0.y = S0.y * f.y + k.y * va; S0.z = S0.z * f.z + k.z * va; S0.w = S0.w * f.w + k.w * va;
      const float y0 = row16_sum(dot4(S0, q));
      ym0 = (ks == i) ? y0 : ym0;
    }
    {
      const int s = c * 16 + ks; const int tok = dir ? (T - 1 - s) : s;
      odir[(size_t)(row0 + tok) * 256 + head * 64 + v0] = ym0;
    }
    if (c + 1 < nch) HG_WRITE((c + 1) & 1);
    __syncthreads();
  }
#undef HG_LOAD
#undef HG_WRITE
  if (seq < 32) {
    float* sp = p.out + O_HG + ((((size_t)seq * 4 + l) * 2 + dir) * 4 + head) * 4096;
    sp[(ks * 4 + 0) * 64 + v0] = S0.x; sp[(ks * 4 + 1) * 64 + v0] = S0.y; sp[(ks * 4 + 2) * 64 + v0] = S0.z; sp[(ks * 4 + 3) * 64 + v0] = S0.w;
  }
}

template <int MODE>
DEV void attn_item(const Params& p, int l, int item, char* lds) {
  const int t = tid(), lane = t & 63, w = t >> 6, q = lane & 31, hh = lane >> 5;
  const bf16_t* P = (const bf16_t*)(p.ws + OFF_P);
  bf16_t* Y = (bf16_t*)(p.ws + OFF_YMIX);
  char* sK = lds;
  char* sV = lds + 8192;
  float* sBias = (float*)(lds + 8192 + 8704);
  int head, qrow, qcol, kcol, vcol, ocol, nloc, nt, rowbaseP;
  int qr = 0, qc = 0, rlo = 0, qpos = 0, lo = 0, rsq = 0, wsq = 0;
  float sink = 0.f;
  const float* cache = nullptr; int cH = 1, cHead = 0;
  if (MODE == 0 || MODE == 1) {
    const int b = item >> 3; head = (item >> 1) & 3; const int half = item & 1;
    rowbaseP = b * 256; qrow = rowbaseP + half * 128 + w * 32 + q; nloc = 4; nt = 4;
  } else {
    const int b = item >> 5; head = (item >> 3) & 3; const int sub = item & 7;
    rowbaseP = NCTX + b * 1024;
    if (MODE == 2) {
      qr = 2 * sub + (w >> 1); qc = (w & 1) * 32 + q; qrow = rowbaseP + qr * 64 + qc;
      rlo = clampi(2 * sub - 4, 0, 8); const int rhi = clampi(2 * sub - 3, 0, 8) + 7; nloc = rhi - rlo + 1; nt = nloc + 4;
      rsq = clampi(qr - 4, 0, 8); wsq = clampi(qc - 8, 0, 48);
      cache = p.in[I_CNAT] + (size_t)((b * 4 + l) * 2) * 256 * 256; cH = 4; cHead = head;
      for (int i = t; i < 465; i += 256) sBias[i] = p.in[I_RPB][(size_t)(l * 4 + head) * 465 + i];
    } else {
      qpos = sub * 128 + w * 32 + q; qrow = rowbaseP + qpos;
      lo = (sub - 1) * 128;
      nloc = 6; nt = nloc + 4;
      cache = p.in[I_CSWA] + (size_t)((b * 4 + l) * 2) * 256 * 128; cH = 2; cHead = head >> 1;
    }
  }
  if (MODE == 0 || MODE == 2) { qcol = C_NQ + head * 64; kcol = C_NK + head * 64; vcol = C_NV + head * 64; ocol = 256 + head * 64; }
  else { qcol = C_SQ + head * 64; kcol = C_SK + (head >> 1) * 64; vcol = C_SV + (head >> 1) * 64; ocol = 768 + head * 64; sink = p.in[I_SINK][l * 4 + head]; }

  bf16x8 bq[4];
#pragma unroll
  for (int s = 0; s < 4; ++s) bq[s] = *(const bf16x8*)(P + (size_t)qrow * DIN + qcol + 16 * s + 8 * hh);
  f32x16 oacc[2];
#pragma unroll
  for (int r = 0; r < 16; ++r) { oacc[0][r] = 0.f; oacc[1][r] = 0.f; }
  float m_run = -1e30f, l_run = 0.f;
  const int key = t >> 2, dq = t & 3;
  const int kswz = (key >> 1) & 7;
  float4 raw[8];
#define ATT_ISSUE(jj) do { const int j_ = (jj); \
    if (j_ < nloc) { \
      int krow_; \
      if (MODE == 0 || MODE == 1) krow_ = rowbaseP + j_ * 64 + key; \
      else if (MODE == 2) krow_ = rowbaseP + (rlo + j_) * 64 + key; \
      else krow_ = rowbaseP + clampi(lo + j_ * 64 + key, 0, 1023); \
      const bf16_t* kp_ = P + (size_t)krow_ * DIN + kcol + dq * 16; \
      const bf16_t* vp_ = P + (size_t)krow_ * DIN + vcol + dq * 16; \
      raw[0] = *(const float4*)kp_; raw[1] = *(const float4*)(kp_ + 8); raw[2] = *(const float4*)vp_; raw[3] = *(const float4*)(vp_ + 8); \
    } else { \
      const int ct_ = (j_ - nloc) * 64 + key; \
      const float* kp_ = cache + ((size_t)ct_ * cH + cHead) * 64 + dq * 16; \
      const float* vp_ = kp_ + (size_t)256 * cH * 64; \
      raw[0] = *(const float4*)kp_; raw[1] = *(const float4*)(kp_ + 4); raw[2] = *(const float4*)(kp_ + 8); raw[3] = *(const float4*)(kp_ + 12); \
      raw[4] = *(const float4*)vp_; raw[5] = *(const float4*)(vp_ + 4); raw[6] = *(const float4*)(vp_ + 8); raw[7] = *(const float4*)(vp_ + 12); \
    } } while (0)
  ATT_ISSUE(0);
  for (int j = 0; j < nt; ++j) {
    uint4 kr[2], vr[2];
    const bool isP = j < nloc;
    if (isP) {
      kr[0] = __builtin_bit_cast(uint4, raw[0]); kr[1] = __builtin_bit_cast(uint4, raw[1]);
      vr[0] = __builtin_bit_cast(uint4, raw[2]); vr[1] = __builtin_bit_cast(uint4, raw[3]);
    } else {
      kr[0].x = pk2(raw[0].x, raw[0].y); kr[0].y = pk2(raw[0].z, raw[0].w); kr[0].z = pk2(raw[1].x, raw[1].y); kr[0].w = pk2(raw[1].z, raw[1].w);
      kr[1].x = pk2(raw[2].x, raw[2].y); kr[1].y = pk2(raw[2].z, raw[2].w); kr[1].z = pk2(raw[3].x, raw[3].y); kr[1].w = pk2(raw[3].z, raw[3].w);
      vr[0].x = pk2(raw[4].x, raw[4].y); vr[0].y = pk2(raw[4].z, raw[4].w); vr[0].z = pk2(raw[5].x, raw[5].y); vr[0].w = pk2(raw[5].z, raw[5].w);
      vr[1].x = pk2(raw[6].x, raw[6].y); vr[1].y = pk2(raw[6].z, raw[6].w); vr[1].z = pk2(raw[7].x, raw[7].y); vr[1].w = pk2(raw[7].z, raw[7].w);
    }
    if (j + 1 < nt) ATT_ISSUE(j + 1);
    __syncthreads();
    *(uint4*)(sK + key * 128 + (((dq * 2 + 0) ^ kswz) << 4)) = kr[0];
    *(uint4*)(sK + key * 128 + (((dq * 2 + 1) ^ kswz) << 4)) = kr[1];
    {
      bf16_t* vt = (bf16_t*)sV;
      const unsigned vv[8] = {vr[0].x, vr[0].y, vr[0].z, vr[0].w, vr[1].x, vr[1].y, vr[1].z, vr[1].w};
#pragma unroll
      for (int e = 0; e < 8; ++e) {
        vt[(dq * 16 + 2 * e) * 68 + key] = (bf16_t)(vv[e] & 0xffffu);
        vt[(dq * 16 + 2 * e + 1) * 68 + key] = (bf16_t)(vv[e] >> 16);
      }
    }
    __syncthreads();
    f32x16 sacc[2];
#pragma unroll
    for (int r = 0; r < 16; ++r) { sacc[0][r] = 0.f; sacc[1][r] = 0.f; }
    const int qswz = (q >> 1) & 7;
#pragma unroll
    for (int s = 0; s < 4; ++s) {
      const int co = (((s * 2 + hh) ^ qswz) << 4);
      const bf16x8 a0 = *(const bf16x8*)(sK + q * 128 + co);
      const bf16x8 a1 = *(const bf16x8*)(sK + (32 + q) * 128 + co);
      sacc[0] = MFMA32(a0, bq[s], sacc[0]);
      sacc[1] = MFMA32(a1, bq[s], sacc[1]);
    }
    float mx = -1e30f;
#pragma unroll
    for (int sub = 0; sub < 2; ++sub)
#pragma unroll
      for (int r = 0; r < 16; ++r) {
        const int kidx = sub * 32 + (r & 3) + 8 * (r >> 2) + 4 * hh;
        float v = sacc[sub][r] * 0.125f;
        bool ok = true;
        if (MODE == 2 && isP) {
          const int kr_ = rlo + j, kc_ = kidx;
          ok = (kr_ >= rsq) && (kr_ < rsq + 8) && (kc_ >= wsq) && (kc_ < wsq + 16);
          const int bi = ok ? ((kr_ - qr + 7) * 31 + (kc_ - qc + 15)) : 0;
          v += sBias[bi];
        }
        if (MODE == 3 && isP) {
          const int kpos = lo + j * 64 + kidx, dlt = kpos - qpos;
          ok = (dlt <= 128) && (dlt >= -128) && (kpos >= 0) && (kpos < 1024);
        }
        v = ok ? v : -1e30f;
        sacc[sub][r] = v;
        mx = fmaxf(mx, v);
      }
    mx = fmaxf(mx, __shfl_xor(mx, 32));
    const float m_new = fmaxf(m_run, mx);
    const float alpha = __expf(m_run - m_new);
    float rsum = 0.f;
#pragma unroll
    for (int sub = 0; sub < 2; ++sub)
#pragma unroll
      for (int r = 0; r < 16; ++r) {
        const float v = sacc[sub][r];
        const float pv = (v > -1e29f) ? __expf(v - m_new) : 0.f;
        sacc[sub][r] = pv; rsum += pv;
      }
    rsum += __shfl_xor(rsum, 32);
    l_run = l_run * alpha + rsum; m_run = m_new;
#pragma unroll
    for (int r = 0; r < 16; ++r) { oacc[0][r] *= alpha; oacc[1][r] *= alpha; }
#pragma unroll
    for (int k4 = 0; k4 < 4; ++k4) {
      const int sub = k4 >> 1, s2 = k4 & 1;
      uint4 pbu;
      pbu.x = pk2(sacc[sub][8 * s2 + 0], sacc[sub][8 * s2 + 1]); pbu.y = pk2(sacc[sub][8 * s2 + 2], sacc[sub][8 * s2 + 3]);
      pbu.z = pk2(sacc[sub][8 * s2 + 4], sacc[sub][8 * s2 + 5]); pbu.w = pk2(sacc[sub][8 * s2 + 6], sacc[sub][8 * s2 + 7]);
      const bf16x8 pb = __builtin_bit_cast(bf16x8, pbu);
#pragma unroll
      for (int dt = 0; dt < 2; ++dt) {
        const char* vp = sV + (dt * 32 + q) * 136 + (16 * k4 + 4 * hh) * 2;
        const uint2 lo8 = *(const uint2*)vp, hi8 = *(const uint2*)(vp + 16);
        uint4 avu; avu.x = lo8.x; avu.y = lo8.y; avu.z = hi8.x; avu.w = hi8.y;
        oacc[dt] = MFMA32(__builtin_bit_cast(bf16x8, avu), pb, oacc[dt]);
      }
    }
  }
#undef ATT_ISSUE
  float scale;
  if (MODE == 1 || MODE == 3) {
    const float m_f = fmaxf(m_run, sink);
    const float e = __expf(m_run - m_f);
    scale = e / (l_run * e + __expf(sink - m_f));
  } else scale = 1.0f / l_run;
#pragma unroll
  for (int dt = 0; dt < 2; ++dt)
#pragma unroll
    for (int g4 = 0; g4 < 4; ++g4) {
      const int d = dt * 32 + 8 * g4 + 4 * hh;
      uint2 o; o.x = pk2(oacc[dt][4 * g4] * scale, oacc[dt][4 * g4 + 1] * scale); o.y = pk2(oacc[dt][4 * g4 + 2] * scale, oacc[dt][4 * g4 + 3] * scale);
      *(uint2*)(Y + (size_t)qrow * D + ocol + d) = o;
    }
  __syncthreads();
}

DEV void post_item(const Params& p, int l, int tile, char* lds) {
  const int t = tid(), r0 = tile * TOKT, c = t;
  float* sT = (float*)lds;
  float* sgo = sT + 128 * TOKT;
  const bf16_t* P = (const bf16_t*)(p.ws + OFF_P);
  bf16_t* Y = (bf16_t*)(p.ws + OFF_YMIX);
  const float* Y0 = (const float*)(p.ws + OFF_YDIR); const float* Y1 = Y0 + ARRF;
  const float* H0 = (const float*)(p.ws + OFF_HDIR); const float* H1 = H0 + ARRF;
  const float* BON = (const float*)(p.ws + OFF_BONUS);
  __syncthreads();
#pragma unroll
  for (int i = 0; i < TOKT / 2; ++i) {
    const int e = t + 256 * i, tk = e >> 7, j = e & 127;
    sT[j * TOKT + tk] = sigmoidf_(bf2f(P[(size_t)(r0 + tk) * DIN + C_GH + j]));
  }
  __syncthreads();
  {
    const float* g2p = p.in[I_G2] + (size_t)l * 128 * 256 + c;
    float ag[TOKT];
#pragma unroll
    for (int k = 0; k < TOKT; ++k) ag[k] = 0.f;
    float g2c[128];
#pragma unroll
    for (int j = 0; j < 128; ++j) g2c[j] = g2p[j * 256];
#pragma unroll
    for (int j = 0; j < 128; ++j) {
      const float gj = g2c[j];
#pragma unroll
      for (int k4 = 0; k4 < TOKT / 4; ++k4) {
        const float4 s4 = *(const float4*)(sT + j * TOKT + k4 * 4);
        ag[k4 * 4 + 0] += s4.x * gj; ag[k4 * 4 + 1] += s4.y * gj; ag[k4 * 4 + 2] += s4.z * gj; ag[k4 * 4 + 3] += s4.w * gj;
      }
    }
#pragma unroll
    for (int k = 0; k < TOKT; ++k) sgo[k * 256 + c] = ag[k];
  }
  const float lnw = p.in[I_LNW][l * 256 + c], lnb = p.in[I_LNB][l * 256 + c], hgn = p.in[I_HGN][l * 256 + c];
  for (int tb = 0; tb < TOKT; tb += 5) {
    float y[5], o[5], bn[5], gv[5], hg[5];
#pragma unroll
    for (int u = 0; u < 5; ++u) {
      const int row = r0 + tb + u;
      const size_t idx = (size_t)row * 256 + c;
      y[u] = Y0[idx] + Y1[idx]; o[u] = H0[idx] + H1[idx]; bn[u] = BON[idx];
      gv[u] = sgo[(tb + u) * 256 + c]; hg[u] = bf2f(P[(size_t)row * DIN + C_HG + c]);
    }
#pragma unroll
    for (int u = 0; u < 5; ++u) {
      const int row = r0 + tb + u;
      const float mu = wave_sum(y[u]) * (1.0f / 64.0f);
      const float dy = y[u] - mu;
      const float var = wave_sum(dy * dy) * (1.0f / 64.0f);
      const float yn = dy * rsqrtf(var + 64e-5f) * lnw + lnb + bn[u];
      Y[(size_t)row * D + c] = f2bf(yn * gv[u]);
      const float ms = wave_sum(o[u] * o[u]) * (1.0f / 64.0f);
      Y[(size_t)row * D + 512 + c] = f2bf(o[u] * rsqrtf(ms + 1e-6f) * hgn * sigmoidf_(hg[u]));
    }
  }
  __syncthreads();
}

constexpr int OFF_CTR_WORD = 3600;
DEV void mixer_phase(const Params& p, int l, char* lds0, volatile LAS unsigned* st, bool rerun) {
  const int hf = half_id(); char* lds = lds0 + hf * 65536;
  const int npairs = (256 + 512 + 512) / 2;
  unsigned* ctr = (unsigned*)(p.ws + OFF_BAR) + OFF_CTR_WORD + 64 * l + (rerun ? 32 : 0);
  for (;;) {
    if (threadIdx.x == 0) st[4] = __hip_atomic_fetch_add(ctr, 1u, __ATOMIC_RELAXED, __HIP_MEMORY_SCOPE_AGENT);
    __syncthreads();
    const int pair = (int)st[4];
    __syncthreads();
    if (pair >= npairs) break;
    const int it = pair * 2 + hf;
    const bool is_scan = it < 128 || (it >= 256 && it < 768);
    if (rerun && PROBE_SUB == 1 && !is_scan) continue;
    if (rerun && PROBE_SUB == 2 && is_scan) continue;
    if (rerun && PROBE_SUB == 3 && !(it < 128)) continue;
    if (rerun && PROBE_SUB == 4 && !(it >= 256 && it < 768)) continue;
    if (it < 128) {
      const int idx = it >> 1; const int seq = 32 + (idx >> 5), rem = idx & 31;
      if ((it & 1) == 0) rwkv_scan16(p, l, seq, rem >> 3, (rem >> 2) & 1, rem & 3, lds);
      else hgrn_scan16(p, l, seq, rem >> 3, (rem >> 2) & 1, rem & 3, lds);
    } else if (it < 192) attn_item<3>(p, l, it - 128, lds);
    else if (it < 256) attn_item<2>(p, l, it - 192, lds);
    else if (it < 768) {
      const int idx = (it - 256) & 255; const int seq = idx >> 3, rem = idx & 7;
      if (it < 512) rwkv_scan<2>(p, l, seq, rem >> 1, rem & 1, 0, lds);
      else hgrn_scan<2>(p, l, seq, rem >> 1, rem & 1, 0, lds);
    } else if (it < 1024) attn_item<0>(p, l, it - 768, lds);
    else attn_item<1>(p, l, it - 1024, lds);
  }
}

DEV void run_phase(const Params& p, int ph, char* lds, bool rerun, volatile LAS unsigned* st) {
  if (ph == 0) { phase0(p, lds); return; }
  if (ph == 1) { row_phase(p, 0, 0); return; }
  const int l = (ph - 2) / 9, s = (ph - 2) % 9;
  const bf16_t* H = (const bf16_t*)(p.ws + OFF_H);
  const int hf = half_id(); char* ldsh = lds + hf * 65536;
  switch (s) {
    case 0: gemm_run<0>(p, l, H, (const bf16_t*)(p.ws + OFF_WIN) + (size_t)l * DINP * D, D, DINP, lds); break;
    case 1:
      for (int it = blockIdx.x * 2 + hf; it < 512 + 32; it += gridDim.x * 2) { if (it < 512) prep_item(p, l, it, ldsh); else if (!rerun) rope_item(p, it - 512); }
      break;
    case 2: mixer_phase(p, l, lds, st, rerun); break;
    case 3: for (int it = blockIdx.x * 2 + hf; it < 512; it += gridDim.x * 2) post_item(p, l, it, ldsh); break;
    case 4: gemm_run<1>(p, l, (const bf16_t*)(p.ws + OFF_YMIX), (const bf16_t*)(p.ws + OFF_WOUT) + (size_t)l * D * D, D, D, lds); break;
    case 5: row_phase(p, 1, l); break;
    case 6: gemm_run<2>(p, l, H, (const bf16_t*)(p.ws + OFF_W1) + (size_t)l * FF * D, D, FF, lds); break;
    case 7: gemm_run<1>(p, l, (const bf16_t*)(p.ws + OFF_HID), (const bf16_t*)(p.ws + OFF_W2) + (size_t)l * D * FF, FF, D, lds); break;
    case 8: row_phase(p, 2, l); break;
  }
}

#define XB_TMO      128
#define XB_XCNT(j)  (256  + 64 * (j))
#define XB_XSUB(j)  (1280 + 64 * (j))
#define XB_XGEN(j)  (2304 + 64 * (j))
#define XB_TOP      3328
#define XB_TOPGEN   3392
#define XCD_BAR_WORDS 3456
#define XB_SPIN_CAP (1u << 18)
DEV unsigned xb_ld(unsigned* p) { return __hip_atomic_load(p, __ATOMIC_RELAXED, __HIP_MEMORY_SCOPE_AGENT); }
DEV unsigned xb_add(unsigned* p, unsigned v) { return __hip_atomic_fetch_add(p, v, __ATOMIC_RELAXED, __HIP_MEMORY_SCOPE_AGENT); }
DEV unsigned xb_xcc_id() { return (unsigned)__builtin_amdgcn_s_getreg((3 << 11) | 20) & 0xFu; }
#define XB_SPIN(cond, bar) do { unsigned _sp = 0; while (cond) { __builtin_amdgcn_s_sleep(1); \
    if ((++_sp & 255u) == 0u) { if (xb_ld(&(bar)[XB_TMO])) break; if (_sp > XB_SPIN_CAP) { atomicAdd(&(bar)[XB_TMO], 1u); break; } } } } while (0)
struct XcdBarrier { unsigned* bar; unsigned x; volatile LAS unsigned* st; };
DEV XcdBarrier xcd_barrier_post(unsigned* bar, volatile LAS unsigned* st) {
  XcdBarrier b; b.bar = bar; b.x = xb_xcc_id(); b.st = st;
  if (threadIdx.x == 0) (void)xb_add(&bar[XB_XCNT(b.x)], 1u);
  return b;
}
DEV void xcd_barrier_complete(unsigned* bar, unsigned x, unsigned& nloc, unsigned& nx) {
  const unsigned G = gridDim.x * gridDim.y * gridDim.z;
  unsigned sum, cnt, mine, sp = 0u;
  for (;;) {
    sum = 0u; cnt = 0u; mine = 0u;
#pragma unroll
    for (unsigned j = 0; j < 16; ++j) { const unsigned c = xb_ld(&bar[XB_XCNT(j)]); sum += c; cnt += (c > 0u) ? 1u : 0u; mine = (j == x) ? c : mine; }
    if (sum == G) break;
    __builtin_amdgcn_s_sleep(1);
    if ((++sp & 255u) == 0u) { if (xb_ld(&bar[XB_TMO])) break; if (sp > XB_SPIN_CAP) { atomicAdd(&bar[XB_TMO], 1u); break; } }
  }
  nloc = mine > 0u ? mine : 1u; nx = cnt > 0u ? cnt : 1u;
}
DEV void xcd_barrier(const XcdBarrier& b) {
  asm volatile("s_waitcnt vmcnt(0)" ::: "memory");
  __syncthreads();
  if (threadIdx.x == 0) {
    unsigned* bar = b.bar;
    { size_t zb_; asm volatile("s_mov_b64 %0, 0" : "=s"(zb_)); bar += zb_; }
    __builtin_amdgcn_s_waitcnt(0);
    unsigned nloc = b.st[0], nx = b.st[1];
    if (nloc == 0u) { xcd_barrier_complete(bar, b.x, nloc, nx); b.st[0] = nloc; b.st[1] = nx; }
    const unsigned old = xb_add(&bar[XB_XSUB(b.x)], 1u);
    const unsigned gen = old / nloc;
    if (old + 1u == (gen + 1u) * nloc) {
      __builtin_amdgcn_fence(__ATOMIC_RELEASE, "agent");
      asm volatile("s_waitcnt vmcnt(0)" ::: "memory");
      const unsigned og = xb_add(&bar[XB_TOP], 1u);
      const unsigned tg = og / nx;
      if (og + 1u == (tg + 1u) * nx) xb_add(&bar[XB_TOPGEN], 1u);
      else XB_SPIN(xb_ld(&bar[XB_TOPGEN]) == tg, bar);
      __builtin_amdgcn_fence(__ATOMIC_ACQUIRE, "agent");
      xb_add(&bar[XB_XGEN(b.x)], 1u);
      asm volatile("s_waitcnt vmcnt(0)" ::: "memory");
    } else {
      XB_SPIN(xb_ld(&bar[XB_XGEN(b.x)]) == gen, bar);
      __builtin_amdgcn_fence(__ATOMIC_ACQUIRE, "agent");
      asm volatile("s_waitcnt vmcnt(0)" ::: "memory");
    }
  }
  __syncthreads();
}

DEV int phase_kind(int ph) {
  if (ph == 0) return 0;
  if (ph == 1) return 1;
  const int s = (ph - 2) % 9;
  return s == 0 ? 2 : s == 1 ? 3 : s == 2 ? 4 : s == 3 ? 5 : s == 4 ? 6 : s == 5 ? 1 : s == 6 ? 7 : s == 7 ? 8 : 1;
}

constexpr int LDS_BYTES = 131072 + 64;

__global__ void __launch_bounds__(512, 2) mega(Params p, int ph_lo, int ph_hi) {
  extern __shared__ __attribute__((aligned(16))) unsigned char smem[];
  char* lds = (char*)smem;
  volatile LAS unsigned* st = (volatile LAS unsigned*)((LAS unsigned char*)smem + 131072);
  if (threadIdx.x == 0) { st[0] = 0u; st[1] = 0u; }
  __syncthreads();
  XcdBarrier xb = xcd_barrier_post((unsigned*)(p.ws + OFF_BAR), st);
  if (ph_hi < 0) cg::this_grid().sync();
  char* const ws0 = p.ws; float* const out0 = p.out;
  for (int ph = ph_lo; ph < ph_hi; ++ph) {
    { size_t z0_; asm volatile("s_mov_b64 %0, 0" : "=s"(z0_)); p.ws = ws0 + z0_; p.out = out0 + z0_; }
    run_phase(p, ph, lds, false, st);
    if (PROBE_KIND >= 0 && (PROBE_KIND == 9 || phase_kind(ph) == PROBE_KIND)) {
      xcd_barrier(xb);
      if (PROBE_KIND != 9) run_phase(p, ph, lds, true, st);
    }
    if (ph + 1 < ph_hi) xcd_barrier(xb);
  }
}

extern "C" void kernel_launch(void* const* d_in, const int* in_sizes, int n_in, void* d_out, int out_size, void* d_ws, size_t ws_size,
                              hipStream_t stream) {
  static int grid_blocks = 0;
  if (!grid_blocks) {
    int dev = 0, cus = 0, per_cu = 0;
    (void)hipGetDevice(&dev);
    (void)hipDeviceGetAttribute(&cus, hipDeviceAttributeMultiprocessorCount, dev);
    if (hipFuncSetAttribute((const void*)mega, hipFuncAttributeMaxDynamicSharedMemorySize, LDS_BYTES) != hipSuccess) fprintf(stderr, "hipFuncSetAttribute failed\n");
    (void)hipOccupancyMaxActiveBlocksPerMultiprocessor(&per_cu, mega, 512, LDS_BYTES);
    if (per_cu < 1) fprintf(stderr, "occupancy query reports %d blocks per CU\n", per_cu);
    (void)hipGetLastError();
    grid_blocks = cus;
  }
  if (ws_size < WS_TOTAL) { fprintf(stderr, "workspace too small: %zu < %zu\n", ws_size, (size_t)WS_TOTAL); return; }
  Params p{};
  for (int i = 0; i < 31; ++i) p.in[i] = (const float*)d_in[i];
  p.out = (float*)d_out;
  p.ws = (char*)d_ws;
  (void)hipMemsetAsync((char*)d_ws + OFF_BAR, 0, 16384, stream);
  int lo = 0, hi = NPH;
  void* args[] = {&p, &lo, &hi};
  hipError_t e = hipLaunchCooperativeKernel((void*)mega, dim3(grid_blocks), dim3(512), args, LDS_BYTES, stream);
  if (e != hipSuccess) fprintf(stderr, "cooperative launch failed: %s (grid %d)\n", hipGetErrorString(e), grid_blocks);
}
```

```cpp
#include <hip/hip_runtime.h>
#include <hip/hip_cooperative_groups.h>
#include <cstdio>
#include <cstdint>
namespace cg = cooperative_groups;

#ifndef ONE_LAUNCH
#define ONE_LAUNCH 1
#endif
#define PROBE_KIND -1
#define PROBE_SUB 0

#define DEV __device__ __forceinline__
#define LAS __attribute__((address_space(3)))
typedef unsigned short bf16_t;
typedef short bf16x8 __attribute__((ext_vector_type(8)));
typedef float f32x16 __attribute__((ext_vector_type(16)));
typedef __bf16 bf2_t __attribute__((ext_vector_type(2)));
typedef float f2_t __attribute__((ext_vector_type(2)));

constexpr int D = 1024, DIN = 3712, FF = 4096, NCTX = 8192, MT = 10240;
constexpr int NPH = 38;
constexpr int DINP = 3840;
constexpr int C_R = 0, C_K = 256, C_V = 512, C_GH = 768, C_WHF = 896, C_WHB = 1024;
constexpr int C_NQ = 1152, C_NK = 1408, C_NV = 1664;
constexpr int C_HQ = 1920, C_HI = 2176, C_HG = 2432, C_HFF = 2688, C_HFB = 2944;
constexpr int C_SQ = 3200, C_SK = 3456, C_SV = 3584;
constexpr size_t O_NAT = 10485760, O_SWA = 27262976, O_RW = 35651584, O_HG = 39845888;
constexpr size_t ARRF = (size_t)MT * 256;
constexpr size_t ARR = ARRF * 4;
constexpr size_t OFF_WIN = 0;
constexpr size_t OFF_WOUT = OFF_WIN + (size_t)4 * DINP * D * 2;
constexpr size_t OFF_W1 = OFF_WOUT + (size_t)4 * D * D * 2;
constexpr size_t OFF_W2 = OFF_W1 + (size_t)4 * FF * D * 2;
constexpr size_t OFF_MOD = OFF_W2 + (size_t)4 * FF * D * 2;
constexpr size_t OFF_HGLB = OFF_MOD + (size_t)4 * 3 * 6144 * 4;
constexpr size_t OFF_P = OFF_HGLB + 8192;
constexpr size_t OFF_R1 = OFF_P + (size_t)MT * DIN * 2;
constexpr size_t OFF_H = OFF_R1;
constexpr size_t OFF_HID = OFF_H + (size_t)MT * D * 2;
constexpr size_t OFF_U = OFF_HID + (size_t)MT * FF * 2;
constexpr size_t OFF_PREP = OFF_R1;
constexpr size_t OFF_YDIR = OFF_PREP + 12 * ARR;
constexpr size_t OFF_BONUS = OFF_R1 + 14 * ARR;
constexpr size_t OFF_HDIR = OFF_BONUS + ARR / 2;
constexpr size_t OFF_YMIX = OFF_HDIR + 2 * ARR;
constexpr size_t OFF_X16 = OFF_YMIX + (size_t)MT * D * 2;
constexpr size_t OFF_BAR = OFF_X16 + (size_t)MT * D * 2;
constexpr size_t WS_TOTAL = OFF_BAR + 16384;
static_assert(OFF_U + (size_t)MT * D * 4 == OFF_BONUS, "R1 layout");

struct Params {
  const float* in[31];
  float* out;
  char* ws;
};
enum { I_XP = 0, I_XS, I_CNAT, I_CSWA, I_SRW, I_SHG, I_C, I_CCTX, I_NORMG, I_MODW, I_MODB, I_WIN, I_WOUT, I_MURKV, I_MULORA,
       I_W0, I_W2, I_A0, I_A2, I_G2, I_KK, I_KA, I_RK, I_LNW, I_LNB, I_RPB, I_HGLB, I_HGN, I_SINK, I_FW1, I_FW2 };

DEV bf16_t f2bf(float f) { unsigned u = __float_as_uint(f); u += 0x7fffu + ((u >> 16) & 1u); return (bf16_t)(u >> 16); }
DEV float bf2f(bf16_t h) { return __uint_as_float(((unsigned)h) << 16); }
DEV unsigned pk2(float a, float b) { f2_t v = {a, b}; bf2_t r = __builtin_convertvector(v, bf2_t); return __builtin_bit_cast(unsigned, r); }
DEV float bflo(unsigned u) { return __uint_as_float(u << 16); }
DEV float bfhi(unsigned u) { return __uint_as_float(u & 0xffff0000u); }
DEV float rcpf_(float x) { return __builtin_amdgcn_rcpf(x); }
DEV float sigmoidf_(float x) { return rcpf_(1.0f + __expf(-x)); }
DEV float tanhf_(float x) { return 1.0f - 2.0f * rcpf_(1.0f + __expf(2.0f * x)); }
template <int CTRL> DEV float dppf(float x) { return __int_as_float(__builtin_amdgcn_update_dpp(0, __float_as_int(x), CTRL, 0xF, 0xF, false)); }
DEV float row16_sum(float x) { x += dppf<0xB1>(x); x += dppf<0x4E>(x); x += dppf<0x141>(x); x += dppf<0x140>(x); return x; }
DEV float wave_sum(float x) { x = row16_sum(x); x += __shfl_xor(x, 16); x += __shfl_xor(x, 32); return x; }
DEV int clampi(int v, int lo, int hi) { return v < lo ? lo : (v > hi ? hi : v); }
#define MFMA32(a, b, c) __builtin_amdgcn_mfma_f32_32x32x16_bf16((a), (b), (c), 0, 0, 0)

DEV int tid() { int z; asm volatile("v_mov_b32 %0, 0" : "=v"(z)); return (int)(threadIdx.x & 255u) + z; }
DEV int half_id() { return __builtin_amdgcn_readfirstlane((int)(threadIdx.x >> 8)); }
DEV void transpose_item(const float* W, bf16_t* WT, int K, int N, int kt, int nt, char* lds) {
  bf16_t* s = (bf16_t*)lds;
  const int t = tid();
#pragma unroll
  for (int i = 0; i < 4; ++i) {
    const int k = (t >> 4) + 16 * i, n4 = (t & 15) * 4;
    const float4 v = *(const float4*)(W + (size_t)(kt * 64 + k) * N + nt * 64 + n4);
    s[(n4 + 0) * 72 + k] = f2bf(v.x); s[(n4 + 1) * 72 + k] = f2bf(v.y);
    s[(n4 + 2) * 72 + k] = f2bf(v.z); s[(n4 + 3) * 72 + k] = f2bf(v.w);
  }
  __syncthreads();
#pragma unroll
  for (int i = 0; i < 2; ++i) {
    const int n = (t >> 3) + 32 * i, kc = t & 7;
    const uint4 v = *(const uint4*)(s + n * 72 + kc * 8);
    *(uint4*)(WT + (size_t)(nt * 64 + n) * K + kt * 64 + kc * 8) = v;
  }
  __syncthreads();
}

DEV void mod_item(const Params& p, int l, int jb, char* lds) {
  float* sc = (float*)lds;
  float* red = (float*)(lds + 12288);
  const int t = tid();
  for (int i = t; i < 3072; i += 256) {
    const int c = i >> 10, k = i & 1023;
    const float x = (c == 0) ? p.in[I_CCTX][k] : p.in[I_C][(c - 1) * 1024 + k];
    sc[i] = x * rcpf_(1.0f + __expf(-x));
  }
  __syncthreads();
  const int c4 = t & 15, ks = t >> 4;
  const float* wp = p.in[I_MODW] + ((size_t)l * 1024 + ks * 64) * 6144 + jb * 64 + c4 * 4;
  float a00 = 0, a01 = 0, a02 = 0, a03 = 0, a10 = 0, a11 = 0, a12 = 0, a13 = 0, a20 = 0, a21 = 0, a22 = 0, a23 = 0;
#pragma unroll 16
  for (int ii = 0; ii < 64; ++ii) {
    const float4 w = *(const float4*)(wp + (size_t)ii * 6144);
    const int k = ks * 64 + ii;
    const float s0 = sc[k], s1 = sc[1024 + k], s2 = sc[2048 + k];
    a00 += s0 * w.x; a01 += s0 * w.y; a02 += s0 * w.z; a03 += s0 * w.w;
    a10 += s1 * w.x; a11 += s1 * w.y; a12 += s1 * w.z; a13 += s1 * w.w;
    a20 += s2 * w.x; a21 += s2 * w.y; a22 += s2 * w.z; a23 += s2 * w.w;
  }
  float* r0 = red + (ks * 3 + 0) * 64 + c4 * 4; r0[0] = a00; r0[1] = a01; r0[2] = a02; r0[3] = a03;
  float* r1 = red + (ks * 3 + 1) * 64 + c4 * 4; r1[0] = a10; r1[1] = a11; r1[2] = a12; r1[3] = a13;
  float* r2 = red + (ks * 3 + 2) * 64 + c4 * 4; r2[0] = a20; r2[1] = a21; r2[2] = a22; r2[3] = a23;
  __syncthreads();
  if (t < 192) {
    const int c = t >> 6, col = t & 63;
    float v = p.in[I_MODB][l * 6144 + jb * 64 + col];
#pragma unroll
    for (int k2 = 0; k2 < 16; ++k2) v += red[(k2 * 3 + c) * 64 + col];
    ((float*)(p.ws + OFF_MOD))[(size_t)(l * 3 + c) * 6144 + jb * 64 + col] = v;
  }
  __syncthreads();
}

DEV void hglb_item(const Params& p) {
  const int c = tid();
  float* HGLB = (float*)(p.ws + OFF_HGLB);
  for (int dir = 0; dir < 2; ++dir) {
    float x[4], mx = -1e30f;
    for (int l = 0; l < 4; ++l) { x[l] = p.in[I_HGLB][(dir * 4 + l) * 256 + c]; mx = fmaxf(mx, x[l]); }
    float s = 0;
    for (int l = 0; l < 4; ++l) { x[l] = __expf(x[l] - mx); s += x[l]; }
    float cum = 0; const float s0 = x[0] / s;
    for (int l = 0; l < 4; ++l) { cum += x[l] / s; HGLB[(l * 2 + dir) * 256 + c] = cum - s0; }
  }
}

constexpr int NT_LAYER = 928 + 256 + 1024 + 1024;
struct TileDesc { const float* W; bf16_t* WT; int K, N, kt, nt; };
DEV TileDesc layer_tile_desc(const Params& p, int l, int j) {
  TileDesc d;
  if (j < 928) { d.W = p.in[I_WIN] + (size_t)l * D * DIN; d.WT = (bf16_t*)(p.ws + OFF_WIN) + (size_t)l * DINP * D; d.K = D; d.N = DIN; d.kt = j / 58; d.nt = j % 58; return d; }
  j -= 928;
  if (j < 256) { d.W = p.in[I_WOUT] + (size_t)l * D * D; d.WT = (bf16_t*)(p.ws + OFF_WOUT) + (size_t)l * D * D; d.K = D; d.N = D; d.kt = j / 16; d.nt = j % 16; return d; }
  j -= 256;
  if (j < 1024) { d.W = p.in[I_FW1] + (size_t)l * D * FF; d.WT = (bf16_t*)(p.ws + OFF_W1) + (size_t)l * FF * D; d.K = D; d.N = FF; d.kt = j / 64; d.nt = j % 64; return d; }
  j -= 1024;
  d.W = p.in[I_FW2] + (size_t)l * FF * D; d.WT = (bf16_t*)(p.ws + OFF_W2) + (size_t)l * D * FF; d.K = FF; d.N = D; d.kt = j / 16; d.nt = j % 16; return d;
}
DEV void tile_load(const TileDesc& d, float4 (&v)[4]) {
  const int t = tid();
#pragma unroll
  for (int i = 0; i < 4; ++i) v[i] = *(const float4*)(d.W + (size_t)(d.kt * 64 + (t >> 4) + 16 * i) * d.N + d.nt * 64 + (t & 15) * 4);
}
DEV void tile_store(const TileDesc& d, const float4 (&v)[4], char* lds) {
  bf16_t* s = (bf16_t*)lds;
  const int t = tid();
#pragma unroll
  for (int i = 0; i < 4; ++i) {
    const int k = (t >> 4) + 16 * i, n4 = (t & 15) * 4;
    s[(n4 + 0) * 72 + k] = f2bf(v[i].x); s[(n4 + 1) * 72 + k] = f2bf(v[i].y);
    s[(n4 + 2) * 72 + k] = f2bf(v[i].z); s[(n4 + 3) * 72 + k] = f2bf(v[i].w);
  }
  __syncthreads();
#pragma unroll
  for (int i = 0; i < 2; ++i) {
    const int n = (t >> 3) + 32 * i, kc = t & 7;
    const uint4 o = *(const uint4*)(s + n * 72 + kc * 8);
    *(uint4*)(d.WT + (size_t)(d.nt * 64 + n) * d.K + d.kt * 64 + kc * 8) = o;
  }
  __syncthreads();
}
DEV void layer_tiles(const Params& p, int l, int lo, int hi, int vb, int nvb, char* lds0) {
  const int hf = half_id(); char* lds = lds0 + hf * 65536;
  int it = lo + vb * 2 + hf;
  if (it >= hi) return;
  float4 vn[4];
  TileDesc dn = layer_tile_desc(p, l, it);
  tile_load(dn, vn);
  for (; it < hi; it += nvb * 2) {
    float4 vc[4] = {vn[0], vn[1], vn[2], vn[3]};
    const TileDesc dc = dn;
    if (it + nvb * 2 < hi) { dn = layer_tile_desc(p, l, it + nvb * 2); tile_load(dn, vn); }
    tile_store(dc, vc, lds);
  }
}

DEV void phase0(const Params& p, char* lds0) {
  const int hf = half_id(); char* lds = lds0 + hf * 65536;
  const int nitems = 386 + 4;
  for (int it = blockIdx.x * 2 + hf; it < nitems; it += gridDim.x * 2) {
    if (it < 384) { mod_item(p, it / 96, it % 96, lds); continue; }
    if (it == 384) { hglb_item(p); continue; }
    if (it == 385) continue;
    const int j = it - 386;
    {
      uint4* z = (uint4*)((bf16_t*)(p.ws + OFF_WIN) + ((size_t)j * DINP + DIN) * D);
      const int t = tid();
      for (int i = t; i < 128 * D * 2 / 16; i += 256) z[i] = make_uint4(0u, 0u, 0u, 0u);
    }
  }
  const int vb = ((int)blockIdx.x + (int)gridDim.x - 195 % (int)gridDim.x) % (int)gridDim.x;
  layer_tiles(p, 0, 0, NT_LAYER, vb, (int)gridDim.x, lds0);
}

constexpr int RPW = 5;
DEV void row_phase(const Params& p, int mode, int l) {
  const int lane = tid() & 63;
  const int nw = gridDim.x * 8;
  const float* MOD = (const float*)(p.ws + OFF_MOD);
  const float* NG = p.in[I_NORMG];
  const bf16_t* U = (const bf16_t*)(p.ws + OFF_U);
  bf16_t* H = (bf16_t*)(p.ws + OFF_H);
  bf16_t* X16 = (bf16_t*)(p.ws + OFF_X16);
  const bool has_next = !(mode == 2 && l == 3);
  const int ln = (mode == 0) ? 0 : (mode == 1 ? l : l + 1);
  const int gi = (mode == 1) ? 2 : 0, shi = (mode == 1) ? 3 : 0, sci = (mode == 1) ? 4 : 1;
  const float* ga = NG + (size_t)(l * 4 + (mode == 1 ? 1 : 3)) * 1024;
  const float* gb = NG + (size_t)((has_next ? ln : 0) * 4 + gi) * 1024;
  for (int rowa = blockIdx.x * 8 + half_id() * 4 + (tid() >> 6); rowa < MT; rowa += RPW * nw) {
    float4 x[RPW][4]; uint2 ub[RPW][4];
    int rows[RPW]; bool ok[RPW];
#pragma unroll
    for (int q = 0; q < RPW; ++q) {
      rows[q] = rowa + q * nw; ok[q] = rows[q] < MT;
      const int row = ok[q] ? rows[q] : rowa;
      if (mode == 0) {
        const float* src = row < NCTX ? p.in[I_XP] + (size_t)row * D : p.in[I_XS] + (size_t)(row - NCTX) * D;
#pragma unroll
        for (int i = 0; i < 4; ++i) x[q][i] = *(const float4*)(src + i * 256 + lane * 4);
      } else {
#pragma unroll
        for (int i = 0; i < 4; ++i) {
          const uint2 xb = *(const uint2*)(X16 + (size_t)row * D + i * 256 + lane * 4);
          x[q][i] = make_float4(bflo(xb.x), bfhi(xb.x), bflo(xb.y), bfhi(xb.y));
          ub[q][i] = *(const uint2*)(U + (size_t)row * D + i * 256 + lane * 4);
        }
      }
    }
#pragma unroll
    for (int q = 0; q < RPW; ++q) {
      const int row = ok[q] ? rows[q] : rowa;
      const int cond = row < NCTX ? 0 : 1 + ((row - NCTX) >> 10);
      if (mode != 0) {
        float4 u[4];
        float ss = 0;
#pragma unroll
        for (int i = 0; i < 4; ++i) {
          u[i] = make_float4(bflo(ub[q][i].x), bfhi(ub[q][i].x), bflo(ub[q][i].y), bfhi(ub[q][i].y));
          ss += u[i].x * u[i].x + u[i].y * u[i].y + u[i].z * u[i].z + u[i].w * u[i].w;
        }
        ss = wave_sum(ss);
        const float r = rsqrtf(ss * (1.0f / 1024.0f) + 1e-6f);
        const float* gate = MOD + (size_t)(l * 3 + cond) * 6144 + (mode == 1 ? 2 : 5) * 1024;
#pragma unroll
        for (int i = 0; i < 4; ++i) {
          const float4 g4 = *(const float4*)(gate + i * 256 + lane * 4);
          const float4 a4 = *(const float4*)(ga + i * 256 + lane * 4);
          x[q][i].x += g4.x * (u[i].x * r * a4.x); x[q][i].y += g4.y * (u[i].y * r * a4.y);
          x[q][i].z += g4.z * (u[i].z * r * a4.z); x[q][i].w += g4.w * (u[i].w * r * a4.w);
        }
      }
      if (ok[q]) {
        if (has_next) {
#pragma unroll
          for (int i = 0; i < 4; ++i) { uint2 o; o.x = pk2(x[q][i].x, x[q][i].y); o.y = pk2(x[q][i].z, x[q][i].w); *(uint2*)(X16 + (size_t)row * D + i * 256 + lane * 4) = o; }
        } else {
#pragma unroll
          for (int i = 0; i < 4; ++i) *(float4*)(p.out + (size_t)row * D + i * 256 + lane * 4) = x[q][i];
        }
      }
      if (has_next) {
        float ss = 0;
#pragma unroll
        for (int i = 0; i < 4; ++i) ss += x[q][i].x * x[q][i].x + x[q][i].y * x[q][i].y + x[q][i].z * x[q][i].z + x[q][i].w * x[q][i].w;
        ss = wave_sum(ss);
        const float r2 = rsqrtf(ss * (1.0f / 1024.0f) + 1e-6f);
        const float* sh = MOD + (size_t)(ln * 3 + cond) * 6144 + shi * 1024;
        const float* sc = MOD + (size_t)(ln * 3 + cond) * 6144 + sci * 1024;
        if (ok[q]) {
#pragma unroll
          for (int i = 0; i < 4; ++i) {
            const float4 g4 = *(const float4*)(gb + i * 256 + lane * 4);
            const float4 s4 = *(const float4*)(sc + i * 256 + lane * 4);
            const float4 h4 = *(const float4*)(sh + i * 256 + lane * 4);
            const float h0 = x[q][i].x * r2 * g4.x * (1.0f + s4.x) + h4.x;
            const float h1 = x[q][i].y * r2 * g4.y * (1.0f + s4.y) + h4.y;
            const float h2 = x[q][i].z * r2 * g4.z * (1.0f + s4.z) + h4.z;
            const float h3 = x[q][i].w * r2 * g4.w * (1.0f + s4.w) + h4.w;
            uint2 o; o.x = pk2(h0, h1); o.y = pk2(h2, h3);
            *(uint2*)(H + (size_t)row * D + i * 256 + lane * 4) = o;
          }
        }
      }
    }
  }
}

namespace pg8 {
#define PG8_LAS __attribute__((address_space(3)))
typedef unsigned short bf16_t;
typedef short bf16x8 __attribute__((ext_vector_type(8)));
typedef float f32x4 __attribute__((ext_vector_type(4)));
typedef unsigned u32x4 __attribute__((ext_vector_type(4)));
constexpr int BM = 256, BK = 64, HALF = 128, HTB = HALF * BK * 2  , STAGE_BYTES = 8 * HTB, NXCD = 8, WGM = 8;

__host__ __device__ __forceinline__ int lds_byte(int r, int c) { const int st = (r >> 4) * 2 + (c >> 5), rr = r & 15, cc = c & 31, ob = rr * 64 + cc * 2; return st * 1024 + (ob ^ (((ob >> 9) & 1) << 5)); }
__host__ __device__ __forceinline__ void stage_rc(int b, int& R, int& C) { const int st = b / 1024, sb = b % 1024, swz = sb ^ (((sb >> 9) & 1) << 5); R = (st >> 1) * 16 + swz / 64; C = (st & 1) * 32 + (swz % 64) / 2; }
__host__ __device__ __forceinline__ int perm32(int rho) { const int n = rho >> 4, i = rho & 15; return 8 * (i >> 2) + 4 * n + (i & 3); }

struct Unit { int pm, pn; };
struct Gemm { const bf16_t* A; const bf16_t* Bt; int M, N, K; };

struct StaticOrder {
    int nM, nN, nwg, G, c;
    __host__ __device__ void init(int M, int N, int G_, int c_) { nM = M / BM; nN = N / BM; nwg = nM * nN; G = G_; c = c_; }
    __host__ __device__ bool next(int i, Unit& u) const {
        const long L = (long)i * G + c; if (L >= nwg) return false;
        int wgid = (int)L; { const int q = nwg / NXCD, r = nwg % NXCD, xcd = wgid % NXCD, off = wgid / NXCD; wgid = (xcd < r ? xcd * (q + 1) : r * (q + 1) + (xcd - r) * q) + off; }
        const int nig = WGM * nN, gid = wgid / nig, fm = gid * WGM, gsz = (nM - fm) < WGM ? (nM - fm) : WGM;
        u.pm = fm + ((wgid % nig) % gsz); u.pn = (wgid % nig) / gsz; return true;
    }
    __device__ __forceinline__ void a_ready(const Unit&) const {}
    __device__ __forceinline__ void done(const Unit&) const {}
};

template <class Epi, class Sched, bool ALIGN_EPI = false, bool SP2 = false>
__device__ __forceinline__ void gemm_phase(PG8_LAS unsigned char* lds, const Gemm g, const Sched& S, const Epi& E) {
    int tid_z; asm volatile("v_mov_b32 %0, 0" : "=v"(tid_z)); const int tid = (int)threadIdx.x + tid_z, wid = __builtin_amdgcn_readfirstlane(tid >> 6), lane = tid & 63, wr = wid >> 2, wc = wid & 3, fr = lane & 15, fq = lane >> 4;
    const int K = g.K, nt = K / BK;
    unsigned voffA[2], voffB[2];
#pragma unroll
    for (int i = 0; i < 2; ++i) { int R, C; stage_rc(tid * 16 + i * 8192, R, C); const int Rb = Epi::PERM ? ((R & ~31) + perm32(R & 31)) : R;
        voffA[i] = (unsigned)(R * K + C) * 2u; voffB[i] = (unsigned)(Rb * K + C) * 2u; }
    const size_t kstep = (size_t)(BK * 2);
    const size_t hstep = (size_t)HALF * K * 2;
    const size_t tstep = 2 * hstep;
    const unsigned ldsw = (unsigned)wid * 1024u;
    const int aoff = lds_byte(wr * 64 + fr, fq * 8), boff = lds_byte(wc * 32 + fr, fq * 8);
#define PG8_SA(b, h) (((b) * 2 + (h)) * HTB)
#define PG8_SB(b, h) ((4 + (b) * 2 + (h)) * HTB)
#define PG8_STAGE(bufoff, gbase, voff) do { _Pragma("unroll") for (int _i = 0; _i < 2; ++_i) \
        __builtin_amdgcn_global_load_lds((const unsigned*)((const char*)(gbase) + (voff)[_i]), (PG8_LAS unsigned*)(lds + (bufoff) + ldsw + _i * 8192), 16, 0, 0); } while (0)
#define PG8_LDA(dst, b, h) do { _Pragma("unroll") for (int m = 0; m < 4; ++m) _Pragma("unroll") for (int k = 0; k < 2; ++k) dst[m][k] = *(const PG8_LAS bf16x8*)(lds + PG8_SA(b, h) + aoff + m * 2048 + k * 1024); } while (0)
#define PG8_LDB(dst, b, h) do { _Pragma("unroll") for (int n = 0; n < 2; ++n) _Pragma("unroll") for (int k = 0; k < 2; ++k) dst[n][k] = *(const PG8_LAS bf16x8*)(lds + PG8_SB(b, h) + boff + n * 2048 + k * 1024); } while (0)
#define PG8_MMA(ai, bj, At, Bt) do { __builtin_amdgcn_s_setprio(1); _Pragma("unroll") for (int m = 0; m < 4; ++m) _Pragma("unroll") for (int n = 0; n < 2; ++n) _Pragma("unroll") for (int k = 0; k < 2; ++k) \
        acc[ai][bj][m][n] = __builtin_amdgcn_mfma_f32_16x16x32_bf16(Bt[n][k], At[m][k], acc[ai][bj][m][n], 0, 0, 0); __builtin_amdgcn_s_setprio(0); } while (0)
#define PG8_WAIT_V(n) asm volatile("s_waitcnt vmcnt(" #n ")" ::: "memory")
#define PG8_WAIT_L(n) asm volatile("s_waitcnt lgkmcnt(" #n ")" ::: "memory")
#define PG8_BAR __builtin_amdgcn_s_barrier()
#define PG8_SCHED __builtin_amdgcn_sched_barrier(0)
    Unit cur, nxt; int ui = 0;
    if (!S.next(0, cur)) return;
    f32x4 acc[2][2][4][2];
#pragma unroll
    for (int a = 0; a < 2; ++a)
#pragma unroll
        for (int b = 0; b < 2; ++b)
#pragma unroll
            for (int m = 0; m < 4; ++m)
#pragma unroll
                for (int n = 0; n < 2; ++n) acc[a][b][m][n] = (f32x4){0.f, 0.f, 0.f, 0.f};
    bf16x8 At[4][2], B0[2][2], B1[2][2];
    const char* cA = (const char*)g.A + (size_t)cur.pm * tstep; const char* cB = (const char*)g.Bt + (size_t)cur.pn * tstep;
    S.a_ready(cur);
    if constexpr (SP2) {
        PG8_STAGE(PG8_SB(0, 0), cB, voffB); PG8_STAGE(PG8_SB(0, 1), cB + hstep, voffB); PG8_STAGE(PG8_SA(0, 0), cA, voffA); PG8_STAGE(PG8_SA(0, 1), cA + hstep, voffA);
        if (wr == 1) PG8_BAR;
        PG8_WAIT_V(2); PG8_BAR;
        PG8_STAGE(PG8_SB(1, 0), cB + kstep, voffB); PG8_STAGE(PG8_SA(1, 0), cA + kstep, voffA); PG8_STAGE(PG8_SB(1, 1), cB + hstep + kstep, voffB);
        PG8_WAIT_V(6); PG8_BAR;
    } else {
        PG8_STAGE(PG8_SB(0, 0), cB, voffB); PG8_STAGE(PG8_SA(0, 0), cA, voffA); PG8_STAGE(PG8_SB(0, 1), cB + hstep, voffB); PG8_STAGE(PG8_SA(0, 1), cA + hstep, voffA);
        if (wr == 1) PG8_BAR;
        PG8_WAIT_V(4); PG8_BAR;
        PG8_STAGE(PG8_SB(1, 0), cB + kstep, voffB); PG8_STAGE(PG8_SA(1, 0), cA + kstep, voffA); PG8_STAGE(PG8_SB(1, 1), cB + hstep + kstep, voffB);
        PG8_WAIT_V(6); PG8_BAR;
    }
    for (;;) {
        const bool has_next = S.next(ui + 1, nxt);
        const char* nA = has_next ? (const char*)g.A + (size_t)nxt.pm * tstep : cA; const char* nB = has_next ? (const char*)g.Bt + (size_t)nxt.pn * tstep : cB;
        for (int t = 0; t < nt; t += 2) {
            const bool last = (t == nt - 2);
            const char* a1 = cA + (size_t)(t + 1) * kstep;
            const char* a2 = last ? nA : cA + (size_t)(t + 2) * kstep; const char* b2 = last ? nB : cB + (size_t)(t + 2) * kstep;
            const char* a3 = a2 + kstep; const char* b3 = b2 + kstep;
            if (last && has_next) S.a_ready(nxt);
            if constexpr (SP2) {
            PG8_LDB(B0, 0, 0); PG8_LDB(B1, 0, 1); PG8_SCHED; PG8_LDA(At, 0, 0); PG8_STAGE(PG8_SA(1, 1), a1 + hstep, voffA);
            PG8_WAIT_V(8); PG8_WAIT_L(0); PG8_BAR; PG8_MMA(0, 0, At, B0); PG8_MMA(0, 1, At, B1); PG8_BAR; PG8_SCHED;
            PG8_LDA(At, 0, 1); PG8_STAGE(PG8_SB(0, 0), b2, voffB); PG8_STAGE(PG8_SB(0, 1), b2 + hstep, voffB); PG8_STAGE(PG8_SA(0, 0), a2, voffA);
            PG8_WAIT_V(8); PG8_WAIT_L(0); PG8_BAR; PG8_MMA(1, 0, At, B0); PG8_MMA(1, 1, At, B1); PG8_BAR; PG8_SCHED;
            PG8_LDB(B0, 1, 0); PG8_LDB(B1, 1, 1); PG8_SCHED; PG8_LDA(At, 1, 0); PG8_STAGE(PG8_SA(0, 1), a2 + hstep, voffA);
            PG8_WAIT_V(8); PG8_WAIT_L(0); PG8_BAR; PG8_MMA(0, 0, At, B0); PG8_MMA(0, 1, At, B1); PG8_BAR; PG8_SCHED;
            PG8_LDA(At, 1, 1); PG8_STAGE(PG8_SB(1, 0), b3, voffB); PG8_STAGE(PG8_SB(1, 1), b3 + hstep, voffB); PG8_STAGE(PG8_SA(1, 0), a3, voffA);
            PG8_WAIT_V(8); PG8_WAIT_L(0); PG8_BAR; PG8_MMA(1, 0, At, B0); PG8_MMA(1, 1, At, B1); PG8_BAR; PG8_SCHED;
            } else {
            PG8_LDB(B0, 0, 0); PG8_SCHED; PG8_LDA(At, 0, 0); PG8_STAGE(PG8_SA(1, 1), a1 + hstep, voffA);
            PG8_WAIT_L(8); PG8_BAR; PG8_WAIT_L(0); PG8_MMA(0, 0, At, B0); PG8_BAR; PG8_SCHED;
            PG8_LDB(B1, 0, 1); PG8_STAGE(PG8_SB(0, 0), b2, voffB);
            PG8_BAR; PG8_WAIT_L(0); PG8_MMA(0, 1, At, B1); PG8_BAR;
            PG8_LDA(At, 0, 1); PG8_STAGE(PG8_SA(0, 0), a2, voffA);
            PG8_BAR; PG8_WAIT_L(0); PG8_MMA(1, 0, At, B0); PG8_BAR; PG8_SCHED;
            PG8_STAGE(PG8_SB(0, 1), b2 + hstep, voffB);
            PG8_WAIT_V(6); PG8_BAR; PG8_MMA(1, 1, At, B1); PG8_BAR;
            PG8_LDB(B0, 1, 0); PG8_SCHED; PG8_LDA(At, 1, 0); PG8_STAGE(PG8_SA(0, 1), a2 + hstep, voffA);
            PG8_WAIT_L(8); PG8_BAR; PG8_WAIT_L(0); PG8_MMA(0, 0, At, B0); PG8_BAR; PG8_SCHED;
            PG8_LDB(B1, 1, 1); PG8_STAGE(PG8_SB(1, 0), b3, voffB);
            PG8_BAR; PG8_WAIT_L(0); PG8_MMA(0, 1, At, B1); PG8_BAR;
            PG8_LDA(At, 1, 1); PG8_STAGE(PG8_SA(1, 0), a3, voffA);
            PG8_BAR; PG8_WAIT_L(0); PG8_MMA(1, 0, At, B0); PG8_BAR; PG8_SCHED;
            PG8_STAGE(PG8_SB(1, 1), b3 + hstep, voffB);
            PG8_WAIT_V(6); PG8_BAR; PG8_MMA(1, 1, At, B1); PG8_BAR;
            }
        }
        if constexpr (ALIGN_EPI) { if (wr == 0) PG8_BAR; }
        if constexpr (!Epi::AFTER_DRAIN) { E(acc, cur, wr, wc, fr, fq); S.done(cur); }
        if (!has_next) break;
#pragma unroll
        for (int a = 0; a < 2; ++a)
#pragma unroll
            for (int b = 0; b < 2; ++b)
#pragma unroll
                for (int m = 0; m < 4; ++m)
#pragma unroll
                    for (int n = 0; n < 2; ++n) acc[a][b][m][n] = (f32x4){0.f, 0.f, 0.f, 0.f};
        cur = nxt; cA = nA; cB = nB; ++ui;
        if constexpr (ALIGN_EPI) { if (wr == 1) PG8_BAR; }
    }
    PG8_WAIT_V(0);
    if constexpr (!ALIGN_EPI) { if (wr == 0) PG8_BAR; }
    PG8_BAR;
    if constexpr (Epi::AFTER_DRAIN) { E.fused(acc, cur, wr, wc, fr, fq, lds, wid, lane); S.done(cur); }
#undef PG8_SA
#undef PG8_SB
#undef PG8_STAGE
#undef PG8_LDA
#undef PG8_LDB
#undef PG8_MMA
#undef PG8_WAIT_V
#undef PG8_WAIT_L
#undef PG8_BAR
#undef PG8_SCHED
}
}

template <int MODE> struct EpiMK {
  static constexpr bool PERM = false, AFTER_DRAIN = false;
  const Params* pp; int l;
  DEV void operator()(const pg8::f32x4 (&acc)[2][2][4][2], const pg8::Unit& u, int wr, int wc, int fr, int fq) const {
    const Params& p = *pp;
#pragma unroll
    for (int ai = 0; ai < 2; ++ai)
#pragma unroll
      for (int m = 0; m < 4; ++m) {
        const int row = u.pm * 256 + ai * 128 + wr * 64 + m * 16 + fr;
#pragma unroll
        for (int bj = 0; bj < 2; ++bj)
#pragma unroll
          for (int n = 0; n < 2; ++n) {
            const int col = u.pn * 256 + bj * 128 + wc * 32 + n * 16 + fq * 4;
            const pg8::f32x4 v = acc[ai][bj][m][n];
            if (MODE == 0) {
              if (col < DIN) {
                uint2 o; o.x = pk2(v[0], v[1]); o.y = pk2(v[2], v[3]);
                *(uint2*)((bf16_t*)(p.ws + OFF_P) + (size_t)row * DIN + col) = o;
                if (row < NCTX) {
                  if (col >= C_NK && col < C_HQ) {
                    const int kv = col >= C_NV;
                    *(pg8::f32x4*)(p.out + O_NAT + (size_t)(((row >> 8) * 4 + l) * 2 + kv) * 65536 + (row & 255) * 256 + (col - (kv ? C_NV : C_NK))) = v;
                  } else if (col >= C_SK) {
                    const int kv = col >= C_SV;
                    *(pg8::f32x4*)(p.out + O_SWA + (size_t)(((row >> 8) * 4 + l) * 2 + kv) * 32768 + (row & 255) * 128 + (col - (kv ? C_SV : C_SK))) = v;
                  }
                }
              }
            } else if (MODE == 1) {
              uint2 o; o.x = pk2(v[0], v[1]); o.y = pk2(v[2], v[3]);
              *(uint2*)((bf16_t*)(p.ws + OFF_U) + (size_t)row * D + col) = o;
            } else {
              const float r0 = fmaxf(v[0], 0.f), r1 = fmaxf(v[1], 0.f), r2 = fmaxf(v[2], 0.f), r3 = fmaxf(v[3], 0.f);
              uint2 o; o.x = pk2(r0 * r0, r1 * r1); o.y = pk2(r2 * r2, r3 * r3);
              *(uint2*)((bf16_t*)(p.ws + OFF_HID) + (size_t)row * FF + col) = o;
            }
          }
      }
  }
};

template <int MODE>
DEV void gemm_run(const Params& p, int l, const bf16_t* A, const bf16_t* BT, int K, int N, char* lds) {
  pg8::Gemm g{A, BT, MT, N, K};
  pg8::StaticOrder S; S.init(MT, N, (int)gridDim.x, (int)blockIdx.x);
  EpiMK<MODE> E{&p, l};
  pg8::gemm_phase<EpiMK<MODE>, pg8::StaticOrder, true, true>((PG8_LAS unsigned char*)lds, g, S, E);
  if (MODE == 1 && l < 3 && (int)gridDim.x > 160 && (int)blockIdx.x >= 160) {
    if (K == D) layer_tiles(p, l + 1, 0, 640, (int)blockIdx.x - 160, (int)gridDim.x - 160, lds);
    else layer_tiles(p, l + 1, 640, NT_LAYER, (int)blockIdx.x - 160, (int)gridDim.x - 160, lds);
  }
}

constexpr int TOKT = 20;
DEV void prep_item(const Params& p, int l, int tile, char* lds) {
  const int t = tid(), r0 = tile * TOKT, c = t;
  float* sT = (float*)lds;
  float* swl = sT + 128 * TOKT;
  float* sal = swl + TOKT * 256;
  const bf16_t* P = (const bf16_t*)(p.ws + OFF_P);
  float* PREP = (float*)(p.ws + OFF_PREP);
  bf16_t* BON = (bf16_t*)(p.ws + OFF_BONUS);
  for (int dir = 0; dir < 2; ++dir) {
    __syncthreads();
#pragma unroll
    for (int i = 0; i < TOKT / 2; ++i) {
      const int e = t + 256 * i, tk = e >> 7, j = e & 127, which = j >> 6, jj = j & 63;
      const int row = r0 + tk, prow = dir ? row + 1 : row - 1;
      const int tis = row < NCTX ? (row & 255) : ((row - NCTX) & 1023), Tm1 = row < NCTX ? 255 : 1023;
      const bool pv = dir ? (tis < Tm1) : (tis > 0);
      const int col = (dir ? C_WHB : C_WHF) + which * 64 + jj;
      const float cur = bf2f(P[(size_t)row * DIN + col]);
      const float prev = bf2f(P[(size_t)(pv ? prow : row) * DIN + col]) * (pv ? 1.f : 0.f);
      const float mu = p.in[I_MULORA][((l * 2 + dir) * 2 + which) * 64 + jj];
      const float val = cur + (prev - cur) * mu;
      sT[j * TOKT + tk] = (which == 0) ? tanhf_(val) : val;
    }
    __syncthreads();
    {
      const float* w2p = p.in[I_W2] + (size_t)(l * 2 + dir) * 64 * 256 + c;
      const float* a2p = p.in[I_A2] + (size_t)(l * 2 + dir) * 64 * 256 + c;
#pragma unroll
      for (int which = 0; which < 2; ++which) {
        float acc[TOKT];
#pragma unroll
        for (int k = 0; k < TOKT; ++k) acc[k] = 0.f;
        float colv[64];
        const float* cp = which ? a2p : w2p;
#pragma unroll
        for (int j = 0; j < 64; ++j) colv[j] = cp[j * 256];
#pragma unroll
        for (int j = 0; j < 64; ++j) {
#pragma unroll
          for (int k4 = 0; k4 < TOKT / 4; ++k4) {
            const float4 x4 = *(const float4*)(sT + (which * 64 + j) * TOKT + k4 * 4);
            acc[k4 * 4 + 0] += x4.x * colv[j]; acc[k4 * 4 + 1] += x4.y * colv[j]; acc[k4 * 4 + 2] += x4.z * colv[j]; acc[k4 * 4 + 3] += x4.w * colv[j];
          }
        }
        float* dst = which ? sal : swl;
#pragma unroll
        for (int k = 0; k < TOKT; ++k) dst[k * 256 + c] = acc[k];
      }
#pragma unroll
      for (int k = 0; k < 1; ++k) {}
    }
    const float w0v = p.in[I_W0][(l * 2 + dir) * 256 + c], a0v = p.in[I_A0][(l * 2 + dir) * 256 + c];
    const float kkv = p.in[I_KK][l * 256 + c], kav = p.in[I_KA][l * 256 + c], rkv = p.in[I_RK][l * 256 + c];
    const float mur = p.in[I_MURKV][((l * 2 + dir) * 3 + 0) * 256 + c], muk = p.in[I_MURKV][((l * 2 + dir) * 3 + 1) * 256 + c],
                muv = p.in[I_MURKV][((l * 2 + dir) * 3 + 2) * 256 + c];
    float* pr = PREP + (size_t)dir * 6 * ARRF;
    for (int tb = 0; tb < TOKT; tb += 5) {
      float rc[5], kc[5], vc[5], rp[5], kq[5], vp[5], wlv[5], alv[5];
#pragma unroll
      for (int u = 0; u < 5; ++u) {
        const int tk = tb + u, row = r0 + tk, prow = dir ? row + 1 : row - 1;
        const int tis = row < NCTX ? (row & 255) : ((row - NCTX) & 1023), Tm1 = row < NCTX ? 255 : 1023;
        const bool pv = dir ? (tis < Tm1) : (tis > 0);
        const float pm = pv ? 1.f : 0.f;
        const bf16_t* pc = P + (size_t)row * DIN + c;
        const bf16_t* pp = P + (size_t)(pv ? prow : row) * DIN + c;
        rc[u] = bf2f(pc[C_R]); kc[u] = bf2f(pc[C_K]); vc[u] = bf2f(pc[C_V]);
        rp[u] = bf2f(pp[C_R]) * pm; kq[u] = bf2f(pp[C_K]) * pm; vp[u] = bf2f(pp[C_V]) * pm;
        wlv[u] = swl[tk * 256 + c]; alv[u] = sal[tk * 256 + c];
      }
      float bprev[5];
#pragma unroll
      for (int u = 0; u < 5; ++u) bprev[u] = (dir == 1) ? bf2f(BON[(size_t)(r0 + tb + u) * 256 + c]) : 0.f;
#pragma unroll
      for (int u = 0; u < 5; ++u) {
        const int row = r0 + tb + u;
        const float rs = rc[u] + (rp[u] - rc[u]) * mur, ks = kc[u] + (kq[u] - kc[u]) * muk, vs = vc[u] + (vp[u] - vc[u]) * muv;
        const float wl = w0v + wlv[u], al = a0v + alv[u];
        const float wv = __expf(-0.6065306597126334f * sigmoidf_(wl));
        const float av = sigmoidf_(al);
        const float kkr = ks * kkv;
        const float n2 = wave_sum(kkr * kkr);
        const float kk = kkr * rcpf_(fmaxf(__builtin_amdgcn_sqrtf(n2), 1e-12f));
        const float kp = ks * (1.0f + (av - 1.0f) * kav);
        const float bs = wave_sum(rs * kp * rkv);
        const float bon = bs * vs;
        const size_t idx = (size_t)row * 256 + c;
        pr[idx] = rs; pr[ARRF + idx] = wv; pr[2 * ARRF + idx] = kp; pr[3 * ARRF + idx] = vs; pr[4 * ARRF + idx] = kk; pr[5 * ARRF + idx] = kk * av;
        BON[idx] = f2bf(bprev[u] + bon);
      }
    }
  }
  __syncthreads();
}

DEV void rope_item(const Params& p, int item) {
  bf16_t* P = (bf16_t*)(p.ws + OFF_P);
  const int t = tid();
  for (int e = t; e < 64 * 192; e += 256) {
    const int tk = e / 192, r = e % 192, hs = r >> 5, pi = r & 31;
    const int lt = item * 64 + tk;
    const int tt = lt & 1023;
    const int grow = tt >> 6, gcol = tt & 63;
    const int fi = pi & 15;
    const float pos = (pi < 16) ? (float)grow : (float)gcol;
    const float inv = exp2f(-(float)fi * (13.287712379549449f / 16.0f));
    const float ang = pos * inv;
    const float cs = __cosf(ang), sn = __sinf(ang);
    const int d1 = (pi < 16) ? fi : 32 + fi;
    bf16_t* base = P + (size_t)(NCTX + lt) * DIN + C_SQ + hs * 64;
    const float x1 = bf2f(base[d1]), x2 = bf2f(base[d1 + 16]);
    base[d1] = f2bf(x1 * cs - x2 * sn);
    base[d1 + 16] = f2bf(x2 * cs + x1 * sn);
  }
}

constexpr int SC_BUF = 20480 + 4096;
typedef float f2 __attribute__((ext_vector_type(2)));
DEV float dot4(const float4& a, const float4& b) { return a.x * b.x + a.y * b.y + a.z * b.z + a.w * b.w; }
DEV float red8(float x) { x += dppf<0xB1>(x); x += dppf<0x4E>(x); x += dppf<0x141>(x); return x; }
DEV float dot8(const f2 (&S)[4], const float4& a, const float4& b) {
  f2 acc = S[0] * (f2){a.x, a.y};
  acc += S[1] * (f2){a.z, a.w}; acc += S[2] * (f2){b.x, b.y}; acc += S[3] * (f2){b.z, b.w};
  return acc.x + acc.y;
}

template <int NCH>
DEV void rwkv_scan(const Params& p, int l, int seq, int head, int dir, int rsel, char* lds) {
  const int t = tid(), rr = t >> 3, g = t & 7, rl = t >> 4, ks = t & 15;
  const int T = seq < 32 ? 256 : 1024;
  const int row0 = seq < 32 ? seq * 256 : NCTX + (seq - 32) * 1024;
  const float* prep = (const float*)(p.ws + OFF_PREP) + (size_t)dir * 6 * ARRF;
  float* ydir = (float*)(p.ws + OFF_YDIR) + (size_t)dir * ARRF;
  const int vbase = (NCH == 2) ? 0 : rsel * 32;
  f2 S[NCH][4];
#pragma unroll
  for (int c = 0; c < NCH; ++c)
#pragma unroll
    for (int j = 0; j < 4; ++j) S[c][j] = (f2){0.f, 0.f};
  if (seq >= 32) {
    const float* sp = p.in[I_SRW] + ((((size_t)(seq - 32) * 4 + l) * 2 + dir) * 4 + head) * 4096 + g * 8;
#pragma unroll
    for (int c = 0; c < NCH; ++c) {
      const float4 a = *(const float4*)(sp + (vbase + rr + 32 * c) * 64), b = *(const float4*)(sp + (vbase + rr + 32 * c) * 64 + 4);
      S[c][0] = (f2){a.x, a.y}; S[c][1] = (f2){a.z, a.w}; S[c][2] = (f2){b.x, b.y}; S[c][3] = (f2){b.z, b.w};
    }
  }
  const int nch = T >> 4;
  float4 pre0, pre1, pre2, pre3, pre4, pvv;
#define RW_LOAD(cc) do { const int s_ = (cc) * 16 + rl; const int tok_ = dir ? (T - 1 - s_) : s_; \
    const size_t base_ = (size_t)(row0 + tok_) * 256 + head * 64; \
    pre0 = *(const float4*)(prep + base_ + ks * 4); pre1 = *(const float4*)(prep + ARRF + base_ + ks * 4); \
    pre2 = *(const float4*)(prep + 2 * ARRF + base_ + ks * 4); pre3 = *(const float4*)(prep + 4 * ARRF + base_ + ks * 4); \
    pre4 = *(const float4*)(prep + 5 * ARRF + base_ + ks * 4); \
    if (NCH == 2) pvv = *(const float4*)(prep + 3 * ARRF + base_ + ks * 4); \
    else { const f2 v2_ = *(const f2*)(prep + 3 * ARRF + base_ + vbase + ks * 2); pvv.x = v2_.x; pvv.y = v2_.y; } } while (0)
#define RW_WRITE(bb) do { float4* sb_ = (float4*)(lds + (bb) * SC_BUF); float* vb_ = (float*)(lds + (bb) * SC_BUF + 20480); \
    sb_[(0 * 16 + rl) * 16 + ks] = pre0; sb_[(1 * 16 + rl) * 16 + ks] = pre1; sb_[(2 * 16 + rl) * 16 + ks] = pre2; \
    sb_[(3 * 16 + rl) * 16 + ks] = pre3; sb_[(4 * 16 + rl) * 16 + ks] = pre4; \
    if (NCH == 2) *(float4*)(vb_ + rl * 64 + ks * 4) = pvv; else *(f2*)(vb_ + rl * 64 + ks * 2) = (f2){pvv.x, pvv.y}; } while (0)
  __syncthreads();
  RW_LOAD(0); RW_WRITE(0);
  __syncthreads();
  for (int c = 0; c < nch; ++c) {
    if (c + 1 < nch) RW_LOAD(c + 1);
    const float4* sbuf = (const float4*)(lds + (c & 1) * SC_BUF);
    const float* vbuf = (const float*)(lds + (c & 1) * SC_BUF + 20480);
    float ym[NCH][2];
#pragma unroll
    for (int cc = 0; cc < NCH; ++cc) { ym[cc][0] = 0.f; ym[cc][1] = 0.f; }
#pragma unroll
    for (int i = 0; i < 16; ++i) {
      const float4 ra = sbuf[(0 * 16 + i) * 16 + g * 2], rb = sbuf[(0 * 16 + i) * 16 + g * 2 + 1];
      const float4 wa = sbuf[(1 * 16 + i) * 16 + g * 2], wb = sbuf[(1 * 16 + i) * 16 + g * 2 + 1];
      const float4 ka_ = sbuf[(2 * 16 + i) * 16 + g * 2], kb_ = sbuf[(2 * 16 + i) * 16 + g * 2 + 1];
      const float4 na = sbuf[(3 * 16 + i) * 16 + g * 2], nb = sbuf[(3 * 16 + i) * 16 + g * 2 + 1];
      const float4 aa = sbuf[(4 * 16 + i) * 16 + g * 2], ab = sbuf[(4 * 16 + i) * 16 + g * 2 + 1];
      const f2 w2[4] = {(f2){wa.x, wa.y}, (f2){wa.z, wa.w}, (f2){wb.x, wb.y}, (f2){wb.z, wb.w}};
      const f2 k2[4] = {(f2){ka_.x, ka_.y}, (f2){ka_.z, ka_.w}, (f2){kb_.x, kb_.y}, (f2){kb_.z, kb_.w}};
      const f2 a2[4] = {(f2){aa.x, aa.y}, (f2){aa.z, aa.w}, (f2){ab.x, ab.y}, (f2){ab.z, ab.w}};
#pragma unroll
      for (int cc = 0; cc < NCH; ++cc) {
        const float v = vbuf[i * 64 + rr + 32 * cc];
        const float sa = -red8(dot8(S[cc], na, nb));
#pragma unroll
        for (int j = 0; j < 4; ++j) S[cc][j] = S[cc][j] * w2[j] + a2[j] * sa + k2[j] * v;
        const float y = red8(dot8(S[cc], ra, rb));
        ym[cc][i >> 3] = (g == (i & 7)) ? y : ym[cc][i >> 3];
      }
    }
#pragma unroll
    for (int hh = 0; hh < 2; ++hh) {
      const int s = c * 16 + hh * 8 + g; const int tok = dir ? (T - 1 - s) : s;
      float* yo = ydir + (size_t)(row0 + tok) * 256 + head * 64 + vbase + rr;
#pragma unroll
      for (int cc = 0; cc < NCH; ++cc) yo[32 * cc] = ym[cc][hh];
    }
    if (c + 1 < nch) RW_WRITE((c + 1) & 1);
    __syncthreads();
  }
#undef RW_LOAD
#undef RW_WRITE
  if (seq < 32) {
    float* sp = p.out + O_RW + ((((size_t)seq * 4 + l) * 2 + dir) * 4 + head) * 4096 + g * 8;
#pragma unroll
    for (int c = 0; c < NCH; ++c) {
      *(float4*)(sp + (vbase + rr + 32 * c) * 64) = make_float4(S[c][0].x, S[c][0].y, S[c][1].x, S[c][1].y);
      *(float4*)(sp + (vbase + rr + 32 * c) * 64 + 4) = make_float4(S[c][2].x, S[c][2].y, S[c][3].x, S[c][3].y);
    }
  }
}

template <int NCH>
DEV void hgrn_scan(const Params& p, int l, int seq, int head, int dir, int rsel, char* lds) {
  const int t = tid(), rr = t >> 3, g = t & 7, rl = t >> 4, ks = t & 15;
  const int T = seq < 32 ? 256 : 1024;
  const int row0 = seq < 32 ? seq * 256 : NCTX + (seq - 32) * 1024;
  const bf16_t* P = (const bf16_t*)(p.ws + OFF_P);
  float* odir = (float*)(p.ws + OFF_HDIR) + (size_t)dir * ARRF;
  const float4 lb4 = *(const float4*)((const float*)(p.ws + OFF_HGLB) + (l * 2 + dir) * 256 + head * 64 + ks * 4);
  const int vbase = (NCH == 2) ? 0 : rsel * 32;
  f2 S[NCH][4];
#pragma unroll
  for (int c = 0; c < NCH; ++c)
#pragma unroll
    for (int j = 0; j < 4; ++j) S[c][j] = (f2){0.f, 0.f};
  if (seq >= 32) {
    const float* sp = p.in[I_SHG] + ((((size_t)(seq - 32) * 4 + l) * 2 + dir) * 4 + head) * 4096;
#pragma unroll
    for (int c = 0; c < NCH; ++c)
#pragma unroll
      for (int j = 0; j < 4; ++j) {
        const int v = vbase + rr + 32 * c;
        S[c][j] = (f2){sp[(g * 8 + 2 * j) * 64 + v], sp[(g * 8 + 2 * j + 1) * 64 + v]};
      }
  }
  const int nch = T >> 4;
  const int fcol = (dir ? C_HFB : C_HFF) + head * 64;
  uint2 pq, pf, pv2;
#define HG_LOAD(cc) do { const int s_ = (cc) * 16 + rl; const int tok_ = dir ? (T - 1 - s_) : s_; \
    const bf16_t* pr_ = P + (size_t)(row0 + tok_) * DIN; \
    pq = *(const uint2*)(pr_ + C_HQ + head * 64 + ks * 4); pf = *(const uint2*)(pr_ + fcol + ks * 4); \
    if (NCH == 2) pv2 = *(const uint2*)(pr_ + C_HI + head * 64 + ks * 4); else pv2.x = *(const unsigned*)(pr_ + C_HI + head * 64 + vbase + ks * 2); } while (0)
#define HG_WRITE(bb) do { float4* sb_ = (float4*)(lds + (bb) * SC_BUF); float* vb_ = (float*)(lds + (bb) * SC_BUF + 20480); \
    float4 q_, f_, k_; float a_, sg_; \
    a_ = bflo(pq.x); q_.x = a_ * sigmoidf_(a_); a_ = bfhi(pq.x); q_.y = a_ * sigmoidf_(a_); \
    a_ = bflo(pq.y); q_.z = a_ * sigmoidf_(a_); a_ = bfhi(pq.y); q_.w = a_ * sigmoidf_(a_); \
    sg_ = sigmoidf_(bflo(pf.x)); f_.x = lb4.x + (1.f - lb4.x) * sg_; k_.x = (1.f - lb4.x) * (1.f - sg_); \
    sg_ = sigmoidf_(bfhi(pf.x)); f_.y = lb4.y + (1.f - lb4.y) * sg_; k_.y = (1.f - lb4.y) * (1.f - sg_); \
    sg_ = sigmoidf_(bflo(pf.y)); f_.z = lb4.z + (1.f - lb4.z) * sg_; k_.z = (1.f - lb4.z) * (1.f - sg_); \
    sg_ = sigmoidf_(bfhi(pf.y)); f_.w = lb4.w + (1.f - lb4.w) * sg_; k_.w = (1.f - lb4.w) * (1.f - sg_); \
    sb_[(0 * 16 + rl) * 16 + ks] = q_; sb_[(1 * 16 + rl) * 16 + ks] = f_; sb_[(2 * 16 + rl) * 16 + ks] = k_; \
    if (NCH == 2) *(float4*)(vb_ + rl * 64 + ks * 4) = make_float4(bflo(pv2.x), bfhi(pv2.x), bflo(pv2.y), bfhi(pv2.y)); \
    else *(f2*)(vb_ + rl * 64 + ks * 2) = (f2){bflo(pv2.x), bfhi(pv2.x)}; } while (0)
  __syncthreads();
  HG_LOAD(0); HG_WRITE(0);
  __syncthreads();
  for (int c = 0; c < nch; ++c) {
    if (c + 1 < nch) HG_LOAD(c + 1);
    const float4* sbuf = (const float4*)(lds + (c & 1) * SC_BUF);
    const float* vbuf = (const float*)(lds + (c & 1) * SC_BUF + 20480);
    float ym[NCH][2];
#pragma unroll
    for (int cc = 0; cc < NCH; ++cc) { ym[cc][0] = 0.f; ym[cc][1] = 0.f; }
#pragma unroll
    for (int i = 0; i < 16; ++i) {
      const float4 qa = sbuf[(0 * 16 + i) * 16 + g * 2], qb = sbuf[(0 * 16 + i) * 16 + g * 2 + 1];
      const float4 fa = sbuf[(1 * 16 + i) * 16 + g * 2], fb = sbuf[(1 * 16 + i) * 16 + g * 2 + 1];
      const float4 ka_ = sbuf[(2 * 16 + i) * 16 + g * 2], kb_ = sbuf[(2 * 16 + i) * 16 + g * 2 + 1];
      const f2 f2v[4] = {(f2){fa.x, fa.y}, (f2){fa.z, fa.w}, (f2){fb.x, fb.y}, (f2){fb.z, fb.w}};
      const f2 k2[4] = {(f2){ka_.x, ka_.y}, (f2){ka_.z, ka_.w}, (f2){kb_.x, kb_.y}, (f2){kb_.z, kb_.w}};
#pragma unroll
      for (int cc = 0; cc < NCH; ++cc) {
        const float v = vbuf[i * 64 + rr + 32 * cc];
#pragma unroll
        for (int j = 0; j < 4; ++j) S[cc][j] = S[cc][j] * f2v[j] + k2[j] * v;
        const float y = red8(dot8(S[cc], qa, qb));
        ym[cc][i >> 3] = (g == (i & 7)) ? y : ym[cc][i >> 3];
      }
    }
#pragma unroll
    for (int hh = 0; hh < 2; ++hh) {
      const int s = c * 16 + hh * 8 + g; const int tok = dir ? (T - 1 - s) : s;
      float* yo = odir + (size_t)(row0 + tok) * 256 + head * 64 + vbase + rr;
#pragma unroll
      for (int cc = 0; cc < NCH; ++cc) yo[32 * cc] = ym[cc][hh];
    }
    if (c + 1 < nch) HG_WRITE((c + 1) & 1);
    __syncthreads();
  }
#undef HG_LOAD
#undef HG_WRITE
  if (seq < 32) {
    float* sp = p.out + O_HG + ((((size_t)seq * 4 + l) * 2 + dir) * 4 + head) * 4096;
#pragma unroll
    for (int c = 0; c < NCH; ++c)
#pragma unroll
      for (int j = 0; j < 4; ++j) {
        const int v = vbase + rr + 32 * c;
        sp[(g * 8 + 2 * j) * 64 + v] = S[c][j].x; sp[(g * 8 + 2 * j + 1) * 64 + v] = S[c][j].y;
      }
  }
}

DEV void rwkv_scan16(const Params& p, int l, int seq, int head, int dir, int rg, char* lds) {
  const int t = tid(), rl = t >> 4, ks = t & 15;
  const int T = seq < 32 ? 256 : 1024;
  const int row0 = seq < 32 ? seq * 256 : NCTX + (seq - 32) * 1024;
  const float* prep = (const float*)(p.ws + OFF_PREP) + (size_t)dir * 6 * ARRF;
  float* ydir = (float*)(p.ws + OFF_YDIR) + (size_t)dir * ARRF;
  const int v0 = rg * 16 + rl;
  float4 S0 = make_float4(0.f, 0.f, 0.f, 0.f);
  if (seq >= 32) S0 = *(const float4*)(p.in[I_SRW] + ((((size_t)(seq - 32) * 4 + l) * 2 + dir) * 4 + head) * 4096 + ks * 4 + v0 * 64);
  const int nch = T >> 4;
  float4 pre0, pre1, pre2, pre3, pre4; float pv0;
#define RW_LOAD(cc) do { const int s_ = (cc) * 16 + rl; const int tok_ = dir ? (T - 1 - s_) : s_; \
    const size_t base_ = (size_t)(row0 + tok_) * 256 + head * 64; \
    pre0 = *(const float4*)(prep + base_ + ks * 4); pre1 = *(const float4*)(prep + ARRF + base_ + ks * 4); \
    pre2 = *(const float4*)(prep + 2 * ARRF + base_ + ks * 4); pre3 = *(const float4*)(prep + 4 * ARRF + base_ + ks * 4); \
    pre4 = *(const float4*)(prep + 5 * ARRF + base_ + ks * 4); pv0 = prep[3 * ARRF + base_ + rg * 16 + ks]; } while (0)
#define RW_WRITE(bb) do { float4* sb_ = (float4*)(lds + (bb) * SC_BUF); float* vb_ = (float*)(lds + (bb) * SC_BUF + 20480); \
    sb_[(0 * 16 + rl) * 16 + ks] = pre0; sb_[(1 * 16 + rl) * 16 + ks] = pre1; sb_[(2 * 16 + rl) * 16 + ks] = pre2; \
    sb_[(3 * 16 + rl) * 16 + ks] = pre3; sb_[(4 * 16 + rl) * 16 + ks] = pre4; vb_[rl * 16 + ks] = pv0; } while (0)
  __syncthreads();
  RW_LOAD(0); RW_WRITE(0);
  __syncthreads();
  for (int c = 0; c < nch; ++c) {
    if (c + 1 < nch) RW_LOAD(c + 1);
    const float4* sbuf = (const float4*)(lds + (c & 1) * SC_BUF);
    const float* vbuf = (const float*)(lds + (c & 1) * SC_BUF + 20480);
    float ym0 = 0.f;
#pragma unroll
    for (int i = 0; i < 16; ++i) {
      const float4 r = sbuf[(0 * 16 + i) * 16 + ks], wv = sbuf[(1 * 16 + i) * 16 + ks], kv = sbuf[(2 * 16 + i) * 16 + ks],
                   kk = sbuf[(3 * 16 + i) * 16 + ks], ka = sbuf[(4 * 16 + i) * 16 + ks];
      const float va = vbuf[i * 16 + rl];
      const float sa0 = -row16_sum(dot4(S0, kk));
      S0.x = S0.x * wv.x + sa0 * ka.x + va * kv.x; S0.y = S0.y * wv.y + sa0 * ka.y + va * kv.y;
      S0.z = S0.z * wv.z + sa0 * ka.z + va * kv.z; S0.w = S0.w * wv.w + sa0 * ka.w + va * kv.w;
      const float y0 = row16_sum(dot4(S0, r));
      ym0 = (ks == i) ? y0 : ym0;
    }
    {
      const int s = c * 16 + ks; const int tok = dir ? (T - 1 - s) : s;
      ydir[(size_t)(row0 + tok) * 256 + head * 64 + v0] = ym0;
    }
    if (c + 1 < nch) RW_WRITE((c + 1) & 1);
    __syncthreads();
  }
#undef RW_LOAD
#undef RW_WRITE
  if (seq < 32) *(float4*)(p.out + O_RW + ((((size_t)seq * 4 + l) * 2 + dir) * 4 + head) * 4096 + ks * 4 + v0 * 64) = S0;
}

DEV void hgrn_scan16(const Params& p, int l, int seq, int head, int dir, int rg, char* lds) {
  const int t = tid(), rl = t >> 4, ks = t & 15;
  const int T = seq < 32 ? 256 : 1024;
  const int row0 = seq < 32 ? seq * 256 : NCTX + (seq - 32) * 1024;
  const bf16_t* P = (const bf16_t*)(p.ws + OFF_P);
  float* odir = (float*)(p.ws + OFF_HDIR) + (size_t)dir * ARRF;
  const float4 lb4 = *(const float4*)((const float*)(p.ws + OFF_HGLB) + (l * 2 + dir) * 256 + head * 64 + ks * 4);
  const int v0 = rg * 16 + rl;
  float4 S0 = make_float4(0.f, 0.f, 0.f, 0.f);
  if (seq >= 32) {
    const float* sp = p.in[I_SHG] + ((((size_t)(seq - 32) * 4 + l) * 2 + dir) * 4 + head) * 4096;
    S0.x = sp[(ks * 4 + 0) * 64 + v0]; S0.y = sp[(ks * 4 + 1) * 64 + v0]; S0.z = sp[(ks * 4 + 2) * 64 + v0]; S0.w = sp[(ks * 4 + 3) * 64 + v0];
  }
  const int nch = T >> 4;
  const int fcol = (dir ? C_HFB : C_HFF) + head * 64;
  uint2 pq, pf; bf16_t pva;
#define HG_LOAD(cc) do { const int s_ = (cc) * 16 + rl; const int tok_ = dir ? (T - 1 - s_) : s_; \
    const bf16_t* pr_ = P + (size_t)(row0 + tok_) * DIN; \
    pq = *(const uint2*)(pr_ + C_HQ + head * 64 + ks * 4); pf = *(const uint2*)(pr_ + fcol + ks * 4); \
    pva = pr_[C_HI + head * 64 + rg * 16 + ks]; } while (0)
#define HG_WRITE(bb) do { float4* sb_ = (float4*)(lds + (bb) * SC_BUF); float* vb_ = (float*)(lds + (bb) * SC_BUF + 20480); \
    float4 q_, f_, k_; float a_, sg_; \
    a_ = bflo(pq.x); q_.x = a_ * sigmoidf_(a_); a_ = bfhi(pq.x); q_.y = a_ * sigmoidf_(a_); \
    a_ = bflo(pq.y); q_.z = a_ * sigmoidf_(a_); a_ = bfhi(pq.y); q_.w = a_ * sigmoidf_(a_); \
    sg_ = sigmoidf_(bflo(pf.x)); f_.x = lb4.x + (1.f - lb4.x) * sg_; k_.x = (1.f - lb4.x) * (1.f - sg_); \
    sg_ = sigmoidf_(bfhi(pf.x)); f_.y = lb4.y + (1.f - lb4.y) * sg_; k_.y = (1.f - lb4.y) * (1.f - sg_); \
    sg_ = sigmoidf_(bflo(pf.y)); f_.z = lb4.z + (1.f - lb4.z) * sg_; k_.z = (1.f - lb4.z) * (1.f - sg_); \
    sg_ = sigmoidf_(bfhi(pf.y)); f_.w = lb4.w + (1.f - lb4.w) * sg_; k_.w = (1.f - lb4.w) * (1.f - sg_); \
    sb_[(0 * 16 + rl) * 16 + ks] = q_; sb_[(1 * 16 + rl) * 16 + ks] = f_; sb_[(2 * 16 + rl) * 16 + ks] = k_; \
    vb_[rl * 16 + ks] = bf2f(pva); } while (0)
  __syncthreads();
  HG_LOAD(0); HG_WRITE(0);
  __syncthreads();
  for (int c = 0; c < nch; ++c) {
    if (c + 1 < nch) HG_LOAD(c + 1);
    const float4* sbuf = (const float4*)(lds + (c & 1) * SC_BUF);
    const float* vbuf = (const float*)(lds + (c & 1) * SC_BUF + 20480);
    float ym0 = 0.f;
#pragma unroll
    for (int i = 0; i < 16; ++i) {
      const float4 q = sbuf[(0 * 16 + i) * 16 + ks], f = sbuf[(1 * 16 + i) * 16 + ks], k = sbuf[(2 * 16 + i) * 16 + ks];
      const float va = vbuf[i * 16 + rl];
      S0.x = S0.x * f.x + k.x * va; S0.y = S0.y * f.y + k.y * va; S0.z = S0.z * f.z + k.z * va; S0.w = S0.w * f.w + k.w * va;
      const float y0 = row16_sum(dot4(S0, q));
      ym0 = (ks == i) ? y0 : ym0;
    }
    {
      const int s = c * 16 + ks; const int tok = dir ? (T - 1 - s) : s;
      odir[(size_t)(row0 + tok) * 256 + head * 64 + v0] = ym0;
    }
    if (c + 1 < nch) HG_WRITE((c + 1) & 1);
    __syncthreads();
  }
#undef HG_LOAD
#undef HG_WRITE
  if (seq < 32) {
    float* sp = p.out + O_HG + ((((size_t)seq * 4 + l) * 2 + dir) * 4 + head) * 4096;
    sp[(ks * 4 + 0) * 64 + v0] = S0.x; sp[(ks * 4 + 1) * 64 + v0] = S0.y; sp[(ks * 4 + 2) * 64 + v0] = S0.z; sp[(ks * 4 + 3) * 64 + v0] = S0.w;
  }
}

template <int MODE>
DEV void attn_item(const Params& p, int l, int item, char* lds) {
  const int t = tid(), lane = t & 63, w = t >> 6, q = lane & 31, hh = lane >> 5;
  const bf16_t* P = (const bf16_t*)(p.ws + OFF_P);
  bf16_t* Y = (bf16_t*)(p.ws + OFF_YMIX);
  char* sK = lds;
  char* sV = lds + 8192;
  float* sBias = (float*)(lds + 8192 + 8704);
  int head, qrow, qcol, kcol, vcol, ocol, nloc, nt, rowbaseP;
  int qr = 0, qc = 0, rlo = 0, qpos = 0, lo = 0, rsq = 0, wsq = 0;
  float sink = 0.f;
  const float* cache = nullptr; int cH = 1, cHead = 0;
  if (MODE == 0 || MODE == 1) {
    const int b = item >> 3; head = (item >> 1) & 3; const int half = item & 1;
    rowbaseP = b * 256; qrow = rowbaseP + half * 128 + w * 32 + q; nloc = 4; nt = 4;
  } else {
    const int b = item >> 5; head = (item >> 3) & 3; const int sub = item & 7;
    rowbaseP = NCTX + b * 1024;
    if (MODE == 2) {
      qr = 2 * sub + (w >> 1); qc = (w & 1) * 32 + q; qrow = rowbaseP + qr * 64 + qc;
      rlo = clampi(2 * sub - 4, 0, 8); const int rhi = clampi(2 * sub - 3, 0, 8) + 7; nloc = rhi - rlo + 1; nt = nloc + 4;
      rsq = clampi(qr - 4, 0, 8); wsq = clampi(qc - 8, 0, 48);
      cache = p.in[I_CNAT] + (size_t)((b * 4 + l) * 2) * 256 * 256; cH = 4; cHead = head;
      for (int i = t; i < 465; i += 256) sBias[i] = p.in[I_RPB][(size_t)(l * 4 + head) * 465 + i];
    } else {
      qpos = sub * 128 + w * 32 + q; qrow = rowbaseP + qpos;
      lo = (sub - 1) * 128;
      nloc = 6; nt = nloc + 4;
      cache = p.in[I_CSWA] + (size_t)((b * 4 + l) * 2) * 256 * 128; cH = 2; cHead = head >> 1;
    }
  }
  if (MODE == 0 || MODE == 2) { qcol = C_NQ + head * 64; kcol = C_NK + head * 64; vcol = C_NV + head * 64; ocol = 256 + head * 64; }
  else { qcol = C_SQ + head * 64; kcol = C_SK + (head >> 1) * 64; vcol = C_SV + (head >> 1) * 64; ocol = 768 + head * 64; sink = p.in[I_SINK][l * 4 + head]; }

  bf16x8 bq[4];
#pragma unroll
  for (int s = 0; s < 4; ++s) bq[s] = *(const bf16x8*)(P + (size_t)qrow * DIN + qcol + 16 * s + 8 * hh);
  f32x16 oacc[2];
#pragma unroll
  for (int r = 0; r < 16; ++r) { oacc[0][r] = 0.f; oacc[1][r] = 0.f; }
  float m_run = -1e30f, l_run = 0.f;
  const int key = t >> 2, dq = t & 3;
  const int kswz = (key >> 1) & 7;
  float4 raw[8];
#define ATT_ISSUE(jj) do { const int j_ = (jj); \
    if (j_ < nloc) { \
      int krow_; \
      if (MODE == 0 || MODE == 1) krow_ = rowbaseP + j_ * 64 + key; \
      else if (MODE == 2) krow_ = rowbaseP + (rlo + j_) * 64 + key; \
      else krow_ = rowbaseP + clampi(lo + j_ * 64 + key, 0, 1023); \
      const bf16_t* kp_ = P + (size_t)krow_ * DIN + kcol + dq * 16; \
      const bf16_t* vp_ = P + (size_t)krow_ * DIN + vcol + dq * 16; \
      raw[0] = *(const float4*)kp_; raw[1] = *(const float4*)(kp_ + 8); raw[2] = *(const float4*)vp_; raw[3] = *(const float4*)(vp_ + 8); \
    } else { \
      const int ct_ = (j_ - nloc) * 64 + key; \
      const float* kp_ = cache + ((size_t)ct_ * cH + cHead) * 64 + dq * 16; \
      const float* vp_ = kp_ + (size_t)256 * cH * 64; \
      raw[0] = *(const float4*)kp_; raw[1] = *(const float4*)(kp_ + 4); raw[2] = *(const float4*)(kp_ + 8); raw[3] = *(const float4*)(kp_ + 12); \
      raw[4] = *(const float4*)vp_; raw[5] = *(const float4*)(vp_ + 4); raw[6] = *(const float4*)(vp_ + 8); raw[7] = *(const float4*)(vp_ + 12); \
    } } while (0)
  ATT_ISSUE(0);
  for (int j = 0; j < nt; ++j) {
    uint4 kr[2], vr[2];
    const bool isP = j < nloc;
    if (isP) {
      kr[0] = __builtin_bit_cast(uint4, raw[0]); kr[1] = __builtin_bit_cast(uint4, raw[1]);
      vr[0] = __builtin_bit_cast(uint4, raw[2]); vr[1] = __builtin_bit_cast(uint4, raw[3]);
    } else {
      kr[0].x = pk2(raw[0].x, raw[0].y); kr[0].y = pk2(raw[0].z, raw[0].w); kr[0].z = pk2(raw[1].x, raw[1].y); kr[0].w = pk2(raw[1].z, raw[1].w);
      kr[1].x = pk2(raw[2].x, raw[2].y); kr[1].y = pk2(raw[2].z, raw[2].w); kr[1].z = pk2(raw[3].x, raw[3].y); kr[1].w = pk2(raw[3].z, raw[3].w);
      vr[0].x = pk2(raw[4].x, raw[4].y); vr[0].y = pk2(raw[4].z, raw[4].w); vr[0].z = pk2(raw[5].x, raw[5].y); vr[0].w = pk2(raw[5].z, raw[5].w);
      vr[1].x = pk2(raw[6].x, raw[6].y); vr[1].y = pk2(raw[6].z, raw[6].w); vr[1].z = pk2(raw[7].x, raw[7].y); vr[1].w = pk2(raw[7].z, raw[7].w);
    }
    if (j + 1 < nt) ATT_ISSUE(j + 1);
    __syncthreads();
    *(uint4*)(sK + key * 128 + (((dq * 2 + 0) ^ kswz) << 4)) = kr[0];
    *(uint4*)(sK + key * 128 + (((dq * 2 + 1) ^ kswz) << 4)) = kr[1];
    {
      bf16_t* vt = (bf16_t*)sV;
      const unsigned vv[8] = {vr[0].x, vr[0].y, vr[0].z, vr[0].w, vr[1].x, vr[1].y, vr[1].z, vr[1].w};
#pragma unroll
      for (int e = 0; e < 8; ++e) {
        vt[(dq * 16 + 2 * e) * 68 + key] = (bf16_t)(vv[e] & 0xffffu);
        vt[(dq * 16 + 2 * e + 1) * 68 + key] = (bf16_t)(vv[e] >> 16);
      }
    }
    __syncthreads();
    f32x16 sacc[2];
#pragma unroll
    for (int r = 0; r < 16; ++r) { sacc[0][r] = 0.f; sacc[1][r] = 0.f; }
    const int qswz = (q >> 1) & 7;
#pragma unroll
    for (int s = 0; s < 4; ++s) {
      const int co = (((s * 2 + hh) ^ qswz) << 4);
      const bf16x8 a0 = *(const bf16x8*)(sK + q * 128 + co);
      const bf16x8 a1 = *(const bf16x8*)(sK + (32 + q) * 128 + co);
      sacc[0] = MFMA32(a0, bq[s], sacc[0]);
      sacc[1] = MFMA32(a1, bq[s], sacc[1]);
    }
    float mx = -1e30f;
#pragma unroll
    for (int sub = 0; sub < 2; ++sub)
#pragma unroll
      for (int r = 0; r < 16; ++r) {
        const int kidx = sub * 32 + (r & 3) + 8 * (r >> 2) + 4 * hh;
        float v = sacc[sub][r] * 0.125f;
        bool ok = true;
        if (MODE == 2 && isP) {
          const int kr_ = rlo + j, kc_ = kidx;
          ok = (kr_ >= rsq) && (kr_ < rsq + 8) && (kc_ >= wsq) && (kc_ < wsq + 16);
          const int bi = ok ? ((kr_ - qr + 7) * 31 + (kc_ - qc + 15)) : 0;
          v += sBias[bi];
        }
        if (MODE == 3 && isP) {
          const int kpos = lo + j * 64 + kidx, dlt = kpos - qpos;
          ok = (dlt <= 128) && (dlt >= -128) && (kpos >= 0) && (kpos < 1024);
        }
        v = ok ? v : -1e30f;
        sacc[sub][r] = v;
        mx = fmaxf(mx, v);
      }
    mx = fmaxf(mx, __shfl_xor(mx, 32));
    const float m_new = fmaxf(m_run, mx);
    const float alpha = __expf(m_run - m_new);
    float rsum = 0.f;
#pragma unroll
    for (int sub = 0; sub < 2; ++sub)
#pragma unroll
      for (int r = 0; r < 16; ++r) {
        const float v = sacc[sub][r];
        const float pv = (v > -1e29f) ? __expf(v - m_new) : 0.f;
        sacc[sub][r] = pv; rsum += pv;
      }
    rsum += __shfl_xor(rsum, 32);
    l_run = l_run * alpha + rsum; m_run = m_new;
#pragma unroll
    for (int r = 0; r < 16; ++r) { oacc[0][r] *= alpha; oacc[1][r] *= alpha; }
#pragma unroll
    for (int k4 = 0; k4 < 4; ++k4) {
      const int sub = k4 >> 1, s2 = k4 & 1;
      uint4 pbu;
      pbu.x = pk2(sacc[sub][8 * s2 + 0], sacc[sub][8 * s2 + 1]); pbu.y = pk2(sacc[sub][8 * s2 + 2], sacc[sub][8 * s2 + 3]);
      pbu.z = pk2(sacc[sub][8 * s2 + 4], sacc[sub][8 * s2 + 5]); pbu.w = pk2(sacc[sub][8 * s2 + 6], sacc[sub][8 * s2 + 7]);
      const bf16x8 pb = __builtin_bit_cast(bf16x8, pbu);
#pragma unroll
      for (int dt = 0; dt < 2; ++dt) {
        const char* vp = sV + (dt * 32 + q) * 136 + (16 * k4 + 4 * hh) * 2;
        const uint2 lo8 = *(const uint2*)vp, hi8 = *(const uint2*)(vp + 16);
        uint4 avu; avu.x = lo8.x; avu.y = lo8.y; avu.z = hi8.x; avu.w = hi8.y;
        oacc[dt] = MFMA32(__builtin_bit_cast(bf16x8, avu), pb, oacc[dt]);
      }
    }
  }
#undef ATT_ISSUE
  float scale;
  if (MODE == 1 || MODE == 3) {
    const float m_f = fmaxf(m_run, sink);
    const float e = __expf(m_run - m_f);
    scale = e / (l_run * e + __expf(sink - m_f));
  } else scale = 1.0f / l_run;
#pragma unroll
  for (int dt = 0; dt < 2; ++dt)
#pragma unroll
    for (int g4 = 0; g4 < 4; ++g4) {
      const int d = dt * 32 + 8 * g4 + 4 * hh;
      uint2 o; o.x = pk2(oacc[dt][4 * g4] * scale, oacc[dt][4 * g4 + 1] * scale); o.y = pk2(oacc[dt][4 * g4 + 2] * scale, oacc[dt][4 * g4 + 3] * scale);
      *(uint2*)(Y + (size_t)qrow * D + ocol + d) = o;
    }
  __syncthreads();
}

DEV void post_item(const Params& p, int l, int tile, char* lds) {
  const int t = tid(), r0 = tile * TOKT, c = t;
  float* sT = (float*)lds;
  float* sgo = sT + 128 * TOKT;
  const bf16_t* P = (const bf16_t*)(p.ws + OFF_P);
  bf16_t* Y = (bf16_t*)(p.ws + OFF_YMIX);
  const float* Y0 = (const float*)(p.ws + OFF_YDIR); const float* Y1 = Y0 + ARRF;
  const float* H0 = (const float*)(p.ws + OFF_HDIR); const float* H1 = H0 + ARRF;
  const bf16_t* BON = (const bf16_t*)(p.ws + OFF_BONUS);
  __syncthreads();
#pragma unroll
  for (int i = 0; i < TOKT / 2; ++i) {
    const int e = t + 256 * i, tk = e >> 7, j = e & 127;
    sT[j * TOKT + tk] = sigmoidf_(bf2f(P[(size_t)(r0 + tk) * DIN + C_GH + j]));
  }
  __syncthreads();
  {
    const float* g2p = p.in[I_G2] + (size_t)l * 128 * 256 + c;
    float ag[TOKT];
#pragma unroll
    for (int k = 0; k < TOKT; ++k) ag[k] = 0.f;
    float g2c[128];
#pragma unroll
    for (int j = 0; j < 128; ++j) g2c[j] = g2p[j * 256];
#pragma unroll
    for (int j = 0; j < 128; ++j) {
      const float gj = g2c[j];
#pragma unroll
      for (int k4 = 0; k4 < TOKT / 4; ++k4) {
        const float4 s4 = *(const float4*)(sT + j * TOKT + k4 * 4);
        ag[k4 * 4 + 0] += s4.x * gj; ag[k4 * 4 + 1] += s4.y * gj; ag[k4 * 4 + 2] += s4.z * gj; ag[k4 * 4 + 3] += s4.w * gj;
      }
    }
#pragma unroll
    for (int k = 0; k < TOKT; ++k) sgo[k * 256 + c] = ag[k];
  }
  const float lnw = p.in[I_LNW][l * 256 + c], lnb = p.in[I_LNB][l * 256 + c], hgn = p.in[I_HGN][l * 256 + c];
  for (int tb = 0; tb < TOKT; tb += 5) {
    float y[5], o[5], bn[5], gv[5], hg[5];
#pragma unroll
    for (int u = 0; u < 5; ++u) {
      const int row = r0 + tb + u;
      const size_t idx = (size_t)row * 256 + c;
      y[u] = Y0[idx] + Y1[idx]; o[u] = H0[idx] + H1[idx]; bn[u] = bf2f(BON[idx]);
      gv[u] = sgo[(tb + u) * 256 + c]; hg[u] = bf2f(P[(size_t)row * DIN + C_HG + c]);
    }
#pragma unroll
    for (int u = 0; u < 5; ++u) {
      const int row = r0 + tb + u;
      const float mu = wave_sum(y[u]) * (1.0f / 64.0f);
      const float dy = y[u] - mu;
      const float var = wave_sum(dy * dy) * (1.0f / 64.0f);
      const float yn = dy * rsqrtf(var + 64e-5f) * lnw + lnb + bn[u];
      Y[(size_t)row * D + c] = f2bf(yn * gv[u]);
      const float ms = wave_sum(o[u] * o[u]) * (1.0f / 64.0f);
      Y[(size_t)row * D + 512 + c] = f2bf(o[u] * rsqrtf(ms + 1e-6f) * hgn * sigmoidf_(hg[u]));
    }
  }
  __syncthreads();
}

constexpr int OFF_CTR_WORD = 3600;
DEV void mixer_phase(const Params& p, int l, char* lds0, volatile LAS unsigned* st, bool rerun) {
  const int hf = half_id(); char* lds = lds0 + hf * 65536;
  const int npairs = (256 + 512 + 512) / 2;
  unsigned* ctr = (unsigned*)(p.ws + OFF_BAR) + OFF_CTR_WORD + 64 * l + (rerun ? 32 : 0);
  for (;;) {
    if (threadIdx.x == 0) st[4] = __hip_atomic_fetch_add(ctr, 1u, __ATOMIC_RELAXED, __HIP_MEMORY_SCOPE_AGENT);
    __syncthreads();
    const int pair = (int)st[4];
    __syncthreads();
    if (pair >= npairs) break;
    const int it = pair * 2 + hf;
    const bool is_scan = it < 128 || (it >= 256 && it < 768);
    if (rerun && PROBE_SUB == 1 && !is_scan) continue;
    if (rerun && PROBE_SUB == 2 && is_scan) continue;
    if (rerun && PROBE_SUB == 3 && !(it < 128)) continue;
    if (rerun && PROBE_SUB == 4 && !(it >= 256 && it < 768)) continue;
    if (it < 128) {
      const int idx = it >> 1; const int seq = 32 + (idx >> 5), rem = idx & 31;
      if ((it & 1) == 0) rwkv_scan16(p, l, seq, rem >> 3, (rem >> 2) & 1, rem & 3, lds);
      else hgrn_scan16(p, l, seq, rem >> 3, (rem >> 2) & 1, rem & 3, lds);
    } else if (it < 192) attn_item<3>(p, l, it - 128, lds);
    else if (it < 256) attn_item<2>(p, l, it - 192, lds);
    else if (it < 768) {
      const int idx = (it - 256) & 255; const int seq = idx >> 3, rem = idx & 7;
      if (it < 512) rwkv_scan<2>(p, l, seq, rem >> 1, rem & 1, 0, lds);
      else hgrn_scan<2>(p, l, seq, rem >> 1, rem & 1, 0, lds);
    } else if (it < 1024) attn_item<0>(p, l, it - 768, lds);
    else attn_item<1>(p, l, it - 1024, lds);
  }
}

DEV void run_phase(const Params& p, int ph, char* lds, bool rerun, volatile LAS unsigned* st) {
  if (ph == 0) { phase0(p, lds); return; }
  if (ph == 1) { row_phase(p, 0, 0); return; }
  const int l = (ph - 2) / 9, s = (ph - 2) % 9;
  const bf16_t* H = (const bf16_t*)(p.ws + OFF_H);
  const int hf = half_id(); char* ldsh = lds + hf * 65536;
  switch (s) {
    case 0: gemm_run<0>(p, l, H, (const bf16_t*)(p.ws + OFF_WIN) + (size_t)l * DINP * D, D, DINP, lds); break;
    case 1:
      for (int it = blockIdx.x * 2 + hf; it < 512 + 32; it += gridDim.x * 2) { if (it < 512) prep_item(p, l, it, ldsh); else if (!rerun) rope_item(p, it - 512); }
      break;
    case 2: mixer_phase(p, l, lds, st, rerun); break;
    case 3: for (int it = blockIdx.x * 2 + hf; it < 512; it += gridDim.x * 2) post_item(p, l, it, ldsh); break;
    case 4: gemm_run<1>(p, l, (const bf16_t*)(p.ws + OFF_YMIX), (const bf16_t*)(p.ws + OFF_WOUT) + (size_t)l * D * D, D, D, lds); break;
    case 5: row_phase(p, 1, l); break;
    case 6: gemm_run<2>(p, l, H, (const bf16_t*)(p.ws + OFF_W1) + (size_t)l * FF * D, D, FF, lds); break;
    case 7: gemm_run<1>(p, l, (const bf16_t*)(p.ws + OFF_HID), (const bf16_t*)(p.ws + OFF_W2) + (size_t)l * D * FF, FF, D, lds); break;
    case 8: row_phase(p, 2, l); break;
  }
}

#define XB_TMO      128
#define XB_XCNT(j)  (256  + 64 * (j))
#define XB_XSUB(j)  (1280 + 64 * (j))
#define XB_XGEN(j)  (2304 + 64 * (j))
#define XB_TOP      3328
#define XB_TOPGEN   3392
#define XCD_BAR_WORDS 3456
#define XB_SPIN_CAP (1u << 18)
DEV unsigned xb_ld(unsigned* p) { return __hip_atomic_load(p, __ATOMIC_RELAXED, __HIP_MEMORY_SCOPE_AGENT); }
DEV unsigned xb_add(unsigned* p, unsigned v) { return __hip_atomic_fetch_add(p, v, __ATOMIC_RELAXED, __HIP_MEMORY_SCOPE_AGENT); }
DEV unsigned xb_xcc_id() { return (unsigned)__builtin_amdgcn_s_getreg((3 << 11) | 20) & 0xFu; }
#define XB_SPIN(cond, bar) do { unsigned _sp = 0; while (cond) { __builtin_amdgcn_s_sleep(1); \
    if ((++_sp & 255u) == 0u) { if (xb_ld(&(bar)[XB_TMO])) break; if (_sp > XB_SPIN_CAP) { atomicAdd(&(bar)[XB_TMO], 1u); break; } } } } while (0)
struct XcdBarrier { unsigned* bar; unsigned x; volatile LAS unsigned* st; };
DEV XcdBarrier xcd_barrier_post(unsigned* bar, volatile LAS unsigned* st) {
  XcdBarrier b; b.bar = bar; b.x = xb_xcc_id(); b.st = st;
  if (threadIdx.x == 0) (void)xb_add(&bar[XB_XCNT(b.x)], 1u);
  return b;
}
DEV void xcd_barrier_complete(unsigned* bar, unsigned x, unsigned& nloc, unsigned& nx) {
  const unsigned G = gridDim.x * gridDim.y * gridDim.z;
  unsigned sum, cnt, mine, sp = 0u;
  for (;;) {
    sum = 0u; cnt = 0u; mine = 0u;
#pragma unroll
    for (unsigned j = 0; j < 16; ++j) { const unsigned c = xb_ld(&bar[XB_XCNT(j)]); sum += c; cnt += (c > 0u) ? 1u : 0u; mine = (j == x) ? c : mine; }
    if (sum == G) break;
    __builtin_amdgcn_s_sleep(1);
    if ((++sp & 255u) == 0u) { if (xb_ld(&bar[XB_TMO])) break; if (sp > XB_SPIN_CAP) { atomicAdd(&bar[XB_TMO], 1u); break; } }
  }
  nloc = mine > 0u ? mine : 1u; nx = cnt > 0u ? cnt : 1u;
}
DEV void xcd_barrier(const XcdBarrier& b) {
  asm volatile("s_waitcnt vmcnt(0)" ::: "memory");
  __syncthreads();
  if (threadIdx.x == 0) {
    unsigned* bar = b.bar;
    { size_t zb_; asm volatile("s_mov_b64 %0, 0" : "=s"(zb_)); bar += zb_; }
    __builtin_amdgcn_s_waitcnt(0);
    unsigned nloc = b.st[0], nx = b.st[1];
    if (nloc == 0u) { xcd_barrier_complete(bar, b.x, nloc, nx); b.st[0] = nloc; b.st[1] = nx; }
    const unsigned old = xb_add(&bar[XB_XSUB(b.x)], 1u);
    const unsigned gen = old / nloc;
    if (old + 1u == (gen + 1u) * nloc) {
      __builtin_amdgcn_fence(__ATOMIC_RELEASE, "agent");
      asm volatile("s_waitcnt vmcnt(0)" ::: "memory");
      const unsigned og = xb_add(&bar[XB_TOP], 1u);
      const unsigned tg = og / nx;
      if (og + 1u == (tg + 1u) * nx) xb_add(&bar[XB_TOPGEN], 1u);
      else XB_SPIN(xb_ld(&bar[XB_TOPGEN]) == tg, bar);
      __builtin_amdgcn_fence(__ATOMIC_ACQUIRE, "agent");
      xb_add(&bar[XB_XGEN(b.x)], 1u);
      asm volatile("s_waitcnt vmcnt(0)" ::: "memory");
    } else {
      XB_SPIN(xb_ld(&bar[XB_XGEN(b.x)]) == gen, bar);
      __builtin_amdgcn_fence(__ATOMIC_ACQUIRE, "agent");
      asm volatile("s_waitcnt vmcnt(0)" ::: "memory");
    }
  }
  __syncthreads();
}

DEV int phase_kind(int ph) {
  if (ph == 0) return 0;
  if (ph == 1) return 1;
  const int s = (ph - 2) % 9;
  return s == 0 ? 2 : s == 1 ? 3 : s == 2 ? 4 : s == 3 ? 5 : s == 4 ? 6 : s == 5 ? 1 : s == 6 ? 7 : s == 7 ? 8 : 1;
}

constexpr int LDS_BYTES = 131072 + 64;

__global__ void __launch_bounds__(512, 2) mega(Params p, int ph_lo, int ph_hi) {
  extern __shared__ __attribute__((aligned(16))) unsigned char smem[];
  char* lds = (char*)smem;
  volatile LAS unsigned* st = (volatile LAS unsigned*)((LAS unsigned char*)smem + 131072);
  if (threadIdx.x == 0) { st[0] = 0u; st[1] = 0u; }
  __syncthreads();
  XcdBarrier xb = xcd_barrier_post((unsigned*)(p.ws + OFF_BAR), st);
  if (ph_hi < 0) cg::this_grid().sync();
  char* const ws0 = p.ws; float* const out0 = p.out;
  for (int ph = ph_lo; ph < ph_hi; ++ph) {
    { size_t z0_; asm volatile("s_mov_b64 %0, 0" : "=s"(z0_)); p.ws = ws0 + z0_; p.out = out0 + z0_; }
    run_phase(p, ph, lds, false, st);
    if (PROBE_KIND >= 0 && (PROBE_KIND == 9 || phase_kind(ph) == PROBE_KIND)) {
      xcd_barrier(xb);
      if (PROBE_KIND != 9) run_phase(p, ph, lds, true, st);
    }
    if (ph + 1 < ph_hi) xcd_barrier(xb);
  }
}

extern "C" void kernel_launch(void* const* d_in, const int* in_sizes, int n_in, void* d_out, int out_size, void* d_ws, size_t ws_size,
                              hipStream_t stream) {
  static int grid_blocks = 0;
  if (!grid_blocks) {
    int dev = 0, cus = 0, per_cu = 0;
    (void)hipGetDevice(&dev);
    (void)hipDeviceGetAttribute(&cus, hipDeviceAttributeMultiprocessorCount, dev);
    if (hipFuncSetAttribute((const void*)mega, hipFuncAttributeMaxDynamicSharedMemorySize, LDS_BYTES) != hipSuccess) fprintf(stderr, "hipFuncSetAttribute failed\n");
    (void)hipOccupancyMaxActiveBlocksPerMultiprocessor(&per_cu, mega, 512, LDS_BYTES);
    if (per_cu < 1) fprintf(stderr, "occupancy query reports %d blocks per CU\n", per_cu);
    (void)hipGetLastError();
    grid_blocks = cus;
  }
  if (ws_size < WS_TOTAL) { fprintf(stderr, "workspace too small: %zu < %zu\n", ws_size, (size_t)WS_TOTAL); return; }
  Params p{};
  for (int i = 0; i < 31; ++i) p.in[i] = (const float*)d_in[i];
  p.out = (float*)d_out;
  p.ws = (char*)d_ws;
  (void)hipMemsetAsync((char*)d_ws + OFF_BAR, 0, 16384, stream);
  int lo = 0, hi = NPH;
  void* args[] = {&p, &lo, &hi};
  hipError_t e = hipLaunchCooperativeKernel((void*)mega, dim3(grid_blocks), dim3(512), args, LDS_BYTES, stream);
  if (e != hipSuccess) fprintf(stderr, "cooperative launch failed: %s (grid %d)\n", hipGetErrorString(e), grid_blocks);
}
```

```cpp
#include <hip/hip_runtime.h>
#include <hip/hip_cooperative_groups.h>
#include <cstdio>
#include <cstdint>
namespace cg = cooperative_groups;

#ifndef ONE_LAUNCH
#define ONE_LAUNCH 1
#endif
#define PROBE_KIND -1
#define PROBE_SUB 0

#define DEV __device__ __forceinline__
#define LAS __attribute__((address_space(3)))
typedef unsigned short bf16_t;
typedef short bf16x8 __attribute__((ext_vector_type(8)));
typedef float f32x16 __attribute__((ext_vector_type(16)));
typedef __bf16 bf2_t __attribute__((ext_vector_type(2)));
typedef float f2_t __attribute__((ext_vector_type(2)));

constexpr int D = 1024, DIN = 3712, FF = 4096, NCTX = 8192, MT = 10240;
constexpr int NPH = 38;
constexpr int DINP = 3840;
constexpr int C_R = 0, C_K = 256, C_V = 512, C_GH = 768, C_WHF = 896, C_WHB = 1024;
constexpr int C_NQ = 1152, C_NK = 1408, C_NV = 1664;
constexpr int C_HQ = 1920, C_HI = 2176, C_HG = 2432, C_HFF = 2688, C_HFB = 2944;
constexpr int C_SQ = 3200, C_SK = 3456, C_SV = 3584;
constexpr size_t O_NAT = 10485760, O_SWA = 27262976, O_RW = 35651584, O_HG = 39845888;
constexpr size_t ARRF = (size_t)MT * 256;
constexpr size_t ARR = ARRF * 4;
constexpr size_t OFF_WIN = 0;
constexpr size_t OFF_WOUT = OFF_WIN + (size_t)4 * DINP * D * 2;
constexpr size_t OFF_W1 = OFF_WOUT + (size_t)4 * D * D * 2;
constexpr size_t OFF_W2 = OFF_W1 + (size_t)4 * FF * D * 2;
constexpr size_t OFF_MOD = OFF_W2 + (size_t)4 * FF * D * 2;
constexpr size_t OFF_HGLB = OFF_MOD + (size_t)4 * 3 * 6144 * 4;
constexpr size_t OFF_P = OFF_HGLB + 8192;
constexpr size_t OFF_R1 = OFF_P + (size_t)MT * DIN * 2;
constexpr size_t OFF_H = OFF_R1;
constexpr size_t OFF_HID = OFF_H + (size_t)MT * D * 2;
constexpr size_t OFF_U = OFF_HID + (size_t)MT * FF * 2;
constexpr size_t OFF_PREP = OFF_R1;
constexpr size_t OFF_YDIR = OFF_PREP + 12 * ARR;
constexpr size_t OFF_BONUS = OFF_R1 + 14 * ARR;
constexpr size_t OFF_HDIR = OFF_BONUS + ARR / 2;
constexpr size_t OFF_YMIX = OFF_HDIR + 2 * ARR;
constexpr size_t OFF_X16 = OFF_YMIX + (size_t)MT * D * 2;
constexpr size_t OFF_BAR = OFF_X16 + (size_t)MT * D * 2;
constexpr size_t OFF_W2T = OFF_BAR + 16384;
constexpr size_t OFF_A2T = OFF_W2T + (size_t)4 * 2 * 256 * 64 * 2;
constexpr size_t OFF_G2T = OFF_A2T + (size_t)4 * 2 * 256 * 64 * 2;
constexpr size_t WS_TOTAL = OFF_G2T + (size_t)4 * 256 * 128 * 2;
static_assert(OFF_U + (size_t)MT * D * 4 == OFF_BONUS, "R1 layout");

struct Params {
  const float* in[31];
  float* out;
  char* ws;
};
enum { I_XP = 0, I_XS, I_CNAT, I_CSWA, I_SRW, I_SHG, I_C, I_CCTX, I_NORMG, I_MODW, I_MODB, I_WIN, I_WOUT, I_MURKV, I_MULORA,
       I_W0, I_W2, I_A0, I_A2, I_G2, I_KK, I_KA, I_RK, I_LNW, I_LNB, I_RPB, I_HGLB, I_HGN, I_SINK, I_FW1, I_FW2 };

DEV bf16_t f2bf(float f) { unsigned u = __float_as_uint(f); u += 0x7fffu + ((u >> 16) & 1u); return (bf16_t)(u >> 16); }
DEV float bf2f(bf16_t h) { return __uint_as_float(((unsigned)h) << 16); }
DEV unsigned pk2(float a, float b) { f2_t v = {a, b}; bf2_t r = __builtin_convertvector(v, bf2_t); return __builtin_bit_cast(unsigned, r); }
DEV float4 bf4(uint2 u) { return make_float4(__uint_as_float(u.x << 16), __uint_as_float(u.x & 0xffff0000u), __uint_as_float(u.y << 16), __uint_as_float(u.y & 0xffff0000u)); }
DEV float bflo(unsigned u) { return __uint_as_float(u << 16); }
DEV float bfhi(unsigned u) { return __uint_as_float(u & 0xffff0000u); }
DEV float rcpf_(float x) { return __builtin_amdgcn_rcpf(x); }
DEV float sigmoidf_(float x) { return rcpf_(1.0f + __expf(-x)); }
DEV float tanhf_(float x) { return 1.0f - 2.0f * rcpf_(1.0f + __expf(2.0f * x)); }
template <int CTRL> DEV float dppf(float x) { return __int_as_float(__builtin_amdgcn_update_dpp(0, __float_as_int(x), CTRL, 0xF, 0xF, false)); }
DEV float row16_sum(float x) { x += dppf<0xB1>(x); x += dppf<0x4E>(x); x += dppf<0x141>(x); x += dppf<0x140>(x); return x; }
DEV float wave_sum(float x) { x = row16_sum(x); x += __shfl_xor(x, 16); x += __shfl_xor(x, 32); return x; }
DEV int clampi(int v, int lo, int hi) { return v < lo ? lo : (v > hi ? hi : v); }
#define MFMA32(a, b, c) __builtin_amdgcn_mfma_f32_32x32x16_bf16((a), (b), (c), 0, 0, 0)

DEV int tid() { int z; asm volatile("v_mov_b32 %0, 0" : "=v"(z)); return (int)(threadIdx.x & 255u) + z; }
DEV int half_id() { return __builtin_amdgcn_readfirstlane((int)(threadIdx.x >> 8)); }
DEV void transpose_item(const float* W, bf16_t* WT, int K, int N, int kt, int nt, char* lds) {
  bf16_t* s = (bf16_t*)lds;
  const int t = tid();
#pragma unroll
  for (int i = 0; i < 4; ++i) {
    const int k = (t >> 4) + 16 * i, n4 = (t & 15) * 4;
    const float4 v = *(const float4*)(W + (size_t)(kt * 64 + k) * N + nt * 64 + n4);
    s[(n4 + 0) * 72 + k] = f2bf(v.x); s[(n4 + 1) * 72 + k] = f2bf(v.y);
    s[(n4 + 2) * 72 + k] = f2bf(v.z); s[(n4 + 3) * 72 + k] = f2bf(v.w);
  }
  __syncthreads();
#pragma unroll
  for (int i = 0; i < 2; ++i) {
    const int n = (t >> 3) + 32 * i, kc = t & 7;
    const uint4 v = *(const uint4*)(s + n * 72 + kc * 8);
    *(uint4*)(WT + (size_t)(nt * 64 + n) * K + kt * 64 + kc * 8) = v;
  }
  __syncthreads();
}

DEV void mod_item(const Params& p, int l, int jb, char* lds) {
  float* sc = (float*)lds;
  float* red = (float*)(lds + 12288);
  const int t = tid();
  for (int i = t; i < 3072; i += 256) {
    const int c = i >> 10, k = i & 1023;
    const float x = (c == 0) ? p.in[I_CCTX][k] : p.in[I_C][(c - 1) * 1024 + k];
    sc[i] = x * rcpf_(1.0f + __expf(-x));
  }
  __syncthreads();
  const int c4 = t & 15, ks = t >> 4;
  const float* wp = p.in[I_MODW] + ((size_t)l * 1024 + ks * 64) * 6144 + jb * 64 + c4 * 4;
  float a00 = 0, a01 = 0, a02 = 0, a03 = 0, a10 = 0, a11 = 0, a12 = 0, a13 = 0, a20 = 0, a21 = 0, a22 = 0, a23 = 0;
#pragma unroll 16
  for (int ii = 0; ii < 64; ++ii) {
    const float4 w = *(const float4*)(wp + (size_t)ii * 6144);
    const int k = ks * 64 + ii;
    const float s0 = sc[k], s1 = sc[1024 + k], s2 = sc[2048 + k];
    a00 += s0 * w.x; a01 += s0 * w.y; a02 += s0 * w.z; a03 += s0 * w.w;
    a10 += s1 * w.x; a11 += s1 * w.y; a12 += s1 * w.z; a13 += s1 * w.w;
    a20 += s2 * w.x; a21 += s2 * w.y; a22 += s2 * w.z; a23 += s2 * w.w;
  }
  float* r0 = red + (ks * 3 + 0) * 64 + c4 * 4; r0[0] = a00; r0[1] = a01; r0[2] = a02; r0[3] = a03;
  float* r1 = red + (ks * 3 + 1) * 64 + c4 * 4; r1[0] = a10; r1[1] = a11; r1[2] = a12; r1[3] = a13;
  float* r2 = red + (ks * 3 + 2) * 64 + c4 * 4; r2[0] = a20; r2[1] = a21; r2[2] = a22; r2[3] = a23;
  __syncthreads();
  if (t < 192) {
    const int c = t >> 6, col = t & 63;
    float v = p.in[I_MODB][l * 6144 + jb * 64 + col];
#pragma unroll
    for (int k2 = 0; k2 < 16; ++k2) v += red[(k2 * 3 + c) * 64 + col];
    ((float*)(p.ws + OFF_MOD))[(size_t)(l * 3 + c) * 6144 + jb * 64 + col] = v;
  }
  __syncthreads();
}

DEV void hglb_item(const Params& p) {
  const int c = tid();
  float* HGLB = (float*)(p.ws + OFF_HGLB);
  for (int dir = 0; dir < 2; ++dir) {
    float x[4], mx = -1e30f;
    for (int l = 0; l < 4; ++l) { x[l] = p.in[I_HGLB][(dir * 4 + l) * 256 + c]; mx = fmaxf(mx, x[l]); }
    float s = 0;
    for (int l = 0; l < 4; ++l) { x[l] = __expf(x[l] - mx); s += x[l]; }
    float cum = 0; const float s0 = x[0] / s;
    for (int l = 0; l < 4; ++l) { cum += x[l] / s; HGLB[(l * 2 + dir) * 256 + c] = cum - s0; }
  }
}

constexpr int NT_LAYER = 928 + 256 + 1024 + 1024;
struct TileDesc { const float* W; bf16_t* WT; int K, N, kt, nt; };
DEV TileDesc layer_tile_desc(const Params& p, int l, int j) {
  TileDesc d;
  if (j < 928) { d.W = p.in[I_WIN] + (size_t)l * D * DIN; d.WT = (bf16_t*)(p.ws + OFF_WIN) + (size_t)l * DINP * D; d.K = D; d.N = DIN; d.kt = j / 58; d.nt = j % 58; return d; }
  j -= 928;
  if (j < 256) { d.W = p.in[I_WOUT] + (size_t)l * D * D; d.WT = (bf16_t*)(p.ws + OFF_WOUT) + (size_t)l * D * D; d.K = D; d.N = D; d.kt = j / 16; d.nt = j % 16; return d; }
  j -= 256;
  if (j < 1024) { d.W = p.in[I_FW1] + (size_t)l * D * FF; d.WT = (bf16_t*)(p.ws + OFF_W1) + (size_t)l * FF * D; d.K = D; d.N = FF; d.kt = j / 64; d.nt = j % 64; return d; }
  j -= 1024;
  d.W = p.in[I_FW2] + (size_t)l * FF * D; d.WT = (bf16_t*)(p.ws + OFF_W2) + (size_t)l * D * FF; d.K = FF; d.N = D; d.kt = j / 16; d.nt = j % 16; return d;
}
DEV void tile_load(const TileDesc& d, float4 (&v)[4]) {
  const int t = tid();
#pragma unroll
  for (int i = 0; i < 4; ++i) v[i] = *(const float4*)(d.W + (size_t)(d.kt * 64 + (t >> 4) + 16 * i) * d.N + d.nt * 64 + (t & 15) * 4);
}
DEV void tile_store(const TileDesc& d, const float4 (&v)[4], char* lds) {
  bf16_t* s = (bf16_t*)lds;
  const int t = tid();
#pragma unroll
  for (int i = 0; i < 4; ++i) {
    const int k = (t >> 4) + 16 * i, n4 = (t & 15) * 4;
    s[(n4 + 0) * 72 + k] = f2bf(v[i].x); s[(n4 + 1) * 72 + k] = f2bf(v[i].y);
    s[(n4 + 2) * 72 + k] = f2bf(v[i].z); s[(n4 + 3) * 72 + k] = f2bf(v[i].w);
  }
  __syncthreads();
#pragma unroll
  for (int i = 0; i < 2; ++i) {
    const int n = (t >> 3) + 32 * i, kc = t & 7;
    const uint4 o = *(const uint4*)(s + n * 72 + kc * 8);
    *(uint4*)(d.WT + (size_t)(d.nt * 64 + n) * d.K + d.kt * 64 + kc * 8) = o;
  }
  __syncthreads();
}
DEV void layer_tiles(const Params& p, int l, int lo, int hi, int vb, int nvb, char* lds0) {
  const int hf = half_id(); char* lds = lds0 + hf * 65536;
  int it = lo + vb * 2 + hf;
  if (it >= hi) return;
  float4 vn[4];
  TileDesc dn = layer_tile_desc(p, l, it);
  tile_load(dn, vn);
  for (; it < hi; it += nvb * 2) {
    float4 vc[4] = {vn[0], vn[1], vn[2], vn[3]};
    const TileDesc dc = dn;
    if (it + nvb * 2 < hi) { dn = layer_tile_desc(p, l, it + nvb * 2); tile_load(dn, vn); }
    tile_store(dc, vc, lds);
  }
}

DEV void phase0(const Params& p, char* lds0) {
  const int hf = half_id(); char* lds = lds0 + hf * 65536;
  const int nitems = 386 + 4 + 20;
  for (int it = blockIdx.x * 2 + hf; it < nitems; it += gridDim.x * 2) {
    if (it < 384) { mod_item(p, it / 96, it % 96, lds); continue; }
    if (it == 384) { hglb_item(p); continue; }
    if (it == 385) continue;
    const int j = it - 386;
    if (j >= 4) {
      const int s = j - 4, n = tid();
      const float* src; bf16_t* dst; int KK;
      if (s < 8) { src = p.in[I_W2] + (size_t)s * 64 * 256; dst = (bf16_t*)(p.ws + OFF_W2T) + (size_t)s * 256 * 64; KK = 64; }
      else if (s < 16) { src = p.in[I_A2] + (size_t)(s - 8) * 64 * 256; dst = (bf16_t*)(p.ws + OFF_A2T) + (size_t)(s - 8) * 256 * 64; KK = 64; }
      else { src = p.in[I_G2] + (size_t)(s - 16) * 128 * 256; dst = (bf16_t*)(p.ws + OFF_G2T) + (size_t)(s - 16) * 256 * 128; KK = 128; }
      for (int k0 = 0; k0 < KK; k0 += 8) {
        float v[8];
#pragma unroll
        for (int e = 0; e < 8; ++e) v[e] = src[(size_t)(k0 + e) * 256 + n];
        uint4 o; o.x = pk2(v[0], v[1]); o.y = pk2(v[2], v[3]); o.z = pk2(v[4], v[5]); o.w = pk2(v[6], v[7]);
        *(uint4*)(dst + (size_t)n * KK + k0) = o;
      }
      continue;
    }
    {
      uint4* z = (uint4*)((bf16_t*)(p.ws + OFF_WIN) + ((size_t)j * DINP + DIN) * D);
      const int t = tid();
      for (int i = t; i < 128 * D * 2 / 16; i += 256) z[i] = make_uint4(0u, 0u, 0u, 0u);
    }
  }
  const int vb = ((int)blockIdx.x + (int)gridDim.x - 195 % (int)gridDim.x) % (int)gridDim.x;
  layer_tiles(p, 0, 0, NT_LAYER, vb, (int)gridDim.x, lds0);
}

constexpr int RPW = 5;
DEV void row_phase(const Params& p, int mode, int l) {
  const int lane = tid() & 63;
  const int nw = gridDim.x * 8;
  const float* MOD = (const float*)(p.ws + OFF_MOD);
  const float* NG = p.in[I_NORMG];
  const bf16_t* U = (const bf16_t*)(p.ws + OFF_U);
  bf16_t* H = (bf16_t*)(p.ws + OFF_H);
  bf16_t* X16 = (bf16_t*)(p.ws + OFF_X16);
  const bool has_next = !(mode == 2 && l == 3);
  const int ln = (mode == 0) ? 0 : (mode == 1 ? l : l + 1);
  const int gi = (mode == 1) ? 2 : 0, shi = (mode == 1) ? 3 : 0, sci = (mode == 1) ? 4 : 1;
  const float* ga = NG + (size_t)(l * 4 + (mode == 1 ? 1 : 3)) * 1024;
  const float* gb = NG + (size_t)((has_next ? ln : 0) * 4 + gi) * 1024;
  for (int rowa = blockIdx.x * 8 + half_id() * 4 + (tid() >> 6); rowa < MT; rowa += RPW * nw) {
    float4 x[RPW][4]; uint2 ub[RPW][4];
    int rows[RPW]; bool ok[RPW];
#pragma unroll
    for (int q = 0; q < RPW; ++q) {
      rows[q] = rowa + q * nw; ok[q] = rows[q] < MT;
      const int row = ok[q] ? rows[q] : rowa;
      if (mode == 0) {
        const float* src = row < NCTX ? p.in[I_XP] + (size_t)row * D : p.in[I_XS] + (size_t)(row - NCTX) * D;
#pragma unroll
        for (int i = 0; i < 4; ++i) x[q][i] = *(const float4*)(src + i * 256 + lane * 4);
      } else {
#pragma unroll
        for (int i = 0; i < 4; ++i) {
          const uint2 xb = *(const uint2*)(X16 + (size_t)row * D + i * 256 + lane * 4);
          x[q][i] = make_float4(bflo(xb.x), bfhi(xb.x), bflo(xb.y), bfhi(xb.y));
          ub[q][i] = *(const uint2*)(U + (size_t)row * D + i * 256 + lane * 4);
        }
      }
    }
#pragma unroll
    for (int q = 0; q < RPW; ++q) {
      const int row = ok[q] ? rows[q] : rowa;
      const int cond = row < NCTX ? 0 : 1 + ((row - NCTX) >> 10);
      if (mode != 0) {
        float4 u[4];
        float ss = 0;
#pragma unroll
        for (int i = 0; i < 4; ++i) {
          u[i] = make_float4(bflo(ub[q][i].x), bfhi(ub[q][i].x), bflo(ub[q][i].y), bfhi(ub[q][i].y));
          ss += u[i].x * u[i].x + u[i].y * u[i].y + u[i].z * u[i].z + u[i].w * u[i].w;
        }
        ss = wave_sum(ss);
        const float r = rsqrtf(ss * (1.0f / 1024.0f) + 1e-6f);
        const float* gate = MOD + (size_t)(l * 3 + cond) * 6144 + (mode == 1 ? 2 : 5) * 1024;
#pragma unroll
        for (int i = 0; i < 4; ++i) {
          const float4 g4 = *(const float4*)(gate + i * 256 + lane * 4);
          const float4 a4 = *(const float4*)(ga + i * 256 + lane * 4);
          x[q][i].x += g4.x * (u[i].x * r * a4.x); x[q][i].y += g4.y * (u[i].y * r * a4.y);
          x[q][i].z += g4.z * (u[i].z * r * a4.z); x[q][i].w += g4.w * (u[i].w * r * a4.w);
        }
      }
      if (ok[q]) {
        if (has_next) {
#pragma unroll
          for (int i = 0; i < 4; ++i) { uint2 o; o.x = pk2(x[q][i].x, x[q][i].y); o.y = pk2(x[q][i].z, x[q][i].w); *(uint2*)(X16 + (size_t)row * D + i * 256 + lane * 4) = o; }
        } else {
#pragma unroll
          for (int i = 0; i < 4; ++i) *(float4*)(p.out + (size_t)row * D + i * 256 + lane * 4) = x[q][i];
        }
      }
      if (has_next) {
        float ss = 0;
#pragma unroll
        for (int i = 0; i < 4; ++i) ss += x[q][i].x * x[q][i].x + x[q][i].y * x[q][i].y + x[q][i].z * x[q][i].z + x[q][i].w * x[q][i].w;
        ss = wave_sum(ss);
        const float r2 = rsqrtf(ss * (1.0f / 1024.0f) + 1e-6f);
        const float* sh = MOD + (size_t)(ln * 3 + cond) * 6144 + shi * 1024;
        const float* sc = MOD + (size_t)(ln * 3 + cond) * 6144 + sci * 1024;
        if (ok[q]) {
#pragma unroll
          for (int i = 0; i < 4; ++i) {
            const float4 g4 = *(const float4*)(gb + i * 256 + lane * 4);
            const float4 s4 = *(const float4*)(sc + i * 256 + lane * 4);
            const float4 h4 = *(const float4*)(sh + i * 256 + lane * 4);
            const float h0 = x[q][i].x * r2 * g4.x * (1.0f + s4.x) + h4.x;
            const float h1 = x[q][i].y * r2 * g4.y * (1.0f + s4.y) + h4.y;
            const float h2 = x[q][i].z * r2 * g4.z * (1.0f + s4.z) + h4.z;
            const float h3 = x[q][i].w * r2 * g4.w * (1.0f + s4.w) + h4.w;
            uint2 o; o.x = pk2(h0, h1); o.y = pk2(h2, h3);
            *(uint2*)(H + (size_t)row * D + i * 256 + lane * 4) = o;
          }
        }
      }
    }
  }
}

namespace pg8 {
#define PG8_LAS __attribute__((address_space(3)))
typedef unsigned short bf16_t;
typedef short bf16x8 __attribute__((ext_vector_type(8)));
typedef float f32x4 __attribute__((ext_vector_type(4)));
typedef unsigned u32x4 __attribute__((ext_vector_type(4)));
constexpr int BM = 256, BK = 64, HALF = 128, HTB = HALF * BK * 2  , STAGE_BYTES = 8 * HTB, NXCD = 8, WGM = 8;

__host__ __device__ __forceinline__ int lds_byte(int r, int c) { const int st = (r >> 4) * 2 + (c >> 5), rr = r & 15, cc = c & 31, ob = rr * 64 + cc * 2; return st * 1024 + (ob ^ (((ob >> 9) & 1) << 5)); }
__host__ __device__ __forceinline__ void stage_rc(int b, int& R, int& C) { const int st = b / 1024, sb = b % 1024, swz = sb ^ (((sb >> 9) & 1) << 5); R = (st >> 1) * 16 + swz / 64; C = (st & 1) * 32 + (swz % 64) / 2; }
__host__ __device__ __forceinline__ int perm32(int rho) { const int n = rho >> 4, i = rho & 15; return 8 * (i >> 2) + 4 * n + (i & 3); }

struct Unit { int pm, pn; };
struct Gemm { const bf16_t* A; const bf16_t* Bt; int M, N, K; };

struct StaticOrder {
    int nM, nN, nwg, G, c;
    __host__ __device__ void init(int M, int N, int G_, int c_) { nM = M / BM; nN = N / BM; nwg = nM * nN; G = G_; c = c_; }
    __host__ __device__ bool next(int i, Unit& u) const {
        const long L = (long)i * G + c; if (L >= nwg) return false;
        int wgid = (int)L; { const int q = nwg / NXCD, r = nwg % NXCD, xcd = wgid % NXCD, off = wgid / NXCD; wgid = (xcd < r ? xcd * (q + 1) : r * (q + 1) + (xcd - r) * q) + off; }
        const int nig = WGM * nN, gid = wgid / nig, fm = gid * WGM, gsz = (nM - fm) < WGM ? (nM - fm) : WGM;
        u.pm = fm + ((wgid % nig) % gsz); u.pn = (wgid % nig) / gsz; return true;
    }
    __device__ __forceinline__ void a_ready(const Unit&) const {}
    __device__ __forceinline__ void done(const Unit&) const {}
};

template <class Epi, class Sched, bool ALIGN_EPI = false, bool SP2 = false>
__device__ __forceinline__ void gemm_phase(PG8_LAS unsigned char* lds, const Gemm g, const Sched& S, const Epi& E) {
    int tid_z; asm volatile("v_mov_b32 %0, 0" : "=v"(tid_z)); const int tid = (int)threadIdx.x + tid_z, wid = __builtin_amdgcn_readfirstlane(tid >> 6), lane = tid & 63, wr = wid >> 2, wc = wid & 3, fr = lane & 15, fq = lane >> 4;
    const int K = g.K, nt = K / BK;
    unsigned voffA[2], voffB[2];
#pragma unroll
    for (int i = 0; i < 2; ++i) { int R, C; stage_rc(tid * 16 + i * 8192, R, C); const int Rb = Epi::PERM ? ((R & ~31) + perm32(R & 31)) : R;
        voffA[i] = (unsigned)(R * K + C) * 2u; voffB[i] = (unsigned)(Rb * K + C) * 2u; }
    const size_t kstep = (size_t)(BK * 2);
    const size_t hstep = (size_t)HALF * K * 2;
    const size_t tstep = 2 * hstep;
    const unsigned ldsw = (unsigned)wid * 1024u;
    const int aoff = lds_byte(wr * 64 + fr, fq * 8), boff = lds_byte(wc * 32 + fr, fq * 8);
#define PG8_SA(b, h) (((b) * 2 + (h)) * HTB)
#define PG8_SB(b, h) ((4 + (b) * 2 + (h)) * HTB)
#define PG8_STAGE(bufoff, gbase, voff) do { _Pragma("unroll") for (int _i = 0; _i < 2; ++_i) \
        __builtin_amdgcn_global_load_lds((const unsigned*)((const char*)(gbase) + (voff)[_i]), (PG8_LAS unsigned*)(lds + (bufoff) + ldsw + _i * 8192), 16, 0, 0); } while (0)
#define PG8_LDA(dst, b, h) do { _Pragma("unroll") for (int m = 0; m < 4; ++m) _Pragma("unroll") for (int k = 0; k < 2; ++k) dst[m][k] = *(const PG8_LAS bf16x8*)(lds + PG8_SA(b, h) + aoff + m * 2048 + k * 1024); } while (0)
#define PG8_LDB(dst, b, h) do { _Pragma("unroll") for (int n = 0; n < 2; ++n) _Pragma("unroll") for (int k = 0; k < 2; ++k) dst[n][k] = *(const PG8_LAS bf16x8*)(lds + PG8_SB(b, h) + boff + n * 2048 + k * 1024); } while (0)
#define PG8_MMA(ai, bj, At, Bt) do { __builtin_amdgcn_s_setprio(1); _Pragma("unroll") for (int m = 0; m < 4; ++m) _Pragma("unroll") for (int n = 0; n < 2; ++n) _Pragma("unroll") for (int k = 0; k < 2; ++k) \
        acc[ai][bj][m][n] = __builtin_amdgcn_mfma_f32_16x16x32_bf16(Bt[n][k], At[m][k], acc[ai][bj][m][n], 0, 0, 0); __builtin_amdgcn_s_setprio(0); } while (0)
#define PG8_WAIT_V(n) asm volatile("s_waitcnt vmcnt(" #n ")" ::: "memory")
#define PG8_WAIT_L(n) asm volatile("s_waitcnt lgkmcnt(" #n ")" ::: "memory")
#define PG8_BAR __builtin_amdgcn_s_barrier()
#define PG8_SCHED __builtin_amdgcn_sched_barrier(0)
    Unit cur, nxt; int ui = 0;
    if (!S.next(0, cur)) return;
    f32x4 acc[2][2][4][2];
#pragma unroll
    for (int a = 0; a < 2; ++a)
#pragma unroll
        for (int b = 0; b < 2; ++b)
#pragma unroll
            for (int m = 0; m < 4; ++m)
#pragma unroll
                for (int n = 0; n < 2; ++n) acc[a][b][m][n] = (f32x4){0.f, 0.f, 0.f, 0.f};
    bf16x8 At[4][2], B0[2][2], B1[2][2];
    const char* cA = (const char*)g.A + (size_t)cur.pm * tstep; const char* cB = (const char*)g.Bt + (size_t)cur.pn * tstep;
    S.a_ready(cur);
    if constexpr (SP2) {
        PG8_STAGE(PG8_SB(0, 0), cB, voffB); PG8_STAGE(PG8_SB(0, 1), cB + hstep, voffB); PG8_STAGE(PG8_SA(0, 0), cA, voffA); PG8_STAGE(PG8_SA(0, 1), cA + hstep, voffA);
        if (wr == 1) PG8_BAR;
        PG8_WAIT_V(2); PG8_BAR;
        PG8_STAGE(PG8_SB(1, 0), cB + kstep, voffB); PG8_STAGE(PG8_SA(1, 0), cA + kstep, voffA); PG8_STAGE(PG8_SB(1, 1), cB + hstep + kstep, voffB);
        PG8_WAIT_V(6); PG8_BAR;
    } else {
        PG8_STAGE(PG8_SB(0, 0), cB, voffB); PG8_STAGE(PG8_SA(0, 0), cA, voffA); PG8_STAGE(PG8_SB(0, 1), cB + hstep, voffB); PG8_STAGE(PG8_SA(0, 1), cA + hstep, voffA);
        if (wr == 1) PG8_BAR;
        PG8_WAIT_V(4); PG8_BAR;
        PG8_STAGE(PG8_SB(1, 0), cB + kstep, voffB); PG8_STAGE(PG8_SA(1, 0), cA + kstep, voffA); PG8_STAGE(PG8_SB(1, 1), cB + hstep + kstep, voffB);
        PG8_WAIT_V(6); PG8_BAR;
    }
    for (;;) {
        const bool has_next = S.next(ui + 1, nxt);
        const char* nA = has_next ? (const char*)g.A + (size_t)nxt.pm * tstep : cA; const char* nB = has_next ? (const char*)g.Bt + (size_t)nxt.pn * tstep : cB;
        for (int t = 0; t < nt; t += 2) {
            const bool last = (t == nt - 2);
            const char* a1 = cA + (size_t)(t + 1) * kstep;
            const char* a2 = last ? nA : cA + (size_t)(t + 2) * kstep; const char* b2 = last ? nB : cB + (size_t)(t + 2) * kstep;
            const char* a3 = a2 + kstep; const char* b3 = b2 + kstep;
            if (last && has_next) S.a_ready(nxt);
            if constexpr (SP2) {
            PG8_LDB(B0, 0, 0); PG8_LDB(B1, 0, 1); PG8_SCHED; PG8_LDA(At, 0, 0); PG8_STAGE(PG8_SA(1, 1), a1 + hstep, voffA);
            PG8_WAIT_V(8); PG8_WAIT_L(0); PG8_BAR; PG8_MMA(0, 0, At, B0); PG8_MMA(0, 1, At, B1); PG8_BAR; PG8_SCHED;
            PG8_LDA(At, 0, 1); PG8_STAGE(PG8_SB(0, 0), b2, voffB); PG8_STAGE(PG8_SB(0, 1), b2 + hstep, voffB); PG8_STAGE(PG8_SA(0, 0), a2, voffA);
            PG8_WAIT_V(8); PG8_WAIT_L(0); PG8_BAR; PG8_MMA(1, 0, At, B0); PG8_MMA(1, 1, At, B1); PG8_BAR; PG8_SCHED;
            PG8_LDB(B0, 1, 0); PG8_LDB(B1, 1, 1); PG8_SCHED; PG8_LDA(At, 1, 0); PG8_STAGE(PG8_SA(0, 1), a2 + hstep, voffA);
            PG8_WAIT_V(8); PG8_WAIT_L(0); PG8_BAR; PG8_MMA(0, 0, At, B0); PG8_MMA(0, 1, At, B1); PG8_BAR; PG8_SCHED;
            PG8_LDA(At, 1, 1); PG8_STAGE(PG8_SB(1, 0), b3, voffB); PG8_STAGE(PG8_SB(1, 1), b3 + hstep, voffB); PG8_STAGE(PG8_SA(1, 0), a3, voffA);
            PG8_WAIT_V(8); PG8_WAIT_L(0); PG8_BAR; PG8_MMA(1, 0, At, B0); PG8_MMA(1, 1, At, B1); PG8_BAR; PG8_SCHED;
            } else {
            PG8_LDB(B0, 0, 0); PG8_SCHED; PG8_LDA(At, 0, 0); PG8_STAGE(PG8_SA(1, 1), a1 + hstep, voffA);
            PG8_WAIT_L(8); PG8_BAR; PG8_WAIT_L(0); PG8_MMA(0, 0, At, B0); PG8_BAR; PG8_SCHED;
            PG8_LDB(B1, 0, 1); PG8_STAGE(PG8_SB(0, 0), b2, voffB);
            PG8_BAR; PG8_WAIT_L(0); PG8_MMA(0, 1, At, B1); PG8_BAR;
            PG8_LDA(At, 0, 1); PG8_STAGE(PG8_SA(0, 0), a2, voffA);
            PG8_BAR; PG8_WAIT_L(0); PG8_MMA(1, 0, At, B0); PG8_BAR; PG8_SCHED;
            PG8_STAGE(PG8_SB(0, 1), b2 + hstep, voffB);
            PG8_WAIT_V(6); PG8_BAR; PG8_MMA(1, 1, At, B1); PG8_BAR;
            PG8_LDB(B0, 1, 0); PG8_SCHED; PG8_LDA(At, 1, 0); PG8_STAGE(PG8_SA(0, 1), a2 + hstep, voffA);
            PG8_WAIT_L(8); PG8_BAR; PG8_WAIT_L(0); PG8_MMA(0, 0, At, B0); PG8_BAR; PG8_SCHED;
            PG8_LDB(B1, 1, 1); PG8_STAGE(PG8_SB(1, 0), b3, voffB);
            PG8_BAR; PG8_WAIT_L(0); PG8_MMA(0, 1, At, B1); PG8_BAR;
            PG8_LDA(At, 1, 1); PG8_STAGE(PG8_SA(1, 0), a3, voffA);
            PG8_BAR; PG8_WAIT_L(0); PG8_MMA(1, 0, At, B0); PG8_BAR; PG8_SCHED;
            PG8_STAGE(PG8_SB(1, 1), b3 + hstep, voffB);
            PG8_WAIT_V(6); PG8_BAR; PG8_MMA(1, 1, At, B1); PG8_BAR;
            }
        }
        if constexpr (ALIGN_EPI) { if (wr == 0) PG8_BAR; }
        if constexpr (!Epi::AFTER_DRAIN) { E(acc, cur, wr, wc, fr, fq); S.done(cur); }
        if (!has_next) break;
#pragma unroll
        for (int a = 0; a < 2; ++a)
#pragma unroll
            for (int b = 0; b < 2; ++b)
#pragma unroll
                for (int m = 0; m < 4; ++m)
#pragma unroll
                    for (int n = 0; n < 2; ++n) acc[a][b][m][n] = (f32x4){0.f, 0.f, 0.f, 0.f};
        cur = nxt; cA = nA; cB = nB; ++ui;
        if constexpr (ALIGN_EPI) { if (wr == 1) PG8_BAR; }
    }
    PG8_WAIT_V(0);
    if constexpr (!ALIGN_EPI) { if (wr == 0) PG8_BAR; }
    PG8_BAR;
    if constexpr (Epi::AFTER_DRAIN) { E.fused(acc, cur, wr, wc, fr, fq, lds, wid, lane); S.done(cur); }
#undef PG8_SA
#undef PG8_SB
#undef PG8_STAGE
#undef PG8_LDA
#undef PG8_LDB
#undef PG8_MMA
#undef PG8_WAIT_V
#undef PG8_WAIT_L
#undef PG8_BAR
#undef PG8_SCHED
}
}

template <int MODE> struct EpiMK {
  static constexpr bool PERM = false, AFTER_DRAIN = false;
  const Params* pp; int l;
  DEV void operator()(const pg8::f32x4 (&acc)[2][2][4][2], const pg8::Unit& u, int wr, int wc, int fr, int fq) const {
    const Params& p = *pp;
#pragma unroll
    for (int ai = 0; ai < 2; ++ai)
#pragma unroll
      for (int m = 0; m < 4; ++m) {
        const int row = u.pm * 256 + ai * 128 + wr * 64 + m * 16 + fr;
#pragma unroll
        for (int bj = 0; bj < 2; ++bj)
#pragma unroll
          for (int n = 0; n < 2; ++n) {
            const int col = u.pn * 256 + bj * 128 + wc * 32 + n * 16 + fq * 4;
            const pg8::f32x4 v = acc[ai][bj][m][n];
            if (MODE == 0) {
              if (col < DIN) {
                uint2 o; o.x = pk2(v[0], v[1]); o.y = pk2(v[2], v[3]);
                *(uint2*)((bf16_t*)(p.ws + OFF_P) + (size_t)row * DIN + col) = o;
                if (row < NCTX) {
                  if (col >= C_NK && col < C_HQ) {
                    const int kv = col >= C_NV;
                    *(pg8::f32x4*)(p.out + O_NAT + (size_t)(((row >> 8) * 4 + l) * 2 + kv) * 65536 + (row & 255) * 256 + (col - (kv ? C_NV : C_NK))) = v;
                  } else if (col >= C_SK) {
                    const int kv = col >= C_SV;
                    *(pg8::f32x4*)(p.out + O_SWA + (size_t)(((row >> 8) * 4 + l) * 2 + kv) * 32768 + (row & 255) * 128 + (col - (kv ? C_SV : C_SK))) = v;
                  }
                }
              }
            } else if (MODE == 1) {
              uint2 o; o.x = pk2(v[0], v[1]); o.y = pk2(v[2], v[3]);
              *(uint2*)((bf16_t*)(p.ws + OFF_U) + (size_t)row * D + col) = o;
            } else {
              const float r0 = fmaxf(v[0], 0.f), r1 = fmaxf(v[1], 0.f), r2 = fmaxf(v[2], 0.f), r3 = fmaxf(v[3], 0.f);
              uint2 o; o.x = pk2(r0 * r0, r1 * r1); o.y = pk2(r2 * r2, r3 * r3);
              *(uint2*)((bf16_t*)(p.ws + OFF_HID) + (size_t)row * FF + col) = o;
            }
          }
      }
  }
};

template <int MODE>
DEV void gemm_run(const Params& p, int l, const bf16_t* A, const bf16_t* BT, int K, int N, char* lds) {
  pg8::Gemm g{A, BT, MT, N, K};
  pg8::StaticOrder S; S.init(MT, N, (int)gridDim.x, (int)blockIdx.x);
  EpiMK<MODE> E{&p, l};
  pg8::gemm_phase<EpiMK<MODE>, pg8::StaticOrder, true, true>((PG8_LAS unsigned char*)lds, g, S, E);
  if (MODE == 1 && l < 3 && (int)gridDim.x > 160 && (int)blockIdx.x >= 160) {
    if (K == D) layer_tiles(p, l + 1, 0, 640, (int)blockIdx.x - 160, (int)gridDim.x - 160, lds);
    else layer_tiles(p, l + 1, 640, NT_LAYER, (int)blockIdx.x - 160, (int)gridDim.x - 160, lds);
  }
}

constexpr int TOKT = 20;
DEV void prep_item(const Params& p, int l, int tile, char* lds) {
  const int t = tid(), r0 = tile * TOKT, c = t;
  bf16_t* sA = (bf16_t*)lds;
  float* swl = (float*)(lds + 32 * 136 * 2);
  float* sal = swl + TOKT * 256;
  const bf16_t* P = (const bf16_t*)(p.ws + OFF_P);
  bf16_t* PREP = (bf16_t*)(p.ws + OFF_PREP);
  bf16_t* BON = (bf16_t*)(p.ws + OFF_BONUS);
  for (int dir = 0; dir < 2; ++dir) {
    __syncthreads();
#pragma unroll
    for (int i = 0; i < TOKT / 2; ++i) {
      const int e = t + 256 * i, tk = e >> 7, j = e & 127, which = j >> 6, jj = j & 63;
      const int row = r0 + tk, prow = dir ? row + 1 : row - 1;
      const int tis = row < NCTX ? (row & 255) : ((row - NCTX) & 1023), Tm1 = row < NCTX ? 255 : 1023;
      const bool pv = dir ? (tis < Tm1) : (tis > 0);
      const int col = (dir ? C_WHB : C_WHF) + which * 64 + jj;
      const float cur = bf2f(P[(size_t)row * DIN + col]);
      const float prev = bf2f(P[(size_t)(pv ? prow : row) * DIN + col]) * (pv ? 1.f : 0.f);
      const float mu = p.in[I_MULORA][((l * 2 + dir) * 2 + which) * 64 + jj];
      const float val = cur + (prev - cur) * mu;
      sA[tk * 136 + j] = f2bf((which == 0) ? tanhf_(val) : val);
    }
    __syncthreads();
    {
      const int lane = t & 63, w = t >> 6, q = lane & 31, hh = lane >> 5;
#pragma unroll
      for (int mat = 0; mat < 2; ++mat) {
        bf16x8 af[4];
#pragma unroll
        for (int s = 0; s < 4; ++s) af[s] = *(const bf16x8*)(sA + q * 136 + mat * 64 + 16 * s + 8 * hh);
        const bf16_t* WT = (const bf16_t*)(p.ws + (mat ? OFF_A2T : OFF_W2T)) + (size_t)(l * 2 + dir) * 256 * 64;
        float* dst = mat ? sal : swl;
#pragma unroll
        for (int nt = 0; nt < 2; ++nt) {
          const int n = w * 64 + nt * 32 + q;
          f32x16 acc;
#pragma unroll
          for (int r = 0; r < 16; ++r) acc[r] = 0.f;
#pragma unroll
          for (int s = 0; s < 4; ++s) acc = MFMA32(af[s], *(const bf16x8*)(WT + (size_t)n * 64 + 16 * s + 8 * hh), acc);
#pragma unroll
          for (int r = 0; r < 8; ++r) dst[((r & 3) + 8 * (r >> 2) + 4 * hh) * 256 + n] = acc[r];
          if (hh == 0) {
#pragma unroll
            for (int r = 8; r < 12; ++r) dst[((r & 3) + 16) * 256 + n] = acc[r];
          }
        }
      }
    }
    __syncthreads();
    const float w0v = p.in[I_W0][(l * 2 + dir) * 256 + c], a0v = p.in[I_A0][(l * 2 + dir) * 256 + c];
    const float kkv = p.in[I_KK][l * 256 + c], kav = p.in[I_KA][l * 256 + c], rkv = p.in[I_RK][l * 256 + c];
    const float mur = p.in[I_MURKV][((l * 2 + dir) * 3 + 0) * 256 + c], muk = p.in[I_MURKV][((l * 2 + dir) * 3 + 1) * 256 + c],
                muv = p.in[I_MURKV][((l * 2 + dir) * 3 + 2) * 256 + c];
    bf16_t* pr = PREP + (size_t)dir * 6 * ARRF;
    for (int tb = 0; tb < TOKT; tb += 5) {
      float rc[5], kc[5], vc[5], rp[5], kq[5], vp[5], wlv[5], alv[5];
#pragma unroll
      for (int u = 0; u < 5; ++u) {
        const int tk = tb + u, row = r0 + tk, prow = dir ? row + 1 : row - 1;
        const int tis = row < NCTX ? (row & 255) : ((row - NCTX) & 1023), Tm1 = row < NCTX ? 255 : 1023;
        const bool pv = dir ? (tis < Tm1) : (tis > 0);
        const float pm = pv ? 1.f : 0.f;
        const bf16_t* pc = P + (size_t)row * DIN + c;
        const bf16_t* pp = P + (size_t)(pv ? prow : row) * DIN + c;
        rc[u] = bf2f(pc[C_R]); kc[u] = bf2f(pc[C_K]); vc[u] = bf2f(pc[C_V]);
        rp[u] = bf2f(pp[C_R]) * pm; kq[u] = bf2f(pp[C_K]) * pm; vp[u] = bf2f(pp[C_V]) * pm;
        wlv[u] = swl[tk * 256 + c]; alv[u] = sal[tk * 256 + c];
      }
      float bprev[5];
#pragma unroll
      for (int u = 0; u < 5; ++u) bprev[u] = (dir == 1) ? bf2f(BON[(size_t)(r0 + tb + u) * 256 + c]) : 0.f;
#pragma unroll
      for (int u = 0; u < 5; ++u) {
        const int row = r0 + tb + u;
        const float rs = rc[u] + (rp[u] - rc[u]) * mur, ks = kc[u] + (kq[u] - kc[u]) * muk, vs = vc[u] + (vp[u] - vc[u]) * muv;
        const float wl = w0v + wlv[u], al = a0v + alv[u];
        const float wv = __expf(-0.6065306597126334f * sigmoidf_(wl));
        const float av = sigmoidf_(al);
        const float kkr = ks * kkv;
        const float n2 = wave_sum(kkr * kkr);
        const float kk = kkr * rcpf_(fmaxf(__builtin_amdgcn_sqrtf(n2), 1e-12f));
        const float kp = ks * (1.0f + (av - 1.0f) * kav);
        const float bs = wave_sum(rs * kp * rkv);
        const float bon = bs * vs;
        const size_t idx = (size_t)row * 256 + c;
        pr[idx] = f2bf(rs); pr[ARRF + idx] = f2bf(wv); pr[2 * ARRF + idx] = f2bf(kp); pr[3 * ARRF + idx] = f2bf(vs); pr[4 * ARRF + idx] = f2bf(kk); pr[5 * ARRF + idx] = f2bf(kk * av);
        BON[idx] = f2bf(bprev[u] + bon);
      }
    }
  }
  __syncthreads();
}

DEV void rope_item(const Params& p, int item) {
  bf16_t* P = (bf16_t*)(p.ws + OFF_P);
  const int t = tid();
  for (int e = t; e < 64 * 192; e += 256) {
    const int tk = e / 192, r = e % 192, hs = r >> 5, pi = r & 31;
    const int lt = item * 64 + tk;
    const int tt = lt & 1023;
    const int grow = tt >> 6, gcol = tt & 63;
    const int fi = pi & 15;
    const float pos = (pi < 16) ? (float)grow : (float)gcol;
    const float inv = exp2f(-(float)fi * (13.287712379549449f / 16.0f));
    const float ang = pos * inv;
    const float cs = __cosf(ang), sn = __sinf(ang);
    const int d1 = (pi < 16) ? fi : 32 + fi;
    bf16_t* base = P + (size_t)(NCTX + lt) * DIN + C_SQ + hs * 64;
    const float x1 = bf2f(base[d1]), x2 = bf2f(base[d1 + 16]);
    base[d1] = f2bf(x1 * cs - x2 * sn);
    base[d1 + 16] = f2bf(x2 * cs + x1 * sn);
  }
}

constexpr int SC_BUF = 20480 + 4096;
typedef float f2 __attribute__((ext_vector_type(2)));
DEV float dot4(const float4& a, const float4& b) { return a.x * b.x + a.y * b.y + a.z * b.z + a.w * b.w; }
DEV float red8(float x) { x += dppf<0xB1>(x); x += dppf<0x4E>(x); x += dppf<0x141>(x); return x; }
DEV float dot8(const f2 (&S)[4], const float4& a, const float4& b) {
  f2 acc = S[0] * (f2){a.x, a.y};
  acc += S[1] * (f2){a.z, a.w}; acc += S[2] * (f2){b.x, b.y}; acc += S[3] * (f2){b.z, b.w};
  return acc.x + acc.y;
}

template <int NCH>
DEV void rwkv_scan(const Params& p, int l, int seq, int head, int dir, int rsel, char* lds) {
  const int t = tid(), rr = t >> 3, g = t & 7, rl = t >> 4, ks = t & 15;
  const int T = seq < 32 ? 256 : 1024;
  const int row0 = seq < 32 ? seq * 256 : NCTX + (seq - 32) * 1024;
  const bf16_t* prep = (const bf16_t*)(p.ws + OFF_PREP) + (size_t)dir * 6 * ARRF;
  float* ydir = (float*)(p.ws + OFF_YDIR) + (size_t)dir * ARRF;
  const int vbase = (NCH == 2) ? 0 : rsel * 32;
  f2 S[NCH][4];
#pragma unroll
  for (int c = 0; c < NCH; ++c)
#pragma unroll
    for (int j = 0; j < 4; ++j) S[c][j] = (f2){0.f, 0.f};
  if (seq >= 32) {
    const float* sp = p.in[I_SRW] + ((((size_t)(seq - 32) * 4 + l) * 2 + dir) * 4 + head) * 4096 + g * 8;
#pragma unroll
    for (int c = 0; c < NCH; ++c) {
      const float4 a = *(const float4*)(sp + (vbase + rr + 32 * c) * 64), b = *(const float4*)(sp + (vbase + rr + 32 * c) * 64 + 4);
      S[c][0] = (f2){a.x, a.y}; S[c][1] = (f2){a.z, a.w}; S[c][2] = (f2){b.x, b.y}; S[c][3] = (f2){b.z, b.w};
    }
  }
  const int nch = T >> 4;
  uint2 pre0, pre1, pre2, pre3, pre4, pvv;
#define RW_LOAD(cc) do { const int s_ = (cc) * 16 + rl; const int tok_ = dir ? (T - 1 - s_) : s_; \
    const size_t base_ = (size_t)(row0 + tok_) * 256 + head * 64; \
    pre0 = *(const uint2*)(prep + base_ + ks * 4); pre1 = *(const uint2*)(prep + ARRF + base_ + ks * 4); \
    pre2 = *(const uint2*)(prep + 2 * ARRF + base_ + ks * 4); pre3 = *(const uint2*)(prep + 4 * ARRF + base_ + ks * 4); \
    pre4 = *(const uint2*)(prep + 5 * ARRF + base_ + ks * 4); \
    if (NCH == 2) pvv = *(const uint2*)(prep + 3 * ARRF + base_ + ks * 4); \
    else pvv.x = *(const unsigned*)(prep + 3 * ARRF + base_ + vbase + ks * 2); } while (0)
#define RW_WRITE(bb) do { float4* sb_ = (float4*)(lds + (bb) * SC_BUF); float* vb_ = (float*)(lds + (bb) * SC_BUF + 20480); \
    sb_[(0 * 16 + rl) * 16 + ks] = bf4(pre0); sb_[(1 * 16 + rl) * 16 + ks] = bf4(pre1); sb_[(2 * 16 + rl) * 16 + ks] = bf4(pre2); \
    sb_[(3 * 16 + rl) * 16 + ks] = bf4(pre3); sb_[(4 * 16 + rl) * 16 + ks] = bf4(pre4); \
    if (NCH == 2) *(float4*)(vb_ + rl * 64 + ks * 4) = bf4(pvv); else *(f2*)(vb_ + rl * 64 + ks * 2) = (f2){bflo(pvv.x), bfhi(pvv.x)}; } while (0)
  __syncthreads();
  RW_LOAD(0); RW_WRITE(0);
  __syncthreads();
  for (int c = 0; c < nch; ++c) {
    if (c + 1 < nch) RW_LOAD(c + 1);
    const float4* sbuf = (const float4*)(lds + (c & 1) * SC_BUF);
    const float* vbuf = (const float*)(lds + (c & 1) * SC_BUF + 20480);
    float ym[NCH][2];
#pragma unroll
    for (int cc = 0; cc < NCH; ++cc) { ym[cc][0] = 0.f; ym[cc][1] = 0.f; }
#pragma unroll
    for (int i = 0; i < 16; ++i) {
      const float4 ra = sbuf[(0 * 16 + i) * 16 + g * 2], rb = sbuf[(0 * 16 + i) * 16 + g * 2 + 1];
      const float4 wa = sbuf[(1 * 16 + i) * 16 + g * 2], wb = sbuf[(1 * 16 + i) * 16 + g * 2 + 1];
      const float4 ka_ = sbuf[(2 * 16 + i) * 16 + g * 2], kb_ = sbuf[(2 * 16 + i) * 16 + g * 2 + 1];
      const float4 na = sbuf[(3 * 16 + i) * 16 + g * 2], nb = sbuf[(3 * 16 + i) * 16 + g * 2 + 1];
      const float4 aa = sbuf[(4 * 16 + i) * 16 + g * 2], ab = sbuf[(4 * 16 + i) * 16 + g * 2 + 1];
      const f2 w2[4] = {(f2){wa.x, wa.y}, (f2){wa.z, wa.w}, (f2){wb.x, wb.y}, (f2){wb.z, wb.w}};
      const f2 k2[4] = {(f2){ka_.x, ka_.y}, (f2){ka_.z, ka_.w}, (f2){kb_.x, kb_.y}, (f2){kb_.z, kb_.w}};
      const f2 a2[4] = {(f2){aa.x, aa.y}, (f2){aa.z, aa.w}, (f2){ab.x, ab.y}, (f2){ab.z, ab.w}};
#pragma unroll
      for (int cc = 0; cc < NCH; ++cc) {
        const float v = vbuf[i * 64 + rr + 32 * cc];
        const float sa = -red8(dot8(S[cc], na, nb));
#pragma unroll
        for (int j = 0; j < 4; ++j) S[cc][j] = S[cc][j] * w2[j] + a2[j] * sa + k2[j] * v;
        const float y = red8(dot8(S[cc], ra, rb));
        ym[cc][i >> 3] = (g == (i & 7)) ? y : ym[cc][i >> 3];
      }
    }
#pragma unroll
    for (int hh = 0; hh < 2; ++hh) {
      const int s = c * 16 + hh * 8 + g; const int tok = dir ? (T - 1 - s) : s;
      float* yo = ydir + (size_t)(row0 + tok) * 256 + head * 64 + vbase + rr;
#pragma unroll
      for (int cc = 0; cc < NCH; ++cc) yo[32 * cc] = ym[cc][hh];
    }
    if (c + 1 < nch) RW_WRITE((c + 1) & 1);
    __syncthreads();
  }
#undef RW_LOAD
#undef RW_WRITE
  if (seq < 32) {
    float* sp = p.out + O_RW + ((((size_t)seq * 4 + l) * 2 + dir) * 4 + head) * 4096 + g * 8;
#pragma unroll
    for (int c = 0; c < NCH; ++c) {
      *(float4*)(sp + (vbase + rr + 32 * c) * 64) = make_float4(S[c][0].x, S[c][0].y, S[c][1].x, S[c][1].y);
      *(float4*)(sp + (vbase + rr + 32 * c) * 64 + 4) = make_float4(S[c][2].x, S[c][2].y, S[c][3].x, S[c][3].y);
    }
  }
}

template <int NCH>
DEV void hgrn_scan(const Params& p, int l, int seq, int head, int dir, int rsel, char* lds) {
  const int t = tid(), rr = t >> 3, g = t & 7, rl = t >> 4, ks = t & 15;
  const int T = seq < 32 ? 256 : 1024;
  const int row0 = seq < 32 ? seq * 256 : NCTX + (seq - 32) * 1024;
  const bf16_t* P = (const bf16_t*)(p.ws + OFF_P);
  float* odir = (float*)(p.ws + OFF_HDIR) + (size_t)dir * ARRF;
  const float4 lb4 = *(const float4*)((const float*)(p.ws + OFF_HGLB) + (l * 2 + dir) * 256 + head * 64 + ks * 4);
  const int vbase = (NCH == 2) ? 0 : rsel * 32;
  f2 S[NCH][4];
#pragma unroll
  for (int c = 0; c < NCH; ++c)
#pragma unroll
    for (int j = 0; j < 4; ++j) S[c][j] = (f2){0.f, 0.f};
  if (seq >= 32) {
    const float* sp = p.in[I_SHG] + ((((size_t)(seq - 32) * 4 + l) * 2 + dir) * 4 + head) * 4096;
#pragma unroll
    for (int c = 0; c < NCH; ++c)
#pragma unroll
      for (int j = 0; j < 4; ++j) {
        const int v = vbase + rr + 32 * c;
        S[c][j] = (f2){sp[(g * 8 + 2 * j) * 64 + v], sp[(g * 8 + 2 * j + 1) * 64 + v]};
      }
  }
  const int nch = T >> 4;
  const int fcol = (dir ? C_HFB : C_HFF) + head * 64;
  uint2 pq, pf, pv2;
#define HG_LOAD(cc) do { const int s_ = (cc) * 16 + rl; const int tok_ = dir ? (T - 1 - s_) : s_; \
    const bf16_t* pr_ = P + (size_t)(row0 + tok_) * DIN; \
    pq = *(const uint2*)(pr_ + C_HQ + head * 64 + ks * 4); pf = *(const uint2*)(pr_ + fcol + ks * 4); \
    if (NCH == 2) pv2 = *(const uint2*)(pr_ + C_HI + head * 64 + ks * 4); else pv2.x = *(const unsigned*)(pr_ + C_HI + head * 64 + vbase + ks * 2); } while (0)
#define HG_WRITE(bb) do { float4* sb_ = (float4*)(lds + (bb) * SC_BUF); float* vb_ = (float*)(lds + (bb) * SC_BUF + 20480); \
    float4 q_, f_, k_; float a_, sg_; \
    a_ = bflo(pq.x); q_.x = a_ * sigmoidf_(a_); a_ = bfhi(pq.x); q_.y = a_ * sigmoidf_(a_); \
    a_ = bflo(pq.y); q_.z = a_ * sigmoidf_(a_); a_ = bfhi(pq.y); q_.w = a_ * sigmoidf_(a_); \
    sg_ = sigmoidf_(bflo(pf.x)); f_.x = lb4.x + (1.f - lb4.x) * sg_; k_.x = (1.f - lb4.x) * (1.f - sg_); \
    sg_ = sigmoidf_(bfhi(pf.x)); f_.y = lb4.y + (1.f - lb4.y) * sg_; k_.y = (1.f - lb4.y) * (1.f - sg_); \
    sg_ = sigmoidf_(bflo(pf.y)); f_.z = lb4.z + (1.f - lb4.z) * sg_; k_.z = (1.f - lb4.z) * (1.f - sg_); \
    sg_ = sigmoidf_(bfhi(pf.y)); f_.w = lb4.w + (1.f - lb4.w) * sg_; k_.w = (1.f - lb4.w) * (1.f - sg_); \
    sb_[(0 * 16 + rl) * 16 + ks] = q_; sb_[(1 * 16 + rl) * 16 + ks] = f_; sb_[(2 * 16 + rl) * 16 + ks] = k_; \
    if (NCH == 2) *(float4*)(vb_ + rl * 64 + ks * 4) = make_float4(bflo(pv2.x), bfhi(pv2.x), bflo(pv2.y), bfhi(pv2.y)); \
    else *(f2*)(vb_ + rl * 64 + ks * 2) = (f2){bflo(pv2.x), bfhi(pv2.x)}; } while (0)
  __syncthreads();
  HG_LOAD(0); HG_WRITE(0);
  __syncthreads();
  for (int c = 0; c < nch; ++c) {
    if (c + 1 < nch) HG_LOAD(c + 1);
    const float4* sbuf = (const float4*)(lds + (c & 1) * SC_BUF);
    const float* vbuf = (const float*)(lds + (c & 1) * SC_BUF + 20480);
    float ym[NCH][2];
#pragma unroll
    for (int cc = 0; cc < NCH; ++cc) { ym[cc][0] = 0.f; ym[cc][1] = 0.f; }
#pragma unroll
    for (int i = 0; i < 16; ++i) {
      const float4 qa = sbuf[(0 * 16 + i) * 16 + g * 2], qb = sbuf[(0 * 16 + i) * 16 + g * 2 + 1];
      const float4 fa = sbuf[(1 * 16 + i) * 16 + g * 2], fb = sbuf[(1 * 16 + i) * 16 + g * 2 + 1];
      const float4 ka_ = sbuf[(2 * 16 + i) * 16 + g * 2], kb_ = sbuf[(2 * 16 + i) * 16 + g * 2 + 1];
      const f2 f2v[4] = {(f2){fa.x, fa.y}, (f2){fa.z, fa.w}, (f2){fb.x, fb.y}, (f2){fb.z, fb.w}};
      const f2 k2[4] = {(f2){ka_.x, ka_.y}, (f2){ka_.z, ka_.w}, (f2){kb_.x, kb_.y}, (f2){kb_.z, kb_.w}};
#pragma unroll
      for (int cc = 0; cc < NCH; ++cc) {
        const float v = vbuf[i * 64 + rr + 32 * cc];
#pragma unroll
        for (int j = 0; j < 4; ++j) S[cc][j] = S[cc][j] * f2v[j] + k2[j] * v;
        const float y = red8(dot8(S[cc], qa, qb));
        ym[cc][i >> 3] = (g == (i & 7)) ? y : ym[cc][i >> 3];
      }
    }
#pragma unroll
    for (int hh = 0; hh < 2; ++hh) {
      const int s = c * 16 + hh * 8 + g; const int tok = dir ? (T - 1 - s) : s;
      float* yo = odir + (size_t)(row0 + tok) * 256 + head * 64 + vbase + rr;
#pragma unroll
      for (int cc = 0; cc < NCH; ++cc) yo[32 * cc] = ym[cc][hh];
    }
    if (c + 1 < nch) HG_WRITE((c + 1) & 1);
    __syncthreads();
  }
#undef HG_LOAD
#undef HG_WRITE
  if (seq < 32) {
    float* sp = p.out + O_HG + ((((size_t)seq * 4 + l) * 2 + dir) * 4 + head) * 4096;
#pragma unroll
    for (int c = 0; c < NCH; ++c)
#pragma unroll
      for (int j = 0; j < 4; ++j) {
        const int v = vbase + rr + 32 * c;
        sp[(g * 8 + 2 * j) * 64 + v] = S[c][j].x; sp[(g * 8 + 2 * j + 1) * 64 + v] = S[c][j].y;
      }
  }
}

DEV void rwkv_scan16(const Params& p, int l, int seq, int head, int dir, int rg, char* lds) {
  const int t = tid(), rl = t >> 4, ks = t & 15;
  const int T = seq < 32 ? 256 : 1024;
  const int row0 = seq < 32 ? seq * 256 : NCTX + (seq - 32) * 1024;
  const bf16_t* prep = (const bf16_t*)(p.ws + OFF_PREP) + (size_t)dir * 6 * ARRF;
  float* ydir = (float*)(p.ws + OFF_YDIR) + (size_t)dir * ARRF;
  const int v0 = rg * 16 + rl;
  float4 S0 = make_float4(0.f, 0.f, 0.f, 0.f);
  if (seq >= 32) S0 = *(const float4*)(p.in[I_SRW] + ((((size_t)(seq - 32) * 4 + l) * 2 + dir) * 4 + head) * 4096 + ks * 4 + v0 * 64);
  const int nch = T >> 4;
  uint2 pre0, pre1, pre2, pre3, pre4; bf16_t pv0;
#define RW_LOAD(cc) do { const int s_ = (cc) * 16 + rl; const int tok_ = dir ? (T - 1 - s_) : s_; \
    const size_t base_ = (size_t)(row0 + tok_) * 256 + head * 64; \
    pre0 = *(const uint2*)(prep + base_ + ks * 4); pre1 = *(const uint2*)(prep + ARRF + base_ + ks * 4); \
    pre2 = *(const uint2*)(prep + 2 * ARRF + base_ + ks * 4); pre3 = *(const uint2*)(prep + 4 * ARRF + base_ + ks * 4); \
    pre4 = *(const uint2*)(prep + 5 * ARRF + base_ + ks * 4); pv0 = prep[3 * ARRF + base_ + rg * 16 + ks]; } while (0)
#define RW_WRITE(bb) do { float4* sb_ = (float4*)(lds + (bb) * SC_BUF); float* vb_ = (float*)(lds + (bb) * SC_BUF + 20480); \
    sb_[(0 * 16 + rl) * 16 + ks] = bf4(pre0); sb_[(1 * 16 + rl) * 16 + ks] = bf4(pre1); sb_[(2 * 16 + rl) * 16 + ks] = bf4(pre2); \
    sb_[(3 * 16 + rl) * 16 + ks] = bf4(pre3); sb_[(4 * 16 + rl) * 16 + ks] = bf4(pre4); vb_[rl * 16 + ks] = bf2f(pv0); } while (0)
  __syncthreads();
  RW_LOAD(0); RW_WRITE(0);
  __syncthreads();
  for (int c = 0; c < nch; ++c) {
    if (c + 1 < nch) RW_LOAD(c + 1);
    const float4* sbuf = (const float4*)(lds + (c & 1) * SC_BUF);
    const float* vbuf = (const float*)(lds + (c & 1) * SC_BUF + 20480);
    float ym0 = 0.f;
#pragma unroll
    for (int i = 0; i < 16; ++i) {
      const float4 r = sbuf[(0 * 16 + i) * 16 + ks], wv = sbuf[(1 * 16 + i) * 16 + ks], kv = sbuf[(2 * 16 + i) * 16 + ks],
                   kk = sbuf[(3 * 16 + i) * 16 + ks], ka = sbuf[(4 * 16 + i) * 16 + ks];
      const float va = vbuf[i * 16 + rl];
      const float sa0 = -row16_sum(dot4(S0, kk));
      S0.x = S0.x * wv.x + sa0 * ka.x + va * kv.x; S0.y = S0.y * wv.y + sa0 * ka.y + va * kv.y;
      S0.z = S0.z * wv.z + sa0 * ka.z + va * kv.z; S0.w = S0.w * wv.w + sa0 * ka.w + va * kv.w;
      const float y0 = row16_sum(dot4(S0, r));
      ym0 = (ks == i) ? y0 : ym0;
    }
    {
      const int s = c * 16 + ks; const int tok = dir ? (T - 1 - s) : s;
      ydir[(size_t)(row0 + tok) * 256 + head * 64 + v0] = ym0;
    }
    if (c + 1 < nch) RW_WRITE((c + 1) & 1);
    __syncthreads();
  }
#undef RW_LOAD
#undef RW_WRITE
  if (seq < 32) *(float4*)(p.out + O_RW + ((((size_t)seq * 4 + l) * 2 + dir) * 4 + head) * 4096 + ks * 4 + v0 * 64) = S0;
}

DEV void hgrn_scan16(const Params& p, int l, int seq, int head, int dir, int rg, char* lds) {
  const int t = tid(), rl = t >> 4, ks = t & 15;
  const int T = seq < 32 ? 256 : 1024;
  const int row0 = seq < 32 ? seq * 256 : NCTX + (seq - 32) * 1024;
  const bf16_t* P = (const bf16_t*)(p.ws + OFF_P);
  float* odir = (float*)(p.ws + OFF_HDIR) + (size_t)dir * ARRF;
  const float4 lb4 = *(const float4*)((const float*)(p.ws + OFF_HGLB) + (l * 2 + dir) * 256 + head * 64 + ks * 4);
  const int v0 = rg * 16 + rl;
  float4 S0 = make_float4(0.f, 0.f, 0.f, 0.f);
  if (seq >= 32) {
    const float* sp = p.in[I_SHG] + ((((size_t)(seq - 32) * 4 + l) * 2 + dir) * 4 + head) * 4096;
    S0.x = sp[(ks * 4 + 0) * 64 + v0]; S0.y = sp[(ks * 4 + 1) * 64 + v0]; S0.z = sp[(ks * 4 + 2) * 64 + v0]; S0.w = sp[(ks * 4 + 3) * 64 + v0];
  }
  const int nch = T >> 4;
  const int fcol = (dir ? C_HFB : C_HFF) + head * 64;
  uint2 pq, pf; bf16_t pva;
#define HG_LOAD(cc) do { const int s_ = (cc) * 16 + rl; const int tok_ = dir ? (T - 1 - s_) : s_; \
    const bf16_t* pr_ = P + (size_t)(row0 + tok_) * DIN; \
    pq = *(const uint2*)(pr_ + C_HQ + head * 64 + ks * 4); pf = *(const uint2*)(pr_ + fcol + ks * 4); \
    pva = pr_[C_HI + head * 64 + rg * 16 + ks]; } while (0)
#define HG_WRITE(bb) do { float4* sb_ = (float4*)(lds + (bb) * SC_BUF); float* vb_ = (float*)(lds + (bb) * SC_BUF + 20480); \
    float4 q_, f_, k_; float a_, sg_; \
    a_ = bflo(pq.x); q_.x = a_ * sigmoidf_(a_); a_ = bfhi(pq.x); q_.y = a_ * sigmoidf_(a_); \
    a_ = bflo(pq.y); q_.z = a_ * sigmoidf_(a_); a_ = bfhi(pq.y); q_.w = a_ * sigmoidf_(a_); \
    sg_ = sigmoidf_(bflo(pf.x)); f_.x = lb4.x + (1.f - lb4.x) * sg_; k_.x = (1.f - lb4.x) * (1.f - sg_); \
    sg_ = sigmoidf_(bfhi(pf.x)); f_.y = lb4.y + (1.f - lb4.y) * sg_; k_.y = (1.f - lb4.y) * (1.f - sg_); \
    sg_ = sigmoidf_(bflo(pf.y)); f_.z = lb4.z + (1.f - lb4.z) * sg_; k_.z = (1.f - lb4.z) * (1.f - sg_); \
    sg_ = sigmoidf_(bfhi(pf.y)); f_.w = lb4.w + (1.f - lb4.w) * sg_; k_.w = (1.f - lb4.w) * (1.f - sg_); \
    sb_[(0 * 16 + rl) * 16 + ks] = q_; sb_[(1 * 16 + rl) * 16 + ks] = f_; sb_[(2 * 16 + rl) * 16 + ks] = k_; \
    vb_[rl * 16 + ks] = bf2f(pva); } while (0)
  __syncthreads();
  HG_LOAD(0); HG_WRITE(0);
  __syncthreads();
  for (int c = 0; c < nch; ++c) {
    if (c + 1 < nch) HG_LOAD(c + 1);
    const float4* sbuf = (const float4*)(lds + (c & 1) * SC_BUF);
    const float* vbuf = (const float*)(lds + (c & 1) * SC_BUF + 20480);
    float ym0 = 0.f;
#pragma unroll
    for (int i = 0; i < 16; ++i) {
      const float4 q = sbuf[(0 * 16 + i) * 16 + ks], f = sbuf[(1 * 16 + i) * 16 + ks], k = sbuf[(2 * 16 + i) * 16 + ks];
      const float va = vbuf[i * 16 + rl];
      S0.x = S0.x * f.x + k.x * va; S0.y = S0.y * f.y + k.y * va; S0.z = S0.z * f.z + k.z * va; S0.w = S0.w * f.w + k.w * va;
      const float y0 = row16_sum(dot4(S0, q));
      ym0 = (ks == i) ? y0 : ym0;
    }
    {
      const int s = c * 16 + ks; const int tok = dir ? (T - 1 - s) : s;
      odir[(size_t)(row0 + tok) * 256 + head * 64 + v0] = ym0;
    }
    if (c + 1 < nch) HG_WRITE((c + 1) & 1);
    __syncthreads();
  }
#undef HG_LOAD
#undef HG_WRITE
  if (seq < 32) {
    float* sp = p.out + O_HG + ((((size_t)seq * 4 + l) * 2 + dir) * 4 + head) * 4096;
    sp[(ks * 4 + 0) * 64 + v0] = S0.x; sp[(ks * 4 + 1) * 64 + v0] = S0.y; sp[(ks * 4 + 2) * 64 + v0] = S0.z; sp[(ks * 4 + 3) * 64 + v0] = S0.w;
  }
}

template <int MODE>
DEV void attn_item(const Params& p, int l, int item, char* lds) {
  const int t = tid(), lane = t & 63, w = t >> 6, q = lane & 31, hh = lane >> 5;
  const bf16_t* P = (const bf16_t*)(p.ws + OFF_P);
  bf16_t* Y = (bf16_t*)(p.ws + OFF_YMIX);
  char* sK = lds;
  char* sV = lds + 8192;
  float* sBias = (float*)(lds + 8192 + 8704);
  int head, qrow, qcol, kcol, vcol, ocol, nloc, nt, rowbaseP;
  int qr = 0, qc = 0, rlo = 0, qpos = 0, lo = 0, rsq = 0, wsq = 0;
  float sink = 0.f;
  const float* cache = nullptr; int cH = 1, cHead = 0;
  if (MODE == 0 || MODE == 1) {
    const int b = item >> 3; head = (item >> 1) & 3; const int half = item & 1;
    rowbaseP = b * 256; qrow = rowbaseP + half * 128 + w * 32 + q; nloc = 4; nt = 4;
  } else {
    const int b = item >> 5; head = (item >> 3) & 3; const int sub = item & 7;
    rowbaseP = NCTX + b * 1024;
    if (MODE == 2) {
      qr = 2 * sub + (w >> 1); qc = (w & 1) * 32 + q; qrow = rowbaseP + qr * 64 + qc;
      rlo = clampi(2 * sub - 4, 0, 8); const int rhi = clampi(2 * sub - 3, 0, 8) + 7; nloc = rhi - rlo + 1; nt = nloc + 4;
      rsq = clampi(qr - 4, 0, 8); wsq = clampi(qc - 8, 0, 48);
      cache = p.in[I_CNAT] + (size_t)((b * 4 + l) * 2) * 256 * 256; cH = 4; cHead = head;
      for (int i = t; i < 465; i += 256) sBias[i] = p.in[I_RPB][(size_t)(l * 4 + head) * 465 + i];
    } else {
      qpos = sub * 128 + w * 32 + q; qrow = rowbaseP + qpos;
      lo = (sub - 1) * 128;
      nloc = 6; nt = nloc + 4;
      cache = p.in[I_CSWA] + (size_t)((b * 4 + l) * 2) * 256 * 128; cH = 2; cHead = head >> 1;
    }
  }
  if (MODE == 0 || MODE == 2) { qcol = C_NQ + head * 64; kcol = C_NK + head * 64; vcol = C_NV + head * 64; ocol = 256 + head * 64; }
  else { qcol = C_SQ + head * 64; kcol = C_SK + (head >> 1) * 64; vcol = C_SV + (head >> 1) * 64; ocol = 768 + head * 64; sink = p.in[I_SINK][l * 4 + head]; }

  bf16x8 bq[4];
#pragma unroll
  for (int s = 0; s < 4; ++s) bq[s] = *(const bf16x8*)(P + (size_t)qrow * DIN + qcol + 16 * s + 8 * hh);
  f32x16 oacc[2];
#pragma unroll
  for (int r = 0; r < 16; ++r) { oacc[0][r] = 0.f; oacc[1][r] = 0.f; }
  float m_run = -1e30f, l_run = 0.f;
  const int key = t >> 2, dq = t & 3;
  const int kswz = (key >> 1) & 7;
  float4 raw[8];
#define ATT_ISSUE(jj) do { const int j_ = (jj); \
    if (j_ < nloc) { \
      int krow_; \
      if (MODE == 0 || MODE == 1) krow_ = rowbaseP + j_ * 64 + key; \
      else if (MODE == 2) krow_ = rowbaseP + (rlo + j_) * 64 + key; \
      else krow_ = rowbaseP + clampi(lo + j_ * 64 + key, 0, 1023); \
      const bf16_t* kp_ = P + (size_t)krow_ * DIN + kcol + dq * 16; \
      const bf16_t* vp_ = P + (size_t)krow_ * DIN + vcol + dq * 16; \
      raw[0] = *(const float4*)kp_; raw[1] = *(const float4*)(kp_ + 8); raw[2] = *(const float4*)vp_; raw[3] = *(const float4*)(vp_ + 8); \
    } else { \
      const int ct_ = (j_ - nloc) * 64 + key; \
      const float* kp_ = cache + ((size_t)ct_ * cH + cHead) * 64 + dq * 16; \
      const float* vp_ = kp_ + (size_t)256 * cH * 64; \
      raw[0] = *(const float4*)kp_; raw[1] = *(const float4*)(kp_ + 4); raw[2] = *(const float4*)(kp_ + 8); raw[3] = *(const float4*)(kp_ + 12); \
      raw[4] = *(const float4*)vp_; raw[5] = *(const float4*)(vp_ + 4); raw[6] = *(const float4*)(vp_ + 8); raw[7] = *(const float4*)(vp_ + 12); \
    } } while (0)
  ATT_ISSUE(0);
  for (int j = 0; j < nt; ++j) {
    uint4 kr[2], vr[2];
    const bool isP = j < nloc;
    if (isP) {
      kr[0] = __builtin_bit_cast(uint4, raw[0]); kr[1] = __builtin_bit_cast(uint4, raw[1]);
      vr[0] = __builtin_bit_cast(uint4, raw[2]); vr[1] = __builtin_bit_cast(uint4, raw[3]);
    } else {
      kr[0].x = pk2(raw[0].x, raw[0].y); kr[0].y = pk2(raw[0].z, raw[0].w); kr[0].z = pk2(raw[1].x, raw[1].y); kr[0].w = pk2(raw[1].z, raw[1].w);
      kr[1].x = pk2(raw[2].x, raw[2].y); kr[1].y = pk2(raw[2].z, raw[2].w); kr[1].z = pk2(raw[3].x, raw[3].y); kr[1].w = pk2(raw[3].z, raw[3].w);
      vr[0].x = pk2(raw[4].x, raw[4].y); vr[0].y = pk2(raw[4].z, raw[4].w); vr[0].z = pk2(raw[5].x, raw[5].y); vr[0].w = pk2(raw[5].z, raw[5].w);
      vr[1].x = pk2(raw[6].x, raw[6].y); vr[1].y = pk2(raw[6].z, raw[6].w); vr[1].z = pk2(raw[7].x, raw[7].y); vr[1].w = pk2(raw[7].z, raw[7].w);
    }
    if (j + 1 < nt) ATT_ISSUE(j + 1);
    __syncthreads();
    *(uint4*)(sK + key * 128 + (((dq * 2 + 0) ^ kswz) << 4)) = kr[0];
    *(uint4*)(sK + key * 128 + (((dq * 2 + 1) ^ kswz) << 4)) = kr[1];
    {
      bf16_t* vt = (bf16_t*)sV;
      const unsigned vv[8] = {vr[0].x, vr[0].y, vr[0].z, vr[0].w, vr[1].x, vr[1].y, vr[1].z, vr[1].w};
#pragma unroll
      for (int e = 0; e < 8; ++e) {
        vt[(dq * 16 + 2 * e) * 68 + key] = (bf16_t)(vv[e] & 0xffffu);
        vt[(dq * 16 + 2 * e + 1) * 68 + key] = (bf16_t)(vv[e] >> 16);
      }
    }
    __syncthreads();
    f32x16 sacc[2];
#pragma unroll
    for (int r = 0; r < 16; ++r) { sacc[0][r] = 0.f; sacc[1][r] = 0.f; }
    const int qswz = (q >> 1) & 7;
#pragma unroll
    for (int s = 0; s < 4; ++s) {
      const int co = (((s * 2 + hh) ^ qswz) << 4);
      const bf16x8 a0 = *(const bf16x8*)(sK + q * 128 + co);
      const bf16x8 a1 = *(const bf16x8*)(sK + (32 + q) * 128 + co);
      sacc[0] = MFMA32(a0, bq[s], sacc[0]);
      sacc[1] = MFMA32(a1, bq[s], sacc[1]);
    }
    float mx = -1e30f;
#pragma unroll
    for (int sub = 0; sub < 2; ++sub)
#pragma unroll
      for (int r = 0; r < 16; ++r) {
        const int kidx = sub * 32 + (r & 3) + 8 * (r >> 2) + 4 * hh;
        float v = sacc[sub][r] * 0.125f;
        bool ok = true;
        if (MODE == 2 && isP) {
          const int kr_ = rlo + j, kc_ = kidx;
          ok = (kr_ >= rsq) && (kr_ < rsq + 8) && (kc_ >= wsq) && (kc_ < wsq + 16);
          const int bi = ok ? ((kr_ - qr + 7) * 31 + (kc_ - qc + 15)) : 0;
          v += sBias[bi];
        }
        if (MODE == 3 && isP) {
          const int kpos = lo + j * 64 + kidx, dlt = kpos - qpos;
          ok = (dlt <= 128) && (dlt >= -128) && (kpos >= 0) && (kpos < 1024);
        }
        v = ok ? v : -1e30f;
        sacc[sub][r] = v;
        mx = fmaxf(mx, v);
      }
    mx = fmaxf(mx, __shfl_xor(mx, 32));
    const float m_new = fmaxf(m_run, mx);
    const float alpha = __expf(m_run - m_new);
    float rsum = 0.f;
#pragma unroll
    for (int sub = 0; sub < 2; ++sub)
#pragma unroll
      for (int r = 0; r < 16; ++r) {
        const float v = sacc[sub][r];
        const float pv = (v > -1e29f) ? __expf(v - m_new) : 0.f;
        sacc[sub][r] = pv; rsum += pv;
      }
    rsum += __shfl_xor(rsum, 32);
    l_run = l_run * alpha + rsum; m_run = m_new;
#pragma unroll
    for (int r = 0; r < 16; ++r) { oacc[0][r] *= alpha; oacc[1][r] *= alpha; }
#pragma unroll
    for (int k4 = 0; k4 < 4; ++k4) {
      const int sub = k4 >> 1, s2 = k4 & 1;
      uint4 pbu;
      pbu.x = pk2(sacc[sub][8 * s2 + 0], sacc[sub][8 * s2 + 1]); pbu.y = pk2(sacc[sub][8 * s2 + 2], sacc[sub][8 * s2 + 3]);
      pbu.z = pk2(sacc[sub][8 * s2 + 4], sacc[sub][8 * s2 + 5]); pbu.w = pk2(sacc[sub][8 * s2 + 6], sacc[sub][8 * s2 + 7]);
      const bf16x8 pb = __builtin_bit_cast(bf16x8, pbu);
#pragma unroll
      for (int dt = 0; dt < 2; ++dt) {
        const char* vp = sV + (dt * 32 + q) * 136 + (16 * k4 + 4 * hh) * 2;
        const uint2 lo8 = *(const uint2*)vp, hi8 = *(const uint2*)(vp + 16);
        uint4 avu; avu.x = lo8.x; avu.y = lo8.y; avu.z = hi8.x; avu.w = hi8.y;
        oacc[dt] = MFMA32(__builtin_bit_cast(bf16x8, avu), pb, oacc[dt]);
      }
    }
  }
#undef ATT_ISSUE
  float scale;
  if (MODE == 1 || MODE == 3) {
    const float m_f = fmaxf(m_run, sink);
    const float e = __expf(m_run - m_f);
    scale = e / (l_run * e + __expf(sink - m_f));
  } else scale = 1.0f / l_run;
#pragma unroll
  for (int dt = 0; dt < 2; ++dt)
#pragma unroll
    for (int g4 = 0; g4 < 4; ++g4) {
      const int d = dt * 32 + 8 * g4 + 4 * hh;
      uint2 o; o.x = pk2(oacc[dt][4 * g4] * scale, oacc[dt][4 * g4 + 1] * scale); o.y = pk2(oacc[dt][4 * g4 + 2] * scale, oacc[dt][4 * g4 + 3] * scale);
      *(uint2*)(Y + (size_t)qrow * D + ocol + d) = o;
    }
  __syncthreads();
}

DEV void post_item(const Params& p, int l, int tile, char* lds) {
  const int t = tid(), r0 = tile * TOKT, c = t;
  bf16_t* sA = (bf16_t*)lds;
  float* sgo = (float*)(lds + 32 * 136 * 2);
  const bf16_t* P = (const bf16_t*)(p.ws + OFF_P);
  bf16_t* Y = (bf16_t*)(p.ws + OFF_YMIX);
  const float* Y0 = (const float*)(p.ws + OFF_YDIR); const float* Y1 = Y0 + ARRF;
  const float* H0 = (const float*)(p.ws + OFF_HDIR); const float* H1 = H0 + ARRF;
  const bf16_t* BON = (const bf16_t*)(p.ws + OFF_BONUS);
  __syncthreads();
#pragma unroll
  for (int i = 0; i < TOKT / 2; ++i) {
    const int e = t + 256 * i, tk = e >> 7, j = e & 127;
    sA[tk * 136 + j] = f2bf(sigmoidf_(bf2f(P[(size_t)(r0 + tk) * DIN + C_GH + j])));
  }
  __syncthreads();
  {
    const int lane = t & 63, w = t >> 6, q = lane & 31, hh = lane >> 5;
    bf16x8 af[8];
#pragma unroll
    for (int s = 0; s < 8; ++s) af[s] = *(const bf16x8*)(sA + q * 136 + 16 * s + 8 * hh);
    const bf16_t* GT = (const bf16_t*)(p.ws + OFF_G2T) + (size_t)l * 256 * 128;
#pragma unroll
    for (int nt = 0; nt < 2; ++nt) {
      const int n = w * 64 + nt * 32 + q;
      f32x16 acc;
#pragma unroll
      for (int r = 0; r < 16; ++r) acc[r] = 0.f;
#pragma unroll
      for (int s = 0; s < 8; ++s) acc = MFMA32(af[s], *(const bf16x8*)(GT + (size_t)n * 128 + 16 * s + 8 * hh), acc);
#pragma unroll
      for (int r = 0; r < 8; ++r) sgo[((r & 3) + 8 * (r >> 2) + 4 * hh) * 256 + n] = acc[r];
      if (hh == 0) {
#pragma unroll
        for (int r = 8; r < 12; ++r) sgo[((r & 3) + 16) * 256 + n] = acc[r];
      }
    }
  }
  __syncthreads();
  const float lnw = p.in[I_LNW][l * 256 + c], lnb = p.in[I_LNB][l * 256 + c], hgn = p.in[I_HGN][l * 256 + c];
  for (int tb = 0; tb < TOKT; tb += 5) {
    float y[5], o[5], bn[5], gv[5], hg[5];
#pragma unroll
    for (int u = 0; u < 5; ++u) {
      const int row = r0 + tb + u;
      const size_t idx = (size_t)row * 256 + c;
      y[u] = Y0[idx] + Y1[idx]; o[u] = H0[idx] + H1[idx]; bn[u] = bf2f(BON[idx]);
      gv[u] = sgo[(tb + u) * 256 + c]; hg[u] = bf2f(P[(size_t)row * DIN + C_HG + c]);
    }
#pragma unroll
    for (int u = 0; u < 5; ++u) {
      const int row = r0 + tb + u;
      const float mu = wave_sum(y[u]) * (1.0f / 64.0f);
      const float dy = y[u] - mu;
      const float var = wave_sum(dy * dy) * (1.0f / 64.0f);
      const float yn = dy * rsqrtf(var + 64e-5f) * lnw + lnb + bn[u];
      Y[(size_t)row * D + c] = f2bf(yn * gv[u]);
      const float ms = wave_sum(o[u] * o[u]) * (1.0f / 64.0f);
      Y[(size_t)row * D + 512 + c] = f2bf(o[u] * rsqrtf(ms + 1e-6f) * hgn * sigmoidf_(hg[u]));
    }
  }
  __syncthreads();
}

constexpr int OFF_CTR_WORD = 3600;
DEV void mixer_phase(const Params& p, int l, char* lds0, volatile LAS unsigned* st, bool rerun) {
  const int hf = half_id(); char* lds = lds0 + hf * 65536;
  const int npairs = (256 + 512 + 512) / 2;
  unsigned* ctr = (unsigned*)(p.ws + OFF_BAR) + OFF_CTR_WORD + 64 * l + (rerun ? 32 : 0);
  for (;;) {
    if (threadIdx.x == 0) st[4] = __hip_atomic_fetch_add(ctr, 1u, __ATOMIC_RELAXED, __HIP_MEMORY_SCOPE_AGENT);
    __syncthreads();
    const int pair = (int)st[4];
    __syncthreads();
    if (pair >= npairs) break;
    const int it = pair * 2 + hf;
    const bool is_scan = it < 128 || (it >= 256 && it < 768);
    if (rerun && PROBE_SUB == 1 && !is_scan) continue;
    if (rerun && PROBE_SUB == 2 && is_scan) continue;
    if (rerun && PROBE_SUB == 3 && !(it < 128)) continue;
    if (rerun && PROBE_SUB == 4 && !(it >= 256 && it < 768)) continue;
    if (it < 128) {
      const int idx = it >> 1; const int seq = 32 + (idx >> 5), rem = idx & 31;
      if ((it & 1) == 0) rwkv_scan16(p, l, seq, rem >> 3, (rem >> 2) & 1, rem & 3, lds);
      else hgrn_scan16(p, l, seq, rem >> 3, (rem >> 2) & 1, rem & 3, lds);
    } else if (it < 192) attn_item<3>(p, l, it - 128, lds);
    else if (it < 256) attn_item<2>(p, l, it - 192, lds);
    else if (it < 768) {
      const int idx = (it - 256) & 255; const int seq = idx >> 3, rem = idx & 7;
      if (it < 512) rwkv_scan<2>(p, l, seq, rem >> 1, rem & 1, 0, lds);
      else hgrn_scan<2>(p, l, seq, rem >> 1, rem & 1, 0, lds);
    } else if (it < 1024) attn_item<0>(p, l, it - 768, lds);
    else attn_item<1>(p, l, it - 1024, lds);
  }
}

DEV void run_phase(const Params& p, int ph, char* lds, bool rerun, volatile LAS unsigned* st) {
  if (ph == 0) { phase0(p, lds); return; }
  if (ph == 1) { row_phase(p, 0, 0); return; }
  const int l = (ph - 2) / 9, s = (ph - 2) % 9;
  const bf16_t* H = (const bf16_t*)(p.ws + OFF_H);
  const int hf = half_id(); char* ldsh = lds + hf * 65536;
  switch (s) {
    case 0: gemm_run<0>(p, l, H, (const bf16_t*)(p.ws + OFF_WIN) + (size_t)l * DINP * D, D, DINP, lds); break;
    case 1:
      for (int it = blockIdx.x * 2 + hf; it < 512 + 32; it += gridDim.x * 2) { if (it < 512) prep_item(p, l, it, ldsh); else if (!rerun) rope_item(p, it - 512); }
      break;
    case 2: mixer_phase(p, l, lds, st, rerun); break;
    case 3: for (int it = blockIdx.x * 2 + hf; it < 512; it += gridDim.x * 2) post_item(p, l, it, ldsh); break;
    case 4: gemm_run<1>(p, l, (const bf16_t*)(p.ws + OFF_YMIX), (const bf16_t*)(p.ws + OFF_WOUT) + (size_t)l * D * D, D, D, lds); break;
    case 5: row_phase(p, 1, l); break;
    case 6: gemm_run<2>(p, l, H, (const bf16_t*)(p.ws + OFF_W1) + (size_t)l * FF * D, D, FF, lds); break;
    case 7: gemm_run<1>(p, l, (const bf16_t*)(p.ws + OFF_HID), (const bf16_t*)(p.ws + OFF_W2) + (size_t)l * D * FF, FF, D, lds); break;
    case 8: row_phase(p, 2, l); break;
  }
}

#define XB_TMO      128
#define XB_XCNT(j)  (256  + 64 * (j))
#define XB_XSUB(j)  (1280 + 64 * (j))
#define XB_XGEN(j)  (2304 + 64 * (j))
#define XB_TOP      3328
#define XB_TOPGEN   3392
#define XCD_BAR_WORDS 3456
#define XB_SPIN_CAP (1u << 18)
DEV unsigned xb_ld(unsigned* p) { return __hip_atomic_load(p, __ATOMIC_RELAXED, __HIP_MEMORY_SCOPE_AGENT); }
DEV unsigned xb_add(unsigned* p, unsigned v) { return __hip_atomic_fetch_add(p, v, __ATOMIC_RELAXED, __HIP_MEMORY_SCOPE_AGENT); }
DEV unsigned xb_xcc_id() { return (unsigned)__builtin_amdgcn_s_getreg((3 << 11) | 20) & 0xFu; }
#define XB_SPIN(cond, bar) do { unsigned _sp = 0; while (cond) { __builtin_amdgcn_s_sleep(1); \
    if ((++_sp & 255u) == 0u) { if (xb_ld(&(bar)[XB_TMO])) break; if (_sp > XB_SPIN_CAP) { atomicAdd(&(bar)[XB_TMO], 1u); break; } } } } while (0)
struct XcdBarrier { unsigned* bar; unsigned x; volatile LAS unsigned* st; };
DEV XcdBarrier xcd_barrier_post(unsigned* bar, volatile LAS unsigned* st) {
  XcdBarrier b; b.bar = bar; b.x = xb_xcc_id(); b.st = st;
  if (threadIdx.x == 0) (void)xb_add(&bar[XB_XCNT(b.x)], 1u);
  return b;
}
DEV void xcd_barrier_complete(unsigned* bar, unsigned x, unsigned& nloc, unsigned& nx) {
  const unsigned G = gridDim.x * gridDim.y * gridDim.z;
  unsigned sum, cnt, mine, sp = 0u;
  for (;;) {
    sum = 0u; cnt = 0u; mine = 0u;
#pragma unroll
    for (unsigned j = 0; j < 16; ++j) { const unsigned c = xb_ld(&bar[XB_XCNT(j)]); sum += c; cnt += (c > 0u) ? 1u : 0u; mine = (j == x) ? c : mine; }
    if (sum == G) break;
    __builtin_amdgcn_s_sleep(1);
    if ((++sp & 255u) == 0u) { if (xb_ld(&bar[XB_TMO])) break; if (sp > XB_SPIN_CAP) { atomicAdd(&bar[XB_TMO], 1u); break; } }
  }
  nloc = mine > 0u ? mine : 1u; nx = cnt > 0u ? cnt : 1u;
}
DEV void xcd_barrier(const XcdBarrier& b) {
  asm volatile("s_waitcnt vmcnt(0)" ::: "memory");
  __syncthreads();
  if (threadIdx.x == 0) {
    unsigned* bar = b.bar;
    { size_t zb_; asm volatile("s_mov_b64 %0, 0" : "=s"(zb_)); bar += zb_; }
    __builtin_amdgcn_s_waitcnt(0);
    unsigned nloc = b.st[0], nx = b.st[1];
    if (nloc == 0u) { xcd_barrier_complete(bar, b.x, nloc, nx); b.st[0] = nloc; b.st[1] = nx; }
    const unsigned old = xb_add(&bar[XB_XSUB(b.x)], 1u);
    const unsigned gen = old / nloc;
    if (old + 1u == (gen + 1u) * nloc) {
      __builtin_amdgcn_fence(__ATOMIC_RELEASE, "agent");
      asm volatile("s_waitcnt vmcnt(0)" ::: "memory");
      const unsigned og = xb_add(&bar[XB_TOP], 1u);
      const unsigned tg = og / nx;
      if (og + 1u == (tg + 1u) * nx) xb_add(&bar[XB_TOPGEN], 1u);
      else XB_SPIN(xb_ld(&bar[XB_TOPGEN]) == tg, bar);
      __builtin_amdgcn_fence(__ATOMIC_ACQUIRE, "agent");
      xb_add(&bar[XB_XGEN(b.x)], 1u);
      asm volatile("s_waitcnt vmcnt(0)" ::: "memory");
    } else {
      XB_SPIN(xb_ld(&bar[XB_XGEN(b.x)]) == gen, bar);
      __builtin_amdgcn_fence(__ATOMIC_ACQUIRE, "agent");
      asm volatile("s_waitcnt vmcnt(0)" ::: "memory");
    }
  }
  __syncthreads();
}

DEV int phase_kind(int ph) {
  if (ph == 0) return 0;
  if (ph == 1) return 1;
  const int s = (ph - 2) % 9;
  return s == 0 ? 2 : s == 1 ? 3 : s == 2 ? 4 : s == 3 ? 5 : s == 4 ? 6 : s == 5 ? 1 : s == 6 ? 7 : s == 7 ? 8 : 1;
}

constexpr int LDS_BYTES = 131072 + 64;

__global__ void __launch_bounds__(512, 2) mega(Params p, int ph_lo, int ph_hi) {
  extern __shared__ __attribute__((aligned(16))) unsigned char smem[];
  char* lds = (char*)smem;
  volatile LAS unsigned* st = (volatile LAS unsigned*)((LAS unsigned char*)smem + 131072);
  if (threadIdx.x == 0) { st[0] = 0u; st[1] = 0u; }
  __syncthreads();
  XcdBarrier xb = xcd_barrier_post((unsigned*)(p.ws + OFF_BAR), st);
  if (ph_hi < 0) cg::this_grid().sync();
  char* const ws0 = p.ws; float* const out0 = p.out;
  for (int ph = ph_lo; ph < ph_hi; ++ph) {
    { size_t z0_; asm volatile("s_mov_b64 %0, 0" : "=s"(z0_)); p.ws = ws0 + z0_; p.out = out0 + z0_; }
    run_phase(p, ph, lds, false, st);
    if (PROBE_KIND >= 0 && (PROBE_KIND == 9 || phase_kind(ph) == PROBE_KIND)) {
      xcd_barrier(xb);
      if (PROBE_KIND != 9) run_phase(p, ph, lds, true, st);
    }
    if (ph + 1 < ph_hi) xcd_barrier(xb);
  }
}

extern "C" void kernel_launch(void* const* d_in, const int* in_sizes, int n_in, void* d_out, int out_size, void* d_ws, size_t ws_size,
                              hipStream_t stream) {
  static int grid_blocks = 0;
  if (!grid_blocks) {
    int dev = 0, cus = 0, per_cu = 0;
    (void)hipGetDevice(&dev);
    (void)hipDeviceGetAttribute(&cus, hipDeviceAttributeMultiprocessorCount, dev);
    if (hipFuncSetAttribute((const void*)mega, hipFuncAttributeMaxDynamicSharedMemorySize, LDS_BYTES) != hipSuccess) fprintf(stderr, "hipFuncSetAttribute failed\n");
    (void)hipOccupancyMaxActiveBlocksPerMultiprocessor(&per_cu, mega, 512, LDS_BYTES);
    if (per_cu < 1) fprintf(stderr, "occupancy query reports %d blocks per CU\n", per_cu);
    (void)hipGetLastError();
    grid_blocks = cus;
  }
  if (ws_size < WS_TOTAL) { fprintf(stderr, "workspace too small: %zu < %zu\n", ws_size, (size_t)WS_TOTAL); return; }
  Params p{};
  for (int i = 0; i < 31; ++i) p.in[i] = (const float*)d_in[i];
  p.out = (float*)d_out;
  p.ws = (char*)d_ws;
  (void)hipMemsetAsync((char*)d_ws + OFF_BAR, 0, 16384, stream);
  int lo = 0, hi = NPH;
  void* args[] = {&p, &lo, &hi};
  hipError_t e = hipLaunchCooperativeKernel((void*)mega, dim3(grid_blocks), dim3(512), args, LDS_BYTES, stream);
  if (e != hipSuccess) fprintf(stderr, "cooperative launch failed: %s (grid %d)\n", hipGetErrorString(e), grid_blocks);
}
```

```cpp
#include <hip/hip_runtime.h>
#include <hip/hip_cooperative_groups.h>
#include <cstdio>
#include <cstdint>
namespace cg = cooperative_groups;

#ifndef ONE_LAUNCH
#define ONE_LAUNCH 1
#endif
#define PROBE_KIND -1
#define PROBE_SUB 0

#define DEV __device__ __forceinline__
#define LAS __attribute__((address_space(3)))
typedef unsigned short bf16_t;
typedef short bf16x8 __attribute__((ext_vector_type(8)));
typedef float f32x16 __attribute__((ext_vector_type(16)));
typedef __bf16 bf2_t __attribute__((ext_vector_type(2)));
typedef float f2_t __attribute__((ext_vector_type(2)));

constexpr int D = 1024, DIN = 3712, FF = 4096, NCTX = 8192, MT = 10240;
constexpr int NPH = 38;
constexpr int DINP = 3840;
constexpr int C_R = 0, C_K = 256, C_V = 512, C_GH = 768, C_WHF = 896, C_WHB = 1024;
constexpr int C_NQ = 1152, C_NK = 1408, C_NV = 1664;
constexpr int C_HQ = 1920, C_HI = 2176, C_HG = 2432, C_HFF = 2688, C_HFB = 2944;
constexpr int C_SQ = 3200, C_SK = 3456, C_SV = 3584;
constexpr size_t O_NAT = 10485760, O_SWA = 27262976, O_RW = 35651584, O_HG = 39845888;
constexpr size_t ARRF = (size_t)MT * 256;
constexpr size_t ARR = ARRF * 4;
constexpr size_t OFF_WIN = 0;
constexpr size_t OFF_WOUT = OFF_WIN + (size_t)4 * DINP * D * 2;
constexpr size_t OFF_W1 = OFF_WOUT + (size_t)4 * D * D * 2;
constexpr size_t OFF_W2 = OFF_W1 + (size_t)4 * FF * D * 2;
constexpr size_t OFF_MOD = OFF_W2 + (size_t)4 * FF * D * 2;
constexpr size_t OFF_HGLB = OFF_MOD + (size_t)4 * 3 * 6144 * 4;
constexpr size_t OFF_P = OFF_HGLB + 8192;
constexpr size_t OFF_R1 = OFF_P + (size_t)MT * DIN * 2;
constexpr size_t OFF_H = OFF_R1;
constexpr size_t OFF_HID = OFF_H + (size_t)MT * D * 2;
constexpr size_t OFF_U = OFF_HID + (size_t)MT * FF * 2;
constexpr size_t OFF_PREP = OFF_R1;
constexpr size_t OFF_YDIR = OFF_PREP + 12 * ARR;
constexpr size_t OFF_BONUS = OFF_R1 + 14 * ARR;
constexpr size_t OFF_HDIR = OFF_BONUS + ARR / 2;
constexpr size_t OFF_YMIX = OFF_HDIR + 2 * ARR;
constexpr size_t OFF_X16 = OFF_YMIX + (size_t)MT * D * 2;
constexpr size_t OFF_BAR = OFF_X16 + (size_t)MT * D * 2;
constexpr size_t OFF_W2T = OFF_BAR + 16384;
constexpr size_t OFF_A2T = OFF_W2T + (size_t)4 * 2 * 256 * 64 * 2;
constexpr size_t OFF_G2T = OFF_A2T + (size_t)4 * 2 * 256 * 64 * 2;
constexpr size_t WS_TOTAL = OFF_G2T + (size_t)4 * 256 * 128 * 2;
static_assert(OFF_U + (size_t)MT * D * 4 == OFF_BONUS, "R1 layout");

struct Params {
  const float* in[31];
  float* out;
  char* ws;
};
enum { I_XP = 0, I_XS, I_CNAT, I_CSWA, I_SRW, I_SHG, I_C, I_CCTX, I_NORMG, I_MODW, I_MODB, I_WIN, I_WOUT, I_MURKV, I_MULORA,
       I_W0, I_W2, I_A0, I_A2, I_G2, I_KK, I_KA, I_RK, I_LNW, I_LNB, I_RPB, I_HGLB, I_HGN, I_SINK, I_FW1, I_FW2 };

DEV bf16_t f2bf(float f) { unsigned u = __float_as_uint(f); u += 0x7fffu + ((u >> 16) & 1u); return (bf16_t)(u >> 16); }
DEV float bf2f(bf16_t h) { return __uint_as_float(((unsigned)h) << 16); }
DEV unsigned pk2(float a, float b) { f2_t v = {a, b}; bf2_t r = __builtin_convertvector(v, bf2_t); return __builtin_bit_cast(unsigned, r); }
DEV float4 bf4(uint2 u) { return make_float4(__uint_as_float(u.x << 16), __uint_as_float(u.x & 0xffff0000u), __uint_as_float(u.y << 16), __uint_as_float(u.y & 0xffff0000u)); }
DEV float bflo(unsigned u) { return __uint_as_float(u << 16); }
DEV float bfhi(unsigned u) { return __uint_as_float(u & 0xffff0000u); }
DEV float rcpf_(float x) { return __builtin_amdgcn_rcpf(x); }
DEV float sigmoidf_(float x) { return rcpf_(1.0f + __expf(-x)); }
DEV float tanhf_(float x) { return 1.0f - 2.0f * rcpf_(1.0f + __expf(2.0f * x)); }
template <int CTRL> DEV float dppf(float x) { return __int_as_float(__builtin_amdgcn_update_dpp(0, __float_as_int(x), CTRL, 0xF, 0xF, false)); }
DEV float row16_sum(float x) { x += dppf<0xB1>(x); x += dppf<0x4E>(x); x += dppf<0x141>(x); x += dppf<0x140>(x); return x; }
DEV float wave_sum(float x) { x = row16_sum(x); x += __shfl_xor(x, 16); x += __shfl_xor(x, 32); return x; }
DEV int clampi(int v, int lo, int hi) { return v < lo ? lo : (v > hi ? hi : v); }
#define MFMA32(a, b, c) __builtin_amdgcn_mfma_f32_32x32x16_bf16((a), (b), (c), 0, 0, 0)

DEV int tid() { int z; asm volatile("v_mov_b32 %0, 0" : "=v"(z)); return (int)(threadIdx.x & 255u) + z; }
DEV int half_id() { return __builtin_amdgcn_readfirstlane((int)(threadIdx.x >> 8)); }
DEV void transpose_item(const float* W, bf16_t* WT, int K, int N, int kt, int nt, char* lds) {
  bf16_t* s = (bf16_t*)lds;
  const int t = tid();
#pragma unroll
  for (int i = 0; i < 4; ++i) {
    const int k = (t >> 4) + 16 * i, n4 = (t & 15) * 4;
    const float4 v = *(const float4*)(W + (size_t)(kt * 64 + k) * N + nt * 64 + n4);
    s[(n4 + 0) * 72 + k] = f2bf(v.x); s[(n4 + 1) * 72 + k] = f2bf(v.y);
    s[(n4 + 2) * 72 + k] = f2bf(v.z); s[(n4 + 3) * 72 + k] = f2bf(v.w);
  }
  __syncthreads();
#pragma unroll
  for (int i = 0; i < 2; ++i) {
    const int n = (t >> 3) + 32 * i, kc = t & 7;
    const uint4 v = *(const uint4*)(s + n * 72 + kc * 8);
    *(uint4*)(WT + (size_t)(nt * 64 + n) * K + kt * 64 + kc * 8) = v;
  }
  __syncthreads();
}

DEV void mod_item(const Params& p, int l, int jb, char* lds) {
  float* sc = (float*)lds;
  float* red = (float*)(lds + 12288);
  const int t = tid();
  for (int i = t; i < 3072; i += 256) {
    const int c = i >> 10, k = i & 1023;
    const float x = (c == 0) ? p.in[I_CCTX][k] : p.in[I_C][(c - 1) * 1024 + k];
    sc[i] = x * rcpf_(1.0f + __expf(-x));
  }
  __syncthreads();
  const int c4 = t & 15, ks = t >> 4;
  const float* wp = p.in[I_MODW] + ((size_t)l * 1024 + ks * 64) * 6144 + jb * 64 + c4 * 4;
  float a00 = 0, a01 = 0, a02 = 0, a03 = 0, a10 = 0, a11 = 0, a12 = 0, a13 = 0, a20 = 0, a21 = 0, a22 = 0, a23 = 0;
#pragma unroll 16
  for (int ii = 0; ii < 64; ++ii) {
    const float4 w = *(const float4*)(wp + (size_t)ii * 6144);
    const int k = ks * 64 + ii;
    const float s0 = sc[k], s1 = sc[1024 + k], s2 = sc[2048 + k];
    a00 += s0 * w.x; a01 += s0 * w.y; a02 += s0 * w.z; a03 += s0 * w.w;
    a10 += s1 * w.x; a11 += s1 * w.y; a12 += s1 * w.z; a13 += s1 * w.w;
    a20 += s2 * w.x; a21 += s2 * w.y; a22 += s2 * w.z; a23 += s2 * w.w;
  }
  float* r0 = red + (ks * 3 + 0) * 64 + c4 * 4; r0[0] = a00; r0[1] = a01; r0[2] = a02; r0[3] = a03;
  float* r1 = red + (ks * 3 + 1) * 64 + c4 * 4; r1[0] = a10; r1[1] = a11; r1[2] = a12; r1[3] = a13;
  float* r2 = red + (ks * 3 + 2) * 64 + c4 * 4; r2[0] = a20; r2[1] = a21; r2[2] = a22; r2[3] = a23;
  __syncthreads();
  if (t < 192) {
    const int c = t >> 6, col = t & 63;
    float v = p.in[I_MODB][l * 6144 + jb * 64 + col];
#pragma unroll
    for (int k2 = 0; k2 < 16; ++k2) v += red[(k2 * 3 + c) * 64 + col];
    ((float*)(p.ws + OFF_MOD))[(size_t)(l * 3 + c) * 6144 + jb * 64 + col] = v;
  }
  __syncthreads();
}

DEV void hglb_item(const Params& p) {
  const int c = tid();
  float* HGLB = (float*)(p.ws + OFF_HGLB);
  for (int dir = 0; dir < 2; ++dir) {
    float x[4], mx = -1e30f;
    for (int l = 0; l < 4; ++l) { x[l] = p.in[I_HGLB][(dir * 4 + l) * 256 + c]; mx = fmaxf(mx, x[l]); }
    float s = 0;
    for (int l = 0; l < 4; ++l) { x[l] = __expf(x[l] - mx); s += x[l]; }
    float cum = 0; const float s0 = x[0] / s;
    for (int l = 0; l < 4; ++l) { cum += x[l] / s; HGLB[(l * 2 + dir) * 256 + c] = cum - s0; }
  }
}

constexpr int NT_LAYER = 928 + 256 + 1024 + 1024;
struct TileDesc { const float* W; bf16_t* WT; int K, N, kt, nt; };
DEV TileDesc layer_tile_desc(const Params& p, int l, int j) {
  TileDesc d;
  if (j < 928) { d.W = p.in[I_WIN] + (size_t)l * D * DIN; d.WT = (bf16_t*)(p.ws + OFF_WIN) + (size_t)l * DINP * D; d.K = D; d.N = DIN; d.kt = j / 58; d.nt = j % 58; return d; }
  j -= 928;
  if (j < 256) { d.W = p.in[I_WOUT] + (size_t)l * D * D; d.WT = (bf16_t*)(p.ws + OFF_WOUT) + (size_t)l * D * D; d.K = D; d.N = D; d.kt = j / 16; d.nt = j % 16; return d; }
  j -= 256;
  if (j < 1024) { d.W = p.in[I_FW1] + (size_t)l * D * FF; d.WT = (bf16_t*)(p.ws + OFF_W1) + (size_t)l * FF * D; d.K = D; d.N = FF; d.kt = j / 64; d.nt = j % 64; return d; }
  j -= 1024;
  d.W = p.in[I_FW2] + (size_t)l * FF * D; d.WT = (bf16_t*)(p.ws + OFF_W2) + (size_t)l * D * FF; d.K = FF; d.N = D; d.kt = j / 16; d.nt = j % 16; return d;
}
DEV void tile_load(const TileDesc& d, float4 (&v)[4]) {
  const int t = tid();
#pragma unroll
  for (int i = 0; i < 4; ++i) v[i] = *(const float4*)(d.W + (size_t)(d.kt * 64 + (t >> 4) + 16 * i) * d.N + d.nt * 64 + (t & 15) * 4);
}
DEV void tile_store(const TileDesc& d, const float4 (&v)[4], char* lds) {
  bf16_t* s = (bf16_t*)lds;
  const int t = tid();
#pragma unroll
  for (int i = 0; i < 4; ++i) {
    const int k = (t >> 4) + 16 * i, n4 = (t & 15) * 4;
    s[(n4 + 0) * 72 + k] = f2bf(v[i].x); s[(n4 + 1) * 72 + k] = f2bf(v[i].y);
    s[(n4 + 2) * 72 + k] = f2bf(v[i].z); s[(n4 + 3) * 72 + k] = f2bf(v[i].w);
  }
  __syncthreads();
#pragma unroll
  for (int i = 0; i < 2; ++i) {
    const int n = (t >> 3) + 32 * i, kc = t & 7;
    const uint4 o = *(const uint4*)(s + n * 72 + kc * 8);
    *(uint4*)(d.WT + (size_t)(d.nt * 64 + n) * d.K + d.kt * 64 + kc * 8) = o;
  }
  __syncthreads();
}
DEV void layer_tiles(const Params& p, int l, int lo, int hi, int vb, int nvb, char* lds0) {
  const int hf = half_id(); char* lds = lds0 + hf * 65536;
  int it = lo + vb * 2 + hf;
  if (it >= hi) return;
  float4 vn[4];
  TileDesc dn = layer_tile_desc(p, l, it);
  tile_load(dn, vn);
  for (; it < hi; it += nvb * 2) {
    float4 vc[4] = {vn[0], vn[1], vn[2], vn[3]};
    const TileDesc dc = dn;
    if (it + nvb * 2 < hi) { dn = layer_tile_desc(p, l, it + nvb * 2); tile_load(dn, vn); }
    tile_store(dc, vc, lds);
  }
}

DEV void phase0(const Params& p, char* lds0) {
  const int hf = half_id(); char* lds = lds0 + hf * 65536;
  const int nitems = 386 + 4 + 20;
  for (int it = blockIdx.x * 2 + hf; it < nitems; it += gridDim.x * 2) {
    if (it < 384) { mod_item(p, it / 96, it % 96, lds); continue; }
    if (it == 384) { hglb_item(p); continue; }
    if (it == 385) continue;
    const int j = it - 386;
    if (j >= 4) {
      const int s = j - 4, n = tid();
      const float* src; bf16_t* dst; int KK;
      if (s < 8) { src = p.in[I_W2] + (size_t)s * 64 * 256; dst = (bf16_t*)(p.ws + OFF_W2T) + (size_t)s * 256 * 64; KK = 64; }
      else if (s < 16) { src = p.in[I_A2] + (size_t)(s - 8) * 64 * 256; dst = (bf16_t*)(p.ws + OFF_A2T) + (size_t)(s - 8) * 256 * 64; KK = 64; }
      else { src = p.in[I_G2] + (size_t)(s - 16) * 128 * 256; dst = (bf16_t*)(p.ws + OFF_G2T) + (size_t)(s - 16) * 256 * 128; KK = 128; }
      for (int k0 = 0; k0 < KK; k0 += 8) {
        float v[8];
#pragma unroll
        for (int e = 0; e < 8; ++e) v[e] = src[(size_t)(k0 + e) * 256 + n];
        uint4 o; o.x = pk2(v[0], v[1]); o.y = pk2(v[2], v[3]); o.z = pk2(v[4], v[5]); o.w = pk2(v[6], v[7]);
        *(uint4*)(dst + (size_t)n * KK + k0) = o;
      }
      continue;
    }
    {
      uint4* z = (uint4*)((bf16_t*)(p.ws + OFF_WIN) + ((size_t)j * DINP + DIN) * D);
      const int t = tid();
      for (int i = t; i < 128 * D * 2 / 16; i += 256) z[i] = make_uint4(0u, 0u, 0u, 0u);
    }
  }
  const int vb = ((int)blockIdx.x + (int)gridDim.x - 195 % (int)gridDim.x) % (int)gridDim.x;
  layer_tiles(p, 0, 0, NT_LAYER, vb, (int)gridDim.x, lds0);
  if ((int)gridDim.x <= 160) { for (int ll = 1; ll < 4; ++ll) layer_tiles(p, ll, 0, NT_LAYER, (int)blockIdx.x, (int)gridDim.x, lds0); }
}

constexpr int RPW = 5;
DEV void row_phase(const Params& p, int mode, int l) {
  const int lane = tid() & 63;
  const int nw = gridDim.x * 8;
  const float* MOD = (const float*)(p.ws + OFF_MOD);
  const float* NG = p.in[I_NORMG];
  const bf16_t* U = (const bf16_t*)(p.ws + OFF_U);
  bf16_t* H = (bf16_t*)(p.ws + OFF_H);
  bf16_t* X16 = (bf16_t*)(p.ws + OFF_X16);
  const bool has_next = !(mode == 2 && l == 3);
  const int ln = (mode == 0) ? 0 : (mode == 1 ? l : l + 1);
  const int gi = (mode == 1) ? 2 : 0, shi = (mode == 1) ? 3 : 0, sci = (mode == 1) ? 4 : 1;
  const float* ga = NG + (size_t)(l * 4 + (mode == 1 ? 1 : 3)) * 1024;
  const float* gb = NG + (size_t)((has_next ? ln : 0) * 4 + gi) * 1024;
  for (int rowa = blockIdx.x * 8 + half_id() * 4 + (tid() >> 6); rowa < MT; rowa += RPW * nw) {
    float4 x[RPW][4]; uint2 ub[RPW][4];
    int rows[RPW]; bool ok[RPW];
#pragma unroll
    for (int q = 0; q < RPW; ++q) {
      rows[q] = rowa + q * nw; ok[q] = rows[q] < MT;
      const int row = ok[q] ? rows[q] : rowa;
      if (mode == 0) {
        const float* src = row < NCTX ? p.in[I_XP] + (size_t)row * D : p.in[I_XS] + (size_t)(row - NCTX) * D;
#pragma unroll
        for (int i = 0; i < 4; ++i) x[q][i] = *(const float4*)(src + i * 256 + lane * 4);
      } else {
#pragma unroll
        for (int i = 0; i < 4; ++i) {
          const uint2 xb = *(const uint2*)(X16 + (size_t)row * D + i * 256 + lane * 4);
          x[q][i] = make_float4(bflo(xb.x), bfhi(xb.x), bflo(xb.y), bfhi(xb.y));
          ub[q][i] = *(const uint2*)(U + (size_t)row * D + i * 256 + lane * 4);
        }
      }
    }
#pragma unroll
    for (int q = 0; q < RPW; ++q) {
      const int row = ok[q] ? rows[q] : rowa;
      const int cond = row < NCTX ? 0 : 1 + ((row - NCTX) >> 10);
      if (mode != 0) {
        float4 u[4];
        float ss = 0;
#pragma unroll
        for (int i = 0; i < 4; ++i) {
          u[i] = make_float4(bflo(ub[q][i].x), bfhi(ub[q][i].x), bflo(ub[q][i].y), bfhi(ub[q][i].y));
          ss += u[i].x * u[i].x + u[i].y * u[i].y + u[i].z * u[i].z + u[i].w * u[i].w;
        }
        ss = wave_sum(ss);
        const float r = rsqrtf(ss * (1.0f / 1024.0f) + 1e-6f);
        const float* gate = MOD + (size_t)(l * 3 + cond) * 6144 + (mode == 1 ? 2 : 5) * 1024;
#pragma unroll
        for (int i = 0; i < 4; ++i) {
          const float4 g4 = *(const float4*)(gate + i * 256 + lane * 4);
          const float4 a4 = *(const float4*)(ga + i * 256 + lane * 4);
          x[q][i].x += g4.x * (u[i].x * r * a4.x); x[q][i].y += g4.y * (u[i].y * r * a4.y);
          x[q][i].z += g4.z * (u[i].z * r * a4.z); x[q][i].w += g4.w * (u[i].w * r * a4.w);
        }
      }
      if (ok[q]) {
        if (has_next) {
#pragma unroll
          for (int i = 0; i < 4; ++i) { uint2 o; o.x = pk2(x[q][i].x, x[q][i].y); o.y = pk2(x[q][i].z, x[q][i].w); *(uint2*)(X16 + (size_t)row * D + i * 256 + lane * 4) = o; }
        } else {
#pragma unroll
          for (int i = 0; i < 4; ++i) *(float4*)(p.out + (size_t)row * D + i * 256 + lane * 4) = x[q][i];
        }
      }
      if (has_next) {
        float ss = 0;
#pragma unroll
        for (int i = 0; i < 4; ++i) ss += x[q][i].x * x[q][i].x + x[q][i].y * x[q][i].y + x[q][i].z * x[q][i].z + x[q][i].w * x[q][i].w;
        ss = wave_sum(ss);
        const float r2 = rsqrtf(ss * (1.0f / 1024.0f) + 1e-6f);
        const float* sh = MOD + (size_t)(ln * 3 + cond) * 6144 + shi * 1024;
        const float* sc = MOD + (size_t)(ln * 3 + cond) * 6144 + sci * 1024;
        if (ok[q]) {
#pragma unroll
          for (int i = 0; i < 4; ++i) {
            const float4 g4 = *(const float4*)(gb + i * 256 + lane * 4);
            const float4 s4 = *(const float4*)(sc + i * 256 + lane * 4);
            const float4 h4 = *(const float4*)(sh + i * 256 + lane * 4);
            const float h0 = x[q][i].x * r2 * g4.x * (1.0f + s4.x) + h4.x;
            const float h1 = x[q][i].y * r2 * g4.y * (1.0f + s4.y) + h4.y;
            const float h2 = x[q][i].z * r2 * g4.z * (1.0f + s4.z) + h4.z;
            const float h3 = x[q][i].w * r2 * g4.w * (1.0f + s4.w) + h4.w;
            uint2 o; o.x = pk2(h0, h1); o.y = pk2(h2, h3);
            *(uint2*)(H + (size_t)row * D + i * 256 + lane * 4) = o;
          }
        }
      }
    }
  }
}

namespace pg8 {
#define PG8_LAS __attribute__((address_space(3)))
typedef unsigned short bf16_t;
typedef short bf16x8 __attribute__((ext_vector_type(8)));
typedef float f32x4 __attribute__((ext_vector_type(4)));
typedef unsigned u32x4 __attribute__((ext_vector_type(4)));
constexpr int BM = 256, BK = 64, HALF = 128, HTB = HALF * BK * 2  , STAGE_BYTES = 8 * HTB, NXCD = 8, WGM = 8;

__host__ __device__ __forceinline__ int lds_byte(int r, int c) { const int st = (r >> 4) * 2 + (c >> 5), rr = r & 15, cc = c & 31, ob = rr * 64 + cc * 2; return st * 1024 + (ob ^ (((ob >> 9) & 1) << 5)); }
__host__ __device__ __forceinline__ void stage_rc(int b, int& R, int& C) { const int st = b / 1024, sb = b % 1024, swz = sb ^ (((sb >> 9) & 1) << 5); R = (st >> 1) * 16 + swz / 64; C = (st & 1) * 32 + (swz % 64) / 2; }
__host__ __device__ __forceinline__ int perm32(int rho) { const int n = rho >> 4, i = rho & 15; return 8 * (i >> 2) + 4 * n + (i & 3); }

struct Unit { int pm, pn; };
struct Gemm { const bf16_t* A; const bf16_t* Bt; int M, N, K; };

struct StaticOrder {
    int nM, nN, nwg, G, c;
    __host__ __device__ void init(int M, int N, int G_, int c_) { nM = M / BM; nN = N / BM; nwg = nM * nN; G = G_; c = c_; }
    __host__ __device__ bool next(int i, Unit& u) const {
        const long L = (long)i * G + c; if (L >= nwg) return false;
        int wgid = (int)L; { const int q = nwg / NXCD, r = nwg % NXCD, xcd = wgid % NXCD, off = wgid / NXCD; wgid = (xcd < r ? xcd * (q + 1) : r * (q + 1) + (xcd - r) * q) + off; }
        const int nig = WGM * nN, gid = wgid / nig, fm = gid * WGM, gsz = (nM - fm) < WGM ? (nM - fm) : WGM;
        u.pm = fm + ((wgid % nig) % gsz); u.pn = (wgid % nig) / gsz; return true;
    }
    __device__ __forceinline__ void a_ready(const Unit&) const {}
    __device__ __forceinline__ void done(const Unit&) const {}
};

template <class Epi, class Sched, bool ALIGN_EPI = false, bool SP2 = false>
__device__ __forceinline__ void gemm_phase(PG8_LAS unsigned char* lds, const Gemm g, const Sched& S, const Epi& E) {
    int tid_z; asm volatile("v_mov_b32 %0, 0" : "=v"(tid_z)); const int tid = (int)threadIdx.x + tid_z, wid = __builtin_amdgcn_readfirstlane(tid >> 6), lane = tid & 63, wr = wid >> 2, wc = wid & 3, fr = lane & 15, fq = lane >> 4;
    const int K = g.K, nt = K / BK;
    unsigned voffA[2], voffB[2];
#pragma unroll
    for (int i = 0; i < 2; ++i) { int R, C; stage_rc(tid * 16 + i * 8192, R, C); const int Rb = Epi::PERM ? ((R & ~31) + perm32(R & 31)) : R;
        voffA[i] = (unsigned)(R * K + C) * 2u; voffB[i] = (unsigned)(Rb * K + C) * 2u; }
    const size_t kstep = (size_t)(BK * 2);
    const size_t hstep = (size_t)HALF * K * 2;
    const size_t tstep = 2 * hstep;
    const unsigned ldsw = (unsigned)wid * 1024u;
    const int aoff = lds_byte(wr * 64 + fr, fq * 8), boff = lds_byte(wc * 32 + fr, fq * 8);
#define PG8_SA(b, h) (((b) * 2 + (h)) * HTB)
#define PG8_SB(b, h) ((4 + (b) * 2 + (h)) * HTB)
#define PG8_STAGE(bufoff, gbase, voff) do { _Pragma("unroll") for (int _i = 0; _i < 2; ++_i) \
        __builtin_amdgcn_global_load_lds((const unsigned*)((const char*)(gbase) + (voff)[_i]), (PG8_LAS unsigned*)(lds + (bufoff) + ldsw + _i * 8192), 16, 0, 0); } while (0)
#define PG8_LDA(dst, b, h) do { _Pragma("unroll") for (int m = 0; m < 4; ++m) _Pragma("unroll") for (int k = 0; k < 2; ++k) dst[m][k] = *(const PG8_LAS bf16x8*)(lds + PG8_SA(b, h) + aoff + m * 2048 + k * 1024); } while (0)
#define PG8_LDB(dst, b, h) do { _Pragma("unroll") for (int n = 0; n < 2; ++n) _Pragma("unroll") for (int k = 0; k < 2; ++k) dst[n][k] = *(const PG8_LAS bf16x8*)(lds + PG8_SB(b, h) + boff + n * 2048 + k * 1024); } while (0)
#define PG8_MMA(ai, bj, At, Bt) do { __builtin_amdgcn_s_setprio(1); _Pragma("unroll") for (int m = 0; m < 4; ++m) _Pragma("unroll") for (int n = 0; n < 2; ++n) _Pragma("unroll") for (int k = 0; k < 2; ++k) \
        acc[ai][bj][m][n] = __builtin_amdgcn_mfma_f32_16x16x32_bf16(Bt[n][k], At[m][k], acc[ai][bj][m][n], 0, 0, 0); __builtin_amdgcn_s_setprio(0); } while (0)
#define PG8_WAIT_V(n) asm volatile("s_waitcnt vmcnt(" #n ")" ::: "memory")
#define PG8_WAIT_L(n) asm volatile("s_waitcnt lgkmcnt(" #n ")" ::: "memory")
#define PG8_BAR __builtin_amdgcn_s_barrier()
#define PG8_SCHED __builtin_amdgcn_sched_barrier(0)
    Unit cur, nxt; int ui = 0;
    if (!S.next(0, cur)) return;
    f32x4 acc[2][2][4][2];
#pragma unroll
    for (int a = 0; a < 2; ++a)
#pragma unroll
        for (int b = 0; b < 2; ++b)
#pragma unroll
            for (int m = 0; m < 4; ++m)
#pragma unroll
                for (int n = 0; n < 2; ++n) acc[a][b][m][n] = (f32x4){0.f, 0.f, 0.f, 0.f};
    bf16x8 At[4][2], B0[2][2], B1[2][2];
    const char* cA = (const char*)g.A + (size_t)cur.pm * tstep; const char* cB = (const char*)g.Bt + (size_t)cur.pn * tstep;
    S.a_ready(cur);
    if constexpr (SP2) {
        PG8_STAGE(PG8_SB(0, 0), cB, voffB); PG8_STAGE(PG8_SB(0, 1), cB + hstep, voffB); PG8_STAGE(PG8_SA(0, 0), cA, voffA); PG8_STAGE(PG8_SA(0, 1), cA + hstep, voffA);
        if (wr == 1) PG8_BAR;
        PG8_WAIT_V(2); PG8_BAR;
        PG8_STAGE(PG8_SB(1, 0), cB + kstep, voffB); PG8_STAGE(PG8_SA(1, 0), cA + kstep, voffA); PG8_STAGE(PG8_SB(1, 1), cB + hstep + kstep, voffB);
        PG8_WAIT_V(6); PG8_BAR;
    } else {
        PG8_STAGE(PG8_SB(0, 0), cB, voffB); PG8_STAGE(PG8_SA(0, 0), cA, voffA); PG8_STAGE(PG8_SB(0, 1), cB + hstep, voffB); PG8_STAGE(PG8_SA(0, 1), cA + hstep, voffA);
        if (wr == 1) PG8_BAR;
        PG8_WAIT_V(4); PG8_BAR;
        PG8_STAGE(PG8_SB(1, 0), cB + kstep, voffB); PG8_STAGE(PG8_SA(1, 0), cA + kstep, voffA); PG8_STAGE(PG8_SB(1, 1), cB + hstep + kstep, voffB);
        PG8_WAIT_V(6); PG8_BAR;
    }
    for (;;) {
        const bool has_next = S.next(ui + 1, nxt);
        const char* nA = has_next ? (const char*)g.A + (size_t)nxt.pm * tstep : cA; const char* nB = has_next ? (const char*)g.Bt + (size_t)nxt.pn * tstep : cB;
        for (int t = 0; t < nt; t += 2) {
            const bool last = (t == nt - 2);
            const char* a1 = cA + (size_t)(t + 1) * kstep;
            const char* a2 = last ? nA : cA + (size_t)(t + 2) * kstep; const char* b2 = last ? nB : cB + (size_t)(t + 2) * kstep;
            const char* a3 = a2 + kstep; const char* b3 = b2 + kstep;
            if (last && has_next) S.a_ready(nxt);
            if constexpr (SP2) {
            PG8_LDB(B0, 0, 0); PG8_LDB(B1, 0, 1); PG8_SCHED; PG8_LDA(At, 0, 0); PG8_STAGE(PG8_SA(1, 1), a1 + hstep, voffA);
            PG8_WAIT_V(8); PG8_WAIT_L(0); PG8_BAR; PG8_MMA(0, 0, At, B0); PG8_MMA(0, 1, At, B1); PG8_BAR; PG8_SCHED;
            PG8_LDA(At, 0, 1); PG8_STAGE(PG8_SB(0, 0), b2, voffB); PG8_STAGE(PG8_SB(0, 1), b2 + hstep, voffB); PG8_STAGE(PG8_SA(0, 0), a2, voffA);
            PG8_WAIT_V(8); PG8_WAIT_L(0); PG8_BAR; PG8_MMA(1, 0, At, B0); PG8_MMA(1, 1, At, B1); PG8_BAR; PG8_SCHED;
            PG8_LDB(B0, 1, 0); PG8_LDB(B1, 1, 1); PG8_SCHED; PG8_LDA(At, 1, 0); PG8_STAGE(PG8_SA(0, 1), a2 + hstep, voffA);
            PG8_WAIT_V(8); PG8_WAIT_L(0); PG8_BAR; PG8_MMA(0, 0, At, B0); PG8_MMA(0, 1, At, B1); PG8_BAR; PG8_SCHED;
            PG8_LDA(At, 1, 1); PG8_STAGE(PG8_SB(1, 0), b3, voffB); PG8_STAGE(PG8_SB(1, 1), b3 + hstep, voffB); PG8_STAGE(PG8_SA(1, 0), a3, voffA);
            PG8_WAIT_V(8); PG8_WAIT_L(0); PG8_BAR; PG8_MMA(1, 0, At, B0); PG8_MMA(1, 1, At, B1); PG8_BAR; PG8_SCHED;
            } else {
            PG8_LDB(B0, 0, 0); PG8_SCHED; PG8_LDA(At, 0, 0); PG8_STAGE(PG8_SA(1, 1), a1 + hstep, voffA);
            PG8_WAIT_L(8); PG8_BAR; PG8_WAIT_L(0); PG8_MMA(0, 0, At, B0); PG8_BAR; PG8_SCHED;
            PG8_LDB(B1, 0, 1); PG8_STAGE(PG8_SB(0, 0), b2, voffB);
            PG8_BAR; PG8_WAIT_L(0); PG8_MMA(0, 1, At, B1); PG8_BAR;
            PG8_LDA(At, 0, 1); PG8_STAGE(PG8_SA(0, 0), a2, voffA);
            PG8_BAR; PG8_WAIT_L(0); PG8_MMA(1, 0, At, B0); PG8_BAR; PG8_SCHED;
            PG8_STAGE(PG8_SB(0, 1), b2 + hstep, voffB);
            PG8_WAIT_V(6); PG8_BAR; PG8_MMA(1, 1, At, B1); PG8_BAR;
            PG8_LDB(B0, 1, 0); PG8_SCHED; PG8_LDA(At, 1, 0); PG8_STAGE(PG8_SA(0, 1), a2 + hstep, voffA);
            PG8_WAIT_L(8); PG8_BAR; PG8_WAIT_L(0); PG8_MMA(0, 0, At, B0); PG8_BAR; PG8_SCHED;
            PG8_LDB(B1, 1, 1); PG8_STAGE(PG8_SB(1, 0), b3, voffB);
            PG8_BAR; PG8_WAIT_L(0); PG8_MMA(0, 1, At, B1); PG8_BAR;
            PG8_LDA(At, 1, 1); PG8_STAGE(PG8_SA(1, 0), a3, voffA);
            PG8_BAR; PG8_WAIT_L(0); PG8_MMA(1, 0, At, B0); PG8_BAR; PG8_SCHED;
            PG8_STAGE(PG8_SB(1, 1), b3 + hstep, voffB);
            PG8_WAIT_V(6); PG8_BAR; PG8_MMA(1, 1, At, B1); PG8_BAR;
            }
        }
        if constexpr (ALIGN_EPI) { if (wr == 0) PG8_BAR; }
        if constexpr (!Epi::AFTER_DRAIN) { E(acc, cur, wr, wc, fr, fq); S.done(cur); }
        if (!has_next) break;
#pragma unroll
        for (int a = 0; a < 2; ++a)
#pragma unroll
            for (int b = 0; b < 2; ++b)
#pragma unroll
                for (int m = 0; m < 4; ++m)
#pragma unroll
                    for (int n = 0; n < 2; ++n) acc[a][b][m][n] = (f32x4){0.f, 0.f, 0.f, 0.f};
        cur = nxt; cA = nA; cB = nB; ++ui;
        if constexpr (ALIGN_EPI) { if (wr == 1) PG8_BAR; }
    }
    PG8_WAIT_V(0);
    if constexpr (!ALIGN_EPI) { if (wr == 0) PG8_BAR; }
    PG8_BAR;
    if constexpr (Epi::AFTER_DRAIN) { E.fused(acc, cur, wr, wc, fr, fq, lds, wid, lane); S.done(cur); }
#undef PG8_SA
#undef PG8_SB
#undef PG8_STAGE
#undef PG8_LDA
#undef PG8_LDB
#undef PG8_MMA
#undef PG8_WAIT_V
#undef PG8_WAIT_L
#undef PG8_BAR
#undef PG8_SCHED
}
}

template <int MODE> struct EpiMK {
  static constexpr bool PERM = true, AFTER_DRAIN = false;
  const Params* pp; int l;
  DEV void operator()(const pg8::f32x4 (&acc)[2][2][4][2], const pg8::Unit& u, int wr, int wc, int fr, int fq) const {
    const Params& p = *pp;
#pragma unroll
    for (int ai = 0; ai < 2; ++ai)
#pragma unroll
      for (int m = 0; m < 4; ++m) {
        const int row = u.pm * 256 + ai * 128 + wr * 64 + m * 16 + fr;
#pragma unroll
        for (int bj = 0; bj < 2; ++bj) {
          const int col = u.pn * 256 + bj * 128 + wc * 32 + fq * 8;
          const pg8::f32x4 v0 = acc[ai][bj][m][0], v1 = acc[ai][bj][m][1];
          if (MODE == 0) {
            if (col < DIN) {
              uint4 o; o.x = pk2(v0[0], v0[1]); o.y = pk2(v0[2], v0[3]); o.z = pk2(v1[0], v1[1]); o.w = pk2(v1[2], v1[3]);
              *(uint4*)((bf16_t*)(p.ws + OFF_P) + (size_t)row * DIN + col) = o;
              if (row < NCTX) {
                if (col >= C_NK && col < C_HQ) {
                  const int kv = col >= C_NV;
                  float* dst = p.out + O_NAT + (size_t)(((row >> 8) * 4 + l) * 2 + kv) * 65536 + (row & 255) * 256 + (col - (kv ? C_NV : C_NK));
                  *(pg8::f32x4*)dst = v0; *(pg8::f32x4*)(dst + 4) = v1;
                } else if (col >= C_SK) {
                  const int kv = col >= C_SV;
                  float* dst = p.out + O_SWA + (size_t)(((row >> 8) * 4 + l) * 2 + kv) * 32768 + (row & 255) * 128 + (col - (kv ? C_SV : C_SK));
                  *(pg8::f32x4*)dst = v0; *(pg8::f32x4*)(dst + 4) = v1;
                }
              }
            }
          } else if (MODE == 1) {
            uint4 o; o.x = pk2(v0[0], v0[1]); o.y = pk2(v0[2], v0[3]); o.z = pk2(v1[0], v1[1]); o.w = pk2(v1[2], v1[3]);
            *(uint4*)((bf16_t*)(p.ws + OFF_U) + (size_t)row * D + col) = o;
          } else {
            float r[8];
#pragma unroll
            for (int e = 0; e < 4; ++e) { const float a = fmaxf(v0[e], 0.f), b2 = fmaxf(v1[e], 0.f); r[e] = a * a; r[4 + e] = b2 * b2; }
            uint4 o; o.x = pk2(r[0], r[1]); o.y = pk2(r[2], r[3]); o.z = pk2(r[4], r[5]); o.w = pk2(r[6], r[7]);
            *(uint4*)((bf16_t*)(p.ws + OFF_HID) + (size_t)row * FF + col) = o;
          }
        }
      }
  }
};

template <int MODE>
DEV void gemm_run(const Params& p, int l, const bf16_t* A, const bf16_t* BT, int K, int N, char* lds) {
  pg8::Gemm g{A, BT, MT, N, K};
  pg8::StaticOrder S; S.init(MT, N, (int)gridDim.x, (int)blockIdx.x);
  EpiMK<MODE> E{&p, l};
  pg8::gemm_phase<EpiMK<MODE>, pg8::StaticOrder, true, true>((PG8_LAS unsigned char*)lds, g, S, E);
  if (MODE == 1 && l < 3 && (int)gridDim.x > 160 && (int)blockIdx.x >= 160) {
    if (K == D) layer_tiles(p, l + 1, 0, 640, (int)blockIdx.x - 160, (int)gridDim.x - 160, lds);
    else layer_tiles(p, l + 1, 640, NT_LAYER, (int)blockIdx.x - 160, (int)gridDim.x - 160, lds);
  }
}

constexpr int TOKT = 20;
DEV void prep_item(const Params& p, int l, int tile, char* lds) {
  const int t = tid(), r0 = tile * TOKT, c = t;
  bf16_t* sA = (bf16_t*)lds;
  float* swl = (float*)(lds + 32 * 136 * 2);
  float* sal = swl + TOKT * 256;
  const bf16_t* P = (const bf16_t*)(p.ws + OFF_P);
  bf16_t* PREP = (bf16_t*)(p.ws + OFF_PREP);
  bf16_t* BON = (bf16_t*)(p.ws + OFF_BONUS);
  for (int dir = 0; dir < 2; ++dir) {
    __syncthreads();
#pragma unroll
    for (int i = 0; i < TOKT / 2; ++i) {
      const int e = t + 256 * i, tk = e >> 7, j = e & 127, which = j >> 6, jj = j & 63;
      const int row = r0 + tk, prow = dir ? row + 1 : row - 1;
      const int tis = row < NCTX ? (row & 255) : ((row - NCTX) & 1023), Tm1 = row < NCTX ? 255 : 1023;
      const bool pv = dir ? (tis < Tm1) : (tis > 0);
      const int col = (dir ? C_WHB : C_WHF) + which * 64 + jj;
      const float cur = bf2f(P[(size_t)row * DIN + col]);
      const float prev = bf2f(P[(size_t)(pv ? prow : row) * DIN + col]) * (pv ? 1.f : 0.f);
      const float mu = p.in[I_MULORA][((l * 2 + dir) * 2 + which) * 64 + jj];
      const float val = cur + (prev - cur) * mu;
      sA[tk * 136 + j] = f2bf((which == 0) ? tanhf_(val) : val);
    }
    __syncthreads();
    {
      const int lane = t & 63, w = t >> 6, q = lane & 31, hh = lane >> 5;
#pragma unroll
      for (int mat = 0; mat < 2; ++mat) {
        bf16x8 af[4];
#pragma unroll
        for (int s = 0; s < 4; ++s) af[s] = *(const bf16x8*)(sA + q * 136 + mat * 64 + 16 * s + 8 * hh);
        const bf16_t* WT = (const bf16_t*)(p.ws + (mat ? OFF_A2T : OFF_W2T)) + (size_t)(l * 2 + dir) * 256 * 64;
        float* dst = mat ? sal : swl;
#pragma unroll
        for (int nt = 0; nt < 2; ++nt) {
          const int n = w * 64 + nt * 32 + q;
          f32x16 acc;
#pragma unroll
          for (int r = 0; r < 16; ++r) acc[r] = 0.f;
#pragma unroll
          for (int s = 0; s < 4; ++s) acc = MFMA32(af[s], *(const bf16x8*)(WT + (size_t)n * 64 + 16 * s + 8 * hh), acc);
#pragma unroll
          for (int r = 0; r < 8; ++r) dst[((r & 3) + 8 * (r >> 2) + 4 * hh) * 256 + n] = acc[r];
          if (hh == 0) {
#pragma unroll
            for (int r = 8; r < 12; ++r) dst[((r & 3) + 16) * 256 + n] = acc[r];
          }
        }
      }
    }
    __syncthreads();
    const float w0v = p.in[I_W0][(l * 2 + dir) * 256 + c], a0v = p.in[I_A0][(l * 2 + dir) * 256 + c];
    const float kkv = p.in[I_KK][l * 256 + c], kav = p.in[I_KA][l * 256 + c], rkv = p.in[I_RK][l * 256 + c];
    const float mur = p.in[I_MURKV][((l * 2 + dir) * 3 + 0) * 256 + c], muk = p.in[I_MURKV][((l * 2 + dir) * 3 + 1) * 256 + c],
                muv = p.in[I_MURKV][((l * 2 + dir) * 3 + 2) * 256 + c];
    bf16_t* pr = PREP + (size_t)dir * 6 * ARRF;
    for (int tb = 0; tb < TOKT; tb += 5) {
      float rc[5], kc[5], vc[5], rp[5], kq[5], vp[5], wlv[5], alv[5];
#pragma unroll
      for (int u = 0; u < 5; ++u) {
        const int tk = tb + u, row = r0 + tk, prow = dir ? row + 1 : row - 1;
        const int tis = row < NCTX ? (row & 255) : ((row - NCTX) & 1023), Tm1 = row < NCTX ? 255 : 1023;
        const bool pv = dir ? (tis < Tm1) : (tis > 0);
        const float pm = pv ? 1.f : 0.f;
        const bf16_t* pc = P + (size_t)row * DIN + c;
        const bf16_t* pp = P + (size_t)(pv ? prow : row) * DIN + c;
        rc[u] = bf2f(pc[C_R]); kc[u] = bf2f(pc[C_K]); vc[u] = bf2f(pc[C_V]);
        rp[u] = bf2f(pp[C_R]) * pm; kq[u] = bf2f(pp[C_K]) * pm; vp[u] = bf2f(pp[C_V]) * pm;
        wlv[u] = swl[tk * 256 + c]; alv[u] = sal[tk * 256 + c];
      }
      float bprev[5];
#pragma unroll
      for (int u = 0; u < 5; ++u) bprev[u] = (dir == 1) ? bf2f(BON[(size_t)(r0 + tb + u) * 256 + c]) : 0.f;
#pragma unroll
      for (int u = 0; u < 5; ++u) {
        const int row = r0 + tb + u;
        const float rs = rc[u] + (rp[u] - rc[u]) * mur, ks = kc[u] + (kq[u] - kc[u]) * muk, vs = vc[u] + (vp[u] - vc[u]) * muv;
        const float wl = w0v + wlv[u], al = a0v + alv[u];
        const float wv = __expf(-0.6065306597126334f * sigmoidf_(wl));
        const float av = sigmoidf_(al);
        const float kkr = ks * kkv;
        const float n2 = wave_sum(kkr * kkr);
        const float kk = kkr * rcpf_(fmaxf(__builtin_amdgcn_sqrtf(n2), 1e-12f));
        const float kp = ks * (1.0f + (av - 1.0f) * kav);
        const float bs = wave_sum(rs * kp * rkv);
        const float bon = bs * vs;
        const size_t idx = (size_t)row * 256 + c;
        pr[idx] = f2bf(rs); pr[ARRF + idx] = f2bf(wv); pr[2 * ARRF + idx] = f2bf(kp); pr[3 * ARRF + idx] = f2bf(vs); pr[4 * ARRF + idx] = f2bf(kk); pr[5 * ARRF + idx] = f2bf(kk * av);
        BON[idx] = f2bf(bprev[u] + bon);
      }
    }
  }
  __syncthreads();
}

DEV void rope_item(const Params& p, int item) {
  bf16_t* P = (bf16_t*)(p.ws + OFF_P);
  const int t = tid();
  for (int e = t; e < 64 * 192; e += 256) {
    const int tk = e / 192, r = e % 192, hs = r >> 5, pi = r & 31;
    const int lt = item * 64 + tk;
    const int tt = lt & 1023;
    const int grow = tt >> 6, gcol = tt & 63;
    const int fi = pi & 15;
    const float pos = (pi < 16) ? (float)grow : (float)gcol;
    const float inv = exp2f(-(float)fi * (13.287712379549449f / 16.0f));
    const float ang = pos * inv;
    const float cs = __cosf(ang), sn = __sinf(ang);
    const int d1 = (pi < 16) ? fi : 32 + fi;
    bf16_t* base = P + (size_t)(NCTX + lt) * DIN + C_SQ + hs * 64;
    const float x1 = bf2f(base[d1]), x2 = bf2f(base[d1 + 16]);
    base[d1] = f2bf(x1 * cs - x2 * sn);
    base[d1 + 16] = f2bf(x2 * cs + x1 * sn);
  }
}

constexpr int SC_BUF = 20480 + 4096;
typedef float f2 __attribute__((ext_vector_type(2)));
DEV float dot4(const float4& a, const float4& b) { return a.x * b.x + a.y * b.y + a.z * b.z + a.w * b.w; }
DEV float red8(float x) { x += dppf<0xB1>(x); x += dppf<0x4E>(x); x += dppf<0x141>(x); return x; }
DEV float dot8(const f2 (&S)[4], const float4& a, const float4& b) {
  f2 acc = S[0] * (f2){a.x, a.y};
  acc += S[1] * (f2){a.z, a.w}; acc += S[2] * (f2){b.x, b.y}; acc += S[3] * (f2){b.z, b.w};
  return acc.x + acc.y;
}

template <int NCH>
DEV void rwkv_scan(const Params& p, int l, int seq, int head, int dir, int rsel, char* lds) {
  const int t = tid(), rr = t >> 3, g = t & 7, rl = t >> 4, ks = t & 15;
  const int T = seq < 32 ? 256 : 1024;
  const int row0 = seq < 32 ? seq * 256 : NCTX + (seq - 32) * 1024;
  const bf16_t* prep = (const bf16_t*)(p.ws + OFF_PREP) + (size_t)dir * 6 * ARRF;
  float* ydir = (float*)(p.ws + OFF_YDIR) + (size_t)dir * ARRF;
  const int vbase = (NCH == 2) ? 0 : rsel * 32;
  f2 S[NCH][4];
#pragma unroll
  for (int c = 0; c < NCH; ++c)
#pragma unroll
    for (int j = 0; j < 4; ++j) S[c][j] = (f2){0.f, 0.f};
  if (seq >= 32) {
    const float* sp = p.in[I_SRW] + ((((size_t)(seq - 32) * 4 + l) * 2 + dir) * 4 + head) * 4096 + g * 8;
#pragma unroll
    for (int c = 0; c < NCH; ++c) {
      const float4 a = *(const float4*)(sp + (vbase + rr + 32 * c) * 64), b = *(const float4*)(sp + (vbase + rr + 32 * c) * 64 + 4);
      S[c][0] = (f2){a.x, a.y}; S[c][1] = (f2){a.z, a.w}; S[c][2] = (f2){b.x, b.y}; S[c][3] = (f2){b.z, b.w};
    }
  }
  const int nch = T >> 4;
  uint2 pre0, pre1, pre2, pre3, pre4, pvv;
#define RW_LOAD(cc) do { const int s_ = (cc) * 16 + rl; const int tok_ = dir ? (T - 1 - s_) : s_; \
    const size_t base_ = (size_t)(row0 + tok_) * 256 + head * 64; \
    pre0 = *(const uint2*)(prep + base_ + ks * 4); pre1 = *(const uint2*)(prep + ARRF + base_ + ks * 4); \
    pre2 = *(const uint2*)(prep + 2 * ARRF + base_ + ks * 4); pre3 = *(const uint2*)(prep + 4 * ARRF + base_ + ks * 4); \
    pre4 = *(const uint2*)(prep + 5 * ARRF + base_ + ks * 4); \
    if (NCH == 2) pvv = *(const uint2*)(prep + 3 * ARRF + base_ + ks * 4); \
    else pvv.x = *(const unsigned*)(prep + 3 * ARRF + base_ + vbase + ks * 2); } while (0)
#define RW_WRITE(bb) do { float4* sb_ = (float4*)(lds + (bb) * SC_BUF); float* vb_ = (float*)(lds + (bb) * SC_BUF + 20480); \
    sb_[(0 * 16 + rl) * 16 + ks] = bf4(pre0); sb_[(1 * 16 + rl) * 16 + ks] = bf4(pre1); sb_[(2 * 16 + rl) * 16 + ks] = bf4(pre2); \
    sb_[(3 * 16 + rl) * 16 + ks] = bf4(pre3); sb_[(4 * 16 + rl) * 16 + ks] = bf4(pre4); \
    if (NCH == 2) *(float4*)(vb_ + rl * 64 + ks * 4) = bf4(pvv); else *(f2*)(vb_ + rl * 64 + ks * 2) = (f2){bflo(pvv.x), bfhi(pvv.x)}; } while (0)
  __syncthreads();
  RW_LOAD(0); RW_WRITE(0);
  __syncthreads();
  for (int c = 0; c < nch; ++c) {
    if (c + 1 < nch) RW_LOAD(c + 1);
    const float4* sbuf = (const float4*)(lds + (c & 1) * SC_BUF);
    const float* vbuf = (const float*)(lds + (c & 1) * SC_BUF + 20480);
    float ym[NCH][2];
#pragma unroll
    for (int cc = 0; cc < NCH; ++cc) { ym[cc][0] = 0.f; ym[cc][1] = 0.f; }
#pragma unroll
    for (int i = 0; i < 16; ++i) {
      const float4 ra = sbuf[(0 * 16 + i) * 16 + g * 2], rb = sbuf[(0 * 16 + i) * 16 + g * 2 + 1];
      const float4 wa = sbuf[(1 * 16 + i) * 16 + g * 2], wb = sbuf[(1 * 16 + i) * 16 + g * 2 + 1];
      const float4 ka_ = sbuf[(2 * 16 + i) * 16 + g * 2], kb_ = sbuf[(2 * 16 + i) * 16 + g * 2 + 1];
      const float4 na = sbuf[(3 * 16 + i) * 16 + g * 2], nb = sbuf[(3 * 16 + i) * 16 + g * 2 + 1];
      const float4 aa = sbuf[(4 * 16 + i) * 16 + g * 2], ab = sbuf[(4 * 16 + i) * 16 + g * 2 + 1];
      const f2 w2[4] = {(f2){wa.x, wa.y}, (f2){wa.z, wa.w}, (f2){wb.x, wb.y}, (f2){wb.z, wb.w}};
      const f2 k2[4] = {(f2){ka_.x, ka_.y}, (f2){ka_.z, ka_.w}, (f2){kb_.x, kb_.y}, (f2){kb_.z, kb_.w}};
      const f2 a2[4] = {(f2){aa.x, aa.y}, (f2){aa.z, aa.w}, (f2){ab.x, ab.y}, (f2){ab.z, ab.w}};
#pragma unroll
      for (int cc = 0; cc < NCH; ++cc) {
        const float v = vbuf[i * 64 + rr + 32 * cc];
        const float sa = -red8(dot8(S[cc], na, nb));
#pragma unroll
        for (int j = 0; j < 4; ++j) S[cc][j] = S[cc][j] * w2[j] + a2[j] * sa + k2[j] * v;
        const float y = red8(dot8(S[cc], ra, rb));
        ym[cc][i >> 3] = (g == (i & 7)) ? y : ym[cc][i >> 3];
      }
    }
#pragma unroll
    for (int hh = 0; hh < 2; ++hh) {
      const int s = c * 16 + hh * 8 + g; const int tok = dir ? (T - 1 - s) : s;
      float* yo = ydir + (size_t)(row0 + tok) * 256 + head * 64 + vbase + rr;
#pragma unroll
      for (int cc = 0; cc < NCH; ++cc) yo[32 * cc] = ym[cc][hh];
    }
    if (c + 1 < nch) RW_WRITE((c + 1) & 1);
    __syncthreads();
  }
#undef RW_LOAD
#undef RW_WRITE
  if (seq < 32) {
    float* sp = p.out + O_RW + ((((size_t)seq * 4 + l) * 2 + dir) * 4 + head) * 4096 + g * 8;
#pragma unroll
    for (int c = 0; c < NCH; ++c) {
      *(float4*)(sp + (vbase + rr + 32 * c) * 64) = make_float4(S[c][0].x, S[c][0].y, S[c][1].x, S[c][1].y);
      *(float4*)(sp + (vbase + rr + 32 * c) * 64 + 4) = make_float4(S[c][2].x, S[c][2].y, S[c][3].x, S[c][3].y);
    }
  }
}

template <int NCH>
DEV void hgrn_scan(const Params& p, int l, int seq, int head, int dir, int rsel, char* lds) {
  const int t = tid(), rr = t >> 3, g = t & 7, rl = t >> 4, ks = t & 15;
  const int T = seq < 32 ? 256 : 1024;
  const int row0 = seq < 32 ? seq * 256 : NCTX + (seq - 32) * 1024;
  const bf16_t* P = (const bf16_t*)(p.ws + OFF_P);
  float* odir = (float*)(p.ws + OFF_HDIR) + (size_t)dir * ARRF;
  const float4 lb4 = *(const float4*)((const float*)(p.ws + OFF_HGLB) + (l * 2 + dir) * 256 + head * 64 + ks * 4);
  const int vbase = (NCH == 2) ? 0 : rsel * 32;
  f2 S[NCH][4];
#pragma unroll
  for (int c = 0; c < NCH; ++c)
#pragma unroll
    for (int j = 0; j < 4; ++j) S[c][j] = (f2){0.f, 0.f};
  if (seq >= 32) {
    const float* sp = p.in[I_SHG] + ((((size_t)(seq - 32) * 4 + l) * 2 + dir) * 4 + head) * 4096;
#pragma unroll
    for (int c = 0; c < NCH; ++c)
#pragma unroll
      for (int j = 0; j < 4; ++j) {
        const int v = vbase + rr + 32 * c;
        S[c][j] = (f2){sp[(g * 8 + 2 * j) * 64 + v], sp[(g * 8 + 2 * j + 1) * 64 + v]};
      }
  }
  const int nch = T >> 4;
  const int fcol = (dir ? C_HFB : C_HFF) + head * 64;
  uint2 pq, pf, pv2;
#define HG_LOAD(cc) do { const int s_ = (cc) * 16 + rl; const int tok_ = dir ? (T - 1 - s_) : s_; \
    const bf16_t* pr_ = P + (size_t)(row0 + tok_) * DIN; \
    pq = *(const uint2*)(pr_ + C_HQ + head * 64 + ks * 4); pf = *(const uint2*)(pr_ + fcol + ks * 4); \
    if (NCH == 2) pv2 = *(const uint2*)(pr_ + C_HI + head * 64 + ks * 4); else pv2.x = *(const unsigned*)(pr_ + C_HI + head * 64 + vbase + ks * 2); } while (0)
#define HG_WRITE(bb) do { float4* sb_ = (float4*)(lds + (bb) * SC_BUF); float* vb_ = (float*)(lds + (bb) * SC_BUF + 20480); \
    float4 q_, f_, k_; float a_, sg_; \
    a_ = bflo(pq.x); q_.x = a_ * sigmoidf_(a_); a_ = bfhi(pq.x); q_.y = a_ * sigmoidf_(a_); \
    a_ = bflo(pq.y); q_.z = a_ * sigmoidf_(a_); a_ = bfhi(pq.y); q_.w = a_ * sigmoidf_(a_); \
    sg_ = sigmoidf_(bflo(pf.x)); f_.x = lb4.x + (1.f - lb4.x) * sg_; k_.x = (1.f - lb4.x) * (1.f - sg_); \
    sg_ = sigmoidf_(bfhi(pf.x)); f_.y = lb4.y + (1.f - lb4.y) * sg_; k_.y = (1.f - lb4.y) * (1.f - sg_); \
    sg_ = sigmoidf_(bflo(pf.y)); f_.z = lb4.z + (1.f - lb4.z) * sg_; k_.z = (1.f - lb4.z) * (1.f - sg_); \
    sg_ = sigmoidf_(bfhi(pf.y)); f_.w = lb4.w + (1.f - lb4.w) * sg_; k_.w = (1.f - lb4.w) * (1.f - sg_); \
    sb_[(0 * 16 + rl) * 16 + ks] = q_; sb_[(1 * 16 + rl) * 16 + ks] = f_; sb_[(2 * 16 + rl) * 16 + ks] = k_; \
    if (NCH == 2) *(float4*)(vb_ + rl * 64 + ks * 4) = make_float4(bflo(pv2.x), bfhi(pv2.x), bflo(pv2.y), bfhi(pv2.y)); \
    else *(f2*)(vb_ + rl * 64 + ks * 2) = (f2){bflo(pv2.x), bfhi(pv2.x)}; } while (0)
  __syncthreads();
  HG_LOAD(0); HG_WRITE(0);
  __syncthreads();
  for (int c = 0; c < nch; ++c) {
    if (c + 1 < nch) HG_LOAD(c + 1);
    const float4* sbuf = (const float4*)(lds + (c & 1) * SC_BUF);
    const float* vbuf = (const float*)(lds + (c & 1) * SC_BUF + 20480);
    float ym[NCH][2];
#pragma unroll
    for (int cc = 0; cc < NCH; ++cc) { ym[cc][0] = 0.f; ym[cc][1] = 0.f; }
#pragma unroll
    for (int i = 0; i < 16; ++i) {
      const float4 qa = sbuf[(0 * 16 + i) * 16 + g * 2], qb = sbuf[(0 * 16 + i) * 16 + g * 2 + 1];
      const float4 fa = sbuf[(1 * 16 + i) * 16 + g * 2], fb = sbuf[(1 * 16 + i) * 16 + g * 2 + 1];
      const float4 ka_ = sbuf[(2 * 16 + i) * 16 + g * 2], kb_ = sbuf[(2 * 16 + i) * 16 + g * 2 + 1];
      const f2 f2v[4] = {(f2){fa.x, fa.y}, (f2){fa.z, fa.w}, (f2){fb.x, fb.y}, (f2){fb.z, fb.w}};
      const f2 k2[4] = {(f2){ka_.x, ka_.y}, (f2){ka_.z, ka_.w}, (f2){kb_.x, kb_.y}, (f2){kb_.z, kb_.w}};
#pragma unroll
      for (int cc = 0; cc < NCH; ++cc) {
        const float v = vbuf[i * 64 + rr + 32 * cc];
#pragma unroll
        for (int j = 0; j < 4; ++j) S[cc][j] = S[cc][j] * f2v[j] + k2[j] * v;
        const float y = red8(dot8(S[cc], qa, qb));
        ym[cc][i >> 3] = (g == (i & 7)) ? y : ym[cc][i >> 3];
      }
    }
#pragma unroll
    for (int hh = 0; hh < 2; ++hh) {
      const int s = c * 16 + hh * 8 + g; const int tok = dir ? (T - 1 - s) : s;
      float* yo = odir + (size_t)(row0 + tok) * 256 + head * 64 + vbase + rr;
#pragma unroll
      for (int cc = 0; cc < NCH; ++cc) yo[32 * cc] = ym[cc][hh];
    }
    if (c + 1 < nch) HG_WRITE((c + 1) & 1);
    __syncthreads();
  }
#undef HG_LOAD
#undef HG_WRITE
  if (seq < 32) {
    float* sp = p.out + O_HG + ((((size_t)seq * 4 + l) * 2 + dir) * 4 + head) * 4096;
#pragma unroll
    for (int c = 0; c < NCH; ++c)
#pragma unroll
      for (int j = 0; j < 4; ++j) {
        const int v = vbase + rr + 32 * c;
        sp[(g * 8 + 2 * j) * 64 + v] = S[c][j].x; sp[(g * 8 + 2 * j + 1) * 64 + v] = S[c][j].y;
      }
  }
}

DEV void rwkv_scan16(const Params& p, int l, int seq, int head, int dir, int rg, char* lds) {
  const int t = tid(), rl = t >> 4, ks = t & 15;
  const int T = seq < 32 ? 256 : 1024;
  const int row0 = seq < 32 ? seq * 256 : NCTX + (seq - 32) * 1024;
  const bf16_t* prep = (const bf16_t*)(p.ws + OFF_PREP) + (size_t)dir * 6 * ARRF;
  float* ydir = (float*)(p.ws + OFF_YDIR) + (size_t)dir * ARRF;
  const int v0 = rg * 16 + rl;
  float4 S0 = make_float4(0.f, 0.f, 0.f, 0.f);
  if (seq >= 32) S0 = *(const float4*)(p.in[I_SRW] + ((((size_t)(seq - 32) * 4 + l) * 2 + dir) * 4 + head) * 4096 + ks * 4 + v0 * 64);
  const int nch = T >> 4;
  uint2 pre0, pre1, pre2, pre3, pre4; bf16_t pv0;
#define RW_LOAD(cc) do { const int s_ = (cc) * 16 + rl; const int tok_ = dir ? (T - 1 - s_) : s_; \
    const size_t base_ = (size_t)(row0 + tok_) * 256 + head * 64; \
    pre0 = *(const uint2*)(prep + base_ + ks * 4); pre1 = *(const uint2*)(prep + ARRF + base_ + ks * 4); \
    pre2 = *(const uint2*)(prep + 2 * ARRF + base_ + ks * 4); pre3 = *(const uint2*)(prep + 4 * ARRF + base_ + ks * 4); \
    pre4 = *(const uint2*)(prep + 5 * ARRF + base_ + ks * 4); pv0 = prep[3 * ARRF + base_ + rg * 16 + ks]; } while (0)
#define RW_WRITE(bb) do { float4* sb_ = (float4*)(lds + (bb) * SC_BUF); float* vb_ = (float*)(lds + (bb) * SC_BUF + 20480); \
    sb_[(0 * 16 + rl) * 16 + ks] = bf4(pre0); sb_[(1 * 16 + rl) * 16 + ks] = bf4(pre1); sb_[(2 * 16 + rl) * 16 + ks] = bf4(pre2); \
    sb_[(3 * 16 + rl) * 16 + ks] = bf4(pre3); sb_[(4 * 16 + rl) * 16 + ks] = bf4(pre4); vb_[rl * 16 + ks] = bf2f(pv0); } while (0)
  __syncthreads();
  RW_LOAD(0); RW_WRITE(0);
  __syncthreads();
  for (int c = 0; c < nch; ++c) {
    if (c + 1 < nch) RW_LOAD(c + 1);
    const float4* sbuf = (const float4*)(lds + (c & 1) * SC_BUF);
    const float* vbuf = (const float*)(lds + (c & 1) * SC_BUF + 20480);
    float ym0 = 0.f;
#pragma unroll
    for (int i = 0; i < 16; ++i) {
      const float4 r = sbuf[(0 * 16 + i) * 16 + ks], wv = sbuf[(1 * 16 + i) * 16 + ks], kv = sbuf[(2 * 16 + i) * 16 + ks],
                   kk = sbuf[(3 * 16 + i) * 16 + ks], ka = sbuf[(4 * 16 + i) * 16 + ks];
      const float va = vbuf[i * 16 + rl];
      const float sa0 = -row16_sum(dot4(S0, kk));
      S0.x = S0.x * wv.x + sa0 * ka.x + va * kv.x; S0.y = S0.y * wv.y + sa0 * ka.y + va * kv.y;
      S0.z = S0.z * wv.z + sa0 * ka.z + va * kv.z; S0.w = S0.w * wv.w + sa0 * ka.w + va * kv.w;
      const float y0 = row16_sum(dot4(S0, r));
      ym0 = (ks == i) ? y0 : ym0;
    }
    {
      const int s = c * 16 + ks; const int tok = dir ? (T - 1 - s) : s;
      ydir[(size_t)(row0 + tok) * 256 + head * 64 + v0] = ym0;
    }
    if (c + 1 < nch) RW_WRITE((c + 1) & 1);
    __syncthreads();
  }
#undef RW_LOAD
#undef RW_WRITE
  if (seq < 32) *(float4*)(p.out + O_RW + ((((size_t)seq * 4 + l) * 2 + dir) * 4 + head) * 4096 + ks * 4 + v0 * 64) = S0;
}

DEV void hgrn_scan16(const Params& p, int l, int seq, int head, int dir, int rg, char* lds) {
  const int t = tid(), rl = t >> 4, ks = t & 15;
  const int T = seq < 32 ? 256 : 1024;
  const int row0 = seq < 32 ? seq * 256 : NCTX + (seq - 32) * 1024;
  const bf16_t* P = (const bf16_t*)(p.ws + OFF_P);
  float* odir = (float*)(p.ws + OFF_HDIR) + (size_t)dir * ARRF;
  const float4 lb4 = *(const float4*)((const float*)(p.ws + OFF_HGLB) + (l * 2 + dir) * 256 + head * 64 + ks * 4);
  const int v0 = rg * 16 + rl;
  float4 S0 = make_float4(0.f, 0.f, 0.f, 0.f);
  if (seq >= 32) {
    const float* sp = p.in[I_SHG] + ((((size_t)(seq - 32) * 4 + l) * 2 + dir) * 4 + head) * 4096;
    S0.x = sp[(ks * 4 + 0) * 64 + v0]; S0.y = sp[(ks * 4 + 1) * 64 + v0]; S0.z = sp[(ks * 4 + 2) * 64 + v0]; S0.w = sp[(ks * 4 + 3) * 64 + v0];
  }
  const int nch = T >> 4;
  const int fcol = (dir ? C_HFB : C_HFF) + head * 64;
  uint2 pq, pf; bf16_t pva;
#define HG_LOAD(cc) do { const int s_ = (cc) * 16 + rl; const int tok_ = dir ? (T - 1 - s_) : s_; \
    const bf16_t* pr_ = P + (size_t)(row0 + tok_) * DIN; \
    pq = *(const uint2*)(pr_ + C_HQ + head * 64 + ks * 4); pf = *(const uint2*)(pr_ + fcol + ks * 4); \
    pva = pr_[C_HI + head * 64 + rg * 16 + ks]; } while (0)
#define HG_WRITE(bb) do { float4* sb_ = (float4*)(lds + (bb) * SC_BUF); float* vb_ = (float*)(lds + (bb) * SC_BUF + 20480); \
    float4 q_, f_, k_; float a_, sg_; \
    a_ = bflo(pq.x); q_.x = a_ * sigmoidf_(a_); a_ = bfhi(pq.x); q_.y = a_ * sigmoidf_(a_); \
    a_ = bflo(pq.y); q_.z = a_ * sigmoidf_(a_); a_ = bfhi(pq.y); q_.w = a_ * sigmoidf_(a_); \
    sg_ = sigmoidf_(bflo(pf.x)); f_.x = lb4.x + (1.f - lb4.x) * sg_; k_.x = (1.f - lb4.x) * (1.f - sg_); \
    sg_ = sigmoidf_(bfhi(pf.x)); f_.y = lb4.y + (1.f - lb4.y) * sg_; k_.y = (1.f - lb4.y) * (1.f - sg_); \
    sg_ = sigmoidf_(bflo(pf.y)); f_.z = lb4.z + (1.f - lb4.z) * sg_; k_.z = (1.f - lb4.z) * (1.f - sg_); \
    sg_ = sigmoidf_(bfhi(pf.y)); f_.w = lb4.w + (1.f - lb4.w) * sg_; k_.w = (1.f - lb4.w) * (1.f - sg_); \
    sb_[(0 * 16 + rl) * 16 + ks] = q_; sb_[(1 * 16 + rl) * 16 + ks] = f_; sb_[(2 * 16 + rl) * 16 + ks] = k_; \
    vb_[rl * 16 + ks] = bf2f(pva); } while (0)
  __syncthreads();
  HG_LOAD(0); HG_WRITE(0);
  __syncthreads();
  for (int c = 0; c < nch; ++c) {
    if (c + 1 < nch) HG_LOAD(c + 1);
    const float4* sbuf = (const float4*)(lds + (c & 1) * SC_BUF);
    const float* vbuf = (const float*)(lds + (c & 1) * SC_BUF + 20480);
    float ym0 = 0.f;
#pragma unroll
    for (int i = 0; i < 16; ++i) {
      const float4 q = sbuf[(0 * 16 + i) * 16 + ks], f = sbuf[(1 * 16 + i) * 16 + ks], k = sbuf[(2 * 16 + i) * 16 + ks];
      const float va = vbuf[i * 16 + rl];
      S0.x = S0.x * f.x + k.x * va; S0.y = S0.y * f.y + k.y * va; S0.z = S0.z * f.z + k.z * va; S0.w = S0.w * f.w + k.w * va;
      const float y0 = row16_sum(dot4(S0, q));
      ym0 = (ks == i) ? y0 : ym0;
    }
    {
      const int s = c * 16 + ks; const int tok = dir ? (T - 1 - s) : s;
      odir[(size_t)(row0 + tok) * 256 + head * 64 + v0] = ym0;
    }
    if (c + 1 < nch) HG_WRITE((c + 1) & 1);
    __syncthreads();
  }
#undef HG_LOAD
#undef HG_WRITE
  if (seq < 32) {
    float* sp = p.out + O_HG + ((((size_t)seq * 4 + l) * 2 + dir) * 4 + head) * 4096;
    sp[(ks * 4 + 0) * 64 + v0] = S0.x; sp[(ks * 4 + 1) * 64 + v0] = S0.y; sp[(ks * 4 + 2) * 64 + v0] = S0.z; sp[(ks * 4 + 3) * 64 + v0] = S0.w;
  }
}

template <int MODE>
DEV void attn_item(const Params& p, int l, int item, char* lds) {
  const int t = tid(), lane = t & 63, w = t >> 6, q = lane & 31, hh = lane >> 5;
  const bf16_t* P = (const bf16_t*)(p.ws + OFF_P);
  bf16_t* Y = (bf16_t*)(p.ws + OFF_YMIX);
  char* sK = lds;
  char* sV = lds + 8192;
  float* sBias = (float*)(lds + 8192 + 8704);
  int head, qrow, qcol, kcol, vcol, ocol, nloc, nt, rowbaseP;
  int qr = 0, qc = 0, rlo = 0, qpos = 0, lo = 0, rsq = 0, wsq = 0;
  float sink = 0.f;
  const float* cache = nullptr; int cH = 1, cHead = 0;
  if (MODE == 0 || MODE == 1) {
    const int b = item >> 3; head = (item >> 1) & 3; const int half = item & 1;
    rowbaseP = b * 256; qrow = rowbaseP + half * 128 + w * 32 + q; nloc = 4; nt = 4;
  } else {
    const int b = item >> 5; head = (item >> 3) & 3; const int sub = item & 7;
    rowbaseP = NCTX + b * 1024;
    if (MODE == 2) {
      qr = 2 * sub + (w >> 1); qc = (w & 1) * 32 + q; qrow = rowbaseP + qr * 64 + qc;
      rlo = clampi(2 * sub - 4, 0, 8); const int rhi = clampi(2 * sub - 3, 0, 8) + 7; nloc = rhi - rlo + 1; nt = nloc + 4;
      rsq = clampi(qr - 4, 0, 8); wsq = clampi(qc - 8, 0, 48);
      cache = p.in[I_CNAT] + (size_t)((b * 4 + l) * 2) * 256 * 256; cH = 4; cHead = head;
      for (int i = t; i < 465; i += 256) sBias[i] = p.in[I_RPB][(size_t)(l * 4 + head) * 465 + i];
    } else {
      qpos = sub * 128 + w * 32 + q; qrow = rowbaseP + qpos;
      lo = (sub - 1) * 128;
      nloc = 6; nt = nloc + 4;
      cache = p.in[I_CSWA] + (size_t)((b * 4 + l) * 2) * 256 * 128; cH = 2; cHead = head >> 1;
    }
  }
  if (MODE == 0 || MODE == 2) { qcol = C_NQ + head * 64; kcol = C_NK + head * 64; vcol = C_NV + head * 64; ocol = 256 + head * 64; }
  else { qcol = C_SQ + head * 64; kcol = C_SK + (head >> 1) * 64; vcol = C_SV + (head >> 1) * 64; ocol = 768 + head * 64; sink = p.in[I_SINK][l * 4 + head]; }

  bf16x8 bq[4];
#pragma unroll
  for (int s = 0; s < 4; ++s) bq[s] = *(const bf16x8*)(P + (size_t)qrow * DIN + qcol + 16 * s + 8 * hh);
  f32x16 oacc[2];
#pragma unroll
  for (int r = 0; r < 16; ++r) { oacc[0][r] = 0.f; oacc[1][r] = 0.f; }
  float m_run = -1e30f, l_run = 0.f;
  const int key = t >> 2, dq = t & 3;
  const int kswz = (key >> 1) & 7;
  float4 raw[8];
#define ATT_ISSUE(jj) do { const int j_ = (jj); \
    if (j_ < nloc) { \
      int krow_; \
      if (MODE == 0 || MODE == 1) krow_ = rowbaseP + j_ * 64 + key; \
      else if (MODE == 2) krow_ = rowbaseP + (rlo + j_) * 64 + key; \
      else krow_ = rowbaseP + clampi(lo + j_ * 64 + key, 0, 1023); \
      const bf16_t* kp_ = P + (size_t)krow_ * DIN + kcol + dq * 16; \
      const bf16_t* vp_ = P + (size_t)krow_ * DIN + vcol + dq * 16; \
      raw[0] = *(const float4*)kp_; raw[1] = *(const float4*)(kp_ + 8); raw[2] = *(const float4*)vp_; raw[3] = *(const float4*)(vp_ + 8); \
    } else { \
      const int ct_ = (j_ - nloc) * 64 + key; \
      const float* kp_ = cache + ((size_t)ct_ * cH + cHead) * 64 + dq * 16; \
      const float* vp_ = kp_ + (size_t)256 * cH * 64; \
      raw[0] = *(const float4*)kp_; raw[1] = *(const float4*)(kp_ + 4); raw[2] = *(const float4*)(kp_ + 8); raw[3] = *(const float4*)(kp_ + 12); \
      raw[4] = *(const float4*)vp_; raw[5] = *(const float4*)(vp_ + 4); raw[6] = *(const float4*)(vp_ + 8); raw[7] = *(const float4*)(vp_ + 12); \
    } } while (0)
  ATT_ISSUE(0);
  for (int j = 0; j < nt; ++j) {
    uint4 kr[2], vr[2];
    const bool isP = j < nloc;
    if (isP) {
      kr[0] = __builtin_bit_cast(uint4, raw[0]); kr[1] = __builtin_bit_cast(uint4, raw[1]);
      vr[0] = __builtin_bit_cast(uint4, raw[2]); vr[1] = __builtin_bit_cast(uint4, raw[3]);
    } else {
      kr[0].x = pk2(raw[0].x, raw[0].y); kr[0].y = pk2(raw[0].z, raw[0].w); kr[0].z = pk2(raw[1].x, raw[1].y); kr[0].w = pk2(raw[1].z, raw[1].w);
      kr[1].x = pk2(raw[2].x, raw[2].y); kr[1].y = pk2(raw[2].z, raw[2].w); kr[1].z = pk2(raw[3].x, raw[3].y); kr[1].w = pk2(raw[3].z, raw[3].w);
      vr[0].x = pk2(raw[4].x, raw[4].y); vr[0].y = pk2(raw[4].z, raw[4].w); vr[0].z = pk2(raw[5].x, raw[5].y); vr[0].w = pk2(raw[5].z, raw[5].w);
      vr[1].x = pk2(raw[6].x, raw[6].y); vr[1].y = pk2(raw[6].z, raw[6].w); vr[1].z = pk2(raw[7].x, raw[7].y); vr[1].w = pk2(raw[7].z, raw[7].w);
    }
    if (j + 1 < nt) ATT_ISSUE(j + 1);
    __syncthreads();
    *(uint4*)(sK + key * 128 + (((dq * 2 + 0) ^ kswz) << 4)) = kr[0];
    *(uint4*)(sK + key * 128 + (((dq * 2 + 1) ^ kswz) << 4)) = kr[1];
    {
      bf16_t* vt = (bf16_t*)sV;
      const unsigned vv[8] = {vr[0].x, vr[0].y, vr[0].z, vr[0].w, vr[1].x, vr[1].y, vr[1].z, vr[1].w};
#pragma unroll
      for (int e = 0; e < 8; ++e) {
        vt[(dq * 16 + 2 * e) * 68 + key] = (bf16_t)(vv[e] & 0xffffu);
        vt[(dq * 16 + 2 * e + 1) * 68 + key] = (bf16_t)(vv[e] >> 16);
      }
    }
    __syncthreads();
    f32x16 sacc[2];
#pragma unroll
    for (int r = 0; r < 16; ++r) { sacc[0][r] = 0.f; sacc[1][r] = 0.f; }
    const int qswz = (q >> 1) & 7;
#pragma unroll
    for (int s = 0; s < 4; ++s) {
      const int co = (((s * 2 + hh) ^ qswz) << 4);
      const bf16x8 a0 = *(const bf16x8*)(sK + q * 128 + co);
      const bf16x8 a1 = *(const bf16x8*)(sK + (32 + q) * 128 + co);
      sacc[0] = MFMA32(a0, bq[s], sacc[0]);
      sacc[1] = MFMA32(a1, bq[s], sacc[1]);
    }
    float mx = -1e30f;
#pragma unroll
    for (int sub = 0; sub < 2; ++sub)
#pragma unroll
      for (int r = 0; r < 16; ++r) {
        const int kidx = sub * 32 + (r & 3) + 8 * (r >> 2) + 4 * hh;
        float v = sacc[sub][r] * 0.125f;
        bool ok = true;
        if (MODE == 2 && isP) {
          const int kr_ = rlo + j, kc_ = kidx;
          ok = (kr_ >= rsq) && (kr_ < rsq + 8) && (kc_ >= wsq) && (kc_ < wsq + 16);
          const int bi = ok ? ((kr_ - qr + 7) * 31 + (kc_ - qc + 15)) : 0;
          v += sBias[bi];
        }
        if (MODE == 3 && isP) {
          const int kpos = lo + j * 64 + kidx, dlt = kpos - qpos;
          ok = (dlt <= 128) && (dlt >= -128) && (kpos >= 0) && (kpos < 1024);
        }
        v = ok ? v : -1e30f;
        sacc[sub][r] = v;
        mx = fmaxf(mx, v);
      }
    mx = fmaxf(mx, __shfl_xor(mx, 32));
    const float m_new = fmaxf(m_run, mx);
    const float alpha = __expf(m_run - m_new);
    float rsum = 0.f;
#pragma unroll
    for (int sub = 0; sub < 2; ++sub)
#pragma unroll
      for (int r = 0; r < 16; ++r) {
        const float v = sacc[sub][r];
        const float pv = (v > -1e29f) ? __expf(v - m_new) : 0.f;
        sacc[sub][r] = pv; rsum += pv;
      }
    rsum += __shfl_xor(rsum, 32);
    l_run = l_run * alpha + rsum; m_run = m_new;
#pragma unroll
    for (int r = 0; r < 16; ++r) { oacc[0][r] *= alpha; oacc[1][r] *= alpha; }
#pragma unroll
    for (int k4 = 0; k4 < 4; ++k4) {
      const int sub = k4 >> 1, s2 = k4 & 1;
      uint4 pbu;
      pbu.x = pk2(sacc[sub][8 * s2 + 0], sacc[sub][8 * s2 + 1]); pbu.y = pk2(sacc[sub][8 * s2 + 2], sacc[sub][8 * s2 + 3]);
      pbu.z = pk2(sacc[sub][8 * s2 + 4], sacc[sub][8 * s2 + 5]); pbu.w = pk2(sacc[sub][8 * s2 + 6], sacc[sub][8 * s2 + 7]);
      const bf16x8 pb = __builtin_bit_cast(bf16x8, pbu);
#pragma unroll
      for (int dt = 0; dt < 2; ++dt) {
        const char* vp = sV + (dt * 32 + q) * 136 + (16 * k4 + 4 * hh) * 2;
        const uint2 lo8 = *(const uint2*)vp, hi8 = *(const uint2*)(vp + 16);
        uint4 avu; avu.x = lo8.x; avu.y = lo8.y; avu.z = hi8.x; avu.w = hi8.y;
        oacc[dt] = MFMA32(__builtin_bit_cast(bf16x8, avu), pb, oacc[dt]);
      }
    }
  }
#undef ATT_ISSUE
  float scale;
  if (MODE == 1 || MODE == 3) {
    const float m_f = fmaxf(m_run, sink);
    const float e = __expf(m_run - m_f);
    scale = e / (l_run * e + __expf(sink - m_f));
  } else scale = 1.0f / l_run;
#pragma unroll
  for (int dt = 0; dt < 2; ++dt)
#pragma unroll
    for (int g4 = 0; g4 < 4; ++g4) {
      const int d = dt * 32 + 8 * g4 + 4 * hh;
      uint2 o; o.x = pk2(oacc[dt][4 * g4] * scale, oacc[dt][4 * g4 + 1] * scale); o.y = pk2(oacc[dt][4 * g4 + 2] * scale, oacc[dt][4 * g4 + 3] * scale);
      *(uint2*)(Y + (size_t)qrow * D + ocol + d) = o;
    }
  __syncthreads();
}

DEV void post_item(const Params& p, int l, int tile, char* lds) {
  const int t = tid(), r0 = tile * TOKT, c = t;
  bf16_t* sA = (bf16_t*)lds;
  float* sgo = (float*)(lds + 32 * 136 * 2);
  const bf16_t* P = (const bf16_t*)(p.ws + OFF_P);
  bf16_t* Y = (bf16_t*)(p.ws + OFF_YMIX);
  const float* Y0 = (const float*)(p.ws + OFF_YDIR); const float* Y1 = Y0 + ARRF;
  const float* H0 = (const float*)(p.ws + OFF_HDIR); const float* H1 = H0 + ARRF;
  const bf16_t* BON = (const bf16_t*)(p.ws + OFF_BONUS);
  __syncthreads();
#pragma unroll
  for (int i = 0; i < TOKT / 2; ++i) {
    const int e = t + 256 * i, tk = e >> 7, j = e & 127;
    sA[tk * 136 + j] = f2bf(sigmoidf_(bf2f(P[(size_t)(r0 + tk) * DIN + C_GH + j])));
  }
  __syncthreads();
  {
    const int lane = t & 63, w = t >> 6, q = lane & 31, hh = lane >> 5;
    bf16x8 af[8];
#pragma unroll
    for (int s = 0; s < 8; ++s) af[s] = *(const bf16x8*)(sA + q * 136 + 16 * s + 8 * hh);
    const bf16_t* GT = (const bf16_t*)(p.ws + OFF_G2T) + (size_t)l * 256 * 128;
#pragma unroll
    for (int nt = 0; nt < 2; ++nt) {
      const int n = w * 64 + nt * 32 + q;
      f32x16 acc;
#pragma unroll
      for (int r = 0; r < 16; ++r) acc[r] = 0.f;
#pragma unroll
      for (int s = 0; s < 8; ++s) acc = MFMA32(af[s], *(const bf16x8*)(GT + (size_t)n * 128 + 16 * s + 8 * hh), acc);
#pragma unroll
      for (int r = 0; r < 8; ++r) sgo[((r & 3) + 8 * (r >> 2) + 4 * hh) * 256 + n] = acc[r];
      if (hh == 0) {
#pragma unroll
        for (int r = 8; r < 12; ++r) sgo[((r & 3) + 16) * 256 + n] = acc[r];
      }
    }
  }
  __syncthreads();
  const float lnw = p.in[I_LNW][l * 256 + c], lnb = p.in[I_LNB][l * 256 + c], hgn = p.in[I_HGN][l * 256 + c];
  for (int tb = 0; tb < TOKT; tb += 5) {
    float y[5], o[5], bn[5], gv[5], hg[5];
#pragma unroll
    for (int u = 0; u < 5; ++u) {
      const int row = r0 + tb + u;
      const size_t idx = (size_t)row * 256 + c;
      y[u] = Y0[idx] + Y1[idx]; o[u] = H0[idx] + H1[idx]; bn[u] = bf2f(BON[idx]);
      gv[u] = sgo[(tb + u) * 256 + c]; hg[u] = bf2f(P[(size_t)row * DIN + C_HG + c]);
    }
#pragma unroll
    for (int u = 0; u < 5; ++u) {
      const int row = r0 + tb + u;
      const float mu = wave_sum(y[u]) * (1.0f / 64.0f);
      const float dy = y[u] - mu;
      const float var = wave_sum(dy * dy) * (1.0f / 64.0f);
      const float yn = dy * rsqrtf(var + 64e-5f) * lnw + lnb + bn[u];
      Y[(size_t)row * D + c] = f2bf(yn * gv[u]);
      const float ms = wave_sum(o[u] * o[u]) * (1.0f / 64.0f);
      Y[(size_t)row * D + 512 + c] = f2bf(o[u] * rsqrtf(ms + 1e-6f) * hgn * sigmoidf_(hg[u]));
    }
  }
  __syncthreads();
}

constexpr int OFF_CTR_WORD = 3600;
DEV void mixer_phase(const Params& p, int l, char* lds0, volatile LAS unsigned* st, bool rerun) {
  const int hf = half_id(); char* lds = lds0 + hf * 65536;
  const int npairs = (256 + 512 + 512) / 2;
  unsigned* ctr = (unsigned*)(p.ws + OFF_BAR) + OFF_CTR_WORD + 64 * l + (rerun ? 32 : 0);
  for (;;) {
    if (threadIdx.x == 0) st[4] = __hip_atomic_fetch_add(ctr, 1u, __ATOMIC_RELAXED, __HIP_MEMORY_SCOPE_AGENT);
    __syncthreads();
    const int pair = (int)st[4];
    __syncthreads();
    if (pair >= npairs) break;
    const int it = pair * 2 + hf;
    const bool is_scan = it < 640;
    if (rerun && PROBE_SUB == 1 && !is_scan) continue;
    if (rerun && PROBE_SUB == 2 && is_scan) continue;
    if (rerun && PROBE_SUB == 3 && !(it < 128)) continue;
    if (rerun && PROBE_SUB == 4 && !(it >= 128 && it < 640)) continue;
    if (it < 128) {
      const int idx = it >> 1; const int seq = 32 + (idx >> 5), rem = idx & 31;
      if ((it & 1) == 0) rwkv_scan16(p, l, seq, rem >> 3, (rem >> 2) & 1, rem & 3, lds);
      else hgrn_scan16(p, l, seq, rem >> 3, (rem >> 2) & 1, rem & 3, lds);
    } else if (it < 640) {
      const int idx = (it - 128) & 255; const int seq = idx >> 3, rem = idx & 7;
      if (it < 384) rwkv_scan<2>(p, l, seq, rem >> 1, rem & 1, 0, lds);
      else hgrn_scan<2>(p, l, seq, rem >> 1, rem & 1, 0, lds);
    } else if (it < 704) attn_item<3>(p, l, it - 640, lds);
    else if (it < 768) attn_item<2>(p, l, it - 704, lds);
    else if (it < 1024) attn_item<0>(p, l, it - 768, lds);
    else attn_item<1>(p, l, it - 1024, lds);
  }
}

DEV void run_phase(const Params& p, int ph, char* lds, bool rerun, volatile LAS unsigned* st) {
  if (ph == 0) { phase0(p, lds); return; }
  if (ph == 1) { row_phase(p, 0, 0); return; }
  const int l = (ph - 2) / 9, s = (ph - 2) % 9;
  const bf16_t* H = (const bf16_t*)(p.ws + OFF_H);
  const int hf = half_id(); char* ldsh = lds + hf * 65536;
  switch (s) {
    case 0: gemm_run<0>(p, l, H, (const bf16_t*)(p.ws + OFF_WIN) + (size_t)l * DINP * D, D, DINP, lds); break;
    case 1:
      for (int it = blockIdx.x * 2 + hf; it < 512 + 32; it += gridDim.x * 2) { if (it < 512) prep_item(p, l, it, ldsh); else if (!rerun) rope_item(p, it - 512); }
      break;
    case 2: mixer_phase(p, l, lds, st, rerun); break;
    case 3: for (int it = blockIdx.x * 2 + hf; it < 512; it += gridDim.x * 2) post_item(p, l, it, ldsh); break;
    case 4: gemm_run<1>(p, l, (const bf16_t*)(p.ws + OFF_YMIX), (const bf16_t*)(p.ws + OFF_WOUT) + (size_t)l * D * D, D, D, lds); break;
    case 5: row_phase(p, 1, l); break;
    case 6: gemm_run<2>(p, l, H, (const bf16_t*)(p.ws + OFF_W1) + (size_t)l * FF * D, D, FF, lds); break;
    case 7: gemm_run<1>(p, l, (const bf16_t*)(p.ws + OFF_HID), (const bf16_t*)(p.ws + OFF_W2) + (size_t)l * D * FF, FF, D, lds); break;
    case 8: row_phase(p, 2, l); break;
  }
}

#define XB_TMO      128
#define XB_XCNT(j)  (256  + 64 * (j))
#define XB_XSUB(j)  (1280 + 64 * (j))
#define XB_XGEN(j)  (2304 + 64 * (j))
#define XB_TOP      3328
#define XB_TOPGEN   3392
#define XCD_BAR_WORDS 3456
#define XB_SPIN_CAP (1u << 18)
DEV unsigned xb_ld(unsigned* p) { return __hip_atomic_load(p, __ATOMIC_RELAXED, __HIP_MEMORY_SCOPE_AGENT); }
DEV unsigned xb_add(unsigned* p, unsigned v) { return __hip_atomic_fetch_add(p, v, __ATOMIC_RELAXED, __HIP_MEMORY_SCOPE_AGENT); }
DEV unsigned xb_xcc_id() { return (unsigned)__builtin_amdgcn_s_getreg((3 << 11) | 20) & 0xFu; }
#define XB_SPIN(cond, bar) do { unsigned _sp = 0; while (cond) { __builtin_amdgcn_s_sleep(1); \
    if ((++_sp & 255u) == 0u) { if (xb_ld(&(bar)[XB_TMO])) break; if (_sp > XB_SPIN_CAP) { atomicAdd(&(bar)[XB_TMO], 1u); break; } } } } while (0)
struct XcdBarrier { unsigned* bar; unsigned x; volatile LAS unsigned* st; };
DEV XcdBarrier xcd_barrier_post(unsigned* bar, volatile LAS unsigned* st) {
  XcdBarrier b; b.bar = bar; b.x = xb_xcc_id(); b.st = st;
  if (threadIdx.x == 0) (void)xb_add(&bar[XB_XCNT(b.x)], 1u);
  return b;
}
DEV void xcd_barrier_complete(unsigned* bar, unsigned x, unsigned& nloc, unsigned& nx) {
  const unsigned G = gridDim.x * gridDim.y * gridDim.z;
  unsigned sum, cnt, mine, sp = 0u;
  for (;;) {
    sum = 0u; cnt = 0u; mine = 0u;
#pragma unroll
    for (unsigned j = 0; j < 16; ++j) { const unsigned c = xb_ld(&bar[XB_XCNT(j)]); sum += c; cnt += (c > 0u) ? 1u : 0u; mine = (j == x) ? c : mine; }
    if (sum == G) break;
    __builtin_amdgcn_s_sleep(1);
    if ((++sp & 255u) == 0u) { if (xb_ld(&bar[XB_TMO])) break; if (sp > XB_SPIN_CAP) { atomicAdd(&bar[XB_TMO], 1u); break; } }
  }
  nloc = mine > 0u ? mine : 1u; nx = cnt > 0u ? cnt : 1u;
}
DEV void xcd_barrier(const XcdBarrier& b) {
  asm volatile("s_waitcnt vmcnt(0)" ::: "memory");
  __syncthreads();
  if (threadIdx.x == 0) {
    unsigned* bar = b.bar;
    { size_t zb_; asm volatile("s_mov_b64 %0, 0" : "=s"(zb_)); bar += zb_; }
    __builtin_amdgcn_s_waitcnt(0);
    unsigned nloc = b.st[0], nx = b.st[1];
    if (nloc == 0u) { xcd_barrier_complete(bar, b.x, nloc, nx); b.st[0] = nloc; b.st[1] = nx; }
    const unsigned old = xb_add(&bar[XB_XSUB(b.x)], 1u);
    const unsigned gen = old / nloc;
    if (old + 1u == (gen + 1u) * nloc) {
      __builtin_amdgcn_fence(__ATOMIC_RELEASE, "agent");
      asm volatile("s_waitcnt vmcnt(0)" ::: "memory");
      const unsigned og = xb_add(&bar[XB_TOP], 1u);
      const unsigned tg = og / nx;
      if (og + 1u == (tg + 1u) * nx) xb_add(&bar[XB_TOPGEN], 1u);
      else XB_SPIN(xb_ld(&bar[XB_TOPGEN]) == tg, bar);
      __builtin_amdgcn_fence(__ATOMIC_ACQUIRE, "agent");
      xb_add(&bar[XB_XGEN(b.x)], 1u);
      asm volatile("s_waitcnt vmcnt(0)" ::: "memory");
    } else {
      XB_SPIN(xb_ld(&bar[XB_XGEN(b.x)]) == gen, bar);
      __builtin_amdgcn_fence(__ATOMIC_ACQUIRE, "agent");
      asm volatile("s_waitcnt vmcnt(0)" ::: "memory");
    }
  }
  __syncthreads();
}

DEV int phase_kind(int ph) {
  if (ph == 0) return 0;
  if (ph == 1) return 1;
  const int s = (ph - 2) % 9;
  return s == 0 ? 2 : s == 1 ? 3 : s == 2 ? 4 : s == 3 ? 5 : s == 4 ? 6 : s == 5 ? 1 : s == 6 ? 7 : s == 7 ? 8 : 1;
}

constexpr int LDS_BYTES = 131072 + 64;

__global__ void __launch_bounds__(512, 2) mega(Params p, int ph_lo, int ph_hi) {
  extern __shared__ __attribute__((aligned(16))) unsigned char smem[];
  char* lds = (char*)smem;
  volatile LAS unsigned* st = (volatile LAS unsigned*)((LAS unsigned char*)smem + 131072);
  if (threadIdx.x == 0) { st[0] = 0u; st[1] = 0u; }
  __syncthreads();
  XcdBarrier xb = xcd_barrier_post((unsigned*)(p.ws + OFF_BAR), st);
  if (ph_hi < 0) cg::this_grid().sync();
  char* const ws0 = p.ws; float* const out0 = p.out;
  for (int ph = ph_lo; ph < ph_hi; ++ph) {
    { size_t z0_; asm volatile("s_mov_b64 %0, 0" : "=s"(z0_)); p.ws = ws0 + z0_; p.out = out0 + z0_; }
    run_phase(p, ph, lds, false, st);
    if (PROBE_KIND >= 0 && (PROBE_KIND == 9 || phase_kind(ph) == PROBE_KIND)) {
      xcd_barrier(xb);
      if (PROBE_KIND != 9) run_phase(p, ph, lds, true, st);
    }
    if (ph + 1 < ph_hi) xcd_barrier(xb);
  }
}

extern "C" void kernel_launch(void* const* d_in, const int* in_sizes, int n_in, void* d_out, int out_size, void* d_ws, size_t ws_size,
                              hipStream_t stream) {
  static int grid_blocks = 0;
  if (!grid_blocks) {
    int dev = 0, cus = 0, per_cu = 0;
    (void)hipGetDevice(&dev);
    (void)hipDeviceGetAttribute(&cus, hipDeviceAttributeMultiprocessorCount, dev);
    if (hipFuncSetAttribute((const void*)mega, hipFuncAttributeMaxDynamicSharedMemorySize, LDS_BYTES) != hipSuccess) fprintf(stderr, "hipFuncSetAttribute failed\n");
    (void)hipOccupancyMaxActiveBlocksPerMultiprocessor(&per_cu, mega, 512, LDS_BYTES);
    if (per_cu < 1) fprintf(stderr, "occupancy query reports %d blocks per CU\n", per_cu);
    (void)hipGetLastError();
    grid_blocks = cus;
  }
  if (ws_size < WS_TOTAL) { fprintf(stderr, "workspace too small: %zu < %zu\n", ws_size, (size_t)WS_TOTAL); return; }
  Params p{};
  for (int i = 0; i < 31; ++i) p.in[i] = (const float*)d_in[i];
  p.out = (float*)d_out;
  p.ws = (char*)d_ws;
  (void)hipMemsetAsync((char*)d_ws + OFF_BAR, 0, 16384, stream);
  int lo = 0, hi = NPH;
  void* args[] = {&p, &lo, &hi};
  hipError_t e = hipLaunchCooperativeKernel((void*)mega, dim3(grid_blocks), dim3(512), args, LDS_BYTES, stream);
  if (e != hipSuccess) fprintf(stderr, "cooperative launch failed: %s (grid %d)\n", hipGetErrorString(e), grid_blocks);
}
```

```cpp
#include <hip/hip_runtime.h>
#include <hip/hip_cooperative_groups.h>
#include <cstdio>
#include <cstdint>
namespace cg = cooperative_groups;

#ifndef ONE_LAUNCH
#define ONE_LAUNCH 1
#endif
#define PROBE_KIND -1
#define PROBE_SUB 0

#define DEV __device__ __forceinline__
#define LAS __attribute__((address_space(3)))
typedef unsigned short bf16_t;
typedef short bf16x8 __attribute__((ext_vector_type(8)));
typedef float f32x16 __attribute__((ext_vector_type(16)));
typedef __bf16 bf2_t __attribute__((ext_vector_type(2)));
typedef float f2_t __attribute__((ext_vector_type(2)));

constexpr int D = 1024, DIN = 3712, FF = 4096, NCTX = 8192, MT = 10240;
constexpr int NPH = 38;
constexpr int DINP = 3840;
constexpr int C_R = 0, C_K = 256, C_V = 512, C_GH = 768, C_WHF = 896, C_WHB = 1024;
constexpr int C_NQ = 1152, C_NK = 1408, C_NV = 1664;
constexpr int C_HQ = 1920, C_HI = 2176, C_HG = 2432, C_HFF = 2688, C_HFB = 2944;
constexpr int C_SQ = 3200, C_SK = 3456, C_SV = 3584;
constexpr size_t O_NAT = 10485760, O_SWA = 27262976, O_RW = 35651584, O_HG = 39845888;
constexpr size_t ARRF = (size_t)MT * 256;
constexpr size_t ARR = ARRF * 4;
constexpr size_t OFF_WIN = 0;
constexpr size_t OFF_WOUT = OFF_WIN + (size_t)4 * DINP * D * 2;
constexpr size_t OFF_W1 = OFF_WOUT + (size_t)4 * D * D * 2;
constexpr size_t OFF_W2 = OFF_W1 + (size_t)4 * FF * D * 2;
constexpr size_t OFF_MOD = OFF_W2 + (size_t)4 * FF * D * 2;
constexpr size_t OFF_HGLB = OFF_MOD + (size_t)4 * 3 * 6144 * 4;
constexpr size_t OFF_P = OFF_HGLB + 8192;
constexpr size_t OFF_R1 = OFF_P + (size_t)MT * DIN * 2;
constexpr size_t OFF_H = OFF_R1;
constexpr size_t OFF_HID = OFF_H + (size_t)MT * D * 2;
constexpr size_t OFF_U = OFF_HID + (size_t)MT * FF * 2;
constexpr size_t OFF_PREP = OFF_R1;
constexpr size_t OFF_YDIR = OFF_PREP + 12 * ARR;
constexpr size_t OFF_BONUS = OFF_R1 + 14 * ARR;
constexpr size_t OFF_HDIR = OFF_BONUS + ARR / 2;
constexpr size_t OFF_YMIX = OFF_HDIR + 2 * ARR;
constexpr size_t OFF_X16 = OFF_YMIX + (size_t)MT * D * 2;
constexpr size_t OFF_BAR = OFF_X16 + (size_t)MT * D * 2;
constexpr size_t OFF_W2T = OFF_BAR + 16384;
constexpr size_t OFF_A2T = OFF_W2T + (size_t)4 * 2 * 256 * 64 * 2;
constexpr size_t OFF_G2T = OFF_A2T + (size_t)4 * 2 * 256 * 64 * 2;
constexpr size_t WS_TOTAL = OFF_G2T + (size_t)4 * 256 * 128 * 2;
static_assert(OFF_U + (size_t)MT * D * 4 == OFF_BONUS, "R1 layout");

struct Params {
  const float* in[31];
  float* out;
  char* ws;
};
enum { I_XP = 0, I_XS, I_CNAT, I_CSWA, I_SRW, I_SHG, I_C, I_CCTX, I_NORMG, I_MODW, I_MODB, I_WIN, I_WOUT, I_MURKV, I_MULORA,
       I_W0, I_W2, I_A0, I_A2, I_G2, I_KK, I_KA, I_RK, I_LNW, I_LNB, I_RPB, I_HGLB, I_HGN, I_SINK, I_FW1, I_FW2 };


DEV float bf2f(bf16_t h) { return __uint_as_float(((unsigned)h) << 16); }
DEV unsigned pk2(float a, float b) { f2_t v = {a, b}; bf2_t r = __builtin_convertvector(v, bf2_t); return __builtin_bit_cast(unsigned, r); }
DEV bf16_t f2bf(float f) { return (bf16_t)(pk2(f, f) & 0xffffu); }
DEV float4 bf4(uint2 u) { return make_float4(__uint_as_float(u.x << 16), __uint_as_float(u.x & 0xffff0000u), __uint_as_float(u.y << 16), __uint_as_float(u.y & 0xffff0000u)); }
DEV float bflo(unsigned u) { return __uint_as_float(u << 16); }
DEV float bfhi(unsigned u) { return __uint_as_float(u & 0xffff0000u); }
DEV float rcpf_(float x) { return __builtin_amdgcn_rcpf(x); }
DEV float sigmoidf_(float x) { return rcpf_(1.0f + __expf(-x)); }
DEV float tanhf_(float x) { return 1.0f - 2.0f * rcpf_(1.0f + __expf(2.0f * x)); }
template <int CTRL> DEV float dppf(float x) { return __int_as_float(__builtin_amdgcn_update_dpp(0, __float_as_int(x), CTRL, 0xF, 0xF, false)); }
DEV float row16_sum(float x) { x += dppf<0xB1>(x); x += dppf<0x4E>(x); x += dppf<0x141>(x); x += dppf<0x140>(x); return x; }
DEV float wave_sum(float x) { x = row16_sum(x); x += __shfl_xor(x, 16); x += __shfl_xor(x, 32); return x; }
DEV int clampi(int v, int lo, int hi) { return v < lo ? lo : (v > hi ? hi : v); }
#define MFMA32(a, b, c) __builtin_amdgcn_mfma_f32_32x32x16_bf16((a), (b), (c), 0, 0, 0)

DEV int tid() { int z; asm volatile("v_mov_b32 %0, 0" : "=v"(z)); return (int)(threadIdx.x & 255u) + z; }
DEV int half_id() { return __builtin_amdgcn_readfirstlane((int)(threadIdx.x >> 8)); }
DEV void transpose_item(const float* W, bf16_t* WT, int K, int N, int kt, int nt, char* lds) {
  bf16_t* s = (bf16_t*)lds;
  const int t = tid();
#pragma unroll
  for (int i = 0; i < 4; ++i) {
    const int k = (t >> 4) + 16 * i, n4 = (t & 15) * 4;
    const float4 v = *(const float4*)(W + (size_t)(kt * 64 + k) * N + nt * 64 + n4);
    s[(n4 + 0) * 72 + k] = f2bf(v.x); s[(n4 + 1) * 72 + k] = f2bf(v.y);
    s[(n4 + 2) * 72 + k] = f2bf(v.z); s[(n4 + 3) * 72 + k] = f2bf(v.w);
  }
  __syncthreads();
#pragma unroll
  for (int i = 0; i < 2; ++i) {
    const int n = (t >> 3) + 32 * i, kc = t & 7;
    const uint4 v = *(const uint4*)(s + n * 72 + kc * 8);
    *(uint4*)(WT + (size_t)(nt * 64 + n) * K + kt * 64 + kc * 8) = v;
  }
  __syncthreads();
}

DEV void mod_item(const Params& p, int l, int jb, char* lds) {
  float* sc = (float*)lds;
  float* red = (float*)(lds + 12288);
  const int t = tid();
  for (int i = t; i < 3072; i += 256) {
    const int c = i >> 10, k = i & 1023;
    const float x = (c == 0) ? p.in[I_CCTX][k] : p.in[I_C][(c - 1) * 1024 + k];
    sc[i] = x * rcpf_(1.0f + __expf(-x));
  }
  __syncthreads();
  const int c4 = t & 15, ks = t >> 4;
  const float* wp = p.in[I_MODW] + ((size_t)l * 1024 + ks * 64) * 6144 + jb * 64 + c4 * 4;
  float a00 = 0, a01 = 0, a02 = 0, a03 = 0, a10 = 0, a11 = 0, a12 = 0, a13 = 0, a20 = 0, a21 = 0, a22 = 0, a23 = 0;
#pragma unroll 16
  for (int ii = 0; ii < 64; ++ii) {
    const float4 w = *(const float4*)(wp + (size_t)ii * 6144);
    const int k = ks * 64 + ii;
    const float s0 = sc[k], s1 = sc[1024 + k], s2 = sc[2048 + k];
    a00 += s0 * w.x; a01 += s0 * w.y; a02 += s0 * w.z; a03 += s0 * w.w;
    a10 += s1 * w.x; a11 += s1 * w.y; a12 += s1 * w.z; a13 += s1 * w.w;
    a20 += s2 * w.x; a21 += s2 * w.y; a22 += s2 * w.z; a23 += s2 * w.w;
  }
  float* r0 = red + (ks * 3 + 0) * 64 + c4 * 4; r0[0] = a00; r0[1] = a01; r0[2] = a02; r0[3] = a03;
  float* r1 = red + (ks * 3 + 1) * 64 + c4 * 4; r1[0] = a10; r1[1] = a11; r1[2] = a12; r1[3] = a13;
  float* r2 = red + (ks * 3 + 2) * 64 + c4 * 4; r2[0] = a20; r2[1] = a21; r2[2] = a22; r2[3] = a23;
  __syncthreads();
  if (t < 192) {
    const int c = t >> 6, col = t & 63;
    float v = p.in[I_MODB][l * 6144 + jb * 64 + col];
#pragma unroll
    for (int k2 = 0; k2 < 16; ++k2) v += red[(k2 * 3 + c) * 64 + col];
    ((float*)(p.ws + OFF_MOD))[(size_t)(l * 3 + c) * 6144 + jb * 64 + col] = v;
  }
  __syncthreads();
}

DEV void hglb_item(const Params& p) {
  const int c = tid();
  float* HGLB = (float*)(p.ws + OFF_HGLB);
  for (int dir = 0; dir < 2; ++dir) {
    float x[4], mx = -1e30f;
    for (int l = 0; l < 4; ++l) { x[l] = p.in[I_HGLB][(dir * 4 + l) * 256 + c]; mx = fmaxf(mx, x[l]); }
    float s = 0;
    for (int l = 0; l < 4; ++l) { x[l] = __expf(x[l] - mx); s += x[l]; }
    float cum = 0; const float s0 = x[0] / s;
    for (int l = 0; l < 4; ++l) { cum += x[l] / s; HGLB[(l * 2 + dir) * 256 + c] = cum - s0; }
  }
}

constexpr int NT_LAYER = 928 + 256 + 1024 + 1024;
struct TileDesc { const float* W; bf16_t* WT; int K, N, kt, nt; };
DEV TileDesc layer_tile_desc(const Params& p, int l, int j) {
  TileDesc d;
  if (j < 928) { d.W = p.in[I_WIN] + (size_t)l * D * DIN; d.WT = (bf16_t*)(p.ws + OFF_WIN) + (size_t)l * DINP * D; d.K = D; d.N = DIN; d.kt = j / 58; d.nt = j % 58; return d; }
  j -= 928;
  if (j < 256) { d.W = p.in[I_WOUT] + (size_t)l * D * D; d.WT = (bf16_t*)(p.ws + OFF_WOUT) + (size_t)l * D * D; d.K = D; d.N = D; d.kt = j / 16; d.nt = j % 16; return d; }
  j -= 256;
  if (j < 1024) { d.W = p.in[I_FW1] + (size_t)l * D * FF; d.WT = (bf16_t*)(p.ws + OFF_W1) + (size_t)l * FF * D; d.K = D; d.N = FF; d.kt = j / 64; d.nt = j % 64; return d; }
  j -= 1024;
  d.W = p.in[I_FW2] + (size_t)l * FF * D; d.WT = (bf16_t*)(p.ws + OFF_W2) + (size_t)l * D * FF; d.K = FF; d.N = D; d.kt = j / 16; d.nt = j % 16; return d;
}
DEV void tile_load(const TileDesc& d, float4 (&v)[4]) {
  const int t = tid();
#pragma unroll
  for (int i = 0; i < 4; ++i) v[i] = *(const float4*)(d.W + (size_t)(d.kt * 64 + (t >> 4) + 16 * i) * d.N + d.nt * 64 + (t & 15) * 4);
}
DEV void tile_store(const TileDesc& d, const float4 (&v)[4], char* lds) {
  bf16_t* s = (bf16_t*)lds;
  const int t = tid();
#pragma unroll
  for (int i = 0; i < 4; ++i) {
    const int k = (t >> 4) + 16 * i, n4 = (t & 15) * 4;
    s[(n4 + 0) * 72 + k] = f2bf(v[i].x); s[(n4 + 1) * 72 + k] = f2bf(v[i].y);
    s[(n4 + 2) * 72 + k] = f2bf(v[i].z); s[(n4 + 3) * 72 + k] = f2bf(v[i].w);
  }
  __syncthreads();
#pragma unroll
  for (int i = 0; i < 2; ++i) {
    const int n = (t >> 3) + 32 * i, kc = t & 7;
    const uint4 o = *(const uint4*)(s + n * 72 + kc * 8);
    *(uint4*)(d.WT + (size_t)(d.nt * 64 + n) * d.K + d.kt * 64 + kc * 8) = o;
  }
  __syncthreads();
}
DEV void layer_tiles(const Params& p, int l, int lo, int hi, int vb, int nvb, char* lds0) {
  const int hf = half_id(); char* lds = lds0 + hf * 65536;
  int it = lo + vb * 2 + hf;
  if (it >= hi) return;
  float4 vn[4];
  TileDesc dn = layer_tile_desc(p, l, it);
  tile_load(dn, vn);
  for (; it < hi; it += nvb * 2) {
    float4 vc[4] = {vn[0], vn[1], vn[2], vn[3]};
    const TileDesc dc = dn;
    if (it + nvb * 2 < hi) { dn = layer_tile_desc(p, l, it + nvb * 2); tile_load(dn, vn); }
    tile_store(dc, vc, lds);
  }
}

DEV void phase0(const Params& p, char* lds0) {
  const int hf = half_id(); char* lds = lds0 + hf * 65536;
  const int nitems = 386 + 4 + 20;
  for (int it = blockIdx.x * 2 + hf; it < nitems; it += gridDim.x * 2) {
    if (it < 384) { mod_item(p, it / 96, it % 96, lds); continue; }
    if (it == 384) { hglb_item(p); continue; }
    if (it == 385) continue;
    const int j = it - 386;
    if (j >= 4) {
      const int s = j - 4, n = tid();
      const float* src; bf16_t* dst; int KK;
      if (s < 8) { src = p.in[I_W2] + (size_t)s * 64 * 256; dst = (bf16_t*)(p.ws + OFF_W2T) + (size_t)s * 256 * 64; KK = 64; }
      else if (s < 16) { src = p.in[I_A2] + (size_t)(s - 8) * 64 * 256; dst = (bf16_t*)(p.ws + OFF_A2T) + (size_t)(s - 8) * 256 * 64; KK = 64; }
      else { src = p.in[I_G2] + (size_t)(s - 16) * 128 * 256; dst = (bf16_t*)(p.ws + OFF_G2T) + (size_t)(s - 16) * 256 * 128; KK = 128; }
      for (int k0 = 0; k0 < KK; k0 += 8) {
        float v[8];
#pragma unroll
        for (int e = 0; e < 8; ++e) v[e] = src[(size_t)(k0 + e) * 256 + n];
        uint4 o; o.x = pk2(v[0], v[1]); o.y = pk2(v[2], v[3]); o.z = pk2(v[4], v[5]); o.w = pk2(v[6], v[7]);
        *(uint4*)(dst + (size_t)n * KK + k0) = o;
      }
      continue;
    }
    {
      uint4* z = (uint4*)((bf16_t*)(p.ws + OFF_WIN) + ((size_t)j * DINP + DIN) * D);
      const int t = tid();
      for (int i = t; i < 128 * D * 2 / 16; i += 256) z[i] = make_uint4(0u, 0u, 0u, 0u);
    }
  }
  const int vb = ((int)blockIdx.x + (int)gridDim.x - 195 % (int)gridDim.x) % (int)gridDim.x;
  layer_tiles(p, 0, 0, NT_LAYER, vb, (int)gridDim.x, lds0);
  if ((int)gridDim.x <= 160) { for (int ll = 1; ll < 4; ++ll) layer_tiles(p, ll, 0, NT_LAYER, (int)blockIdx.x, (int)gridDim.x, lds0); }
}

constexpr int RPW = 5;
DEV void row_phase(const Params& p, int mode, int l) {
  const int lane = tid() & 63;
  const int nw = gridDim.x * 8;
  const float* MOD = (const float*)(p.ws + OFF_MOD);
  const float* NG = p.in[I_NORMG];
  const bf16_t* U = (const bf16_t*)(p.ws + OFF_U);
  bf16_t* H = (bf16_t*)(p.ws + OFF_H);
  bf16_t* X16 = (bf16_t*)(p.ws + OFF_X16);
  const bool has_next = !(mode == 2 && l == 3);
  const int ln = (mode == 0) ? 0 : (mode == 1 ? l : l + 1);
  const int gi = (mode == 1) ? 2 : 0, shi = (mode == 1) ? 3 : 0, sci = (mode == 1) ? 4 : 1;
  const float* ga = NG + (size_t)(l * 4 + (mode == 1 ? 1 : 3)) * 1024;
  const float* gb = NG + (size_t)((has_next ? ln : 0) * 4 + gi) * 1024;
  for (int rowa = blockIdx.x * 8 + half_id() * 4 + (tid() >> 6); rowa < MT; rowa += RPW * nw) {
    float4 x[RPW][4]; uint2 ub[RPW][4];
    int rows[RPW]; bool ok[RPW];
#pragma unroll
    for (int q = 0; q < RPW; ++q) {
      rows[q] = rowa + q * nw; ok[q] = rows[q] < MT;
      const int row = ok[q] ? rows[q] : rowa;
      if (mode == 0) {
        const float* src = row < NCTX ? p.in[I_XP] + (size_t)row * D : p.in[I_XS] + (size_t)(row - NCTX) * D;
#pragma unroll
        for (int i = 0; i < 4; ++i) x[q][i] = *(const float4*)(src + i * 256 + lane * 4);
      } else {
#pragma unroll
        for (int i = 0; i < 4; ++i) {
          const uint2 xb = *(const uint2*)(X16 + (size_t)row * D + i * 256 + lane * 4);
          x[q][i] = make_float4(bflo(xb.x), bfhi(xb.x), bflo(xb.y), bfhi(xb.y));
          ub[q][i] = *(const uint2*)(U + (size_t)row * D + i * 256 + lane * 4);
        }
      }
    }
#pragma unroll
    for (int q = 0; q < RPW; ++q) {
      const int row = ok[q] ? rows[q] : rowa;
      const int cond = row < NCTX ? 0 : 1 + ((row - NCTX) >> 10);
      if (mode != 0) {
        float4 u[4];
        float ss = 0;
#pragma unroll
        for (int i = 0; i < 4; ++i) {
          u[i] = make_float4(bflo(ub[q][i].x), bfhi(ub[q][i].x), bflo(ub[q][i].y), bfhi(ub[q][i].y));
          ss += u[i].x * u[i].x + u[i].y * u[i].y + u[i].z * u[i].z + u[i].w * u[i].w;
        }
        ss = wave_sum(ss);
        const float r = __builtin_amdgcn_rsqf(ss * (1.0f / 1024.0f) + 1e-6f);
        const float* gate = MOD + (size_t)(l * 3 + cond) * 6144 + (mode == 1 ? 2 : 5) * 1024;
#pragma unroll
        for (int i = 0; i < 4; ++i) {
          const float4 g4 = *(const float4*)(gate + i * 256 + lane * 4);
          const float4 a4 = *(const float4*)(ga + i * 256 + lane * 4);
          x[q][i].x += g4.x * (u[i].x * r * a4.x); x[q][i].y += g4.y * (u[i].y * r * a4.y);
          x[q][i].z += g4.z * (u[i].z * r * a4.z); x[q][i].w += g4.w * (u[i].w * r * a4.w);
        }
      }
      if (ok[q]) {
        if (has_next) {
#pragma unroll
          for (int i = 0; i < 4; ++i) { uint2 o; o.x = pk2(x[q][i].x, x[q][i].y); o.y = pk2(x[q][i].z, x[q][i].w); *(uint2*)(X16 + (size_t)row * D + i * 256 + lane * 4) = o; }
        } else {
#pragma unroll
          for (int i = 0; i < 4; ++i) *(float4*)(p.out + (size_t)row * D + i * 256 + lane * 4) = x[q][i];
        }
      }
      if (has_next) {
        float ss = 0;
#pragma unroll
        for (int i = 0; i < 4; ++i) ss += x[q][i].x * x[q][i].x + x[q][i].y * x[q][i].y + x[q][i].z * x[q][i].z + x[q][i].w * x[q][i].w;
        ss = wave_sum(ss);
        const float r2 = __builtin_amdgcn_rsqf(ss * (1.0f / 1024.0f) + 1e-6f);
        const float* sh = MOD + (size_t)(ln * 3 + cond) * 6144 + shi * 1024;
        const float* sc = MOD + (size_t)(ln * 3 + cond) * 6144 + sci * 1024;
        if (ok[q]) {
#pragma unroll
          for (int i = 0; i < 4; ++i) {
            const float4 g4 = *(const float4*)(gb + i * 256 + lane * 4);
            const float4 s4 = *(const float4*)(sc + i * 256 + lane * 4);
            const float4 h4 = *(const float4*)(sh + i * 256 + lane * 4);
            const float h0 = x[q][i].x * r2 * g4.x * (1.0f + s4.x) + h4.x;
            const float h1 = x[q][i].y * r2 * g4.y * (1.0f + s4.y) + h4.y;
            const float h2 = x[q][i].z * r2 * g4.z * (1.0f + s4.z) + h4.z;
            const float h3 = x[q][i].w * r2 * g4.w * (1.0f + s4.w) + h4.w;
            uint2 o; o.x = pk2(h0, h1); o.y = pk2(h2, h3);
            *(uint2*)(H + (size_t)row * D + i * 256 + lane * 4) = o;
          }
        }
      }
    }
  }
}

namespace pg8 {
#define PG8_LAS __attribute__((address_space(3)))
typedef unsigned short bf16_t;
typedef short bf16x8 __attribute__((ext_vector_type(8)));
typedef float f32x4 __attribute__((ext_vector_type(4)));
typedef unsigned u32x4 __attribute__((ext_vector_type(4)));
constexpr int BM = 256, BK = 64, HALF = 128, HTB = HALF * BK * 2  , STAGE_BYTES = 8 * HTB, NXCD = 8, WGM = 8;

__host__ __device__ __forceinline__ int lds_byte(int r, int c) { const int st = (r >> 4) * 2 + (c >> 5), rr = r & 15, cc = c & 31, ob = rr * 64 + cc * 2; return st * 1024 + (ob ^ (((ob >> 9) & 1) << 5)); }
__host__ __device__ __forceinline__ void stage_rc(int b, int& R, int& C) { const int st = b / 1024, sb = b % 1024, swz = sb ^ (((sb >> 9) & 1) << 5); R = (st >> 1) * 16 + swz / 64; C = (st & 1) * 32 + (swz % 64) / 2; }
__host__ __device__ __forceinline__ int perm32(int rho) { const int n = rho >> 4, i = rho & 15; return 8 * (i >> 2) + 4 * n + (i & 3); }

struct Unit { int pm, pn; };
struct Gemm { const bf16_t* A; const bf16_t* Bt; int M, N, K; };

struct StaticOrder {
    int nM, nN, nwg, G, c;
    __host__ __device__ void init(int M, int N, int G_, int c_) { nM = M / BM; nN = N / BM; nwg = nM * nN; G = G_; c = c_; }
    __host__ __device__ bool next(int i, Unit& u) const {
        const long L = (long)i * G + c; if (L >= nwg) return false;
        int wgid = (int)L; { const int q = nwg / NXCD, r = nwg % NXCD, xcd = wgid % NXCD, off = wgid / NXCD; wgid = (xcd < r ? xcd * (q + 1) : r * (q + 1) + (xcd - r) * q) + off; }
        const int nig = WGM * nN, gid = wgid / nig, fm = gid * WGM, gsz = (nM - fm) < WGM ? (nM - fm) : WGM;
        u.pm = fm + ((wgid % nig) % gsz); u.pn = (wgid % nig) / gsz; return true;
    }
    __device__ __forceinline__ void a_ready(const Unit&) const {}
    __device__ __forceinline__ void done(const Unit&) const {}
};

template <class Epi, class Sched, bool ALIGN_EPI = false, bool SP2 = false>
__device__ __forceinline__ void gemm_phase(PG8_LAS unsigned char* lds, const Gemm g, const Sched& S, const Epi& E) {
    int tid_z; asm volatile("v_mov_b32 %0, 0" : "=v"(tid_z)); const int tid = (int)threadIdx.x + tid_z, wid = __builtin_amdgcn_readfirstlane(tid >> 6), lane = tid & 63, wr = wid >> 2, wc = wid & 3, fr = lane & 15, fq = lane >> 4;
    const int K = g.K, nt = K / BK;
    unsigned voffA[2], voffB[2];
#pragma unroll
    for (int i = 0; i < 2; ++i) { int R, C; stage_rc(tid * 16 + i * 8192, R, C); const int Rb = Epi::PERM ? ((R & ~31) + perm32(R & 31)) : R;
        voffA[i] = (unsigned)(R * K + C) * 2u; voffB[i] = (unsigned)(Rb * K + C) * 2u; }
    const size_t kstep = (size_t)(BK * 2);
    const size_t hstep = (size_t)HALF * K * 2;
    const size_t tstep = 2 * hstep;
    const unsigned ldsw = (unsigned)wid * 1024u;
    const int aoff = lds_byte(wr * 64 + fr, fq * 8), boff = lds_byte(wc * 32 + fr, fq * 8);
#define PG8_SA(b, h) (((b) * 2 + (h)) * HTB)
#define PG8_SB(b, h) ((4 + (b) * 2 + (h)) * HTB)
#define PG8_STAGE(bufoff, gbase, voff) do { _Pragma("unroll") for (int _i = 0; _i < 2; ++_i) \
        __builtin_amdgcn_global_load_lds((const unsigned*)((const char*)(gbase) + (voff)[_i]), (PG8_LAS unsigned*)(lds + (bufoff) + ldsw + _i * 8192), 16, 0, 0); } while (0)
#define PG8_LDA(dst, b, h) do { _Pragma("unroll") for (int m = 0; m < 4; ++m) _Pragma("unroll") for (int k = 0; k < 2; ++k) dst[m][k] = *(const PG8_LAS bf16x8*)(lds + PG8_SA(b, h) + aoff + m * 2048 + k * 1024); } while (0)
#define PG8_LDB(dst, b, h) do { _Pragma("unroll") for (int n = 0; n < 2; ++n) _Pragma("unroll") for (int k = 0; k < 2; ++k) dst[n][k] = *(const PG8_LAS bf16x8*)(lds + PG8_SB(b, h) + boff + n * 2048 + k * 1024); } while (0)
#define PG8_MMA(ai, bj, At, Bt) do { __builtin_amdgcn_s_setprio(1); _Pragma("unroll") for (int m = 0; m < 4; ++m) _Pragma("unroll") for (int n = 0; n < 2; ++n) _Pragma("unroll") for (int k = 0; k < 2; ++k) \
        acc[ai][bj][m][n] = __builtin_amdgcn_mfma_f32_16x16x32_bf16(Bt[n][k], At[m][k], acc[ai][bj][m][n], 0, 0, 0); __builtin_amdgcn_s_setprio(0); } while (0)
#define PG8_WAIT_V(n) asm volatile("s_waitcnt vmcnt(" #n ")" ::: "memory")
#define PG8_WAIT_L(n) asm volatile("s_waitcnt lgkmcnt(" #n ")" ::: "memory")
#define PG8_BAR __builtin_amdgcn_s_barrier()
#define PG8_SCHED __builtin_amdgcn_sched_barrier(0)
    Unit cur, nxt; int ui = 0;
    if (!S.next(0, cur)) return;
    f32x4 acc[2][2][4][2];
#pragma unroll
    for (int a = 0; a < 2; ++a)
#pragma unroll
        for (int b = 0; b < 2; ++b)
#pragma unroll
            for (int m = 0; m < 4; ++m)
#pragma unroll
                for (int n = 0; n < 2; ++n) acc[a][b][m][n] = (f32x4){0.f, 0.f, 0.f, 0.f};
    bf16x8 At[4][2], B0[2][2], B1[2][2];
    const char* cA = (const char*)g.A + (size_t)cur.pm * tstep; const char* cB = (const char*)g.Bt + (size_t)cur.pn * tstep;
    S.a_ready(cur);
    if constexpr (SP2) {
        PG8_STAGE(PG8_SB(0, 0), cB, voffB); PG8_STAGE(PG8_SB(0, 1), cB + hstep, voffB); PG8_STAGE(PG8_SA(0, 0), cA, voffA); PG8_STAGE(PG8_SA(0, 1), cA + hstep, voffA);
        if (wr == 1) PG8_BAR;
        PG8_WAIT_V(2); PG8_BAR;
        PG8_STAGE(PG8_SB(1, 0), cB + kstep, voffB); PG8_STAGE(PG8_SA(1, 0), cA + kstep, voffA); PG8_STAGE(PG8_SB(1, 1), cB + hstep + kstep, voffB);
        PG8_WAIT_V(6); PG8_BAR;
    } else {
        PG8_STAGE(PG8_SB(0, 0), cB, voffB); PG8_STAGE(PG8_SA(0, 0), cA, voffA); PG8_STAGE(PG8_SB(0, 1), cB + hstep, voffB); PG8_STAGE(PG8_SA(0, 1), cA + hstep, voffA);
        if (wr == 1) PG8_BAR;
        PG8_WAIT_V(4); PG8_BAR;
        PG8_STAGE(PG8_SB(1, 0), cB + kstep, voffB); PG8_STAGE(PG8_SA(1, 0), cA + kstep, voffA); PG8_STAGE(PG8_SB(1, 1), cB + hstep + kstep, voffB);
        PG8_WAIT_V(6); PG8_BAR;
    }
    for (;;) {
        const bool has_next = S.next(ui + 1, nxt);
        const char* nA = has_next ? (const char*)g.A + (size_t)nxt.pm * tstep : cA; const char* nB = has_next ? (const char*)g.Bt + (size_t)nxt.pn * tstep : cB;
        for (int t = 0; t < nt; t += 2) {
            const bool last = (t == nt - 2);
            const char* a1 = cA + (size_t)(t + 1) * kstep;
            const char* a2 = last ? nA : cA + (size_t)(t + 2) * kstep; const char* b2 = last ? nB : cB + (size_t)(t + 2) * kstep;
            const char* a3 = a2 + kstep; const char* b3 = b2 + kstep;
            if (last && has_next) S.a_ready(nxt);
            if constexpr (SP2) {
            PG8_LDB(B0, 0, 0); PG8_LDB(B1, 0, 1); PG8_SCHED; PG8_LDA(At, 0, 0); PG8_STAGE(PG8_SA(1, 1), a1 + hstep, voffA);
            PG8_WAIT_V(8); PG8_WAIT_L(0); PG8_BAR; PG8_MMA(0, 0, At, B0); PG8_MMA(0, 1, At, B1); PG8_BAR; PG8_SCHED;
            PG8_LDA(At, 0, 1); PG8_STAGE(PG8_SB(0, 0), b2, voffB); PG8_STAGE(PG8_SB(0, 1), b2 + hstep, voffB); PG8_STAGE(PG8_SA(0, 0), a2, voffA);
            PG8_WAIT_V(8); PG8_WAIT_L(0); PG8_BAR; PG8_MMA(1, 0, At, B0); PG8_MMA(1, 1, At, B1); PG8_BAR; PG8_SCHED;
            PG8_LDB(B0, 1, 0); PG8_LDB(B1, 1, 1); PG8_SCHED; PG8_LDA(At, 1, 0); PG8_STAGE(PG8_SA(0, 1), a2 + hstep, voffA);
            PG8_WAIT_V(8); PG8_WAIT_L(0); PG8_BAR; PG8_MMA(0, 0, At, B0); PG8_MMA(0, 1, At, B1); PG8_BAR; PG8_SCHED;
            PG8_LDA(At, 1, 1); PG8_STAGE(PG8_SB(1, 0), b3, voffB); PG8_STAGE(PG8_SB(1, 1), b3 + hstep, voffB); PG8_STAGE(PG8_SA(1, 0), a3, voffA);
            PG8_WAIT_V(8); PG8_WAIT_L(0); PG8_BAR; PG8_MMA(1, 0, At, B0); PG8_MMA(1, 1, At, B1); PG8_BAR; PG8_SCHED;
            } else {
            PG8_LDB(B0, 0, 0); PG8_SCHED; PG8_LDA(At, 0, 0); PG8_STAGE(PG8_SA(1, 1), a1 + hstep, voffA);
            PG8_WAIT_L(8); PG8_BAR; PG8_WAIT_L(0); PG8_MMA(0, 0, At, B0); PG8_BAR; PG8_SCHED;
            PG8_LDB(B1, 0, 1); PG8_STAGE(PG8_SB(0, 0), b2, voffB);
            PG8_BAR; PG8_WAIT_L(0); PG8_MMA(0, 1, At, B1); PG8_BAR;
            PG8_LDA(At, 0, 1); PG8_STAGE(PG8_SA(0, 0), a2, voffA);
            PG8_BAR; PG8_WAIT_L(0); PG8_MMA(1, 0, At, B0); PG8_BAR; PG8_SCHED;
            PG8_STAGE(PG8_SB(0, 1), b2 + hstep, voffB);
            PG8_WAIT_V(6); PG8_BAR; PG8_MMA(1, 1, At, B1); PG8_BAR;
            PG8_LDB(B0, 1, 0); PG8_SCHED; PG8_LDA(At, 1, 0); PG8_STAGE(PG8_SA(0, 1), a2 + hstep, voffA);
            PG8_WAIT_L(8); PG8_BAR; PG8_WAIT_L(0); PG8_MMA(0, 0, At, B0); PG8_BAR; PG8_SCHED;
            PG8_LDB(B1, 1, 1); PG8_STAGE(PG8_SB(1, 0), b3, voffB);
            PG8_BAR; PG8_WAIT_L(0); PG8_MMA(0, 1, At, B1); PG8_BAR;
            PG8_LDA(At, 1, 1); PG8_STAGE(PG8_SA(1, 0), a3, voffA);
            PG8_BAR; PG8_WAIT_L(0); PG8_MMA(1, 0, At, B0); PG8_BAR; PG8_SCHED;
            PG8_STAGE(PG8_SB(1, 1), b3 + hstep, voffB);
            PG8_WAIT_V(6); PG8_BAR; PG8_MMA(1, 1, At, B1); PG8_BAR;
            }
        }
        if constexpr (ALIGN_EPI) { if (wr == 0) PG8_BAR; }
        if constexpr (!Epi::AFTER_DRAIN) { E(acc, cur, wr, wc, fr, fq); S.done(cur); }
        if (!has_next) break;
#pragma unroll
        for (int a = 0; a < 2; ++a)
#pragma unroll
            for (int b = 0; b < 2; ++b)
#pragma unroll
                for (int m = 0; m < 4; ++m)
#pragma unroll
                    for (int n = 0; n < 2; ++n) acc[a][b][m][n] = (f32x4){0.f, 0.f, 0.f, 0.f};
        cur = nxt; cA = nA; cB = nB; ++ui;
        if constexpr (ALIGN_EPI) { if (wr == 1) PG8_BAR; }
    }
    PG8_WAIT_V(0);
    if constexpr (!ALIGN_EPI) { if (wr == 0) PG8_BAR; }
    PG8_BAR;
    if constexpr (Epi::AFTER_DRAIN) { E.fused(acc, cur, wr, wc, fr, fq, lds, wid, lane); S.done(cur); }
#undef PG8_SA
#undef PG8_SB
#undef PG8_STAGE
#undef PG8_LDA
#undef PG8_LDB
#undef PG8_MMA
#undef PG8_WAIT_V
#undef PG8_WAIT_L
#undef PG8_BAR
#undef PG8_SCHED
}
}

template <int MODE> struct EpiMK {
  static constexpr bool PERM = true, AFTER_DRAIN = false;
  const Params* pp; int l;
  DEV void operator()(const pg8::f32x4 (&acc)[2][2][4][2], const pg8::Unit& u, int wr, int wc, int fr, int fq) const {
    const Params& p = *pp;
#pragma unroll
    for (int ai = 0; ai < 2; ++ai)
#pragma unroll
      for (int m = 0; m < 4; ++m) {
        const int row = u.pm * 256 + ai * 128 + wr * 64 + m * 16 + fr;
#pragma unroll
        for (int bj = 0; bj < 2; ++bj) {
          const int col = u.pn * 256 + bj * 128 + wc * 32 + fq * 8;
          const pg8::f32x4 v0 = acc[ai][bj][m][0], v1 = acc[ai][bj][m][1];
          if (MODE == 0) {
            if (col < DIN) {
              uint4 o; o.x = pk2(v0[0], v0[1]); o.y = pk2(v0[2], v0[3]); o.z = pk2(v1[0], v1[1]); o.w = pk2(v1[2], v1[3]);
              *(uint4*)((bf16_t*)(p.ws + OFF_P) + (size_t)row * DIN + col) = o;
              if (row < NCTX) {
                if (col >= C_NK && col < C_HQ) {
                  const int kv = col >= C_NV;
                  float* dst = p.out + O_NAT + (size_t)(((row >> 8) * 4 + l) * 2 + kv) * 65536 + (row & 255) * 256 + (col - (kv ? C_NV : C_NK));
                  *(pg8::f32x4*)dst = v0; *(pg8::f32x4*)(dst + 4) = v1;
                } else if (col >= C_SK) {
                  const int kv = col >= C_SV;
                  float* dst = p.out + O_SWA + (size_t)(((row >> 8) * 4 + l) * 2 + kv) * 32768 + (row & 255) * 128 + (col - (kv ? C_SV : C_SK));
                  *(pg8::f32x4*)dst = v0; *(pg8::f32x4*)(dst + 4) = v1;
                }
              }
            }
          } else if (MODE == 1) {
            uint4 o; o.x = pk2(v0[0], v0[1]); o.y = pk2(v0[2], v0[3]); o.z = pk2(v1[0], v1[1]); o.w = pk2(v1[2], v1[3]);
            *(uint4*)((bf16_t*)(p.ws + OFF_U) + (size_t)row * D + col) = o;
          } else {
            float r[8];
#pragma unroll
            for (int e = 0; e < 4; ++e) { const float a = fmaxf(v0[e], 0.f), b2 = fmaxf(v1[e], 0.f); r[e] = a * a; r[4 + e] = b2 * b2; }
            uint4 o; o.x = pk2(r[0], r[1]); o.y = pk2(r[2], r[3]); o.z = pk2(r[4], r[5]); o.w = pk2(r[6], r[7]);
            *(uint4*)((bf16_t*)(p.ws + OFF_HID) + (size_t)row * FF + col) = o;
          }
        }
      }
  }
};

template <int MODE>
DEV void gemm_run(const Params& p, int l, const bf16_t* A, const bf16_t* BT, int K, int N, char* lds) {
  pg8::Gemm g{A, BT, MT, N, K};
  pg8::StaticOrder S; S.init(MT, N, (int)gridDim.x, (int)blockIdx.x);
  EpiMK<MODE> E{&p, l};
  pg8::gemm_phase<EpiMK<MODE>, pg8::StaticOrder, true, true>((PG8_LAS unsigned char*)lds, g, S, E);
  if (MODE == 1 && l < 3 && (int)gridDim.x > 160 && (int)blockIdx.x >= 160) {
    if (K == D) layer_tiles(p, l + 1, 0, 640, (int)blockIdx.x - 160, (int)gridDim.x - 160, lds);
    else layer_tiles(p, l + 1, 640, NT_LAYER, (int)blockIdx.x - 160, (int)gridDim.x - 160, lds);
  }
}

constexpr int TOKT = 20;
DEV void prep_item(const Params& p, int l, int tile, char* lds) {
  const int t = tid(), r0 = tile * TOKT, c = t;
  bf16_t* sA = (bf16_t*)lds;
  float* swl = (float*)(lds + 32 * 136 * 2);
  float* sal = swl + TOKT * 256;
  const bf16_t* P = (const bf16_t*)(p.ws + OFF_P);
  bf16_t* PREP = (bf16_t*)(p.ws + OFF_PREP);
  bf16_t* BON = (bf16_t*)(p.ws + OFF_BONUS);
  for (int dir = 0; dir < 2; ++dir) {
    __syncthreads();
#pragma unroll
    for (int i = 0; i < TOKT / 2; ++i) {
      const int e = t + 256 * i, tk = e >> 7, j = e & 127, which = j >> 6, jj = j & 63;
      const int row = r0 + tk, prow = dir ? row + 1 : row - 1;
      const int tis = row < NCTX ? (row & 255) : ((row - NCTX) & 1023), Tm1 = row < NCTX ? 255 : 1023;
      const bool pv = dir ? (tis < Tm1) : (tis > 0);
      const int col = (dir ? C_WHB : C_WHF) + which * 64 + jj;
      const float cur = bf2f(P[(size_t)row * DIN + col]);
      const float prev = bf2f(P[(size_t)(pv ? prow : row) * DIN + col]) * (pv ? 1.f : 0.f);
      const float mu = p.in[I_MULORA][((l * 2 + dir) * 2 + which) * 64 + jj];
      const float val = cur + (prev - cur) * mu;
      sA[tk * 136 + j] = f2bf((which == 0) ? tanhf_(val) : val);
    }
    __syncthreads();
    {
      const int lane = t & 63, w = t >> 6, q = lane & 31, hh = lane >> 5;
#pragma unroll
      for (int mat = 0; mat < 2; ++mat) {
        bf16x8 af[4];
#pragma unroll
        for (int s = 0; s < 4; ++s) af[s] = *(const bf16x8*)(sA + q * 136 + mat * 64 + 16 * s + 8 * hh);
        const bf16_t* WT = (const bf16_t*)(p.ws + (mat ? OFF_A2T : OFF_W2T)) + (size_t)(l * 2 + dir) * 256 * 64;
        float* dst = mat ? sal : swl;
#pragma unroll
        for (int nt = 0; nt < 2; ++nt) {
          const int n = w * 64 + nt * 32 + q;
          f32x16 acc;
#pragma unroll
          for (int r = 0; r < 16; ++r) acc[r] = 0.f;
#pragma unroll
          for (int s = 0; s < 4; ++s) acc = MFMA32(af[s], *(const bf16x8*)(WT + (size_t)n * 64 + 16 * s + 8 * hh), acc);
#pragma unroll
          for (int r = 0; r < 8; ++r) dst[((r & 3) + 8 * (r >> 2) + 4 * hh) * 256 + n] = acc[r];
          if (hh == 0) {
#pragma unroll
            for (int r = 8; r < 12; ++r) dst[((r & 3) + 16) * 256 + n] = acc[r];
          }
        }
      }
    }
    __syncthreads();
    const float w0v = p.in[I_W0][(l * 2 + dir) * 256 + c], a0v = p.in[I_A0][(l * 2 + dir) * 256 + c];
    const float kkv = p.in[I_KK][l * 256 + c], kav = p.in[I_KA][l * 256 + c], rkv = p.in[I_RK][l * 256 + c];
    const float mur = p.in[I_MURKV][((l * 2 + dir) * 3 + 0) * 256 + c], muk = p.in[I_MURKV][((l * 2 + dir) * 3 + 1) * 256 + c],
                muv = p.in[I_MURKV][((l * 2 + dir) * 3 + 2) * 256 + c];
    bf16_t* pr = PREP + (size_t)dir * 6 * ARRF;
    for (int tb = 0; tb < TOKT; tb += 5) {
      float rc[5], kc[5], vc[5], rp[5], kq[5], vp[5], wlv[5], alv[5];
#pragma unroll
      for (int u = 0; u < 5; ++u) {
        const int tk = tb + u, row = r0 + tk, prow = dir ? row + 1 : row - 1;
        const int tis = row < NCTX ? (row & 255) : ((row - NCTX) & 1023), Tm1 = row < NCTX ? 255 : 1023;
        const bool pv = dir ? (tis < Tm1) : (tis > 0);
        const float pm = pv ? 1.f : 0.f;
        const bf16_t* pc = P + (size_t)row * DIN + c;
        const bf16_t* pp = P + (size_t)(pv ? prow : row) * DIN + c;
        rc[u] = bf2f(pc[C_R]); kc[u] = bf2f(pc[C_K]); vc[u] = bf2f(pc[C_V]);
        rp[u] = bf2f(pp[C_R]) * pm; kq[u] = bf2f(pp[C_K]) * pm; vp[u] = bf2f(pp[C_V]) * pm;
        wlv[u] = swl[tk * 256 + c]; alv[u] = sal[tk * 256 + c];
      }
      float bprev[5];
#pragma unroll
      for (int u = 0; u < 5; ++u) bprev[u] = (dir == 1) ? bf2f(BON[(size_t)(r0 + tb + u) * 256 + c]) : 0.f;
#pragma unroll
      for (int u = 0; u < 5; ++u) {
        const int row = r0 + tb + u;
        const float rs = rc[u] + (rp[u] - rc[u]) * mur, ks = kc[u] + (kq[u] - kc[u]) * muk, vs = vc[u] + (vp[u] - vc[u]) * muv;
        const float wl = w0v + wlv[u], al = a0v + alv[u];
        const float wv = __expf(-0.6065306597126334f * sigmoidf_(wl));
        const float av = sigmoidf_(al);
        const float kkr = ks * kkv;
        const float n2 = wave_sum(kkr * kkr);
        const float kk = kkr * rcpf_(fmaxf(__builtin_amdgcn_sqrtf(n2), 1e-12f));
        const float kp = ks * (1.0f + (av - 1.0f) * kav);
        const float bs = wave_sum(rs * kp * rkv);
        const float bon = bs * vs;
        const size_t idx = (size_t)row * 256 + c;
        pr[idx] = f2bf(rs); pr[ARRF + idx] = f2bf(wv); pr[2 * ARRF + idx] = f2bf(kp); pr[3 * ARRF + idx] = f2bf(vs); pr[4 * ARRF + idx] = f2bf(kk); pr[5 * ARRF + idx] = f2bf(kk * av);
        BON[idx] = f2bf(bprev[u] + bon);
      }
    }
  }
  __syncthreads();
}

DEV void rope_item(const Params& p, int item) {
  bf16_t* P = (bf16_t*)(p.ws + OFF_P);
  const int t = tid();
  for (int e = t; e < 64 * 192; e += 256) {
    const int tk = e / 192, r = e % 192, hs = r >> 5, pi = r & 31;
    const int lt = item * 64 + tk;
    const int tt = lt & 1023;
    const int grow = tt >> 6, gcol = tt & 63;
    const int fi = pi & 15;
    const float pos = (pi < 16) ? (float)grow : (float)gcol;
    const float inv = exp2f(-(float)fi * (13.287712379549449f / 16.0f));
    const float ang = pos * inv;
    const float cs = __cosf(ang), sn = __sinf(ang);
    const int d1 = (pi < 16) ? fi : 32 + fi;
    bf16_t* base = P + (size_t)(NCTX + lt) * DIN + C_SQ + hs * 64;
    const float x1 = bf2f(base[d1]), x2 = bf2f(base[d1 + 16]);
    base[d1] = f2bf(x1 * cs - x2 * sn);
    base[d1 + 16] = f2bf(x2 * cs + x1 * sn);
  }
}

constexpr int SC_BUF = 20480 + 4096;
typedef float f2 __attribute__((ext_vector_type(2)));
DEV float dot4(const float4& a, const float4& b) { return a.x * b.x + a.y * b.y + a.z * b.z + a.w * b.w; }
DEV float red8(float x) { x += dppf<0xB1>(x); x += dppf<0x4E>(x); x += dppf<0x141>(x); return x; }
DEV float dot8(const f2 (&S)[4], const float4& a, const float4& b) {
  f2 acc = S[0] * (f2){a.x, a.y};
  acc += S[1] * (f2){a.z, a.w}; acc += S[2] * (f2){b.x, b.y}; acc += S[3] * (f2){b.z, b.w};
  return acc.x + acc.y;
}

template <int NCH>
DEV void rwkv_scan(const Params& p, int l, int seq, int head, int dir, int rsel, char* lds) {
  const int t = tid(), rr = t >> 3, g = t & 7, rl = t >> 4, ks = t & 15;
  const int T = seq < 32 ? 256 : 1024;
  const int row0 = seq < 32 ? seq * 256 : NCTX + (seq - 32) * 1024;
  const bf16_t* prep = (const bf16_t*)(p.ws + OFF_PREP) + (size_t)dir * 6 * ARRF;
  float* ydir = (float*)(p.ws + OFF_YDIR) + (size_t)dir * ARRF;
  const int vbase = (NCH == 2) ? 0 : rsel * 32;
  f2 S[NCH][4];
#pragma unroll
  for (int c = 0; c < NCH; ++c)
#pragma unroll
    for (int j = 0; j < 4; ++j) S[c][j] = (f2){0.f, 0.f};
  if (seq >= 32) {
    const float* sp = p.in[I_SRW] + ((((size_t)(seq - 32) * 4 + l) * 2 + dir) * 4 + head) * 4096 + g * 8;
#pragma unroll
    for (int c = 0; c < NCH; ++c) {
      const float4 a = *(const float4*)(sp + (vbase + rr + 32 * c) * 64), b = *(const float4*)(sp + (vbase + rr + 32 * c) * 64 + 4);
      S[c][0] = (f2){a.x, a.y}; S[c][1] = (f2){a.z, a.w}; S[c][2] = (f2){b.x, b.y}; S[c][3] = (f2){b.z, b.w};
    }
  }
  const int nch = T >> 4;
  uint2 pre0, pre1, pre2, pre3, pre4, pvv;
#define RW_LOAD(cc) do { const int s_ = (cc) * 16 + rl; const int tok_ = dir ? (T - 1 - s_) : s_; \
    const size_t base_ = (size_t)(row0 + tok_) * 256 + head * 64; \
    pre0 = *(const uint2*)(prep + base_ + ks * 4); pre1 = *(const uint2*)(prep + ARRF + base_ + ks * 4); \
    pre2 = *(const uint2*)(prep + 2 * ARRF + base_ + ks * 4); pre3 = *(const uint2*)(prep + 4 * ARRF + base_ + ks * 4); \
    pre4 = *(const uint2*)(prep + 5 * ARRF + base_ + ks * 4); \
    if (NCH == 2) pvv = *(const uint2*)(prep + 3 * ARRF + base_ + ks * 4); \
    else pvv.x = *(const unsigned*)(prep + 3 * ARRF + base_ + vbase + ks * 2); } while (0)
#define RW_WRITE(bb) do { float4* sb_ = (float4*)(lds + (bb) * SC_BUF); float* vb_ = (float*)(lds + (bb) * SC_BUF + 20480); \
    sb_[(0 * 16 + rl) * 16 + ks] = bf4(pre0); sb_[(1 * 16 + rl) * 16 + ks] = bf4(pre1); sb_[(2 * 16 + rl) * 16 + ks] = bf4(pre2); \
    sb_[(3 * 16 + rl) * 16 + ks] = bf4(pre3); sb_[(4 * 16 + rl) * 16 + ks] = bf4(pre4); \
    if (NCH == 2) *(float4*)(vb_ + rl * 64 + ks * 4) = bf4(pvv); else *(f2*)(vb_ + rl * 64 + ks * 2) = (f2){bflo(pvv.x), bfhi(pvv.x)}; } while (0)
  __syncthreads();
  RW_LOAD(0); RW_WRITE(0);
  __syncthreads();
  for (int c = 0; c < nch; ++c) {
    if (c + 1 < nch) RW_LOAD(c + 1);
    const float4* sbuf = (const float4*)(lds + (c & 1) * SC_BUF);
    const float* vbuf = (const float*)(lds + (c & 1) * SC_BUF + 20480);
    float ym[NCH][2];
#pragma unroll
    for (int cc = 0; cc < NCH; ++cc) { ym[cc][0] = 0.f; ym[cc][1] = 0.f; }
#pragma unroll
    for (int i = 0; i < 16; ++i) {
      const float4 ra = sbuf[(0 * 16 + i) * 16 + g * 2], rb = sbuf[(0 * 16 + i) * 16 + g * 2 + 1];
      const float4 wa = sbuf[(1 * 16 + i) * 16 + g * 2], wb = sbuf[(1 * 16 + i) * 16 + g * 2 + 1];
      const float4 ka_ = sbuf[(2 * 16 + i) * 16 + g * 2], kb_ = sbuf[(2 * 16 + i) * 16 + g * 2 + 1];
      const float4 na = sbuf[(3 * 16 + i) * 16 + g * 2], nb = sbuf[(3 * 16 + i) * 16 + g * 2 + 1];
      const float4 aa = sbuf[(4 * 16 + i) * 16 + g * 2], ab = sbuf[(4 * 16 + i) * 16 + g * 2 + 1];
      const f2 w2[4] = {(f2){wa.x, wa.y}, (f2){wa.z, wa.w}, (f2){wb.x, wb.y}, (f2){wb.z, wb.w}};
      const f2 k2[4] = {(f2){ka_.x, ka_.y}, (f2){ka_.z, ka_.w}, (f2){kb_.x, kb_.y}, (f2){kb_.z, kb_.w}};
      const f2 a2[4] = {(f2){aa.x, aa.y}, (f2){aa.z, aa.w}, (f2){ab.x, ab.y}, (f2){ab.z, ab.w}};
#pragma unroll
      for (int cc = 0; cc < NCH; ++cc) {
        const float v = vbuf[i * 64 + rr + 32 * cc];
        const float sa = -red8(dot8(S[cc], na, nb));
#pragma unroll
        for (int j = 0; j < 4; ++j) S[cc][j] = S[cc][j] * w2[j] + a2[j] * sa + k2[j] * v;
        const float y = red8(dot8(S[cc], ra, rb));
        ym[cc][i >> 3] = (g == (i & 7)) ? y : ym[cc][i >> 3];
      }
    }
#pragma unroll
    for (int hh = 0; hh < 2; ++hh) {
      const int s = c * 16 + hh * 8 + g; const int tok = dir ? (T - 1 - s) : s;
      float* yo = ydir + (size_t)(row0 + tok) * 256 + head * 64 + vbase + rr;
#pragma unroll
      for (int cc = 0; cc < NCH; ++cc) yo[32 * cc] = ym[cc][hh];
    }
    if (c + 1 < nch) RW_WRITE((c + 1) & 1);
    __syncthreads();
  }
#undef RW_LOAD
#undef RW_WRITE
  if (seq < 32) {
    float* sp = p.out + O_RW + ((((size_t)seq * 4 + l) * 2 + dir) * 4 + head) * 4096 + g * 8;
#pragma unroll
    for (int c = 0; c < NCH; ++c) {
      *(float4*)(sp + (vbase + rr + 32 * c) * 64) = make_float4(S[c][0].x, S[c][0].y, S[c][1].x, S[c][1].y);
      *(float4*)(sp + (vbase + rr + 32 * c) * 64 + 4) = make_float4(S[c][2].x, S[c][2].y, S[c][3].x, S[c][3].y);
    }
  }
}

template <int NCH>
DEV void hgrn_scan(const Params& p, int l, int seq, int head, int dir, int rsel, char* lds) {
  const int t = tid(), rr = t >> 3, g = t & 7, rl = t >> 4, ks = t & 15;
  const int T = seq < 32 ? 256 : 1024;
  const int row0 = seq < 32 ? seq * 256 : NCTX + (seq - 32) * 1024;
  const bf16_t* P = (const bf16_t*)(p.ws + OFF_P);
  float* odir = (float*)(p.ws + OFF_HDIR) + (size_t)dir * ARRF;
  const float4 lb4 = *(const float4*)((const float*)(p.ws + OFF_HGLB) + (l * 2 + dir) * 256 + head * 64 + ks * 4);
  const int vbase = (NCH == 2) ? 0 : rsel * 32;
  f2 S[NCH][4];
#pragma unroll
  for (int c = 0; c < NCH; ++c)
#pragma unroll
    for (int j = 0; j < 4; ++j) S[c][j] = (f2){0.f, 0.f};
  if (seq >= 32) {
    const float* sp = p.in[I_SHG] + ((((size_t)(seq - 32) * 4 + l) * 2 + dir) * 4 + head) * 4096;
#pragma unroll
    for (int c = 0; c < NCH; ++c)
#pragma unroll
      for (int j = 0; j < 4; ++j) {
        const int v = vbase + rr + 32 * c;
        S[c][j] = (f2){sp[(g * 8 + 2 * j) * 64 + v], sp[(g * 8 + 2 * j + 1) * 64 + v]};
      }
  }
  const int nch = T >> 4;
  const int fcol = (dir ? C_HFB : C_HFF) + head * 64;
  uint2 pq, pf, pv2;
#define HG_LOAD(cc) do { const int s_ = (cc) * 16 + rl; const int tok_ = dir ? (T - 1 - s_) : s_; \
    const bf16_t* pr_ = P + (size_t)(row0 + tok_) * DIN; \
    pq = *(const uint2*)(pr_ + C_HQ + head * 64 + ks * 4); pf = *(const uint2*)(pr_ + fcol + ks * 4); \
    if (NCH == 2) pv2 = *(const uint2*)(pr_ + C_HI + head * 64 + ks * 4); else pv2.x = *(const unsigned*)(pr_ + C_HI + head * 64 + vbase + ks * 2); } while (0)
#define HG_WRITE(bb) do { float4* sb_ = (float4*)(lds + (bb) * SC_BUF); float* vb_ = (float*)(lds + (bb) * SC_BUF + 20480); \
    float4 q_, f_, k_; float a_, sg_; \
    a_ = bflo(pq.x); q_.x = a_ * sigmoidf_(a_); a_ = bfhi(pq.x); q_.y = a_ * sigmoidf_(a_); \
    a_ = bflo(pq.y); q_.z = a_ * sigmoidf_(a_); a_ = bfhi(pq.y); q_.w = a_ * sigmoidf_(a_); \
    sg_ = sigmoidf_(bflo(pf.x)); f_.x = lb4.x + (1.f - lb4.x) * sg_; k_.x = (1.f - lb4.x) * (1.f - sg_); \
    sg_ = sigmoidf_(bfhi(pf.x)); f_.y = lb4.y + (1.f - lb4.y) * sg_; k_.y = (1.f - lb4.y) * (1.f - sg_); \
    sg_ = sigmoidf_(bflo(pf.y)); f_.z = lb4.z + (1.f - lb4.z) * sg_; k_.z = (1.f - lb4.z) * (1.f - sg_); \
    sg_ = sigmoidf_(bfhi(pf.y)); f_.w = lb4.w + (1.f - lb4.w) * sg_; k_.w = (1.f - lb4.w) * (1.f - sg_); \
    sb_[(0 * 16 + rl) * 16 + ks] = q_; sb_[(1 * 16 + rl) * 16 + ks] = f_; sb_[(2 * 16 + rl) * 16 + ks] = k_; \
    if (NCH == 2) *(float4*)(vb_ + rl * 64 + ks * 4) = make_float4(bflo(pv2.x), bfhi(pv2.x), bflo(pv2.y), bfhi(pv2.y)); \
    else *(f2*)(vb_ + rl * 64 + ks * 2) = (f2){bflo(pv2.x), bfhi(pv2.x)}; } while (0)
  __syncthreads();
  HG_LOAD(0); HG_WRITE(0);
  __syncthreads();
  for (int c = 0; c < nch; ++c) {
    if (c + 1 < nch) HG_LOAD(c + 1);
    const float4* sbuf = (const float4*)(lds + (c & 1) * SC_BUF);
    const float* vbuf = (const float*)(lds + (c & 1) * SC_BUF + 20480);
    float ym[NCH][2];
#pragma unroll
    for (int cc = 0; cc < NCH; ++cc) { ym[cc][0] = 0.f; ym[cc][1] = 0.f; }
#pragma unroll
    for (int i = 0; i < 16; ++i) {
      const float4 qa = sbuf[(0 * 16 + i) * 16 + g * 2], qb = sbuf[(0 * 16 + i) * 16 + g * 2 + 1];
      const float4 fa = sbuf[(1 * 16 + i) * 16 + g * 2], fb = sbuf[(1 * 16 + i) * 16 + g * 2 + 1];
      const float4 ka_ = sbuf[(2 * 16 + i) * 16 + g * 2], kb_ = sbuf[(2 * 16 + i) * 16 + g * 2 + 1];
      const f2 f2v[4] = {(f2){fa.x, fa.y}, (f2){fa.z, fa.w}, (f2){fb.x, fb.y}, (f2){fb.z, fb.w}};
      const f2 k2[4] = {(f2){ka_.x, ka_.y}, (f2){ka_.z, ka_.w}, (f2){kb_.x, kb_.y}, (f2){kb_.z, kb_.w}};
#pragma unroll
      for (int cc = 0; cc < NCH; ++cc) {
        const float v = vbuf[i * 64 + rr + 32 * cc];
#pragma unroll
        for (int j = 0; j < 4; ++j) S[cc][j] = S[cc][j] * f2v[j] + k2[j] * v;
        const float y = red8(dot8(S[cc], qa, qb));
        ym[cc][i >> 3] = (g == (i & 7)) ? y : ym[cc][i >> 3];
      }
    }
#pragma unroll
    for (int hh = 0; hh < 2; ++hh) {
      const int s = c * 16 + hh * 8 + g; const int tok = dir ? (T - 1 - s) : s;
      float* yo = odir + (size_t)(row0 + tok) * 256 + head * 64 + vbase + rr;
#pragma unroll
      for (int cc = 0; cc < NCH; ++cc) yo[32 * cc] = ym[cc][hh];
    }
    if (c + 1 < nch) HG_WRITE((c + 1) & 1);
    __syncthreads();
  }
#undef HG_LOAD
#undef HG_WRITE
  if (seq < 32) {
    float* sp = p.out + O_HG + ((((size_t)seq * 4 + l) * 2 + dir) * 4 + head) * 4096;
#pragma unroll
    for (int c = 0; c < NCH; ++c)
#pragma unroll
      for (int j = 0; j < 4; ++j) {
        const int v = vbase + rr + 32 * c;
        sp[(g * 8 + 2 * j) * 64 + v] = S[c][j].x; sp[(g * 8 + 2 * j + 1) * 64 + v] = S[c][j].y;
      }
  }
}

DEV void rwkv_scan16(const Params& p, int l, int seq, int head, int dir, int rg, char* lds) {
  const int t = tid(), rl = t >> 4, ks = t & 15;
  const int T = seq < 32 ? 256 : 1024;
  const int row0 = seq < 32 ? seq * 256 : NCTX + (seq - 32) * 1024;
  const bf16_t* prep = (const bf16_t*)(p.ws + OFF_PREP) + (size_t)dir * 6 * ARRF;
  float* ydir = (float*)(p.ws + OFF_YDIR) + (size_t)dir * ARRF;
  const int v0 = rg * 16 + rl;
  float4 S0 = make_float4(0.f, 0.f, 0.f, 0.f);
  if (seq >= 32) S0 = *(const float4*)(p.in[I_SRW] + ((((size_t)(seq - 32) * 4 + l) * 2 + dir) * 4 + head) * 4096 + ks * 4 + v0 * 64);
  const int nch = T >> 4;
  uint2 pre0, pre1, pre2, pre3, pre4; bf16_t pv0;
#define RW_LOAD(cc) do { const int s_ = (cc) * 16 + rl; const int tok_ = dir ? (T - 1 - s_) : s_; \
    const size_t base_ = (size_t)(row0 + tok_) * 256 + head * 64; \
    pre0 = *(const uint2*)(prep + base_ + ks * 4); pre1 = *(const uint2*)(prep + ARRF + base_ + ks * 4); \
    pre2 = *(const uint2*)(prep + 2 * ARRF + base_ + ks * 4); pre3 = *(const uint2*)(prep + 4 * ARRF + base_ + ks * 4); \
    pre4 = *(const uint2*)(prep + 5 * ARRF + base_ + ks * 4); pv0 = prep[3 * ARRF + base_ + rg * 16 + ks]; } while (0)
#define RW_WRITE(bb) do { float4* sb_ = (float4*)(lds + (bb) * SC_BUF); float* vb_ = (float*)(lds + (bb) * SC_BUF + 20480); \
    sb_[(0 * 16 + rl) * 16 + ks] = bf4(pre0); sb_[(1 * 16 + rl) * 16 + ks] = bf4(pre1); sb_[(2 * 16 + rl) * 16 + ks] = bf4(pre2); \
    sb_[(3 * 16 + rl) * 16 + ks] = bf4(pre3); sb_[(4 * 16 + rl) * 16 + ks] = bf4(pre4); vb_[rl * 16 + ks] = bf2f(pv0); } while (0)
  __syncthreads();
  RW_LOAD(0); RW_WRITE(0);
  __syncthreads();
  for (int c = 0; c < nch; ++c) {
    if (c + 1 < nch) RW_LOAD(c + 1);
    const float4* sbuf = (const float4*)(lds + (c & 1) * SC_BUF);
    const float* vbuf = (const float*)(lds + (c & 1) * SC_BUF + 20480);
    float ym0 = 0.f;
#pragma unroll
    for (int i = 0; i < 16; ++i) {
      const float4 r = sbuf[(0 * 16 + i) * 16 + ks], wv = sbuf[(1 * 16 + i) * 16 + ks], kv = sbuf[(2 * 16 + i) * 16 + ks],
                   kk = sbuf[(3 * 16 + i) * 16 + ks], ka = sbuf[(4 * 16 + i) * 16 + ks];
      const float va = vbuf[i * 16 + rl];
      const float sa0 = -row16_sum(dot4(S0, kk));
      S0.x = S0.x * wv.x + sa0 * ka.x + va * kv.x; S0.y = S0.y * wv.y + sa0 * ka.y + va * kv.y;
      S0.z = S0.z * wv.z + sa0 * ka.z + va * kv.z; S0.w = S0.w * wv.w + sa0 * ka.w + va * kv.w;
      const float y0 = row16_sum(dot4(S0, r));
      ym0 = (ks == i) ? y0 : ym0;
    }
    {
      const int s = c * 16 + ks; const int tok = dir ? (T - 1 - s) : s;
      ydir[(size_t)(row0 + tok) * 256 + head * 64 + v0] = ym0;
    }
    if (c + 1 < nch) RW_WRITE((c + 1) & 1);
    __syncthreads();
  }
#undef RW_LOAD
#undef RW_WRITE
  if (seq < 32) *(float4*)(p.out + O_RW + ((((size_t)seq * 4 + l) * 2 + dir) * 4 + head) * 4096 + ks * 4 + v0 * 64) = S0;
}

DEV void hgrn_scan16(const Params& p, int l, int seq, int head, int dir, int rg, char* lds) {
  const int t = tid(), rl = t >> 4, ks = t & 15;
  const int T = seq < 32 ? 256 : 1024;
  const int row0 = seq < 32 ? seq * 256 : NCTX + (seq - 32) * 1024;
  const bf16_t* P = (const bf16_t*)(p.ws + OFF_P);
  float* odir = (float*)(p.ws + OFF_HDIR) + (size_t)dir * ARRF;
  const float4 lb4 = *(const float4*)((const float*)(p.ws + OFF_HGLB) + (l * 2 + dir) * 256 + head * 64 + ks * 4);
  const int v0 = rg * 16 + rl;
  float4 S0 = make_float4(0.f, 0.f, 0.f, 0.f);
  if (seq >= 32) {
    const float* sp = p.in[I_SHG] + ((((size_t)(seq - 32) * 4 + l) * 2 + dir) * 4 + head) * 4096;
    S0.x = sp[(ks * 4 + 0) * 64 + v0]; S0.y = sp[(ks * 4 + 1) * 64 + v0]; S0.z = sp[(ks * 4 + 2) * 64 + v0]; S0.w = sp[(ks * 4 + 3) * 64 + v0];
  }
  const int nch = T >> 4;
  const int fcol = (dir ? C_HFB : C_HFF) + head * 64;
  uint2 pq, pf; bf16_t pva;
#define HG_LOAD(cc) do { const int s_ = (cc) * 16 + rl; const int tok_ = dir ? (T - 1 - s_) : s_; \
    const bf16_t* pr_ = P + (size_t)(row0 + tok_) * DIN; \
    pq = *(const uint2*)(pr_ + C_HQ + head * 64 + ks * 4); pf = *(const uint2*)(pr_ + fcol + ks * 4); \
    pva = pr_[C_HI + head * 64 + rg * 16 + ks]; } while (0)
#define HG_WRITE(bb) do { float4* sb_ = (float4*)(lds + (bb) * SC_BUF); float* vb_ = (float*)(lds + (bb) * SC_BUF + 20480); \
    float4 q_, f_, k_; float a_, sg_; \
    a_ = bflo(pq.x); q_.x = a_ * sigmoidf_(a_); a_ = bfhi(pq.x); q_.y = a_ * sigmoidf_(a_); \
    a_ = bflo(pq.y); q_.z = a_ * sigmoidf_(a_); a_ = bfhi(pq.y); q_.w = a_ * sigmoidf_(a_); \
    sg_ = sigmoidf_(bflo(pf.x)); f_.x = lb4.x + (1.f - lb4.x) * sg_; k_.x = (1.f - lb4.x) * (1.f - sg_); \
    sg_ = sigmoidf_(bfhi(pf.x)); f_.y = lb4.y + (1.f - lb4.y) * sg_; k_.y = (1.f - lb4.y) * (1.f - sg_); \
    sg_ = sigmoidf_(bflo(pf.y)); f_.z = lb4.z + (1.f - lb4.z) * sg_; k_.z = (1.f - lb4.z) * (1.f - sg_); \
    sg_ = sigmoidf_(bfhi(pf.y)); f_.w = lb4.w + (1.f - lb4.w) * sg_; k_.w = (1.f - lb4.w) * (1.f - sg_); \
    sb_[(0 * 16 + rl) * 16 + ks] = q_; sb_[(1 * 16 + rl) * 16 + ks] = f_; sb_[(2 * 16 + rl) * 16 + ks] = k_; \
    vb_[rl * 16 + ks] = bf2f(pva); } while (0)
  __syncthreads();
  HG_LOAD(0); HG_WRITE(0);
  __syncthreads();
  for (int c = 0; c < nch; ++c) {
    if (c + 1 < nch) HG_LOAD(c + 1);
    const float4* sbuf = (const float4*)(lds + (c & 1) * SC_BUF);
    const float* vbuf = (const float*)(lds + (c & 1) * SC_BUF + 20480);
    float ym0 = 0.f;
#pragma unroll
    for (int i = 0; i < 16; ++i) {
      const float4 q = sbuf[(0 * 16 + i) * 16 + ks], f = sbuf[(1 * 16 + i) * 16 + ks], k = sbuf[(2 * 16 + i) * 16 + ks];
      const float va = vbuf[i * 16 + rl];
      S0.x = S0.x * f.x + k.x * va; S0.y = S0.y * f.y + k.y * va; S0.z = S0.z * f.z + k.z * va; S0.w = S0.w * f.w + k.w * va;
      const float y0 = row16_sum(dot4(S0, q));
      ym0 = (ks == i) ? y0 : ym0;
    }
    {
      const int s = c * 16 + ks; const int tok = dir ? (T - 1 - s) : s;
      odir[(size_t)(row0 + tok) * 256 + head * 64 + v0] = ym0;
    }
    if (c + 1 < nch) HG_WRITE((c + 1) & 1);
    __syncthreads();
  }
#undef HG_LOAD
#undef HG_WRITE
  if (seq < 32) {
    float* sp = p.out + O_HG + ((((size_t)seq * 4 + l) * 2 + dir) * 4 + head) * 4096;
    sp[(ks * 4 + 0) * 64 + v0] = S0.x; sp[(ks * 4 + 1) * 64 + v0] = S0.y; sp[(ks * 4 + 2) * 64 + v0] = S0.z; sp[(ks * 4 + 3) * 64 + v0] = S0.w;
  }
}

template <int MODE>
DEV void attn_item(const Params& p, int l, int item, char* lds) {
  const int t = tid(), lane = t & 63, w = t >> 6, q = lane & 31, hh = lane >> 5;
  const bf16_t* P = (const bf16_t*)(p.ws + OFF_P);
  bf16_t* Y = (bf16_t*)(p.ws + OFF_YMIX);
  char* sK = lds;
  char* sV = lds + 8192;
  float* sBias = (float*)(lds + 8192 + 8704);
  int head, qrow, qcol, kcol, vcol, ocol, nloc, nt, rowbaseP;
  int qr = 0, qc = 0, rlo = 0, qpos = 0, lo = 0, rsq = 0, wsq = 0;
  float sink = 0.f;
  const float* cache = nullptr; int cH = 1, cHead = 0;
  if (MODE == 0 || MODE == 1) {
    const int b = item >> 3; head = (item >> 1) & 3; const int half = item & 1;
    rowbaseP = b * 256; qrow = rowbaseP + half * 128 + w * 32 + q; nloc = 4; nt = 4;
  } else {
    const int b = item >> 5; head = (item >> 3) & 3; const int sub = item & 7;
    rowbaseP = NCTX + b * 1024;
    if (MODE == 2) {
      qr = 2 * sub + (w >> 1); qc = (w & 1) * 32 + q; qrow = rowbaseP + qr * 64 + qc;
      rlo = clampi(2 * sub - 4, 0, 8); const int rhi = clampi(2 * sub - 3, 0, 8) + 7; nloc = rhi - rlo + 1; nt = nloc + 4;
      rsq = clampi(qr - 4, 0, 8); wsq = clampi(qc - 8, 0, 48);
      cache = p.in[I_CNAT] + (size_t)((b * 4 + l) * 2) * 256 * 256; cH = 4; cHead = head;
      for (int i = t; i < 465; i += 256) sBias[i] = p.in[I_RPB][(size_t)(l * 4 + head) * 465 + i];
    } else {
      qpos = sub * 128 + w * 32 + q; qrow = rowbaseP + qpos;
      lo = (sub - 1) * 128;
      nloc = 6; nt = nloc + 4;
      cache = p.in[I_CSWA] + (size_t)((b * 4 + l) * 2) * 256 * 128; cH = 2; cHead = head >> 1;
    }
  }
  if (MODE == 0 || MODE == 2) { qcol = C_NQ + head * 64; kcol = C_NK + head * 64; vcol = C_NV + head * 64; ocol = 256 + head * 64; }
  else { qcol = C_SQ + head * 64; kcol = C_SK + (head >> 1) * 64; vcol = C_SV + (head >> 1) * 64; ocol = 768 + head * 64; sink = p.in[I_SINK][l * 4 + head]; }

  bf16x8 bq[4];
#pragma unroll
  for (int s = 0; s < 4; ++s) bq[s] = *(const bf16x8*)(P + (size_t)qrow * DIN + qcol + 16 * s + 8 * hh);
  f32x16 oacc[2];
#pragma unroll
  for (int r = 0; r < 16; ++r) { oacc[0][r] = 0.f; oacc[1][r] = 0.f; }
  float m_run = -1e30f, l_run = 0.f;
  const int key = t >> 2, dq = t & 3;
  const int kswz = (key >> 1) & 7;
  float4 raw[8];
#define ATT_ISSUE(jj) do { const int j_ = (jj); \
    if (j_ < nloc) { \
      int krow_; \
      if (MODE == 0 || MODE == 1) krow_ = rowbaseP + j_ * 64 + key; \
      else if (MODE == 2) krow_ = rowbaseP + (rlo + j_) * 64 + key; \
      else krow_ = rowbaseP + clampi(lo + j_ * 64 + key, 0, 1023); \
      const bf16_t* kp_ = P + (size_t)krow_ * DIN + kcol + dq * 16; \
      const bf16_t* vp_ = P + (size_t)krow_ * DIN + vcol + dq * 16; \
      raw[0] = *(const float4*)kp_; raw[1] = *(const float4*)(kp_ + 8); raw[2] = *(const float4*)vp_; raw[3] = *(const float4*)(vp_ + 8); \
    } else { \
      const int ct_ = (j_ - nloc) * 64 + key; \
      const float* kp_ = cache + ((size_t)ct_ * cH + cHead) * 64 + dq * 16; \
      const float* vp_ = kp_ + (size_t)256 * cH * 64; \
      raw[0] = *(const float4*)kp_; raw[1] = *(const float4*)(kp_ + 4); raw[2] = *(const float4*)(kp_ + 8); raw[3] = *(const float4*)(kp_ + 12); \
      raw[4] = *(const float4*)vp_; raw[5] = *(const float4*)(vp_ + 4); raw[6] = *(const float4*)(vp_ + 8); raw[7] = *(const float4*)(vp_ + 12); \
    } } while (0)
  ATT_ISSUE(0);
  for (int j = 0; j < nt; ++j) {
    uint4 kr[2], vr[2];
    const bool isP = j < nloc;
    if (isP) {
      kr[0] = __builtin_bit_cast(uint4, raw[0]); kr[1] = __builtin_bit_cast(uint4, raw[1]);
      vr[0] = __builtin_bit_cast(uint4, raw[2]); vr[1] = __builtin_bit_cast(uint4, raw[3]);
    } else {
      kr[0].x = pk2(raw[0].x, raw[0].y); kr[0].y = pk2(raw[0].z, raw[0].w); kr[0].z = pk2(raw[1].x, raw[1].y); kr[0].w = pk2(raw[1].z, raw[1].w);
      kr[1].x = pk2(raw[2].x, raw[2].y); kr[1].y = pk2(raw[2].z, raw[2].w); kr[1].z = pk2(raw[3].x, raw[3].y); kr[1].w = pk2(raw[3].z, raw[3].w);
      vr[0].x = pk2(raw[4].x, raw[4].y); vr[0].y = pk2(raw[4].z, raw[4].w); vr[0].z = pk2(raw[5].x, raw[5].y); vr[0].w = pk2(raw[5].z, raw[5].w);
      vr[1].x = pk2(raw[6].x, raw[6].y); vr[1].y = pk2(raw[6].z, raw[6].w); vr[1].z = pk2(raw[7].x, raw[7].y); vr[1].w = pk2(raw[7].z, raw[7].w);
    }
    if (j + 1 < nt) ATT_ISSUE(j + 1);
    __syncthreads();
    *(uint4*)(sK + key * 128 + (((dq * 2 + 0) ^ kswz) << 4)) = kr[0];
    *(uint4*)(sK + key * 128 + (((dq * 2 + 1) ^ kswz) << 4)) = kr[1];
    {
      bf16_t* vt = (bf16_t*)sV;
      const unsigned vv[8] = {vr[0].x, vr[0].y, vr[0].z, vr[0].w, vr[1].x, vr[1].y, vr[1].z, vr[1].w};
#pragma unroll
      for (int e = 0; e < 8; ++e) {
        vt[(dq * 16 + 2 * e) * 68 + key] = (bf16_t)(vv[e] & 0xffffu);
        vt[(dq * 16 + 2 * e + 1) * 68 + key] = (bf16_t)(vv[e] >> 16);
      }
    }
    __syncthreads();
    f32x16 sacc[2];
#pragma unroll
    for (int r = 0; r < 16; ++r) { sacc[0][r] = 0.f; sacc[1][r] = 0.f; }
    const int qswz = (q >> 1) & 7;
#pragma unroll
    for (int s = 0; s < 4; ++s) {
      const int co = (((s * 2 + hh) ^ qswz) << 4);
      const bf16x8 a0 = *(const bf16x8*)(sK + q * 128 + co);
      const bf16x8 a1 = *(const bf16x8*)(sK + (32 + q) * 128 + co);
      sacc[0] = MFMA32(a0, bq[s], sacc[0]);
      sacc[1] = MFMA32(a1, bq[s], sacc[1]);
    }
    float mx = -1e30f;
#pragma unroll
    for (int sub = 0; sub < 2; ++sub)
#pragma unroll
      for (int r = 0; r < 16; ++r) {
        const int kidx = sub * 32 + (r & 3) + 8 * (r >> 2) + 4 * hh;
        float v = sacc[sub][r] * 0.125f;
        bool ok = true;
        if (MODE == 2 && isP) {
          const int kr_ = rlo + j, kc_ = kidx;
          ok = (kr_ >= rsq) && (kr_ < rsq + 8) && (kc_ >= wsq) && (kc_ < wsq + 16);
          const int bi = ok ? ((kr_ - qr + 7) * 31 + (kc_ - qc + 15)) : 0;
          v += sBias[bi];
        }
        if (MODE == 3 && isP) {
          const int kpos = lo + j * 64 + kidx, dlt = kpos - qpos;
          ok = (dlt <= 128) && (dlt >= -128) && (kpos >= 0) && (kpos < 1024);
        }
        v = ok ? v : -1e30f;
        sacc[sub][r] = v;
        mx = fmaxf(mx, v);
      }
    mx = fmaxf(mx, __shfl_xor(mx, 32));
    const float m_new = fmaxf(m_run, mx);
    const float alpha = __expf(m_run - m_new);
    float rsum = 0.f;
#pragma unroll
    for (int sub = 0; sub < 2; ++sub)
#pragma unroll
      for (int r = 0; r < 16; ++r) {
        const float v = sacc[sub][r];
        const float pv = (v > -1e29f) ? __expf(v - m_new) : 0.f;
        sacc[sub][r] = pv; rsum += pv;
      }
    rsum += __shfl_xor(rsum, 32);
    l_run = l_run * alpha + rsum; m_run = m_new;
#pragma unroll
    for (int r = 0; r < 16; ++r) { oacc[0][r] *= alpha; oacc[1][r] *= alpha; }
#pragma unroll
    for (int k4 = 0; k4 < 4; ++k4) {
      const int sub = k4 >> 1, s2 = k4 & 1;
      uint4 pbu;
      pbu.x = pk2(sacc[sub][8 * s2 + 0], sacc[sub][8 * s2 + 1]); pbu.y = pk2(sacc[sub][8 * s2 + 2], sacc[sub][8 * s2 + 3]);
      pbu.z = pk2(sacc[sub][8 * s2 + 4], sacc[sub][8 * s2 + 5]); pbu.w = pk2(sacc[sub][8 * s2 + 6], sacc[sub][8 * s2 + 7]);
      const bf16x8 pb = __builtin_bit_cast(bf16x8, pbu);
#pragma unroll
      for (int dt = 0; dt < 2; ++dt) {
        const char* vp = sV + (dt * 32 + q) * 136 + (16 * k4 + 4 * hh) * 2;
        const uint2 lo8 = *(const uint2*)vp, hi8 = *(const uint2*)(vp + 16);
        uint4 avu; avu.x = lo8.x; avu.y = lo8.y; avu.z = hi8.x; avu.w = hi8.y;
        oacc[dt] = MFMA32(__builtin_bit_cast(bf16x8, avu), pb, oacc[dt]);
      }
    }
  }
#undef ATT_ISSUE
  float scale;
  if (MODE == 1 || MODE == 3) {
    const float m_f = fmaxf(m_run, sink);
    const float e = __expf(m_run - m_f);
    scale = e / (l_run * e + __expf(sink - m_f));
  } else scale = 1.0f / l_run;
#pragma unroll
  for (int dt = 0; dt < 2; ++dt)
#pragma unroll
    for (int g4 = 0; g4 < 4; ++g4) {
      const int d = dt * 32 + 8 * g4 + 4 * hh;
      uint2 o; o.x = pk2(oacc[dt][4 * g4] * scale, oacc[dt][4 * g4 + 1] * scale); o.y = pk2(oacc[dt][4 * g4 + 2] * scale, oacc[dt][4 * g4 + 3] * scale);
      *(uint2*)(Y + (size_t)qrow * D + ocol + d) = o;
    }
  __syncthreads();
}

DEV void post_item(const Params& p, int l, int tile, char* lds) {
  const int t = tid(), r0 = tile * TOKT, c = t;
  bf16_t* sA = (bf16_t*)lds;
  float* sgo = (float*)(lds + 32 * 136 * 2);
  const bf16_t* P = (const bf16_t*)(p.ws + OFF_P);
  bf16_t* Y = (bf16_t*)(p.ws + OFF_YMIX);
  const float* Y0 = (const float*)(p.ws + OFF_YDIR); const float* Y1 = Y0 + ARRF;
  const float* H0 = (const float*)(p.ws + OFF_HDIR); const float* H1 = H0 + ARRF;
  const bf16_t* BON = (const bf16_t*)(p.ws + OFF_BONUS);
  __syncthreads();
#pragma unroll
  for (int i = 0; i < TOKT / 2; ++i) {
    const int e = t + 256 * i, tk = e >> 7, j = e & 127;
    sA[tk * 136 + j] = f2bf(sigmoidf_(bf2f(P[(size_t)(r0 + tk) * DIN + C_GH + j])));
  }
  __syncthreads();
  {
    const int lane = t & 63, w = t >> 6, q = lane & 31, hh = lane >> 5;
    bf16x8 af[8];
#pragma unroll
    for (int s = 0; s < 8; ++s) af[s] = *(const bf16x8*)(sA + q * 136 + 16 * s + 8 * hh);
    const bf16_t* GT = (const bf16_t*)(p.ws + OFF_G2T) + (size_t)l * 256 * 128;
#pragma unroll
    for (int nt = 0; nt < 2; ++nt) {
      const int n = w * 64 + nt * 32 + q;
      f32x16 acc;
#pragma unroll
      for (int r = 0; r < 16; ++r) acc[r] = 0.f;
#pragma unroll
      for (int s = 0; s < 8; ++s) acc = MFMA32(af[s], *(const bf16x8*)(GT + (size_t)n * 128 + 16 * s + 8 * hh), acc);
#pragma unroll
      for (int r = 0; r < 8; ++r) sgo[((r & 3) + 8 * (r >> 2) + 4 * hh) * 256 + n] = acc[r];
      if (hh == 0) {
#pragma unroll
        for (int r = 8; r < 12; ++r) sgo[((r & 3) + 16) * 256 + n] = acc[r];
      }
    }
  }
  __syncthreads();
  const float lnw = p.in[I_LNW][l * 256 + c], lnb = p.in[I_LNB][l * 256 + c], hgn = p.in[I_HGN][l * 256 + c];
  for (int tb = 0; tb < TOKT; tb += 5) {
    float y[5], o[5], bn[5], gv[5], hg[5];
#pragma unroll
    for (int u = 0; u < 5; ++u) {
      const int row = r0 + tb + u;
      const size_t idx = (size_t)row * 256 + c;
      y[u] = Y0[idx] + Y1[idx]; o[u] = H0[idx] + H1[idx]; bn[u] = bf2f(BON[idx]);
      gv[u] = sgo[(tb + u) * 256 + c]; hg[u] = bf2f(P[(size_t)row * DIN + C_HG + c]);
    }
#pragma unroll
    for (int u = 0; u < 5; ++u) {
      const int row = r0 + tb + u;
      const float mu = wave_sum(y[u]) * (1.0f / 64.0f);
      const float dy = y[u] - mu;
      const float var = wave_sum(dy * dy) * (1.0f / 64.0f);
      const float yn = dy * __builtin_amdgcn_rsqf(var + 64e-5f) * lnw + lnb + bn[u];
      Y[(size_t)row * D + c] = f2bf(yn * gv[u]);
      const float ms = wave_sum(o[u] * o[u]) * (1.0f / 64.0f);
      Y[(size_t)row * D + 512 + c] = f2bf(o[u] * __builtin_amdgcn_rsqf(ms + 1e-6f) * hgn * sigmoidf_(hg[u]));
    }
  }
  __syncthreads();
}

constexpr int OFF_CTR_WORD = 3600;
DEV void mixer_phase(const Params& p, int l, char* lds0, volatile LAS unsigned* st, bool rerun) {
  const int hf = half_id(); char* lds = lds0 + hf * 65536;
  const int npairs = (256 + 512 + 512) / 2;
  unsigned* ctr = (unsigned*)(p.ws + OFF_BAR) + OFF_CTR_WORD + 64 * l + (rerun ? 32 : 0);
  for (;;) {
    if (threadIdx.x == 0) st[4] = __hip_atomic_fetch_add(ctr, 1u, __ATOMIC_RELAXED, __HIP_MEMORY_SCOPE_AGENT);
    __syncthreads();
    const int pair = (int)st[4];
    __syncthreads();
    if (pair >= npairs) break;
    const int it = pair * 2 + hf;
    const bool is_scan = it < 640;
    if (rerun && PROBE_SUB == 1 && !is_scan) continue;
    if (rerun && PROBE_SUB == 2 && is_scan) continue;
    if (rerun && PROBE_SUB == 3 && !(it < 128)) continue;
    if (rerun && PROBE_SUB == 4 && !(it >= 128 && it < 640)) continue;
    if (it < 128) {
      const int idx = it >> 1; const int seq = 32 + (idx >> 5), rem = idx & 31;
      if ((it & 1) == 0) rwkv_scan16(p, l, seq, rem >> 3, (rem >> 2) & 1, rem & 3, lds);
      else hgrn_scan16(p, l, seq, rem >> 3, (rem >> 2) & 1, rem & 3, lds);
    } else if (it < 640) {
      const int idx = (it - 128) & 255; const int seq = idx >> 3, rem = idx & 7;
      if (it < 384) rwkv_scan<2>(p, l, seq, rem >> 1, rem & 1, 0, lds);
      else hgrn_scan<2>(p, l, seq, rem >> 1, rem & 1, 0, lds);
    } else if (it < 704) attn_item<3>(p, l, it - 640, lds);
    else if (it < 768) attn_item<2>(p, l, it - 704, lds);
    else if (it < 1024) attn_item<0>(p, l, it - 768, lds);
    else attn_item<1>(p, l, it - 1024, lds);
  }
}

DEV void run_phase(const Params& p, int ph, char* lds, bool rerun, volatile LAS unsigned* st) {
  if (ph == 0) { phase0(p, lds); return; }
  if (ph == 1) { row_phase(p, 0, 0); return; }
  const int l = (ph - 2) / 9, s = (ph - 2) % 9;
  const bf16_t* H = (const bf16_t*)(p.ws + OFF_H);
  const int hf = half_id(); char* ldsh = lds + hf * 65536;
  switch (s) {
    case 0: gemm_run<0>(p, l, H, (const bf16_t*)(p.ws + OFF_WIN) + (size_t)l * DINP * D, D, DINP, lds); break;
    case 1:
      for (int it = blockIdx.x * 2 + hf; it < 512 + 32; it += gridDim.x * 2) { if (it < 512) prep_item(p, l, it, ldsh); else if (!rerun) rope_item(p, it - 512); }
      break;
    case 2: mixer_phase(p, l, lds, st, rerun); break;
    case 3: for (int it = blockIdx.x * 2 + hf; it < 512; it += gridDim.x * 2) post_item(p, l, it, ldsh); break;
    case 4: gemm_run<1>(p, l, (const bf16_t*)(p.ws + OFF_YMIX), (const bf16_t*)(p.ws + OFF_WOUT) + (size_t)l * D * D, D, D, lds); break;
    case 5: row_phase(p, 1, l); break;
    case 6: gemm_run<2>(p, l, H, (const bf16_t*)(p.ws + OFF_W1) + (size_t)l * FF * D, D, FF, lds); break;
    case 7: gemm_run<1>(p, l, (const bf16_t*)(p.ws + OFF_HID), (const bf16_t*)(p.ws + OFF_W2) + (size_t)l * D * FF, FF, D, lds); break;
    case 8: row_phase(p, 2, l); break;
  }
}

#define XB_TMO      128
#define XB_XCNT(j)  (256  + 64 * (j))
#define XB_XSUB(j)  (1280 + 64 * (j))
#define XB_XGEN(j)  (2304 + 64 * (j))
#define XB_TOP      3328
#define XB_TOPGEN   3392
#define XCD_BAR_WORDS 3456
#define XB_SPIN_CAP (1u << 18)
DEV unsigned xb_ld(unsigned* p) { return __hip_atomic_load(p, __ATOMIC_RELAXED, __HIP_MEMORY_SCOPE_AGENT); }
DEV unsigned xb_add(unsigned* p, unsigned v) { return __hip_atomic_fetch_add(p, v, __ATOMIC_RELAXED, __HIP_MEMORY_SCOPE_AGENT); }
DEV unsigned xb_xcc_id() { return (unsigned)__builtin_amdgcn_s_getreg((3 << 11) | 20) & 0xFu; }
#define XB_SPIN(cond, bar) do { unsigned _sp = 0; while (cond) { __builtin_amdgcn_s_sleep(1); \
    if ((++_sp & 255u) == 0u) { if (xb_ld(&(bar)[XB_TMO])) break; if (_sp > XB_SPIN_CAP) { atomicAdd(&(bar)[XB_TMO], 1u); break; } } } } while (0)
struct XcdBarrier { unsigned* bar; unsigned x; volatile LAS unsigned* st; };
DEV XcdBarrier xcd_barrier_post(unsigned* bar, volatile LAS unsigned* st) {
  XcdBarrier b; b.bar = bar; b.x = xb_xcc_id(); b.st = st;
  if (threadIdx.x == 0) (void)xb_add(&bar[XB_XCNT(b.x)], 1u);
  return b;
}
DEV void xcd_barrier_complete(unsigned* bar, unsigned x, unsigned& nloc, unsigned& nx) {
  const unsigned G = gridDim.x * gridDim.y * gridDim.z;
  unsigned sum, cnt, mine, sp = 0u;
  for (;;) {
    sum = 0u; cnt = 0u; mine = 0u;
#pragma unroll
    for (unsigned j = 0; j < 16; ++j) { const unsigned c = xb_ld(&bar[XB_XCNT(j)]); sum += c; cnt += (c > 0u) ? 1u : 0u; mine = (j == x) ? c : mine; }
    if (sum == G) break;
    __builtin_amdgcn_s_sleep(1);
    if ((++sp & 255u) == 0u) { if (xb_ld(&bar[XB_TMO])) break; if (sp > XB_SPIN_CAP) { atomicAdd(&bar[XB_TMO], 1u); break; } }
  }
  nloc = mine > 0u ? mine : 1u; nx = cnt > 0u ? cnt : 1u;
}
DEV void xcd_barrier(const XcdBarrier& b) {
  asm volatile("s_waitcnt vmcnt(0)" ::: "memory");
  __syncthreads();
  if (threadIdx.x == 0) {
    unsigned* bar = b.bar;
    { size_t zb_; asm volatile("s_mov_b64 %0, 0" : "=s"(zb_)); bar += zb_; }
    __builtin_amdgcn_s_waitcnt(0);
    unsigned nloc = b.st[0], nx = b.st[1];
    if (nloc == 0u) { xcd_barrier_complete(bar, b.x, nloc, nx); b.st[0] = nloc; b.st[1] = nx; }
    const unsigned old = xb_add(&bar[XB_XSUB(b.x)], 1u);
    const unsigned gen = old / nloc;
    if (old + 1u == (gen + 1u) * nloc) {
      __builtin_amdgcn_fence(__ATOMIC_RELEASE, "agent");
      asm volatile("s_waitcnt vmcnt(0)" ::: "memory");
      const unsigned og = xb_add(&bar[XB_TOP], 1u);
      const unsigned tg = og / nx;
      if (og + 1u == (tg + 1u) * nx) xb_add(&bar[XB_TOPGEN], 1u);
      else XB_SPIN(xb_ld(&bar[XB_TOPGEN]) == tg, bar);
      __builtin_amdgcn_fence(__ATOMIC_ACQUIRE, "agent");
      xb_add(&bar[XB_XGEN(b.x)], 1u);
      asm volatile("s_waitcnt vmcnt(0)" ::: "memory");
    } else {
      XB_SPIN(xb_ld(&bar[XB_XGEN(b.x)]) == gen, bar);
      __builtin_amdgcn_fence(__ATOMIC_ACQUIRE, "agent");
      asm volatile("s_waitcnt vmcnt(0)" ::: "memory");
    }
  }
  __syncthreads();
}

DEV int phase_kind(int ph) {
  if (ph == 0) return 0;
  if (ph == 1) return 1;
  const int s = (ph - 2) % 9;
  return s == 0 ? 2 : s == 1 ? 3 : s == 2 ? 4 : s == 3 ? 5 : s == 4 ? 6 : s == 5 ? 1 : s == 6 ? 7 : s == 7 ? 8 : 1;
}

constexpr int LDS_BYTES = 131072 + 64;

__global__ void __launch_bounds__(512, 2) mega(Params p, int ph_lo, int ph_hi) {
  extern __shared__ __attribute__((aligned(16))) unsigned char smem[];
  char* lds = (char*)smem;
  volatile LAS unsigned* st = (volatile LAS unsigned*)((LAS unsigned char*)smem + 131072);
  if (threadIdx.x == 0) { st[0] = 0u; st[1] = 0u; }
  __syncthreads();
  XcdBarrier xb = xcd_barrier_post((unsigned*)(p.ws + OFF_BAR), st);
  if (ph_hi < 0) cg::this_grid().sync();
  char* const ws0 = p.ws; float* const out0 = p.out;
  for (int ph = ph_lo; ph < ph_hi; ++ph) {
    { size_t z0_; asm volatile("s_mov_b64 %0, 0" : "=s"(z0_)); p.ws = ws0 + z0_; p.out = out0 + z0_; }
    run_phase(p, ph, lds, false, st);
    if (PROBE_KIND >= 0 && (PROBE_KIND == 9 || phase_kind(ph) == PROBE_KIND)) {
      xcd_barrier(xb);
      if (PROBE_KIND != 9) run_phase(p, ph, lds, true, st);
    }
    if (ph + 1 < ph_hi) xcd_barrier(xb);
  }
}

extern "C" void kernel_launch(void* const* d_in, const int* in_sizes, int n_in, void* d_out, int out_size, void* d_ws, size_t ws_size,
                              hipStream_t stream) {
  static int grid_blocks = 0;
  if (!grid_blocks) {
    int dev = 0, cus = 0, per_cu = 0;
    (void)hipGetDevice(&dev);
    (void)hipDeviceGetAttribute(&cus, hipDeviceAttributeMultiprocessorCount, dev);
    if (hipFuncSetAttribute((const void*)mega, hipFuncAttributeMaxDynamicSharedMemorySize, LDS_BYTES) != hipSuccess) fprintf(stderr, "hipFuncSetAttribute failed\n");
    (void)hipOccupancyMaxActiveBlocksPerMultiprocessor(&per_cu, mega, 512, LDS_BYTES);
    if (per_cu < 1) fprintf(stderr, "occupancy query reports %d blocks per CU\n", per_cu);
    (void)hipGetLastError();
    grid_blocks = cus;
  }
  if (ws_size < WS_TOTAL) { fprintf(stderr, "workspace too small: %zu < %zu\n", ws_size, (size_t)WS_TOTAL); return; }
  Params p{};
  for (int i = 0; i < 31; ++i) p.in[i] = (const float*)d_in[i];
  p.out = (float*)d_out;
  p.ws = (char*)d_ws;
  (void)hipMemsetAsync((char*)d_ws + OFF_BAR, 0, 16384, stream);
  int lo = 0, hi = NPH;
  void* args[] = {&p, &lo, &hi};
  hipError_t e = hipLaunchCooperativeKernel((void*)mega, dim3(grid_blocks), dim3(512), args, LDS_BYTES, stream);
  if (e != hipSuccess) fprintf(stderr, "cooperative launch failed: %s (grid %d)\n", hipGetErrorString(e), grid_blocks);
}
```

```cpp
#include <hip/hip_runtime.h>
#include <hip/hip_cooperative_groups.h>
#include <cstdio>
#include <cstdint>
namespace cg = cooperative_groups;

#ifndef ONE_LAUNCH
#define ONE_LAUNCH 1
#endif
#define PROBE_KIND -1
#define PROBE_SUB 0

#define DEV __device__ __forceinline__
#define LAS __attribute__((address_space(3)))
typedef unsigned short bf16_t;
typedef short bf16x8 __attribute__((ext_vector_type(8)));
typedef float f32x16 __attribute__((ext_vector_type(16)));
typedef __bf16 bf2_t __attribute__((ext_vector_type(2)));
typedef float f2_t __attribute__((ext_vector_type(2)));

constexpr int D = 1024, DIN = 3712, FF = 4096, NCTX = 8192, MT = 10240;
constexpr int NPH = 38;
constexpr int DINP = 3840;
constexpr int C_R = 0, C_K = 256, C_V = 512, C_GH = 768, C_WHF = 896, C_WHB = 1024;
constexpr int C_NQ = 1152, C_NK = 1408, C_NV = 1664;
constexpr int C_HQ = 1920, C_HI = 2176, C_HG = 2432, C_HFF = 2688, C_HFB = 2944;
constexpr int C_SQ = 3200, C_SK = 3456, C_SV = 3584;
constexpr size_t O_NAT = 10485760, O_SWA = 27262976, O_RW = 35651584, O_HG = 39845888;
constexpr size_t ARRF = (size_t)MT * 256;
constexpr size_t ARR = ARRF * 4;
constexpr size_t OFF_WIN = 0;
constexpr size_t OFF_WOUT = OFF_WIN + (size_t)4 * DINP * D * 2;
constexpr size_t OFF_W1 = OFF_WOUT + (size_t)4 * D * D * 2;
constexpr size_t OFF_W2 = OFF_W1 + (size_t)4 * FF * D * 2;
constexpr size_t OFF_MOD = OFF_W2 + (size_t)4 * FF * D * 2;
constexpr size_t OFF_HGLB = OFF_MOD + (size_t)4 * 3 * 6144 * 4;
constexpr size_t OFF_P = OFF_HGLB + 8192;
constexpr size_t OFF_R1 = OFF_P + (size_t)MT * DIN * 2;
constexpr size_t OFF_H = OFF_R1;
constexpr size_t OFF_HID = OFF_H + (size_t)MT * D * 2;
constexpr size_t OFF_U = OFF_HID + (size_t)MT * FF * 2;
constexpr size_t OFF_PREP = OFF_R1;
constexpr size_t OFF_YDIR = OFF_PREP + 12 * ARR;
constexpr size_t OFF_BONUS = OFF_R1 + 14 * ARR;
constexpr size_t OFF_HDIR = OFF_BONUS + ARR / 2;
constexpr size_t OFF_YMIX = OFF_HDIR + 2 * ARR;
constexpr size_t OFF_X16 = OFF_YMIX + (size_t)MT * D * 2;
constexpr size_t OFF_BAR = OFF_X16 + (size_t)MT * D * 2;
constexpr size_t OFF_W2T = OFF_BAR + 16384;
constexpr size_t OFF_A2T = OFF_W2T + (size_t)4 * 2 * 256 * 64 * 2;
constexpr size_t OFF_G2T = OFF_A2T + (size_t)4 * 2 * 256 * 64 * 2;
constexpr size_t WS_TOTAL = OFF_G2T + (size_t)4 * 256 * 128 * 2;
static_assert(OFF_U + (size_t)MT * D * 4 == OFF_BONUS, "R1 layout");

struct Params {
  const float* in[31];
  float* out;
  char* ws;
};
enum { I_XP = 0, I_XS, I_CNAT, I_CSWA, I_SRW, I_SHG, I_C, I_CCTX, I_NORMG, I_MODW, I_MODB, I_WIN, I_WOUT, I_MURKV, I_MULORA,
       I_W0, I_W2, I_A0, I_A2, I_G2, I_KK, I_KA, I_RK, I_LNW, I_LNB, I_RPB, I_HGLB, I_HGN, I_SINK, I_FW1, I_FW2 };


DEV float bf2f(bf16_t h) { return __uint_as_float(((unsigned)h) << 16); }
DEV unsigned pk2(float a, float b) { f2_t v = {a, b}; bf2_t r = __builtin_convertvector(v, bf2_t); return __builtin_bit_cast(unsigned, r); }
DEV bf16_t f2bf(float f) { return (bf16_t)(pk2(f, f) & 0xffffu); }
DEV float4 bf4(uint2 u) { return make_float4(__uint_as_float(u.x << 16), __uint_as_float(u.x & 0xffff0000u), __uint_as_float(u.y << 16), __uint_as_float(u.y & 0xffff0000u)); }
DEV float bflo(unsigned u) { return __uint_as_float(u << 16); }
DEV float bfhi(unsigned u) { return __uint_as_float(u & 0xffff0000u); }
DEV float rcpf_(float x) { return __builtin_amdgcn_rcpf(x); }
DEV float sigmoidf_(float x) { return rcpf_(1.0f + __expf(-x)); }
DEV float tanhf_(float x) { return 1.0f - 2.0f * rcpf_(1.0f + __expf(2.0f * x)); }
template <int CTRL> DEV float dppf(float x) { return __int_as_float(__builtin_amdgcn_update_dpp(0, __float_as_int(x), CTRL, 0xF, 0xF, false)); }
DEV float row16_sum(float x) { x += dppf<0xB1>(x); x += dppf<0x4E>(x); x += dppf<0x141>(x); x += dppf<0x140>(x); return x; }
DEV float wave_sum(float x) { x = row16_sum(x); x += __shfl_xor(x, 16); x += __shfl_xor(x, 32); return x; }
DEV int clampi(int v, int lo, int hi) { return v < lo ? lo : (v > hi ? hi : v); }
#define MFMA32(a, b, c) __builtin_amdgcn_mfma_f32_32x32x16_bf16((a), (b), (c), 0, 0, 0)

DEV int tid() { int z; asm volatile("v_mov_b32 %0, 0" : "=v"(z)); return (int)(threadIdx.x & 255u) + z; }
DEV int half_id() { return __builtin_amdgcn_readfirstlane((int)(threadIdx.x >> 8)); }
DEV void transpose_item(const float* W, bf16_t* WT, int K, int N, int kt, int nt, char* lds) {
  bf16_t* s = (bf16_t*)lds;
  const int t = tid();
#pragma unroll
  for (int i = 0; i < 4; ++i) {
    const int k = (t >> 4) + 16 * i, n4 = (t & 15) * 4;
    const float4 v = *(const float4*)(W + (size_t)(kt * 64 + k) * N + nt * 64 + n4);
    s[(n4 + 0) * 72 + k] = f2bf(v.x); s[(n4 + 1) * 72 + k] = f2bf(v.y);
    s[(n4 + 2) * 72 + k] = f2bf(v.z); s[(n4 + 3) * 72 + k] = f2bf(v.w);
  }
  __syncthreads();
#pragma unroll
  for (int i = 0; i < 2; ++i) {
    const int n = (t >> 3) + 32 * i, kc = t & 7;
    const uint4 v = *(const uint4*)(s + n * 72 + kc * 8);
    *(uint4*)(WT + (size_t)(nt * 64 + n) * K + kt * 64 + kc * 8) = v;
  }
  __syncthreads();
}

DEV void mod_item(const Params& p, int l, int jb, char* lds) {
  float* sc = (float*)lds;
  float* red = (float*)(lds + 12288);
  const int t = tid();
  for (int i = t; i < 3072; i += 256) {
    const int c = i >> 10, k = i & 1023;
    const float x = (c == 0) ? p.in[I_CCTX][k] : p.in[I_C][(c - 1) * 1024 + k];
    sc[i] = x * rcpf_(1.0f + __expf(-x));
  }
  __syncthreads();
  const int c4 = t & 15, ks = t >> 4;
  const float* wp = p.in[I_MODW] + ((size_t)l * 1024 + ks * 64) * 6144 + jb * 64 + c4 * 4;
  float a00 = 0, a01 = 0, a02 = 0, a03 = 0, a10 = 0, a11 = 0, a12 = 0, a13 = 0, a20 = 0, a21 = 0, a22 = 0, a23 = 0;
#pragma unroll 16
  for (int ii = 0; ii < 64; ++ii) {
    const float4 w = *(const float4*)(wp + (size_t)ii * 6144);
    const int k = ks * 64 + ii;
    const float s0 = sc[k], s1 = sc[1024 + k], s2 = sc[2048 + k];
    a00 += s0 * w.x; a01 += s0 * w.y; a02 += s0 * w.z; a03 += s0 * w.w;
    a10 += s1 * w.x; a11 += s1 * w.y; a12 += s1 * w.z; a13 += s1 * w.w;
    a20 += s2 * w.x; a21 += s2 * w.y; a22 += s2 * w.z; a23 += s2 * w.w;
  }
  float* r0 = red + (ks * 3 + 0) * 64 + c4 * 4; r0[0] = a00; r0[1] = a01; r0[2] = a02; r0[3] = a03;
  float* r1 = red + (ks * 3 + 1) * 64 + c4 * 4; r1[0] = a10; r1[1] = a11; r1[2] = a12; r1[3] = a13;
  float* r2 = red + (ks * 3 + 2) * 64 + c4 * 4; r2[0] = a20; r2[1] = a21; r2[2] = a22; r2[3] = a23;
  __syncthreads();
  if (t < 192) {
    const int c = t >> 6, col = t & 63;
    float v = p.in[I_MODB][l * 6144 + jb * 64 + col];
#pragma unroll
    for (int k2 = 0; k2 < 16; ++k2) v += red[(k2 * 3 + c) * 64 + col];
    ((float*)(p.ws + OFF_MOD))[(size_t)(l * 3 + c) * 6144 + jb * 64 + col] = v;
  }
  __syncthreads();
}

DEV void hglb_item(const Params& p) {
  const int c = tid();
  float* HGLB = (float*)(p.ws + OFF_HGLB);
  for (int dir = 0; dir < 2; ++dir) {
    float x[4], mx = -1e30f;
    for (int l = 0; l < 4; ++l) { x[l] = p.in[I_HGLB][(dir * 4 + l) * 256 + c]; mx = fmaxf(mx, x[l]); }
    float s = 0;
    for (int l = 0; l < 4; ++l) { x[l] = __expf(x[l] - mx); s += x[l]; }
    float cum = 0; const float s0 = x[0] / s;
    for (int l = 0; l < 4; ++l) { cum += x[l] / s; HGLB[(l * 2 + dir) * 256 + c] = cum - s0; }
  }
}

constexpr int NT_LAYER = 928 + 256 + 1024 + 1024;
struct TileDesc { const float* W; bf16_t* WT; int K, N, kt, nt; };
DEV TileDesc layer_tile_desc(const Params& p, int l, int j) {
  TileDesc d;
  if (j < 928) { d.W = p.in[I_WIN] + (size_t)l * D * DIN; d.WT = (bf16_t*)(p.ws + OFF_WIN) + (size_t)l * DINP * D; d.K = D; d.N = DIN; d.kt = j / 58; d.nt = j % 58; return d; }
  j -= 928;
  if (j < 256) { d.W = p.in[I_WOUT] + (size_t)l * D * D; d.WT = (bf16_t*)(p.ws + OFF_WOUT) + (size_t)l * D * D; d.K = D; d.N = D; d.kt = j / 16; d.nt = j % 16; return d; }
  j -= 256;
  if (j < 1024) { d.W = p.in[I_FW1] + (size_t)l * D * FF; d.WT = (bf16_t*)(p.ws + OFF_W1) + (size_t)l * FF * D; d.K = D; d.N = FF; d.kt = j / 64; d.nt = j % 64; return d; }
  j -= 1024;
  d.W = p.in[I_FW2] + (size_t)l * FF * D; d.WT = (bf16_t*)(p.ws + OFF_W2) + (size_t)l * D * FF; d.K = FF; d.N = D; d.kt = j / 16; d.nt = j % 16; return d;
}
DEV void tile_load(const TileDesc& d, float4 (&v)[4]) {
  const int t = tid();
#pragma unroll
  for (int i = 0; i < 4; ++i) v[i] = *(const float4*)(d.W + (size_t)(d.kt * 64 + (t >> 4) + 16 * i) * d.N + d.nt * 64 + (t & 15) * 4);
}
DEV void tile_store(const TileDesc& d, const float4 (&v)[4], char* lds) {
  bf16_t* s = (bf16_t*)lds;
  const int t = tid();
#pragma unroll
  for (int i = 0; i < 4; ++i) {
    const int k = (t >> 4) + 16 * i, n4 = (t & 15) * 4;
    s[(n4 + 0) * 72 + k] = f2bf(v[i].x); s[(n4 + 1) * 72 + k] = f2bf(v[i].y);
    s[(n4 + 2) * 72 + k] = f2bf(v[i].z); s[(n4 + 3) * 72 + k] = f2bf(v[i].w);
  }
  __syncthreads();
#pragma unroll
  for (int i = 0; i < 2; ++i) {
    const int n = (t >> 3) + 32 * i, kc = t & 7;
    const uint4 o = *(const uint4*)(s + n * 72 + kc * 8);
    *(uint4*)(d.WT + (size_t)(d.nt * 64 + n) * d.K + d.kt * 64 + kc * 8) = o;
  }
  __syncthreads();
}
DEV void layer_tiles(const Params& p, int l, int lo, int hi, int vb, int nvb, char* lds0) {
  const int hf = half_id(); char* lds = lds0 + hf * 65536;
  int it = lo + vb * 2 + hf;
  if (it >= hi) return;
  float4 vn[4];
  TileDesc dn = layer_tile_desc(p, l, it);
  tile_load(dn, vn);
  for (; it < hi; it += nvb * 2) {
    float4 vc[4] = {vn[0], vn[1], vn[2], vn[3]};
    const TileDesc dc = dn;
    if (it + nvb * 2 < hi) { dn = layer_tile_desc(p, l, it + nvb * 2); tile_load(dn, vn); }
    tile_store(dc, vc, lds);
  }
}

DEV void phase0(const Params& p, char* lds0) {
  const int hf = half_id(); char* lds = lds0 + hf * 65536;
  const int nitems = 386 + 4 + 20;
  for (int it = blockIdx.x * 2 + hf; it < nitems; it += gridDim.x * 2) {
    if (it < 384) { mod_item(p, it / 96, it % 96, lds); continue; }
    if (it == 384) { hglb_item(p); continue; }
    if (it == 385) continue;
    const int j = it - 386;
    if (j >= 4) {
      const int s = j - 4, n = tid();
      const float* src; bf16_t* dst; int KK;
      if (s < 8) { src = p.in[I_W2] + (size_t)s * 64 * 256; dst = (bf16_t*)(p.ws + OFF_W2T) + (size_t)s * 256 * 64; KK = 64; }
      else if (s < 16) { src = p.in[I_A2] + (size_t)(s - 8) * 64 * 256; dst = (bf16_t*)(p.ws + OFF_A2T) + (size_t)(s - 8) * 256 * 64; KK = 64; }
      else { src = p.in[I_G2] + (size_t)(s - 16) * 128 * 256; dst = (bf16_t*)(p.ws + OFF_G2T) + (size_t)(s - 16) * 256 * 128; KK = 128; }
      for (int k0 = 0; k0 < KK; k0 += 8) {
        float v[8];
#pragma unroll
        for (int e = 0; e < 8; ++e) v[e] = src[(size_t)(k0 + e) * 256 + n];
        uint4 o; o.x = pk2(v[0], v[1]); o.y = pk2(v[2], v[3]); o.z = pk2(v[4], v[5]); o.w = pk2(v[6], v[7]);
        *(uint4*)(dst + (size_t)n * KK + k0) = o;
      }
      continue;
    }
    {
      uint4* z = (uint4*)((bf16_t*)(p.ws + OFF_WIN) + ((size_t)j * DINP + DIN) * D);
      const int t = tid();
      for (int i = t; i < 128 * D * 2 / 16; i += 256) z[i] = make_uint4(0u, 0u, 0u, 0u);
    }
  }
  const int vb = ((int)blockIdx.x + (int)gridDim.x - 195 % (int)gridDim.x) % (int)gridDim.x;
  layer_tiles(p, 0, 0, NT_LAYER, vb, (int)gridDim.x, lds0);
  if ((int)gridDim.x <= 160) { for (int ll = 1; ll < 4; ++ll) layer_tiles(p, ll, 0, NT_LAYER, (int)blockIdx.x, (int)gridDim.x, lds0); }
}

constexpr int RPW = 5;
DEV void row_phase(const Params& p, int mode, int l) {
  const int lane = tid() & 63;
  const int nw = gridDim.x * 8;
  const float* MOD = (const float*)(p.ws + OFF_MOD);
  const float* NG = p.in[I_NORMG];
  const bf16_t* U = (const bf16_t*)(p.ws + OFF_U);
  bf16_t* H = (bf16_t*)(p.ws + OFF_H);
  bf16_t* X16 = (bf16_t*)(p.ws + OFF_X16);
  const bool has_next = !(mode == 2 && l == 3);
  const int ln = (mode == 0) ? 0 : (mode == 1 ? l : l + 1);
  const int gi = (mode == 1) ? 2 : 0, shi = (mode == 1) ? 3 : 0, sci = (mode == 1) ? 4 : 1;
  const float* ga = NG + (size_t)(l * 4 + (mode == 1 ? 1 : 3)) * 1024;
  const float* gb = NG + (size_t)((has_next ? ln : 0) * 4 + gi) * 1024;
  for (int rowa = blockIdx.x * 8 + half_id() * 4 + (tid() >> 6); rowa < MT; rowa += RPW * nw) {
    float4 x[RPW][4]; uint2 ub[RPW][4];
    int rows[RPW]; bool ok[RPW];
#pragma unroll
    for (int q = 0; q < RPW; ++q) {
      rows[q] = rowa + q * nw; ok[q] = rows[q] < MT;
      const int row = ok[q] ? rows[q] : rowa;
      if (mode == 0) {
        const float* src = row < NCTX ? p.in[I_XP] + (size_t)row * D : p.in[I_XS] + (size_t)(row - NCTX) * D;
#pragma unroll
        for (int i = 0; i < 4; ++i) x[q][i] = *(const float4*)(src + i * 256 + lane * 4);
      } else {
#pragma unroll
        for (int i = 0; i < 4; ++i) {
          const uint2 xb = *(const uint2*)(X16 + (size_t)row * D + i * 256 + lane * 4);
          x[q][i] = make_float4(bflo(xb.x), bfhi(xb.x), bflo(xb.y), bfhi(xb.y));
          ub[q][i] = *(const uint2*)(U + (size_t)row * D + i * 256 + lane * 4);
        }
      }
    }
#pragma unroll
    for (int q = 0; q < RPW; ++q) {
      const int row = ok[q] ? rows[q] : rowa;
      const int cond = row < NCTX ? 0 : 1 + ((row - NCTX) >> 10);
      if (mode != 0) {
        float4 u[4];
        float ss = 0;
#pragma unroll
        for (int i = 0; i < 4; ++i) {
          u[i] = make_float4(bflo(ub[q][i].x), bfhi(ub[q][i].x), bflo(ub[q][i].y), bfhi(ub[q][i].y));
          ss += u[i].x * u[i].x + u[i].y * u[i].y + u[i].z * u[i].z + u[i].w * u[i].w;
        }
        ss = wave_sum(ss);
        const float r = __builtin_amdgcn_rsqf(ss * (1.0f / 1024.0f) + 1e-6f);
        const float* gate = MOD + (size_t)(l * 3 + cond) * 6144 + (mode == 1 ? 2 : 5) * 1024;
#pragma unroll
        for (int i = 0; i < 4; ++i) {
          const float4 g4 = *(const float4*)(gate + i * 256 + lane * 4);
          const float4 a4 = *(const float4*)(ga + i * 256 + lane * 4);
          x[q][i].x += g4.x * (u[i].x * r * a4.x); x[q][i].y += g4.y * (u[i].y * r * a4.y);
          x[q][i].z += g4.z * (u[i].z * r * a4.z); x[q][i].w += g4.w * (u[i].w * r * a4.w);
        }
      }
      if (ok[q]) {
        if (has_next) {
#pragma unroll
          for (int i = 0; i < 4; ++i) { uint2 o; o.x = pk2(x[q][i].x, x[q][i].y); o.y = pk2(x[q][i].z, x[q][i].w); *(uint2*)(X16 + (size_t)row * D + i * 256 + lane * 4) = o; }
        } else {
#pragma unroll
          for (int i = 0; i < 4; ++i) *(float4*)(p.out + (size_t)row * D + i * 256 + lane * 4) = x[q][i];
        }
      }
      if (has_next) {
        float ss = 0;
#pragma unroll
        for (int i = 0; i < 4; ++i) ss += x[q][i].x * x[q][i].x + x[q][i].y * x[q][i].y + x[q][i].z * x[q][i].z + x[q][i].w * x[q][i].w;
        ss = wave_sum(ss);
        const float r2 = __builtin_amdgcn_rsqf(ss * (1.0f / 1024.0f) + 1e-6f);
        const float* sh = MOD + (size_t)(ln * 3 + cond) * 6144 + shi * 1024;
        const float* sc = MOD + (size_t)(ln * 3 + cond) * 6144 + sci * 1024;
        if (ok[q]) {
#pragma unroll
          for (int i = 0; i < 4; ++i) {
            const float4 g4 = *(const float4*)(gb + i * 256 + lane * 4);
            const float4 s4 = *(const float4*)(sc + i * 256 + lane * 4);
            const float4 h4 = *(const float4*)(sh + i * 256 + lane * 4);
            const float h0 = x[q][i].x * r2 * g4.x * (1.0f + s4.x) + h4.x;
            const float h1 = x[q][i].y * r2 * g4.y * (1.0f + s4.y) + h4.y;
            const float h2 = x[q][i].z * r2 * g4.z * (1.0f + s4.z) + h4.z;
            const float h3 = x[q][i].w * r2 * g4.w * (1.0f + s4.w) + h4.w;
            uint2 o; o.x = pk2(h0, h1); o.y = pk2(h2, h3);
            *(uint2*)(H + (size_t)row * D + i * 256 + lane * 4) = o;
          }
        }
      }
    }
  }
}

namespace pg8 {
#define PG8_LAS __attribute__((address_space(3)))
typedef unsigned short bf16_t;
typedef short bf16x8 __attribute__((ext_vector_type(8)));
typedef float f32x4 __attribute__((ext_vector_type(4)));
typedef unsigned u32x4 __attribute__((ext_vector_type(4)));
constexpr int BM = 256, BK = 64, HALF = 128, HTB = HALF * BK * 2  , STAGE_BYTES = 8 * HTB, NXCD = 8, WGM = 8;

__host__ __device__ __forceinline__ int lds_byte(int r, int c) { const int st = (r >> 4) * 2 + (c >> 5), rr = r & 15, cc = c & 31, ob = rr * 64 + cc * 2; return st * 1024 + (ob ^ (((ob >> 9) & 1) << 5)); }
__host__ __device__ __forceinline__ void stage_rc(int b, int& R, int& C) { const int st = b / 1024, sb = b % 1024, swz = sb ^ (((sb >> 9) & 1) << 5); R = (st >> 1) * 16 + swz / 64; C = (st & 1) * 32 + (swz % 64) / 2; }
__host__ __device__ __forceinline__ int perm32(int rho) { const int n = rho >> 4, i = rho & 15; return 8 * (i >> 2) + 4 * n + (i & 3); }

struct Unit { int pm, pn; };
struct Gemm { const bf16_t* A; const bf16_t* Bt; int M, N, K; };

struct StaticOrder {
    int nM, nN, nwg, G, c;
    __host__ __device__ void init(int M, int N, int G_, int c_) { nM = M / BM; nN = N / BM; nwg = nM * nN; G = G_; c = c_; }
    __host__ __device__ bool next(int i, Unit& u) const {
        const long L = (long)i * G + c; if (L >= nwg) return false;
        int wgid = (int)L; { const int q = nwg / NXCD, r = nwg % NXCD, xcd = wgid % NXCD, off = wgid / NXCD; wgid = (xcd < r ? xcd * (q + 1) : r * (q + 1) + (xcd - r) * q) + off; }
        const int nig = WGM * nN, gid = wgid / nig, fm = gid * WGM, gsz = (nM - fm) < WGM ? (nM - fm) : WGM;
        u.pm = fm + ((wgid % nig) % gsz); u.pn = (wgid % nig) / gsz; return true;
    }
    __device__ __forceinline__ void a_ready(const Unit&) const {}
    __device__ __forceinline__ void done(const Unit&) const {}
};

template <class Epi, class Sched, bool ALIGN_EPI = false, bool SP2 = false>
__device__ __forceinline__ void gemm_phase(PG8_LAS unsigned char* lds, const Gemm g, const Sched& S, const Epi& E) {
    int tid_z; asm volatile("v_mov_b32 %0, 0" : "=v"(tid_z)); const int tid = (int)threadIdx.x + tid_z, wid = __builtin_amdgcn_readfirstlane(tid >> 6), lane = tid & 63, wr = wid >> 2, wc = wid & 3, fr = lane & 15, fq = lane >> 4;
    const int K = g.K, nt = K / BK;
    unsigned voffA[2], voffB[2];
#pragma unroll
    for (int i = 0; i < 2; ++i) { int R, C; stage_rc(tid * 16 + i * 8192, R, C); const int Rb = Epi::PERM ? ((R & ~31) + perm32(R & 31)) : R;
        voffA[i] = (unsigned)(R * K + C) * 2u; voffB[i] = (unsigned)(Rb * K + C) * 2u; }
    const size_t kstep = (size_t)(BK * 2);
    const size_t hstep = (size_t)HALF * K * 2;
    const size_t tstep = 2 * hstep;
    const unsigned ldsw = (unsigned)wid * 1024u;
    const int aoff = lds_byte(wr * 64 + fr, fq * 8), boff = lds_byte(wc * 32 + fr, fq * 8);
#define PG8_SA(b, h) (((b) * 2 + (h)) * HTB)
#define PG8_SB(b, h) ((4 + (b) * 2 + (h)) * HTB)
#define PG8_STAGE(bufoff, gbase, voff) do { _Pragma("unroll") for (int _i = 0; _i < 2; ++_i) \
        __builtin_amdgcn_global_load_lds((const unsigned*)((const char*)(gbase) + (voff)[_i]), (PG8_LAS unsigned*)(lds + (bufoff) + ldsw + _i * 8192), 16, 0, 0); } while (0)
#define PG8_LDA(dst, b, h) do { _Pragma("unroll") for (int m = 0; m < 4; ++m) _Pragma("unroll") for (int k = 0; k < 2; ++k) dst[m][k] = *(const PG8_LAS bf16x8*)(lds + PG8_SA(b, h) + aoff + m * 2048 + k * 1024); } while (0)
#define PG8_LDB(dst, b, h) do { _Pragma("unroll") for (int n = 0; n < 2; ++n) _Pragma("unroll") for (int k = 0; k < 2; ++k) dst[n][k] = *(const PG8_LAS bf16x8*)(lds + PG8_SB(b, h) + boff + n * 2048 + k * 1024); } while (0)
#define PG8_MMA(ai, bj, At, Bt) do { __builtin_amdgcn_s_setprio(1); _Pragma("unroll") for (int m = 0; m < 4; ++m) _Pragma("unroll") for (int n = 0; n < 2; ++n) _Pragma("unroll") for (int k = 0; k < 2; ++k) \
        acc[ai][bj][m][n] = __builtin_amdgcn_mfma_f32_16x16x32_bf16(Bt[n][k], At[m][k], acc[ai][bj][m][n], 0, 0, 0); __builtin_amdgcn_s_setprio(0); } while (0)
#define PG8_WAIT_V(n) asm volatile("s_waitcnt vmcnt(" #n ")" ::: "memory")
#define PG8_WAIT_L(n) asm volatile("s_waitcnt lgkmcnt(" #n ")" ::: "memory")
#define PG8_BAR __builtin_amdgcn_s_barrier()
#define PG8_SCHED __builtin_amdgcn_sched_barrier(0)
    Unit cur, nxt; int ui = 0;
    if (!S.next(0, cur)) return;
    f32x4 acc[2][2][4][2];
#pragma unroll
    for (int a = 0; a < 2; ++a)
#pragma unroll
        for (int b = 0; b < 2; ++b)
#pragma unroll
            for (int m = 0; m < 4; ++m)
#pragma unroll
                for (int n = 0; n < 2; ++n) acc[a][b][m][n] = (f32x4){0.f, 0.f, 0.f, 0.f};
    bf16x8 At[4][2], B0[2][2], B1[2][2];
    const char* cA = (const char*)g.A + (size_t)cur.pm * tstep; const char* cB = (const char*)g.Bt + (size_t)cur.pn * tstep;
    S.a_ready(cur);
    if constexpr (SP2) {
        PG8_STAGE(PG8_SB(0, 0), cB, voffB); PG8_STAGE(PG8_SB(0, 1), cB + hstep, voffB); PG8_STAGE(PG8_SA(0, 0), cA, voffA); PG8_STAGE(PG8_SA(0, 1), cA + hstep, voffA);
        if (wr == 1) PG8_BAR;
        PG8_WAIT_V(2); PG8_BAR;
        PG8_STAGE(PG8_SB(1, 0), cB + kstep, voffB); PG8_STAGE(PG8_SA(1, 0), cA + kstep, voffA); PG8_STAGE(PG8_SB(1, 1), cB + hstep + kstep, voffB);
        PG8_WAIT_V(6); PG8_BAR;
    } else {
        PG8_STAGE(PG8_SB(0, 0), cB, voffB); PG8_STAGE(PG8_SA(0, 0), cA, voffA); PG8_STAGE(PG8_SB(0, 1), cB + hstep, voffB); PG8_STAGE(PG8_SA(0, 1), cA + hstep, voffA);
        if (wr == 1) PG8_BAR;
        PG8_WAIT_V(4); PG8_BAR;
        PG8_STAGE(PG8_SB(1, 0), cB + kstep, voffB); PG8_STAGE(PG8_SA(1, 0), cA + kstep, voffA); PG8_STAGE(PG8_SB(1, 1), cB + hstep + kstep, voffB);
        PG8_WAIT_V(6); PG8_BAR;
    }
    for (;;) {
        const bool has_next = S.next(ui + 1, nxt);
        const char* nA = has_next ? (const char*)g.A + (size_t)nxt.pm * tstep : cA; const char* nB = has_next ? (const char*)g.Bt + (size_t)nxt.pn * tstep : cB;
        for (int t = 0; t < nt; t += 2) {
            const bool last = (t == nt - 2);
            const char* a1 = cA + (size_t)(t + 1) * kstep;
            const char* a2 = last ? nA : cA + (size_t)(t + 2) * kstep; const char* b2 = last ? nB : cB + (size_t)(t + 2) * kstep;
            const char* a3 = a2 + kstep; const char* b3 = b2 + kstep;
            if (last && has_next) S.a_ready(nxt);
            if constexpr (SP2) {
            PG8_LDB(B0, 0, 0); PG8_LDB(B1, 0, 1); PG8_SCHED; PG8_LDA(At, 0, 0); PG8_STAGE(PG8_SA(1, 1), a1 + hstep, voffA);
            PG8_WAIT_V(8); PG8_WAIT_L(0); PG8_BAR; PG8_MMA(0, 0, At, B0); PG8_MMA(0, 1, At, B1); PG8_BAR; PG8_SCHED;
            PG8_LDA(At, 0, 1); PG8_STAGE(PG8_SB(0, 0), b2, voffB); PG8_STAGE(PG8_SB(0, 1), b2 + hstep, voffB); PG8_STAGE(PG8_SA(0, 0), a2, voffA);
            PG8_WAIT_V(8); PG8_WAIT_L(0); PG8_BAR; PG8_MMA(1, 0, At, B0); PG8_MMA(1, 1, At, B1); PG8_BAR; PG8_SCHED;
            PG8_LDB(B0, 1, 0); PG8_LDB(B1, 1, 1); PG8_SCHED; PG8_LDA(At, 1, 0); PG8_STAGE(PG8_SA(0, 1), a2 + hstep, voffA);
            PG8_WAIT_V(8); PG8_WAIT_L(0); PG8_BAR; PG8_MMA(0, 0, At, B0); PG8_MMA(0, 1, At, B1); PG8_BAR; PG8_SCHED;
            PG8_LDA(At, 1, 1); PG8_STAGE(PG8_SB(1, 0), b3, voffB); PG8_STAGE(PG8_SB(1, 1), b3 + hstep, voffB); PG8_STAGE(PG8_SA(1, 0), a3, voffA);
            PG8_WAIT_V(8); PG8_WAIT_L(0); PG8_BAR; PG8_MMA(1, 0, At, B0); PG8_MMA(1, 1, At, B1); PG8_BAR; PG8_SCHED;
            } else {
            PG8_LDB(B0, 0, 0); PG8_SCHED; PG8_LDA(At, 0, 0); PG8_STAGE(PG8_SA(1, 1), a1 + hstep, voffA);
            PG8_WAIT_L(8); PG8_BAR; PG8_WAIT_L(0); PG8_MMA(0, 0, At, B0); PG8_BAR; PG8_SCHED;
            PG8_LDB(B1, 0, 1); PG8_STAGE(PG8_SB(0, 0), b2, voffB);
            PG8_BAR; PG8_WAIT_L(0); PG8_MMA(0, 1, At, B1); PG8_BAR;
            PG8_LDA(At, 0, 1); PG8_STAGE(PG8_SA(0, 0), a2, voffA);
            PG8_BAR; PG8_WAIT_L(0); PG8_MMA(1, 0, At, B0); PG8_BAR; PG8_SCHED;
            PG8_STAGE(PG8_SB(0, 1), b2 + hstep, voffB);
            PG8_WAIT_V(6); PG8_BAR; PG8_MMA(1, 1, At, B1); PG8_BAR;
            PG8_LDB(B0, 1, 0); PG8_SCHED; PG8_LDA(At, 1, 0); PG8_STAGE(PG8_SA(0, 1), a2 + hstep, voffA);
            PG8_WAIT_L(8); PG8_BAR; PG8_WAIT_L(0); PG8_MMA(0, 0, At, B0); PG8_BAR; PG8_SCHED;
            PG8_LDB(B1, 1, 1); PG8_STAGE(PG8_SB(1, 0), b3, voffB);
            PG8_BAR; PG8_WAIT_L(0); PG8_MMA(0, 1, At, B1); PG8_BAR;
            PG8_LDA(At, 1, 1); PG8_STAGE(PG8_SA(1, 0), a3, voffA);
            PG8_BAR; PG8_WAIT_L(0); PG8_MMA(1, 0, At, B0); PG8_BAR; PG8_SCHED;
            PG8_STAGE(PG8_SB(1, 1), b3 + hstep, voffB);
            PG8_WAIT_V(6); PG8_BAR; PG8_MMA(1, 1, At, B1); PG8_BAR;
            }
        }
        if constexpr (ALIGN_EPI) { if (wr == 0) PG8_BAR; }
        if constexpr (!Epi::AFTER_DRAIN) { E(acc, cur, wr, wc, fr, fq); S.done(cur); }
        if (!has_next) break;
#pragma unroll
        for (int a = 0; a < 2; ++a)
#pragma unroll
            for (int b = 0; b < 2; ++b)
#pragma unroll
                for (int m = 0; m < 4; ++m)
#pragma unroll
                    for (int n = 0; n < 2; ++n) acc[a][b][m][n] = (f32x4){0.f, 0.f, 0.f, 0.f};
        cur = nxt; cA = nA; cB = nB; ++ui;
        if constexpr (ALIGN_EPI) { if (wr == 1) PG8_BAR; }
    }
    PG8_WAIT_V(0);
    if constexpr (!ALIGN_EPI) { if (wr == 0) PG8_BAR; }
    PG8_BAR;
    if constexpr (Epi::AFTER_DRAIN) { E.fused(acc, cur, wr, wc, fr, fq, lds, wid, lane); S.done(cur); }
#undef PG8_SA
#undef PG8_SB
#undef PG8_STAGE
#undef PG8_LDA
#undef PG8_LDB
#undef PG8_MMA
#undef PG8_WAIT_V
#undef PG8_WAIT_L
#undef PG8_BAR
#undef PG8_SCHED
}
}

template <int MODE> struct EpiMK {
  static constexpr bool PERM = true, AFTER_DRAIN = false;
  const Params* pp; int l;
  DEV void operator()(const pg8::f32x4 (&acc)[2][2][4][2], const pg8::Unit& u, int wr, int wc, int fr, int fq) const {
    const Params& p = *pp;
#pragma unroll
    for (int ai = 0; ai < 2; ++ai)
#pragma unroll
      for (int m = 0; m < 4; ++m) {
        const int row = u.pm * 256 + ai * 128 + wr * 64 + m * 16 + fr;
#pragma unroll
        for (int bj = 0; bj < 2; ++bj) {
          const int col = u.pn * 256 + bj * 128 + wc * 32 + fq * 8;
          const pg8::f32x4 v0 = acc[ai][bj][m][0], v1 = acc[ai][bj][m][1];
          if (MODE == 0) {
            if (col < DIN) {
              uint4 o; o.x = pk2(v0[0], v0[1]); o.y = pk2(v0[2], v0[3]); o.z = pk2(v1[0], v1[1]); o.w = pk2(v1[2], v1[3]);
              *(uint4*)((bf16_t*)(p.ws + OFF_P) + (size_t)row * DIN + col) = o;
              if (row < NCTX) {
                if (col >= C_NK && col < C_HQ) {
                  const int kv = col >= C_NV;
                  float* dst = p.out + O_NAT + (size_t)(((row >> 8) * 4 + l) * 2 + kv) * 65536 + (row & 255) * 256 + (col - (kv ? C_NV : C_NK));
                  *(pg8::f32x4*)dst = v0; *(pg8::f32x4*)(dst + 4) = v1;
                } else if (col >= C_SK) {
                  const int kv = col >= C_SV;
                  float* dst = p.out + O_SWA + (size_t)(((row >> 8) * 4 + l) * 2 + kv) * 32768 + (row & 255) * 128 + (col - (kv ? C_SV : C_SK));
                  *(pg8::f32x4*)dst = v0; *(pg8::f32x4*)(dst + 4) = v1;
                }
              }
            }
          } else if (MODE == 1) {
            uint4 o; o.x = pk2(v0[0], v0[1]); o.y = pk2(v0[2], v0[3]); o.z = pk2(v1[0], v1[1]); o.w = pk2(v1[2], v1[3]);
            *(uint4*)((bf16_t*)(p.ws + OFF_U) + (size_t)row * D + col) = o;
          } else {
            float r[8];
#pragma unroll
            for (int e = 0; e < 4; ++e) { const float a = fmaxf(v0[e], 0.f), b2 = fmaxf(v1[e], 0.f); r[e] = a * a; r[4 + e] = b2 * b2; }
            uint4 o; o.x = pk2(r[0], r[1]); o.y = pk2(r[2], r[3]); o.z = pk2(r[4], r[5]); o.w = pk2(r[6], r[7]);
            *(uint4*)((bf16_t*)(p.ws + OFF_HID) + (size_t)row * FF + col) = o;
          }
        }
      }
  }
};

template <int MODE>
DEV void gemm_run(const Params& p, int l, const bf16_t* A, const bf16_t* BT, int K, int N, char* lds) {
  pg8::Gemm g{A, BT, MT, N, K};
  pg8::StaticOrder S; S.init(MT, N, (int)gridDim.x, (int)blockIdx.x);
  EpiMK<MODE> E{&p, l};
  pg8::gemm_phase<EpiMK<MODE>, pg8::StaticOrder, true, true>((PG8_LAS unsigned char*)lds, g, S, E);
  if (MODE == 1 && l < 3 && (int)gridDim.x > 160 && (int)blockIdx.x >= 160) {
    if (K == D) layer_tiles(p, l + 1, 0, 640, (int)blockIdx.x - 160, (int)gridDim.x - 160, lds);
    else layer_tiles(p, l + 1, 640, NT_LAYER, (int)blockIdx.x - 160, (int)gridDim.x - 160, lds);
  }
}

constexpr int TOKT = 20;
DEV void prep_item(const Params& p, int l, int tile, char* lds) {
  const int t = tid(), r0 = tile * TOKT, c = t;
  bf16_t* sA = (bf16_t*)lds;
  float* swl = (float*)(lds + 32 * 136 * 2);
  float* sal = swl + TOKT * 256;
  const bf16_t* P = (const bf16_t*)(p.ws + OFF_P);
  bf16_t* PREP = (bf16_t*)(p.ws + OFF_PREP);
  bf16_t* BON = (bf16_t*)(p.ws + OFF_BONUS);
  for (int dir = 0; dir < 2; ++dir) {
    __syncthreads();
#pragma unroll
    for (int i = 0; i < TOKT / 2; ++i) {
      const int e = t + 256 * i, tk = e >> 7, j = e & 127, which = j >> 6, jj = j & 63;
      const int row = r0 + tk, prow = dir ? row + 1 : row - 1;
      const int tis = row < NCTX ? (row & 255) : ((row - NCTX) & 1023), Tm1 = row < NCTX ? 255 : 1023;
      const bool pv = dir ? (tis < Tm1) : (tis > 0);
      const int col = (dir ? C_WHB : C_WHF) + which * 64 + jj;
      const float cur = bf2f(P[(size_t)row * DIN + col]);
      const float prev = bf2f(P[(size_t)(pv ? prow : row) * DIN + col]) * (pv ? 1.f : 0.f);
      const float mu = p.in[I_MULORA][((l * 2 + dir) * 2 + which) * 64 + jj];
      const float val = cur + (prev - cur) * mu;
      sA[tk * 136 + j] = f2bf((which == 0) ? tanhf_(val) : val);
    }
    __syncthreads();
    {
      const int lane = t & 63, w = t >> 6, q = lane & 31, hh = lane >> 5;
#pragma unroll
      for (int mat = 0; mat < 2; ++mat) {
        bf16x8 af[4];
#pragma unroll
        for (int s = 0; s < 4; ++s) af[s] = *(const bf16x8*)(sA + q * 136 + mat * 64 + 16 * s + 8 * hh);
        const bf16_t* WT = (const bf16_t*)(p.ws + (mat ? OFF_A2T : OFF_W2T)) + (size_t)(l * 2 + dir) * 256 * 64;
        float* dst = mat ? sal : swl;
#pragma unroll
        for (int nt = 0; nt < 2; ++nt) {
          const int n = w * 64 + nt * 32 + q;
          f32x16 acc;
#pragma unroll
          for (int r = 0; r < 16; ++r) acc[r] = 0.f;
#pragma unroll
          for (int s = 0; s < 4; ++s) acc = MFMA32(af[s], *(const bf16x8*)(WT + (size_t)n * 64 + 16 * s + 8 * hh), acc);
#pragma unroll
          for (int r = 0; r < 8; ++r) dst[((r & 3) + 8 * (r >> 2) + 4 * hh) * 256 + n] = acc[r];
          if (hh == 0) {
#pragma unroll
            for (int r = 8; r < 12; ++r) dst[((r & 3) + 16) * 256 + n] = acc[r];
          }
        }
      }
    }
    __syncthreads();
    const float w0v = p.in[I_W0][(l * 2 + dir) * 256 + c], a0v = p.in[I_A0][(l * 2 + dir) * 256 + c];
    const float kkv = p.in[I_KK][l * 256 + c], kav = p.in[I_KA][l * 256 + c], rkv = p.in[I_RK][l * 256 + c];
    const float mur = p.in[I_MURKV][((l * 2 + dir) * 3 + 0) * 256 + c], muk = p.in[I_MURKV][((l * 2 + dir) * 3 + 1) * 256 + c],
                muv = p.in[I_MURKV][((l * 2 + dir) * 3 + 2) * 256 + c];
    bf16_t* pr = PREP + (size_t)dir * 6 * ARRF;
    for (int tb = 0; tb < TOKT; tb += 5) {
      float rc[5], kc[5], vc[5], rp[5], kq[5], vp[5], wlv[5], alv[5];
#pragma unroll
      for (int u = 0; u < 5; ++u) {
        const int tk = tb + u, row = r0 + tk, prow = dir ? row + 1 : row - 1;
        const int tis = row < NCTX ? (row & 255) : ((row - NCTX) & 1023), Tm1 = row < NCTX ? 255 : 1023;
        const bool pv = dir ? (tis < Tm1) : (tis > 0);
        const float pm = pv ? 1.f : 0.f;
        const bf16_t* pc = P + (size_t)row * DIN + c;
        const bf16_t* pp = P + (size_t)(pv ? prow : row) * DIN + c;
        rc[u] = bf2f(pc[C_R]); kc[u] = bf2f(pc[C_K]); vc[u] = bf2f(pc[C_V]);
        rp[u] = bf2f(pp[C_R]) * pm; kq[u] = bf2f(pp[C_K]) * pm; vp[u] = bf2f(pp[C_V]) * pm;
        wlv[u] = swl[tk * 256 + c]; alv[u] = sal[tk * 256 + c];
      }
      float bprev[5];
#pragma unroll
      for (int u = 0; u < 5; ++u) bprev[u] = (dir == 1) ? bf2f(BON[(size_t)(r0 + tb + u) * 256 + c]) : 0.f;
#pragma unroll
      for (int u = 0; u < 5; ++u) {
        const int row = r0 + tb + u;
        const float rs = rc[u] + (rp[u] - rc[u]) * mur, ks = kc[u] + (kq[u] - kc[u]) * muk, vs = vc[u] + (vp[u] - vc[u]) * muv;
        const float wl = w0v + wlv[u], al = a0v + alv[u];
        const float wv = __expf(-0.6065306597126334f * sigmoidf_(wl));
        const float av = sigmoidf_(al);
        const float kkr = ks * kkv;
        const float n2 = wave_sum(kkr * kkr);
        const float kk = kkr * rcpf_(fmaxf(__builtin_amdgcn_sqrtf(n2), 1e-12f));
        const float kp = ks * (1.0f + (av - 1.0f) * kav);
        const float bs = wave_sum(rs * kp * rkv);
        const float bon = bs * vs;
        const size_t idx = (size_t)row * 256 + c;
        pr[idx] = f2bf(rs); pr[ARRF + idx] = f2bf(wv); pr[2 * ARRF + idx] = f2bf(kp); pr[3 * ARRF + idx] = f2bf(vs); pr[4 * ARRF + idx] = f2bf(kk); pr[5 * ARRF + idx] = f2bf(kk * av);
        BON[idx] = f2bf(bprev[u] + bon);
      }
    }
  }
  __syncthreads();
}

DEV void rope_item(const Params& p, int item) {
  bf16_t* P = (bf16_t*)(p.ws + OFF_P);
  const int t = tid();
  for (int e = t; e < 64 * 192; e += 256) {
    const int tk = e / 192, r = e % 192, hs = r >> 5, pi = r & 31;
    const int lt = item * 64 + tk;
    const int tt = lt & 1023;
    const int grow = tt >> 6, gcol = tt & 63;
    const int fi = pi & 15;
    const float pos = (pi < 16) ? (float)grow : (float)gcol;
    const float inv = exp2f(-(float)fi * (13.287712379549449f / 16.0f));
    const float ang = pos * inv;
    const float cs = __cosf(ang), sn = __sinf(ang);
    const int d1 = (pi < 16) ? fi : 32 + fi;
    bf16_t* base = P + (size_t)(NCTX + lt) * DIN + C_SQ + hs * 64;
    const float x1 = bf2f(base[d1]), x2 = bf2f(base[d1 + 16]);
    base[d1] = f2bf(x1 * cs - x2 * sn);
    base[d1 + 16] = f2bf(x2 * cs + x1 * sn);
  }
}

constexpr int SC_BUF = 20480 + 4096;
typedef float f2 __attribute__((ext_vector_type(2)));
DEV float dot4(const float4& a, const float4& b) { return a.x * b.x + a.y * b.y + a.z * b.z + a.w * b.w; }
DEV float red8(float x) { x += dppf<0xB1>(x); x += dppf<0x4E>(x); x += dppf<0x141>(x); return x; }
DEV float dot8(const f2 (&S)[4], const float4& a, const float4& b) {
  f2 acc = S[0] * (f2){a.x, a.y};
  acc += S[1] * (f2){a.z, a.w}; acc += S[2] * (f2){b.x, b.y}; acc += S[3] * (f2){b.z, b.w};
  return acc.x + acc.y;
}

template <int NCH>
DEV void rwkv_scan(const Params& p, int l, int seq, int head, int dir, int rsel, char* lds) {
  const int t = tid(), rr = t >> 3, g = t & 7, rl = t >> 4, ks = t & 15;
  const int T = seq < 32 ? 256 : 1024;
  const int row0 = seq < 32 ? seq * 256 : NCTX + (seq - 32) * 1024;
  const bf16_t* prep = (const bf16_t*)(p.ws + OFF_PREP) + (size_t)dir * 6 * ARRF;
  float* ydir = (float*)(p.ws + OFF_YDIR) + (size_t)dir * ARRF;
  const int vbase = (NCH == 2) ? 0 : rsel * 32;
  f2 S[NCH][4];
#pragma unroll
  for (int c = 0; c < NCH; ++c)
#pragma unroll
    for (int j = 0; j < 4; ++j) S[c][j] = (f2){0.f, 0.f};
  if (seq >= 32) {
    const float* sp = p.in[I_SRW] + ((((size_t)(seq - 32) * 4 + l) * 2 + dir) * 4 + head) * 4096 + g * 8;
#pragma unroll
    for (int c = 0; c < NCH; ++c) {
      const float4 a = *(const float4*)(sp + (vbase + rr + 32 * c) * 64), b = *(const float4*)(sp + (vbase + rr + 32 * c) * 64 + 4);
      S[c][0] = (f2){a.x, a.y}; S[c][1] = (f2){a.z, a.w}; S[c][2] = (f2){b.x, b.y}; S[c][3] = (f2){b.z, b.w};
    }
  }
  const int nch = T >> 4;
  uint2 pre0, pre1, pre2, pre3, pre4, pvv;
#define RW_LOAD(cc) do { const int s_ = (cc) * 16 + rl; const int tok_ = dir ? (T - 1 - s_) : s_; \
    const size_t base_ = (size_t)(row0 + tok_) * 256 + head * 64; \
    pre0 = *(const uint2*)(prep + base_ + ks * 4); pre1 = *(const uint2*)(prep + ARRF + base_ + ks * 4); \
    pre2 = *(const uint2*)(prep + 2 * ARRF + base_ + ks * 4); pre3 = *(const uint2*)(prep + 4 * ARRF + base_ + ks * 4); \
    pre4 = *(const uint2*)(prep + 5 * ARRF + base_ + ks * 4); \
    if (NCH == 2) pvv = *(const uint2*)(prep + 3 * ARRF + base_ + ks * 4); \
    else pvv.x = *(const unsigned*)(prep + 3 * ARRF + base_ + vbase + ks * 2); } while (0)
#define RW_WRITE(bb) do { float4* sb_ = (float4*)(lds + (bb) * SC_BUF); float* vb_ = (float*)(lds + (bb) * SC_BUF + 20480); \
    sb_[(0 * 16 + rl) * 16 + ks] = bf4(pre0); sb_[(1 * 16 + rl) * 16 + ks] = bf4(pre1); sb_[(2 * 16 + rl) * 16 + ks] = bf4(pre2); \
    sb_[(3 * 16 + rl) * 16 + ks] = bf4(pre3); sb_[(4 * 16 + rl) * 16 + ks] = bf4(pre4); \
    if (NCH == 2) *(float4*)(vb_ + rl * 64 + ks * 4) = bf4(pvv); else *(f2*)(vb_ + rl * 64 + ks * 2) = (f2){bflo(pvv.x), bfhi(pvv.x)}; } while (0)
  __syncthreads();
  RW_LOAD(0); RW_WRITE(0);
  __syncthreads();
  for (int c = 0; c < nch; ++c) {
    if (c + 1 < nch) RW_LOAD(c + 1);
    const float4* sbuf = (const float4*)(lds + (c & 1) * SC_BUF);
    const float* vbuf = (const float*)(lds + (c & 1) * SC_BUF + 20480);
    float ym[NCH][2];
#pragma unroll
    for (int cc = 0; cc < NCH; ++cc) { ym[cc][0] = 0.f; ym[cc][1] = 0.f; }
#pragma unroll
    for (int i = 0; i < 16; ++i) {
      const float4 ra = sbuf[(0 * 16 + i) * 16 + g * 2], rb = sbuf[(0 * 16 + i) * 16 + g * 2 + 1];
      const float4 wa = sbuf[(1 * 16 + i) * 16 + g * 2], wb = sbuf[(1 * 16 + i) * 16 + g * 2 + 1];
      const float4 ka_ = sbuf[(2 * 16 + i) * 16 + g * 2], kb_ = sbuf[(2 * 16 + i) * 16 + g * 2 + 1];
      const float4 na = sbuf[(3 * 16 + i) * 16 + g * 2], nb = sbuf[(3 * 16 + i) * 16 + g * 2 + 1];
      const float4 aa = sbuf[(4 * 16 + i) * 16 + g * 2], ab = sbuf[(4 * 16 + i) * 16 + g * 2 + 1];
      const f2 w2[4] = {(f2){wa.x, wa.y}, (f2){wa.z, wa.w}, (f2){wb.x, wb.y}, (f2){wb.z, wb.w}};
      const f2 k2[4] = {(f2){ka_.x, ka_.y}, (f2){ka_.z, ka_.w}, (f2){kb_.x, kb_.y}, (f2){kb_.z, kb_.w}};
      const f2 a2[4] = {(f2){aa.x, aa.y}, (f2){aa.z, aa.w}, (f2){ab.x, ab.y}, (f2){ab.z, ab.w}};
#pragma unroll
      for (int cc = 0; cc < NCH; ++cc) {
        const float v = vbuf[i * 64 + rr + 32 * cc];
        const float sa = -red8(dot8(S[cc], na, nb));
#pragma unroll
        for (int j = 0; j < 4; ++j) S[cc][j] = S[cc][j] * w2[j] + a2[j] * sa + k2[j] * v;
        const float y = red8(dot8(S[cc], ra, rb));
        ym[cc][i >> 3] = (g == (i & 7)) ? y : ym[cc][i >> 3];
      }
    }
#pragma unroll
    for (int hh = 0; hh < 2; ++hh) {
      const int s = c * 16 + hh * 8 + g; const int tok = dir ? (T - 1 - s) : s;
      float* yo = ydir + (size_t)(row0 + tok) * 256 + head * 64 + vbase + rr;
#pragma unroll
      for (int cc = 0; cc < NCH; ++cc) yo[32 * cc] = ym[cc][hh];
    }
    if (c + 1 < nch) RW_WRITE((c + 1) & 1);
    __syncthreads();
  }
#undef RW_LOAD
#undef RW_WRITE
  if (seq < 32) {
    float* sp = p.out + O_RW + ((((size_t)seq * 4 + l) * 2 + dir) * 4 + head) * 4096 + g * 8;
#pragma unroll
    for (int c = 0; c < NCH; ++c) {
      *(float4*)(sp + (vbase + rr + 32 * c) * 64) = make_float4(S[c][0].x, S[c][0].y, S[c][1].x, S[c][1].y);
      *(float4*)(sp + (vbase + rr + 32 * c) * 64 + 4) = make_float4(S[c][2].x, S[c][2].y, S[c][3].x, S[c][3].y);
    }
  }
}

template <int NCH>
DEV void hgrn_scan(const Params& p, int l, int seq, int head, int dir, int rsel, char* lds) {
  const int t = tid(), rr = t >> 3, g = t & 7, rl = t >> 4, ks = t & 15;
  const int T = seq < 32 ? 256 : 1024;
  const int row0 = seq < 32 ? seq * 256 : NCTX + (seq - 32) * 1024;
  const bf16_t* P = (const bf16_t*)(p.ws + OFF_P);
  float* odir = (float*)(p.ws + OFF_HDIR) + (size_t)dir * ARRF;
  const float4 lb4 = *(const float4*)((const float*)(p.ws + OFF_HGLB) + (l * 2 + dir) * 256 + head * 64 + ks * 4);
  const int vbase = (NCH == 2) ? 0 : rsel * 32;
  f2 S[NCH][4];
#pragma unroll
  for (int c = 0; c < NCH; ++c)
#pragma unroll
    for (int j = 0; j < 4; ++j) S[c][j] = (f2){0.f, 0.f};
  if (seq >= 32) {
    const float* sp = p.in[I_SHG] + ((((size_t)(seq - 32) * 4 + l) * 2 + dir) * 4 + head) * 4096;
#pragma unroll
    for (int c = 0; c < NCH; ++c)
#pragma unroll
      for (int j = 0; j < 4; ++j) {
        const int v = vbase + rr + 32 * c;
        S[c][j] = (f2){sp[(g * 8 + 2 * j) * 64 + v], sp[(g * 8 + 2 * j + 1) * 64 + v]};
      }
  }
  const int nch = T >> 4;
  const int fcol = (dir ? C_HFB : C_HFF) + head * 64;
  uint2 pq, pf, pv2;
#define HG_LOAD(cc) do { const int s_ = (cc) * 16 + rl; const int tok_ = dir ? (T - 1 - s_) : s_; \
    const bf16_t* pr_ = P + (size_t)(row0 + tok_) * DIN; \
    pq = *(const uint2*)(pr_ + C_HQ + head * 64 + ks * 4); pf = *(const uint2*)(pr_ + fcol + ks * 4); \
    if (NCH == 2) pv2 = *(const uint2*)(pr_ + C_HI + head * 64 + ks * 4); else pv2.x = *(const unsigned*)(pr_ + C_HI + head * 64 + vbase + ks * 2); } while (0)
#define HG_WRITE(bb) do { float4* sb_ = (float4*)(lds + (bb) * SC_BUF); float* vb_ = (float*)(lds + (bb) * SC_BUF + 20480); \
    float4 q_, f_, k_; float a_, sg_; \
    a_ = bflo(pq.x); q_.x = a_ * sigmoidf_(a_); a_ = bfhi(pq.x); q_.y = a_ * sigmoidf_(a_); \
    a_ = bflo(pq.y); q_.z = a_ * sigmoidf_(a_); a_ = bfhi(pq.y); q_.w = a_ * sigmoidf_(a_); \
    sg_ = sigmoidf_(bflo(pf.x)); f_.x = lb4.x + (1.f - lb4.x) * sg_; k_.x = (1.f - lb4.x) * (1.f - sg_); \
    sg_ = sigmoidf_(bfhi(pf.x)); f_.y = lb4.y + (1.f - lb4.y) * sg_; k_.y = (1.f - lb4.y) * (1.f - sg_); \
    sg_ = sigmoidf_(bflo(pf.y)); f_.z = lb4.z + (1.f - lb4.z) * sg_; k_.z = (1.f - lb4.z) * (1.f - sg_); \
    sg_ = sigmoidf_(bfhi(pf.y)); f_.w = lb4.w + (1.f - lb4.w) * sg_; k_.w = (1.f - lb4.w) * (1.f - sg_); \
    sb_[(0 * 16 + rl) * 16 + ks] = q_; sb_[(1 * 16 + rl) * 16 + ks] = f_; sb_[(2 * 16 + rl) * 16 + ks] = k_; \
    if (NCH == 2) *(float4*)(vb_ + rl * 64 + ks * 4) = make_float4(bflo(pv2.x), bfhi(pv2.x), bflo(pv2.y), bfhi(pv2.y)); \
    else *(f2*)(vb_ + rl * 64 + ks * 2) = (f2){bflo(pv2.x), bfhi(pv2.x)}; } while (0)
  __syncthreads();
  HG_LOAD(0); HG_WRITE(0);
  __syncthreads();
  for (int c = 0; c < nch; ++c) {
    if (c + 1 < nch) HG_LOAD(c + 1);
    const float4* sbuf = (const float4*)(lds + (c & 1) * SC_BUF);
    const float* vbuf = (const float*)(lds + (c & 1) * SC_BUF + 20480);
    float ym[NCH][2];
#pragma unroll
    for (int cc = 0; cc < NCH; ++cc) { ym[cc][0] = 0.f; ym[cc][1] = 0.f; }
#pragma unroll
    for (int i = 0; i < 16; ++i) {
      const float4 qa = sbuf[(0 * 16 + i) * 16 + g * 2], qb = sbuf[(0 * 16 + i) * 16 + g * 2 + 1];
      const float4 fa = sbuf[(1 * 16 + i) * 16 + g * 2], fb = sbuf[(1 * 16 + i) * 16 + g * 2 + 1];
      const float4 ka_ = sbuf[(2 * 16 + i) * 16 + g * 2], kb_ = sbuf[(2 * 16 + i) * 16 + g * 2 + 1];
      const f2 f2v[4] = {(f2){fa.x, fa.y}, (f2){fa.z, fa.w}, (f2){fb.x, fb.y}, (f2){fb.z, fb.w}};
      const f2 k2[4] = {(f2){ka_.x, ka_.y}, (f2){ka_.z, ka_.w}, (f2){kb_.x, kb_.y}, (f2){kb_.z, kb_.w}};
#pragma unroll
      for (int cc = 0; cc < NCH; ++cc) {
        const float v = vbuf[i * 64 + rr + 32 * cc];
#pragma unroll
        for (int j = 0; j < 4; ++j) S[cc][j] = S[cc][j] * f2v[j] + k2[j] * v;
        const float y = red8(dot8(S[cc], qa, qb));
        ym[cc][i >> 3] = (g == (i & 7)) ? y : ym[cc][i >> 3];
      }
    }
#pragma unroll
    for (int hh = 0; hh < 2; ++hh) {
      const int s = c * 16 + hh * 8 + g; const int tok = dir ? (T - 1 - s) : s;
      float* yo = odir + (size_t)(row0 + tok) * 256 + head * 64 + vbase + rr;
#pragma unroll
      for (int cc = 0; cc < NCH; ++cc) yo[32 * cc] = ym[cc][hh];
    }
    if (c + 1 < nch) HG_WRITE((c + 1) & 1);
    __syncthreads();
  }
#undef HG_LOAD
#undef HG_WRITE
  if (seq < 32) {
    float* sp = p.out + O_HG + ((((size_t)seq * 4 + l) * 2 + dir) * 4 + head) * 4096;
#pragma unroll
    for (int c = 0; c < NCH; ++c)
#pragma unroll
      for (int j = 0; j < 4; ++j) {
        const int v = vbase + rr + 32 * c;
        sp[(g * 8 + 2 * j) * 64 + v] = S[c][j].x; sp[(g * 8 + 2 * j + 1) * 64 + v] = S[c][j].y;
      }
  }
}

DEV void rwkv_scan16(const Params& p, int l, int seq, int head, int dir, int rg, char* lds) {
  const int t = tid(), rl = t >> 4, ks = t & 15;
  const int T = seq < 32 ? 256 : 1024;
  const int row0 = seq < 32 ? seq * 256 : NCTX + (seq - 32) * 1024;
  const bf16_t* prep = (const bf16_t*)(p.ws + OFF_PREP) + (size_t)dir * 6 * ARRF;
  float* ydir = (float*)(p.ws + OFF_YDIR) + (size_t)dir * ARRF;
  const int v0 = rg * 16 + rl;
  float4 S0 = make_float4(0.f, 0.f, 0.f, 0.f);
  if (seq >= 32) S0 = *(const float4*)(p.in[I_SRW] + ((((size_t)(seq - 32) * 4 + l) * 2 + dir) * 4 + head) * 4096 + ks * 4 + v0 * 64);
  const int nch = T >> 4;
  uint2 pre0, pre1, pre2, pre3, pre4; bf16_t pv0;
#define RW_LOAD(cc) do { const int s_ = (cc) * 16 + rl; const int tok_ = dir ? (T - 1 - s_) : s_; \
    const size_t base_ = (size_t)(row0 + tok_) * 256 + head * 64; \
    pre0 = *(const uint2*)(prep + base_ + ks * 4); pre1 = *(const uint2*)(prep + ARRF + base_ + ks * 4); \
    pre2 = *(const uint2*)(prep + 2 * ARRF + base_ + ks * 4); pre3 = *(const uint2*)(prep + 4 * ARRF + base_ + ks * 4); \
    pre4 = *(const uint2*)(prep + 5 * ARRF + base_ + ks * 4); pv0 = prep[3 * ARRF + base_ + rg * 16 + ks]; } while (0)
#define RW_WRITE(bb) do { float4* sb_ = (float4*)(lds + (bb) * SC_BUF); float* vb_ = (float*)(lds + (bb) * SC_BUF + 20480); \
    sb_[(0 * 16 + rl) * 16 + ks] = bf4(pre0); sb_[(1 * 16 + rl) * 16 + ks] = bf4(pre1); sb_[(2 * 16 + rl) * 16 + ks] = bf4(pre2); \
    sb_[(3 * 16 + rl) * 16 + ks] = bf4(pre3); sb_[(4 * 16 + rl) * 16 + ks] = bf4(pre4); vb_[rl * 16 + ks] = bf2f(pv0); } while (0)
  __syncthreads();
  RW_LOAD(0); RW_WRITE(0);
  __syncthreads();
  for (int c = 0; c < nch; ++c) {
    if (c + 1 < nch) RW_LOAD(c + 1);
    const float4* sbuf = (const float4*)(lds + (c & 1) * SC_BUF);
    const float* vbuf = (const float*)(lds + (c & 1) * SC_BUF + 20480);
    float ym0 = 0.f;
#pragma unroll
    for (int i = 0; i < 16; ++i) {
      const float4 r = sbuf[(0 * 16 + i) * 16 + ks], wv = sbuf[(1 * 16 + i) * 16 + ks], kv = sbuf[(2 * 16 + i) * 16 + ks],
                   kk = sbuf[(3 * 16 + i) * 16 + ks], ka = sbuf[(4 * 16 + i) * 16 + ks];
      const float va = vbuf[i * 16 + rl];
      const float sa0 = -row16_sum(dot4(S0, kk));
      S0.x = S0.x * wv.x + sa0 * ka.x + va * kv.x; S0.y = S0.y * wv.y + sa0 * ka.y + va * kv.y;
      S0.z = S0.z * wv.z + sa0 * ka.z + va * kv.z; S0.w = S0.w * wv.w + sa0 * ka.w + va * kv.w;
      const float y0 = row16_sum(dot4(S0, r));
      ym0 = (ks == i) ? y0 : ym0;
    }
    {
      const int s = c * 16 + ks; const int tok = dir ? (T - 1 - s) : s;
      ydir[(size_t)(row0 + tok) * 256 + head * 64 + v0] = ym0;
    }
    if (c + 1 < nch) RW_WRITE((c + 1) & 1);
    __syncthreads();
  }
#undef RW_LOAD
#undef RW_WRITE
  if (seq < 32) *(float4*)(p.out + O_RW + ((((size_t)seq * 4 + l) * 2 + dir) * 4 + head) * 4096 + ks * 4 + v0 * 64) = S0;
}

DEV void hgrn_scan16(const Params& p, int l, int seq, int head, int dir, int rg, char* lds) {
  const int t = tid(), rl = t >> 4, ks = t & 15;
  const int T = seq < 32 ? 256 : 1024;
  const int row0 = seq < 32 ? seq * 256 : NCTX + (seq - 32) * 1024;
  const bf16_t* P = (const bf16_t*)(p.ws + OFF_P);
  float* odir = (float*)(p.ws + OFF_HDIR) + (size_t)dir * ARRF;
  const float4 lb4 = *(const float4*)((const float*)(p.ws + OFF_HGLB) + (l * 2 + dir) * 256 + head * 64 + ks * 4);
  const int v0 = rg * 16 + rl;
  float4 S0 = make_float4(0.f, 0.f, 0.f, 0.f);
  if (seq >= 32) {
    const float* sp = p.in[I_SHG] + ((((size_t)(seq - 32) * 4 + l) * 2 + dir) * 4 + head) * 4096;
    S0.x = sp[(ks * 4 + 0) * 64 + v0]; S0.y = sp[(ks * 4 + 1) * 64 + v0]; S0.z = sp[(ks * 4 + 2) * 64 + v0]; S0.w = sp[(ks * 4 + 3) * 64 + v0];
  }
  const int nch = T >> 4;
  const int fcol = (dir ? C_HFB : C_HFF) + head * 64;
  uint2 pq, pf; bf16_t pva;
#define HG_LOAD(cc) do { const int s_ = (cc) * 16 + rl; const int tok_ = dir ? (T - 1 - s_) : s_; \
    const bf16_t* pr_ = P + (size_t)(row0 + tok_) * DIN; \
    pq = *(const uint2*)(pr_ + C_HQ + head * 64 + ks * 4); pf = *(const uint2*)(pr_ + fcol + ks * 4); \
    pva = pr_[C_HI + head * 64 + rg * 16 + ks]; } while (0)
#define HG_WRITE(bb) do { float4* sb_ = (float4*)(lds + (bb) * SC_BUF); float* vb_ = (float*)(lds + (bb) * SC_BUF + 20480); \
    float4 q_, f_, k_; float a_, sg_; \
    a_ = bflo(pq.x); q_.x = a_ * sigmoidf_(a_); a_ = bfhi(pq.x); q_.y = a_ * sigmoidf_(a_); \
    a_ = bflo(pq.y); q_.z = a_ * sigmoidf_(a_); a_ = bfhi(pq.y); q_.w = a_ * sigmoidf_(a_); \
    sg_ = sigmoidf_(bflo(pf.x)); f_.x = lb4.x + (1.f - lb4.x) * sg_; k_.x = (1.f - lb4.x) * (1.f - sg_); \
    sg_ = sigmoidf_(bfhi(pf.x)); f_.y = lb4.y + (1.f - lb4.y) * sg_; k_.y = (1.f - lb4.y) * (1.f - sg_); \
    sg_ = sigmoidf_(bflo(pf.y)); f_.z = lb4.z + (1.f - lb4.z) * sg_; k_.z = (1.f - lb4.z) * (1.f - sg_); \
    sg_ = sigmoidf_(bfhi(pf.y)); f_.w = lb4.w + (1.f - lb4.w) * sg_; k_.w = (1.f - lb4.w) * (1.f - sg_); \
    sb_[(0 * 16 + rl) * 16 + ks] = q_; sb_[(1 * 16 + rl) * 16 + ks] = f_; sb_[(2 * 16 + rl) * 16 + ks] = k_; \
    vb_[rl * 16 + ks] = bf2f(pva); } while (0)
  __syncthreads();
  HG_LOAD(0); HG_WRITE(0);
  __syncthreads();
  for (int c = 0; c < nch; ++c) {
    if (c + 1 < nch) HG_LOAD(c + 1);
    const float4* sbuf = (const float4*)(lds + (c & 1) * SC_BUF);
    const float* vbuf = (const float*)(lds + (c & 1) * SC_BUF + 20480);
    float ym0 = 0.f;
#pragma unroll
    for (int i = 0; i < 16; ++i) {
      const float4 q = sbuf[(0 * 16 + i) * 16 + ks], f = sbuf[(1 * 16 + i) * 16 + ks], k = sbuf[(2 * 16 + i) * 16 + ks];
      const float va = vbuf[i * 16 + rl];
      S0.x = S0.x * f.x + k.x * va; S0.y = S0.y * f.y + k.y * va; S0.z = S0.z * f.z + k.z * va; S0.w = S0.w * f.w + k.w * va;
      const float y0 = row16_sum(dot4(S0, q));
      ym0 = (ks == i) ? y0 : ym0;
    }
    {
      const int s = c * 16 + ks; const int tok = dir ? (T - 1 - s) : s;
      odir[(size_t)(row0 + tok) * 256 + head * 64 + v0] = ym0;
    }
    if (c + 1 < nch) HG_WRITE((c + 1) & 1);
    __syncthreads();
  }
#undef HG_LOAD
#undef HG_WRITE
  if (seq < 32) {
    float* sp = p.out + O_HG + ((((size_t)seq * 4 + l) * 2 + dir) * 4 + head) * 4096;
    sp[(ks * 4 + 0) * 64 + v0] = S0.x; sp[(ks * 4 + 1) * 64 + v0] = S0.y; sp[(ks * 4 + 2) * 64 + v0] = S0.z; sp[(ks * 4 + 3) * 64 + v0] = S0.w;
  }
}

template <int MODE>
DEV void attn_item(const Params& p, int l, int item, char* lds) {
  const int t = tid(), lane = t & 63, w = t >> 6, q = lane & 31, hh = lane >> 5;
  const bf16_t* P = (const bf16_t*)(p.ws + OFF_P);
  bf16_t* Y = (bf16_t*)(p.ws + OFF_YMIX);
  char* sK = lds;
  char* sV = lds + 8192;
  float* sBias = (float*)(lds + 8192 + 8704);
  int head, qrow, qcol, kcol, vcol, ocol, nloc, nt, rowbaseP;
  int qr = 0, qc = 0, rlo = 0, qpos = 0, lo = 0, rsq = 0, wsq = 0;
  float sink = 0.f;
  const float* cache = nullptr; int cH = 1, cHead = 0;
  if (MODE == 0 || MODE == 1) {
    const int b = item >> 3; head = (item >> 1) & 3; const int half = item & 1;
    rowbaseP = b * 256; qrow = rowbaseP + half * 128 + w * 32 + q; nloc = 4; nt = 4;
  } else {
    const int b = item >> 5; head = (item >> 3) & 3; const int sub = item & 7;
    rowbaseP = NCTX + b * 1024;
    if (MODE == 2) {
      qr = 2 * sub + (w >> 1); qc = (w & 1) * 32 + q; qrow = rowbaseP + qr * 64 + qc;
      rlo = clampi(2 * sub - 4, 0, 8); const int rhi = clampi(2 * sub - 3, 0, 8) + 7; nloc = rhi - rlo + 1; nt = nloc + 4;
      rsq = clampi(qr - 4, 0, 8); wsq = clampi(qc - 8, 0, 48);
      cache = p.in[I_CNAT] + (size_t)((b * 4 + l) * 2) * 256 * 256; cH = 4; cHead = head;
      for (int i = t; i < 465; i += 256) sBias[i] = p.in[I_RPB][(size_t)(l * 4 + head) * 465 + i];
    } else {
      qpos = sub * 128 + w * 32 + q; qrow = rowbaseP + qpos;
      lo = (sub - 1) * 128;
      nloc = 6; nt = nloc + 4;
      cache = p.in[I_CSWA] + (size_t)((b * 4 + l) * 2) * 256 * 128; cH = 2; cHead = head >> 1;
    }
  }
  if (MODE == 0 || MODE == 2) { qcol = C_NQ + head * 64; kcol = C_NK + head * 64; vcol = C_NV + head * 64; ocol = 256 + head * 64; }
  else { qcol = C_SQ + head * 64; kcol = C_SK + (head >> 1) * 64; vcol = C_SV + (head >> 1) * 64; ocol = 768 + head * 64; sink = p.in[I_SINK][l * 4 + head]; }

  bf16x8 bq[4];
#pragma unroll
  for (int s = 0; s < 4; ++s) bq[s] = *(const bf16x8*)(P + (size_t)qrow * DIN + qcol + 16 * s + 8 * hh);
  f32x16 oacc[2];
#pragma unroll
  for (int r = 0; r < 16; ++r) { oacc[0][r] = 0.f; oacc[1][r] = 0.f; }
  float m_run = -1e30f, l_run = 0.f;
  const int key = t >> 2, dq = t & 3;
  const int kswz = (key >> 1) & 7;
  float4 raw[8];
#define ATT_ISSUE(jj) do { const int j_ = (jj); \
    if (j_ < nloc) { \
      int krow_; \
      if (MODE == 0 || MODE == 1) krow_ = rowbaseP + j_ * 64 + key; \
      else if (MODE == 2) krow_ = rowbaseP + (rlo + j_) * 64 + key; \
      else krow_ = rowbaseP + clampi(lo + j_ * 64 + key, 0, 1023); \
      const bf16_t* kp_ = P + (size_t)krow_ * DIN + kcol + dq * 16; \
      const bf16_t* vp_ = P + (size_t)krow_ * DIN + vcol + dq * 16; \
      raw[0] = *(const float4*)kp_; raw[1] = *(const float4*)(kp_ + 8); raw[2] = *(const float4*)vp_; raw[3] = *(const float4*)(vp_ + 8); \
    } else { \
      const int ct_ = (j_ - nloc) * 64 + key; \
      const float* kp_ = cache + ((size_t)ct_ * cH + cHead) * 64 + dq * 16; \
      const float* vp_ = kp_ + (size_t)256 * cH * 64; \
      raw[0] = *(const float4*)kp_; raw[1] = *(const float4*)(kp_ + 4); raw[2] = *(const float4*)(kp_ + 8); raw[3] = *(const float4*)(kp_ + 12); \
      raw[4] = *(const float4*)vp_; raw[5] = *(const float4*)(vp_ + 4); raw[6] = *(const float4*)(vp_ + 8); raw[7] = *(const float4*)(vp_ + 12); \
    } } while (0)
  ATT_ISSUE(0);
  for (int j = 0; j < nt; ++j) {
    uint4 kr[2], vr[2];
    const bool isP = j < nloc;
    if (isP) {
      kr[0] = __builtin_bit_cast(uint4, raw[0]); kr[1] = __builtin_bit_cast(uint4, raw[1]);
      vr[0] = __builtin_bit_cast(uint4, raw[2]); vr[1] = __builtin_bit_cast(uint4, raw[3]);
    } else {
      kr[0].x = pk2(raw[0].x, raw[0].y); kr[0].y = pk2(raw[0].z, raw[0].w); kr[0].z = pk2(raw[1].x, raw[1].y); kr[0].w = pk2(raw[1].z, raw[1].w);
      kr[1].x = pk2(raw[2].x, raw[2].y); kr[1].y = pk2(raw[2].z, raw[2].w); kr[1].z = pk2(raw[3].x, raw[3].y); kr[1].w = pk2(raw[3].z, raw[3].w);
      vr[0].x = pk2(raw[4].x, raw[4].y); vr[0].y = pk2(raw[4].z, raw[4].w); vr[0].z = pk2(raw[5].x, raw[5].y); vr[0].w = pk2(raw[5].z, raw[5].w);
      vr[1].x = pk2(raw[6].x, raw[6].y); vr[1].y = pk2(raw[6].z, raw[6].w); vr[1].z = pk2(raw[7].x, raw[7].y); vr[1].w = pk2(raw[7].z, raw[7].w);
    }
    if (j + 1 < nt) ATT_ISSUE(j + 1);
    __syncthreads();
    *(uint4*)(sK + key * 128 + (((dq * 2 + 0) ^ kswz) << 4)) = kr[0];
    *(uint4*)(sK + key * 128 + (((dq * 2 + 1) ^ kswz) << 4)) = kr[1];
    {
      bf16_t* vt = (bf16_t*)sV;
      const unsigned vv[8] = {vr[0].x, vr[0].y, vr[0].z, vr[0].w, vr[1].x, vr[1].y, vr[1].z, vr[1].w};
#pragma unroll
      for (int e = 0; e < 8; ++e) {
        vt[(dq * 16 + 2 * e) * 68 + key] = (bf16_t)(vv[e] & 0xffffu);
        vt[(dq * 16 + 2 * e + 1) * 68 + key] = (bf16_t)(vv[e] >> 16);
      }
    }
    __syncthreads();
    f32x16 sacc[2];
#pragma unroll
    for (int r = 0; r < 16; ++r) { sacc[0][r] = 0.f; sacc[1][r] = 0.f; }
    const int qswz = (q >> 1) & 7;
#pragma unroll
    for (int s = 0; s < 4; ++s) {
      const int co = (((s * 2 + hh) ^ qswz) << 4);
      const bf16x8 a0 = *(const bf16x8*)(sK + q * 128 + co);
      const bf16x8 a1 = *(const bf16x8*)(sK + (32 + q) * 128 + co);
      sacc[0] = MFMA32(a0, bq[s], sacc[0]);
      sacc[1] = MFMA32(a1, bq[s], sacc[1]);
    }
    float mx = -1e30f;
#pragma unroll
    for (int sub = 0; sub < 2; ++sub)
#pragma unroll
      for (int r = 0; r < 16; ++r) {
        const int kidx = sub * 32 + (r & 3) + 8 * (r >> 2) + 4 * hh;
        float v = sacc[sub][r] * 0.125f;
        bool ok = true;
        if (MODE == 2 && isP) {
          const int kr_ = rlo + j, kc_ = kidx;
          ok = (kr_ >= rsq) && (kr_ < rsq + 8) && (kc_ >= wsq) && (kc_ < wsq + 16);
          const int bi = ok ? ((kr_ - qr + 7) * 31 + (kc_ - qc + 15)) : 0;
          v += sBias[bi];
        }
        if (MODE == 3 && isP) {
          const int kpos = lo + j * 64 + kidx, dlt = kpos - qpos;
          ok = (dlt <= 128) && (dlt >= -128) && (kpos >= 0) && (kpos < 1024);
        }
        v = ok ? v : -1e30f;
        sacc[sub][r] = v;
        mx = fmaxf(mx, v);
      }
    mx = fmaxf(mx, __shfl_xor(mx, 32));
    const float m_new = fmaxf(m_run, mx);
    const float alpha = __expf(m_run - m_new);
    float rsum = 0.f;
#pragma unroll
    for (int sub = 0; sub < 2; ++sub)
#pragma unroll
      for (int r = 0; r < 16; ++r) {
        const float v = sacc[sub][r];
        const float pv = (v > -1e29f) ? __expf(v - m_new) : 0.f;
        sacc[sub][r] = pv; rsum += pv;
      }
    rsum += __shfl_xor(rsum, 32);
    l_run = l_run * alpha + rsum; m_run = m_new;
#pragma unroll
    for (int r = 0; r < 16; ++r) { oacc[0][r] *= alpha; oacc[1][r] *= alpha; }
#pragma unroll
    for (int k4 = 0; k4 < 4; ++k4) {
      const int sub = k4 >> 1, s2 = k4 & 1;
      uint4 pbu;
      pbu.x = pk2(sacc[sub][8 * s2 + 0], sacc[sub][8 * s2 + 1]); pbu.y = pk2(sacc[sub][8 * s2 + 2], sacc[sub][8 * s2 + 3]);
      pbu.z = pk2(sacc[sub][8 * s2 + 4], sacc[sub][8 * s2 + 5]); pbu.w = pk2(sacc[sub][8 * s2 + 6], sacc[sub][8 * s2 + 7]);
      const bf16x8 pb = __builtin_bit_cast(bf16x8, pbu);
#pragma unroll
      for (int dt = 0; dt < 2; ++dt) {
        const char* vp = sV + (dt * 32 + q) * 136 + (16 * k4 + 4 * hh) * 2;
        const uint2 lo8 = *(const uint2*)vp, hi8 = *(const uint2*)(vp + 16);
        uint4 avu; avu.x = lo8.x; avu.y = lo8.y; avu.z = hi8.x; avu.w = hi8.y;
        oacc[dt] = MFMA32(__builtin_bit_cast(bf16x8, avu), pb, oacc[dt]);
      }
    }
  }
#undef ATT_ISSUE
  float scale;
  if (MODE == 1 || MODE == 3) {
    const float m_f = fmaxf(m_run, sink);
    const float e = __expf(m_run - m_f);
    scale = e / (l_run * e + __expf(sink - m_f));
  } else scale = 1.0f / l_run;
#pragma unroll
  for (int dt = 0; dt < 2; ++dt)
#pragma unroll
    for (int g4 = 0; g4 < 4; ++g4) {
      const int d = dt * 32 + 8 * g4 + 4 * hh;
      uint2 o; o.x = pk2(oacc[dt][4 * g4] * scale, oacc[dt][4 * g4 + 1] * scale); o.y = pk2(oacc[dt][4 * g4 + 2] * scale, oacc[dt][4 * g4 + 3] * scale);
      *(uint2*)(Y + (size_t)qrow * D + ocol + d) = o;
    }
  __syncthreads();
}

DEV void post_item(const Params& p, int l, int tile, char* lds) {
  const int t = tid(), r0 = tile * TOKT, c = t;
  bf16_t* sA = (bf16_t*)lds;
  float* sgo = (float*)(lds + 32 * 136 * 2);
  const bf16_t* P = (const bf16_t*)(p.ws + OFF_P);
  bf16_t* Y = (bf16_t*)(p.ws + OFF_YMIX);
  const float* Y0 = (const float*)(p.ws + OFF_YDIR); const float* Y1 = Y0 + ARRF;
  const float* H0 = (const float*)(p.ws + OFF_HDIR); const float* H1 = H0 + ARRF;
  const bf16_t* BON = (const bf16_t*)(p.ws + OFF_BONUS);
  __syncthreads();
#pragma unroll
  for (int i = 0; i < TOKT / 2; ++i) {
    const int e = t + 256 * i, tk = e >> 7, j = e & 127;
    sA[tk * 136 + j] = f2bf(sigmoidf_(bf2f(P[(size_t)(r0 + tk) * DIN + C_GH + j])));
  }
  __syncthreads();
  {
    const int lane = t & 63, w = t >> 6, q = lane & 31, hh = lane >> 5;
    bf16x8 af[8];
#pragma unroll
    for (int s = 0; s < 8; ++s) af[s] = *(const bf16x8*)(sA + q * 136 + 16 * s + 8 * hh);
    const bf16_t* GT = (const bf16_t*)(p.ws + OFF_G2T) + (size_t)l * 256 * 128;
#pragma unroll
    for (int nt = 0; nt < 2; ++nt) {
      const int n = w * 64 + nt * 32 + q;
      f32x16 acc;
#pragma unroll
      for (int r = 0; r < 16; ++r) acc[r] = 0.f;
#pragma unroll
      for (int s = 0; s < 8; ++s) acc = MFMA32(af[s], *(const bf16x8*)(GT + (size_t)n * 128 + 16 * s + 8 * hh), acc);
#pragma unroll
      for (int r = 0; r < 8; ++r) sgo[((r & 3) + 8 * (r >> 2) + 4 * hh) * 256 + n] = acc[r];
      if (hh == 0) {
#pragma unroll
        for (int r = 8; r < 12; ++r) sgo[((r & 3) + 16) * 256 + n] = acc[r];
      }
    }
  }
  __syncthreads();
  const float lnw = p.in[I_LNW][l * 256 + c], lnb = p.in[I_LNB][l * 256 + c], hgn = p.in[I_HGN][l * 256 + c];
  for (int tb = 0; tb < TOKT; tb += 5) {
    float y[5], o[5], bn[5], gv[5], hg[5];
#pragma unroll
    for (int u = 0; u < 5; ++u) {
      const int row = r0 + tb + u;
      const size_t idx = (size_t)row * 256 + c;
      y[u] = Y0[idx] + Y1[idx]; o[u] = H0[idx] + H1[idx]; bn[u] = bf2f(BON[idx]);
      gv[u] = sgo[(tb + u) * 256 + c]; hg[u] = bf2f(P[(size_t)row * DIN + C_HG + c]);
    }
#pragma unroll
    for (int u = 0; u < 5; ++u) {
      const int row = r0 + tb + u;
      const float mu = wave_sum(y[u]) * (1.0f / 64.0f);
      const float dy = y[u] - mu;
      const float var = wave_sum(dy * dy) * (1.0f / 64.0f);
      const float yn = dy * __builtin_amdgcn_rsqf(var + 64e-5f) * lnw + lnb + bn[u];
      Y[(size_t)row * D + c] = f2bf(yn * gv[u]);
      const float ms = wave_sum(o[u] * o[u]) * (1.0f / 64.0f);
      Y[(size_t)row * D + 512 + c] = f2bf(o[u] * __builtin_amdgcn_rsqf(ms + 1e-6f) * hgn * sigmoidf_(hg[u]));
    }
  }
  __syncthreads();
}

constexpr int OFF_CTR_WORD = 3600;
DEV void mixer_phase(const Params& p, int l, char* lds0, volatile LAS unsigned* st, bool rerun) {
  const int hf = half_id(); char* lds = lds0 + hf * 65536;
  const int npairs = (256 + 512 + 512) / 2;
  unsigned* ctr = (unsigned*)(p.ws + OFF_BAR) + OFF_CTR_WORD + 64 * l + (rerun ? 32 : 0);
  bool first = true;
  for (;;) {
    int pair;
    if (first) { pair = (int)blockIdx.x; first = false; }
    else {
      if (threadIdx.x == 0) st[4] = gridDim.x + __hip_atomic_fetch_add(ctr, 1u, __ATOMIC_RELAXED, __HIP_MEMORY_SCOPE_AGENT);
      __syncthreads();
      pair = (int)st[4];
      __syncthreads();
    }
    if (pair >= npairs) break;
    const int it = pair * 2 + hf;
    const bool is_scan = it < 640;
    if (rerun && PROBE_SUB == 1 && !is_scan) continue;
    if (rerun && PROBE_SUB == 2 && is_scan) continue;
    if (rerun && PROBE_SUB == 3 && !(it < 128)) continue;
    if (rerun && PROBE_SUB == 4 && !(it >= 128 && it < 640)) continue;
    if (it < 128) {
      const int idx = it >> 1; const int seq = 32 + (idx >> 5), rem = idx & 31;
      if ((it & 1) == 0) rwkv_scan16(p, l, seq, rem >> 3, (rem >> 2) & 1, rem & 3, lds);
      else hgrn_scan16(p, l, seq, rem >> 3, (rem >> 2) & 1, rem & 3, lds);
    } else if (it < 640) {
      const int idx = (it - 128) & 255; const int seq = idx >> 3, rem = idx & 7;
      if (it < 384) rwkv_scan<2>(p, l, seq, rem >> 1, rem & 1, 0, lds);
      else hgrn_scan<2>(p, l, seq, rem >> 1, rem & 1, 0, lds);
    } else if (it < 704) attn_item<3>(p, l, it - 640, lds);
    else if (it < 768) attn_item<2>(p, l, it - 704, lds);
    else if (it < 1024) attn_item<0>(p, l, it - 768, lds);
    else attn_item<1>(p, l, it - 1024, lds);
  }
}

DEV void run_phase(const Params& p, int ph, char* lds, bool rerun, volatile LAS unsigned* st) {
  if (ph == 0) { phase0(p, lds); return; }
  if (ph == 1) { row_phase(p, 0, 0); return; }
  const int l = (ph - 2) / 9, s = (ph - 2) % 9;
  const bf16_t* H = (const bf16_t*)(p.ws + OFF_H);
  const int hf = half_id(); char* ldsh = lds + hf * 65536;
  switch (s) {
    case 0: gemm_run<0>(p, l, H, (const bf16_t*)(p.ws + OFF_WIN) + (size_t)l * DINP * D, D, DINP, lds); break;
    case 1:
      for (int it = blockIdx.x * 2 + hf; it < 512 + 32; it += gridDim.x * 2) { if (it < 512) prep_item(p, l, it, ldsh); else if (!rerun) rope_item(p, it - 512); }
      break;
    case 2: mixer_phase(p, l, lds, st, rerun); break;
    case 3: for (int it = blockIdx.x * 2 + hf; it < 512; it += gridDim.x * 2) post_item(p, l, it, ldsh); break;
    case 4: gemm_run<1>(p, l, (const bf16_t*)(p.ws + OFF_YMIX), (const bf16_t*)(p.ws + OFF_WOUT) + (size_t)l * D * D, D, D, lds); break;
    case 5: row_phase(p, 1, l); break;
    case 6: gemm_run<2>(p, l, H, (const bf16_t*)(p.ws + OFF_W1) + (size_t)l * FF * D, D, FF, lds); break;
    case 7: gemm_run<1>(p, l, (const bf16_t*)(p.ws + OFF_HID), (const bf16_t*)(p.ws + OFF_W2) + (size_t)l * D * FF, FF, D, lds); break;
    case 8: row_phase(p, 2, l); break;
  }
}

#define XB_TMO      128
#define XB_XCNT(j)  (256  + 64 * (j))
#define XB_XSUB(j)  (1280 + 64 * (j))
#define XB_XGEN(j)  (2304 + 64 * (j))
#define XB_TOP      3328
#define XB_TOPGEN   3392
#define XCD_BAR_WORDS 3456
#define XB_SPIN_CAP (1u << 18)
DEV unsigned xb_ld(unsigned* p) { return __hip_atomic_load(p, __ATOMIC_RELAXED, __HIP_MEMORY_SCOPE_AGENT); }
DEV unsigned xb_add(unsigned* p, unsigned v) { return __hip_atomic_fetch_add(p, v, __ATOMIC_RELAXED, __HIP_MEMORY_SCOPE_AGENT); }
DEV unsigned xb_xcc_id() { return (unsigned)__builtin_amdgcn_s_getreg((3 << 11) | 20) & 0xFu; }
#define XB_SPIN(cond, bar) do { unsigned _sp = 0; while (cond) { __builtin_amdgcn_s_sleep(1); \
    if ((++_sp & 255u) == 0u) { if (xb_ld(&(bar)[XB_TMO])) break; if (_sp > XB_SPIN_CAP) { atomicAdd(&(bar)[XB_TMO], 1u); break; } } } } while (0)
struct XcdBarrier { unsigned* bar; unsigned x; volatile LAS unsigned* st; };
DEV XcdBarrier xcd_barrier_post(unsigned* bar, volatile LAS unsigned* st) {
  XcdBarrier b; b.bar = bar; b.x = xb_xcc_id(); b.st = st;
  if (threadIdx.x == 0) (void)xb_add(&bar[XB_XCNT(b.x)], 1u);
  return b;
}
DEV void xcd_barrier_complete(unsigned* bar, unsigned x, unsigned& nloc, unsigned& nx) {
  const unsigned G = gridDim.x * gridDim.y * gridDim.z;
  unsigned sum, cnt, mine, sp = 0u;
  for (;;) {
    sum = 0u; cnt = 0u; mine = 0u;
#pragma unroll
    for (unsigned j = 0; j < 16; ++j) { const unsigned c = xb_ld(&bar[XB_XCNT(j)]); sum += c; cnt += (c > 0u) ? 1u : 0u; mine = (j == x) ? c : mine; }
    if (sum == G) break;
    __builtin_amdgcn_s_sleep(1);
    if ((++sp & 255u) == 0u) { if (xb_ld(&bar[XB_TMO])) break; if (sp > XB_SPIN_CAP) { atomicAdd(&bar[XB_TMO], 1u); break; } }
  }
  nloc = mine > 0u ? mine : 1u; nx = cnt > 0u ? cnt : 1u;
}
DEV void xcd_barrier(const XcdBarrier& b) {
  asm volatile("s_waitcnt vmcnt(0)" ::: "memory");
  __syncthreads();
  if (threadIdx.x == 0) {
    unsigned* bar = b.bar;
    { size_t zb_; asm volatile("s_mov_b64 %0, 0" : "=s"(zb_)); bar += zb_; }
    __builtin_amdgcn_s_waitcnt(0);
    unsigned nloc = b.st[0], nx = b.st[1];
    if (nloc == 0u) { xcd_barrier_complete(bar, b.x, nloc, nx); b.st[0] = nloc; b.st[1] = nx; }
    const unsigned old = xb_add(&bar[XB_XSUB(b.x)], 1u);
    const unsigned gen = old / nloc;
    if (old + 1u == (gen + 1u) * nloc) {
      __builtin_amdgcn_fence(__ATOMIC_RELEASE, "agent");
      asm volatile("s_waitcnt vmcnt(0)" ::: "memory");
      const unsigned og = xb_add(&bar[XB_TOP], 1u);
      const unsigned tg = og / nx;
      if (og + 1u == (tg + 1u) * nx) xb_add(&bar[XB_TOPGEN], 1u);
      else XB_SPIN(xb_ld(&bar[XB_TOPGEN]) == tg, bar);
      __builtin_amdgcn_fence(__ATOMIC_ACQUIRE, "agent");
      xb_add(&bar[XB_XGEN(b.x)], 1u);
      asm volatile("s_waitcnt vmcnt(0)" ::: "memory");
    } else {
      XB_SPIN(xb_ld(&bar[XB_XGEN(b.x)]) == gen, bar);
      __builtin_amdgcn_fence(__ATOMIC_ACQUIRE, "agent");
      asm volatile("s_waitcnt vmcnt(0)" ::: "memory");
    }
  }
  __syncthreads();
}

DEV int phase_kind(int ph) {
  if (ph == 0) return 0;
  if (ph == 1) return 1;
  const int s = (ph - 2) % 9;
  return s == 0 ? 2 : s == 1 ? 3 : s == 2 ? 4 : s == 3 ? 5 : s == 4 ? 6 : s == 5 ? 1 : s == 6 ? 7 : s == 7 ? 8 : 1;
}

constexpr int LDS_BYTES = 131072 + 64;

__global__ void __launch_bounds__(512, 2) mega(Params p, int ph_lo, int ph_hi) {
  extern __shared__ __attribute__((aligned(16))) unsigned char smem[];
  char* lds = (char*)smem;
  volatile LAS unsigned* st = (volatile LAS unsigned*)((LAS unsigned char*)smem + 131072);
  if (threadIdx.x == 0) { st[0] = 0u; st[1] = 0u; }
  __syncthreads();
  XcdBarrier xb = xcd_barrier_post((unsigned*)(p.ws + OFF_BAR), st);
  if (ph_hi < 0) cg::this_grid().sync();
  char* const ws0 = p.ws; float* const out0 = p.out;
  for (int ph = ph_lo; ph < ph_hi; ++ph) {
    { size_t z0_; asm volatile("s_mov_b64 %0, 0" : "=s"(z0_)); p.ws = ws0 + z0_; p.out = out0 + z0_; }
    run_phase(p, ph, lds, false, st);
    if (PROBE_KIND >= 0 && (PROBE_KIND == 9 || phase_kind(ph) == PROBE_KIND)) {
      xcd_barrier(xb);
      if (PROBE_KIND != 9) run_phase(p, ph, lds, true, st);
    }
    if (ph + 1 < ph_hi) xcd_barrier(xb);
  }
}

extern "C" void kernel_launch(void* const* d_in, const int* in_sizes, int n_in, void* d_out, int out_size, void* d_ws, size_t ws_size,
                              hipStream_t stream) {
  static int grid_blocks = 0;
  if (!grid_blocks) {
    int dev = 0, cus = 0, per_cu = 0;
    (void)hipGetDevice(&dev);
    (void)hipDeviceGetAttribute(&cus, hipDeviceAttributeMultiprocessorCount, dev);
    if (hipFuncSetAttribute((const void*)mega, hipFuncAttributeMaxDynamicSharedMemorySize, LDS_BYTES) != hipSuccess) fprintf(stderr, "hipFuncSetAttribute failed\n");
    (void)hipOccupancyMaxActiveBlocksPerMultiprocessor(&per_cu, mega, 512, LDS_BYTES);
    if (per_cu < 1) fprintf(stderr, "occupancy query reports %d blocks per CU\n", per_cu);
    (void)hipGetLastError();
    grid_blocks = cus;
  }
  if (ws_size < WS_TOTAL) { fprintf(stderr, "workspace too small: %zu < %zu\n", ws_size, (size_t)WS_TOTAL); return; }
  Params p{};
  for (int i = 0; i < 31; ++i) p.in[i] = (const float*)d_in[i];
  p.out = (float*)d_out;
  p.ws = (char*)d_ws;
  (void)hipMemsetAsync((char*)d_ws + OFF_BAR, 0, 16384, stream);
  int lo = 0, hi = NPH;
  void* args[] = {&p, &lo, &hi};
  hipError_t e = hipLaunchCooperativeKernel((void*)mega, dim3(grid_blocks), dim3(512), args, LDS_BYTES, stream);
  if (e != hipSuccess) fprintf(stderr, "cooperative launch failed: %s (grid %d)\n", hipGetErrorString(e), grid_blocks);
}
```

```cpp
#include <hip/hip_runtime.h>
#include <hip/hip_cooperative_groups.h>
#include <cstdio>
#include <cstdint>
namespace cg = cooperative_groups;

#ifndef ONE_LAUNCH
#define ONE_LAUNCH 1
#endif
#define PROBE_KIND -1
#define PROBE_SUB 0

#define DEV __device__ __forceinline__
#define LAS __attribute__((address_space(3)))
typedef unsigned short bf16_t;
typedef short bf16x8 __attribute__((ext_vector_type(8)));
typedef float f32x16 __attribute__((ext_vector_type(16)));
typedef __bf16 bf2_t __attribute__((ext_vector_type(2)));
typedef float f2_t __attribute__((ext_vector_type(2)));

constexpr int D = 1024, DIN = 3712, FF = 4096, NCTX = 8192, MT = 10240;
constexpr int NPH = 38;
constexpr int DINP = 3840;
constexpr int C_R = 0, C_K = 256, C_V = 512, C_GH = 768, C_WHF = 896, C_WHB = 1024;
constexpr int C_NQ = 1152, C_NK = 1408, C_NV = 1664;
constexpr int C_HQ = 1920, C_HI = 2176, C_HG = 2432, C_HFF = 2688, C_HFB = 2944;
constexpr int C_SQ = 3200, C_SK = 3456, C_SV = 3584;
constexpr size_t O_NAT = 10485760, O_SWA = 27262976, O_RW = 35651584, O_HG = 39845888;
constexpr size_t ARRF = (size_t)MT * 256;
constexpr size_t ARR = ARRF * 4;
constexpr size_t OFF_WIN = 0;
constexpr size_t OFF_WOUT = OFF_WIN + (size_t)4 * DINP * D * 2;
constexpr size_t OFF_W1 = OFF_WOUT + (size_t)4 * D * D * 2;
constexpr size_t OFF_W2 = OFF_W1 + (size_t)4 * FF * D * 2;
constexpr size_t OFF_MOD = OFF_W2 + (size_t)4 * FF * D * 2;
constexpr size_t OFF_HGLB = OFF_MOD + (size_t)4 * 3 * 6144 * 4;
constexpr size_t OFF_P = OFF_HGLB + 8192;
constexpr size_t OFF_R1 = OFF_P + (size_t)MT * DIN * 2;
constexpr size_t OFF_H = OFF_R1;
constexpr size_t OFF_HID = OFF_H + (size_t)MT * D * 2;
constexpr size_t OFF_U = OFF_HID + (size_t)MT * FF * 2;
constexpr size_t OFF_PREP = OFF_R1;
constexpr size_t OFF_YDIR = OFF_PREP + 12 * ARR;
constexpr size_t OFF_BONUS = OFF_R1 + 14 * ARR;
constexpr size_t OFF_HDIR = OFF_BONUS + ARR / 2;
constexpr size_t OFF_YMIX = OFF_HDIR + 2 * ARR;
constexpr size_t OFF_X16 = OFF_YMIX + (size_t)MT * D * 2;
constexpr size_t OFF_BAR = OFF_X16 + (size_t)MT * D * 2;
constexpr size_t OFF_W2T = OFF_BAR + 16384;
constexpr size_t OFF_A2T = OFF_W2T + (size_t)4 * 2 * 256 * 64 * 2;
constexpr size_t OFF_G2T = OFF_A2T + (size_t)4 * 2 * 256 * 64 * 2;
constexpr size_t WS_TOTAL = OFF_G2T + (size_t)4 * 256 * 128 * 2;
static_assert(OFF_U + (size_t)MT * D * 4 == OFF_BONUS, "R1 layout");

struct Params {
  const float* in[31];
  float* out;
  char* ws;
};
enum { I_XP = 0, I_XS, I_CNAT, I_CSWA, I_SRW, I_SHG, I_C, I_CCTX, I_NORMG, I_MODW, I_MODB, I_WIN, I_WOUT, I_MURKV, I_MULORA,
       I_W0, I_W2, I_A0, I_A2, I_G2, I_KK, I_KA, I_RK, I_LNW, I_LNB, I_RPB, I_HGLB, I_HGN, I_SINK, I_FW1, I_FW2 };


DEV float bf2f(bf16_t h) { return __uint_as_float(((unsigned)h) << 16); }
DEV unsigned pk2(float a, float b) { f2_t v = {a, b}; bf2_t r = __builtin_convertvector(v, bf2_t); return __builtin_bit_cast(unsigned, r); }
DEV bf16_t f2bf(float f) { return (bf16_t)(pk2(f, f) & 0xffffu); }
DEV float4 bf4(uint2 u) { return make_float4(__uint_as_float(u.x << 16), __uint_as_float(u.x & 0xffff0000u), __uint_as_float(u.y << 16), __uint_as_float(u.y & 0xffff0000u)); }
DEV float bflo(unsigned u) { return __uint_as_float(u << 16); }
DEV float bfhi(unsigned u) { return __uint_as_float(u & 0xffff0000u); }
DEV float rcpf_(float x) { return __builtin_amdgcn_rcpf(x); }
DEV float sigmoidf_(float x) { return rcpf_(1.0f + __expf(-x)); }
DEV float tanhf_(float x) { return 1.0f - 2.0f * rcpf_(1.0f + __expf(2.0f * x)); }
template <int CTRL> DEV float dppf(float x) { return __int_as_float(__builtin_amdgcn_update_dpp(0, __float_as_int(x), CTRL, 0xF, 0xF, false)); }
DEV float row16_sum(float x) { x += dppf<0xB1>(x); x += dppf<0x4E>(x); x += dppf<0x141>(x); x += dppf<0x140>(x); return x; }
DEV float wave_sum(float x) { x = row16_sum(x); x += __shfl_xor(x, 16); x += __shfl_xor(x, 32); return x; }
DEV int clampi(int v, int lo, int hi) { return v < lo ? lo : (v > hi ? hi : v); }
#define MFMA32(a, b, c) __builtin_amdgcn_mfma_f32_32x32x16_bf16((a), (b), (c), 0, 0, 0)

DEV int tid() { int z; asm volatile("v_mov_b32 %0, 0" : "=v"(z)); return (int)(threadIdx.x & 255u) + z; }
DEV int half_id() { return __builtin_amdgcn_readfirstlane((int)(threadIdx.x >> 8)); }
DEV void transpose_item(const float* W, bf16_t* WT, int K, int N, int kt, int nt, char* lds) {
  bf16_t* s = (bf16_t*)lds;
  const int t = tid();
#pragma unroll
  for (int i = 0; i < 4; ++i) {
    const int k = (t >> 4) + 16 * i, n4 = (t & 15) * 4;
    const float4 v = *(const float4*)(W + (size_t)(kt * 64 + k) * N + nt * 64 + n4);
    s[(n4 + 0) * 72 + k] = f2bf(v.x); s[(n4 + 1) * 72 + k] = f2bf(v.y);
    s[(n4 + 2) * 72 + k] = f2bf(v.z); s[(n4 + 3) * 72 + k] = f2bf(v.w);
  }
  __syncthreads();
#pragma unroll
  for (int i = 0; i < 2; ++i) {
    const int n = (t >> 3) + 32 * i, kc = t & 7;
    const uint4 v = *(const uint4*)(s + n * 72 + kc * 8);
    *(uint4*)(WT + (size_t)(nt * 64 + n) * K + kt * 64 + kc * 8) = v;
  }
  __syncthreads();
}

DEV void mod_item(const Params& p, int l, int jb, char* lds) {
  float* sc = (float*)lds;
  float* red = (float*)(lds + 12288);
  const int t = tid();
  for (int i = t; i < 3072; i += 256) {
    const int c = i >> 10, k = i & 1023;
    const float x = (c == 0) ? p.in[I_CCTX][k] : p.in[I_C][(c - 1) * 1024 + k];
    sc[i] = x * rcpf_(1.0f + __expf(-x));
  }
  __syncthreads();
  const int c4 = t & 15, ks = t >> 4;
  const float* wp = p.in[I_MODW] + ((size_t)l * 1024 + ks * 64) * 6144 + jb * 64 + c4 * 4;
  float a00 = 0, a01 = 0, a02 = 0, a03 = 0, a10 = 0, a11 = 0, a12 = 0, a13 = 0, a20 = 0, a21 = 0, a22 = 0, a23 = 0;
#pragma unroll 16
  for (int ii = 0; ii < 64; ++ii) {
    const float4 w = *(const float4*)(wp + (size_t)ii * 6144);
    const int k = ks * 64 + ii;
    const float s0 = sc[k], s1 = sc[1024 + k], s2 = sc[2048 + k];
    a00 += s0 * w.x; a01 += s0 * w.y; a02 += s0 * w.z; a03 += s0 * w.w;
    a10 += s1 * w.x; a11 += s1 * w.y; a12 += s1 * w.z; a13 += s1 * w.w;
    a20 += s2 * w.x; a21 += s2 * w.y; a22 += s2 * w.z; a23 += s2 * w.w;
  }
  float* r0 = red + (ks * 3 + 0) * 64 + c4 * 4; r0[0] = a00; r0[1] = a01; r0[2] = a02; r0[3] = a03;
  float* r1 = red + (ks * 3 + 1) * 64 + c4 * 4; r1[0] = a10; r1[1] = a11; r1[2] = a12; r1[3] = a13;
  float* r2 = red + (ks * 3 + 2) * 64 + c4 * 4; r2[0] = a20; r2[1] = a21; r2[2] = a22; r2[3] = a23;
  __syncthreads();
  if (t < 192) {
    const int c = t >> 6, col = t & 63;
    float v = p.in[I_MODB][l * 6144 + jb * 64 + col];
#pragma unroll
    for (int k2 = 0; k2 < 16; ++k2) v += red[(k2 * 3 + c) * 64 + col];
    ((float*)(p.ws + OFF_MOD))[(size_t)(l * 3 + c) * 6144 + jb * 64 + col] = v;
  }
  __syncthreads();
}

DEV void hglb_item(const Params& p) {
  const int c = tid();
  float* HGLB = (float*)(p.ws + OFF_HGLB);
  for (int dir = 0; dir < 2; ++dir) {
    float x[4], mx = -1e30f;
    for (int l = 0; l < 4; ++l) { x[l] = p.in[I_HGLB][(dir * 4 + l) * 256 + c]; mx = fmaxf(mx, x[l]); }
    float s = 0;
    for (int l = 0; l < 4; ++l) { x[l] = __expf(x[l] - mx); s += x[l]; }
    float cum = 0; const float s0 = x[0] / s;
    for (int l = 0; l < 4; ++l) { cum += x[l] / s; HGLB[(l * 2 + dir) * 256 + c] = cum - s0; }
  }
}

constexpr int NT_LAYER = 928 + 256 + 1024 + 1024;
struct TileDesc { const float* W; bf16_t* WT; int K, N, kt, nt; };
DEV TileDesc layer_tile_desc(const Params& p, int l, int j) {
  TileDesc d;
  if (j < 928) { d.W = p.in[I_WIN] + (size_t)l * D * DIN; d.WT = (bf16_t*)(p.ws + OFF_WIN) + (size_t)l * DINP * D; d.K = D; d.N = DIN; d.kt = j / 58; d.nt = j % 58; return d; }
  j -= 928;
  if (j < 256) { d.W = p.in[I_WOUT] + (size_t)l * D * D; d.WT = (bf16_t*)(p.ws + OFF_WOUT) + (size_t)l * D * D; d.K = D; d.N = D; d.kt = j / 16; d.nt = j % 16; return d; }
  j -= 256;
  if (j < 1024) { d.W = p.in[I_FW1] + (size_t)l * D * FF; d.WT = (bf16_t*)(p.ws + OFF_W1) + (size_t)l * FF * D; d.K = D; d.N = FF; d.kt = j / 64; d.nt = j % 64; return d; }
  j -= 1024;
  d.W = p.in[I_FW2] + (size_t)l * FF * D; d.WT = (bf16_t*)(p.ws + OFF_W2) + (size_t)l * D * FF; d.K = FF; d.N = D; d.kt = j / 16; d.nt = j % 16; return d;
}
DEV void tile_load(const TileDesc& d, float4 (&v)[4]) {
  const int t = tid();
#pragma unroll
  for (int i = 0; i < 4; ++i) v[i] = *(const float4*)(d.W + (size_t)(d.kt * 64 + (t >> 4) + 16 * i) * d.N + d.nt * 64 + (t & 15) * 4);
}
DEV void tile_store(const TileDesc& d, const float4 (&v)[4], char* lds) {
  bf16_t* s = (bf16_t*)lds;
  const int t = tid();
#pragma unroll
  for (int i = 0; i < 4; ++i) {
    const int k = (t >> 4) + 16 * i, n4 = (t & 15) * 4;
    s[(n4 + 0) * 72 + k] = f2bf(v[i].x); s[(n4 + 1) * 72 + k] = f2bf(v[i].y);
    s[(n4 + 2) * 72 + k] = f2bf(v[i].z); s[(n4 + 3) * 72 + k] = f2bf(v[i].w);
  }
  __syncthreads();
#pragma unroll
  for (int i = 0; i < 2; ++i) {
    const int n = (t >> 3) + 32 * i, kc = t & 7;
    const uint4 o = *(const uint4*)(s + n * 72 + kc * 8);
    *(uint4*)(d.WT + (size_t)(d.nt * 64 + n) * d.K + d.kt * 64 + kc * 8) = o;
  }
  __syncthreads();
}
DEV void layer_tiles(const Params& p, int l, int lo, int hi, int vb, int nvb, char* lds0) {
  const int hf = half_id(); char* lds = lds0 + hf * 65536;
  int it = lo + vb * 2 + hf;
  if (it >= hi) return;
  float4 vn[4];
  TileDesc dn = layer_tile_desc(p, l, it);
  tile_load(dn, vn);
  for (; it < hi; it += nvb * 2) {
    float4 vc[4] = {vn[0], vn[1], vn[2], vn[3]};
    const TileDesc dc = dn;
    if (it + nvb * 2 < hi) { dn = layer_tile_desc(p, l, it + nvb * 2); tile_load(dn, vn); }
    tile_store(dc, vc, lds);
  }
}

DEV void phase0(const Params& p, char* lds0) {
  const int hf = half_id(); char* lds = lds0 + hf * 65536;
  const int nitems = 386 + 4 + 20;
  for (int it = blockIdx.x * 2 + hf; it < nitems; it += gridDim.x * 2) {
    if (it < 384) { mod_item(p, it / 96, it % 96, lds); continue; }
    if (it == 384) { hglb_item(p); continue; }
    if (it == 385) continue;
    const int j = it - 386;
    if (j >= 4) {
      const int s = j - 4, n = tid();
      const float* src; bf16_t* dst; int KK;
      if (s < 8) { src = p.in[I_W2] + (size_t)s * 64 * 256; dst = (bf16_t*)(p.ws + OFF_W2T) + (size_t)s * 256 * 64; KK = 64; }
      else if (s < 16) { src = p.in[I_A2] + (size_t)(s - 8) * 64 * 256; dst = (bf16_t*)(p.ws + OFF_A2T) + (size_t)(s - 8) * 256 * 64; KK = 64; }
      else { src = p.in[I_G2] + (size_t)(s - 16) * 128 * 256; dst = (bf16_t*)(p.ws + OFF_G2T) + (size_t)(s - 16) * 256 * 128; KK = 128; }
      for (int k0 = 0; k0 < KK; k0 += 8) {
        float v[8];
#pragma unroll
        for (int e = 0; e < 8; ++e) v[e] = src[(size_t)(k0 + e) * 256 + n];
        uint4 o; o.x = pk2(v[0], v[1]); o.y = pk2(v[2], v[3]); o.z = pk2(v[4], v[5]); o.w = pk2(v[6], v[7]);
        *(uint4*)(dst + (size_t)n * KK + k0) = o;
      }
      continue;
    }
    {
      uint4* z = (uint4*)((bf16_t*)(p.ws + OFF_WIN) + ((size_t)j * DINP + DIN) * D);
      const int t = tid();
      for (int i = t; i < 128 * D * 2 / 16; i += 256) z[i] = make_uint4(0u, 0u, 0u, 0u);
    }
  }
  const int vb = ((int)blockIdx.x + (int)gridDim.x - 195 % (int)gridDim.x) % (int)gridDim.x;
  layer_tiles(p, 0, 0, NT_LAYER, vb, (int)gridDim.x, lds0);
  if ((int)gridDim.x <= 160) { for (int ll = 1; ll < 4; ++ll) layer_tiles(p, ll, 0, NT_LAYER, (int)blockIdx.x, (int)gridDim.x, lds0); }
}

constexpr int RPW = 5;
DEV void row_phase(const Params& p, int mode, int l) {
  const int lane = tid() & 63;
  const int nw = gridDim.x * 8;
  const float* MOD = (const float*)(p.ws + OFF_MOD);
  const float* NG = p.in[I_NORMG];
  const bf16_t* U = (const bf16_t*)(p.ws + OFF_U);
  bf16_t* H = (bf16_t*)(p.ws + OFF_H);
  bf16_t* X16 = (bf16_t*)(p.ws + OFF_X16);
  const bool has_next = !(mode == 2 && l == 3);
  const int ln = (mode == 0) ? 0 : (mode == 1 ? l : l + 1);
  const int gi = (mode == 1) ? 2 : 0, shi = (mode == 1) ? 3 : 0, sci = (mode == 1) ? 4 : 1;
  const float* ga = NG + (size_t)(l * 4 + (mode == 1 ? 1 : 3)) * 1024;
  const float* gb = NG + (size_t)((has_next ? ln : 0) * 4 + gi) * 1024;
  for (int rowa = blockIdx.x * 8 + half_id() * 4 + (tid() >> 6); rowa < MT; rowa += RPW * nw) {
    float4 x[RPW][4]; uint2 ub[RPW][4];
    int rows[RPW]; bool ok[RPW];
#pragma unroll
    for (int q = 0; q < RPW; ++q) {
      rows[q] = rowa + q * nw; ok[q] = rows[q] < MT;
      const int row = ok[q] ? rows[q] : rowa;
      if (mode == 0) {
        const float* src = row < NCTX ? p.in[I_XP] + (size_t)row * D : p.in[I_XS] + (size_t)(row - NCTX) * D;
#pragma unroll
        for (int i = 0; i < 4; ++i) x[q][i] = *(const float4*)(src + i * 256 + lane * 4);
      } else {
#pragma unroll
        for (int i = 0; i < 4; ++i) {
          const uint2 xb = *(const uint2*)(X16 + (size_t)row * D + i * 256 + lane * 4);
          x[q][i] = make_float4(bflo(xb.x), bfhi(xb.x), bflo(xb.y), bfhi(xb.y));
          ub[q][i] = *(const uint2*)(U + (size_t)row * D + i * 256 + lane * 4);
        }
      }
    }
#pragma unroll
    for (int q = 0; q < RPW; ++q) {
      const int row = ok[q] ? rows[q] : rowa;
      const int cond = row < NCTX ? 0 : 1 + ((row - NCTX) >> 10);
      if (mode != 0) {
        float4 u[4];
        float ss = 0;
#pragma unroll
        for (int i = 0; i < 4; ++i) {
          u[i] = make_float4(bflo(ub[q][i].x), bfhi(ub[q][i].x), bflo(ub[q][i].y), bfhi(ub[q][i].y));
          ss += u[i].x * u[i].x + u[i].y * u[i].y + u[i].z * u[i].z + u[i].w * u[i].w;
        }
        ss = wave_sum(ss);
        const float r = __builtin_amdgcn_rsqf(ss * (1.0f / 1024.0f) + 1e-6f);
        const float* gate = MOD + (size_t)(l * 3 + cond) * 6144 + (mode == 1 ? 2 : 5) * 1024;
#pragma unroll
        for (int i = 0; i < 4; ++i) {
          const float4 g4 = *(const float4*)(gate + i * 256 + lane * 4);
          const float4 a4 = *(const float4*)(ga + i * 256 + lane * 4);
          x[q][i].x += g4.x * (u[i].x * r * a4.x); x[q][i].y += g4.y * (u[i].y * r * a4.y);
          x[q][i].z += g4.z * (u[i].z * r * a4.z); x[q][i].w += g4.w * (u[i].w * r * a4.w);
        }
      }
      if (ok[q]) {
        if (has_next) {
#pragma unroll
          for (int i = 0; i < 4; ++i) { uint2 o; o.x = pk2(x[q][i].x, x[q][i].y); o.y = pk2(x[q][i].z, x[q][i].w); *(uint2*)(X16 + (size_t)row * D + i * 256 + lane * 4) = o; }
        } else {
#pragma unroll
          for (int i = 0; i < 4; ++i) *(float4*)(p.out + (size_t)row * D + i * 256 + lane * 4) = x[q][i];
        }
      }
      if (has_next) {
        float ss = 0;
#pragma unroll
        for (int i = 0; i < 4; ++i) ss += x[q][i].x * x[q][i].x + x[q][i].y * x[q][i].y + x[q][i].z * x[q][i].z + x[q][i].w * x[q][i].w;
        ss = wave_sum(ss);
        const float r2 = __builtin_amdgcn_rsqf(ss * (1.0f / 1024.0f) + 1e-6f);
        const float* sh = MOD + (size_t)(ln * 3 + cond) * 6144 + shi * 1024;
        const float* sc = MOD + (size_t)(ln * 3 + cond) * 6144 + sci * 1024;
        if (ok[q]) {
#pragma unroll
          for (int i = 0; i < 4; ++i) {
            const float4 g4 = *(const float4*)(gb + i * 256 + lane * 4);
            const float4 s4 = *(const float4*)(sc + i * 256 + lane * 4);
            const float4 h4 = *(const float4*)(sh + i * 256 + lane * 4);
            const float h0 = x[q][i].x * r2 * g4.x * (1.0f + s4.x) + h4.x;
            const float h1 = x[q][i].y * r2 * g4.y * (1.0f + s4.y) + h4.y;
            const float h2 = x[q][i].z * r2 * g4.z * (1.0f + s4.z) + h4.z;
            const float h3 = x[q][i].w * r2 * g4.w * (1.0f + s4.w) + h4.w;
            uint2 o; o.x = pk2(h0, h1); o.y = pk2(h2, h3);
            *(uint2*)(H + (size_t)row * D + i * 256 + lane * 4) = o;
          }
        }
      }
    }
  }
}

namespace pg8 {
#define PG8_LAS __attribute__((address_space(3)))
typedef unsigned short bf16_t;
typedef short bf16x8 __attribute__((ext_vector_type(8)));
typedef float f32x4 __attribute__((ext_vector_type(4)));
typedef unsigned u32x4 __attribute__((ext_vector_type(4)));
constexpr int BM = 256, BK = 64, HALF = 128, HTB = HALF * BK * 2  , STAGE_BYTES = 8 * HTB, NXCD = 8, WGM = 8;

__host__ __device__ __forceinline__ int lds_byte(int r, int c) { const int st = (r >> 4) * 2 + (c >> 5), rr = r & 15, cc = c & 31, ob = rr * 64 + cc * 2; return st * 1024 + (ob ^ (((ob >> 9) & 1) << 5)); }
__host__ __device__ __forceinline__ void stage_rc(int b, int& R, int& C) { const int st = b / 1024, sb = b % 1024, swz = sb ^ (((sb >> 9) & 1) << 5); R = (st >> 1) * 16 + swz / 64; C = (st & 1) * 32 + (swz % 64) / 2; }
__host__ __device__ __forceinline__ int perm32(int rho) { const int n = rho >> 4, i = rho & 15; return 8 * (i >> 2) + 4 * n + (i & 3); }

struct Unit { int pm, pn; };
struct Gemm { const bf16_t* A; const bf16_t* Bt; int M, N, K; };

struct StaticOrder {
    int nM, nN, nwg, G, c;
    __host__ __device__ void init(int M, int N, int G_, int c_) { nM = M / BM; nN = N / BM; nwg = nM * nN; G = G_; c = c_; }
    __host__ __device__ bool next(int i, Unit& u) const {
        const long L = (long)i * G + c; if (L >= nwg) return false;
        int wgid = (int)L; { const int q = nwg / NXCD, r = nwg % NXCD, xcd = wgid % NXCD, off = wgid / NXCD; wgid = (xcd < r ? xcd * (q + 1) : r * (q + 1) + (xcd - r) * q) + off; }
        const int nig = WGM * nN, gid = wgid / nig, fm = gid * WGM, gsz = (nM - fm) < WGM ? (nM - fm) : WGM;
        u.pm = fm + ((wgid % nig) % gsz); u.pn = (wgid % nig) / gsz; return true;
    }
    __device__ __forceinline__ void a_ready(const Unit&) const {}
    __device__ __forceinline__ void done(const Unit&) const {}
};

template <class Epi, class Sched, bool ALIGN_EPI = false, bool SP2 = false>
__device__ __forceinline__ void gemm_phase(PG8_LAS unsigned char* lds, const Gemm g, const Sched& S, const Epi& E) {
    int tid_z; asm volatile("v_mov_b32 %0, 0" : "=v"(tid_z)); const int tid = (int)threadIdx.x + tid_z, wid = __builtin_amdgcn_readfirstlane(tid >> 6), lane = tid & 63, wr = wid >> 2, wc = wid & 3, fr = lane & 15, fq = lane >> 4;
    const int K = g.K, nt = K / BK;
    unsigned voffA[2], voffB[2];
#pragma unroll
    for (int i = 0; i < 2; ++i) { int R, C; stage_rc(tid * 16 + i * 8192, R, C); const int Rb = Epi::PERM ? ((R & ~31) + perm32(R & 31)) : R;
        voffA[i] = (unsigned)(R * K + C) * 2u; voffB[i] = (unsigned)(Rb * K + C) * 2u; }
    const size_t kstep = (size_t)(BK * 2);
    const size_t hstep = (size_t)HALF * K * 2;
    const size_t tstep = 2 * hstep;
    const unsigned ldsw = (unsigned)wid * 1024u;
    const int aoff = lds_byte(wr * 64 + fr, fq * 8), boff = lds_byte(wc * 32 + fr, fq * 8);
#define PG8_SA(b, h) (((b) * 2 + (h)) * HTB)
#define PG8_SB(b, h) ((4 + (b) * 2 + (h)) * HTB)
#define PG8_STAGE(bufoff, gbase, voff) do { _Pragma("unroll") for (int _i = 0; _i < 2; ++_i) \
        __builtin_amdgcn_global_load_lds((const unsigned*)((const char*)(gbase) + (voff)[_i]), (PG8_LAS unsigned*)(lds + (bufoff) + ldsw + _i * 8192), 16, 0, 0); } while (0)
#define PG8_LDA(dst, b, h) do { _Pragma("unroll") for (int m = 0; m < 4; ++m) _Pragma("unroll") for (int k = 0; k < 2; ++k) dst[m][k] = *(const PG8_LAS bf16x8*)(lds + PG8_SA(b, h) + aoff + m * 2048 + k * 1024); } while (0)
#define PG8_LDB(dst, b, h) do { _Pragma("unroll") for (int n = 0; n < 2; ++n) _Pragma("unroll") for (int k = 0; k < 2; ++k) dst[n][k] = *(const PG8_LAS bf16x8*)(lds + PG8_SB(b, h) + boff + n * 2048 + k * 1024); } while (0)
#define PG8_MMA(ai, bj, At, Bt) do { __builtin_amdgcn_s_setprio(1); _Pragma("unroll") for (int m = 0; m < 4; ++m) _Pragma("unroll") for (int n = 0; n < 2; ++n) _Pragma("unroll") for (int k = 0; k < 2; ++k) \
        acc[ai][bj][m][n] = __builtin_amdgcn_mfma_f32_16x16x32_bf16(Bt[n][k], At[m][k], acc[ai][bj][m][n], 0, 0, 0); __builtin_amdgcn_s_setprio(0); } while (0)
#define PG8_WAIT_V(n) asm volatile("s_waitcnt vmcnt(" #n ")" ::: "memory")
#define PG8_WAIT_L(n) asm volatile("s_waitcnt lgkmcnt(" #n ")" ::: "memory")
#define PG8_BAR __builtin_amdgcn_s_barrier()
#define PG8_SCHED __builtin_amdgcn_sched_barrier(0)
    Unit cur, nxt; int ui = 0;
    if (!S.next(0, cur)) return;
    f32x4 acc[2][2][4][2];
#pragma unroll
    for (int a = 0; a < 2; ++a)
#pragma unroll
        for (int b = 0; b < 2; ++b)
#pragma unroll
            for (int m = 0; m < 4; ++m)
#pragma unroll
                for (int n = 0; n < 2; ++n) acc[a][b][m][n] = (f32x4){0.f, 0.f, 0.f, 0.f};
    bf16x8 At[4][2], B0[2][2], B1[2][2];
    const char* cA = (const char*)g.A + (size_t)cur.pm * tstep; const char* cB = (const char*)g.Bt + (size_t)cur.pn * tstep;
    S.a_ready(cur);
    if constexpr (SP2) {
        PG8_STAGE(PG8_SB(0, 0), cB, voffB); PG8_STAGE(PG8_SB(0, 1), cB + hstep, voffB); PG8_STAGE(PG8_SA(0, 0), cA, voffA); PG8_STAGE(PG8_SA(0, 1), cA + hstep, voffA);
        if (wr == 1) PG8_BAR;
        PG8_WAIT_V(2); PG8_BAR;
        PG8_STAGE(PG8_SB(1, 0), cB + kstep, voffB); PG8_STAGE(PG8_SA(1, 0), cA + kstep, voffA); PG8_STAGE(PG8_SB(1, 1), cB + hstep + kstep, voffB);
        PG8_WAIT_V(6); PG8_BAR;
    } else {
        PG8_STAGE(PG8_SB(0, 0), cB, voffB); PG8_STAGE(PG8_SA(0, 0), cA, voffA); PG8_STAGE(PG8_SB(0, 1), cB + hstep, voffB); PG8_STAGE(PG8_SA(0, 1), cA + hstep, voffA);
        if (wr == 1) PG8_BAR;
        PG8_WAIT_V(4); PG8_BAR;
        PG8_STAGE(PG8_SB(1, 0), cB + kstep, voffB); PG8_STAGE(PG8_SA(1, 0), cA + kstep, voffA); PG8_STAGE(PG8_SB(1, 1), cB + hstep + kstep, voffB);
        PG8_WAIT_V(6); PG8_BAR;
    }
    for (;;) {
        const bool has_next = S.next(ui + 1, nxt);
        const char* nA = has_next ? (const char*)g.A + (size_t)nxt.pm * tstep : cA; const char* nB = has_next ? (const char*)g.Bt + (size_t)nxt.pn * tstep : cB;
        for (int t = 0; t < nt; t += 2) {
            const bool last = (t == nt - 2);
            const char* a1 = cA + (size_t)(t + 1) * kstep;
            const char* a2 = last ? nA : cA + (size_t)(t + 2) * kstep; const char* b2 = last ? nB : cB + (size_t)(t + 2) * kstep;
            const char* a3 = a2 + kstep; const char* b3 = b2 + kstep;
            if (last && has_next) S.a_ready(nxt);
            if constexpr (SP2) {
            PG8_LDB(B0, 0, 0); PG8_LDB(B1, 0, 1); PG8_SCHED; PG8_LDA(At, 0, 0); PG8_STAGE(PG8_SA(1, 1), a1 + hstep, voffA);
            PG8_WAIT_V(8); PG8_WAIT_L(0); PG8_BAR; PG8_MMA(0, 0, At, B0); PG8_MMA(0, 1, At, B1); PG8_BAR; PG8_SCHED;
            PG8_LDA(At, 0, 1); PG8_STAGE(PG8_SB(0, 0), b2, voffB); PG8_STAGE(PG8_SB(0, 1), b2 + hstep, voffB); PG8_STAGE(PG8_SA(0, 0), a2, voffA);
            PG8_WAIT_V(8); PG8_WAIT_L(0); PG8_BAR; PG8_MMA(1, 0, At, B0); PG8_MMA(1, 1, At, B1); PG8_BAR; PG8_SCHED;
            PG8_LDB(B0, 1, 0); PG8_LDB(B1, 1, 1); PG8_SCHED; PG8_LDA(At, 1, 0); PG8_STAGE(PG8_SA(0, 1), a2 + hstep, voffA);
            PG8_WAIT_V(8); PG8_WAIT_L(0); PG8_BAR; PG8_MMA(0, 0, At, B0); PG8_MMA(0, 1, At, B1); PG8_BAR; PG8_SCHED;
            PG8_LDA(At, 1, 1); PG8_STAGE(PG8_SB(1, 0), b3, voffB); PG8_STAGE(PG8_SB(1, 1), b3 + hstep, voffB); PG8_STAGE(PG8_SA(1, 0), a3, voffA);
            PG8_WAIT_V(8); PG8_WAIT_L(0); PG8_BAR; PG8_MMA(1, 0, At, B0); PG8_MMA(1, 1, At, B1); PG8_BAR; PG8_SCHED;
            } else {
            PG8_LDB(B0, 0, 0); PG8_SCHED; PG8_LDA(At, 0, 0); PG8_STAGE(PG8_SA(1, 1), a1 + hstep, voffA);
            PG8_WAIT_L(8); PG8_BAR; PG8_WAIT_L(0); PG8_MMA(0, 0, At, B0); PG8_BAR; PG8_SCHED;
            PG8_LDB(B1, 0, 1); PG8_STAGE(PG8_SB(0, 0), b2, voffB);
            PG8_BAR; PG8_WAIT_L(0); PG8_MMA(0, 1, At, B1); PG8_BAR;
            PG8_LDA(At, 0, 1); PG8_STAGE(PG8_SA(0, 0), a2, voffA);
            PG8_BAR; PG8_WAIT_L(0); PG8_MMA(1, 0, At, B0); PG8_BAR; PG8_SCHED;
            PG8_STAGE(PG8_SB(0, 1), b2 + hstep, voffB);
            PG8_WAIT_V(6); PG8_BAR; PG8_MMA(1, 1, At, B1); PG8_BAR;
            PG8_LDB(B0, 1, 0); PG8_SCHED; PG8_LDA(At, 1, 0); PG8_STAGE(PG8_SA(0, 1), a2 + hstep, voffA);
            PG8_WAIT_L(8); PG8_BAR; PG8_WAIT_L(0); PG8_MMA(0, 0, At, B0); PG8_BAR; PG8_SCHED;
            PG8_LDB(B1, 1, 1); PG8_STAGE(PG8_SB(1, 0), b3, voffB);
            PG8_BAR; PG8_WAIT_L(0); PG8_MMA(0, 1, At, B1); PG8_BAR;
            PG8_LDA(At, 1, 1); PG8_STAGE(PG8_SA(1, 0), a3, voffA);
            PG8_BAR; PG8_WAIT_L(0); PG8_MMA(1, 0, At, B0); PG8_BAR; PG8_SCHED;
            PG8_STAGE(PG8_SB(1, 1), b3 + hstep, voffB);
            PG8_WAIT_V(6); PG8_BAR; PG8_MMA(1, 1, At, B1); PG8_BAR;
            }
        }
        if constexpr (ALIGN_EPI) { if (wr == 0) PG8_BAR; }
        if constexpr (!Epi::AFTER_DRAIN) { E(acc, cur, wr, wc, fr, fq); S.done(cur); }
        if (!has_next) break;
#pragma unroll
        for (int a = 0; a < 2; ++a)
#pragma unroll
            for (int b = 0; b < 2; ++b)
#pragma unroll
                for (int m = 0; m < 4; ++m)
#pragma unroll
                    for (int n = 0; n < 2; ++n) acc[a][b][m][n] = (f32x4){0.f, 0.f, 0.f, 0.f};
        cur = nxt; cA = nA; cB = nB; ++ui;
        if constexpr (ALIGN_EPI) { if (wr == 1) PG8_BAR; }
    }
    PG8_WAIT_V(0);
    if constexpr (!ALIGN_EPI) { if (wr == 0) PG8_BAR; }
    PG8_BAR;
    if constexpr (Epi::AFTER_DRAIN) { E.fused(acc, cur, wr, wc, fr, fq, lds, wid, lane); S.done(cur); }
#undef PG8_SA
#undef PG8_SB
#undef PG8_STAGE
#undef PG8_LDA
#undef PG8_LDB
#undef PG8_MMA
#undef PG8_WAIT_V
#undef PG8_WAIT_L
#undef PG8_BAR
#undef PG8_SCHED
}
}

template <int MODE> struct EpiMK {
  static constexpr bool PERM = true, AFTER_DRAIN = false;
  const Params* pp; int l;
  DEV void operator()(const pg8::f32x4 (&acc)[2][2][4][2], const pg8::Unit& u, int wr, int wc, int fr, int fq) const {
    const Params& p = *pp;
#pragma unroll
    for (int ai = 0; ai < 2; ++ai)
#pragma unroll
      for (int m = 0; m < 4; ++m) {
        const int row = u.pm * 256 + ai * 128 + wr * 64 + m * 16 + fr;
#pragma unroll
        for (int bj = 0; bj < 2; ++bj) {
          const int col = u.pn * 256 + bj * 128 + wc * 32 + fq * 8;
          const pg8::f32x4 v0 = acc[ai][bj][m][0], v1 = acc[ai][bj][m][1];
          if (MODE == 0) {
            if (col < DIN) {
              uint4 o; o.x = pk2(v0[0], v0[1]); o.y = pk2(v0[2], v0[3]); o.z = pk2(v1[0], v1[1]); o.w = pk2(v1[2], v1[3]);
              *(uint4*)((bf16_t*)(p.ws + OFF_P) + (size_t)row * DIN + col) = o;
              if (row < NCTX) {
                if (col >= C_NK && col < C_HQ) {
                  const int kv = col >= C_NV;
                  float* dst = p.out + O_NAT + (size_t)(((row >> 8) * 4 + l) * 2 + kv) * 65536 + (row & 255) * 256 + (col - (kv ? C_NV : C_NK));
                  *(pg8::f32x4*)dst = v0; *(pg8::f32x4*)(dst + 4) = v1;
                } else if (col >= C_SK) {
                  const int kv = col >= C_SV;
                  float* dst = p.out + O_SWA + (size_t)(((row >> 8) * 4 + l) * 2 + kv) * 32768 + (row & 255) * 128 + (col - (kv ? C_SV : C_SK));
                  *(pg8::f32x4*)dst = v0; *(pg8::f32x4*)(dst + 4) = v1;
                }
              }
            }
          } else if (MODE == 1) {
            uint4 o; o.x = pk2(v0[0], v0[1]); o.y = pk2(v0[2], v0[3]); o.z = pk2(v1[0], v1[1]); o.w = pk2(v1[2], v1[3]);
            *(uint4*)((bf16_t*)(p.ws + OFF_U) + (size_t)row * D + col) = o;
          } else {
            float r[8];
#pragma unroll
            for (int e = 0; e < 4; ++e) { const float a = fmaxf(v0[e], 0.f), b2 = fmaxf(v1[e], 0.f); r[e] = a * a; r[4 + e] = b2 * b2; }
            uint4 o; o.x = pk2(r[0], r[1]); o.y = pk2(r[2], r[3]); o.z = pk2(r[4], r[5]); o.w = pk2(r[6], r[7]);
            *(uint4*)((bf16_t*)(p.ws + OFF_HID) + (size_t)row * FF + col) = o;
          }
        }
      }
  }
};

template <int MODE>
DEV void gemm_run(const Params& p, int l, const bf16_t* A, const bf16_t* BT, int K, int N, char* lds) {
  pg8::Gemm g{A, BT, MT, N, K};
  pg8::StaticOrder S; S.init(MT, N, (int)gridDim.x, (int)blockIdx.x);
  EpiMK<MODE> E{&p, l};
  pg8::gemm_phase<EpiMK<MODE>, pg8::StaticOrder, true, true>((PG8_LAS unsigned char*)lds, g, S, E);
  if (MODE == 1 && l < 3 && (int)gridDim.x > 160 && (int)blockIdx.x >= 160) {
    if (K == D) layer_tiles(p, l + 1, 0, 640, (int)blockIdx.x - 160, (int)gridDim.x - 160, lds);
    else layer_tiles(p, l + 1, 640, NT_LAYER, (int)blockIdx.x - 160, (int)gridDim.x - 160, lds);
  }
}

constexpr int TOKT = 20;
DEV void prep_item(const Params& p, int l, int tile, char* lds) {
  const int t = tid(), r0 = tile * TOKT, c = t;
  bf16_t* sA = (bf16_t*)lds;
  float* swl = (float*)(lds + 32 * 136 * 2);
  float* sal = swl + TOKT * 256;
  const bf16_t* P = (const bf16_t*)(p.ws + OFF_P);
  bf16_t* PREP = (bf16_t*)(p.ws + OFF_PREP);
  bf16_t* BON = (bf16_t*)(p.ws + OFF_BONUS);
  for (int dir = 0; dir < 2; ++dir) {
    __syncthreads();
#pragma unroll
    for (int i = 0; i < TOKT / 2; ++i) {
      const int e = t + 256 * i, tk = e >> 7, j = e & 127, which = j >> 6, jj = j & 63;
      const int row = r0 + tk, prow = dir ? row + 1 : row - 1;
      const int tis = row < NCTX ? (row & 255) : ((row - NCTX) & 1023), Tm1 = row < NCTX ? 255 : 1023;
      const bool pv = dir ? (tis < Tm1) : (tis > 0);
      const int col = (dir ? C_WHB : C_WHF) + which * 64 + jj;
      const float cur = bf2f(P[(size_t)row * DIN + col]);
      const float prev = bf2f(P[(size_t)(pv ? prow : row) * DIN + col]) * (pv ? 1.f : 0.f);
      const float mu = p.in[I_MULORA][((l * 2 + dir) * 2 + which) * 64 + jj];
      const float val = cur + (prev - cur) * mu;
      sA[tk * 136 + j] = f2bf((which == 0) ? tanhf_(val) : val);
    }
    __syncthreads();
    {
      const int lane = t & 63, w = t >> 6, q = lane & 31, hh = lane >> 5;
#pragma unroll
      for (int mat = 0; mat < 2; ++mat) {
        bf16x8 af[4];
#pragma unroll
        for (int s = 0; s < 4; ++s) af[s] = *(const bf16x8*)(sA + q * 136 + mat * 64 + 16 * s + 8 * hh);
        const bf16_t* WT = (const bf16_t*)(p.ws + (mat ? OFF_A2T : OFF_W2T)) + (size_t)(l * 2 + dir) * 256 * 64;
        float* dst = mat ? sal : swl;
#pragma unroll
        for (int nt = 0; nt < 2; ++nt) {
          const int n = w * 64 + nt * 32 + q;
          f32x16 acc;
#pragma unroll
          for (int r = 0; r < 16; ++r) acc[r] = 0.f;
#pragma unroll
          for (int s = 0; s < 4; ++s) acc = MFMA32(af[s], *(const bf16x8*)(WT + (size_t)n * 64 + 16 * s + 8 * hh), acc);
#pragma unroll
          for (int r = 0; r < 8; ++r) dst[((r & 3) + 8 * (r >> 2) + 4 * hh) * 256 + n] = acc[r];
          if (hh == 0) {
#pragma unroll
            for (int r = 8; r < 12; ++r) dst[((r & 3) + 16) * 256 + n] = acc[r];
          }
        }
      }
    }
    __syncthreads();
    const float w0v = p.in[I_W0][(l * 2 + dir) * 256 + c], a0v = p.in[I_A0][(l * 2 + dir) * 256 + c];
    const float kkv = p.in[I_KK][l * 256 + c], kav = p.in[I_KA][l * 256 + c], rkv = p.in[I_RK][l * 256 + c];
    const float mur = p.in[I_MURKV][((l * 2 + dir) * 3 + 0) * 256 + c], muk = p.in[I_MURKV][((l * 2 + dir) * 3 + 1) * 256 + c],
                muv = p.in[I_MURKV][((l * 2 + dir) * 3 + 2) * 256 + c];
    bf16_t* pr = PREP + (size_t)dir * 6 * ARRF;
    for (int tb = 0; tb < TOKT; tb += 5) {
      float rc[5], kc[5], vc[5], rp[5], kq[5], vp[5], wlv[5], alv[5];
#pragma unroll
      for (int u = 0; u < 5; ++u) {
        const int tk = tb + u, row = r0 + tk, prow = dir ? row + 1 : row - 1;
        const int tis = row < NCTX ? (row & 255) : ((row - NCTX) & 1023), Tm1 = row < NCTX ? 255 : 1023;
        const bool pv = dir ? (tis < Tm1) : (tis > 0);
        const float pm = pv ? 1.f : 0.f;
        const bf16_t* pc = P + (size_t)row * DIN + c;
        const bf16_t* pp = P + (size_t)(pv ? prow : row) * DIN + c;
        rc[u] = bf2f(pc[C_R]); kc[u] = bf2f(pc[C_K]); vc[u] = bf2f(pc[C_V]);
        rp[u] = bf2f(pp[C_R]) * pm; kq[u] = bf2f(pp[C_K]) * pm; vp[u] = bf2f(pp[C_V]) * pm;
        wlv[u] = swl[tk * 256 + c]; alv[u] = sal[tk * 256 + c];
      }
      float bprev[5];
#pragma unroll
      for (int u = 0; u < 5; ++u) bprev[u] = (dir == 1) ? bf2f(BON[(size_t)(r0 + tb + u) * 256 + c]) : 0.f;
#pragma unroll
      for (int u = 0; u < 5; ++u) {
        const int row = r0 + tb + u;
        const float rs = rc[u] + (rp[u] - rc[u]) * mur, ks = kc[u] + (kq[u] - kc[u]) * muk, vs = vc[u] + (vp[u] - vc[u]) * muv;
        const float wl = w0v + wlv[u], al = a0v + alv[u];
        const float wv = __expf(-0.6065306597126334f * sigmoidf_(wl));
        const float av = sigmoidf_(al);
        const float kkr = ks * kkv;
        const float n2 = wave_sum(kkr * kkr);
        const float kk = kkr * rcpf_(fmaxf(__builtin_amdgcn_sqrtf(n2), 1e-12f));
        const float kp = ks * (1.0f + (av - 1.0f) * kav);
        const float bs = wave_sum(rs * kp * rkv);
        const float bon = bs * vs;
        const size_t idx = (size_t)row * 256 + c;
        pr[idx] = f2bf(rs); pr[ARRF + idx] = f2bf(wv); pr[2 * ARRF + idx] = f2bf(kp); pr[3 * ARRF + idx] = f2bf(vs); pr[4 * ARRF + idx] = f2bf(kk); pr[5 * ARRF + idx] = f2bf(kk * av);
        BON[idx] = f2bf(bprev[u] + bon);
      }
    }
  }
  __syncthreads();
}

DEV void rope_item(const Params& p, int item) {
  bf16_t* P = (bf16_t*)(p.ws + OFF_P);
  const int t = tid();
  for (int e = t; e < 8 * 192; e += 256) {
    const int tk = e / 192, r = e % 192, hs = r >> 5, pi = r & 31;
    const int lt = item * 8 + tk;
    const int tt = lt & 1023;
    const int grow = tt >> 6, gcol = tt & 63;
    const int fi = pi & 15;
    const float pos = (pi < 16) ? (float)grow : (float)gcol;
    const float inv = exp2f(-(float)fi * (13.287712379549449f / 16.0f));
    const float ang = pos * inv;
    const float cs = __cosf(ang), sn = __sinf(ang);
    const int d1 = (pi < 16) ? fi : 32 + fi;
    bf16_t* base = P + (size_t)(NCTX + lt) * DIN + C_SQ + hs * 64;
    const float x1 = bf2f(base[d1]), x2 = bf2f(base[d1 + 16]);
    base[d1] = f2bf(x1 * cs - x2 * sn);
    base[d1 + 16] = f2bf(x2 * cs + x1 * sn);
  }
}

constexpr int SC_BUF = 20480 + 4096;
typedef float f2 __attribute__((ext_vector_type(2)));
DEV float dot4(const float4& a, const float4& b) { return a.x * b.x + a.y * b.y + a.z * b.z + a.w * b.w; }
DEV float red8(float x) { x += dppf<0xB1>(x); x += dppf<0x4E>(x); x += dppf<0x141>(x); return x; }
DEV float dot8(const f2 (&S)[4], const float4& a, const float4& b) {
  f2 acc = S[0] * (f2){a.x, a.y};
  acc += S[1] * (f2){a.z, a.w}; acc += S[2] * (f2){b.x, b.y}; acc += S[3] * (f2){b.z, b.w};
  return acc.x + acc.y;
}

template <int NCH>
DEV void rwkv_scan(const Params& p, int l, int seq, int head, int dir, int rsel, char* lds) {
  const int t = tid(), rr = t >> 3, g = t & 7, rl = t >> 4, ks = t & 15;
  const int T = seq < 32 ? 256 : 1024;
  const int row0 = seq < 32 ? seq * 256 : NCTX + (seq - 32) * 1024;
  const bf16_t* prep = (const bf16_t*)(p.ws + OFF_PREP) + (size_t)dir * 6 * ARRF;
  float* ydir = (float*)(p.ws + OFF_YDIR) + (size_t)dir * ARRF;
  const int vbase = (NCH == 2) ? 0 : rsel * 32;
  f2 S[NCH][4];
#pragma unroll
  for (int c = 0; c < NCH; ++c)
#pragma unroll
    for (int j = 0; j < 4; ++j) S[c][j] = (f2){0.f, 0.f};
  if (seq >= 32) {
    const float* sp = p.in[I_SRW] + ((((size_t)(seq - 32) * 4 + l) * 2 + dir) * 4 + head) * 4096 + g * 8;
#pragma unroll
    for (int c = 0; c < NCH; ++c) {
      const float4 a = *(const float4*)(sp + (vbase + rr + 32 * c) * 64), b = *(const float4*)(sp + (vbase + rr + 32 * c) * 64 + 4);
      S[c][0] = (f2){a.x, a.y}; S[c][1] = (f2){a.z, a.w}; S[c][2] = (f2){b.x, b.y}; S[c][3] = (f2){b.z, b.w};
    }
  }
  const int nch = T >> 4;
  uint2 pre0, pre1, pre2, pre3, pre4, pvv;
#define RW_LOAD(cc) do { const int s_ = (cc) * 16 + rl; const int tok_ = dir ? (T - 1 - s_) : s_; \
    const size_t base_ = (size_t)(row0 + tok_) * 256 + head * 64; \
    pre0 = *(const uint2*)(prep + base_ + ks * 4); pre1 = *(const uint2*)(prep + ARRF + base_ + ks * 4); \
    pre2 = *(const uint2*)(prep + 2 * ARRF + base_ + ks * 4); pre3 = *(const uint2*)(prep + 4 * ARRF + base_ + ks * 4); \
    pre4 = *(const uint2*)(prep + 5 * ARRF + base_ + ks * 4); \
    if (NCH == 2) pvv = *(const uint2*)(prep + 3 * ARRF + base_ + ks * 4); \
    else pvv.x = *(const unsigned*)(prep + 3 * ARRF + base_ + vbase + ks * 2); } while (0)
#define RW_WRITE(bb) do { float4* sb_ = (float4*)(lds + (bb) * SC_BUF); float* vb_ = (float*)(lds + (bb) * SC_BUF + 20480); \
    sb_[(0 * 16 + rl) * 16 + ks] = bf4(pre0); sb_[(1 * 16 + rl) * 16 + ks] = bf4(pre1); sb_[(2 * 16 + rl) * 16 + ks] = bf4(pre2); \
    sb_[(3 * 16 + rl) * 16 + ks] = bf4(pre3); sb_[(4 * 16 + rl) * 16 + ks] = bf4(pre4); \
    if (NCH == 2) *(float4*)(vb_ + rl * 64 + ks * 4) = bf4(pvv); else *(f2*)(vb_ + rl * 64 + ks * 2) = (f2){bflo(pvv.x), bfhi(pvv.x)}; } while (0)
  __syncthreads();
  RW_LOAD(0); RW_WRITE(0);
  __syncthreads();
  for (int c = 0; c < nch; ++c) {
    if (c + 1 < nch) RW_LOAD(c + 1);
    const float4* sbuf = (const float4*)(lds + (c & 1) * SC_BUF);
    const float* vbuf = (const float*)(lds + (c & 1) * SC_BUF + 20480);
    float ym[NCH][2];
#pragma unroll
    for (int cc = 0; cc < NCH; ++cc) { ym[cc][0] = 0.f; ym[cc][1] = 0.f; }
#pragma unroll
    for (int i = 0; i < 16; ++i) {
      const float4 ra = sbuf[(0 * 16 + i) * 16 + g * 2], rb = sbuf[(0 * 16 + i) * 16 + g * 2 + 1];
      const float4 wa = sbuf[(1 * 16 + i) * 16 + g * 2], wb = sbuf[(1 * 16 + i) * 16 + g * 2 + 1];
      const float4 ka_ = sbuf[(2 * 16 + i) * 16 + g * 2], kb_ = sbuf[(2 * 16 + i) * 16 + g * 2 + 1];
      const float4 na = sbuf[(3 * 16 + i) * 16 + g * 2], nb = sbuf[(3 * 16 + i) * 16 + g * 2 + 1];
      const float4 aa = sbuf[(4 * 16 + i) * 16 + g * 2], ab = sbuf[(4 * 16 + i) * 16 + g * 2 + 1];
      const f2 w2[4] = {(f2){wa.x, wa.y}, (f2){wa.z, wa.w}, (f2){wb.x, wb.y}, (f2){wb.z, wb.w}};
      const f2 k2[4] = {(f2){ka_.x, ka_.y}, (f2){ka_.z, ka_.w}, (f2){kb_.x, kb_.y}, (f2){kb_.z, kb_.w}};
      const f2 a2[4] = {(f2){aa.x, aa.y}, (f2){aa.z, aa.w}, (f2){ab.x, ab.y}, (f2){ab.z, ab.w}};
#pragma unroll
      for (int cc = 0; cc < NCH; ++cc) {
        const float v = vbuf[i * 64 + rr + 32 * cc];
        const float sa = -red8(dot8(S[cc], na, nb));
#pragma unroll
        for (int j = 0; j < 4; ++j) S[cc][j] = S[cc][j] * w2[j] + a2[j] * sa + k2[j] * v;
        const float y = red8(dot8(S[cc], ra, rb));
        ym[cc][i >> 3] = (g == (i & 7)) ? y : ym[cc][i >> 3];
      }
    }
#pragma unroll
    for (int hh = 0; hh < 2; ++hh) {
      const int s = c * 16 + hh * 8 + g; const int tok = dir ? (T - 1 - s) : s;
      float* yo = ydir + (size_t)(row0 + tok) * 256 + head * 64 + vbase + rr;
#pragma unroll
      for (int cc = 0; cc < NCH; ++cc) yo[32 * cc] = ym[cc][hh];
    }
    if (c + 1 < nch) RW_WRITE((c + 1) & 1);
    __syncthreads();
  }
#undef RW_LOAD
#undef RW_WRITE
  if (seq < 32) {
    float* sp = p.out + O_RW + ((((size_t)seq * 4 + l) * 2 + dir) * 4 + head) * 4096 + g * 8;
#pragma unroll
    for (int c = 0; c < NCH; ++c) {
      *(float4*)(sp + (vbase + rr + 32 * c) * 64) = make_float4(S[c][0].x, S[c][0].y, S[c][1].x, S[c][1].y);
      *(float4*)(sp + (vbase + rr + 32 * c) * 64 + 4) = make_float4(S[c][2].x, S[c][2].y, S[c][3].x, S[c][3].y);
    }
  }
}

template <int NCH>
DEV void hgrn_scan(const Params& p, int l, int seq, int head, int dir, int rsel, char* lds) {
  const int t = tid(), rr = t >> 3, g = t & 7, rl = t >> 4, ks = t & 15;
  const int T = seq < 32 ? 256 : 1024;
  const int row0 = seq < 32 ? seq * 256 : NCTX + (seq - 32) * 1024;
  const bf16_t* P = (const bf16_t*)(p.ws + OFF_P);
  float* odir = (float*)(p.ws + OFF_HDIR) + (size_t)dir * ARRF;
  const float4 lb4 = *(const float4*)((const float*)(p.ws + OFF_HGLB) + (l * 2 + dir) * 256 + head * 64 + ks * 4);
  const int vbase = (NCH == 2) ? 0 : rsel * 32;
  f2 S[NCH][4];
#pragma unroll
  for (int c = 0; c < NCH; ++c)
#pragma unroll
    for (int j = 0; j < 4; ++j) S[c][j] = (f2){0.f, 0.f};
  if (seq >= 32) {
    const float* sp = p.in[I_SHG] + ((((size_t)(seq - 32) * 4 + l) * 2 + dir) * 4 + head) * 4096;
#pragma unroll
    for (int c = 0; c < NCH; ++c)
#pragma unroll
      for (int j = 0; j < 4; ++j) {
        const int v = vbase + rr + 32 * c;
        S[c][j] = (f2){sp[(g * 8 + 2 * j) * 64 + v], sp[(g * 8 + 2 * j + 1) * 64 + v]};
      }
  }
  const int nch = T >> 4;
  const int fcol = (dir ? C_HFB : C_HFF) + head * 64;
  uint2 pq, pf, pv2;
#define HG_LOAD(cc) do { const int s_ = (cc) * 16 + rl; const int tok_ = dir ? (T - 1 - s_) : s_; \
    const bf16_t* pr_ = P + (size_t)(row0 + tok_) * DIN; \
    pq = *(const uint2*)(pr_ + C_HQ + head * 64 + ks * 4); pf = *(const uint2*)(pr_ + fcol + ks * 4); \
    if (NCH == 2) pv2 = *(const uint2*)(pr_ + C_HI + head * 64 + ks * 4); else pv2.x = *(const unsigned*)(pr_ + C_HI + head * 64 + vbase + ks * 2); } while (0)
#define HG_WRITE(bb) do { float4* sb_ = (float4*)(lds + (bb) * SC_BUF); float* vb_ = (float*)(lds + (bb) * SC_BUF + 20480); \
    float4 q_, f_, k_; float a_, sg_; \
    a_ = bflo(pq.x); q_.x = a_ * sigmoidf_(a_); a_ = bfhi(pq.x); q_.y = a_ * sigmoidf_(a_); \
    a_ = bflo(pq.y); q_.z = a_ * sigmoidf_(a_); a_ = bfhi(pq.y); q_.w = a_ * sigmoidf_(a_); \
    sg_ = sigmoidf_(bflo(pf.x)); f_.x = lb4.x + (1.f - lb4.x) * sg_; k_.x = (1.f - lb4.x) * (1.f - sg_); \
    sg_ = sigmoidf_(bfhi(pf.x)); f_.y = lb4.y + (1.f - lb4.y) * sg_; k_.y = (1.f - lb4.y) * (1.f - sg_); \
    sg_ = sigmoidf_(bflo(pf.y)); f_.z = lb4.z + (1.f - lb4.z) * sg_; k_.z = (1.f - lb4.z) * (1.f - sg_); \
    sg_ = sigmoidf_(bfhi(pf.y)); f_.w = lb4.w + (1.f - lb4.w) * sg_; k_.w = (1.f - lb4.w) * (1.f - sg_); \
    sb_[(0 * 16 + rl) * 16 + ks] = q_; sb_[(1 * 16 + rl) * 16 + ks] = f_; sb_[(2 * 16 + rl) * 16 + ks] = k_; \
    if (NCH == 2) *(float4*)(vb_ + rl * 64 + ks * 4) = make_float4(bflo(pv2.x), bfhi(pv2.x), bflo(pv2.y), bfhi(pv2.y)); \
    else *(f2*)(vb_ + rl * 64 + ks * 2) = (f2){bflo(pv2.x), bfhi(pv2.x)}; } while (0)
  __syncthreads();
  HG_LOAD(0); HG_WRITE(0);
  __syncthreads();
  for (int c = 0; c < nch; ++c) {
    if (c + 1 < nch) HG_LOAD(c + 1);
    const float4* sbuf = (const float4*)(lds + (c & 1) * SC_BUF);
    const float* vbuf = (const float*)(lds + (c & 1) * SC_BUF + 20480);
    float ym[NCH][2];
#pragma unroll
    for (int cc = 0; cc < NCH; ++cc) { ym[cc][0] = 0.f; ym[cc][1] = 0.f; }
#pragma unroll
    for (int i = 0; i < 16; ++i) {
      const float4 qa = sbuf[(0 * 16 + i) * 16 + g * 2], qb = sbuf[(0 * 16 + i) * 16 + g * 2 + 1];
      const float4 fa = sbuf[(1 * 16 + i) * 16 + g * 2], fb = sbuf[(1 * 16 + i) * 16 + g * 2 + 1];
      const float4 ka_ = sbuf[(2 * 16 + i) * 16 + g * 2], kb_ = sbuf[(2 * 16 + i) * 16 + g * 2 + 1];
      const f2 f2v[4] = {(f2){fa.x, fa.y}, (f2){fa.z, fa.w}, (f2){fb.x, fb.y}, (f2){fb.z, fb.w}};
      const f2 k2[4] = {(f2){ka_.x, ka_.y}, (f2){ka_.z, ka_.w}, (f2){kb_.x, kb_.y}, (f2){kb_.z, kb_.w}};
#pragma unroll
      for (int cc = 0; cc < NCH; ++cc) {
        const float v = vbuf[i * 64 + rr + 32 * cc];
#pragma unroll
        for (int j = 0; j < 4; ++j) S[cc][j] = S[cc][j] * f2v[j] + k2[j] * v;
        const float y = red8(dot8(S[cc], qa, qb));
        ym[cc][i >> 3] = (g == (i & 7)) ? y : ym[cc][i >> 3];
      }
    }
#pragma unroll
    for (int hh = 0; hh < 2; ++hh) {
      const int s = c * 16 + hh * 8 + g; const int tok = dir ? (T - 1 - s) : s;
      float* yo = odir + (size_t)(row0 + tok) * 256 + head * 64 + vbase + rr;
#pragma unroll
      for (int cc = 0; cc < NCH; ++cc) yo[32 * cc] = ym[cc][hh];
    }
    if (c + 1 < nch) HG_WRITE((c + 1) & 1);
    __syncthreads();
  }
#undef HG_LOAD
#undef HG_WRITE
  if (seq < 32) {
    float* sp = p.out + O_HG + ((((size_t)seq * 4 + l) * 2 + dir) * 4 + head) * 4096;
#pragma unroll
    for (int c = 0; c < NCH; ++c)
#pragma unroll
      for (int j = 0; j < 4; ++j) {
        const int v = vbase + rr + 32 * c;
        sp[(g * 8 + 2 * j) * 64 + v] = S[c][j].x; sp[(g * 8 + 2 * j + 1) * 64 + v] = S[c][j].y;
      }
  }
}

DEV void rwkv_scan16(const Params& p, int l, int seq, int head, int dir, int rg, char* lds) {
  const int t = tid(), rl = t >> 4, ks = t & 15;
  const int T = seq < 32 ? 256 : 1024;
  const int row0 = seq < 32 ? seq * 256 : NCTX + (seq - 32) * 1024;
  const bf16_t* prep = (const bf16_t*)(p.ws + OFF_PREP) + (size_t)dir * 6 * ARRF;
  float* ydir = (float*)(p.ws + OFF_YDIR) + (size_t)dir * ARRF;
  const int v0 = rg * 16 + rl;
  float4 S0 = make_float4(0.f, 0.f, 0.f, 0.f);
  if (seq >= 32) S0 = *(const float4*)(p.in[I_SRW] + ((((size_t)(seq - 32) * 4 + l) * 2 + dir) * 4 + head) * 4096 + ks * 4 + v0 * 64);
  const int nch = T >> 4;
  uint2 pre0, pre1, pre2, pre3, pre4; bf16_t pv0;
#define RW_LOAD(cc) do { const int s_ = (cc) * 16 + rl; const int tok_ = dir ? (T - 1 - s_) : s_; \
    const size_t base_ = (size_t)(row0 + tok_) * 256 + head * 64; \
    pre0 = *(const uint2*)(prep + base_ + ks * 4); pre1 = *(const uint2*)(prep + ARRF + base_ + ks * 4); \
    pre2 = *(const uint2*)(prep + 2 * ARRF + base_ + ks * 4); pre3 = *(const uint2*)(prep + 4 * ARRF + base_ + ks * 4); \
    pre4 = *(const uint2*)(prep + 5 * ARRF + base_ + ks * 4); pv0 = prep[3 * ARRF + base_ + rg * 16 + ks]; } while (0)
#define RW_WRITE(bb) do { float4* sb_ = (float4*)(lds + (bb) * SC_BUF); float* vb_ = (float*)(lds + (bb) * SC_BUF + 20480); \
    sb_[(0 * 16 + rl) * 16 + ks] = bf4(pre0); sb_[(1 * 16 + rl) * 16 + ks] = bf4(pre1); sb_[(2 * 16 + rl) * 16 + ks] = bf4(pre2); \
    sb_[(3 * 16 + rl) * 16 + ks] = bf4(pre3); sb_[(4 * 16 + rl) * 16 + ks] = bf4(pre4); vb_[rl * 16 + ks] = bf2f(pv0); } while (0)
  __syncthreads();
  RW_LOAD(0); RW_WRITE(0);
  __syncthreads();
  for (int c = 0; c < nch; ++c) {
    if (c + 1 < nch) RW_LOAD(c + 1);
    const float4* sbuf = (const float4*)(lds + (c & 1) * SC_BUF);
    const float* vbuf = (const float*)(lds + (c & 1) * SC_BUF + 20480);
    float ym0 = 0.f;
#pragma unroll
    for (int i = 0; i < 16; ++i) {
      const float4 r = sbuf[(0 * 16 + i) * 16 + ks], wv = sbuf[(1 * 16 + i) * 16 + ks], kv = sbuf[(2 * 16 + i) * 16 + ks],
                   kk = sbuf[(3 * 16 + i) * 16 + ks], ka = sbuf[(4 * 16 + i) * 16 + ks];
      const float va = vbuf[i * 16 + rl];
      const float sa0 = -row16_sum(dot4(S0, kk));
      S0.x = S0.x * wv.x + sa0 * ka.x + va * kv.x; S0.y = S0.y * wv.y + sa0 * ka.y + va * kv.y;
      S0.z = S0.z * wv.z + sa0 * ka.z + va * kv.z; S0.w = S0.w * wv.w + sa0 * ka.w + va * kv.w;
      const float y0 = row16_sum(dot4(S0, r));
      ym0 = (ks == i) ? y0 : ym0;
    }
    {
      const int s = c * 16 + ks; const int tok = dir ? (T - 1 - s) : s;
      ydir[(size_t)(row0 + tok) * 256 + head * 64 + v0] = ym0;
    }
    if (c + 1 < nch) RW_WRITE((c + 1) & 1);
    __syncthreads();
  }
#undef RW_LOAD
#undef RW_WRITE
  if (seq < 32) *(float4*)(p.out + O_RW + ((((size_t)seq * 4 + l) * 2 + dir) * 4 + head) * 4096 + ks * 4 + v0 * 64) = S0;
}

DEV void hgrn_scan16(const Params& p, int l, int seq, int head, int dir, int rg, char* lds) {
  const int t = tid(), rl = t >> 4, ks = t & 15;
  const int T = seq < 32 ? 256 : 1024;
  const int row0 = seq < 32 ? seq * 256 : NCTX + (seq - 32) * 1024;
  const bf16_t* P = (const bf16_t*)(p.ws + OFF_P);
  float* odir = (float*)(p.ws + OFF_HDIR) + (size_t)dir * ARRF;
  const float4 lb4 = *(const float4*)((const float*)(p.ws + OFF_HGLB) + (l * 2 + dir) * 256 + head * 64 + ks * 4);
  const int v0 = rg * 16 + rl;
  float4 S0 = make_float4(0.f, 0.f, 0.f, 0.f);
  if (seq >= 32) {
    const float* sp = p.in[I_SHG] + ((((size_t)(seq - 32) * 4 + l) * 2 + dir) * 4 + head) * 4096;
    S0.x = sp[(ks * 4 + 0) * 64 + v0]; S0.y = sp[(ks * 4 + 1) * 64 + v0]; S0.z = sp[(ks * 4 + 2) * 64 + v0]; S0.w = sp[(ks * 4 + 3) * 64 + v0];
  }
  const int nch = T >> 4;
  const int fcol = (dir ? C_HFB : C_HFF) + head * 64;
  uint2 pq, pf; bf16_t pva;
#define HG_LOAD(cc) do { const int s_ = (cc) * 16 + rl; const int tok_ = dir ? (T - 1 - s_) : s_; \
    const bf16_t* pr_ = P + (size_t)(row0 + tok_) * DIN; \
    pq = *(const uint2*)(pr_ + C_HQ + head * 64 + ks * 4); pf = *(const uint2*)(pr_ + fcol + ks * 4); \
    pva = pr_[C_HI + head * 64 + rg * 16 + ks]; } while (0)
#define HG_WRITE(bb) do { float4* sb_ = (float4*)(lds + (bb) * SC_BUF); float* vb_ = (float*)(lds + (bb) * SC_BUF + 20480); \
    float4 q_, f_, k_; float a_, sg_; \
    a_ = bflo(pq.x); q_.x = a_ * sigmoidf_(a_); a_ = bfhi(pq.x); q_.y = a_ * sigmoidf_(a_); \
    a_ = bflo(pq.y); q_.z = a_ * sigmoidf_(a_); a_ = bfhi(pq.y); q_.w = a_ * sigmoidf_(a_); \
    sg_ = sigmoidf_(bflo(pf.x)); f_.x = lb4.x + (1.f - lb4.x) * sg_; k_.x = (1.f - lb4.x) * (1.f - sg_); \
    sg_ = sigmoidf_(bfhi(pf.x)); f_.y = lb4.y + (1.f - lb4.y) * sg_; k_.y = (1.f - lb4.y) * (1.f - sg_); \
    sg_ = sigmoidf_(bflo(pf.y)); f_.z = lb4.z + (1.f - lb4.z) * sg_; k_.z = (1.f - lb4.z) * (1.f - sg_); \
    sg_ = sigmoidf_(bfhi(pf.y)); f_.w = lb4.w + (1.f - lb4.w) * sg_; k_.w = (1.f - lb4.w) * (1.f - sg_); \
    sb_[(0 * 16 + rl) * 16 + ks] = q_; sb_[(1 * 16 + rl) * 16 + ks] = f_; sb_[(2 * 16 + rl) * 16 + ks] = k_; \
    vb_[rl * 16 + ks] = bf2f(pva); } while (0)
  __syncthreads();
  HG_LOAD(0); HG_WRITE(0);
  __syncthreads();
  for (int c = 0; c < nch; ++c) {
    if (c + 1 < nch) HG_LOAD(c + 1);
    const float4* sbuf = (const float4*)(lds + (c & 1) * SC_BUF);
    const float* vbuf = (const float*)(lds + (c & 1) * SC_BUF + 20480);
    float ym0 = 0.f;
#pragma unroll
    for (int i = 0; i < 16; ++i) {
      const float4 q = sbuf[(0 * 16 + i) * 16 + ks], f = sbuf[(1 * 16 + i) * 16 + ks], k = sbuf[(2 * 16 + i) * 16 + ks];
      const float va = vbuf[i * 16 + rl];
      S0.x = S0.x * f.x + k.x * va; S0.y = S0.y * f.y + k.y * va; S0.z = S0.z * f.z + k.z * va; S0.w = S0.w * f.w + k.w * va;
      const float y0 = row16_sum(dot4(S0, q));
      ym0 = (ks == i) ? y0 : ym0;
    }
    {
      const int s = c * 16 + ks; const int tok = dir ? (T - 1 - s) : s;
      odir[(size_t)(row0 + tok) * 256 + head * 64 + v0] = ym0;
    }
    if (c + 1 < nch) HG_WRITE((c + 1) & 1);
    __syncthreads();
  }
#undef HG_LOAD
#undef HG_WRITE
  if (seq < 32) {
    float* sp = p.out + O_HG + ((((size_t)seq * 4 + l) * 2 + dir) * 4 + head) * 4096;
    sp[(ks * 4 + 0) * 64 + v0] = S0.x; sp[(ks * 4 + 1) * 64 + v0] = S0.y; sp[(ks * 4 + 2) * 64 + v0] = S0.z; sp[(ks * 4 + 3) * 64 + v0] = S0.w;
  }
}

template <int MODE>
DEV void attn_item(const Params& p, int l, int item, char* lds) {
  const int t = tid(), lane = t & 63, w = t >> 6, q = lane & 31, hh = lane >> 5;
  const bf16_t* P = (const bf16_t*)(p.ws + OFF_P);
  bf16_t* Y = (bf16_t*)(p.ws + OFF_YMIX);
  char* sK = lds;
  char* sV = lds + 8192;
  float* sBias = (float*)(lds + 8192 + 8704);
  int head, qrow, qcol, kcol, vcol, ocol, nloc, nt, rowbaseP;
  int qr = 0, qc = 0, rlo = 0, qpos = 0, lo = 0, rsq = 0, wsq = 0;
  float sink = 0.f;
  const float* cache = nullptr; int cH = 1, cHead = 0;
  if (MODE == 0 || MODE == 1) {
    const int b = item >> 3; head = (item >> 1) & 3; const int half = item & 1;
    rowbaseP = b * 256; qrow = rowbaseP + half * 128 + w * 32 + q; nloc = 4; nt = 4;
  } else {
    const int b = item >> 5; head = (item >> 3) & 3; const int sub = item & 7;
    rowbaseP = NCTX + b * 1024;
    if (MODE == 2) {
      qr = 2 * sub + (w >> 1); qc = (w & 1) * 32 + q; qrow = rowbaseP + qr * 64 + qc;
      rlo = clampi(2 * sub - 4, 0, 8); const int rhi = clampi(2 * sub - 3, 0, 8) + 7; nloc = rhi - rlo + 1; nt = nloc + 4;
      rsq = clampi(qr - 4, 0, 8); wsq = clampi(qc - 8, 0, 48);
      cache = p.in[I_CNAT] + (size_t)((b * 4 + l) * 2) * 256 * 256; cH = 4; cHead = head;
      for (int i = t; i < 465; i += 256) sBias[i] = p.in[I_RPB][(size_t)(l * 4 + head) * 465 + i];
    } else {
      qpos = sub * 128 + w * 32 + q; qrow = rowbaseP + qpos;
      lo = (sub - 1) * 128;
      nloc = 6; nt = nloc + 4;
      cache = p.in[I_CSWA] + (size_t)((b * 4 + l) * 2) * 256 * 128; cH = 2; cHead = head >> 1;
    }
  }
  if (MODE == 0 || MODE == 2) { qcol = C_NQ + head * 64; kcol = C_NK + head * 64; vcol = C_NV + head * 64; ocol = 256 + head * 64; }
  else { qcol = C_SQ + head * 64; kcol = C_SK + (head >> 1) * 64; vcol = C_SV + (head >> 1) * 64; ocol = 768 + head * 64; sink = p.in[I_SINK][l * 4 + head]; }

  bf16x8 bq[4];
#pragma unroll
  for (int s = 0; s < 4; ++s) bq[s] = *(const bf16x8*)(P + (size_t)qrow * DIN + qcol + 16 * s + 8 * hh);
  f32x16 oacc[2];
#pragma unroll
  for (int r = 0; r < 16; ++r) { oacc[0][r] = 0.f; oacc[1][r] = 0.f; }
  float m_run = -1e30f, l_run = 0.f;
  const int key = t >> 2, dq = t & 3;
  const int kswz = (key >> 1) & 7;
  float4 raw[8];
#define ATT_ISSUE(jj) do { const int j_ = (jj); \
    if (j_ < nloc) { \
      int krow_; \
      if (MODE == 0 || MODE == 1) krow_ = rowbaseP + j_ * 64 + key; \
      else if (MODE == 2) krow_ = rowbaseP + (rlo + j_) * 64 + key; \
      else krow_ = rowbaseP + clampi(lo + j_ * 64 + key, 0, 1023); \
      const bf16_t* kp_ = P + (size_t)krow_ * DIN + kcol + dq * 16; \
      const bf16_t* vp_ = P + (size_t)krow_ * DIN + vcol + dq * 16; \
      raw[0] = *(const float4*)kp_; raw[1] = *(const float4*)(kp_ + 8); raw[2] = *(const float4*)vp_; raw[3] = *(const float4*)(vp_ + 8); \
    } else { \
      const int ct_ = (j_ - nloc) * 64 + key; \
      const float* kp_ = cache + ((size_t)ct_ * cH + cHead) * 64 + dq * 16; \
      const float* vp_ = kp_ + (size_t)256 * cH * 64; \
      raw[0] = *(const float4*)kp_; raw[1] = *(const float4*)(kp_ + 4); raw[2] = *(const float4*)(kp_ + 8); raw[3] = *(const float4*)(kp_ + 12); \
      raw[4] = *(const float4*)vp_; raw[5] = *(const float4*)(vp_ + 4); raw[6] = *(const float4*)(vp_ + 8); raw[7] = *(const float4*)(vp_ + 12); \
    } } while (0)
  ATT_ISSUE(0);
  for (int j = 0; j < nt; ++j) {
    uint4 kr[2], vr[2];
    const bool isP = j < nloc;
    if (isP) {
      kr[0] = __builtin_bit_cast(uint4, raw[0]); kr[1] = __builtin_bit_cast(uint4, raw[1]);
      vr[0] = __builtin_bit_cast(uint4, raw[2]); vr[1] = __builtin_bit_cast(uint4, raw[3]);
    } else {
      kr[0].x = pk2(raw[0].x, raw[0].y); kr[0].y = pk2(raw[0].z, raw[0].w); kr[0].z = pk2(raw[1].x, raw[1].y); kr[0].w = pk2(raw[1].z, raw[1].w);
      kr[1].x = pk2(raw[2].x, raw[2].y); kr[1].y = pk2(raw[2].z, raw[2].w); kr[1].z = pk2(raw[3].x, raw[3].y); kr[1].w = pk2(raw[3].z, raw[3].w);
      vr[0].x = pk2(raw[4].x, raw[4].y); vr[0].y = pk2(raw[4].z, raw[4].w); vr[0].z = pk2(raw[5].x, raw[5].y); vr[0].w = pk2(raw[5].z, raw[5].w);
      vr[1].x = pk2(raw[6].x, raw[6].y); vr[1].y = pk2(raw[6].z, raw[6].w); vr[1].z = pk2(raw[7].x, raw[7].y); vr[1].w = pk2(raw[7].z, raw[7].w);
    }
    if (j + 1 < nt) ATT_ISSUE(j + 1);
    __syncthreads();
    *(uint4*)(sK + key * 128 + (((dq * 2 + 0) ^ kswz) << 4)) = kr[0];
    *(uint4*)(sK + key * 128 + (((dq * 2 + 1) ^ kswz) << 4)) = kr[1];
    {
      bf16_t* vt = (bf16_t*)sV;
      const unsigned vv[8] = {vr[0].x, vr[0].y, vr[0].z, vr[0].w, vr[1].x, vr[1].y, vr[1].z, vr[1].w};
#pragma unroll
      for (int e = 0; e < 8; ++e) {
        vt[(dq * 16 + 2 * e) * 68 + key] = (bf16_t)(vv[e] & 0xffffu);
        vt[(dq * 16 + 2 * e + 1) * 68 + key] = (bf16_t)(vv[e] >> 16);
      }
    }
    __syncthreads();
    f32x16 sacc[2];
#pragma unroll
    for (int r = 0; r < 16; ++r) { sacc[0][r] = 0.f; sacc[1][r] = 0.f; }
    const int qswz = (q >> 1) & 7;
#pragma unroll
    for (int s = 0; s < 4; ++s) {
      const int co = (((s * 2 + hh) ^ qswz) << 4);
      const bf16x8 a0 = *(const bf16x8*)(sK + q * 128 + co);
      const bf16x8 a1 = *(const bf16x8*)(sK + (32 + q) * 128 + co);
      sacc[0] = MFMA32(a0, bq[s], sacc[0]);
      sacc[1] = MFMA32(a1, bq[s], sacc[1]);
    }
    float mx = -1e30f;
#pragma unroll
    for (int sub = 0; sub < 2; ++sub)
#pragma unroll
      for (int r = 0; r < 16; ++r) {
        const int kidx = sub * 32 + (r & 3) + 8 * (r >> 2) + 4 * hh;
        float v = sacc[sub][r] * 0.125f;
        bool ok = true;
        if (MODE == 2 && isP) {
          const int kr_ = rlo + j, kc_ = kidx;
          ok = (kr_ >= rsq) && (kr_ < rsq + 8) && (kc_ >= wsq) && (kc_ < wsq + 16);
          const int bi = ok ? ((kr_ - qr + 7) * 31 + (kc_ - qc + 15)) : 0;
          v += sBias[bi];
        }
        if (MODE == 3 && isP) {
          const int kpos = lo + j * 64 + kidx, dlt = kpos - qpos;
          ok = (dlt <= 128) && (dlt >= -128) && (kpos >= 0) && (kpos < 1024);
        }
        v = ok ? v : -1e30f;
        sacc[sub][r] = v;
        mx = fmaxf(mx, v);
      }
    mx = fmaxf(mx, __shfl_xor(mx, 32));
    const float m_new = fmaxf(m_run, mx);
    const float alpha = __expf(m_run - m_new);
    float rsum = 0.f;
#pragma unroll
    for (int sub = 0; sub < 2; ++sub)
#pragma unroll
      for (int r = 0; r < 16; ++r) {
        const float v = sacc[sub][r];
        const float pv = (v > -1e29f) ? __expf(v - m_new) : 0.f;
        sacc[sub][r] = pv; rsum += pv;
      }
    rsum += __shfl_xor(rsum, 32);
    l_run = l_run * alpha + rsum; m_run = m_new;
#pragma unroll
    for (int r = 0; r < 16; ++r) { oacc[0][r] *= alpha; oacc[1][r] *= alpha; }
#pragma unroll
    for (int k4 = 0; k4 < 4; ++k4) {
      const int sub = k4 >> 1, s2 = k4 & 1;
      uint4 pbu;
      pbu.x = pk2(sacc[sub][8 * s2 + 0], sacc[sub][8 * s2 + 1]); pbu.y = pk2(sacc[sub][8 * s2 + 2], sacc[sub][8 * s2 + 3]);
      pbu.z = pk2(sacc[sub][8 * s2 + 4], sacc[sub][8 * s2 + 5]); pbu.w = pk2(sacc[sub][8 * s2 + 6], sacc[sub][8 * s2 + 7]);
      const bf16x8 pb = __builtin_bit_cast(bf16x8, pbu);
#pragma unroll
      for (int dt = 0; dt < 2; ++dt) {
        const char* vp = sV + (dt * 32 + q) * 136 + (16 * k4 + 4 * hh) * 2;
        const uint2 lo8 = *(const uint2*)vp, hi8 = *(const uint2*)(vp + 16);
        uint4 avu; avu.x = lo8.x; avu.y = lo8.y; avu.z = hi8.x; avu.w = hi8.y;
        oacc[dt] = MFMA32(__builtin_bit_cast(bf16x8, avu), pb, oacc[dt]);
      }
    }
  }
#undef ATT_ISSUE
  float scale;
  if (MODE == 1 || MODE == 3) {
    const float m_f = fmaxf(m_run, sink);
    const float e = __expf(m_run - m_f);
    scale = e / (l_run * e + __expf(sink - m_f));
  } else scale = 1.0f / l_run;
#pragma unroll
  for (int dt = 0; dt < 2; ++dt)
#pragma unroll
    for (int g4 = 0; g4 < 4; ++g4) {
      const int d = dt * 32 + 8 * g4 + 4 * hh;
      uint2 o; o.x = pk2(oacc[dt][4 * g4] * scale, oacc[dt][4 * g4 + 1] * scale); o.y = pk2(oacc[dt][4 * g4 + 2] * scale, oacc[dt][4 * g4 + 3] * scale);
      *(uint2*)(Y + (size_t)qrow * D + ocol + d) = o;
    }
  __syncthreads();
}

DEV void post_item(const Params& p, int l, int tile, char* lds) {
  const int t = tid(), r0 = tile * TOKT, c = t;
  bf16_t* sA = (bf16_t*)lds;
  float* sgo = (float*)(lds + 32 * 136 * 2);
  const bf16_t* P = (const bf16_t*)(p.ws + OFF_P);
  bf16_t* Y = (bf16_t*)(p.ws + OFF_YMIX);
  const float* Y0 = (const float*)(p.ws + OFF_YDIR); const float* Y1 = Y0 + ARRF;
  const float* H0 = (const float*)(p.ws + OFF_HDIR); const float* H1 = H0 + ARRF;
  const bf16_t* BON = (const bf16_t*)(p.ws + OFF_BONUS);
  __syncthreads();
#pragma unroll
  for (int i = 0; i < TOKT / 2; ++i) {
    const int e = t + 256 * i, tk = e >> 7, j = e & 127;
    sA[tk * 136 + j] = f2bf(sigmoidf_(bf2f(P[(size_t)(r0 + tk) * DIN + C_GH + j])));
  }
  __syncthreads();
  {
    const int lane = t & 63, w = t >> 6, q = lane & 31, hh = lane >> 5;
    bf16x8 af[8];
#pragma unroll
    for (int s = 0; s < 8; ++s) af[s] = *(const bf16x8*)(sA + q * 136 + 16 * s + 8 * hh);
    const bf16_t* GT = (const bf16_t*)(p.ws + OFF_G2T) + (size_t)l * 256 * 128;
#pragma unroll
    for (int nt = 0; nt < 2; ++nt) {
      const int n = w * 64 + nt * 32 + q;
      f32x16 acc;
#pragma unroll
      for (int r = 0; r < 16; ++r) acc[r] = 0.f;
#pragma unroll
      for (int s = 0; s < 8; ++s) acc = MFMA32(af[s], *(const bf16x8*)(GT + (size_t)n * 128 + 16 * s + 8 * hh), acc);
#pragma unroll
      for (int r = 0; r < 8; ++r) sgo[((r & 3) + 8 * (r >> 2) + 4 * hh) * 256 + n] = acc[r];
      if (hh == 0) {
#pragma unroll
        for (int r = 8; r < 12; ++r) sgo[((r & 3) + 16) * 256 + n] = acc[r];
      }
    }
  }
  __syncthreads();
  const float lnw = p.in[I_LNW][l * 256 + c], lnb = p.in[I_LNB][l * 256 + c], hgn = p.in[I_HGN][l * 256 + c];
  for (int tb = 0; tb < TOKT; tb += 5) {
    float y[5], o[5], bn[5], gv[5], hg[5];
#pragma unroll
    for (int u = 0; u < 5; ++u) {
      const int row = r0 + tb + u;
      const size_t idx = (size_t)row * 256 + c;
      y[u] = Y0[idx] + Y1[idx]; o[u] = H0[idx] + H1[idx]; bn[u] = bf2f(BON[idx]);
      gv[u] = sgo[(tb + u) * 256 + c]; hg[u] = bf2f(P[(size_t)row * DIN + C_HG + c]);
    }
#pragma unroll
    for (int u = 0; u < 5; ++u) {
      const int row = r0 + tb + u;
      const float mu = wave_sum(y[u]) * (1.0f / 64.0f);
      const float dy = y[u] - mu;
      const float var = wave_sum(dy * dy) * (1.0f / 64.0f);
      const float yn = dy * __builtin_amdgcn_rsqf(var + 64e-5f) * lnw + lnb + bn[u];
      Y[(size_t)row * D + c] = f2bf(yn * gv[u]);
      const float ms = wave_sum(o[u] * o[u]) * (1.0f / 64.0f);
      Y[(size_t)row * D + 512 + c] = f2bf(o[u] * __builtin_amdgcn_rsqf(ms + 1e-6f) * hgn * sigmoidf_(hg[u]));
    }
  }
  __syncthreads();
}

constexpr int OFF_CTR_WORD = 3600;
DEV void mixer_phase(const Params& p, int l, char* lds0, volatile LAS unsigned* st, bool rerun) {
  const int hf = half_id(); char* lds = lds0 + hf * 65536;
  const int npairs = (256 + 512 + 512) / 2;
  unsigned* ctr = (unsigned*)(p.ws + OFF_BAR) + OFF_CTR_WORD + 64 * l + (rerun ? 32 : 0);
  bool first = true;
  for (;;) {
    int pair;
    if (first) { pair = (int)blockIdx.x; first = false; }
    else {
      if (threadIdx.x == 0) st[4] = gridDim.x + __hip_atomic_fetch_add(ctr, 1u, __ATOMIC_RELAXED, __HIP_MEMORY_SCOPE_AGENT);
      __syncthreads();
      pair = (int)st[4];
      __syncthreads();
    }
    if (pair >= npairs) break;
    const int it = pair * 2 + hf;
    const bool is_scan = it < 640;
    if (rerun && PROBE_SUB == 1 && !is_scan) continue;
    if (rerun && PROBE_SUB == 2 && is_scan) continue;
    if (rerun && PROBE_SUB == 3 && !(it < 128)) continue;
    if (rerun && PROBE_SUB == 4 && !(it >= 128 && it < 640)) continue;
    if (it < 128) {
      const int idx = it >> 1; const int seq = 32 + (idx >> 5), rem = idx & 31;
      if ((it & 1) == 0) rwkv_scan16(p, l, seq, rem >> 3, (rem >> 2) & 1, rem & 3, lds);
      else hgrn_scan16(p, l, seq, rem >> 3, (rem >> 2) & 1, rem & 3, lds);
    } else if (it < 640) {
      const int idx = (it - 128) & 255; const int seq = idx >> 3, rem = idx & 7;
      if (it < 384) rwkv_scan<2>(p, l, seq, rem >> 1, rem & 1, 0, lds);
      else hgrn_scan<2>(p, l, seq, rem >> 1, rem & 1, 0, lds);
    } else if (it < 704) attn_item<3>(p, l, it - 640, lds);
    else if (it < 768) attn_item<2>(p, l, it - 704, lds);
    else if (it < 1024) attn_item<0>(p, l, it - 768, lds);
    else attn_item<1>(p, l, it - 1024, lds);
  }
}

DEV void run_phase(const Params& p, int ph, char* lds, bool rerun, volatile LAS unsigned* st) {
  if (ph == 0) { phase0(p, lds); return; }
  if (ph == 1) { row_phase(p, 0, 0); return; }
  const int l = (ph - 2) / 9, s = (ph - 2) % 9;
  const bf16_t* H = (const bf16_t*)(p.ws + OFF_H);
  const int hf = half_id(); char* ldsh = lds + hf * 65536;
  switch (s) {
    case 0: gemm_run<0>(p, l, H, (const bf16_t*)(p.ws + OFF_WIN) + (size_t)l * DINP * D, D, DINP, lds); break;
    case 1:
      for (int it = blockIdx.x * 2 + hf; it < 512 + 256; it += gridDim.x * 2) { if (it < 512) prep_item(p, l, it, ldsh); else if (!rerun) rope_item(p, it - 512); }
      break;
    case 2: mixer_phase(p, l, lds, st, rerun); break;
    case 3: for (int it = blockIdx.x * 2 + hf; it < 512; it += gridDim.x * 2) post_item(p, l, it, ldsh); break;
    case 4: gemm_run<1>(p, l, (const bf16_t*)(p.ws + OFF_YMIX), (const bf16_t*)(p.ws + OFF_WOUT) + (size_t)l * D * D, D, D, lds); break;
    case 5: row_phase(p, 1, l); break;
    case 6: gemm_run<2>(p, l, H, (const bf16_t*)(p.ws + OFF_W1) + (size_t)l * FF * D, D, FF, lds); break;
    case 7: gemm_run<1>(p, l, (const bf16_t*)(p.ws + OFF_HID), (const bf16_t*)(p.ws + OFF_W2) + (size_t)l * D * FF, FF, D, lds); break;
    case 8: row_phase(p, 2, l); break;
  }
}

#define XB_TMO      128
#define XB_XCNT(j)  (256  + 64 * (j))
#define XB_XSUB(j)  (1280 + 64 * (j))
#define XB_XGEN(j)  (2304 + 64 * (j))
#define XB_TOP      3328
#define XB_TOPGEN   3392
#define XCD_BAR_WORDS 3456
#define XB_SPIN_CAP (1u << 18)
DEV unsigned xb_ld(unsigned* p) { return __hip_atomic_load(p, __ATOMIC_RELAXED, __HIP_MEMORY_SCOPE_AGENT); }
DEV unsigned xb_add(unsigned* p, unsigned v) { return __hip_atomic_fetch_add(p, v, __ATOMIC_RELAXED, __HIP_MEMORY_SCOPE_AGENT); }
DEV unsigned xb_xcc_id() { return (unsigned)__builtin_amdgcn_s_getreg((3 << 11) | 20) & 0xFu; }
#define XB_SPIN(cond, bar) do { unsigned _sp = 0; while (cond) { __builtin_amdgcn_s_sleep(1); \
    if ((++_sp & 255u) == 0u) { if (xb_ld(&(bar)[XB_TMO])) break; if (_sp > XB_SPIN_CAP) { atomicAdd(&(bar)[XB_TMO], 1u); break; } } } } while (0)
struct XcdBarrier { unsigned* bar; unsigned x; volatile LAS unsigned* st; };
DEV XcdBarrier xcd_barrier_post(unsigned* bar, volatile LAS unsigned* st) {
  XcdBarrier b; b.bar = bar; b.x = xb_xcc_id(); b.st = st;
  if (threadIdx.x == 0) (void)xb_add(&bar[XB_XCNT(b.x)], 1u);
  return b;
}
DEV void xcd_barrier_complete(unsigned* bar, unsigned x, unsigned& nloc, unsigned& nx) {
  const unsigned G = gridDim.x * gridDim.y * gridDim.z;
  unsigned sum, cnt, mine, sp = 0u;
  for (;;) {
    sum = 0u; cnt = 0u; mine = 0u;
#pragma unroll
    for (unsigned j = 0; j < 16; ++j) { const unsigned c = xb_ld(&bar[XB_XCNT(j)]); sum += c; cnt += (c > 0u) ? 1u : 0u; mine = (j == x) ? c : mine; }
    if (sum == G) break;
    __builtin_amdgcn_s_sleep(1);
    if ((++sp & 255u) == 0u) { if (xb_ld(&bar[XB_TMO])) break; if (sp > XB_SPIN_CAP) { atomicAdd(&bar[XB_TMO], 1u); break; } }
  }
  nloc = mine > 0u ? mine : 1u; nx = cnt > 0u ? cnt : 1u;
}
DEV void xcd_barrier(const XcdBarrier& b) {
  asm volatile("s_waitcnt vmcnt(0)" ::: "memory");
  __syncthreads();
  if (threadIdx.x == 0) {
    unsigned* bar = b.bar;
    { size_t zb_; asm volatile("s_mov_b64 %0, 0" : "=s"(zb_)); bar += zb_; }
    __builtin_amdgcn_s_waitcnt(0);
    unsigned nloc = b.st[0], nx = b.st[1];
    if (nloc == 0u) { xcd_barrier_complete(bar, b.x, nloc, nx); b.st[0] = nloc; b.st[1] = nx; }
    const unsigned old = xb_add(&bar[XB_XSUB(b.x)], 1u);
    const unsigned gen = old / nloc;
    if (old + 1u == (gen + 1u) * nloc) {
      __builtin_amdgcn_fence(__ATOMIC_RELEASE, "agent");
      asm volatile("s_waitcnt vmcnt(0)" ::: "memory");
      const unsigned og = xb_add(&bar[XB_TOP], 1u);
      const unsigned tg = og / nx;
      if (og + 1u == (tg + 1u) * nx) xb_add(&bar[XB_TOPGEN], 1u);
      else XB_SPIN(xb_ld(&bar[XB_TOPGEN]) == tg, bar);
      __builtin_amdgcn_fence(__ATOMIC_ACQUIRE, "agent");
      xb_add(&bar[XB_XGEN(b.x)], 1u);
      asm volatile("s_waitcnt vmcnt(0)" ::: "memory");
    } else {
      XB_SPIN(xb_ld(&bar[XB_XGEN(b.x)]) == gen, bar);
      __builtin_amdgcn_fence(__ATOMIC_ACQUIRE, "agent");
      asm volatile("s_waitcnt vmcnt(0)" ::: "memory");
    }
  }
  __syncthreads();
}

DEV int phase_kind(int ph) {
  if (ph == 0) return 0;
  if (ph == 1) return 1;
  const int s = (ph - 2) % 9;
  return s == 0 ? 2 : s == 1 ? 3 : s == 2 ? 4 : s == 3 ? 5 : s == 4 ? 6 : s == 5 ? 1 : s == 6 ? 7 : s == 7 ? 8 : 1;
}

constexpr int LDS_BYTES = 131072 + 64;

__global__ void __launch_bounds__(512, 2) mega(Params p, int ph_lo, int ph_hi) {
  extern __shared__ __attribute__((aligned(16))) unsigned char smem[];
  char* lds = (char*)smem;
  volatile LAS unsigned* st = (volatile LAS unsigned*)((LAS unsigned char*)smem + 131072);
  if (threadIdx.x == 0) { st[0] = 0u; st[1] = 0u; }
  __syncthreads();
  XcdBarrier xb = xcd_barrier_post((unsigned*)(p.ws + OFF_BAR), st);
  if (ph_hi < 0) cg::this_grid().sync();
  char* const ws0 = p.ws; float* const out0 = p.out;
  for (int ph = ph_lo; ph < ph_hi; ++ph) {
    { size_t z0_; asm volatile("s_mov_b64 %0, 0" : "=s"(z0_)); p.ws = ws0 + z0_; p.out = out0 + z0_; }
    run_phase(p, ph, lds, false, st);
    if (PROBE_KIND >= 0 && (PROBE_KIND == 9 || phase_kind(ph) == PROBE_KIND)) {
      xcd_barrier(xb);
      if (PROBE_KIND != 9) run_phase(p, ph, lds, true, st);
    }
    if (ph + 1 < ph_hi) xcd_barrier(xb);
  }
}

extern "C" void kernel_launch(void* const* d_in, const int* in_sizes, int n_in, void* d_out, int out_size, void* d_ws, size_t ws_size,
                              hipStream_t stream) {
  static int grid_blocks = 0;
  if (!grid_blocks) {
    int dev = 0, cus = 0, per_cu = 0;
    (void)hipGetDevice(&dev);
    (void)hipDeviceGetAttribute(&cus, hipDeviceAttributeMultiprocessorCount, dev);
    if (hipFuncSetAttribute((const void*)mega, hipFuncAttributeMaxDynamicSharedMemorySize, LDS_BYTES) != hipSuccess) fprintf(stderr, "hipFuncSetAttribute failed\n");
    (void)hipOccupancyMaxActiveBlocksPerMultiprocessor(&per_cu, mega, 512, LDS_BYTES);
    if (per_cu < 1) fprintf(stderr, "occupancy query reports %d blocks per CU\n", per_cu);
    (void)hipGetLastError();
    grid_blocks = cus;
  }
  if (ws_size < WS_TOTAL) { fprintf(stderr, "workspace too small: %zu < %zu\n", ws_size, (size_t)WS_TOTAL); return; }
  Params p{};
  for (int i = 0; i < 31; ++i) p.in[i] = (const float*)d_in[i];
  p.out = (float*)d_out;
  p.ws = (char*)d_ws;
  (void)hipMemsetAsync((char*)d_ws + OFF_BAR, 0, 16384, stream);
  int lo = 0, hi = NPH;
  void* args[] = {&p, &lo, &hi};
  hipError_t e = hipLaunchCooperativeKernel((void*)mega, dim3(grid_blocks), dim3(512), args, LDS_BYTES, stream);
  if (e != hipSuccess) fprintf(stderr, "cooperative launch failed: %s (grid %d)\n", hipGetErrorString(e), grid_blocks);
}
```

```cpp
#include <hip/hip_runtime.h>
#include <hip/hip_cooperative_groups.h>
#include <cstdio>
#include <cstdint>
namespace cg = cooperative_groups;

#ifndef ONE_LAUNCH
#define ONE_LAUNCH 1
#endif
#define PROBE_KIND -1
#define PROBE_SUB 0

#define DEV __device__ __forceinline__
#define LAS __attribute__((address_space(3)))
typedef unsigned short bf16_t;
typedef short bf16x8 __attribute__((ext_vector_type(8)));
typedef float f32x16 __attribute__((ext_vector_type(16)));
typedef __bf16 bf2_t __attribute__((ext_vector_type(2)));
typedef float f2_t __attribute__((ext_vector_type(2)));

constexpr int D = 1024, DIN = 3712, FF = 4096, NCTX = 8192, MT = 10240;
constexpr int NPH = 38;
constexpr int DINP = 3840;
constexpr int C_R = 0, C_K = 256, C_V = 512, C_GH = 768, C_WHF = 896, C_WHB = 1024;
constexpr int C_NQ = 1152, C_NK = 1408, C_NV = 1664;
constexpr int C_HQ = 1920, C_HI = 2176, C_HG = 2432, C_HFF = 2688, C_HFB = 2944;
constexpr int C_SQ = 3200, C_SK = 3456, C_SV = 3584;
constexpr size_t O_NAT = 10485760, O_SWA = 27262976, O_RW = 35651584, O_HG = 39845888;
constexpr size_t ARRF = (size_t)MT * 256;
constexpr size_t ARR = ARRF * 4;
constexpr size_t OFF_WIN = 0;
constexpr size_t OFF_WOUT = OFF_WIN + (size_t)4 * DINP * D * 2;
constexpr size_t OFF_W1 = OFF_WOUT + (size_t)4 * D * D * 2;
constexpr size_t OFF_W2 = OFF_W1 + (size_t)4 * FF * D * 2;
constexpr size_t OFF_MOD = OFF_W2 + (size_t)4 * FF * D * 2;
constexpr size_t OFF_HGLB = OFF_MOD + (size_t)4 * 3 * 6144 * 4;
constexpr size_t OFF_P = OFF_HGLB + 8192;
constexpr size_t OFF_R1 = OFF_P + (size_t)MT * DIN * 2;
constexpr size_t OFF_H = OFF_R1;
constexpr size_t OFF_HID = OFF_H + (size_t)MT * D * 2;
constexpr size_t OFF_U = OFF_HID + (size_t)MT * FF * 2;
constexpr size_t OFF_PREP = OFF_R1;
constexpr size_t OFF_YDIR = OFF_PREP + 12 * ARR;
constexpr size_t OFF_BONUS = OFF_R1 + 14 * ARR;
constexpr size_t OFF_HDIR = OFF_BONUS + ARR / 2;
constexpr size_t OFF_YMIX = OFF_HDIR + 2 * ARR;
constexpr size_t OFF_X16 = OFF_YMIX + (size_t)MT * D * 2;
constexpr size_t OFF_BAR = OFF_X16 + (size_t)MT * D * 2;
constexpr size_t OFF_W2T = OFF_BAR + 16384;
constexpr size_t OFF_A2T = OFF_W2T + (size_t)4 * 2 * 256 * 64 * 2;
constexpr size_t OFF_G2T = OFF_A2T + (size_t)4 * 2 * 256 * 64 * 2;
constexpr size_t WS_TOTAL = OFF_G2T + (size_t)4 * 256 * 128 * 2;
static_assert(OFF_U + (size_t)MT * D * 4 == OFF_BONUS, "R1 layout");

struct Params {
  const float* in[31];
  float* out;
  char* ws;
};
enum { I_XP = 0, I_XS, I_CNAT, I_CSWA, I_SRW, I_SHG, I_C, I_CCTX, I_NORMG, I_MODW, I_MODB, I_WIN, I_WOUT, I_MURKV, I_MULORA,
       I_W0, I_W2, I_A0, I_A2, I_G2, I_KK, I_KA, I_RK, I_LNW, I_LNB, I_RPB, I_HGLB, I_HGN, I_SINK, I_FW1, I_FW2 };


DEV float bf2f(bf16_t h) { return __uint_as_float(((unsigned)h) << 16); }
DEV unsigned pk2(float a, float b) { f2_t v = {a, b}; bf2_t r = __builtin_convertvector(v, bf2_t); return __builtin_bit_cast(unsigned, r); }
DEV bf16_t f2bf(float f) { return (bf16_t)(pk2(f, f) & 0xffffu); }
DEV float4 bf4(uint2 u) { return make_float4(__uint_as_float(u.x << 16), __uint_as_float(u.x & 0xffff0000u), __uint_as_float(u.y << 16), __uint_as_float(u.y & 0xffff0000u)); }
DEV float bflo(unsigned u) { return __uint_as_float(u << 16); }
DEV float bfhi(unsigned u) { return __uint_as_float(u & 0xffff0000u); }
DEV float rcpf_(float x) { return __builtin_amdgcn_rcpf(x); }
DEV float sigmoidf_(float x) { return rcpf_(1.0f + __expf(-x)); }
DEV float tanhf_(float x) { return 1.0f - 2.0f * rcpf_(1.0f + __expf(2.0f * x)); }
template <int CTRL> DEV float dppf(float x) { return __int_as_float(__builtin_amdgcn_update_dpp(0, __float_as_int(x), CTRL, 0xF, 0xF, false)); }
DEV float row16_sum(float x) { x += dppf<0xB1>(x); x += dppf<0x4E>(x); x += dppf<0x141>(x); x += dppf<0x140>(x); return x; }
DEV float wave_sum(float x) { x = row16_sum(x); x += __shfl_xor(x, 16); x += __shfl_xor(x, 32); return x; }
DEV int clampi(int v, int lo, int hi) { return v < lo ? lo : (v > hi ? hi : v); }
#define MFMA32(a, b, c) __builtin_amdgcn_mfma_f32_32x32x16_bf16((a), (b), (c), 0, 0, 0)

DEV int tid() { int z; asm volatile("v_mov_b32 %0, 0" : "=v"(z)); return (int)(threadIdx.x & 255u) + z; }
DEV int half_id() { return __builtin_amdgcn_readfirstlane((int)(threadIdx.x >> 8)); }
DEV void transpose_item(const float* W, bf16_t* WT, int K, int N, int kt, int nt, char* lds) {
  bf16_t* s = (bf16_t*)lds;
  const int t = tid();
#pragma unroll
  for (int i = 0; i < 4; ++i) {
    const int k = (t >> 4) + 16 * i, n4 = (t & 15) * 4;
    const float4 v = *(const float4*)(W + (size_t)(kt * 64 + k) * N + nt * 64 + n4);
    s[(n4 + 0) * 72 + k] = f2bf(v.x); s[(n4 + 1) * 72 + k] = f2bf(v.y);
    s[(n4 + 2) * 72 + k] = f2bf(v.z); s[(n4 + 3) * 72 + k] = f2bf(v.w);
  }
  __syncthreads();
#pragma unroll
  for (int i = 0; i < 2; ++i) {
    const int n = (t >> 3) + 32 * i, kc = t & 7;
    const uint4 v = *(const uint4*)(s + n * 72 + kc * 8);
    *(uint4*)(WT + (size_t)(nt * 64 + n) * K + kt * 64 + kc * 8) = v;
  }
  __syncthreads();
}

DEV void mod_item(const Params& p, int l, int jb, char* lds) {
  float* sc = (float*)lds;
  float* red = (float*)(lds + 12288);
  const int t = tid();
  for (int i = t; i < 3072; i += 256) {
    const int c = i >> 10, k = i & 1023;
    const float x = (c == 0) ? p.in[I_CCTX][k] : p.in[I_C][(c - 1) * 1024 + k];
    sc[i] = x * rcpf_(1.0f + __expf(-x));
  }
  __syncthreads();
  const int c4 = t & 15, ks = t >> 4;
  const float* wp = p.in[I_MODW] + ((size_t)l * 1024 + ks * 64) * 6144 + jb * 64 + c4 * 4;
  float a00 = 0, a01 = 0, a02 = 0, a03 = 0, a10 = 0, a11 = 0, a12 = 0, a13 = 0, a20 = 0, a21 = 0, a22 = 0, a23 = 0;
#pragma unroll 16
  for (int ii = 0; ii < 64; ++ii) {
    const float4 w = *(const float4*)(wp + (size_t)ii * 6144);
    const int k = ks * 64 + ii;
    const float s0 = sc[k], s1 = sc[1024 + k], s2 = sc[2048 + k];
    a00 += s0 * w.x; a01 += s0 * w.y; a02 += s0 * w.z; a03 += s0 * w.w;
    a10 += s1 * w.x; a11 += s1 * w.y; a12 += s1 * w.z; a13 += s1 * w.w;
    a20 += s2 * w.x; a21 += s2 * w.y; a22 += s2 * w.z; a23 += s2 * w.w;
  }
  float* r0 = red + (ks * 3 + 0) * 64 + c4 * 4; r0[0] = a00; r0[1] = a01; r0[2] = a02; r0[3] = a03;
  float* r1 = red + (ks * 3 + 1) * 64 + c4 * 4; r1[0] = a10; r1[1] = a11; r1[2] = a12; r1[3] = a13;
  float* r2 = red + (ks * 3 + 2) * 64 + c4 * 4; r2[0] = a20; r2[1] = a21; r2[2] = a22; r2[3] = a23;
  __syncthreads();
  if (t < 192) {
    const int c = t >> 6, col = t & 63;
    float v = p.in[I_MODB][l * 6144 + jb * 64 + col];
#pragma unroll
    for (int k2 = 0; k2 < 16; ++k2) v += red[(k2 * 3 + c) * 64 + col];
    ((float*)(p.ws + OFF_MOD))[(size_t)(l * 3 + c) * 6144 + jb * 64 + col] = v;
  }
  __syncthreads();
}

DEV void hglb_item(const Params& p) {
  const int c = tid();
  float* HGLB = (float*)(p.ws + OFF_HGLB);
  for (int dir = 0; dir < 2; ++dir) {
    float x[4], mx = -1e30f;
    for (int l = 0; l < 4; ++l) { x[l] = p.in[I_HGLB][(dir * 4 + l) * 256 + c]; mx = fmaxf(mx, x[l]); }
    float s = 0;
    for (int l = 0; l < 4; ++l) { x[l] = __expf(x[l] - mx); s += x[l]; }
    float cum = 0; const float s0 = x[0] / s;
    for (int l = 0; l < 4; ++l) { cum += x[l] / s; HGLB[(l * 2 + dir) * 256 + c] = cum - s0; }
  }
}

constexpr int NT_LAYER = 928 + 256 + 1024 + 1024;
struct TileDesc { const float* W; bf16_t* WT; int K, N, kt, nt; };
DEV TileDesc layer_tile_desc(const Params& p, int l, int j) {
  TileDesc d;
  if (j < 928) { d.W = p.in[I_WIN] + (size_t)l * D * DIN; d.WT = (bf16_t*)(p.ws + OFF_WIN) + (size_t)l * DINP * D; d.K = D; d.N = DIN; d.kt = j / 58; d.nt = j % 58; return d; }
  j -= 928;
  if (j < 256) { d.W = p.in[I_WOUT] + (size_t)l * D * D; d.WT = (bf16_t*)(p.ws + OFF_WOUT) + (size_t)l * D * D; d.K = D; d.N = D; d.kt = j / 16; d.nt = j % 16; return d; }
  j -= 256;
  if (j < 1024) { d.W = p.in[I_FW1] + (size_t)l * D * FF; d.WT = (bf16_t*)(p.ws + OFF_W1) + (size_t)l * FF * D; d.K = D; d.N = FF; d.kt = j / 64; d.nt = j % 64; return d; }
  j -= 1024;
  d.W = p.in[I_FW2] + (size_t)l * FF * D; d.WT = (bf16_t*)(p.ws + OFF_W2) + (size_t)l * D * FF; d.K = FF; d.N = D; d.kt = j / 16; d.nt = j % 16; return d;
}
DEV void tile_load(const TileDesc& d, float4 (&v)[4]) {
  const int t = tid();
#pragma unroll
  for (int i = 0; i < 4; ++i) v[i] = *(const float4*)(d.W + (size_t)(d.kt * 64 + (t >> 4) + 16 * i) * d.N + d.nt * 64 + (t & 15) * 4);
}
DEV void tile_store(const TileDesc& d, const float4 (&v)[4], char* lds) {
  bf16_t* s = (bf16_t*)lds;
  const int t = tid();
#pragma unroll
  for (int i = 0; i < 4; ++i) {
    const int k = (t >> 4) + 16 * i, n4 = (t & 15) * 4;
    s[(n4 + 0) * 72 + k] = f2bf(v[i].x); s[(n4 + 1) * 72 + k] = f2bf(v[i].y);
    s[(n4 + 2) * 72 + k] = f2bf(v[i].z); s[(n4 + 3) * 72 + k] = f2bf(v[i].w);
  }
  __syncthreads();
#pragma unroll
  for (int i = 0; i < 2; ++i) {
    const int n = (t >> 3) + 32 * i, kc = t & 7;
    const uint4 o = *(const uint4*)(s + n * 72 + kc * 8);
    *(uint4*)(d.WT + (size_t)(d.nt * 64 + n) * d.K + d.kt * 64 + kc * 8) = o;
  }
  __syncthreads();
}
DEV void layer_tiles(const Params& p, int l, int lo, int hi, int vb, int nvb, char* lds0) {
  const int hf = half_id(); char* lds = lds0 + hf * 65536;
  int it = lo + vb * 2 + hf;
  if (it >= hi) return;
  float4 vn[4];
  TileDesc dn = layer_tile_desc(p, l, it);
  tile_load(dn, vn);
  for (; it < hi; it += nvb * 2) {
    float4 vc[4] = {vn[0], vn[1], vn[2], vn[3]};
    const TileDesc dc = dn;
    if (it + nvb * 2 < hi) { dn = layer_tile_desc(p, l, it + nvb * 2); tile_load(dn, vn); }
    tile_store(dc, vc, lds);
  }
}

DEV void phase0(const Params& p, char* lds0) {
  const int hf = half_id(); char* lds = lds0 + hf * 65536;
  const int nitems = 386 + 4 + 20;
  for (int it = blockIdx.x * 2 + hf; it < nitems; it += gridDim.x * 2) {
    if (it < 384) { mod_item(p, it / 96, it % 96, lds); continue; }
    if (it == 384) { hglb_item(p); continue; }
    if (it == 385) continue;
    const int j = it - 386;
    if (j >= 4) {
      const int s = j - 4, n = tid();
      const float* src; bf16_t* dst; int KK;
      if (s < 8) { src = p.in[I_W2] + (size_t)s * 64 * 256; dst = (bf16_t*)(p.ws + OFF_W2T) + (size_t)s * 256 * 64; KK = 64; }
      else if (s < 16) { src = p.in[I_A2] + (size_t)(s - 8) * 64 * 256; dst = (bf16_t*)(p.ws + OFF_A2T) + (size_t)(s - 8) * 256 * 64; KK = 64; }
      else { src = p.in[I_G2] + (size_t)(s - 16) * 128 * 256; dst = (bf16_t*)(p.ws + OFF_G2T) + (size_t)(s - 16) * 256 * 128; KK = 128; }
      for (int k0 = 0; k0 < KK; k0 += 32) {
        float v[32];
#pragma unroll
        for (int e = 0; e < 32; ++e) v[e] = src[(size_t)(k0 + e) * 256 + n];
#pragma unroll
        for (int q4 = 0; q4 < 4; ++q4) {
          uint4 o; o.x = pk2(v[8 * q4], v[8 * q4 + 1]); o.y = pk2(v[8 * q4 + 2], v[8 * q4 + 3]); o.z = pk2(v[8 * q4 + 4], v[8 * q4 + 5]); o.w = pk2(v[8 * q4 + 6], v[8 * q4 + 7]);
          *(uint4*)(dst + (size_t)n * KK + k0 + 8 * q4) = o;
        }
      }
      continue;
    }
    {
      uint4* z = (uint4*)((bf16_t*)(p.ws + OFF_WIN) + ((size_t)j * DINP + DIN) * D);
      const int t = tid();
      for (int i = t; i < 128 * D * 2 / 16; i += 256) z[i] = make_uint4(0u, 0u, 0u, 0u);
    }
  }
  const int vb = ((int)blockIdx.x + (int)gridDim.x - 195 % (int)gridDim.x) % (int)gridDim.x;
  layer_tiles(p, 0, 0, NT_LAYER, vb, (int)gridDim.x, lds0);
  if ((int)gridDim.x <= 160) { for (int ll = 1; ll < 4; ++ll) layer_tiles(p, ll, 0, NT_LAYER, (int)blockIdx.x, (int)gridDim.x, lds0); }
}

constexpr int RPW = 5;
DEV void row_phase(const Params& p, int mode, int l) {
  const int lane = tid() & 63;
  const int nw = gridDim.x * 8;
  const float* MOD = (const float*)(p.ws + OFF_MOD);
  const float* NG = p.in[I_NORMG];
  const bf16_t* U = (const bf16_t*)(p.ws + OFF_U);
  bf16_t* H = (bf16_t*)(p.ws + OFF_H);
  bf16_t* X16 = (bf16_t*)(p.ws + OFF_X16);
  const bool has_next = !(mode == 2 && l == 3);
  const int ln = (mode == 0) ? 0 : (mode == 1 ? l : l + 1);
  const int gi = (mode == 1) ? 2 : 0, shi = (mode == 1) ? 3 : 0, sci = (mode == 1) ? 4 : 1;
  const float* ga = NG + (size_t)(l * 4 + (mode == 1 ? 1 : 3)) * 1024;
  const float* gb = NG + (size_t)((has_next ? ln : 0) * 4 + gi) * 1024;
  for (int rowa = blockIdx.x * 8 + half_id() * 4 + (tid() >> 6); rowa < MT; rowa += RPW * nw) {
    float4 x[RPW][4]; uint2 ub[RPW][4];
    int rows[RPW]; bool ok[RPW];
#pragma unroll
    for (int q = 0; q < RPW; ++q) {
      rows[q] = rowa + q * nw; ok[q] = rows[q] < MT;
      const int row = ok[q] ? rows[q] : rowa;
      if (mode == 0) {
        const float* src = row < NCTX ? p.in[I_XP] + (size_t)row * D : p.in[I_XS] + (size_t)(row - NCTX) * D;
#pragma unroll
        for (int i = 0; i < 4; ++i) x[q][i] = *(const float4*)(src + i * 256 + lane * 4);
      } else {
#pragma unroll
        for (int i = 0; i < 4; ++i) {
          const uint2 xb = *(const uint2*)(X16 + (size_t)row * D + i * 256 + lane * 4);
          x[q][i] = make_float4(bflo(xb.x), bfhi(xb.x), bflo(xb.y), bfhi(xb.y));
          ub[q][i] = *(const uint2*)(U + (size_t)row * D + i * 256 + lane * 4);
        }
      }
    }
#pragma unroll
    for (int q = 0; q < RPW; ++q) {
      const int row = ok[q] ? rows[q] : rowa;
      const int cond = row < NCTX ? 0 : 1 + ((row - NCTX) >> 10);
      if (mode != 0) {
        float4 u[4];
        float ss = 0;
#pragma unroll
        for (int i = 0; i < 4; ++i) {
          u[i] = make_float4(bflo(ub[q][i].x), bfhi(ub[q][i].x), bflo(ub[q][i].y), bfhi(ub[q][i].y));
          ss += u[i].x * u[i].x + u[i].y * u[i].y + u[i].z * u[i].z + u[i].w * u[i].w;
        }
        ss = wave_sum(ss);
        const float r = __builtin_amdgcn_rsqf(ss * (1.0f / 1024.0f) + 1e-6f);
        const float* gate = MOD + (size_t)(l * 3 + cond) * 6144 + (mode == 1 ? 2 : 5) * 1024;
#pragma unroll
        for (int i = 0; i < 4; ++i) {
          const float4 g4 = *(const float4*)(gate + i * 256 + lane * 4);
          const float4 a4 = *(const float4*)(ga + i * 256 + lane * 4);
          x[q][i].x += g4.x * (u[i].x * r * a4.x); x[q][i].y += g4.y * (u[i].y * r * a4.y);
          x[q][i].z += g4.z * (u[i].z * r * a4.z); x[q][i].w += g4.w * (u[i].w * r * a4.w);
        }
      }
      if (ok[q]) {
        if (has_next) {
#pragma unroll
          for (int i = 0; i < 4; ++i) { uint2 o; o.x = pk2(x[q][i].x, x[q][i].y); o.y = pk2(x[q][i].z, x[q][i].w); *(uint2*)(X16 + (size_t)row * D + i * 256 + lane * 4) = o; }
        } else {
#pragma unroll
          for (int i = 0; i < 4; ++i) *(float4*)(p.out + (size_t)row * D + i * 256 + lane * 4) = x[q][i];
        }
      }
      if (has_next) {
        float ss = 0;
#pragma unroll
        for (int i = 0; i < 4; ++i) ss += x[q][i].x * x[q][i].x + x[q][i].y * x[q][i].y + x[q][i].z * x[q][i].z + x[q][i].w * x[q][i].w;
        ss = wave_sum(ss);
        const float r2 = __builtin_amdgcn_rsqf(ss * (1.0f / 1024.0f) + 1e-6f);
        const float* sh = MOD + (size_t)(ln * 3 + cond) * 6144 + shi * 1024;
        const float* sc = MOD + (size_t)(ln * 3 + cond) * 6144 + sci * 1024;
        if (ok[q]) {
#pragma unroll
          for (int i = 0; i < 4; ++i) {
            const float4 g4 = *(const float4*)(gb + i * 256 + lane * 4);
            const float4 s4 = *(const float4*)(sc + i * 256 + lane * 4);
            const float4 h4 = *(const float4*)(sh + i * 256 + lane * 4);
            const float h0 = x[q][i].x * r2 * g4.x * (1.0f + s4.x) + h4.x;
            const float h1 = x[q][i].y * r2 * g4.y * (1.0f + s4.y) + h4.y;
            const float h2 = x[q][i].z * r2 * g4.z * (1.0f + s4.z) + h4.z;
            const float h3 = x[q][i].w * r2 * g4.w * (1.0f + s4.w) + h4.w;
            uint2 o; o.x = pk2(h0, h1); o.y = pk2(h2, h3);
            *(uint2*)(H + (size_t)row * D + i * 256 + lane * 4) = o;
          }
        }
      }
    }
  }
}

namespace pg8 {
#define PG8_LAS __attribute__((address_space(3)))
typedef unsigned short bf16_t;
typedef short bf16x8 __attribute__((ext_vector_type(8)));
typedef float f32x4 __attribute__((ext_vector_type(4)));
typedef unsigned u32x4 __attribute__((ext_vector_type(4)));
constexpr int BM = 256, BK = 64, HALF = 128, HTB = HALF * BK * 2  , STAGE_BYTES = 8 * HTB, NXCD = 8, WGM = 8;

__host__ __device__ __forceinline__ int lds_byte(int r, int c) { const int st = (r >> 4) * 2 + (c >> 5), rr = r & 15, cc = c & 31, ob = rr * 64 + cc * 2; return st * 1024 + (ob ^ (((ob >> 9) & 1) << 5)); }
__host__ __device__ __forceinline__ void stage_rc(int b, int& R, int& C) { const int st = b / 1024, sb = b % 1024, swz = sb ^ (((sb >> 9) & 1) << 5); R = (st >> 1) * 16 + swz / 64; C = (st & 1) * 32 + (swz % 64) / 2; }
__host__ __device__ __forceinline__ int perm32(int rho) { const int n = rho >> 4, i = rho & 15; return 8 * (i >> 2) + 4 * n + (i & 3); }

struct Unit { int pm, pn; };
struct Gemm { const bf16_t* A; const bf16_t* Bt; int M, N, K; };

struct StaticOrder {
    int nM, nN, nwg, G, c;
    __host__ __device__ void init(int M, int N, int G_, int c_) { nM = M / BM; nN = N / BM; nwg = nM * nN; G = G_; c = c_; }
    __host__ __device__ bool next(int i, Unit& u) const {
        const long L = (long)i * G + c; if (L >= nwg) return false;
        int wgid = (int)L; { const int q = nwg / NXCD, r = nwg % NXCD, xcd = wgid % NXCD, off = wgid / NXCD; wgid = (xcd < r ? xcd * (q + 1) : r * (q + 1) + (xcd - r) * q) + off; }
        const int nig = WGM * nN, gid = wgid / nig, fm = gid * WGM, gsz = (nM - fm) < WGM ? (nM - fm) : WGM;
        u.pm = fm + ((wgid % nig) % gsz); u.pn = (wgid % nig) / gsz; return true;
    }
    __device__ __forceinline__ void a_ready(const Unit&) const {}
    __device__ __forceinline__ void done(const Unit&) const {}
};

template <class Epi, class Sched, bool ALIGN_EPI = false, bool SP2 = false>
__device__ __forceinline__ void gemm_phase(PG8_LAS unsigned char* lds, const Gemm g, const Sched& S, const Epi& E) {
    int tid_z; asm volatile("v_mov_b32 %0, 0" : "=v"(tid_z)); const int tid = (int)threadIdx.x + tid_z, wid = __builtin_amdgcn_readfirstlane(tid >> 6), lane = tid & 63, wr = wid >> 2, wc = wid & 3, fr = lane & 15, fq = lane >> 4;
    const int K = g.K, nt = K / BK;
    unsigned voffA[2], voffB[2];
#pragma unroll
    for (int i = 0; i < 2; ++i) { int R, C; stage_rc(tid * 16 + i * 8192, R, C); const int Rb = Epi::PERM ? ((R & ~31) + perm32(R & 31)) : R;
        voffA[i] = (unsigned)(R * K + C) * 2u; voffB[i] = (unsigned)(Rb * K + C) * 2u; }
    const size_t kstep = (size_t)(BK * 2);
    const size_t hstep = (size_t)HALF * K * 2;
    const size_t tstep = 2 * hstep;
    const unsigned ldsw = (unsigned)wid * 1024u;
    const int aoff = lds_byte(wr * 64 + fr, fq * 8), boff = lds_byte(wc * 32 + fr, fq * 8);
#define PG8_SA(b, h) (((b) * 2 + (h)) * HTB)
#define PG8_SB(b, h) ((4 + (b) * 2 + (h)) * HTB)
#define PG8_STAGE(bufoff, gbase, voff) do { _Pragma("unroll") for (int _i = 0; _i < 2; ++_i) \
        __builtin_amdgcn_global_load_lds((const unsigned*)((const char*)(gbase) + (voff)[_i]), (PG8_LAS unsigned*)(lds + (bufoff) + ldsw + _i * 8192), 16, 0, 0); } while (0)
#define PG8_LDA(dst, b, h) do { _Pragma("unroll") for (int m = 0; m < 4; ++m) _Pragma("unroll") for (int k = 0; k < 2; ++k) dst[m][k] = *(const PG8_LAS bf16x8*)(lds + PG8_SA(b, h) + aoff + m * 2048 + k * 1024); } while (0)
#define PG8_LDB(dst, b, h) do { _Pragma("unroll") for (int n = 0; n < 2; ++n) _Pragma("unroll") for (int k = 0; k < 2; ++k) dst[n][k] = *(const PG8_LAS bf16x8*)(lds + PG8_SB(b, h) + boff + n * 2048 + k * 1024); } while (0)
#define PG8_MMA(ai, bj, At, Bt) do { __builtin_amdgcn_s_setprio(1); _Pragma("unroll") for (int m = 0; m < 4; ++m) _Pragma("unroll") for (int n = 0; n < 2; ++n) _Pragma("unroll") for (int k = 0; k < 2; ++k) \
        acc[ai][bj][m][n] = __builtin_amdgcn_mfma_f32_16x16x32_bf16(Bt[n][k], At[m][k], acc[ai][bj][m][n], 0, 0, 0); __builtin_amdgcn_s_setprio(0); } while (0)
#define PG8_WAIT_V(n) asm volatile("s_waitcnt vmcnt(" #n ")" ::: "memory")
#define PG8_WAIT_L(n) asm volatile("s_waitcnt lgkmcnt(" #n ")" ::: "memory")
#define PG8_BAR __builtin_amdgcn_s_barrier()
#define PG8_SCHED __builtin_amdgcn_sched_barrier(0)
    Unit cur, nxt; int ui = 0;
    if (!S.next(0, cur)) return;
    f32x4 acc[2][2][4][2];
#pragma unroll
    for (int a = 0; a < 2; ++a)
#pragma unroll
        for (int b = 0; b < 2; ++b)
#pragma unroll
            for (int m = 0; m < 4; ++m)
#pragma unroll
                for (int n = 0; n < 2; ++n) acc[a][b][m][n] = (f32x4){0.f, 0.f, 0.f, 0.f};
    bf16x8 At[4][2], B0[2][2], B1[2][2];
    const char* cA = (const char*)g.A + (size_t)cur.pm * tstep; const char* cB = (const char*)g.Bt + (size_t)cur.pn * tstep;
    S.a_ready(cur);
    if constexpr (SP2) {
        PG8_STAGE(PG8_SB(0, 0), cB, voffB); PG8_STAGE(PG8_SB(0, 1), cB + hstep, voffB); PG8_STAGE(PG8_SA(0, 0), cA, voffA); PG8_STAGE(PG8_SA(0, 1), cA + hstep, voffA);
        if (wr == 1) PG8_BAR;
        PG8_WAIT_V(2); PG8_BAR;
        PG8_STAGE(PG8_SB(1, 0), cB + kstep, voffB); PG8_STAGE(PG8_SA(1, 0), cA + kstep, voffA); PG8_STAGE(PG8_SB(1, 1), cB + hstep + kstep, voffB);
        PG8_WAIT_V(6); PG8_BAR;
    } else {
        PG8_STAGE(PG8_SB(0, 0), cB, voffB); PG8_STAGE(PG8_SA(0, 0), cA, voffA); PG8_STAGE(PG8_SB(0, 1), cB + hstep, voffB); PG8_STAGE(PG8_SA(0, 1), cA + hstep, voffA);
        if (wr == 1) PG8_BAR;
        PG8_WAIT_V(4); PG8_BAR;
        PG8_STAGE(PG8_SB(1, 0), cB + kstep, voffB); PG8_STAGE(PG8_SA(1, 0), cA + kstep, voffA); PG8_STAGE(PG8_SB(1, 1), cB + hstep + kstep, voffB);
        PG8_WAIT_V(6); PG8_BAR;
    }
    for (;;) {
        const bool has_next = S.next(ui + 1, nxt);
        const char* nA = has_next ? (const char*)g.A + (size_t)nxt.pm * tstep : cA; const char* nB = has_next ? (const char*)g.Bt + (size_t)nxt.pn * tstep : cB;
        for (int t = 0; t < nt; t += 2) {
            const bool last = (t == nt - 2);
            const char* a1 = cA + (size_t)(t + 1) * kstep;
            const char* a2 = last ? nA : cA + (size_t)(t + 2) * kstep; const char* b2 = last ? nB : cB + (size_t)(t + 2) * kstep;
            const char* a3 = a2 + kstep; const char* b3 = b2 + kstep;
            if (last && has_next) S.a_ready(nxt);
            if constexpr (SP2) {
            PG8_LDB(B0, 0, 0); PG8_LDB(B1, 0, 1); PG8_SCHED; PG8_LDA(At, 0, 0); PG8_STAGE(PG8_SA(1, 1), a1 + hstep, voffA);
            PG8_WAIT_V(8); PG8_WAIT_L(0); PG8_BAR; PG8_MMA(0, 0, At, B0); PG8_MMA(0, 1, At, B1); PG8_BAR; PG8_SCHED;
            PG8_LDA(At, 0, 1); PG8_STAGE(PG8_SB(0, 0), b2, voffB); PG8_STAGE(PG8_SB(0, 1), b2 + hstep, voffB); PG8_STAGE(PG8_SA(0, 0), a2, voffA);
            PG8_WAIT_V(8); PG8_WAIT_L(0); PG8_BAR; PG8_MMA(1, 0, At, B0); PG8_MMA(1, 1, At, B1); PG8_BAR; PG8_SCHED;
            PG8_LDB(B0, 1, 0); PG8_LDB(B1, 1, 1); PG8_SCHED; PG8_LDA(At, 1, 0); PG8_STAGE(PG8_SA(0, 1), a2 + hstep, voffA);
            PG8_WAIT_V(8); PG8_WAIT_L(0); PG8_BAR; PG8_MMA(0, 0, At, B0); PG8_MMA(0, 1, At, B1); PG8_BAR; PG8_SCHED;
            PG8_LDA(At, 1, 1); PG8_STAGE(PG8_SB(1, 0), b3, voffB); PG8_STAGE(PG8_SB(1, 1), b3 + hstep, voffB); PG8_STAGE(PG8_SA(1, 0), a3, voffA);
            PG8_WAIT_V(8); PG8_WAIT_L(0); PG8_BAR; PG8_MMA(1, 0, At, B0); PG8_MMA(1, 1, At, B1); PG8_BAR; PG8_SCHED;
            } else {
            PG8_LDB(B0, 0, 0); PG8_SCHED; PG8_LDA(At, 0, 0); PG8_STAGE(PG8_SA(1, 1), a1 + hstep, voffA);
            PG8_WAIT_L(8); PG8_BAR; PG8_WAIT_L(0); PG8_MMA(0, 0, At, B0); PG8_BAR; PG8_SCHED;
            PG8_LDB(B1, 0, 1); PG8_STAGE(PG8_SB(0, 0), b2, voffB);
            PG8_BAR; PG8_WAIT_L(0); PG8_MMA(0, 1, At, B1); PG8_BAR;
            PG8_LDA(At, 0, 1); PG8_STAGE(PG8_SA(0, 0), a2, voffA);
            PG8_BAR; PG8_WAIT_L(0); PG8_MMA(1, 0, At, B0); PG8_BAR; PG8_SCHED;
            PG8_STAGE(PG8_SB(0, 1), b2 + hstep, voffB);
            PG8_WAIT_V(6); PG8_BAR; PG8_MMA(1, 1, At, B1); PG8_BAR;
            PG8_LDB(B0, 1, 0); PG8_SCHED; PG8_LDA(At, 1, 0); PG8_STAGE(PG8_SA(0, 1), a2 + hstep, voffA);
            PG8_WAIT_L(8); PG8_BAR; PG8_WAIT_L(0); PG8_MMA(0, 0, At, B0); PG8_BAR; PG8_SCHED;
            PG8_LDB(B1, 1, 1); PG8_STAGE(PG8_SB(1, 0), b3, voffB);
            PG8_BAR; PG8_WAIT_L(0); PG8_MMA(0, 1, At, B1); PG8_BAR;
            PG8_LDA(At, 1, 1); PG8_STAGE(PG8_SA(1, 0), a3, voffA);
            PG8_BAR; PG8_WAIT_L(0); PG8_MMA(1, 0, At, B0); PG8_BAR; PG8_SCHED;
            PG8_STAGE(PG8_SB(1, 1), b3 + hstep, voffB);
            PG8_WAIT_V(6); PG8_BAR; PG8_MMA(1, 1, At, B1); PG8_BAR;
            }
        }
        if constexpr (ALIGN_EPI) { if (wr == 0) PG8_BAR; }
        if constexpr (!Epi::AFTER_DRAIN) { E(acc, cur, wr, wc, fr, fq); S.done(cur); }
        if (!has_next) break;
#pragma unroll
        for (int a = 0; a < 2; ++a)
#pragma unroll
            for (int b = 0; b < 2; ++b)
#pragma unroll
                for (int m = 0; m < 4; ++m)
#pragma unroll
                    for (int n = 0; n < 2; ++n) acc[a][b][m][n] = (f32x4){0.f, 0.f, 0.f, 0.f};
        cur = nxt; cA = nA; cB = nB; ++ui;
        if constexpr (ALIGN_EPI) { if (wr == 1) PG8_BAR; }
    }
    PG8_WAIT_V(0);
    if constexpr (!ALIGN_EPI) { if (wr == 0) PG8_BAR; }
    PG8_BAR;
    if constexpr (Epi::AFTER_DRAIN) { E.fused(acc, cur, wr, wc, fr, fq, lds, wid, lane); S.done(cur); }
#undef PG8_SA
#undef PG8_SB
#undef PG8_STAGE
#undef PG8_LDA
#undef PG8_LDB
#undef PG8_MMA
#undef PG8_WAIT_V
#undef PG8_WAIT_L
#undef PG8_BAR
#undef PG8_SCHED
}
}

template <int MODE> struct EpiMK {
  static constexpr bool PERM = true, AFTER_DRAIN = false;
  const Params* pp; int l;
  DEV void operator()(const pg8::f32x4 (&acc)[2][2][4][2], const pg8::Unit& u, int wr, int wc, int fr, int fq) const {
    const Params& p = *pp;
#pragma unroll
    for (int ai = 0; ai < 2; ++ai)
#pragma unroll
      for (int m = 0; m < 4; ++m) {
        const int row = u.pm * 256 + ai * 128 + wr * 64 + m * 16 + fr;
#pragma unroll
        for (int bj = 0; bj < 2; ++bj) {
          const int col = u.pn * 256 + bj * 128 + wc * 32 + fq * 8;
          const pg8::f32x4 v0 = acc[ai][bj][m][0], v1 = acc[ai][bj][m][1];
          if (MODE == 0) {
            if (col < DIN) {
              uint4 o; o.x = pk2(v0[0], v0[1]); o.y = pk2(v0[2], v0[3]); o.z = pk2(v1[0], v1[1]); o.w = pk2(v1[2], v1[3]);
              *(uint4*)((bf16_t*)(p.ws + OFF_P) + (size_t)row * DIN + col) = o;
              if (row < NCTX) {
                if (col >= C_NK && col < C_HQ) {
                  const int kv = col >= C_NV;
                  float* dst = p.out + O_NAT + (size_t)(((row >> 8) * 4 + l) * 2 + kv) * 65536 + (row & 255) * 256 + (col - (kv ? C_NV : C_NK));
                  *(pg8::f32x4*)dst = v0; *(pg8::f32x4*)(dst + 4) = v1;
                } else if (col >= C_SK) {
                  const int kv = col >= C_SV;
                  float* dst = p.out + O_SWA + (size_t)(((row >> 8) * 4 + l) * 2 + kv) * 32768 + (row & 255) * 128 + (col - (kv ? C_SV : C_SK));
                  *(pg8::f32x4*)dst = v0; *(pg8::f32x4*)(dst + 4) = v1;
                }
              }
            }
          } else if (MODE == 1) {
            uint4 o; o.x = pk2(v0[0], v0[1]); o.y = pk2(v0[2], v0[3]); o.z = pk2(v1[0], v1[1]); o.w = pk2(v1[2], v1[3]);
            *(uint4*)((bf16_t*)(p.ws + OFF_U) + (size_t)row * D + col) = o;
          } else {
            float r[8];
#pragma unroll
            for (int e = 0; e < 4; ++e) { const float a = fmaxf(v0[e], 0.f), b2 = fmaxf(v1[e], 0.f); r[e] = a * a; r[4 + e] = b2 * b2; }
            uint4 o; o.x = pk2(r[0], r[1]); o.y = pk2(r[2], r[3]); o.z = pk2(r[4], r[5]); o.w = pk2(r[6], r[7]);
            *(uint4*)((bf16_t*)(p.ws + OFF_HID) + (size_t)row * FF + col) = o;
          }
        }
      }
  }
};

template <int MODE>
DEV void gemm_run(const Params& p, int l, const bf16_t* A, const bf16_t* BT, int K, int N, char* lds) {
  pg8::Gemm g{A, BT, MT, N, K};
  pg8::StaticOrder S; S.init(MT, N, (int)gridDim.x, (int)blockIdx.x);
  EpiMK<MODE> E{&p, l};
  pg8::gemm_phase<EpiMK<MODE>, pg8::StaticOrder, true, true>((PG8_LAS unsigned char*)lds, g, S, E);
  if (MODE == 1 && l < 3 && (int)gridDim.x > 160 && (int)blockIdx.x >= 160) {
    if (K == D) layer_tiles(p, l + 1, 0, 640, (int)blockIdx.x - 160, (int)gridDim.x - 160, lds);
    else layer_tiles(p, l + 1, 640, NT_LAYER, (int)blockIdx.x - 160, (int)gridDim.x - 160, lds);
  }
}

constexpr int TOKT = 20;
DEV void prep_item(const Params& p, int l, int tile, char* lds) {
  const int t = tid(), r0 = tile * TOKT, c = t;
  bf16_t* sA = (bf16_t*)lds;
  float* swl = (float*)(lds + 32 * 136 * 2);
  float* sal = swl + TOKT * 256;
  const bf16_t* P = (const bf16_t*)(p.ws + OFF_P);
  bf16_t* PREP = (bf16_t*)(p.ws + OFF_PREP);
  bf16_t* BON = (bf16_t*)(p.ws + OFF_BONUS);
  for (int dir = 0; dir < 2; ++dir) {
    __syncthreads();
#pragma unroll
    for (int i = 0; i < TOKT / 2; ++i) {
      const int e = t + 256 * i, tk = e >> 7, j = e & 127, which = j >> 6, jj = j & 63;
      const int row = r0 + tk, prow = dir ? row + 1 : row - 1;
      const int tis = row < NCTX ? (row & 255) : ((row - NCTX) & 1023), Tm1 = row < NCTX ? 255 : 1023;
      const bool pv = dir ? (tis < Tm1) : (tis > 0);
      const int col = (dir ? C_WHB : C_WHF) + which * 64 + jj;
      const float cur = bf2f(P[(size_t)row * DIN + col]);
      const float prev = bf2f(P[(size_t)(pv ? prow : row) * DIN + col]) * (pv ? 1.f : 0.f);
      const float mu = p.in[I_MULORA][((l * 2 + dir) * 2 + which) * 64 + jj];
      const float val = cur + (prev - cur) * mu;
      sA[tk * 136 + j] = f2bf((which == 0) ? tanhf_(val) : val);
    }
    __syncthreads();
    {
      const int lane = t & 63, w = t >> 6, q = lane & 31, hh = lane >> 5;
#pragma unroll
      for (int mat = 0; mat < 2; ++mat) {
        bf16x8 af[4];
#pragma unroll
        for (int s = 0; s < 4; ++s) af[s] = *(const bf16x8*)(sA + q * 136 + mat * 64 + 16 * s + 8 * hh);
        const bf16_t* WT = (const bf16_t*)(p.ws + (mat ? OFF_A2T : OFF_W2T)) + (size_t)(l * 2 + dir) * 256 * 64;
        float* dst = mat ? sal : swl;
#pragma unroll
        for (int nt = 0; nt < 2; ++nt) {
          const int n = w * 64 + nt * 32 + q;
          f32x16 acc;
#pragma unroll
          for (int r = 0; r < 16; ++r) acc[r] = 0.f;
#pragma unroll
          for (int s = 0; s < 4; ++s) acc = MFMA32(af[s], *(const bf16x8*)(WT + (size_t)n * 64 + 16 * s + 8 * hh), acc);
#pragma unroll
          for (int r = 0; r < 8; ++r) dst[((r & 3) + 8 * (r >> 2) + 4 * hh) * 256 + n] = acc[r];
          if (hh == 0) {
#pragma unroll
            for (int r = 8; r < 12; ++r) dst[((r & 3) + 16) * 256 + n] = acc[r];
          }
        }
      }
    }
    __syncthreads();
    const float w0v = p.in[I_W0][(l * 2 + dir) * 256 + c], a0v = p.in[I_A0][(l * 2 + dir) * 256 + c];
    const float kkv = p.in[I_KK][l * 256 + c], kav = p.in[I_KA][l * 256 + c], rkv = p.in[I_RK][l * 256 + c];
    const float mur = p.in[I_MURKV][((l * 2 + dir) * 3 + 0) * 256 + c], muk = p.in[I_MURKV][((l * 2 + dir) * 3 + 1) * 256 + c],
                muv = p.in[I_MURKV][((l * 2 + dir) * 3 + 2) * 256 + c];
    bf16_t* pr = PREP + (size_t)dir * 6 * ARRF;
    for (int tb = 0; tb < TOKT; tb += 5) {
      float rc[5], kc[5], vc[5], rp[5], kq[5], vp[5], wlv[5], alv[5];
#pragma unroll
      for (int u = 0; u < 5; ++u) {
        const int tk = tb + u, row = r0 + tk, prow = dir ? row + 1 : row - 1;
        const int tis = row < NCTX ? (row & 255) : ((row - NCTX) & 1023), Tm1 = row < NCTX ? 255 : 1023;
        const bool pv = dir ? (tis < Tm1) : (tis > 0);
        const float pm = pv ? 1.f : 0.f;
        const bf16_t* pc = P + (size_t)row * DIN + c;
        const bf16_t* pp = P + (size_t)(pv ? prow : row) * DIN + c;
        rc[u] = bf2f(pc[C_R]); kc[u] = bf2f(pc[C_K]); vc[u] = bf2f(pc[C_V]);
        rp[u] = bf2f(pp[C_R]) * pm; kq[u] = bf2f(pp[C_K]) * pm; vp[u] = bf2f(pp[C_V]) * pm;
        wlv[u] = swl[tk * 256 + c]; alv[u] = sal[tk * 256 + c];
      }
      float bprev[5];
#pragma unroll
      for (int u = 0; u < 5; ++u) bprev[u] = (dir == 1) ? bf2f(BON[(size_t)(r0 + tb + u) * 256 + c]) : 0.f;
#pragma unroll
      for (int u = 0; u < 5; ++u) {
        const int row = r0 + tb + u;
        const float rs = rc[u] + (rp[u] - rc[u]) * mur, ks = kc[u] + (kq[u] - kc[u]) * muk, vs = vc[u] + (vp[u] - vc[u]) * muv;
        const float wl = w0v + wlv[u], al = a0v + alv[u];
        const float wv = __expf(-0.6065306597126334f * sigmoidf_(wl));
        const float av = sigmoidf_(al);
        const float kkr = ks * kkv;
        const float n2 = wave_sum(kkr * kkr);
        const float kk = kkr * rcpf_(fmaxf(__builtin_amdgcn_sqrtf(n2), 1e-12f));
        const float kp = ks * (1.0f + (av - 1.0f) * kav);
        const float bs = wave_sum(rs * kp * rkv);
        const float bon = bs * vs;
        const size_t idx = (size_t)row * 256 + c;
        pr[idx] = f2bf(rs); pr[ARRF + idx] = f2bf(wv); pr[2 * ARRF + idx] = f2bf(kp); pr[3 * ARRF + idx] = f2bf(vs); pr[4 * ARRF + idx] = f2bf(kk); pr[5 * ARRF + idx] = f2bf(kk * av);
        BON[idx] = f2bf(bprev[u] + bon);
      }
    }
  }
  __syncthreads();
}

DEV void rope_item(const Params& p, int item) {
  bf16_t* P = (bf16_t*)(p.ws + OFF_P);
  const int t = tid();
  for (int e = t; e < 8 * 192; e += 256) {
    const int tk = e / 192, r = e % 192, hs = r >> 5, pi = r & 31;
    const int lt = item * 8 + tk;
    const int tt = lt & 1023;
    const int grow = tt >> 6, gcol = tt & 63;
    const int fi = pi & 15;
    const float pos = (pi < 16) ? (float)grow : (float)gcol;
    const float inv = exp2f(-(float)fi * (13.287712379549449f / 16.0f));
    const float ang = pos * inv;
    const float cs = __cosf(ang), sn = __sinf(ang);
    const int d1 = (pi < 16) ? fi : 32 + fi;
    bf16_t* base = P + (size_t)(NCTX + lt) * DIN + C_SQ + hs * 64;
    const float x1 = bf2f(base[d1]), x2 = bf2f(base[d1 + 16]);
    base[d1] = f2bf(x1 * cs - x2 * sn);
    base[d1 + 16] = f2bf(x2 * cs + x1 * sn);
  }
}

constexpr int SC_BUF = 20480 + 4096;
typedef float f2 __attribute__((ext_vector_type(2)));
DEV float dot4(const float4& a, const float4& b) { return a.x * b.x + a.y * b.y + a.z * b.z + a.w * b.w; }
DEV float red8(float x) { x += dppf<0xB1>(x); x += dppf<0x4E>(x); x += dppf<0x141>(x); return x; }
DEV float dot8(const f2 (&S)[4], const float4& a, const float4& b) {
  f2 acc = S[0] * (f2){a.x, a.y};
  acc += S[1] * (f2){a.z, a.w}; acc += S[2] * (f2){b.x, b.y}; acc += S[3] * (f2){b.z, b.w};
  return acc.x + acc.y;
}

template <int NCH>
DEV void rwkv_scan(const Params& p, int l, int seq, int head, int dir, int rsel, char* lds) {
  const int t = tid(), rr = t >> 3, g = t & 7, rl = t >> 4, ks = t & 15;
  const int T = seq < 32 ? 256 : 1024;
  const int row0 = seq < 32 ? seq * 256 : NCTX + (seq - 32) * 1024;
  const bf16_t* prep = (const bf16_t*)(p.ws + OFF_PREP) + (size_t)dir * 6 * ARRF;
  float* ydir = (float*)(p.ws + OFF_YDIR) + (size_t)dir * ARRF;
  const int vbase = (NCH == 2) ? 0 : rsel * 32;
  f2 S[NCH][4];
#pragma unroll
  for (int c = 0; c < NCH; ++c)
#pragma unroll
    for (int j = 0; j < 4; ++j) S[c][j] = (f2){0.f, 0.f};
  if (seq >= 32) {
    const float* sp = p.in[I_SRW] + ((((size_t)(seq - 32) * 4 + l) * 2 + dir) * 4 + head) * 4096 + g * 8;
#pragma unroll
    for (int c = 0; c < NCH; ++c) {
      const float4 a = *(const float4*)(sp + (vbase + rr + 32 * c) * 64), b = *(const float4*)(sp + (vbase + rr + 32 * c) * 64 + 4);
      S[c][0] = (f2){a.x, a.y}; S[c][1] = (f2){a.z, a.w}; S[c][2] = (f2){b.x, b.y}; S[c][3] = (f2){b.z, b.w};
    }
  }
  const int nch = T >> 4;
  uint2 pre0, pre1, pre2, pre3, pre4, pvv;
#define RW_LOAD(cc) do { const int s_ = (cc) * 16 + rl; const int tok_ = dir ? (T - 1 - s_) : s_; \
    const size_t base_ = (size_t)(row0 + tok_) * 256 + head * 64; \
    pre0 = *(const uint2*)(prep + base_ + ks * 4); pre1 = *(const uint2*)(prep + ARRF + base_ + ks * 4); \
    pre2 = *(const uint2*)(prep + 2 * ARRF + base_ + ks * 4); pre3 = *(const uint2*)(prep + 4 * ARRF + base_ + ks * 4); \
    pre4 = *(const uint2*)(prep + 5 * ARRF + base_ + ks * 4); \
    if (NCH == 2) pvv = *(const uint2*)(prep + 3 * ARRF + base_ + ks * 4); \
    else pvv.x = *(const unsigned*)(prep + 3 * ARRF + base_ + vbase + ks * 2); } while (0)
#define RW_WRITE(bb) do { float4* sb_ = (float4*)(lds + (bb) * SC_BUF); float* vb_ = (float*)(lds + (bb) * SC_BUF + 20480); \
    sb_[(0 * 16 + rl) * 16 + ks] = bf4(pre0); sb_[(1 * 16 + rl) * 16 + ks] = bf4(pre1); sb_[(2 * 16 + rl) * 16 + ks] = bf4(pre2); \
    sb_[(3 * 16 + rl) * 16 + ks] = bf4(pre3); sb_[(4 * 16 + rl) * 16 + ks] = bf4(pre4); \
    if (NCH == 2) *(float4*)(vb_ + rl * 64 + ks * 4) = bf4(pvv); else *(f2*)(vb_ + rl * 64 + ks * 2) = (f2){bflo(pvv.x), bfhi(pvv.x)}; } while (0)
  __syncthreads();
  RW_LOAD(0); RW_WRITE(0);
  __syncthreads();
  for (int c = 0; c < nch; ++c) {
    if (c + 1 < nch) RW_LOAD(c + 1);
    const float4* sbuf = (const float4*)(lds + (c & 1) * SC_BUF);
    const float* vbuf = (const float*)(lds + (c & 1) * SC_BUF + 20480);
    float ym[NCH][2];
#pragma unroll
    for (int cc = 0; cc < NCH; ++cc) { ym[cc][0] = 0.f; ym[cc][1] = 0.f; }
#pragma unroll
    for (int i = 0; i < 16; ++i) {
      const float4 ra = sbuf[(0 * 16 + i) * 16 + g * 2], rb = sbuf[(0 * 16 + i) * 16 + g * 2 + 1];
      const float4 wa = sbuf[(1 * 16 + i) * 16 + g * 2], wb = sbuf[(1 * 16 + i) * 16 + g * 2 + 1];
      const float4 ka_ = sbuf[(2 * 16 + i) * 16 + g * 2], kb_ = sbuf[(2 * 16 + i) * 16 + g * 2 + 1];
      const float4 na = sbuf[(3 * 16 + i) * 16 + g * 2], nb = sbuf[(3 * 16 + i) * 16 + g * 2 + 1];
      const float4 aa = sbuf[(4 * 16 + i) * 16 + g * 2], ab = sbuf[(4 * 16 + i) * 16 + g * 2 + 1];
      const f2 w2[4] = {(f2){wa.x, wa.y}, (f2){wa.z, wa.w}, (f2){wb.x, wb.y}, (f2){wb.z, wb.w}};
      const f2 k2[4] = {(f2){ka_.x, ka_.y}, (f2){ka_.z, ka_.w}, (f2){kb_.x, kb_.y}, (f2){kb_.z, kb_.w}};
      const f2 a2[4] = {(f2){aa.x, aa.y}, (f2){aa.z, aa.w}, (f2){ab.x, ab.y}, (f2){ab.z, ab.w}};
#pragma unroll
      for (int cc = 0; cc < NCH; ++cc) {
        const float v = vbuf[i * 64 + rr + 32 * cc];
        const float sa = -red8(dot8(S[cc], na, nb));
#pragma unroll
        for (int j = 0; j < 4; ++j) S[cc][j] = S[cc][j] * w2[j] + a2[j] * sa + k2[j] * v;
        const float y = red8(dot8(S[cc], ra, rb));
        ym[cc][i >> 3] = (g == (i & 7)) ? y : ym[cc][i >> 3];
      }
    }
#pragma unroll
    for (int hh = 0; hh < 2; ++hh) {
      const int s = c * 16 + hh * 8 + g; const int tok = dir ? (T - 1 - s) : s;
      float* yo = ydir + (size_t)(row0 + tok) * 256 + head * 64 + vbase + rr;
#pragma unroll
      for (int cc = 0; cc < NCH; ++cc) yo[32 * cc] = ym[cc][hh];
    }
    if (c + 1 < nch) RW_WRITE((c + 1) & 1);
    __syncthreads();
  }
#undef RW_LOAD
#undef RW_WRITE
  if (seq < 32) {
    float* sp = p.out + O_RW + ((((size_t)seq * 4 + l) * 2 + dir) * 4 + head) * 4096 + g * 8;
#pragma unroll
    for (int c = 0; c < NCH; ++c) {
      *(float4*)(sp + (vbase + rr + 32 * c) * 64) = make_float4(S[c][0].x, S[c][0].y, S[c][1].x, S[c][1].y);
      *(float4*)(sp + (vbase + rr + 32 * c) * 64 + 4) = make_float4(S[c][2].x, S[c][2].y, S[c][3].x, S[c][3].y);
    }
  }
}

template <int NCH>
DEV void hgrn_scan(const Params& p, int l, int seq, int head, int dir, int rsel, char* lds) {
  const int t = tid(), rr = t >> 3, g = t & 7, rl = t >> 4, ks = t & 15;
  const int T = seq < 32 ? 256 : 1024;
  const int row0 = seq < 32 ? seq * 256 : NCTX + (seq - 32) * 1024;
  const bf16_t* P = (const bf16_t*)(p.ws + OFF_P);
  float* odir = (float*)(p.ws + OFF_HDIR) + (size_t)dir * ARRF;
  const float4 lb4 = *(const float4*)((const float*)(p.ws + OFF_HGLB) + (l * 2 + dir) * 256 + head * 64 + ks * 4);
  const int vbase = (NCH == 2) ? 0 : rsel * 32;
  f2 S[NCH][4];
#pragma unroll
  for (int c = 0; c < NCH; ++c)
#pragma unroll
    for (int j = 0; j < 4; ++j) S[c][j] = (f2){0.f, 0.f};
  if (seq >= 32) {
    const float* sp = p.in[I_SHG] + ((((size_t)(seq - 32) * 4 + l) * 2 + dir) * 4 + head) * 4096;
#pragma unroll
    for (int c = 0; c < NCH; ++c)
#pragma unroll
      for (int j = 0; j < 4; ++j) {
        const int v = vbase + rr + 32 * c;
        S[c][j] = (f2){sp[(g * 8 + 2 * j) * 64 + v], sp[(g * 8 + 2 * j + 1) * 64 + v]};
      }
  }
  const int nch = T >> 4;
  const int fcol = (dir ? C_HFB : C_HFF) + head * 64;
  uint2 pq, pf, pv2;
#define HG_LOAD(cc) do { const int s_ = (cc) * 16 + rl; const int tok_ = dir ? (T - 1 - s_) : s_; \
    const bf16_t* pr_ = P + (size_t)(row0 + tok_) * DIN; \
    pq = *(const uint2*)(pr_ + C_HQ + head * 64 + ks * 4); pf = *(const uint2*)(pr_ + fcol + ks * 4); \
    if (NCH == 2) pv2 = *(const uint2*)(pr_ + C_HI + head * 64 + ks * 4); else pv2.x = *(const unsigned*)(pr_ + C_HI + head * 64 + vbase + ks * 2); } while (0)
#define HG_WRITE(bb) do { float4* sb_ = (float4*)(lds + (bb) * SC_BUF); float* vb_ = (float*)(lds + (bb) * SC_BUF + 20480); \
    float4 q_, f_, k_; float a_, sg_; \
    a_ = bflo(pq.x); q_.x = a_ * sigmoidf_(a_); a_ = bfhi(pq.x); q_.y = a_ * sigmoidf_(a_); \
    a_ = bflo(pq.y); q_.z = a_ * sigmoidf_(a_); a_ = bfhi(pq.y); q_.w = a_ * sigmoidf_(a_); \
    sg_ = sigmoidf_(bflo(pf.x)); f_.x = lb4.x + (1.f - lb4.x) * sg_; k_.x = (1.f - lb4.x) * (1.f - sg_); \
    sg_ = sigmoidf_(bfhi(pf.x)); f_.y = lb4.y + (1.f - lb4.y) * sg_; k_.y = (1.f - lb4.y) * (1.f - sg_); \
    sg_ = sigmoidf_(bflo(pf.y)); f_.z = lb4.z + (1.f - lb4.z) * sg_; k_.z = (1.f - lb4.z) * (1.f - sg_); \
    sg_ = sigmoidf_(bfhi(pf.y)); f_.w = lb4.w + (1.f - lb4.w) * sg_; k_.w = (1.f - lb4.w) * (1.f - sg_); \
    sb_[(0 * 16 + rl) * 16 + ks] = q_; sb_[(1 * 16 + rl) * 16 + ks] = f_; sb_[(2 * 16 + rl) * 16 + ks] = k_; \
    if (NCH == 2) *(float4*)(vb_ + rl * 64 + ks * 4) = make_float4(bflo(pv2.x), bfhi(pv2.x), bflo(pv2.y), bfhi(pv2.y)); \
    else *(f2*)(vb_ + rl * 64 + ks * 2) = (f2){bflo(pv2.x), bfhi(pv2.x)}; } while (0)
  __syncthreads();
  HG_LOAD(0); HG_WRITE(0);
  __syncthreads();
  for (int c = 0; c < nch; ++c) {
    if (c + 1 < nch) HG_LOAD(c + 1);
    const float4* sbuf = (const float4*)(lds + (c & 1) * SC_BUF);
    const float* vbuf = (const float*)(lds + (c & 1) * SC_BUF + 20480);
    float ym[NCH][2];
#pragma unroll
    for (int cc = 0; cc < NCH; ++cc) { ym[cc][0] = 0.f; ym[cc][1] = 0.f; }
#pragma unroll
    for (int i = 0; i < 16; ++i) {
      const float4 qa = sbuf[(0 * 16 + i) * 16 + g * 2], qb = sbuf[(0 * 16 + i) * 16 + g * 2 + 1];
      const float4 fa = sbuf[(1 * 16 + i) * 16 + g * 2], fb = sbuf[(1 * 16 + i) * 16 + g * 2 + 1];
      const float4 ka_ = sbuf[(2 * 16 + i) * 16 + g * 2], kb_ = sbuf[(2 * 16 + i) * 16 + g * 2 + 1];
      const f2 f2v[4] = {(f2){fa.x, fa.y}, (f2){fa.z, fa.w}, (f2){fb.x, fb.y}, (f2){fb.z, fb.w}};
      const f2 k2[4] = {(f2){ka_.x, ka_.y}, (f2){ka_.z, ka_.w}, (f2){kb_.x, kb_.y}, (f2){kb_.z, kb_.w}};
#pragma unroll
      for (int cc = 0; cc < NCH; ++cc) {
        const float v = vbuf[i * 64 + rr + 32 * cc];
#pragma unroll
        for (int j = 0; j < 4; ++j) S[cc][j] = S[cc][j] * f2v[j] + k2[j] * v;
        const float y = red8(dot8(S[cc], qa, qb));
        ym[cc][i >> 3] = (g == (i & 7)) ? y : ym[cc][i >> 3];
      }
    }
#pragma unroll
    for (int hh = 0; hh < 2; ++hh) {
      const int s = c * 16 + hh * 8 + g; const int tok = dir ? (T - 1 - s) : s;
      float* yo = odir + (size_t)(row0 + tok) * 256 + head * 64 + vbase + rr;
#pragma unroll
      for (int cc = 0; cc < NCH; ++cc) yo[32 * cc] = ym[cc][hh];
    }
    if (c + 1 < nch) HG_WRITE((c + 1) & 1);
    __syncthreads();
  }
#undef HG_LOAD
#undef HG_WRITE
  if (seq < 32) {
    float* sp = p.out + O_HG + ((((size_t)seq * 4 + l) * 2 + dir) * 4 + head) * 4096;
#pragma unroll
    for (int c = 0; c < NCH; ++c)
#pragma unroll
      for (int j = 0; j < 4; ++j) {
        const int v = vbase + rr + 32 * c;
        sp[(g * 8 + 2 * j) * 64 + v] = S[c][j].x; sp[(g * 8 + 2 * j + 1) * 64 + v] = S[c][j].y;
      }
  }
}

DEV void rwkv_scan16(const Params& p, int l, int seq, int head, int dir, int rg, char* lds) {
  const int t = tid(), rl = t >> 4, ks = t & 15;
  const int T = seq < 32 ? 256 : 1024;
  const int row0 = seq < 32 ? seq * 256 : NCTX + (seq - 32) * 1024;
  const bf16_t* prep = (const bf16_t*)(p.ws + OFF_PREP) + (size_t)dir * 6 * ARRF;
  float* ydir = (float*)(p.ws + OFF_YDIR) + (size_t)dir * ARRF;
  const int v0 = rg * 16 + rl;
  float4 S0 = make_float4(0.f, 0.f, 0.f, 0.f);
  if (seq >= 32) S0 = *(const float4*)(p.in[I_SRW] + ((((size_t)(seq - 32) * 4 + l) * 2 + dir) * 4 + head) * 4096 + ks * 4 + v0 * 64);
  const int nch = T >> 4;
  uint2 pre0, pre1, pre2, pre3, pre4; bf16_t pv0;
#define RW_LOAD(cc) do { const int s_ = (cc) * 16 + rl; const int tok_ = dir ? (T - 1 - s_) : s_; \
    const size_t base_ = (size_t)(row0 + tok_) * 256 + head * 64; \
    pre0 = *(const uint2*)(prep + base_ + ks * 4); pre1 = *(const uint2*)(prep + ARRF + base_ + ks * 4); \
    pre2 = *(const uint2*)(prep + 2 * ARRF + base_ + ks * 4); pre3 = *(const uint2*)(prep + 4 * ARRF + base_ + ks * 4); \
    pre4 = *(const uint2*)(prep + 5 * ARRF + base_ + ks * 4); pv0 = prep[3 * ARRF + base_ + rg * 16 + ks]; } while (0)
#define RW_WRITE(bb) do { float4* sb_ = (float4*)(lds + (bb) * SC_BUF); float* vb_ = (float*)(lds + (bb) * SC_BUF + 20480); \
    sb_[(0 * 16 + rl) * 16 + ks] = bf4(pre0); sb_[(1 * 16 + rl) * 16 + ks] = bf4(pre1); sb_[(2 * 16 + rl) * 16 + ks] = bf4(pre2); \
    sb_[(3 * 16 + rl) * 16 + ks] = bf4(pre3); sb_[(4 * 16 + rl) * 16 + ks] = bf4(pre4); vb_[rl * 16 + ks] = bf2f(pv0); } while (0)
  __syncthreads();
  RW_LOAD(0); RW_WRITE(0);
  __syncthreads();
  for (int c = 0; c < nch; ++c) {
    if (c + 1 < nch) RW_LOAD(c + 1);
    const float4* sbuf = (const float4*)(lds + (c & 1) * SC_BUF);
    const float* vbuf = (const float*)(lds + (c & 1) * SC_BUF + 20480);
    float ym0 = 0.f;
#pragma unroll
    for (int i = 0; i < 16; ++i) {
      const float4 r = sbuf[(0 * 16 + i) * 16 + ks], wv = sbuf[(1 * 16 + i) * 16 + ks], kv = sbuf[(2 * 16 + i) * 16 + ks],
                   kk = sbuf[(3 * 16 + i) * 16 + ks], ka = sbuf[(4 * 16 + i) * 16 + ks];
      const float va = vbuf[i * 16 + rl];
      const float sa0 = -row16_sum(dot4(S0, kk));
      S0.x = S0.x * wv.x + sa0 * ka.x + va * kv.x; S0.y = S0.y * wv.y + sa0 * ka.y + va * kv.y;
      S0.z = S0.z * wv.z + sa0 * ka.z + va * kv.z; S0.w = S0.w * wv.w + sa0 * ka.w + va * kv.w;
      const float y0 = row16_sum(dot4(S0, r));
      ym0 = (ks == i) ? y0 : ym0;
    }
    {
      const int s = c * 16 + ks; const int tok = dir ? (T - 1 - s) : s;
      ydir[(size_t)(row0 + tok) * 256 + head * 64 + v0] = ym0;
    }
    if (c + 1 < nch) RW_WRITE((c + 1) & 1);
    __syncthreads();
  }
#undef RW_LOAD
#undef RW_WRITE
  if (seq < 32) *(float4*)(p.out + O_RW + ((((size_t)seq * 4 + l) * 2 + dir) * 4 + head) * 4096 + ks * 4 + v0 * 64) = S0;
}

DEV void hgrn_scan16(const Params& p, int l, int seq, int head, int dir, int rg, char* lds) {
  const int t = tid(), rl = t >> 4, ks = t & 15;
  const int T = seq < 32 ? 256 : 1024;
  const int row0 = seq < 32 ? seq * 256 : NCTX + (seq - 32) * 1024;
  const bf16_t* P = (const bf16_t*)(p.ws + OFF_P);
  float* odir = (float*)(p.ws + OFF_HDIR) + (size_t)dir * ARRF;
  const float4 lb4 = *(const float4*)((const float*)(p.ws + OFF_HGLB) + (l * 2 + dir) * 256 + head * 64 + ks * 4);
  const int v0 = rg * 16 + rl;
  float4 S0 = make_float4(0.f, 0.f, 0.f, 0.f);
  if (seq >= 32) {
    const float* sp = p.in[I_SHG] + ((((size_t)(seq - 32) * 4 + l) * 2 + dir) * 4 + head) * 4096;
    S0.x = sp[(ks * 4 + 0) * 64 + v0]; S0.y = sp[(ks * 4 + 1) * 64 + v0]; S0.z = sp[(ks * 4 + 2) * 64 + v0]; S0.w = sp[(ks * 4 + 3) * 64 + v0];
  }
  const int nch = T >> 4;
  const int fcol = (dir ? C_HFB : C_HFF) + head * 64;
  uint2 pq, pf; bf16_t pva;
#define HG_LOAD(cc) do { const int s_ = (cc) * 16 + rl; const int tok_ = dir ? (T - 1 - s_) : s_; \
    const bf16_t* pr_ = P + (size_t)(row0 + tok_) * DIN; \
    pq = *(const uint2*)(pr_ + C_HQ + head * 64 + ks * 4); pf = *(const uint2*)(pr_ + fcol + ks * 4); \
    pva = pr_[C_HI + head * 64 + rg * 16 + ks]; } while (0)
#define HG_WRITE(bb) do { float4* sb_ = (float4*)(lds + (bb) * SC_BUF); float* vb_ = (float*)(lds + (bb) * SC_BUF + 20480); \
    float4 q_, f_, k_; float a_, sg_; \
    a_ = bflo(pq.x); q_.x = a_ * sigmoidf_(a_); a_ = bfhi(pq.x); q_.y = a_ * sigmoidf_(a_); \
    a_ = bflo(pq.y); q_.z = a_ * sigmoidf_(a_); a_ = bfhi(pq.y); q_.w = a_ * sigmoidf_(a_); \
    sg_ = sigmoidf_(bflo(pf.x)); f_.x = lb4.x + (1.f - lb4.x) * sg_; k_.x = (1.f - lb4.x) * (1.f - sg_); \
    sg_ = sigmoidf_(bfhi(pf.x)); f_.y = lb4.y + (1.f - lb4.y) * sg_; k_.y = (1.f - lb4.y) * (1.f - sg_); \
    sg_ = sigmoidf_(bflo(pf.y)); f_.z = lb4.z + (1.f - lb4.z) * sg_; k_.z = (1.f - lb4.z) * (1.f - sg_); \
    sg_ = sigmoidf_(bfhi(pf.y)); f_.w = lb4.w + (1.f - lb4.w) * sg_; k_.w = (1.f - lb4.w) * (1.f - sg_); \
    sb_[(0 * 16 + rl) * 16 + ks] = q_; sb_[(1 * 16 + rl) * 16 + ks] = f_; sb_[(2 * 16 + rl) * 16 + ks] = k_; \
    vb_[rl * 16 + ks] = bf2f(pva); } while (0)
  __syncthreads();
  HG_LOAD(0); HG_WRITE(0);
  __syncthreads();
  for (int c = 0; c < nch; ++c) {
    if (c + 1 < nch) HG_LOAD(c + 1);
    const float4* sbuf = (const float4*)(lds + (c & 1) * SC_BUF);
    const float* vbuf = (const float*)(lds + (c & 1) * SC_BUF + 20480);
    float ym0 = 0.f;
#pragma unroll
    for (int i = 0; i < 16; ++i) {
      const float4 q = sbuf[(0 * 16 + i) * 16 + ks], f = sbuf[(1 * 16 + i) * 16 + ks], k = sbuf[(2 * 16 + i) * 16 + ks];
      const float va = vbuf[i * 16 + rl];
      S0.x = S0.x * f.x + k.x * va; S0.y = S0.y * f.y + k.y * va; S0.z = S0.z * f.z + k.z * va; S0.w = S0.w * f.w + k.w * va;
      const float y0 = row16_sum(dot4(S0, q));
      ym0 = (ks == i) ? y0 : ym0;
    }
    {
      const int s = c * 16 + ks; const int tok = dir ? (T - 1 - s) : s;
      odir[(size_t)(row0 + tok) * 256 + head * 64 + v0] = ym0;
    }
    if (c + 1 < nch) HG_WRITE((c + 1) & 1);
    __syncthreads();
  }
#undef HG_LOAD
#undef HG_WRITE
  if (seq < 32) {
    float* sp = p.out + O_HG + ((((size_t)seq * 4 + l) * 2 + dir) * 4 + head) * 4096;
    sp[(ks * 4 + 0) * 64 + v0] = S0.x; sp[(ks * 4 + 1) * 64 + v0] = S0.y; sp[(ks * 4 + 2) * 64 + v0] = S0.z; sp[(ks * 4 + 3) * 64 + v0] = S0.w;
  }
}

template <int MODE>
DEV void attn_item(const Params& p, int l, int item, char* lds) {
  const int t = tid(), lane = t & 63, w = t >> 6, q = lane & 31, hh = lane >> 5;
  const bf16_t* P = (const bf16_t*)(p.ws + OFF_P);
  bf16_t* Y = (bf16_t*)(p.ws + OFF_YMIX);
  char* sK = lds;
  char* sV = lds + 8192;
  float* sBias = (float*)(lds + 8192 + 8704);
  int head, qrow, qcol, kcol, vcol, ocol, nloc, nt, rowbaseP;
  int qr = 0, qc = 0, rlo = 0, qpos = 0, lo = 0, rsq = 0, wsq = 0;
  float sink = 0.f;
  const float* cache = nullptr; int cH = 1, cHead = 0;
  if (MODE == 0 || MODE == 1) {
    const int b = item >> 3; head = (item >> 1) & 3; const int half = item & 1;
    rowbaseP = b * 256; qrow = rowbaseP + half * 128 + w * 32 + q; nloc = 4; nt = 4;
  } else {
    const int b = item >> 5; head = (item >> 3) & 3; const int sub = item & 7;
    rowbaseP = NCTX + b * 1024;
    if (MODE == 2) {
      qr = 2 * sub + (w >> 1); qc = (w & 1) * 32 + q; qrow = rowbaseP + qr * 64 + qc;
      rlo = clampi(2 * sub - 4, 0, 8); const int rhi = clampi(2 * sub - 3, 0, 8) + 7; nloc = rhi - rlo + 1; nt = nloc + 4;
      rsq = clampi(qr - 4, 0, 8); wsq = clampi(qc - 8, 0, 48);
      cache = p.in[I_CNAT] + (size_t)((b * 4 + l) * 2) * 256 * 256; cH = 4; cHead = head;
      for (int i = t; i < 465; i += 256) sBias[i] = p.in[I_RPB][(size_t)(l * 4 + head) * 465 + i];
    } else {
      qpos = sub * 128 + w * 32 + q; qrow = rowbaseP + qpos;
      lo = (sub - 1) * 128;
      nloc = 6; nt = nloc + 4;
      cache = p.in[I_CSWA] + (size_t)((b * 4 + l) * 2) * 256 * 128; cH = 2; cHead = head >> 1;
    }
  }
  if (MODE == 0 || MODE == 2) { qcol = C_NQ + head * 64; kcol = C_NK + head * 64; vcol = C_NV + head * 64; ocol = 256 + head * 64; }
  else { qcol = C_SQ + head * 64; kcol = C_SK + (head >> 1) * 64; vcol = C_SV + (head >> 1) * 64; ocol = 768 + head * 64; sink = p.in[I_SINK][l * 4 + head]; }

  bf16x8 bq[4];
#pragma unroll
  for (int s = 0; s < 4; ++s) bq[s] = *(const bf16x8*)(P + (size_t)qrow * DIN + qcol + 16 * s + 8 * hh);
  f32x16 oacc[2];
#pragma unroll
  for (int r = 0; r < 16; ++r) { oacc[0][r] = 0.f; oacc[1][r] = 0.f; }
  float m_run = -1e30f, l_run = 0.f;
  const int key = t >> 2, dq = t & 3;
  const int kswz = (key >> 1) & 7;
  float4 raw[8];
#define ATT_ISSUE(jj) do { const int j_ = (jj); \
    if (j_ < nloc) { \
      int krow_; \
      if (MODE == 0 || MODE == 1) krow_ = rowbaseP + j_ * 64 + key; \
      else if (MODE == 2) krow_ = rowbaseP + (rlo + j_) * 64 + key; \
      else krow_ = rowbaseP + clampi(lo + j_ * 64 + key, 0, 1023); \
      const bf16_t* kp_ = P + (size_t)krow_ * DIN + kcol + dq * 16; \
      const bf16_t* vp_ = P + (size_t)krow_ * DIN + vcol + dq * 16; \
      raw[0] = *(const float4*)kp_; raw[1] = *(const float4*)(kp_ + 8); raw[2] = *(const float4*)vp_; raw[3] = *(const float4*)(vp_ + 8); \
    } else { \
      const int ct_ = (j_ - nloc) * 64 + key; \
      const float* kp_ = cache + ((size_t)ct_ * cH + cHead) * 64 + dq * 16; \
      const float* vp_ = kp_ + (size_t)256 * cH * 64; \
      raw[0] = *(const float4*)kp_; raw[1] = *(const float4*)(kp_ + 4); raw[2] = *(const float4*)(kp_ + 8); raw[3] = *(const float4*)(kp_ + 12); \
      raw[4] = *(const float4*)vp_; raw[5] = *(const float4*)(vp_ + 4); raw[6] = *(const float4*)(vp_ + 8); raw[7] = *(const float4*)(vp_ + 12); \
    } } while (0)
  ATT_ISSUE(0);
  for (int j = 0; j < nt; ++j) {
    uint4 kr[2], vr[2];
    const bool isP = j < nloc;
    if (isP) {
      kr[0] = __builtin_bit_cast(uint4, raw[0]); kr[1] = __builtin_bit_cast(uint4, raw[1]);
      vr[0] = __builtin_bit_cast(uint4, raw[2]); vr[1] = __builtin_bit_cast(uint4, raw[3]);
    } else {
      kr[0].x = pk2(raw[0].x, raw[0].y); kr[0].y = pk2(raw[0].z, raw[0].w); kr[0].z = pk2(raw[1].x, raw[1].y); kr[0].w = pk2(raw[1].z, raw[1].w);
      kr[1].x = pk2(raw[2].x, raw[2].y); kr[1].y = pk2(raw[2].z, raw[2].w); kr[1].z = pk2(raw[3].x, raw[3].y); kr[1].w = pk2(raw[3].z, raw[3].w);
      vr[0].x = pk2(raw[4].x, raw[4].y); vr[0].y = pk2(raw[4].z, raw[4].w); vr[0].z = pk2(raw[5].x, raw[5].y); vr[0].w = pk2(raw[5].z, raw[5].w);
      vr[1].x = pk2(raw[6].x, raw[6].y); vr[1].y = pk2(raw[6].z, raw[6].w); vr[1].z = pk2(raw[7].x, raw[7].y); vr[1].w = pk2(raw[7].z, raw[7].w);
    }
    if (j + 1 < nt) ATT_ISSUE(j + 1);
    __syncthreads();
    *(uint4*)(sK + key * 128 + (((dq * 2 + 0) ^ kswz) << 4)) = kr[0];
    *(uint4*)(sK + key * 128 + (((dq * 2 + 1) ^ kswz) << 4)) = kr[1];
    {
      bf16_t* vt = (bf16_t*)sV;
      const unsigned vv[8] = {vr[0].x, vr[0].y, vr[0].z, vr[0].w, vr[1].x, vr[1].y, vr[1].z, vr[1].w};
#pragma unroll
      for (int e = 0; e < 8; ++e) {
        vt[(dq * 16 + 2 * e) * 68 + key] = (bf16_t)(vv[e] & 0xffffu);
        vt[(dq * 16 + 2 * e + 1) * 68 + key] = (bf16_t)(vv[e] >> 16);
      }
    }
    __syncthreads();
    f32x16 sacc[2];
#pragma unroll
    for (int r = 0; r < 16; ++r) { sacc[0][r] = 0.f; sacc[1][r] = 0.f; }
    const int qswz = (q >> 1) & 7;
#pragma unroll
    for (int s = 0; s < 4; ++s) {
      const int co = (((s * 2 + hh) ^ qswz) << 4);
      const bf16x8 a0 = *(const bf16x8*)(sK + q * 128 + co);
      const bf16x8 a1 = *(const bf16x8*)(sK + (32 + q) * 128 + co);
      sacc[0] = MFMA32(a0, bq[s], sacc[0]);
      sacc[1] = MFMA32(a1, bq[s], sacc[1]);
    }
    float mx = -1e30f;
#pragma unroll
    for (int sub = 0; sub < 2; ++sub)
#pragma unroll
      for (int r = 0; r < 16; ++r) {
        const int kidx = sub * 32 + (r & 3) + 8 * (r >> 2) + 4 * hh;
        float v = sacc[sub][r] * 0.125f;
        bool ok = true;
        if (MODE == 2 && isP) {
          const int kr_ = rlo + j, kc_ = kidx;
          ok = (kr_ >= rsq) && (kr_ < rsq + 8) && (kc_ >= wsq) && (kc_ < wsq + 16);
          const int bi = ok ? ((kr_ - qr + 7) * 31 + (kc_ - qc + 15)) : 0;
          v += sBias[bi];
        }
        if (MODE == 3 && isP) {
          const int kpos = lo + j * 64 + kidx, dlt = kpos - qpos;
          ok = (dlt <= 128) && (dlt >= -128) && (kpos >= 0) && (kpos < 1024);
        }
        v = ok ? v : -1e30f;
        sacc[sub][r] = v;
        mx = fmaxf(mx, v);
      }
    mx = fmaxf(mx, __shfl_xor(mx, 32));
    const float m_new = fmaxf(m_run, mx);
    const float alpha = __expf(m_run - m_new);
    float rsum = 0.f;
#pragma unroll
    for (int sub = 0; sub < 2; ++sub)
#pragma unroll
      for (int r = 0; r < 16; ++r) {
        const float v = sacc[sub][r];
        const float pv = (v > -1e29f) ? __expf(v - m_new) : 0.f;
        sacc[sub][r] = pv; rsum += pv;
      }
    rsum += __shfl_xor(rsum, 32);
    l_run = l_run * alpha + rsum; m_run = m_new;
#pragma unroll
    for (int r = 0; r < 16; ++r) { oacc[0][r] *= alpha; oacc[1][r] *= alpha; }
#pragma unroll
    for (int k4 = 0; k4 < 4; ++k4) {
      const int sub = k4 >> 1, s2 = k4 & 1;
      uint4 pbu;
      pbu.x = pk2(sacc[sub][8 * s2 + 0], sacc[sub][8 * s2 + 1]); pbu.y = pk2(sacc[sub][8 * s2 + 2], sacc[sub][8 * s2 + 3]);
      pbu.z = pk2(sacc[sub][8 * s2 + 4], sacc[sub][8 * s2 + 5]); pbu.w = pk2(sacc[sub][8 * s2 + 6], sacc[sub][8 * s2 + 7]);
      const bf16x8 pb = __builtin_bit_cast(bf16x8, pbu);
#pragma unroll
      for (int dt = 0; dt < 2; ++dt) {
        const char* vp = sV + (dt * 32 + q) * 136 + (16 * k4 + 4 * hh) * 2;
        const uint2 lo8 = *(const uint2*)vp, hi8 = *(const uint2*)(vp + 16);
        uint4 avu; avu.x = lo8.x; avu.y = lo8.y; avu.z = hi8.x; avu.w = hi8.y;
        oacc[dt] = MFMA32(__builtin_bit_cast(bf16x8, avu), pb, oacc[dt]);
      }
    }
  }
#undef ATT_ISSUE
  float scale;
  if (MODE == 1 || MODE == 3) {
    const float m_f = fmaxf(m_run, sink);
    const float e = __expf(m_run - m_f);
    scale = e / (l_run * e + __expf(sink - m_f));
  } else scale = 1.0f / l_run;
#pragma unroll
  for (int dt = 0; dt < 2; ++dt)
#pragma unroll
    for (int g4 = 0; g4 < 4; ++g4) {
      const int d = dt * 32 + 8 * g4 + 4 * hh;
      uint2 o; o.x = pk2(oacc[dt][4 * g4] * scale, oacc[dt][4 * g4 + 1] * scale); o.y = pk2(oacc[dt][4 * g4 + 2] * scale, oacc[dt][4 * g4 + 3] * scale);
      *(uint2*)(Y + (size_t)qrow * D + ocol + d) = o;
    }
  __syncthreads();
}

DEV void post_item(const Params& p, int l, int tile, char* lds) {
  const int t = tid(), r0 = tile * TOKT, c = t;
  bf16_t* sA = (bf16_t*)lds;
  float* sgo = (float*)(lds + 32 * 136 * 2);
  const bf16_t* P = (const bf16_t*)(p.ws + OFF_P);
  bf16_t* Y = (bf16_t*)(p.ws + OFF_YMIX);
  const float* Y0 = (const float*)(p.ws + OFF_YDIR); const float* Y1 = Y0 + ARRF;
  const float* H0 = (const float*)(p.ws + OFF_HDIR); const float* H1 = H0 + ARRF;
  const bf16_t* BON = (const bf16_t*)(p.ws + OFF_BONUS);
  __syncthreads();
#pragma unroll
  for (int i = 0; i < TOKT / 2; ++i) {
    const int e = t + 256 * i, tk = e >> 7, j = e & 127;
    sA[tk * 136 + j] = f2bf(sigmoidf_(bf2f(P[(size_t)(r0 + tk) * DIN + C_GH + j])));
  }
  __syncthreads();
  {
    const int lane = t & 63, w = t >> 6, q = lane & 31, hh = lane >> 5;
    bf16x8 af[8];
#pragma unroll
    for (int s = 0; s < 8; ++s) af[s] = *(const bf16x8*)(sA + q * 136 + 16 * s + 8 * hh);
    const bf16_t* GT = (const bf16_t*)(p.ws + OFF_G2T) + (size_t)l * 256 * 128;
#pragma unroll
    for (int nt = 0; nt < 2; ++nt) {
      const int n = w * 64 + nt * 32 + q;
      f32x16 acc;
#pragma unroll
      for (int r = 0; r < 16; ++r) acc[r] = 0.f;
#pragma unroll
      for (int s = 0; s < 8; ++s) acc = MFMA32(af[s], *(const bf16x8*)(GT + (size_t)n * 128 + 16 * s + 8 * hh), acc);
#pragma unroll
      for (int r = 0; r < 8; ++r) sgo[((r & 3) + 8 * (r >> 2) + 4 * hh) * 256 + n] = acc[r];
      if (hh == 0) {
#pragma unroll
        for (int r = 8; r < 12; ++r) sgo[((r & 3) + 16) * 256 + n] = acc[r];
      }
    }
  }
  __syncthreads();
  const float lnw = p.in[I_LNW][l * 256 + c], lnb = p.in[I_LNB][l * 256 + c], hgn = p.in[I_HGN][l * 256 + c];
  for (int tb = 0; tb < TOKT; tb += 5) {
    float y[5], o[5], bn[5], gv[5], hg[5];
#pragma unroll
    for (int u = 0; u < 5; ++u) {
      const int row = r0 + tb + u;
      const size_t idx = (size_t)row * 256 + c;
      y[u] = Y0[idx] + Y1[idx]; o[u] = H0[idx] + H1[idx]; bn[u] = bf2f(BON[idx]);
      gv[u] = sgo[(tb + u) * 256 + c]; hg[u] = bf2f(P[(size_t)row * DIN + C_HG + c]);
    }
#pragma unroll
    for (int u = 0; u < 5; ++u) {
      const int row = r0 + tb + u;
      const float mu = wave_sum(y[u]) * (1.0f / 64.0f);
      const float dy = y[u] - mu;
      const float var = wave_sum(dy * dy) * (1.0f / 64.0f);
      const float yn = dy * __builtin_amdgcn_rsqf(var + 64e-5f) * lnw + lnb + bn[u];
      Y[(size_t)row * D + c] = f2bf(yn * gv[u]);
      const float ms = wave_sum(o[u] * o[u]) * (1.0f / 64.0f);
      Y[(size_t)row * D + 512 + c] = f2bf(o[u] * __builtin_amdgcn_rsqf(ms + 1e-6f) * hgn * sigmoidf_(hg[u]));
    }
  }
  __syncthreads();
}

constexpr int OFF_CTR_WORD = 3600;
DEV void mixer_phase(const Params& p, int l, char* lds0, volatile LAS unsigned* st, bool rerun) {
  const int hf = half_id(); char* lds = lds0 + hf * 65536;
  const int npairs = (256 + 512 + 512) / 2;
  unsigned* ctr = (unsigned*)(p.ws + OFF_BAR) + OFF_CTR_WORD + 64 * l + (rerun ? 32 : 0);
  bool first = true;
  for (;;) {
    int pair;
    if (first) { pair = (int)blockIdx.x; first = false; }
    else {
      if (threadIdx.x == 0) st[4] = gridDim.x + __hip_atomic_fetch_add(ctr, 1u, __ATOMIC_RELAXED, __HIP_MEMORY_SCOPE_AGENT);
      __syncthreads();
      pair = (int)st[4];
      __syncthreads();
    }
    if (pair >= npairs) break;
    const int it = pair * 2 + hf;
    const bool is_scan = it < 640;
    if (rerun && PROBE_SUB == 1 && !is_scan) continue;
    if (rerun && PROBE_SUB == 2 && is_scan) continue;
    if (rerun && PROBE_SUB == 3 && !(it < 128)) continue;
    if (rerun && PROBE_SUB == 4 && !(it >= 128 && it < 640)) continue;
    if (it < 128) {
      const int idx = it >> 1; const int seq = 32 + (idx >> 5), rem = idx & 31;
      if ((it & 1) == 0) rwkv_scan16(p, l, seq, rem >> 3, (rem >> 2) & 1, rem & 3, lds);
      else hgrn_scan16(p, l, seq, rem >> 3, (rem >> 2) & 1, rem & 3, lds);
    } else if (it < 640) {
      const int idx = (it - 128) & 255; const int seq = idx >> 3, rem = idx & 7;
      if (it < 384) rwkv_scan<2>(p, l, seq, rem >> 1, rem & 1, 0, lds);
      else hgrn_scan<2>(p, l, seq, rem >> 1, rem & 1, 0, lds);
    } else if (it < 704) attn_item<3>(p, l, it - 640, lds);
    else if (it < 768) attn_item<2>(p, l, it - 704, lds);
    else if (it < 1024) attn_item<0>(p, l, it - 768, lds);
    else attn_item<1>(p, l, it - 1024, lds);
  }
}

DEV void run_phase(const Params& p, int ph, char* lds, bool rerun, volatile LAS unsigned* st) {
  if (ph == 0) { phase0(p, lds); return; }
  if (ph == 1) { row_phase(p, 0, 0); return; }
  const int l = (ph - 2) / 9, s = (ph - 2) % 9;
  const bf16_t* H = (const bf16_t*)(p.ws + OFF_H);
  const int hf = half_id(); char* ldsh = lds + hf * 65536;
  switch (s) {
    case 0: gemm_run<0>(p, l, H, (const bf16_t*)(p.ws + OFF_WIN) + (size_t)l * DINP * D, D, DINP, lds); break;
    case 1:
      for (int it = blockIdx.x * 2 + hf; it < 512 + 256; it += gridDim.x * 2) { if (it < 512) prep_item(p, l, it, ldsh); else if (!rerun) rope_item(p, it - 512); }
      break;
    case 2: mixer_phase(p, l, lds, st, rerun); break;
    case 3: for (int it = blockIdx.x * 2 + hf; it < 512; it += gridDim.x * 2) post_item(p, l, it, ldsh); break;
    case 4: gemm_run<1>(p, l, (const bf16_t*)(p.ws + OFF_YMIX), (const bf16_t*)(p.ws + OFF_WOUT) + (size_t)l * D * D, D, D, lds); break;
    case 5: row_phase(p, 1, l); break;
    case 6: gemm_run<2>(p, l, H, (const bf16_t*)(p.ws + OFF_W1) + (size_t)l * FF * D, D, FF, lds); break;
    case 7: gemm_run<1>(p, l, (const bf16_t*)(p.ws + OFF_HID), (const bf16_t*)(p.ws + OFF_W2) + (size_t)l * D * FF, FF, D, lds); break;
    case 8: row_phase(p, 2, l); break;
  }
}

#define XB_TMO      128
#define XB_XCNT(j)  (256  + 64 * (j))
#define XB_XSUB(j)  (1280 + 64 * (j))
#define XB_XGEN(j)  (2304 + 64 * (j))
#define XB_TOP      3328
#define XB_TOPGEN   3392
#define XCD_BAR_WORDS 3456
#define XB_SPIN_CAP (1u << 18)
DEV unsigned xb_ld(unsigned* p) { return __hip_atomic_load(p, __ATOMIC_RELAXED, __HIP_MEMORY_SCOPE_AGENT); }
DEV unsigned xb_add(unsigned* p, unsigned v) { return __hip_atomic_fetch_add(p, v, __ATOMIC_RELAXED, __HIP_MEMORY_SCOPE_AGENT); }
DEV unsigned xb_xcc_id() { return (unsigned)__builtin_amdgcn_s_getreg((3 << 11) | 20) & 0xFu; }
#define XB_SPIN(cond, bar) do { unsigned _sp = 0; while (cond) { __builtin_amdgcn_s_sleep(1); \
    if ((++_sp & 255u) == 0u) { if (xb_ld(&(bar)[XB_TMO])) break; if (_sp > XB_SPIN_CAP) { atomicAdd(&(bar)[XB_TMO], 1u); break; } } } } while (0)
struct XcdBarrier { unsigned* bar; unsigned x; volatile LAS unsigned* st; };
DEV XcdBarrier xcd_barrier_post(unsigned* bar, volatile LAS unsigned* st) {
  XcdBarrier b; b.bar = bar; b.x = xb_xcc_id(); b.st = st;
  if (threadIdx.x == 0) (void)xb_add(&bar[XB_XCNT(b.x)], 1u);
  return b;
}
DEV void xcd_barrier_complete(unsigned* bar, unsigned x, unsigned& nloc, unsigned& nx) {
  const unsigned G = gridDim.x * gridDim.y * gridDim.z;
  unsigned sum, cnt, mine, sp = 0u;
  for (;;) {
    sum = 0u; cnt = 0u; mine = 0u;
#pragma unroll
    for (unsigned j = 0; j < 16; ++j) { const unsigned c = xb_ld(&bar[XB_XCNT(j)]); sum += c; cnt += (c > 0u) ? 1u : 0u; mine = (j == x) ? c : mine; }
    if (sum == G) break;
    __builtin_amdgcn_s_sleep(1);
    if ((++sp & 255u) == 0u) { if (xb_ld(&bar[XB_TMO])) break; if (sp > XB_SPIN_CAP) { atomicAdd(&bar[XB_TMO], 1u); break; } }
  }
  nloc = mine > 0u ? mine : 1u; nx = cnt > 0u ? cnt : 1u;
}
DEV void xcd_barrier(const XcdBarrier& b) {
  asm volatile("s_waitcnt vmcnt(0)" ::: "memory");
  __syncthreads();
  if (threadIdx.x == 0) {
    unsigned* bar = b.bar;
    { size_t zb_; asm volatile("s_mov_b64 %0, 0" : "=s"(zb_)); bar += zb_; }
    __builtin_amdgcn_s_waitcnt(0);
    unsigned nloc = b.st[0], nx = b.st[1];
    if (nloc == 0u) { xcd_barrier_complete(bar, b.x, nloc, nx); b.st[0] = nloc; b.st[1] = nx; }
    const unsigned old = xb_add(&bar[XB_XSUB(b.x)], 1u);
    const unsigned gen = old / nloc;
    if (old + 1u == (gen + 1u) * nloc) {
      __builtin_amdgcn_fence(__ATOMIC_RELEASE, "agent");
      asm volatile("s_waitcnt vmcnt(0)" ::: "memory");
      const unsigned og = xb_add(&bar[XB_TOP], 1u);
      const unsigned tg = og / nx;
      if (og + 1u == (tg + 1u) * nx) xb_add(&bar[XB_TOPGEN], 1u);
      else XB_SPIN(xb_ld(&bar[XB_TOPGEN]) == tg, bar);
      __builtin_amdgcn_fence(__ATOMIC_ACQUIRE, "agent");
      xb_add(&bar[XB_XGEN(b.x)], 1u);
      asm volatile("s_waitcnt vmcnt(0)" ::: "memory");
    } else {
      XB_SPIN(xb_ld(&bar[XB_XGEN(b.x)]) == gen, bar);
      __builtin_amdgcn_fence(__ATOMIC_ACQUIRE, "agent");
      asm volatile("s_waitcnt vmcnt(0)" ::: "memory");
    }
  }
  __syncthreads();
}

DEV int phase_kind(int ph) {
  if (ph == 0) return 0;
  if (ph == 1) return 1;
  const int s = (ph - 2) % 9;
  return s == 0 ? 2 : s == 1 ? 3 : s == 2 ? 4 : s == 3 ? 5 : s == 4 ? 6 : s == 5 ? 1 : s == 6 ? 7 : s == 7 ? 8 : 1;
}

constexpr int LDS_BYTES = 131072 + 64;

__global__ void __launch_bounds__(512, 2) mega(Params p, int ph_lo, int ph_hi) {
  extern __shared__ __attribute__((aligned(16))) unsigned char smem[];
  char* lds = (char*)smem;
  volatile LAS unsigned* st = (volatile LAS unsigned*)((LAS unsigned char*)smem + 131072);
  if (threadIdx.x == 0) { st[0] = 0u; st[1] = 0u; }
  __syncthreads();
  XcdBarrier xb = xcd_barrier_post((unsigned*)(p.ws + OFF_BAR), st);
  if (ph_hi < 0) cg::this_grid().sync();
  char* const ws0 = p.ws; float* const out0 = p.out;
  for (int ph = ph_lo; ph < ph_hi; ++ph) {
    { size_t z0_; asm volatile("s_mov_b64 %0, 0" : "=s"(z0_)); p.ws = ws0 + z0_; p.out = out0 + z0_; }
    run_phase(p, ph, lds, false, st);
    if (PROBE_KIND >= 0 && (PROBE_KIND == 9 || phase_kind(ph) == PROBE_KIND)) {
      xcd_barrier(xb);
      if (PROBE_KIND != 9) run_phase(p, ph, lds, true, st);
    }
    if (ph + 1 < ph_hi) xcd_barrier(xb);
  }
}

extern "C" void kernel_launch(void* const* d_in, const int* in_sizes, int n_in, void* d_out, int out_size, void* d_ws, size_t ws_size,
                              hipStream_t stream) {
  static int grid_blocks = 0;
  if (!grid_blocks) {
    int dev = 0, cus = 0, per_cu = 0;
    (void)hipGetDevice(&dev);
    (void)hipDeviceGetAttribute(&cus, hipDeviceAttributeMultiprocessorCount, dev);
    if (hipFuncSetAttribute((const void*)mega, hipFuncAttributeMaxDynamicSharedMemorySize, LDS_BYTES) != hipSuccess) fprintf(stderr, "hipFuncSetAttribute failed\n");
    (void)hipOccupancyMaxActiveBlocksPerMultiprocessor(&per_cu, mega, 512, LDS_BYTES);
    if (per_cu < 1) fprintf(stderr, "occupancy query reports %d blocks per CU\n", per_cu);
    (void)hipGetLastError();
    grid_blocks = cus;
  }
  if (ws_size < WS_TOTAL) { fprintf(stderr, "workspace too small: %zu < %zu\n", ws_size, (size_t)WS_TOTAL); return; }
  Params p{};
  for (int i = 0; i < 31; ++i) p.in[i] = (const float*)d_in[i];
  p.out = (float*)d_out;
  p.ws = (char*)d_ws;
  (void)hipMemsetAsync((char*)d_ws + OFF_BAR, 0, 16384, stream);
  int lo = 0, hi = NPH;
  void* args[] = {&p, &lo, &hi};
  hipError_t e = hipLaunchCooperativeKernel((void*)mega, dim3(grid_blocks), dim3(512), args, LDS_BYTES, stream);
  if (e != hipSuccess) fprintf(stderr, "cooperative launch failed: %s (grid %d)\n", hipGetErrorString(e), grid_blocks);
}
```

```cpp
#include <hip/hip_runtime.h>
#include <hip/hip_cooperative_groups.h>
#include <cstdio>
#include <cstdint>
namespace cg = cooperative_groups;

#ifndef ONE_LAUNCH
#define ONE_LAUNCH 1
#endif
#define PROBE_KIND -1
#define PROBE_SUB 0

#define DEV __device__ __forceinline__
#define LAS __attribute__((address_space(3)))
typedef unsigned short bf16_t;
typedef short bf16x8 __attribute__((ext_vector_type(8)));
typedef float f32x16 __attribute__((ext_vector_type(16)));
typedef __bf16 bf2_t __attribute__((ext_vector_type(2)));
typedef float f2_t __attribute__((ext_vector_type(2)));

constexpr int D = 1024, DIN = 3712, FF = 4096, NCTX = 8192, MT = 10240;
constexpr int NPH = 38;
constexpr int DINP = 3840;
constexpr int C_R = 0, C_K = 256, C_V = 512, C_GH = 768, C_WHF = 896, C_WHB = 1024;
constexpr int C_NQ = 1152, C_NK = 1408, C_NV = 1664;
constexpr int C_HQ = 1920, C_HI = 2176, C_HG = 2432, C_HFF = 2688, C_HFB = 2944;
constexpr int C_SQ = 3200, C_SK = 3456, C_SV = 3584;
constexpr size_t O_NAT = 10485760, O_SWA = 27262976, O_RW = 35651584, O_HG = 39845888;
constexpr size_t ARRF = (size_t)MT * 256;
constexpr size_t ARR = ARRF * 4;
constexpr size_t OFF_WIN = 0;
constexpr size_t OFF_WOUT = OFF_WIN + (size_t)4 * DINP * D * 2;
constexpr size_t OFF_W1 = OFF_WOUT + (size_t)4 * D * D * 2;
constexpr size_t OFF_W2 = OFF_W1 + (size_t)4 * FF * D * 2;
constexpr size_t OFF_MOD = OFF_W2 + (size_t)4 * FF * D * 2;
constexpr size_t OFF_HGLB = OFF_MOD + (size_t)4 * 3 * 6144 * 4;
constexpr size_t OFF_P = OFF_HGLB + 8192;
constexpr size_t OFF_R1 = OFF_P + (size_t)MT * DIN * 2;
constexpr size_t OFF_H = OFF_R1;
constexpr size_t OFF_HID = OFF_H + (size_t)MT * D * 2;
constexpr size_t OFF_U = OFF_HID + (size_t)MT * FF * 2;
constexpr size_t OFF_PREP = OFF_R1;
constexpr size_t OFF_YDIR = OFF_PREP + 12 * ARR;
constexpr size_t OFF_BONUS = OFF_R1 + 14 * ARR;
constexpr size_t OFF_HDIR = OFF_BONUS + ARR / 2;
constexpr size_t OFF_YMIX = OFF_HDIR + 2 * ARR;
constexpr size_t OFF_X16 = OFF_YMIX + (size_t)MT * D * 2;
constexpr size_t OFF_BAR = OFF_X16 + (size_t)MT * D * 2;
constexpr size_t OFF_W2T = OFF_BAR + 16384;
constexpr size_t OFF_A2T = OFF_W2T + (size_t)4 * 2 * 256 * 64 * 2;
constexpr size_t OFF_G2T = OFF_A2T + (size_t)4 * 2 * 256 * 64 * 2;
constexpr size_t WS_TOTAL = OFF_G2T + (size_t)4 * 256 * 128 * 2;
static_assert(OFF_U + (size_t)MT * D * 4 == OFF_BONUS, "R1 layout");

struct Params {
  const float* in[31];
  float* out;
  char* ws;
};
enum { I_XP = 0, I_XS, I_CNAT, I_CSWA, I_SRW, I_SHG, I_C, I_CCTX, I_NORMG, I_MODW, I_MODB, I_WIN, I_WOUT, I_MURKV, I_MULORA,
       I_W0, I_W2, I_A0, I_A2, I_G2, I_KK, I_KA, I_RK, I_LNW, I_LNB, I_RPB, I_HGLB, I_HGN, I_SINK, I_FW1, I_FW2 };


DEV float bf2f(bf16_t h) { return __uint_as_float(((unsigned)h) << 16); }
DEV unsigned pk2(float a, float b) { f2_t v = {a, b}; bf2_t r = __builtin_convertvector(v, bf2_t); return __builtin_bit_cast(unsigned, r); }
DEV bf16_t f2bf(float f) { return (bf16_t)(pk2(f, f) & 0xffffu); }
DEV float4 bf4(uint2 u) { return make_float4(__uint_as_float(u.x << 16), __uint_as_float(u.x & 0xffff0000u), __uint_as_float(u.y << 16), __uint_as_float(u.y & 0xffff0000u)); }
DEV float bflo(unsigned u) { return __uint_as_float(u << 16); }
DEV float bfhi(unsigned u) { return __uint_as_float(u & 0xffff0000u); }
DEV float rcpf_(float x) { return __builtin_amdgcn_rcpf(x); }
DEV float sigmoidf_(float x) { return rcpf_(1.0f + __expf(-x)); }
DEV float tanhf_(float x) { return 1.0f - 2.0f * rcpf_(1.0f + __expf(2.0f * x)); }
template <int CTRL> DEV float dppf(float x) { return __int_as_float(__builtin_amdgcn_update_dpp(0, __float_as_int(x), CTRL, 0xF, 0xF, false)); }
DEV float row16_sum(float x) { x += dppf<0xB1>(x); x += dppf<0x4E>(x); x += dppf<0x141>(x); x += dppf<0x140>(x); return x; }
DEV float wave_sum(float x) { x = row16_sum(x); x += __shfl_xor(x, 16); x += __shfl_xor(x, 32); return x; }
DEV int clampi(int v, int lo, int hi) { return v < lo ? lo : (v > hi ? hi : v); }
#define MFMA32(a, b, c) __builtin_amdgcn_mfma_f32_32x32x16_bf16((a), (b), (c), 0, 0, 0)

DEV int tid() { int z; asm volatile("v_mov_b32 %0, 0" : "=v"(z)); return (int)(threadIdx.x & 255u) + z; }
DEV int half_id() { return __builtin_amdgcn_readfirstlane((int)(threadIdx.x >> 8)); }
DEV void transpose_item(const float* W, bf16_t* WT, int K, int N, int kt, int nt, char* lds) {
  bf16_t* s = (bf16_t*)lds;
  const int t = tid();
#pragma unroll
  for (int i = 0; i < 4; ++i) {
    const int k = (t >> 4) + 16 * i, n4 = (t & 15) * 4;
    const float4 v = *(const float4*)(W + (size_t)(kt * 64 + k) * N + nt * 64 + n4);
    s[(n4 + 0) * 72 + k] = f2bf(v.x); s[(n4 + 1) * 72 + k] = f2bf(v.y);
    s[(n4 + 2) * 72 + k] = f2bf(v.z); s[(n4 + 3) * 72 + k] = f2bf(v.w);
  }
  __syncthreads();
#pragma unroll
  for (int i = 0; i < 2; ++i) {
    const int n = (t >> 3) + 32 * i, kc = t & 7;
    const uint4 v = *(const uint4*)(s + n * 72 + kc * 8);
    *(uint4*)(WT + (size_t)(nt * 64 + n) * K + kt * 64 + kc * 8) = v;
  }
  __syncthreads();
}

DEV void mod_item(const Params& p, int l, int jb, char* lds) {
  float* sc = (float*)lds;
  float* red = (float*)(lds + 12288);
  const int t = tid();
  for (int i = t; i < 3072; i += 256) {
    const int c = i >> 10, k = i & 1023;
    const float x = (c == 0) ? p.in[I_CCTX][k] : p.in[I_C][(c - 1) * 1024 + k];
    sc[i] = x * rcpf_(1.0f + __expf(-x));
  }
  __syncthreads();
  const int c4 = t & 15, ks = t >> 4;
  const float* wp = p.in[I_MODW] + ((size_t)l * 1024 + ks * 64) * 6144 + jb * 64 + c4 * 4;
  float a00 = 0, a01 = 0, a02 = 0, a03 = 0, a10 = 0, a11 = 0, a12 = 0, a13 = 0, a20 = 0, a21 = 0, a22 = 0, a23 = 0;
#pragma unroll 16
  for (int ii = 0; ii < 64; ++ii) {
    const float4 w = *(const float4*)(wp + (size_t)ii * 6144);
    const int k = ks * 64 + ii;
    const float s0 = sc[k], s1 = sc[1024 + k], s2 = sc[2048 + k];
    a00 += s0 * w.x; a01 += s0 * w.y; a02 += s0 * w.z; a03 += s0 * w.w;
    a10 += s1 * w.x; a11 += s1 * w.y; a12 += s1 * w.z; a13 += s1 * w.w;
    a20 += s2 * w.x; a21 += s2 * w.y; a22 += s2 * w.z; a23 += s2 * w.w;
  }
  float* r0 = red + (ks * 3 + 0) * 64 + c4 * 4; r0[0] = a00; r0[1] = a01; r0[2] = a02; r0[3] = a03;
  float* r1 = red + (ks * 3 + 1) * 64 + c4 * 4; r1[0] = a10; r1[1] = a11; r1[2] = a12; r1[3] = a13;
  float* r2 = red + (ks * 3 + 2) * 64 + c4 * 4; r2[0] = a20; r2[1] = a21; r2[2] = a22; r2[3] = a23;
  __syncthreads();
  if (t < 192) {
    const int c = t >> 6, col = t & 63;
    float v = p.in[I_MODB][l * 6144 + jb * 64 + col];
#pragma unroll
    for (int k2 = 0; k2 < 16; ++k2) v += red[(k2 * 3 + c) * 64 + col];
    ((float*)(p.ws + OFF_MOD))[(size_t)(l * 3 + c) * 6144 + jb * 64 + col] = v;
  }
  __syncthreads();
}

DEV void hglb_item(const Params& p) {
  const int c = tid();
  float* HGLB = (float*)(p.ws + OFF_HGLB);
  for (int dir = 0; dir < 2; ++dir) {
    float x[4], mx = -1e30f;
    for (int l = 0; l < 4; ++l) { x[l] = p.in[I_HGLB][(dir * 4 + l) * 256 + c]; mx = fmaxf(mx, x[l]); }
    float s = 0;
    for (int l = 0; l < 4; ++l) { x[l] = __expf(x[l] - mx); s += x[l]; }
    float cum = 0; const float s0 = x[0] / s;
    for (int l = 0; l < 4; ++l) { cum += x[l] / s; HGLB[(l * 2 + dir) * 256 + c] = cum - s0; }
  }
}

constexpr int NT_LAYER = 928 + 256 + 1024 + 1024;
struct TileDesc { const float* W; bf16_t* WT; int K, N, kt, nt; };
DEV TileDesc layer_tile_desc(const Params& p, int l, int j) {
  TileDesc d;
  if (j < 928) { d.W = p.in[I_WIN] + (size_t)l * D * DIN; d.WT = (bf16_t*)(p.ws + OFF_WIN) + (size_t)l * DINP * D; d.K = D; d.N = DIN; d.kt = j / 58; d.nt = j % 58; return d; }
  j -= 928;
  if (j < 256) { d.W = p.in[I_WOUT] + (size_t)l * D * D; d.WT = (bf16_t*)(p.ws + OFF_WOUT) + (size_t)l * D * D; d.K = D; d.N = D; d.kt = j / 16; d.nt = j % 16; return d; }
  j -= 256;
  if (j < 1024) { d.W = p.in[I_FW1] + (size_t)l * D * FF; d.WT = (bf16_t*)(p.ws + OFF_W1) + (size_t)l * FF * D; d.K = D; d.N = FF; d.kt = j / 64; d.nt = j % 64; return d; }
  j -= 1024;
  d.W = p.in[I_FW2] + (size_t)l * FF * D; d.WT = (bf16_t*)(p.ws + OFF_W2) + (size_t)l * D * FF; d.K = FF; d.N = D; d.kt = j / 16; d.nt = j % 16; return d;
}
DEV void tile_load(const TileDesc& d, float4 (&v)[4]) {
  const int t = tid();
#pragma unroll
  for (int i = 0; i < 4; ++i) v[i] = *(const float4*)(d.W + (size_t)(d.kt * 64 + (t >> 4) + 16 * i) * d.N + d.nt * 64 + (t & 15) * 4);
}
DEV void tile_store(const TileDesc& d, const float4 (&v)[4], char* lds) {
  bf16_t* s = (bf16_t*)lds;
  const int t = tid();
#pragma unroll
  for (int i = 0; i < 4; ++i) {
    const int k = (t >> 4) + 16 * i, n4 = (t & 15) * 4;
    s[(n4 + 0) * 72 + k] = f2bf(v[i].x); s[(n4 + 1) * 72 + k] = f2bf(v[i].y);
    s[(n4 + 2) * 72 + k] = f2bf(v[i].z); s[(n4 + 3) * 72 + k] = f2bf(v[i].w);
  }
  __syncthreads();
#pragma unroll
  for (int i = 0; i < 2; ++i) {
    const int n = (t >> 3) + 32 * i, kc = t & 7;
    const uint4 o = *(const uint4*)(s + n * 72 + kc * 8);
    *(uint4*)(d.WT + (size_t)(d.nt * 64 + n) * d.K + d.kt * 64 + kc * 8) = o;
  }
  __syncthreads();
}
DEV void layer_tiles(const Params& p, int l, int lo, int hi, int vb, int nvb, char* lds0) {
  const int hf = half_id(); char* lds = lds0 + hf * 65536;
  int it = lo + vb * 2 + hf;
  if (it >= hi) return;
  float4 vn[4];
  TileDesc dn = layer_tile_desc(p, l, it);
  tile_load(dn, vn);
  for (; it < hi; it += nvb * 2) {
    float4 vc[4] = {vn[0], vn[1], vn[2], vn[3]};
    const TileDesc dc = dn;
    if (it + nvb * 2 < hi) { dn = layer_tile_desc(p, l, it + nvb * 2); tile_load(dn, vn); }
    tile_store(dc, vc, lds);
  }
}

DEV void phase0(const Params& p, char* lds0) {
  const int hf = half_id(); char* lds = lds0 + hf * 65536;
  const int nitems = 386 + 4 + 20;
  for (int it = blockIdx.x * 2 + hf; it < nitems; it += gridDim.x * 2) {
    if (it < 384) { mod_item(p, it / 96, it % 96, lds); continue; }
    if (it == 384) { hglb_item(p); continue; }
    if (it == 385) continue;
    const int j = it - 386;
    if (j >= 4) {
      const int s = j - 4, n = tid();
      const float* src; bf16_t* dst; int KK;
      if (s < 8) { src = p.in[I_W2] + (size_t)s * 64 * 256; dst = (bf16_t*)(p.ws + OFF_W2T) + (size_t)s * 256 * 64; KK = 64; }
      else if (s < 16) { src = p.in[I_A2] + (size_t)(s - 8) * 64 * 256; dst = (bf16_t*)(p.ws + OFF_A2T) + (size_t)(s - 8) * 256 * 64; KK = 64; }
      else { src = p.in[I_G2] + (size_t)(s - 16) * 128 * 256; dst = (bf16_t*)(p.ws + OFF_G2T) + (size_t)(s - 16) * 256 * 128; KK = 128; }
      for (int k0 = 0; k0 < KK; k0 += 32) {
        float v[32];
#pragma unroll
        for (int e = 0; e < 32; ++e) v[e] = src[(size_t)(k0 + e) * 256 + n];
#pragma unroll
        for (int q4 = 0; q4 < 4; ++q4) {
          uint4 o; o.x = pk2(v[8 * q4], v[8 * q4 + 1]); o.y = pk2(v[8 * q4 + 2], v[8 * q4 + 3]); o.z = pk2(v[8 * q4 + 4], v[8 * q4 + 5]); o.w = pk2(v[8 * q4 + 6], v[8 * q4 + 7]);
          *(uint4*)(dst + (size_t)n * KK + k0 + 8 * q4) = o;
        }
      }
      continue;
    }
    {
      uint4* z = (uint4*)((bf16_t*)(p.ws + OFF_WIN) + ((size_t)j * DINP + DIN) * D);
      const int t = tid();
      for (int i = t; i < 128 * D * 2 / 16; i += 256) z[i] = make_uint4(0u, 0u, 0u, 0u);
    }
  }
  const int vb = ((int)blockIdx.x + (int)gridDim.x - 195 % (int)gridDim.x) % (int)gridDim.x;
  layer_tiles(p, 0, 0, NT_LAYER, vb, (int)gridDim.x, lds0);
  if ((int)gridDim.x <= 160) { for (int ll = 1; ll < 4; ++ll) layer_tiles(p, ll, 0, NT_LAYER, (int)blockIdx.x, (int)gridDim.x, lds0); }
}

constexpr int RPW = 5;
DEV void row_phase(const Params& p, int mode, int l) {
  const int lane = tid() & 63;
  const int nw = gridDim.x * 8;
  const float* MOD = (const float*)(p.ws + OFF_MOD);
  const float* NG = p.in[I_NORMG];
  const bf16_t* U = (const bf16_t*)(p.ws + OFF_U);
  bf16_t* H = (bf16_t*)(p.ws + OFF_H);
  bf16_t* X16 = (bf16_t*)(p.ws + OFF_X16);
  const bool has_next = !(mode == 2 && l == 3);
  const int ln = (mode == 0) ? 0 : (mode == 1 ? l : l + 1);
  const int gi = (mode == 1) ? 2 : 0, shi = (mode == 1) ? 3 : 0, sci = (mode == 1) ? 4 : 1;
  const float* ga = NG + (size_t)(l * 4 + (mode == 1 ? 1 : 3)) * 1024;
  const float* gb = NG + (size_t)((has_next ? ln : 0) * 4 + gi) * 1024;
  for (int rowa = blockIdx.x * 8 + half_id() * 4 + (tid() >> 6); rowa < MT; rowa += RPW * nw) {
    float4 x[RPW][4]; uint2 ub[RPW][4];
    int rows[RPW]; bool ok[RPW];
#pragma unroll
    for (int q = 0; q < RPW; ++q) {
      rows[q] = rowa + q * nw; ok[q] = rows[q] < MT;
      const int row = ok[q] ? rows[q] : rowa;
      if (mode == 0) {
        const float* src = row < NCTX ? p.in[I_XP] + (size_t)row * D : p.in[I_XS] + (size_t)(row - NCTX) * D;
#pragma unroll
        for (int i = 0; i < 4; ++i) x[q][i] = *(const float4*)(src + i * 256 + lane * 4);
      } else {
#pragma unroll
        for (int i = 0; i < 4; ++i) {
          const uint2 xb = *(const uint2*)(X16 + (size_t)row * D + i * 256 + lane * 4);
          x[q][i] = make_float4(bflo(xb.x), bfhi(xb.x), bflo(xb.y), bfhi(xb.y));
          ub[q][i] = *(const uint2*)(U + (size_t)row * D + i * 256 + lane * 4);
        }
      }
    }
#pragma unroll
    for (int q = 0; q < RPW; ++q) {
      const int row = ok[q] ? rows[q] : rowa;
      const int cond = row < NCTX ? 0 : 1 + ((row - NCTX) >> 10);
      if (mode != 0) {
        float4 u[4];
        float ss = 0;
#pragma unroll
        for (int i = 0; i < 4; ++i) {
          u[i] = make_float4(bflo(ub[q][i].x), bfhi(ub[q][i].x), bflo(ub[q][i].y), bfhi(ub[q][i].y));
          ss += u[i].x * u[i].x + u[i].y * u[i].y + u[i].z * u[i].z + u[i].w * u[i].w;
        }
        ss = wave_sum(ss);
        const float r = __builtin_amdgcn_rsqf(ss * (1.0f / 1024.0f) + 1e-6f);
        const float* gate = MOD + (size_t)(l * 3 + cond) * 6144 + (mode == 1 ? 2 : 5) * 1024;
#pragma unroll
        for (int i = 0; i < 4; ++i) {
          const float4 g4 = *(const float4*)(gate + i * 256 + lane * 4);
          const float4 a4 = *(const float4*)(ga + i * 256 + lane * 4);
          x[q][i].x += g4.x * (u[i].x * r * a4.x); x[q][i].y += g4.y * (u[i].y * r * a4.y);
          x[q][i].z += g4.z * (u[i].z * r * a4.z); x[q][i].w += g4.w * (u[i].w * r * a4.w);
        }
      }
      if (ok[q]) {
        if (has_next) {
#pragma unroll
          for (int i = 0; i < 4; ++i) { uint2 o; o.x = pk2(x[q][i].x, x[q][i].y); o.y = pk2(x[q][i].z, x[q][i].w); *(uint2*)(X16 + (size_t)row * D + i * 256 + lane * 4) = o; }
        } else {
#pragma unroll
          for (int i = 0; i < 4; ++i) *(float4*)(p.out + (size_t)row * D + i * 256 + lane * 4) = x[q][i];
        }
      }
      if (has_next) {
        float ss = 0;
#pragma unroll
        for (int i = 0; i < 4; ++i) ss += x[q][i].x * x[q][i].x + x[q][i].y * x[q][i].y + x[q][i].z * x[q][i].z + x[q][i].w * x[q][i].w;
        ss = wave_sum(ss);
        const float r2 = __builtin_amdgcn_rsqf(ss * (1.0f / 1024.0f) + 1e-6f);
        const float* sh = MOD + (size_t)(ln * 3 + cond) * 6144 + shi * 1024;
        const float* sc = MOD + (size_t)(ln * 3 + cond) * 6144 + sci * 1024;
        if (ok[q]) {
#pragma unroll
          for (int i = 0; i < 4; ++i) {
            const float4 g4 = *(const float4*)(gb + i * 256 + lane * 4);
            const float4 s4 = *(const float4*)(sc + i * 256 + lane * 4);
            const float4 h4 = *(const float4*)(sh + i * 256 + lane * 4);
            const float h0 = x[q][i].x * r2 * g4.x * (1.0f + s4.x) + h4.x;
            const float h1 = x[q][i].y * r2 * g4.y * (1.0f + s4.y) + h4.y;
            const float h2 = x[q][i].z * r2 * g4.z * (1.0f + s4.z) + h4.z;
            const float h3 = x[q][i].w * r2 * g4.w * (1.0f + s4.w) + h4.w;
            uint2 o; o.x = pk2(h0, h1); o.y = pk2(h2, h3);
            *(uint2*)(H + (size_t)row * D + i * 256 + lane * 4) = o;
          }
        }
      }
    }
  }
}

namespace pg8 {
#define PG8_LAS __attribute__((address_space(3)))
typedef unsigned short bf16_t;
typedef short bf16x8 __attribute__((ext_vector_type(8)));
typedef float f32x4 __attribute__((ext_vector_type(4)));
typedef unsigned u32x4 __attribute__((ext_vector_type(4)));
constexpr int BM = 256, BK = 64, HALF = 128, HTB = HALF * BK * 2  , STAGE_BYTES = 8 * HTB, NXCD = 8, WGM = 8;

__host__ __device__ __forceinline__ int lds_byte(int r, int c) { const int st = (r >> 4) * 2 + (c >> 5), rr = r & 15, cc = c & 31, ob = rr * 64 + cc * 2; return st * 1024 + (ob ^ (((ob >> 9) & 1) << 5)); }
__host__ __device__ __forceinline__ void stage_rc(int b, int& R, int& C) { const int st = b / 1024, sb = b % 1024, swz = sb ^ (((sb >> 9) & 1) << 5); R = (st >> 1) * 16 + swz / 64; C = (st & 1) * 32 + (swz % 64) / 2; }
__host__ __device__ __forceinline__ int perm32(int rho) { const int n = rho >> 4, i = rho & 15; return 8 * (i >> 2) + 4 * n + (i & 3); }

struct Unit { int pm, pn; };
struct Gemm { const bf16_t* A; const bf16_t* Bt; int M, N, K; };

struct StaticOrder {
    int nM, nN, nwg, G, c;
    __host__ __device__ void init(int M, int N, int G_, int c_) { nM = M / BM; nN = N / BM; nwg = nM * nN; G = G_; c = c_; }
    __host__ __device__ bool next(int i, Unit& u) const {
        const long L = (long)i * G + c; if (L >= nwg) return false;
        int wgid = (int)L; { const int q = nwg / NXCD, r = nwg % NXCD, xcd = wgid % NXCD, off = wgid / NXCD; wgid = (xcd < r ? xcd * (q + 1) : r * (q + 1) + (xcd - r) * q) + off; }
        const int nig = WGM * nN, gid = wgid / nig, fm = gid * WGM, gsz = (nM - fm) < WGM ? (nM - fm) : WGM;
        u.pm = fm + ((wgid % nig) % gsz); u.pn = (wgid % nig) / gsz; return true;
    }
    __device__ __forceinline__ void a_ready(const Unit&) const {}
    __device__ __forceinline__ void done(const Unit&) const {}
};

template <class Epi, class Sched, bool ALIGN_EPI = false, bool SP2 = false>
__device__ __forceinline__ void gemm_phase(PG8_LAS unsigned char* lds, const Gemm g, const Sched& S, const Epi& E) {
    int tid_z; asm volatile("v_mov_b32 %0, 0" : "=v"(tid_z)); const int tid = (int)threadIdx.x + tid_z, wid = __builtin_amdgcn_readfirstlane(tid >> 6), lane = tid & 63, wr = wid >> 2, wc = wid & 3, fr = lane & 15, fq = lane >> 4;
    const int K = g.K, nt = K / BK;
    unsigned voffA[2], voffB[2];
#pragma unroll
    for (int i = 0; i < 2; ++i) { int R, C; stage_rc(tid * 16 + i * 8192, R, C); const int Rb = Epi::PERM ? ((R & ~31) + perm32(R & 31)) : R;
        voffA[i] = (unsigned)(R * K + C) * 2u; voffB[i] = (unsigned)(Rb * K + C) * 2u; }
    const size_t kstep = (size_t)(BK * 2);
    const size_t hstep = (size_t)HALF * K * 2;
    const size_t tstep = 2 * hstep;
    const unsigned ldsw = (unsigned)wid * 1024u;
    const int aoff = lds_byte(wr * 64 + fr, fq * 8), boff = lds_byte(wc * 32 + fr, fq * 8);
#define PG8_SA(b, h) (((b) * 2 + (h)) * HTB)
#define PG8_SB(b, h) ((4 + (b) * 2 + (h)) * HTB)
#define PG8_STAGE(bufoff, gbase, voff) do { _Pragma("unroll") for (int _i = 0; _i < 2; ++_i) \
        __builtin_amdgcn_global_load_lds((const unsigned*)((const char*)(gbase) + (voff)[_i]), (PG8_LAS unsigned*)(lds + (bufoff) + ldsw + _i * 8192), 16, 0, 0); } while (0)
#define PG8_LDA(dst, b, h) do { _Pragma("unroll") for (int m = 0; m < 4; ++m) _Pragma("unroll") for (int k = 0; k < 2; ++k) dst[m][k] = *(const PG8_LAS bf16x8*)(lds + PG8_SA(b, h) + aoff + m * 2048 + k * 1024); } while (0)
#define PG8_LDB(dst, b, h) do { _Pragma("unroll") for (int n = 0; n < 2; ++n) _Pragma("unroll") for (int k = 0; k < 2; ++k) dst[n][k] = *(const PG8_LAS bf16x8*)(lds + PG8_SB(b, h) + boff + n * 2048 + k * 1024); } while (0)
#define PG8_MMA(ai, bj, At, Bt) do { __builtin_amdgcn_s_setprio(1); _Pragma("unroll") for (int m = 0; m < 4; ++m) _Pragma("unroll") for (int n = 0; n < 2; ++n) _Pragma("unroll") for (int k = 0; k < 2; ++k) \
        acc[ai][bj][m][n] = __builtin_amdgcn_mfma_f32_16x16x32_bf16(Bt[n][k], At[m][k], acc[ai][bj][m][n], 0, 0, 0); __builtin_amdgcn_s_setprio(0); } while (0)
#define PG8_WAIT_V(n) asm volatile("s_waitcnt vmcnt(" #n ")" ::: "memory")
#define PG8_WAIT_L(n) asm volatile("s_waitcnt lgkmcnt(" #n ")" ::: "memory")
#define PG8_BAR __builtin_amdgcn_s_barrier()
#define PG8_SCHED __builtin_amdgcn_sched_barrier(0)
    Unit cur, nxt; int ui = 0;
    if (!S.next(0, cur)) return;
    f32x4 acc[2][2][4][2];
#pragma unroll
    for (int a = 0; a < 2; ++a)
#pragma unroll
        for (int b = 0; b < 2; ++b)
#pragma unroll
            for (int m = 0; m < 4; ++m)
#pragma unroll
                for (int n = 0; n < 2; ++n) acc[a][b][m][n] = (f32x4){0.f, 0.f, 0.f, 0.f};
    bf16x8 At[4][2], B0[2][2], B1[2][2];
    const char* cA = (const char*)g.A + (size_t)cur.pm * tstep; const char* cB = (const char*)g.Bt + (size_t)cur.pn * tstep;
    S.a_ready(cur);
    if constexpr (SP2) {
        PG8_STAGE(PG8_SB(0, 0), cB, voffB); PG8_STAGE(PG8_SB(0, 1), cB + hstep, voffB); PG8_STAGE(PG8_SA(0, 0), cA, voffA); PG8_STAGE(PG8_SA(0, 1), cA + hstep, voffA);
        if (wr == 1) PG8_BAR;
        PG8_WAIT_V(2); PG8_BAR;
        PG8_STAGE(PG8_SB(1, 0), cB + kstep, voffB); PG8_STAGE(PG8_SA(1, 0), cA + kstep, voffA); PG8_STAGE(PG8_SB(1, 1), cB + hstep + kstep, voffB);
        PG8_WAIT_V(6); PG8_BAR;
    } else {
        PG8_STAGE(PG8_SB(0, 0), cB, voffB); PG8_STAGE(PG8_SA(0, 0), cA, voffA); PG8_STAGE(PG8_SB(0, 1), cB + hstep, voffB); PG8_STAGE(PG8_SA(0, 1), cA + hstep, voffA);
        if (wr == 1) PG8_BAR;
        PG8_WAIT_V(4); PG8_BAR;
        PG8_STAGE(PG8_SB(1, 0), cB + kstep, voffB); PG8_STAGE(PG8_SA(1, 0), cA + kstep, voffA); PG8_STAGE(PG8_SB(1, 1), cB + hstep + kstep, voffB);
        PG8_WAIT_V(6); PG8_BAR;
    }
    for (;;) {
        const bool has_next = S.next(ui + 1, nxt);
        const char* nA = has_next ? (const char*)g.A + (size_t)nxt.pm * tstep : cA; const char* nB = has_next ? (const char*)g.Bt + (size_t)nxt.pn * tstep : cB;
        for (int t = 0; t < nt; t += 2) {
            const bool last = (t == nt - 2);
            const char* a1 = cA + (size_t)(t + 1) * kstep;
            const char* a2 = last ? nA : cA + (size_t)(t + 2) * kstep; const char* b2 = last ? nB : cB + (size_t)(t + 2) * kstep;
            const char* a3 = a2 + kstep; const char* b3 = b2 + kstep;
            if (last && has_next) S.a_ready(nxt);
            if constexpr (SP2) {
            PG8_LDB(B0, 0, 0); PG8_LDB(B1, 0, 1); PG8_SCHED; PG8_LDA(At, 0, 0); PG8_STAGE(PG8_SA(1, 1), a1 + hstep, voffA);
            PG8_WAIT_V(8); PG8_WAIT_L(0); PG8_BAR; PG8_MMA(0, 0, At, B0); PG8_MMA(0, 1, At, B1); PG8_BAR; PG8_SCHED;
            PG8_LDA(At, 0, 1); PG8_STAGE(PG8_SB(0, 0), b2, voffB); PG8_STAGE(PG8_SB(0, 1), b2 + hstep, voffB); PG8_STAGE(PG8_SA(0, 0), a2, voffA);
            PG8_WAIT_V(8); PG8_WAIT_L(0); PG8_BAR; PG8_MMA(1, 0, At, B0); PG8_MMA(1, 1, At, B1); PG8_BAR; PG8_SCHED;
            PG8_LDB(B0, 1, 0); PG8_LDB(B1, 1, 1); PG8_SCHED; PG8_LDA(At, 1, 0); PG8_STAGE(PG8_SA(0, 1), a2 + hstep, voffA);
            PG8_WAIT_V(8); PG8_WAIT_L(0); PG8_BAR; PG8_MMA(0, 0, At, B0); PG8_MMA(0, 1, At, B1); PG8_BAR; PG8_SCHED;
            PG8_LDA(At, 1, 1); PG8_STAGE(PG8_SB(1, 0), b3, voffB); PG8_STAGE(PG8_SB(1, 1), b3 + hstep, voffB); PG8_STAGE(PG8_SA(1, 0), a3, voffA);
            PG8_WAIT_V(8); PG8_WAIT_L(0); PG8_BAR; PG8_MMA(1, 0, At, B0); PG8_MMA(1, 1, At, B1); PG8_BAR; PG8_SCHED;
            } else {
            PG8_LDB(B0, 0, 0); PG8_SCHED; PG8_LDA(At, 0, 0); PG8_STAGE(PG8_SA(1, 1), a1 + hstep, voffA);
            PG8_WAIT_L(8); PG8_BAR; PG8_WAIT_L(0); PG8_MMA(0, 0, At, B0); PG8_BAR; PG8_SCHED;
            PG8_LDB(B1, 0, 1); PG8_STAGE(PG8_SB(0, 0), b2, voffB);
            PG8_BAR; PG8_WAIT_L(0); PG8_MMA(0, 1, At, B1); PG8_BAR;
            PG8_LDA(At, 0, 1); PG8_STAGE(PG8_SA(0, 0), a2, voffA);
            PG8_BAR; PG8_WAIT_L(0); PG8_MMA(1, 0, At, B0); PG8_BAR; PG8_SCHED;
            PG8_STAGE(PG8_SB(0, 1), b2 + hstep, voffB);
            PG8_WAIT_V(6); PG8_BAR; PG8_MMA(1, 1, At, B1); PG8_BAR;
            PG8_LDB(B0, 1, 0); PG8_SCHED; PG8_LDA(At, 1, 0); PG8_STAGE(PG8_SA(0, 1), a2 + hstep, voffA);
            PG8_WAIT_L(8); PG8_BAR; PG8_WAIT_L(0); PG8_MMA(0, 0, At, B0); PG8_BAR; PG8_SCHED;
            PG8_LDB(B1, 1, 1); PG8_STAGE(PG8_SB(1, 0), b3, voffB);
            PG8_BAR; PG8_WAIT_L(0); PG8_MMA(0, 1, At, B1); PG8_BAR;
            PG8_LDA(At, 1, 1); PG8_STAGE(PG8_SA(1, 0), a3, voffA);
            PG8_BAR; PG8_WAIT_L(0); PG8_MMA(1, 0, At, B0); PG8_BAR; PG8_SCHED;
            PG8_STAGE(PG8_SB(1, 1), b3 + hstep, voffB);
            PG8_WAIT_V(6); PG8_BAR; PG8_MMA(1, 1, At, B1); PG8_BAR;
            }
        }
        if constexpr (ALIGN_EPI) { if (wr == 0) PG8_BAR; }
        if constexpr (!Epi::AFTER_DRAIN) { E(acc, cur, wr, wc, fr, fq); S.done(cur); }
        if (!has_next) break;
#pragma unroll
        for (int a = 0; a < 2; ++a)
#pragma unroll
            for (int b = 0; b < 2; ++b)
#pragma unroll
                for (int m = 0; m < 4; ++m)
#pragma unroll
                    for (int n = 0; n < 2; ++n) acc[a][b][m][n] = (f32x4){0.f, 0.f, 0.f, 0.f};
        cur = nxt; cA = nA; cB = nB; ++ui;
        if constexpr (ALIGN_EPI) { if (wr == 1) PG8_BAR; }
    }
    PG8_WAIT_V(0);
    if constexpr (!ALIGN_EPI) { if (wr == 0) PG8_BAR; }
    PG8_BAR;
    if constexpr (Epi::AFTER_DRAIN) { E.fused(acc, cur, wr, wc, fr, fq, lds, wid, lane); S.done(cur); }
#undef PG8_SA
#undef PG8_SB
#undef PG8_STAGE
#undef PG8_LDA
#undef PG8_LDB
#undef PG8_MMA
#undef PG8_WAIT_V
#undef PG8_WAIT_L
#undef PG8_BAR
#undef PG8_SCHED
}
}

template <int MODE> struct EpiMK {
  static constexpr bool PERM = true, AFTER_DRAIN = false;
  const Params* pp; int l;
  DEV void operator()(const pg8::f32x4 (&acc)[2][2][4][2], const pg8::Unit& u, int wr, int wc, int fr, int fq) const {
    const Params& p = *pp;
#pragma unroll
    for (int ai = 0; ai < 2; ++ai)
#pragma unroll
      for (int m = 0; m < 4; ++m) {
        const int row = u.pm * 256 + ai * 128 + wr * 64 + m * 16 + fr;
#pragma unroll
        for (int bj = 0; bj < 2; ++bj) {
          const int col = u.pn * 256 + bj * 128 + wc * 32 + fq * 8;
          const pg8::f32x4 v0 = acc[ai][bj][m][0], v1 = acc[ai][bj][m][1];
          if (MODE == 0) {
            if (col < DIN) {
              uint4 o; o.x = pk2(v0[0], v0[1]); o.y = pk2(v0[2], v0[3]); o.z = pk2(v1[0], v1[1]); o.w = pk2(v1[2], v1[3]);
              *(uint4*)((bf16_t*)(p.ws + OFF_P) + (size_t)row * DIN + col) = o;
              if (row < NCTX) {
                if (col >= C_NK && col < C_HQ) {
                  const int kv = col >= C_NV;
                  float* dst = p.out + O_NAT + (size_t)(((row >> 8) * 4 + l) * 2 + kv) * 65536 + (row & 255) * 256 + (col - (kv ? C_NV : C_NK));
                  *(pg8::f32x4*)dst = v0; *(pg8::f32x4*)(dst + 4) = v1;
                } else if (col >= C_SK) {
                  const int kv = col >= C_SV;
                  float* dst = p.out + O_SWA + (size_t)(((row >> 8) * 4 + l) * 2 + kv) * 32768 + (row & 255) * 128 + (col - (kv ? C_SV : C_SK));
                  *(pg8::f32x4*)dst = v0; *(pg8::f32x4*)(dst + 4) = v1;
                }
              }
            }
          } else if (MODE == 1) {
            uint4 o; o.x = pk2(v0[0], v0[1]); o.y = pk2(v0[2], v0[3]); o.z = pk2(v1[0], v1[1]); o.w = pk2(v1[2], v1[3]);
            *(uint4*)((bf16_t*)(p.ws + OFF_U) + (size_t)row * D + col) = o;
          } else {
            float r[8];
#pragma unroll
            for (int e = 0; e < 4; ++e) { const float a = fmaxf(v0[e], 0.f), b2 = fmaxf(v1[e], 0.f); r[e] = a * a; r[4 + e] = b2 * b2; }
            uint4 o; o.x = pk2(r[0], r[1]); o.y = pk2(r[2], r[3]); o.z = pk2(r[4], r[5]); o.w = pk2(r[6], r[7]);
            *(uint4*)((bf16_t*)(p.ws + OFF_HID) + (size_t)row * FF + col) = o;
          }
        }
      }
  }
};

template <int MODE>
DEV void gemm_run(const Params& p, int l, const bf16_t* A, const bf16_t* BT, int K, int N, char* lds) {
  pg8::Gemm g{A, BT, MT, N, K};
  pg8::StaticOrder S; S.init(MT, N, (int)gridDim.x, (int)blockIdx.x);
  EpiMK<MODE> E{&p, l};
  pg8::gemm_phase<EpiMK<MODE>, pg8::StaticOrder, true, true>((PG8_LAS unsigned char*)lds, g, S, E);
  if (MODE == 1 && l < 3 && (int)gridDim.x > 160 && (int)blockIdx.x >= 160) {
    if (K == D) layer_tiles(p, l + 1, 0, 640, (int)blockIdx.x - 160, (int)gridDim.x - 160, lds);
    else layer_tiles(p, l + 1, 640, NT_LAYER, (int)blockIdx.x - 160, (int)gridDim.x - 160, lds);
  }
}

constexpr int TOKT = 20;
DEV void prep_item(const Params& p, int l, int tile, char* lds) {
  const int t = tid(), r0 = tile * TOKT, c = t;
  bf16_t* sA = (bf16_t*)lds;
  float* swl = (float*)(lds + 32 * 136 * 2);
  float* sal = swl + TOKT * 256;
  const bf16_t* P = (const bf16_t*)(p.ws + OFF_P);
  bf16_t* PREP = (bf16_t*)(p.ws + OFF_PREP);
  bf16_t* BON = (bf16_t*)(p.ws + OFF_BONUS);
  for (int dir = 0; dir < 2; ++dir) {
    __syncthreads();
#pragma unroll
    for (int i = 0; i < TOKT / 2; ++i) {
      const int e = t + 256 * i, tk = e >> 7, j = e & 127, which = j >> 6, jj = j & 63;
      const int row = r0 + tk, prow = dir ? row + 1 : row - 1;
      const int tis = row < NCTX ? (row & 255) : ((row - NCTX) & 1023), Tm1 = row < NCTX ? 255 : 1023;
      const bool pv = dir ? (tis < Tm1) : (tis > 0);
      const int col = (dir ? C_WHB : C_WHF) + which * 64 + jj;
      const float cur = bf2f(P[(size_t)row * DIN + col]);
      const float prev = bf2f(P[(size_t)(pv ? prow : row) * DIN + col]) * (pv ? 1.f : 0.f);
      const float mu = p.in[I_MULORA][((l * 2 + dir) * 2 + which) * 64 + jj];
      const float val = cur + (prev - cur) * mu;
      sA[tk * 136 + j] = f2bf((which == 0) ? tanhf_(val) : val);
    }
    __syncthreads();
    {
      const int lane = t & 63, w = t >> 6, q = lane & 31, hh = lane >> 5;
#pragma unroll
      for (int mat = 0; mat < 2; ++mat) {
        bf16x8 af[4];
#pragma unroll
        for (int s = 0; s < 4; ++s) af[s] = *(const bf16x8*)(sA + q * 136 + mat * 64 + 16 * s + 8 * hh);
        const bf16_t* WT = (const bf16_t*)(p.ws + (mat ? OFF_A2T : OFF_W2T)) + (size_t)(l * 2 + dir) * 256 * 64;
        float* dst = mat ? sal : swl;
#pragma unroll
        for (int nt = 0; nt < 2; ++nt) {
          const int n = w * 64 + nt * 32 + q;
          f32x16 acc;
#pragma unroll
          for (int r = 0; r < 16; ++r) acc[r] = 0.f;
#pragma unroll
          for (int s = 0; s < 4; ++s) acc = MFMA32(af[s], *(const bf16x8*)(WT + (size_t)n * 64 + 16 * s + 8 * hh), acc);
#pragma unroll
          for (int r = 0; r < 8; ++r) dst[((r & 3) + 8 * (r >> 2) + 4 * hh) * 256 + n] = acc[r];
          if (hh == 0) {
#pragma unroll
            for (int r = 8; r < 12; ++r) dst[((r & 3) + 16) * 256 + n] = acc[r];
          }
        }
      }
    }
    __syncthreads();
    const float w0v = p.in[I_W0][(l * 2 + dir) * 256 + c], a0v = p.in[I_A0][(l * 2 + dir) * 256 + c];
    const float kkv = p.in[I_KK][l * 256 + c], kav = p.in[I_KA][l * 256 + c], rkv = p.in[I_RK][l * 256 + c];
    const float mur = p.in[I_MURKV][((l * 2 + dir) * 3 + 0) * 256 + c], muk = p.in[I_MURKV][((l * 2 + dir) * 3 + 1) * 256 + c],
                muv = p.in[I_MURKV][((l * 2 + dir) * 3 + 2) * 256 + c];
    bf16_t* pr = PREP + (size_t)dir * 6 * ARRF;
    for (int tb = 0; tb < TOKT; tb += 5) {
      float rc[5], kc[5], vc[5], rp[5], kq[5], vp[5], wlv[5], alv[5];
#pragma unroll
      for (int u = 0; u < 5; ++u) {
        const int tk = tb + u, row = r0 + tk, prow = dir ? row + 1 : row - 1;
        const int tis = row < NCTX ? (row & 255) : ((row - NCTX) & 1023), Tm1 = row < NCTX ? 255 : 1023;
        const bool pv = dir ? (tis < Tm1) : (tis > 0);
        const float pm = pv ? 1.f : 0.f;
        const bf16_t* pc = P + (size_t)row * DIN + c;
        const bf16_t* pp = P + (size_t)(pv ? prow : row) * DIN + c;
        rc[u] = bf2f(pc[C_R]); kc[u] = bf2f(pc[C_K]); vc[u] = bf2f(pc[C_V]);
        rp[u] = bf2f(pp[C_R]) * pm; kq[u] = bf2f(pp[C_K]) * pm; vp[u] = bf2f(pp[C_V]) * pm;
        wlv[u] = swl[tk * 256 + c]; alv[u] = sal[tk * 256 + c];
      }
      float bprev[5];
#pragma unroll
      for (int u = 0; u < 5; ++u) bprev[u] = (dir == 1) ? bf2f(BON[(size_t)(r0 + tb + u) * 256 + c]) : 0.f;
#pragma unroll
      for (int u = 0; u < 5; ++u) {
        const int row = r0 + tb + u;
        const float rs = rc[u] + (rp[u] - rc[u]) * mur, ks = kc[u] + (kq[u] - kc[u]) * muk, vs = vc[u] + (vp[u] - vc[u]) * muv;
        const float wl = w0v + wlv[u], al = a0v + alv[u];
        const float wv = __expf(-0.6065306597126334f * sigmoidf_(wl));
        const float av = sigmoidf_(al);
        const float kkr = ks * kkv;
        const float n2 = wave_sum(kkr * kkr);
        const float kk = kkr * rcpf_(fmaxf(__builtin_amdgcn_sqrtf(n2), 1e-12f));
        const float kp = ks * (1.0f + (av - 1.0f) * kav);
        const float bs = wave_sum(rs * kp * rkv);
        const float bon = bs * vs;
        const size_t idx = (size_t)row * 256 + c;
        pr[idx] = f2bf(rs); pr[ARRF + idx] = f2bf(wv); pr[2 * ARRF + idx] = f2bf(kp); pr[3 * ARRF + idx] = f2bf(vs); pr[4 * ARRF + idx] = f2bf(kk); pr[5 * ARRF + idx] = f2bf(kk * av);
        BON[idx] = f2bf(bprev[u] + bon);
      }
    }
  }
  __syncthreads();
}

DEV void rope_item(const Params& p, int item) {
  bf16_t* P = (bf16_t*)(p.ws + OFF_P);
  const int t = tid();
  for (int e = t; e < 8 * 192; e += 256) {
    const int tk = e / 192, r = e % 192, hs = r >> 5, pi = r & 31;
    const int lt = item * 8 + tk;
    const int tt = lt & 1023;
    const int grow = tt >> 6, gcol = tt & 63;
    const int fi = pi & 15;
    const float pos = (pi < 16) ? (float)grow : (float)gcol;
    const float inv = exp2f(-(float)fi * (13.287712379549449f / 16.0f));
    const float ang = pos * inv;
    const float cs = __cosf(ang), sn = __sinf(ang);
    const int d1 = (pi < 16) ? fi : 32 + fi;
    bf16_t* base = P + (size_t)(NCTX + lt) * DIN + C_SQ + hs * 64;
    const float x1 = bf2f(base[d1]), x2 = bf2f(base[d1 + 16]);
    base[d1] = f2bf(x1 * cs - x2 * sn);
    base[d1 + 16] = f2bf(x2 * cs + x1 * sn);
  }
}

constexpr int SC_BUF = 20480 + 4096;
typedef float f2 __attribute__((ext_vector_type(2)));
DEV float dot4(const float4& a, const float4& b) { return a.x * b.x + a.y * b.y + a.z * b.z + a.w * b.w; }
DEV float red8(float x) { x += dppf<0xB1>(x); x += dppf<0x4E>(x); x += dppf<0x141>(x); return x; }
DEV float dot8(const f2 (&S)[4], const float4& a, const float4& b) {
  f2 acc = S[0] * (f2){a.x, a.y};
  acc += S[1] * (f2){a.z, a.w}; acc += S[2] * (f2){b.x, b.y}; acc += S[3] * (f2){b.z, b.w};
  return acc.x + acc.y;
}

template <int NCH>
DEV void rwkv_scan(const Params& p, int l, int seq, int head, int dir, int rsel, char* lds) {
  const int t = tid(), rr = t >> 3, g = t & 7, rl = t >> 4, ks = t & 15;
  const int T = seq < 32 ? 256 : 1024;
  const int row0 = seq < 32 ? seq * 256 : NCTX + (seq - 32) * 1024;
  const bf16_t* prep = (const bf16_t*)(p.ws + OFF_PREP) + (size_t)dir * 6 * ARRF;
  float* ydir = (float*)(p.ws + OFF_YDIR) + (size_t)dir * ARRF;
  const int vbase = (NCH == 2) ? 0 : rsel * 32;
  f2 S[NCH][4];
#pragma unroll
  for (int c = 0; c < NCH; ++c)
#pragma unroll
    for (int j = 0; j < 4; ++j) S[c][j] = (f2){0.f, 0.f};
  if (seq >= 32) {
    const float* sp = p.in[I_SRW] + ((((size_t)(seq - 32) * 4 + l) * 2 + dir) * 4 + head) * 4096 + g * 8;
#pragma unroll
    for (int c = 0; c < NCH; ++c) {
      const float4 a = *(const float4*)(sp + (vbase + rr + 32 * c) * 64), b = *(const float4*)(sp + (vbase + rr + 32 * c) * 64 + 4);
      S[c][0] = (f2){a.x, a.y}; S[c][1] = (f2){a.z, a.w}; S[c][2] = (f2){b.x, b.y}; S[c][3] = (f2){b.z, b.w};
    }
  }
  const int nch = T >> 4;
  uint2 pre0, pre1, pre2, pre3, pre4, pvv;
#define RW_LOAD(cc) do { const int s_ = (cc) * 16 + rl; const int tok_ = dir ? (T - 1 - s_) : s_; \
    const size_t base_ = (size_t)(row0 + tok_) * 256 + head * 64; \
    pre0 = *(const uint2*)(prep + base_ + ks * 4); pre1 = *(const uint2*)(prep + ARRF + base_ + ks * 4); \
    pre2 = *(const uint2*)(prep + 2 * ARRF + base_ + ks * 4); pre3 = *(const uint2*)(prep + 4 * ARRF + base_ + ks * 4); \
    pre4 = *(const uint2*)(prep + 5 * ARRF + base_ + ks * 4); \
    if (NCH == 2) pvv = *(const uint2*)(prep + 3 * ARRF + base_ + ks * 4); \
    else pvv.x = *(const unsigned*)(prep + 3 * ARRF + base_ + vbase + ks * 2); } while (0)
#define RW_WRITE(bb) do { float4* sb_ = (float4*)(lds + (bb) * SC_BUF); float* vb_ = (float*)(lds + (bb) * SC_BUF + 20480); \
    sb_[(0 * 16 + rl) * 16 + ks] = bf4(pre0); sb_[(1 * 16 + rl) * 16 + ks] = bf4(pre1); sb_[(2 * 16 + rl) * 16 + ks] = bf4(pre2); \
    sb_[(3 * 16 + rl) * 16 + ks] = bf4(pre3); sb_[(4 * 16 + rl) * 16 + ks] = bf4(pre4); \
    if (NCH == 2) *(float4*)(vb_ + rl * 64 + ks * 4) = bf4(pvv); else *(f2*)(vb_ + rl * 64 + ks * 2) = (f2){bflo(pvv.x), bfhi(pvv.x)}; } while (0)
  __syncthreads();
  RW_LOAD(0); RW_WRITE(0);
  __syncthreads();
  for (int c = 0; c < nch; ++c) {
    if (c + 1 < nch) RW_LOAD(c + 1);
    const float4* sbuf = (const float4*)(lds + (c & 1) * SC_BUF);
    const float* vbuf = (const float*)(lds + (c & 1) * SC_BUF + 20480);
    float ym[NCH][2];
#pragma unroll
    for (int cc = 0; cc < NCH; ++cc) { ym[cc][0] = 0.f; ym[cc][1] = 0.f; }
#pragma unroll
    for (int i = 0; i < 16; ++i) {
      const float4 ra = sbuf[(0 * 16 + i) * 16 + g * 2], rb = sbuf[(0 * 16 + i) * 16 + g * 2 + 1];
      const float4 wa = sbuf[(1 * 16 + i) * 16 + g * 2], wb = sbuf[(1 * 16 + i) * 16 + g * 2 + 1];
      const float4 ka_ = sbuf[(2 * 16 + i) * 16 + g * 2], kb_ = sbuf[(2 * 16 + i) * 16 + g * 2 + 1];
      const float4 na = sbuf[(3 * 16 + i) * 16 + g * 2], nb = sbuf[(3 * 16 + i) * 16 + g * 2 + 1];
      const float4 aa = sbuf[(4 * 16 + i) * 16 + g * 2], ab = sbuf[(4 * 16 + i) * 16 + g * 2 + 1];
      const f2 w2[4] = {(f2){wa.x, wa.y}, (f2){wa.z, wa.w}, (f2){wb.x, wb.y}, (f2){wb.z, wb.w}};
      const f2 k2[4] = {(f2){ka_.x, ka_.y}, (f2){ka_.z, ka_.w}, (f2){kb_.x, kb_.y}, (f2){kb_.z, kb_.w}};
      const f2 a2[4] = {(f2){aa.x, aa.y}, (f2){aa.z, aa.w}, (f2){ab.x, ab.y}, (f2){ab.z, ab.w}};
#pragma unroll
      for (int cc = 0; cc < NCH; ++cc) {
        const float v = vbuf[i * 64 + rr + 32 * cc];
        const float sa = -red8(dot8(S[cc], na, nb));
#pragma unroll
        for (int j = 0; j < 4; ++j) S[cc][j] = S[cc][j] * w2[j] + a2[j] * sa + k2[j] * v;
        const float y = red8(dot8(S[cc], ra, rb));
        ym[cc][i >> 3] = (g == (i & 7)) ? y : ym[cc][i >> 3];
      }
    }
#pragma unroll
    for (int hh = 0; hh < 2; ++hh) {
      const int s = c * 16 + hh * 8 + g; const int tok = dir ? (T - 1 - s) : s;
      float* yo = ydir + (size_t)(row0 + tok) * 256 + head * 64 + vbase + rr;
#pragma unroll
      for (int cc = 0; cc < NCH; ++cc) yo[32 * cc] = ym[cc][hh];
    }
    if (c + 1 < nch) RW_WRITE((c + 1) & 1);
    __syncthreads();
  }
#undef RW_LOAD
#undef RW_WRITE
  if (seq < 32) {
    float* sp = p.out + O_RW + ((((size_t)seq * 4 + l) * 2 + dir) * 4 + head) * 4096 + g * 8;
#pragma unroll
    for (int c = 0; c < NCH; ++c) {
      *(float4*)(sp + (vbase + rr + 32 * c) * 64) = make_float4(S[c][0].x, S[c][0].y, S[c][1].x, S[c][1].y);
      *(float4*)(sp + (vbase + rr + 32 * c) * 64 + 4) = make_float4(S[c][2].x, S[c][2].y, S[c][3].x, S[c][3].y);
    }
  }
}

template <int NCH>
DEV void hgrn_scan(const Params& p, int l, int seq, int head, int dir, int rsel, char* lds) {
  const int t = tid(), rr = t >> 3, g = t & 7, rl = t >> 4, ks = t & 15;
  const int T = seq < 32 ? 256 : 1024;
  const int row0 = seq < 32 ? seq * 256 : NCTX + (seq - 32) * 1024;
  const bf16_t* P = (const bf16_t*)(p.ws + OFF_P);
  float* odir = (float*)(p.ws + OFF_HDIR) + (size_t)dir * ARRF;
  const float4 lb4 = *(const float4*)((const float*)(p.ws + OFF_HGLB) + (l * 2 + dir) * 256 + head * 64 + ks * 4);
  const int vbase = (NCH == 2) ? 0 : rsel * 32;
  f2 S[NCH][4];
#pragma unroll
  for (int c = 0; c < NCH; ++c)
#pragma unroll
    for (int j = 0; j < 4; ++j) S[c][j] = (f2){0.f, 0.f};
  if (seq >= 32) {
    const float* sp = p.in[I_SHG] + ((((size_t)(seq - 32) * 4 + l) * 2 + dir) * 4 + head) * 4096;
#pragma unroll
    for (int c = 0; c < NCH; ++c)
#pragma unroll
      for (int j = 0; j < 4; ++j) {
        const int v = vbase + rr + 32 * c;
        S[c][j] = (f2){sp[(g * 8 + 2 * j) * 64 + v], sp[(g * 8 + 2 * j + 1) * 64 + v]};
      }
  }
  const int nch = T >> 4;
  const int fcol = (dir ? C_HFB : C_HFF) + head * 64;
  uint2 pq, pf, pv2;
#define HG_LOAD(cc) do { const int s_ = (cc) * 16 + rl; const int tok_ = dir ? (T - 1 - s_) : s_; \
    const bf16_t* pr_ = P + (size_t)(row0 + tok_) * DIN; \
    pq = *(const uint2*)(pr_ + C_HQ + head * 64 + ks * 4); pf = *(const uint2*)(pr_ + fcol + ks * 4); \
    if (NCH == 2) pv2 = *(const uint2*)(pr_ + C_HI + head * 64 + ks * 4); else pv2.x = *(const unsigned*)(pr_ + C_HI + head * 64 + vbase + ks * 2); } while (0)
#define HG_WRITE(bb) do { float4* sb_ = (float4*)(lds + (bb) * SC_BUF); float* vb_ = (float*)(lds + (bb) * SC_BUF + 20480); \
    float4 q_, f_, k_; float a_, sg_; \
    a_ = bflo(pq.x); q_.x = a_ * sigmoidf_(a_); a_ = bfhi(pq.x); q_.y = a_ * sigmoidf_(a_); \
    a_ = bflo(pq.y); q_.z = a_ * sigmoidf_(a_); a_ = bfhi(pq.y); q_.w = a_ * sigmoidf_(a_); \
    sg_ = sigmoidf_(bflo(pf.x)); f_.x = lb4.x + (1.f - lb4.x) * sg_; k_.x = (1.f - lb4.x) * (1.f - sg_); \
    sg_ = sigmoidf_(bfhi(pf.x)); f_.y = lb4.y + (1.f - lb4.y) * sg_; k_.y = (1.f - lb4.y) * (1.f - sg_); \
    sg_ = sigmoidf_(bflo(pf.y)); f_.z = lb4.z + (1.f - lb4.z) * sg_; k_.z = (1.f - lb4.z) * (1.f - sg_); \
    sg_ = sigmoidf_(bfhi(pf.y)); f_.w = lb4.w + (1.f - lb4.w) * sg_; k_.w = (1.f - lb4.w) * (1.f - sg_); \
    sb_[(0 * 16 + rl) * 16 + ks] = q_; sb_[(1 * 16 + rl) * 16 + ks] = f_; sb_[(2 * 16 + rl) * 16 + ks] = k_; \
    if (NCH == 2) *(float4*)(vb_ + rl * 64 + ks * 4) = make_float4(bflo(pv2.x), bfhi(pv2.x), bflo(pv2.y), bfhi(pv2.y)); \
    else *(f2*)(vb_ + rl * 64 + ks * 2) = (f2){bflo(pv2.x), bfhi(pv2.x)}; } while (0)
  __syncthreads();
  HG_LOAD(0); HG_WRITE(0);
  __syncthreads();
  for (int c = 0; c < nch; ++c) {
    if (c + 1 < nch) HG_LOAD(c + 1);
    const float4* sbuf = (const float4*)(lds + (c & 1) * SC_BUF);
    const float* vbuf = (const float*)(lds + (c & 1) * SC_BUF + 20480);
    float ym[NCH][2];
#pragma unroll
    for (int cc = 0; cc < NCH; ++cc) { ym[cc][0] = 0.f; ym[cc][1] = 0.f; }
#pragma unroll
    for (int i = 0; i < 16; ++i) {
      const float4 qa = sbuf[(0 * 16 + i) * 16 + g * 2], qb = sbuf[(0 * 16 + i) * 16 + g * 2 + 1];
      const float4 fa = sbuf[(1 * 16 + i) * 16 + g * 2], fb = sbuf[(1 * 16 + i) * 16 + g * 2 + 1];
      const float4 ka_ = sbuf[(2 * 16 + i) * 16 + g * 2], kb_ = sbuf[(2 * 16 + i) * 16 + g * 2 + 1];
      const f2 f2v[4] = {(f2){fa.x, fa.y}, (f2){fa.z, fa.w}, (f2){fb.x, fb.y}, (f2){fb.z, fb.w}};
      const f2 k2[4] = {(f2){ka_.x, ka_.y}, (f2){ka_.z, ka_.w}, (f2){kb_.x, kb_.y}, (f2){kb_.z, kb_.w}};
#pragma unroll
      for (int cc = 0; cc < NCH; ++cc) {
        const float v = vbuf[i * 64 + rr + 32 * cc];
#pragma unroll
        for (int j = 0; j < 4; ++j) S[cc][j] = S[cc][j] * f2v[j] + k2[j] * v;
        const float y = red8(dot8(S[cc], qa, qb));
        ym[cc][i >> 3] = (g == (i & 7)) ? y : ym[cc][i >> 3];
      }
    }
#pragma unroll
    for (int hh = 0; hh < 2; ++hh) {
      const int s = c * 16 + hh * 8 + g; const int tok = dir ? (T - 1 - s) : s;
      float* yo = odir + (size_t)(row0 + tok) * 256 + head * 64 + vbase + rr;
#pragma unroll
      for (int cc = 0; cc < NCH; ++cc) yo[32 * cc] = ym[cc][hh];
    }
    if (c + 1 < nch) HG_WRITE((c + 1) & 1);
    __syncthreads();
  }
#undef HG_LOAD
#undef HG_WRITE
  if (seq < 32) {
    float* sp = p.out + O_HG + ((((size_t)seq * 4 + l) * 2 + dir) * 4 + head) * 4096;
#pragma unroll
    for (int c = 0; c < NCH; ++c)
#pragma unroll
      for (int j = 0; j < 4; ++j) {
        const int v = vbase + rr + 32 * c;
        sp[(g * 8 + 2 * j) * 64 + v] = S[c][j].x; sp[(g * 8 + 2 * j + 1) * 64 + v] = S[c][j].y;
      }
  }
}

DEV void rwkv_scan16(const Params& p, int l, int seq, int head, int dir, int rg, char* lds) {
  const int t = tid(), rl = t >> 4, ks = t & 15;
  const int T = seq < 32 ? 256 : 1024;
  const int row0 = seq < 32 ? seq * 256 : NCTX + (seq - 32) * 1024;
  const bf16_t* prep = (const bf16_t*)(p.ws + OFF_PREP) + (size_t)dir * 6 * ARRF;
  float* ydir = (float*)(p.ws + OFF_YDIR) + (size_t)dir * ARRF;
  const int v0 = rg * 16 + rl;
  float4 S0 = make_float4(0.f, 0.f, 0.f, 0.f);
  if (seq >= 32) S0 = *(const float4*)(p.in[I_SRW] + ((((size_t)(seq - 32) * 4 + l) * 2 + dir) * 4 + head) * 4096 + ks * 4 + v0 * 64);
  const int nch = T >> 4;
  uint2 pre0, pre1, pre2, pre3, pre4; bf16_t pv0;
#define RW_LOAD(cc) do { const int s_ = (cc) * 16 + rl; const int tok_ = dir ? (T - 1 - s_) : s_; \
    const size_t base_ = (size_t)(row0 + tok_) * 256 + head * 64; \
    pre0 = *(const uint2*)(prep + base_ + ks * 4); pre1 = *(const uint2*)(prep + ARRF + base_ + ks * 4); \
    pre2 = *(const uint2*)(prep + 2 * ARRF + base_ + ks * 4); pre3 = *(const uint2*)(prep + 4 * ARRF + base_ + ks * 4); \
    pre4 = *(const uint2*)(prep + 5 * ARRF + base_ + ks * 4); pv0 = prep[3 * ARRF + base_ + rg * 16 + ks]; } while (0)
#define RW_WRITE(bb) do { float4* sb_ = (float4*)(lds + (bb) * SC_BUF); float* vb_ = (float*)(lds + (bb) * SC_BUF + 20480); \
    sb_[(0 * 16 + rl) * 16 + ks] = bf4(pre0); sb_[(1 * 16 + rl) * 16 + ks] = bf4(pre1); sb_[(2 * 16 + rl) * 16 + ks] = bf4(pre2); \
    sb_[(3 * 16 + rl) * 16 + ks] = bf4(pre3); sb_[(4 * 16 + rl) * 16 + ks] = bf4(pre4); vb_[rl * 16 + ks] = bf2f(pv0); } while (0)
  __syncthreads();
  RW_LOAD(0); RW_WRITE(0);
  __syncthreads();
  for (int c = 0; c < nch; ++c) {
    if (c + 1 < nch) RW_LOAD(c + 1);
    const float4* sbuf = (const float4*)(lds + (c & 1) * SC_BUF);
    const float* vbuf = (const float*)(lds + (c & 1) * SC_BUF + 20480);
    float ym0 = 0.f;
#pragma unroll
    for (int i = 0; i < 16; ++i) {
      const float4 r = sbuf[(0 * 16 + i) * 16 + ks], wv = sbuf[(1 * 16 + i) * 16 + ks], kv = sbuf[(2 * 16 + i) * 16 + ks],
                   kk = sbuf[(3 * 16 + i) * 16 + ks], ka = sbuf[(4 * 16 + i) * 16 + ks];
      const float va = vbuf[i * 16 + rl];
      const float sa0 = -row16_sum(dot4(S0, kk));
      S0.x = S0.x * wv.x + sa0 * ka.x + va * kv.x; S0.y = S0.y * wv.y + sa0 * ka.y + va * kv.y;
      S0.z = S0.z * wv.z + sa0 * ka.z + va * kv.z; S0.w = S0.w * wv.w + sa0 * ka.w + va * kv.w;
      const float y0 = row16_sum(dot4(S0, r));
      ym0 = (ks == i) ? y0 : ym0;
    }
    {
      const int s = c * 16 + ks; const int tok = dir ? (T - 1 - s) : s;
      ydir[(size_t)(row0 + tok) * 256 + head * 64 + v0] = ym0;
    }
    if (c + 1 < nch) RW_WRITE((c + 1) & 1);
    __syncthreads();
  }
#undef RW_LOAD
#undef RW_WRITE
  if (seq < 32) *(float4*)(p.out + O_RW + ((((size_t)seq * 4 + l) * 2 + dir) * 4 + head) * 4096 + ks * 4 + v0 * 64) = S0;
}

DEV void hgrn_scan16(const Params& p, int l, int seq, int head, int dir, int rg, char* lds) {
  const int t = tid(), rl = t >> 4, ks = t & 15;
  const int T = seq < 32 ? 256 : 1024;
  const int row0 = seq < 32 ? seq * 256 : NCTX + (seq - 32) * 1024;
  const bf16_t* P = (const bf16_t*)(p.ws + OFF_P);
  float* odir = (float*)(p.ws + OFF_HDIR) + (size_t)dir * ARRF;
  const float4 lb4 = *(const float4*)((const float*)(p.ws + OFF_HGLB) + (l * 2 + dir) * 256 + head * 64 + ks * 4);
  const int v0 = rg * 16 + rl;
  float4 S0 = make_float4(0.f, 0.f, 0.f, 0.f);
  if (seq >= 32) {
    const float* sp = p.in[I_SHG] + ((((size_t)(seq - 32) * 4 + l) * 2 + dir) * 4 + head) * 4096;
    S0.x = sp[(ks * 4 + 0) * 64 + v0]; S0.y = sp[(ks * 4 + 1) * 64 + v0]; S0.z = sp[(ks * 4 + 2) * 64 + v0]; S0.w = sp[(ks * 4 + 3) * 64 + v0];
  }
  const int nch = T >> 4;
  const int fcol = (dir ? C_HFB : C_HFF) + head * 64;
  uint2 pq, pf; bf16_t pva;
#define HG_LOAD(cc) do { const int s_ = (cc) * 16 + rl; const int tok_ = dir ? (T - 1 - s_) : s_; \
    const bf16_t* pr_ = P + (size_t)(row0 + tok_) * DIN; \
    pq = *(const uint2*)(pr_ + C_HQ + head * 64 + ks * 4); pf = *(const uint2*)(pr_ + fcol + ks * 4); \
    pva = pr_[C_HI + head * 64 + rg * 16 + ks]; } while (0)
#define HG_WRITE(bb) do { float4* sb_ = (float4*)(lds + (bb) * SC_BUF); float* vb_ = (float*)(lds + (bb) * SC_BUF + 20480); \
    float4 q_, f_, k_; float a_, sg_; \
    a_ = bflo(pq.x); q_.x = a_ * sigmoidf_(a_); a_ = bfhi(pq.x); q_.y = a_ * sigmoidf_(a_); \
    a_ = bflo(pq.y); q_.z = a_ * sigmoidf_(a_); a_ = bfhi(pq.y); q_.w = a_ * sigmoidf_(a_); \
    sg_ = sigmoidf_(bflo(pf.x)); f_.x = lb4.x + (1.f - lb4.x) * sg_; k_.x = (1.f - lb4.x) * (1.f - sg_); \
    sg_ = sigmoidf_(bfhi(pf.x)); f_.y = lb4.y + (1.f - lb4.y) * sg_; k_.y = (1.f - lb4.y) * (1.f - sg_); \
    sg_ = sigmoidf_(bflo(pf.y)); f_.z = lb4.z + (1.f - lb4.z) * sg_; k_.z = (1.f - lb4.z) * (1.f - sg_); \
    sg_ = sigmoidf_(bfhi(pf.y)); f_.w = lb4.w + (1.f - lb4.w) * sg_; k_.w = (1.f - lb4.w) * (1.f - sg_); \
    sb_[(0 * 16 + rl) * 16 + ks] = q_; sb_[(1 * 16 + rl) * 16 + ks] = f_; sb_[(2 * 16 + rl) * 16 + ks] = k_; \
    vb_[rl * 16 + ks] = bf2f(pva); } while (0)
  __syncthreads();
  HG_LOAD(0); HG_WRITE(0);
  __syncthreads();
  for (int c = 0; c < nch; ++c) {
    if (c + 1 < nch) HG_LOAD(c + 1);
    const float4* sbuf = (const float4*)(lds + (c & 1) * SC_BUF);
    const float* vbuf = (const float*)(lds + (c & 1) * SC_BUF + 20480);
    float ym0 = 0.f;
#pragma unroll
    for (int i = 0; i < 16; ++i) {
      const float4 q = sbuf[(0 * 16 + i) * 16 + ks], f = sbuf[(1 * 16 + i) * 16 + ks], k = sbuf[(2 * 16 + i) * 16 + ks];
      const float va = vbuf[i * 16 + rl];
      S0.x = S0.x * f.x + k.x * va; S0.y = S0.y * f.y + k.y * va; S0.z = S0.z * f.z + k.z * va; S0.w = S0.w * f.w + k.w * va;
      const float y0 = row16_sum(dot4(S0, q));
      ym0 = (ks == i) ? y0 : ym0;
    }
    {
      const int s = c * 16 + ks; const int tok = dir ? (T - 1 - s) : s;
      odir[(size_t)(row0 + tok) * 256 + head * 64 + v0] = ym0;
    }
    if (c + 1 < nch) HG_WRITE((c + 1) & 1);
    __syncthreads();
  }
#undef HG_LOAD
#undef HG_WRITE
  if (seq < 32) {
    float* sp = p.out + O_HG + ((((size_t)seq * 4 + l) * 2 + dir) * 4 + head) * 4096;
    sp[(ks * 4 + 0) * 64 + v0] = S0.x; sp[(ks * 4 + 1) * 64 + v0] = S0.y; sp[(ks * 4 + 2) * 64 + v0] = S0.z; sp[(ks * 4 + 3) * 64 + v0] = S0.w;
  }
}

template <int MODE>
DEV void attn_item(const Params& p, int l, int item, char* lds) {
  const int t = tid(), lane = t & 63, w = t >> 6, q = lane & 31, hh = lane >> 5;
  const bf16_t* P = (const bf16_t*)(p.ws + OFF_P);
  bf16_t* Y = (bf16_t*)(p.ws + OFF_YMIX);
  char* sK = lds;
  char* sV = lds + 8192;
  float* sBias = (float*)(lds + 8192 + 8704);
  int head, qrow, qcol, kcol, vcol, ocol, nloc, nt, rowbaseP;
  int qr = 0, qc = 0, rlo = 0, qpos = 0, lo = 0, rsq = 0, wsq = 0;
  float sink = 0.f;
  const float* cache = nullptr; int cH = 1, cHead = 0;
  if (MODE == 0 || MODE == 1) {
    const int b = item >> 3; head = (item >> 1) & 3; const int half = item & 1;
    rowbaseP = b * 256; qrow = rowbaseP + half * 128 + w * 32 + q; nloc = 4; nt = 4;
  } else {
    const int b = item >> 5; head = (item >> 3) & 3; const int sub = item & 7;
    rowbaseP = NCTX + b * 1024;
    if (MODE == 2) {
      qr = 2 * sub + (w >> 1); qc = (w & 1) * 32 + q; qrow = rowbaseP + qr * 64 + qc;
      rlo = clampi(2 * sub - 4, 0, 8); const int rhi = clampi(2 * sub - 3, 0, 8) + 7; nloc = rhi - rlo + 1; nt = nloc + 4;
      rsq = clampi(qr - 4, 0, 8); wsq = clampi(qc - 8, 0, 48);
      cache = p.in[I_CNAT] + (size_t)((b * 4 + l) * 2) * 256 * 256; cH = 4; cHead = head;
      for (int i = t; i < 465; i += 256) sBias[i] = p.in[I_RPB][(size_t)(l * 4 + head) * 465 + i];
    } else {
      qpos = sub * 128 + w * 32 + q; qrow = rowbaseP + qpos;
      lo = (sub - 1) * 128;
      nloc = 6; nt = nloc + 4;
      cache = p.in[I_CSWA] + (size_t)((b * 4 + l) * 2) * 256 * 128; cH = 2; cHead = head >> 1;
    }
  }
  if (MODE == 0 || MODE == 2) { qcol = C_NQ + head * 64; kcol = C_NK + head * 64; vcol = C_NV + head * 64; ocol = 256 + head * 64; }
  else { qcol = C_SQ + head * 64; kcol = C_SK + (head >> 1) * 64; vcol = C_SV + (head >> 1) * 64; ocol = 768 + head * 64; sink = p.in[I_SINK][l * 4 + head]; }

  bf16x8 bq[4];
#pragma unroll
  for (int s = 0; s < 4; ++s) bq[s] = *(const bf16x8*)(P + (size_t)qrow * DIN + qcol + 16 * s + 8 * hh);
  f32x16 oacc[2];
#pragma unroll
  for (int r = 0; r < 16; ++r) { oacc[0][r] = 0.f; oacc[1][r] = 0.f; }
  float m_run = -1e30f, l_run = 0.f;
  const int key = t >> 2, dq = t & 3;
  const int kswz = (key >> 1) & 7;
  float4 raw[8];
#define ATT_ISSUE(jj) do { const int j_ = (jj); \
    if (j_ < nloc) { \
      int krow_; \
      if (MODE == 0 || MODE == 1) krow_ = rowbaseP + j_ * 64 + key; \
      else if (MODE == 2) krow_ = rowbaseP + (rlo + j_) * 64 + key; \
      else krow_ = rowbaseP + clampi(lo + j_ * 64 + key, 0, 1023); \
      const bf16_t* kp_ = P + (size_t)krow_ * DIN + kcol + dq * 16; \
      const bf16_t* vp_ = P + (size_t)krow_ * DIN + vcol + dq * 16; \
      raw[0] = *(const float4*)kp_; raw[1] = *(const float4*)(kp_ + 8); raw[2] = *(const float4*)vp_; raw[3] = *(const float4*)(vp_ + 8); \
    } else { \
      const int ct_ = (j_ - nloc) * 64 + key; \
      const float* kp_ = cache + ((size_t)ct_ * cH + cHead) * 64 + dq * 16; \
      const float* vp_ = kp_ + (size_t)256 * cH * 64; \
      raw[0] = *(const float4*)kp_; raw[1] = *(const float4*)(kp_ + 4); raw[2] = *(const float4*)(kp_ + 8); raw[3] = *(const float4*)(kp_ + 12); \
      raw[4] = *(const float4*)vp_; raw[5] = *(const float4*)(vp_ + 4); raw[6] = *(const float4*)(vp_ + 8); raw[7] = *(const float4*)(vp_ + 12); \
    } } while (0)
  ATT_ISSUE(0);
  for (int j = 0; j < nt; ++j) {
    uint4 kr[2], vr[2];
    const bool isP = j < nloc;
    if (isP) {
      kr[0] = __builtin_bit_cast(uint4, raw[0]); kr[1] = __builtin_bit_cast(uint4, raw[1]);
      vr[0] = __builtin_bit_cast(uint4, raw[2]); vr[1] = __builtin_bit_cast(uint4, raw[3]);
    } else {
      kr[0].x = pk2(raw[0].x, raw[0].y); kr[0].y = pk2(raw[0].z, raw[0].w); kr[0].z = pk2(raw[1].x, raw[1].y); kr[0].w = pk2(raw[1].z, raw[1].w);
      kr[1].x = pk2(raw[2].x, raw[2].y); kr[1].y = pk2(raw[2].z, raw[2].w); kr[1].z = pk2(raw[3].x, raw[3].y); kr[1].w = pk2(raw[3].z, raw[3].w);
      vr[0].x = pk2(raw[4].x, raw[4].y); vr[0].y = pk2(raw[4].z, raw[4].w); vr[0].z = pk2(raw[5].x, raw[5].y); vr[0].w = pk2(raw[5].z, raw[5].w);
      vr[1].x = pk2(raw[6].x, raw[6].y); vr[1].y = pk2(raw[6].z, raw[6].w); vr[1].z = pk2(raw[7].x, raw[7].y); vr[1].w = pk2(raw[7].z, raw[7].w);
    }
    if (j + 1 < nt) ATT_ISSUE(j + 1);
    __syncthreads();
    *(uint4*)(sK + key * 128 + (((dq * 2 + 0) ^ kswz) << 4)) = kr[0];
    *(uint4*)(sK + key * 128 + (((dq * 2 + 1) ^ kswz) << 4)) = kr[1];
    {
      bf16_t* vt = (bf16_t*)sV;
      const unsigned vv[8] = {vr[0].x, vr[0].y, vr[0].z, vr[0].w, vr[1].x, vr[1].y, vr[1].z, vr[1].w};
#pragma unroll
      for (int e = 0; e < 8; ++e) {
        vt[(dq * 16 + 2 * e) * 68 + key] = (bf16_t)(vv[e] & 0xffffu);
        vt[(dq * 16 + 2 * e + 1) * 68 + key] = (bf16_t)(vv[e] >> 16);
      }
    }
    __syncthreads();
    f32x16 sacc[2];
#pragma unroll
    for (int r = 0; r < 16; ++r) { sacc[0][r] = 0.f; sacc[1][r] = 0.f; }
    const int qswz = (q >> 1) & 7;
#pragma unroll
    for (int s = 0; s < 4; ++s) {
      const int co = (((s * 2 + hh) ^ qswz) << 4);
      const bf16x8 a0 = *(const bf16x8*)(sK + q * 128 + co);
      const bf16x8 a1 = *(const bf16x8*)(sK + (32 + q) * 128 + co);
      sacc[0] = MFMA32(a0, bq[s], sacc[0]);
      sacc[1] = MFMA32(a1, bq[s], sacc[1]);
    }
    float mx = -1e30f;
#pragma unroll
    for (int sub = 0; sub < 2; ++sub)
#pragma unroll
      for (int r = 0; r < 16; ++r) {
        const int kidx = sub * 32 + (r & 3) + 8 * (r >> 2) + 4 * hh;
        float v = sacc[sub][r] * 0.125f;
        bool ok = true;
        if (MODE == 2 && isP) {
          const int kr_ = rlo + j, kc_ = kidx;
          ok = (kr_ >= rsq) && (kr_ < rsq + 8) && (kc_ >= wsq) && (kc_ < wsq + 16);
          const int bi = ok ? ((kr_ - qr + 7) * 31 + (kc_ - qc + 15)) : 0;
          v += sBias[bi];
        }
        if (MODE == 3 && isP) {
          const int kpos = lo + j * 64 + kidx, dlt = kpos - qpos;
          ok = (dlt <= 128) && (dlt >= -128) && (kpos >= 0) && (kpos < 1024);
        }
        v = ok ? v : -1e30f;
        sacc[sub][r] = v;
        mx = fmaxf(mx, v);
      }
    mx = fmaxf(mx, __shfl_xor(mx, 32));
    const float m_new = fmaxf(m_run, mx);
    const float alpha = __expf(m_run - m_new);
    float rsum = 0.f;
#pragma unroll
    for (int sub = 0; sub < 2; ++sub)
#pragma unroll
      for (int r = 0; r < 16; ++r) {
        const float v = sacc[sub][r];
        const float pv = (v > -1e29f) ? __expf(v - m_new) : 0.f;
        sacc[sub][r] = pv; rsum += pv;
      }
    rsum += __shfl_xor(rsum, 32);
    l_run = l_run * alpha + rsum; m_run = m_new;
#pragma unroll
    for (int r = 0; r < 16; ++r) { oacc[0][r] *= alpha; oacc[1][r] *= alpha; }
#pragma unroll
    for (int k4 = 0; k4 < 4; ++k4) {
      const int sub = k4 >> 1, s2 = k4 & 1;
      uint4 pbu;
      pbu.x = pk2(sacc[sub][8 * s2 + 0], sacc[sub][8 * s2 + 1]); pbu.y = pk2(sacc[sub][8 * s2 + 2], sacc[sub][8 * s2 + 3]);
      pbu.z = pk2(sacc[sub][8 * s2 + 4], sacc[sub][8 * s2 + 5]); pbu.w = pk2(sacc[sub][8 * s2 + 6], sacc[sub][8 * s2 + 7]);
      const bf16x8 pb = __builtin_bit_cast(bf16x8, pbu);
#pragma unroll
      for (int dt = 0; dt < 2; ++dt) {
        const char* vp = sV + (dt * 32 + q) * 136 + (16 * k4 + 4 * hh) * 2;
        const uint2 lo8 = *(const uint2*)vp, hi8 = *(const uint2*)(vp + 16);
        uint4 avu; avu.x = lo8.x; avu.y = lo8.y; avu.z = hi8.x; avu.w = hi8.y;
        oacc[dt] = MFMA32(__builtin_bit_cast(bf16x8, avu), pb, oacc[dt]);
      }
    }
  }
#undef ATT_ISSUE
  float scale;
  if (MODE == 1 || MODE == 3) {
    const float m_f = fmaxf(m_run, sink);
    const float e = __expf(m_run - m_f);
    scale = e / (l_run * e + __expf(sink - m_f));
  } else scale = 1.0f / l_run;
#pragma unroll
  for (int dt = 0; dt < 2; ++dt)
#pragma unroll
    for (int g4 = 0; g4 < 4; ++g4) {
      const int d = dt * 32 + 8 * g4 + 4 * hh;
      uint2 o; o.x = pk2(oacc[dt][4 * g4] * scale, oacc[dt][4 * g4 + 1] * scale); o.y = pk2(oacc[dt][4 * g4 + 2] * scale, oacc[dt][4 * g4 + 3] * scale);
      *(uint2*)(Y + (size_t)qrow * D + ocol + d) = o;
    }
  __syncthreads();
}

DEV void post_item(const Params& p, int l, int tile, char* lds) {
  const int t = tid(), r0 = tile * TOKT, c = t;
  bf16_t* sA = (bf16_t*)lds;
  float* sgo = (float*)(lds + 32 * 136 * 2);
  const bf16_t* P = (const bf16_t*)(p.ws + OFF_P);
  bf16_t* Y = (bf16_t*)(p.ws + OFF_YMIX);
  const float* Y0 = (const float*)(p.ws + OFF_YDIR); const float* Y1 = Y0 + ARRF;
  const float* H0 = (const float*)(p.ws + OFF_HDIR); const float* H1 = H0 + ARRF;
  const bf16_t* BON = (const bf16_t*)(p.ws + OFF_BONUS);
  __syncthreads();
#pragma unroll
  for (int i = 0; i < TOKT / 2; ++i) {
    const int e = t + 256 * i, tk = e >> 7, j = e & 127;
    sA[tk * 136 + j] = f2bf(sigmoidf_(bf2f(P[(size_t)(r0 + tk) * DIN + C_GH + j])));
  }
  __syncthreads();
  {
    const int lane = t & 63, w = t >> 6, q = lane & 31, hh = lane >> 5;
    bf16x8 af[8];
#pragma unroll
    for (int s = 0; s < 8; ++s) af[s] = *(const bf16x8*)(sA + q * 136 + 16 * s + 8 * hh);
    const bf16_t* GT = (const bf16_t*)(p.ws + OFF_G2T) + (size_t)l * 256 * 128;
#pragma unroll
    for (int nt = 0; nt < 2; ++nt) {
      const int n = w * 64 + nt * 32 + q;
      f32x16 acc;
#pragma unroll
      for (int r = 0; r < 16; ++r) acc[r] = 0.f;
#pragma unroll
      for (int s = 0; s < 8; ++s) acc = MFMA32(af[s], *(const bf16x8*)(GT + (size_t)n * 128 + 16 * s + 8 * hh), acc);
#pragma unroll
      for (int r = 0; r < 8; ++r) sgo[((r & 3) + 8 * (r >> 2) + 4 * hh) * 256 + n] = acc[r];
      if (hh == 0) {
#pragma unroll
        for (int r = 8; r < 12; ++r) sgo[((r & 3) + 16) * 256 + n] = acc[r];
      }
    }
  }
  __syncthreads();
  const float lnw = p.in[I_LNW][l * 256 + c], lnb = p.in[I_LNB][l * 256 + c], hgn = p.in[I_HGN][l * 256 + c];
  float bA[5][5], bB[5][5];
#define POST_LOAD(B_, tbase) do { _Pragma("unroll") for (int u = 0; u < 5; ++u) { \
      const int row_ = r0 + (tbase) + u; const size_t idx_ = (size_t)row_ * 256 + c; \
      B_[0][u] = Y0[idx_] + Y1[idx_]; B_[1][u] = H0[idx_] + H1[idx_]; B_[2][u] = bf2f(BON[idx_]); \
      B_[3][u] = sgo[((tbase) + u) * 256 + c]; B_[4][u] = bf2f(P[(size_t)row_ * DIN + C_HG + c]); } } while (0)
#define POST_COMP(B_, tbase) do { _Pragma("unroll") for (int u = 0; u < 5; ++u) { \
      const int row = r0 + (tbase) + u; \
      const float mu = wave_sum(B_[0][u]) * (1.0f / 64.0f); \
      const float dy = B_[0][u] - mu; \
      const float var = wave_sum(dy * dy) * (1.0f / 64.0f); \
      const float yn = dy * __builtin_amdgcn_rsqf(var + 64e-5f) * lnw + lnb + B_[2][u]; \
      Y[(size_t)row * D + c] = f2bf(yn * B_[3][u]); \
      const float ms = wave_sum(B_[1][u] * B_[1][u]) * (1.0f / 64.0f); \
      Y[(size_t)row * D + 512 + c] = f2bf(B_[1][u] * __builtin_amdgcn_rsqf(ms + 1e-6f) * hgn * sigmoidf_(B_[4][u])); } } while (0)
  static_assert(TOKT == 20, "four batches of five tokens");
  POST_LOAD(bA, 0);
  POST_LOAD(bB, 5);  POST_COMP(bA, 0);
  POST_LOAD(bA, 10); POST_COMP(bB, 5);
  POST_LOAD(bB, 15); POST_COMP(bA, 10);
  POST_COMP(bB, 15);
#undef POST_LOAD
#undef POST_COMP
  __syncthreads();
}

constexpr int OFF_CTR_WORD = 3600;
DEV void mixer_phase(const Params& p, int l, char* lds0, volatile LAS unsigned* st, bool rerun) {
  const int hf = half_id(); char* lds = lds0 + hf * 65536;
  const int npairs = (256 + 512 + 512) / 2;
  unsigned* ctr = (unsigned*)(p.ws + OFF_BAR) + OFF_CTR_WORD + 64 * l + (rerun ? 32 : 0);
  bool first = true;
  for (;;) {
    int pair;
    if (first) { pair = (int)blockIdx.x; first = false; }
    else {
      if (threadIdx.x == 0) st[4] = gridDim.x + __hip_atomic_fetch_add(ctr, 1u, __ATOMIC_RELAXED, __HIP_MEMORY_SCOPE_AGENT);
      __syncthreads();
      pair = (int)st[4];
      __syncthreads();
    }
    if (pair >= npairs) break;
    const int it = pair * 2 + hf;
    const bool is_scan = it < 640;
    if (rerun && PROBE_SUB == 1 && !is_scan) continue;
    if (rerun && PROBE_SUB == 2 && is_scan) continue;
    if (rerun && PROBE_SUB == 3 && !(it < 128)) continue;
    if (rerun && PROBE_SUB == 4 && !(it >= 128 && it < 640)) continue;
    if (it < 128) {
      const int idx = it >> 1; const int seq = 32 + (idx >> 5), rem = idx & 31;
      if ((it & 1) == 0) rwkv_scan16(p, l, seq, rem >> 3, (rem >> 2) & 1, rem & 3, lds);
      else hgrn_scan16(p, l, seq, rem >> 3, (rem >> 2) & 1, rem & 3, lds);
    } else if (it < 640) {
      const int idx = (it - 128) & 255; const int seq = idx >> 3, rem = idx & 7;
      if (it < 384) rwkv_scan<2>(p, l, seq, rem >> 1, rem & 1, 0, lds);
      else hgrn_scan<2>(p, l, seq, rem >> 1, rem & 1, 0, lds);
    } else if (it < 704) attn_item<3>(p, l, it - 640, lds);
    else if (it < 768) attn_item<2>(p, l, it - 704, lds);
    else if (it < 1024) attn_item<0>(p, l, it - 768, lds);
    else attn_item<1>(p, l, it - 1024, lds);
  }
}

DEV void run_phase(const Params& p, int ph, char* lds, bool rerun, volatile LAS unsigned* st) {
  if (ph == 0) { phase0(p, lds); return; }
  if (ph == 1) { row_phase(p, 0, 0); return; }
  const int l = (ph - 2) / 9, s = (ph - 2) % 9;
  const bf16_t* H = (const bf16_t*)(p.ws + OFF_H);
  const int hf = half_id(); char* ldsh = lds + hf * 65536;
  switch (s) {
    case 0: gemm_run<0>(p, l, H, (const bf16_t*)(p.ws + OFF_WIN) + (size_t)l * DINP * D, D, DINP, lds); break;
    case 1:
      for (int it = blockIdx.x * 2 + hf; it < 512 + 256; it += gridDim.x * 2) { if (it < 512) prep_item(p, l, it, ldsh); else if (!rerun) rope_item(p, it - 512); }
      break;
    case 2: mixer_phase(p, l, lds, st, rerun); break;
    case 3: for (int it = blockIdx.x * 2 + hf; it < 512; it += gridDim.x * 2) post_item(p, l, it, ldsh); break;
    case 4: gemm_run<1>(p, l, (const bf16_t*)(p.ws + OFF_YMIX), (const bf16_t*)(p.ws + OFF_WOUT) + (size_t)l * D * D, D, D, lds); break;
    case 5: row_phase(p, 1, l); break;
    case 6: gemm_run<2>(p, l, H, (const bf16_t*)(p.ws + OFF_W1) + (size_t)l * FF * D, D, FF, lds); break;
    case 7: gemm_run<1>(p, l, (const bf16_t*)(p.ws + OFF_HID), (const bf16_t*)(p.ws + OFF_W2) + (size_t)l * D * FF, FF, D, lds); break;
    case 8: row_phase(p, 2, l); break;
  }
}

#define XB_TMO      128
#define XB_XCNT(j)  (256  + 64 * (j))
#define XB_XSUB(j)  (1280 + 64 * (j))
#define XB_XGEN(j)  (2304 + 64 * (j))
#define XB_TOP      3328
#define XB_TOPGEN   3392
#define XCD_BAR_WORDS 3456
#define XB_SPIN_CAP (1u << 18)
DEV unsigned xb_ld(unsigned* p) { return __hip_atomic_load(p, __ATOMIC_RELAXED, __HIP_MEMORY_SCOPE_AGENT); }
DEV unsigned xb_add(unsigned* p, unsigned v) { return __hip_atomic_fetch_add(p, v, __ATOMIC_RELAXED, __HIP_MEMORY_SCOPE_AGENT); }
DEV unsigned xb_xcc_id() { return (unsigned)__builtin_amdgcn_s_getreg((3 << 11) | 20) & 0xFu; }
#define XB_SPIN(cond, bar) do { unsigned _sp = 0; while (cond) { __builtin_amdgcn_s_sleep(1); \
    if ((++_sp & 255u) == 0u) { if (xb_ld(&(bar)[XB_TMO])) break; if (_sp > XB_SPIN_CAP) { atomicAdd(&(bar)[XB_TMO], 1u); break; } } } } while (0)
struct XcdBarrier { unsigned* bar; unsigned x; volatile LAS unsigned* st; };
DEV XcdBarrier xcd_barrier_post(unsigned* bar, volatile LAS unsigned* st) {
  XcdBarrier b; b.bar = bar; b.x = xb_xcc_id(); b.st = st;
  if (threadIdx.x == 0) (void)xb_add(&bar[XB_XCNT(b.x)], 1u);
  return b;
}
DEV void xcd_barrier_complete(unsigned* bar, unsigned x, unsigned& nloc, unsigned& nx) {
  const unsigned G = gridDim.x * gridDim.y * gridDim.z;
  unsigned sum, cnt, mine, sp = 0u;
  for (;;) {
    sum = 0u; cnt = 0u; mine = 0u;
#pragma unroll
    for (unsigned j = 0; j < 16; ++j) { const unsigned c = xb_ld(&bar[XB_XCNT(j)]); sum += c; cnt += (c > 0u) ? 1u : 0u; mine = (j == x) ? c : mine; }
    if (sum == G) break;
    __builtin_amdgcn_s_sleep(1);
    if ((++sp & 255u) == 0u) { if (xb_ld(&bar[XB_TMO])) break; if (sp > XB_SPIN_CAP) { atomicAdd(&bar[XB_TMO], 1u); break; } }
  }
  nloc = mine > 0u ? mine : 1u; nx = cnt > 0u ? cnt : 1u;
}
DEV void xcd_barrier(const XcdBarrier& b) {
  asm volatile("s_waitcnt vmcnt(0)" ::: "memory");
  __syncthreads();
  if (threadIdx.x == 0) {
    unsigned* bar = b.bar;
    { size_t zb_; asm volatile("s_mov_b64 %0, 0" : "=s"(zb_)); bar += zb_; }
    __builtin_amdgcn_s_waitcnt(0);
    unsigned nloc = b.st[0], nx = b.st[1];
    if (nloc == 0u) { xcd_barrier_complete(bar, b.x, nloc, nx); b.st[0] = nloc; b.st[1] = nx; }
    const unsigned old = xb_add(&bar[XB_XSUB(b.x)], 1u);
    const unsigned gen = old / nloc;
    if (old + 1u == (gen + 1u) * nloc) {
      __builtin_amdgcn_fence(__ATOMIC_RELEASE, "agent");
      asm volatile("s_waitcnt vmcnt(0)" ::: "memory");
      const unsigned og = xb_add(&bar[XB_TOP], 1u);
      const unsigned tg = og / nx;
      if (og + 1u == (tg + 1u) * nx) xb_add(&bar[XB_TOPGEN], 1u);
      else XB_SPIN(xb_ld(&bar[XB_TOPGEN]) == tg, bar);
      __builtin_amdgcn_fence(__ATOMIC_ACQUIRE, "agent");
      xb_add(&bar[XB_XGEN(b.x)], 1u);
      asm volatile("s_waitcnt vmcnt(0)" ::: "memory");
    } else {
      XB_SPIN(xb_ld(&bar[XB_XGEN(b.x)]) == gen, bar);
      __builtin_amdgcn_fence(__ATOMIC_ACQUIRE, "agent");
      asm volatile("s_waitcnt vmcnt(0)" ::: "memory");
    }
  }
  __syncthreads();
}

DEV int phase_kind(int ph) {
  if (ph == 0) return 0;
  if (ph == 1) return 1;
  const int s = (ph - 2) % 9;
  return s == 0 ? 2 : s == 1 ? 3 : s == 2 ? 4 : s == 3 ? 5 : s == 4 ? 6 : s == 5 ? 1 : s == 6 ? 7 : s == 7 ? 8 : 1;
}

constexpr int LDS_BYTES = 131072 + 64;

__global__ void __launch_bounds__(512, 2) mega(Params p, int ph_lo, int ph_hi) {
  extern __shared__ __attribute__((aligned(16))) unsigned char smem[];
  char* lds = (char*)smem;
  volatile LAS unsigned* st = (volatile LAS unsigned*)((LAS unsigned char*)smem + 131072);
  if (threadIdx.x == 0) { st[0] = 0u; st[1] = 0u; }
  __syncthreads();
  XcdBarrier xb = xcd_barrier_post((unsigned*)(p.ws + OFF_BAR), st);
  if (ph_hi < 0) cg::this_grid().sync();
  char* const ws0 = p.ws; float* const out0 = p.out;
  for (int ph = ph_lo; ph < ph_hi; ++ph) {
    { size_t z0_; asm volatile("s_mov_b64 %0, 0" : "=s"(z0_)); p.ws = ws0 + z0_; p.out = out0 + z0_; }
    run_phase(p, ph, lds, false, st);
    if (PROBE_KIND >= 0 && (PROBE_KIND == 9 || phase_kind(ph) == PROBE_KIND)) {
      xcd_barrier(xb);
      if (PROBE_KIND != 9) run_phase(p, ph, lds, true, st);
    }
    if (ph + 1 < ph_hi) xcd_barrier(xb);
  }
}

extern "C" void kernel_launch(void* const* d_in, const int* in_sizes, int n_in, void* d_out, int out_size, void* d_ws, size_t ws_size,
                              hipStream_t stream) {
  static int grid_blocks = 0;
  if (!grid_blocks) {
    int dev = 0, cus = 0, per_cu = 0;
    (void)hipGetDevice(&dev);
    (void)hipDeviceGetAttribute(&cus, hipDeviceAttributeMultiprocessorCount, dev);
    if (hipFuncSetAttribute((const void*)mega, hipFuncAttributeMaxDynamicSharedMemorySize, LDS_BYTES) != hipSuccess) fprintf(stderr, "hipFuncSetAttribute failed\n");
    (void)hipOccupancyMaxActiveBlocksPerMultiprocessor(&per_cu, mega, 512, LDS_BYTES);
    if (per_cu < 1) fprintf(stderr, "occupancy query reports %d blocks per CU\n", per_cu);
    (void)hipGetLastError();
    grid_blocks = cus;
  }
  if (ws_size < WS_TOTAL) { fprintf(stderr, "workspace too small: %zu < %zu\n", ws_size, (size_t)WS_TOTAL); return; }
  Params p{};
  for (int i = 0; i < 31; ++i) p.in[i] = (const float*)d_in[i];
  p.out = (float*)d_out;
  p.ws = (char*)d_ws;
  (void)hipMemsetAsync((char*)d_ws + OFF_BAR, 0, 16384, stream);
  int lo = 0, hi = NPH;
  void* args[] = {&p, &lo, &hi};
  hipError_t e = hipLaunchCooperativeKernel((void*)mega, dim3(grid_blocks), dim3(512), args, LDS_BYTES, stream);
  if (e != hipSuccess) fprintf(stderr, "cooperative launch failed: %s (grid %d)\n", hipGetErrorString(e), grid_blocks);
}
```

```cpp
#include <hip/hip_runtime.h>
#include <hip/hip_cooperative_groups.h>
#include <cstdio>
#include <cstdint>
namespace cg = cooperative_groups;

#ifndef ONE_LAUNCH
#define ONE_LAUNCH 1
#endif
#define PROBE_KIND -1
#define PROBE_SUB 0

#define DEV __device__ __forceinline__
#define LAS __attribute__((address_space(3)))
typedef unsigned short bf16_t;
typedef short bf16x8 __attribute__((ext_vector_type(8)));
typedef float f32x16 __attribute__((ext_vector_type(16)));
typedef __bf16 bf2_t __attribute__((ext_vector_type(2)));
typedef float f2_t __attribute__((ext_vector_type(2)));
typedef float f4n_t __attribute__((ext_vector_type(4)));

constexpr int D = 1024, DIN = 3712, FF = 4096, NCTX = 8192, MT = 10240;
constexpr int NPH = 38;
constexpr int DINP = 3840;
constexpr int C_R = 0, C_K = 256, C_V = 512, C_GH = 768, C_WHF = 896, C_WHB = 1024;
constexpr int C_NQ = 1152, C_NK = 1408, C_NV = 1664;
constexpr int C_HQ = 1920, C_HI = 2176, C_HG = 2432, C_HFF = 2688, C_HFB = 2944;
constexpr int C_SQ = 3200, C_SK = 3456, C_SV = 3584;
constexpr size_t O_NAT = 10485760, O_SWA = 27262976, O_RW = 35651584, O_HG = 39845888;
constexpr size_t ARRF = (size_t)MT * 256;
constexpr size_t ARR = ARRF * 4;
constexpr size_t OFF_WIN = 0;
constexpr size_t OFF_WOUT = OFF_WIN + (size_t)4 * DINP * D * 2;
constexpr size_t OFF_W1 = OFF_WOUT + (size_t)4 * D * D * 2;
constexpr size_t OFF_W2 = OFF_W1 + (size_t)4 * FF * D * 2;
constexpr size_t OFF_MOD = OFF_W2 + (size_t)4 * FF * D * 2;
constexpr size_t OFF_HGLB = OFF_MOD + (size_t)4 * 3 * 6144 * 4;
constexpr size_t OFF_P = OFF_HGLB + 8192;
constexpr size_t OFF_R1 = OFF_P + (size_t)MT * DIN * 2;
constexpr size_t OFF_H = OFF_R1;
constexpr size_t OFF_HID = OFF_H + (size_t)MT * D * 2;
constexpr size_t OFF_U = OFF_HID + (size_t)MT * FF * 2;
constexpr size_t OFF_PREP = OFF_R1;
constexpr size_t OFF_YDIR = OFF_PREP + 12 * ARR;
constexpr size_t OFF_BONUS = OFF_R1 + 14 * ARR;
constexpr size_t OFF_HDIR = OFF_BONUS + ARR / 2;
constexpr size_t OFF_YMIX = OFF_HDIR + 2 * ARR;
constexpr size_t OFF_X16 = OFF_YMIX + (size_t)MT * D * 2;
constexpr size_t OFF_BAR = OFF_X16 + (size_t)MT * D * 2;
constexpr size_t OFF_W2T = OFF_BAR + 16384;
constexpr size_t OFF_A2T = OFF_W2T + (size_t)4 * 2 * 256 * 64 * 2;
constexpr size_t OFF_G2T = OFF_A2T + (size_t)4 * 2 * 256 * 64 * 2;
constexpr size_t WS_TOTAL = OFF_G2T + (size_t)4 * 256 * 128 * 2;
static_assert(OFF_U + (size_t)MT * D * 4 == OFF_BONUS, "R1 layout");

struct Params {
  const float* in[31];
  float* out;
  char* ws;
};
enum { I_XP = 0, I_XS, I_CNAT, I_CSWA, I_SRW, I_SHG, I_C, I_CCTX, I_NORMG, I_MODW, I_MODB, I_WIN, I_WOUT, I_MURKV, I_MULORA,
       I_W0, I_W2, I_A0, I_A2, I_G2, I_KK, I_KA, I_RK, I_LNW, I_LNB, I_RPB, I_HGLB, I_HGN, I_SINK, I_FW1, I_FW2 };


DEV float bf2f(bf16_t h) { return __uint_as_float(((unsigned)h) << 16); }
DEV unsigned pk2(float a, float b) { f2_t v = {a, b}; bf2_t r = __builtin_convertvector(v, bf2_t); return __builtin_bit_cast(unsigned, r); }
DEV bf16_t f2bf(float f) { return (bf16_t)(pk2(f, f) & 0xffffu); }
DEV float4 bf4(uint2 u) { return make_float4(__uint_as_float(u.x << 16), __uint_as_float(u.x & 0xffff0000u), __uint_as_float(u.y << 16), __uint_as_float(u.y & 0xffff0000u)); }
DEV float bflo(unsigned u) { return __uint_as_float(u << 16); }
DEV float bfhi(unsigned u) { return __uint_as_float(u & 0xffff0000u); }
DEV float rcpf_(float x) { return __builtin_amdgcn_rcpf(x); }
DEV float sigmoidf_(float x) { return rcpf_(1.0f + __expf(-x)); }
DEV float tanhf_(float x) { return 1.0f - 2.0f * rcpf_(1.0f + __expf(2.0f * x)); }
template <int CTRL> DEV float dppf(float x) { return __int_as_float(__builtin_amdgcn_update_dpp(0, __float_as_int(x), CTRL, 0xF, 0xF, false)); }
DEV float row16_sum(float x) { x += dppf<0xB1>(x); x += dppf<0x4E>(x); x += dppf<0x141>(x); x += dppf<0x140>(x); return x; }
DEV float wave_sum(float x) { x = row16_sum(x); x += __shfl_xor(x, 16); x += __shfl_xor(x, 32); return x; }
DEV int clampi(int v, int lo, int hi) { return v < lo ? lo : (v > hi ? hi : v); }
#define MFMA32(a, b, c) __builtin_amdgcn_mfma_f32_32x32x16_bf16((a), (b), (c), 0, 0, 0)

DEV int tid() { int z; asm volatile("v_mov_b32 %0, 0" : "=v"(z)); return (int)(threadIdx.x & 255u) + z; }
DEV int half_id() { return __builtin_amdgcn_readfirstlane((int)(threadIdx.x >> 8)); }
DEV void transpose_item(const float* W, bf16_t* WT, int K, int N, int kt, int nt, char* lds) {
  bf16_t* s = (bf16_t*)lds;
  const int t = tid();
#pragma unroll
  for (int i = 0; i < 4; ++i) {
    const int k = (t >> 4) + 16 * i, n4 = (t & 15) * 4;
    const float4 v = *(const float4*)(W + (size_t)(kt * 64 + k) * N + nt * 64 + n4);
    s[(n4 + 0) * 72 + k] = f2bf(v.x); s[(n4 + 1) * 72 + k] = f2bf(v.y);
    s[(n4 + 2) * 72 + k] = f2bf(v.z); s[(n4 + 3) * 72 + k] = f2bf(v.w);
  }
  __syncthreads();
#pragma unroll
  for (int i = 0; i < 2; ++i) {
    const int n = (t >> 3) + 32 * i, kc = t & 7;
    const uint4 v = *(const uint4*)(s + n * 72 + kc * 8);
    *(uint4*)(WT + (size_t)(nt * 64 + n) * K + kt * 64 + kc * 8) = v;
  }
  __syncthreads();
}

DEV void mod_item(const Params& p, int l, int jb, char* lds) {
  float* sc = (float*)lds;
  float* red = (float*)(lds + 12288);
  const int t = tid();
  for (int i = t; i < 3072; i += 256) {
    const int c = i >> 10, k = i & 1023;
    const float x = (c == 0) ? p.in[I_CCTX][k] : p.in[I_C][(c - 1) * 1024 + k];
    sc[i] = x * rcpf_(1.0f + __expf(-x));
  }
  __syncthreads();
  const int c4 = t & 15, ks = t >> 4;
  const float* wp = p.in[I_MODW] + ((size_t)l * 1024 + ks * 64) * 6144 + jb * 64 + c4 * 4;
  float a00 = 0, a01 = 0, a02 = 0, a03 = 0, a10 = 0, a11 = 0, a12 = 0, a13 = 0, a20 = 0, a21 = 0, a22 = 0, a23 = 0;
#pragma unroll 16
  for (int ii = 0; ii < 64; ++ii) {
    const f4n_t w = __builtin_nontemporal_load((const f4n_t*)(wp + (size_t)ii * 6144));
    const int k = ks * 64 + ii;
    const float s0 = sc[k], s1 = sc[1024 + k], s2 = sc[2048 + k];
    a00 += s0 * w.x; a01 += s0 * w.y; a02 += s0 * w.z; a03 += s0 * w.w;
    a10 += s1 * w.x; a11 += s1 * w.y; a12 += s1 * w.z; a13 += s1 * w.w;
    a20 += s2 * w.x; a21 += s2 * w.y; a22 += s2 * w.z; a23 += s2 * w.w;
  }
  float* r0 = red + (ks * 3 + 0) * 64 + c4 * 4; r0[0] = a00; r0[1] = a01; r0[2] = a02; r0[3] = a03;
  float* r1 = red + (ks * 3 + 1) * 64 + c4 * 4; r1[0] = a10; r1[1] = a11; r1[2] = a12; r1[3] = a13;
  float* r2 = red + (ks * 3 + 2) * 64 + c4 * 4; r2[0] = a20; r2[1] = a21; r2[2] = a22; r2[3] = a23;
  __syncthreads();
  if (t < 192) {
    const int c = t >> 6, col = t & 63;
    float v = p.in[I_MODB][l * 6144 + jb * 64 + col];
#pragma unroll
    for (int k2 = 0; k2 < 16; ++k2) v += red[(k2 * 3 + c) * 64 + col];
    ((float*)(p.ws + OFF_MOD))[(size_t)(l * 3 + c) * 6144 + jb * 64 + col] = v;
  }
  __syncthreads();
}

DEV void hglb_item(const Params& p) {
  const int c = tid();
  float* HGLB = (float*)(p.ws + OFF_HGLB);
  for (int dir = 0; dir < 2; ++dir) {
    float x[4], mx = -1e30f;
    for (int l = 0; l < 4; ++l) { x[l] = p.in[I_HGLB][(dir * 4 + l) * 256 + c]; mx = fmaxf(mx, x[l]); }
    float s = 0;
    for (int l = 0; l < 4; ++l) { x[l] = __expf(x[l] - mx); s += x[l]; }
    float cum = 0; const float s0 = x[0] / s;
    for (int l = 0; l < 4; ++l) { cum += x[l] / s; HGLB[(l * 2 + dir) * 256 + c] = cum - s0; }
  }
}

constexpr int NT_LAYER = 928 + 256 + 1024 + 1024;
struct TileDesc { const float* W; bf16_t* WT; int K, N, kt, nt; };
DEV TileDesc layer_tile_desc(const Params& p, int l, int j) {
  TileDesc d;
  if (j < 928) { d.W = p.in[I_WIN] + (size_t)l * D * DIN; d.WT = (bf16_t*)(p.ws + OFF_WIN) + (size_t)l * DINP * D; d.K = D; d.N = DIN; d.kt = j / 58; d.nt = j % 58; return d; }
  j -= 928;
  if (j < 256) { d.W = p.in[I_WOUT] + (size_t)l * D * D; d.WT = (bf16_t*)(p.ws + OFF_WOUT) + (size_t)l * D * D; d.K = D; d.N = D; d.kt = j / 16; d.nt = j % 16; return d; }
  j -= 256;
  if (j < 1024) { d.W = p.in[I_FW1] + (size_t)l * D * FF; d.WT = (bf16_t*)(p.ws + OFF_W1) + (size_t)l * FF * D; d.K = D; d.N = FF; d.kt = j / 64; d.nt = j % 64; return d; }
  j -= 1024;
  d.W = p.in[I_FW2] + (size_t)l * FF * D; d.WT = (bf16_t*)(p.ws + OFF_W2) + (size_t)l * D * FF; d.K = FF; d.N = D; d.kt = j / 16; d.nt = j % 16; return d;
}
DEV void tile_load(const TileDesc& d, float4 (&v)[4]) {
  const int t = tid();
#pragma unroll
  for (int i = 0; i < 4; ++i) {
    const f4n_t w = __builtin_nontemporal_load((const f4n_t*)(d.W + (size_t)(d.kt * 64 + (t >> 4) + 16 * i) * d.N + d.nt * 64 + (t & 15) * 4));
    v[i] = make_float4(w.x, w.y, w.z, w.w);
  }
}
DEV void tile_store(const TileDesc& d, const float4 (&v)[4], char* lds) {
  bf16_t* s = (bf16_t*)lds;
  const int t = tid();
#pragma unroll
  for (int i = 0; i < 4; ++i) {
    const int k = (t >> 4) + 16 * i, n4 = (t & 15) * 4;
    s[(n4 + 0) * 72 + k] = f2bf(v[i].x); s[(n4 + 1) * 72 + k] = f2bf(v[i].y);
    s[(n4 + 2) * 72 + k] = f2bf(v[i].z); s[(n4 + 3) * 72 + k] = f2bf(v[i].w);
  }
  __syncthreads();
#pragma unroll
  for (int i = 0; i < 2; ++i) {
    const int n = (t >> 3) + 32 * i, kc = t & 7;
    const uint4 o = *(const uint4*)(s + n * 72 + kc * 8);
    *(uint4*)(d.WT + (size_t)(d.nt * 64 + n) * d.K + d.kt * 64 + kc * 8) = o;
  }
  __syncthreads();
}
DEV void layer_tiles(const Params& p, int l, int lo, int hi, int vb, int nvb, char* lds0) {
  const int hf = half_id(); char* lds = lds0 + hf * 65536;
  int it = lo + vb * 2 + hf;
  if (it >= hi) return;
  float4 vn[4];
  TileDesc dn = layer_tile_desc(p, l, it);
  tile_load(dn, vn);
  for (; it < hi; it += nvb * 2) {
    float4 vc[4] = {vn[0], vn[1], vn[2], vn[3]};
    const TileDesc dc = dn;
    if (it + nvb * 2 < hi) { dn = layer_tile_desc(p, l, it + nvb * 2); tile_load(dn, vn); }
    tile_store(dc, vc, lds);
  }
}

DEV void phase0(const Params& p, char* lds0) {
  const int hf = half_id(); char* lds = lds0 + hf * 65536;
  const int nitems = 386 + 4 + 20;
  for (int it = blockIdx.x * 2 + hf; it < nitems; it += gridDim.x * 2) {
    if (it < 384) { mod_item(p, it / 96, it % 96, lds); continue; }
    if (it == 384) { hglb_item(p); continue; }
    if (it == 385) continue;
    const int j = it - 386;
    if (j >= 4) {
      const int s = j - 4, n = tid();
      const float* src; bf16_t* dst; int KK;
      if (s < 8) { src = p.in[I_W2] + (size_t)s * 64 * 256; dst = (bf16_t*)(p.ws + OFF_W2T) + (size_t)s * 256 * 64; KK = 64; }
      else if (s < 16) { src = p.in[I_A2] + (size_t)(s - 8) * 64 * 256; dst = (bf16_t*)(p.ws + OFF_A2T) + (size_t)(s - 8) * 256 * 64; KK = 64; }
      else { src = p.in[I_G2] + (size_t)(s - 16) * 128 * 256; dst = (bf16_t*)(p.ws + OFF_G2T) + (size_t)(s - 16) * 256 * 128; KK = 128; }
      for (int k0 = 0; k0 < KK; k0 += 32) {
        float v[32];
#pragma unroll
        for (int e = 0; e < 32; ++e) v[e] = src[(size_t)(k0 + e) * 256 + n];
#pragma unroll
        for (int q4 = 0; q4 < 4; ++q4) {
          uint4 o; o.x = pk2(v[8 * q4], v[8 * q4 + 1]); o.y = pk2(v[8 * q4 + 2], v[8 * q4 + 3]); o.z = pk2(v[8 * q4 + 4], v[8 * q4 + 5]); o.w = pk2(v[8 * q4 + 6], v[8 * q4 + 7]);
          *(uint4*)(dst + (size_t)n * KK + k0 + 8 * q4) = o;
        }
      }
      continue;
    }
    {
      uint4* z = (uint4*)((bf16_t*)(p.ws + OFF_WIN) + ((size_t)j * DINP + DIN) * D);
      const int t = tid();
      for (int i = t; i < 128 * D * 2 / 16; i += 256) z[i] = make_uint4(0u, 0u, 0u, 0u);
    }
  }
  const int vb = ((int)blockIdx.x + (int)gridDim.x - 195 % (int)gridDim.x) % (int)gridDim.x;
  layer_tiles(p, 0, 0, NT_LAYER, vb, (int)gridDim.x, lds0);
  if ((int)gridDim.x <= 160) { for (int ll = 1; ll < 4; ++ll) layer_tiles(p, ll, 0, NT_LAYER, (int)blockIdx.x, (int)gridDim.x, lds0); }
}

constexpr int RPW = 5;
DEV void row_phase(const Params& p, int mode, int l) {
  const int lane = tid() & 63;
  const int nw = gridDim.x * 8;
  const float* MOD = (const float*)(p.ws + OFF_MOD);
  const float* NG = p.in[I_NORMG];
  const bf16_t* U = (const bf16_t*)(p.ws + OFF_U);
  bf16_t* H = (bf16_t*)(p.ws + OFF_H);
  bf16_t* X16 = (bf16_t*)(p.ws + OFF_X16);
  const bool has_next = !(mode == 2 && l == 3);
  const int ln = (mode == 0) ? 0 : (mode == 1 ? l : l + 1);
  const int gi = (mode == 1) ? 2 : 0, shi = (mode == 1) ? 3 : 0, sci = (mode == 1) ? 4 : 1;
  const float* ga = NG + (size_t)(l * 4 + (mode == 1 ? 1 : 3)) * 1024;
  const float* gb = NG + (size_t)((has_next ? ln : 0) * 4 + gi) * 1024;
  for (int rowa = blockIdx.x * 8 + half_id() * 4 + (tid() >> 6); rowa < MT; rowa += RPW * nw) {
    float4 x[RPW][4]; uint2 ub[RPW][4];
    int rows[RPW]; bool ok[RPW];
#pragma unroll
    for (int q = 0; q < RPW; ++q) {
      rows[q] = rowa + q * nw; ok[q] = rows[q] < MT;
      const int row = ok[q] ? rows[q] : rowa;
      if (mode == 0) {
        const float* src = row < NCTX ? p.in[I_XP] + (size_t)row * D : p.in[I_XS] + (size_t)(row - NCTX) * D;
#pragma unroll
        for (int i = 0; i < 4; ++i) x[q][i] = *(const float4*)(src + i * 256 + lane * 4);
      } else {
#pragma unroll
        for (int i = 0; i < 4; ++i) {
          const uint2 xb = *(const uint2*)(X16 + (size_t)row * D + i * 256 + lane * 4);
          x[q][i] = make_float4(bflo(xb.x), bfhi(xb.x), bflo(xb.y), bfhi(xb.y));
          ub[q][i] = *(const uint2*)(U + (size_t)row * D + i * 256 + lane * 4);
        }
      }
    }
#pragma unroll
    for (int q = 0; q < RPW; ++q) {
      const int row = ok[q] ? rows[q] : rowa;
      const int cond = row < NCTX ? 0 : 1 + ((row - NCTX) >> 10);
      if (mode != 0) {
        float4 u[4];
        float ss = 0;
#pragma unroll
        for (int i = 0; i < 4; ++i) {
          u[i] = make_float4(bflo(ub[q][i].x), bfhi(ub[q][i].x), bflo(ub[q][i].y), bfhi(ub[q][i].y));
          ss += u[i].x * u[i].x + u[i].y * u[i].y + u[i].z * u[i].z + u[i].w * u[i].w;
        }
        ss = wave_sum(ss);
        const float r = __builtin_amdgcn_rsqf(ss * (1.0f / 1024.0f) + 1e-6f);
        const float* gate = MOD + (size_t)(l * 3 + cond) * 6144 + (mode == 1 ? 2 : 5) * 1024;
#pragma unroll
        for (int i = 0; i < 4; ++i) {
          const float4 g4 = *(const float4*)(gate + i * 256 + lane * 4);
          const float4 a4 = *(const float4*)(ga + i * 256 + lane * 4);
          x[q][i].x += g4.x * (u[i].x * r * a4.x); x[q][i].y += g4.y * (u[i].y * r * a4.y);
          x[q][i].z += g4.z * (u[i].z * r * a4.z); x[q][i].w += g4.w * (u[i].w * r * a4.w);
        }
      }
      if (ok[q]) {
        if (has_next) {
#pragma unroll
          for (int i = 0; i < 4; ++i) { uint2 o; o.x = pk2(x[q][i].x, x[q][i].y); o.y = pk2(x[q][i].z, x[q][i].w); *(uint2*)(X16 + (size_t)row * D + i * 256 + lane * 4) = o; }
        } else {
#pragma unroll
          for (int i = 0; i < 4; ++i) *(float4*)(p.out + (size_t)row * D + i * 256 + lane * 4) = x[q][i];
        }
      }
      if (has_next) {
        float ss = 0;
#pragma unroll
        for (int i = 0; i < 4; ++i) ss += x[q][i].x * x[q][i].x + x[q][i].y * x[q][i].y + x[q][i].z * x[q][i].z + x[q][i].w * x[q][i].w;
        ss = wave_sum(ss);
        const float r2 = __builtin_amdgcn_rsqf(ss * (1.0f / 1024.0f) + 1e-6f);
        const float* sh = MOD + (size_t)(ln * 3 + cond) * 6144 + shi * 1024;
        const float* sc = MOD + (size_t)(ln * 3 + cond) * 6144 + sci * 1024;
        if (ok[q]) {
#pragma unroll
          for (int i = 0; i < 4; ++i) {
            const float4 g4 = *(const float4*)(gb + i * 256 + lane * 4);
            const float4 s4 = *(const float4*)(sc + i * 256 + lane * 4);
            const float4 h4 = *(const float4*)(sh + i * 256 + lane * 4);
            const float h0 = x[q][i].x * r2 * g4.x * (1.0f + s4.x) + h4.x;
            const float h1 = x[q][i].y * r2 * g4.y * (1.0f + s4.y) + h4.y;
            const float h2 = x[q][i].z * r2 * g4.z * (1.0f + s4.z) + h4.z;
            const float h3 = x[q][i].w * r2 * g4.w * (1.0f + s4.w) + h4.w;
            uint2 o; o.x = pk2(h0, h1); o.y = pk2(h2, h3);
            *(uint2*)(H + (size_t)row * D + i * 256 + lane * 4) = o;
          }
        }
      }
    }
  }
}

namespace pg8 {
#define PG8_LAS __attribute__((address_space(3)))
typedef unsigned short bf16_t;
typedef short bf16x8 __attribute__((ext_vector_type(8)));
typedef float f32x4 __attribute__((ext_vector_type(4)));
typedef unsigned u32x4 __attribute__((ext_vector_type(4)));
constexpr int BM = 256, BK = 64, HALF = 128, HTB = HALF * BK * 2  , STAGE_BYTES = 8 * HTB, NXCD = 8, WGM = 8;

__host__ __device__ __forceinline__ int lds_byte(int r, int c) { const int st = (r >> 4) * 2 + (c >> 5), rr = r & 15, cc = c & 31, ob = rr * 64 + cc * 2; return st * 1024 + (ob ^ (((ob >> 9) & 1) << 5)); }
__host__ __device__ __forceinline__ void stage_rc(int b, int& R, int& C) { const int st = b / 1024, sb = b % 1024, swz = sb ^ (((sb >> 9) & 1) << 5); R = (st >> 1) * 16 + swz / 64; C = (st & 1) * 32 + (swz % 64) / 2; }
__host__ __device__ __forceinline__ int perm32(int rho) { const int n = rho >> 4, i = rho & 15; return 8 * (i >> 2) + 4 * n + (i & 3); }

struct Unit { int pm, pn; };
struct Gemm { const bf16_t* A; const bf16_t* Bt; int M, N, K; };

struct StaticOrder {
    int nM, nN, nwg, G, c;
    __host__ __device__ void init(int M, int N, int G_, int c_) { nM = M / BM; nN = N / BM; nwg = nM * nN; G = G_; c = c_; }
    __host__ __device__ bool next(int i, Unit& u) const {
        const long L = (long)i * G + c; if (L >= nwg) return false;
        int wgid = (int)L; { const int q = nwg / NXCD, r = nwg % NXCD, xcd = wgid % NXCD, off = wgid / NXCD; wgid = (xcd < r ? xcd * (q + 1) : r * (q + 1) + (xcd - r) * q) + off; }
        const int nig = WGM * nN, gid = wgid / nig, fm = gid * WGM, gsz = (nM - fm) < WGM ? (nM - fm) : WGM;
        u.pm = fm + ((wgid % nig) % gsz); u.pn = (wgid % nig) / gsz; return true;
    }
    __device__ __forceinline__ void a_ready(const Unit&) const {}
    __device__ __forceinline__ void done(const Unit&) const {}
};

template <class Epi, class Sched, bool ALIGN_EPI = false, bool SP2 = false>
__device__ __forceinline__ void gemm_phase(PG8_LAS unsigned char* lds, const Gemm g, const Sched& S, const Epi& E) {
    int tid_z; asm volatile("v_mov_b32 %0, 0" : "=v"(tid_z)); const int tid = (int)threadIdx.x + tid_z, wid = __builtin_amdgcn_readfirstlane(tid >> 6), lane = tid & 63, wr = wid >> 2, wc = wid & 3, fr = lane & 15, fq = lane >> 4;
    const int K = g.K, nt = K / BK;
    unsigned voffA[2], voffB[2];
#pragma unroll
    for (int i = 0; i < 2; ++i) { int R, C; stage_rc(tid * 16 + i * 8192, R, C); const int Rb = Epi::PERM ? ((R & ~31) + perm32(R & 31)) : R;
        voffA[i] = (unsigned)(R * K + C) * 2u; voffB[i] = (unsigned)(Rb * K + C) * 2u; }
    const size_t kstep = (size_t)(BK * 2);
    const size_t hstep = (size_t)HALF * K * 2;
    const size_t tstep = 2 * hstep;
    const unsigned ldsw = (unsigned)wid * 1024u;
    const int aoff = lds_byte(wr * 64 + fr, fq * 8), boff = lds_byte(wc * 32 + fr, fq * 8);
#define PG8_SA(b, h) (((b) * 2 + (h)) * HTB)
#define PG8_SB(b, h) ((4 + (b) * 2 + (h)) * HTB)
#define PG8_STAGE(bufoff, gbase, voff) do { _Pragma("unroll") for (int _i = 0; _i < 2; ++_i) \
        __builtin_amdgcn_global_load_lds((const unsigned*)((const char*)(gbase) + (voff)[_i]), (PG8_LAS unsigned*)(lds + (bufoff) + ldsw + _i * 8192), 16, 0, 0); } while (0)
#define PG8_LDA(dst, b, h) do { _Pragma("unroll") for (int m = 0; m < 4; ++m) _Pragma("unroll") for (int k = 0; k < 2; ++k) dst[m][k] = *(const PG8_LAS bf16x8*)(lds + PG8_SA(b, h) + aoff + m * 2048 + k * 1024); } while (0)
#define PG8_LDB(dst, b, h) do { _Pragma("unroll") for (int n = 0; n < 2; ++n) _Pragma("unroll") for (int k = 0; k < 2; ++k) dst[n][k] = *(const PG8_LAS bf16x8*)(lds + PG8_SB(b, h) + boff + n * 2048 + k * 1024); } while (0)
#define PG8_MMA(ai, bj, At, Bt) do { __builtin_amdgcn_s_setprio(1); _Pragma("unroll") for (int m = 0; m < 4; ++m) _Pragma("unroll") for (int n = 0; n < 2; ++n) _Pragma("unroll") for (int k = 0; k < 2; ++k) \
        acc[ai][bj][m][n] = __builtin_amdgcn_mfma_f32_16x16x32_bf16(Bt[n][k], At[m][k], acc[ai][bj][m][n], 0, 0, 0); __builtin_amdgcn_s_setprio(0); } while (0)
#define PG8_WAIT_V(n) asm volatile("s_waitcnt vmcnt(" #n ")" ::: "memory")
#define PG8_WAIT_L(n) asm volatile("s_waitcnt lgkmcnt(" #n ")" ::: "memory")
#define PG8_BAR __builtin_amdgcn_s_barrier()
#define PG8_SCHED __builtin_amdgcn_sched_barrier(0)
    Unit cur, nxt; int ui = 0;
    if (!S.next(0, cur)) return;
    f32x4 acc[2][2][4][2];
#pragma unroll
    for (int a = 0; a < 2; ++a)
#pragma unroll
        for (int b = 0; b < 2; ++b)
#pragma unroll
            for (int m = 0; m < 4; ++m)
#pragma unroll
                for (int n = 0; n < 2; ++n) acc[a][b][m][n] = (f32x4){0.f, 0.f, 0.f, 0.f};
    bf16x8 At[4][2], B0[2][2], B1[2][2];
    const char* cA = (const char*)g.A + (size_t)cur.pm * tstep; const char* cB = (const char*)g.Bt + (size_t)cur.pn * tstep;
    S.a_ready(cur);
    if constexpr (SP2) {
        PG8_STAGE(PG8_SB(0, 0), cB, voffB); PG8_STAGE(PG8_SB(0, 1), cB + hstep, voffB); PG8_STAGE(PG8_SA(0, 0), cA, voffA); PG8_STAGE(PG8_SA(0, 1), cA + hstep, voffA);
        if (wr == 1) PG8_BAR;
        PG8_WAIT_V(2); PG8_BAR;
        PG8_STAGE(PG8_SB(1, 0), cB + kstep, voffB); PG8_STAGE(PG8_SA(1, 0), cA + kstep, voffA); PG8_STAGE(PG8_SB(1, 1), cB + hstep + kstep, voffB);
        PG8_WAIT_V(6); PG8_BAR;
    } else {
        PG8_STAGE(PG8_SB(0, 0), cB, voffB); PG8_STAGE(PG8_SA(0, 0), cA, voffA); PG8_STAGE(PG8_SB(0, 1), cB + hstep, voffB); PG8_STAGE(PG8_SA(0, 1), cA + hstep, voffA);
        if (wr == 1) PG8_BAR;
        PG8_WAIT_V(4); PG8_BAR;
        PG8_STAGE(PG8_SB(1, 0), cB + kstep, voffB); PG8_STAGE(PG8_SA(1, 0), cA + kstep, voffA); PG8_STAGE(PG8_SB(1, 1), cB + hstep + kstep, voffB);
        PG8_WAIT_V(6); PG8_BAR;
    }
    for (;;) {
        const bool has_next = S.next(ui + 1, nxt);
        const char* nA = has_next ? (const char*)g.A + (size_t)nxt.pm * tstep : cA; const char* nB = has_next ? (const char*)g.Bt + (size_t)nxt.pn * tstep : cB;
        for (int t = 0; t < nt; t += 2) {
            const bool last = (t == nt - 2);
            const char* a1 = cA + (size_t)(t + 1) * kstep;
            const char* a2 = last ? nA : cA + (size_t)(t + 2) * kstep; const char* b2 = last ? nB : cB + (size_t)(t + 2) * kstep;
            const char* a3 = a2 + kstep; const char* b3 = b2 + kstep;
            if (last && has_next) S.a_ready(nxt);
            if constexpr (SP2) {
            PG8_LDB(B0, 0, 0); PG8_LDB(B1, 0, 1); PG8_SCHED; PG8_LDA(At, 0, 0); PG8_STAGE(PG8_SA(1, 1), a1 + hstep, voffA);
            PG8_WAIT_V(8); PG8_WAIT_L(0); PG8_BAR; PG8_MMA(0, 0, At, B0); PG8_MMA(0, 1, At, B1); PG8_BAR; PG8_SCHED;
            PG8_LDA(At, 0, 1); PG8_STAGE(PG8_SB(0, 0), b2, voffB); PG8_STAGE(PG8_SB(0, 1), b2 + hstep, voffB); PG8_STAGE(PG8_SA(0, 0), a2, voffA);
            PG8_WAIT_V(8); PG8_WAIT_L(0); PG8_BAR; PG8_MMA(1, 0, At, B0); PG8_MMA(1, 1, At, B1); PG8_BAR; PG8_SCHED;
            PG8_LDB(B0, 1, 0); PG8_LDB(B1, 1, 1); PG8_SCHED; PG8_LDA(At, 1, 0); PG8_STAGE(PG8_SA(0, 1), a2 + hstep, voffA);
            PG8_WAIT_V(8); PG8_WAIT_L(0); PG8_BAR; PG8_MMA(0, 0, At, B0); PG8_MMA(0, 1, At, B1); PG8_BAR; PG8_SCHED;
            PG8_LDA(At, 1, 1); PG8_STAGE(PG8_SB(1, 0), b3, voffB); PG8_STAGE(PG8_SB(1, 1), b3 + hstep, voffB); PG8_STAGE(PG8_SA(1, 0), a3, voffA);
            PG8_WAIT_V(8); PG8_WAIT_L(0); PG8_BAR; PG8_MMA(1, 0, At, B0); PG8_MMA(1, 1, At, B1); PG8_BAR; PG8_SCHED;
            } else {
            PG8_LDB(B0, 0, 0); PG8_SCHED; PG8_LDA(At, 0, 0); PG8_STAGE(PG8_SA(1, 1), a1 + hstep, voffA);
            PG8_WAIT_L(8); PG8_BAR; PG8_WAIT_L(0); PG8_MMA(0, 0, At, B0); PG8_BAR; PG8_SCHED;
            PG8_LDB(B1, 0, 1); PG8_STAGE(PG8_SB(0, 0), b2, voffB);
            PG8_BAR; PG8_WAIT_L(0); PG8_MMA(0, 1, At, B1); PG8_BAR;
            PG8_LDA(At, 0, 1); PG8_STAGE(PG8_SA(0, 0), a2, voffA);
            PG8_BAR; PG8_WAIT_L(0); PG8_MMA(1, 0, At, B0); PG8_BAR; PG8_SCHED;
            PG8_STAGE(PG8_SB(0, 1), b2 + hstep, voffB);
            PG8_WAIT_V(6); PG8_BAR; PG8_MMA(1, 1, At, B1); PG8_BAR;
            PG8_LDB(B0, 1, 0); PG8_SCHED; PG8_LDA(At, 1, 0); PG8_STAGE(PG8_SA(0, 1), a2 + hstep, voffA);
            PG8_WAIT_L(8); PG8_BAR; PG8_WAIT_L(0); PG8_MMA(0, 0, At, B0); PG8_BAR; PG8_SCHED;
            PG8_LDB(B1, 1, 1); PG8_STAGE(PG8_SB(1, 0), b3, voffB);
            PG8_BAR; PG8_WAIT_L(0); PG8_MMA(0, 1, At, B1); PG8_BAR;
            PG8_LDA(At, 1, 1); PG8_STAGE(PG8_SA(1, 0), a3, voffA);
            PG8_BAR; PG8_WAIT_L(0); PG8_MMA(1, 0, At, B0); PG8_BAR; PG8_SCHED;
            PG8_STAGE(PG8_SB(1, 1), b3 + hstep, voffB);
            PG8_WAIT_V(6); PG8_BAR; PG8_MMA(1, 1, At, B1); PG8_BAR;
            }
        }
        if constexpr (ALIGN_EPI) { if (wr == 0) PG8_BAR; }
        if constexpr (!Epi::AFTER_DRAIN) { E(acc, cur, wr, wc, fr, fq); S.done(cur); }
        if (!has_next) break;
#pragma unroll
        for (int a = 0; a < 2; ++a)
#pragma unroll
            for (int b = 0; b < 2; ++b)
#pragma unroll
                for (int m = 0; m < 4; ++m)
#pragma unroll
                    for (int n = 0; n < 2; ++n) acc[a][b][m][n] = (f32x4){0.f, 0.f, 0.f, 0.f};
        cur = nxt; cA = nA; cB = nB; ++ui;
        if constexpr (ALIGN_EPI) { if (wr == 1) PG8_BAR; }
    }
    PG8_WAIT_V(0);
    if constexpr (!ALIGN_EPI) { if (wr == 0) PG8_BAR; }
    PG8_BAR;
    if constexpr (Epi::AFTER_DRAIN) { E.fused(acc, cur, wr, wc, fr, fq, lds, wid, lane); S.done(cur); }
#undef PG8_SA
#undef PG8_SB
#undef PG8_STAGE
#undef PG8_LDA
#undef PG8_LDB
#undef PG8_MMA
#undef PG8_WAIT_V
#undef PG8_WAIT_L
#undef PG8_BAR
#undef PG8_SCHED
}
}

template <int MODE> struct EpiMK {
  static constexpr bool PERM = true, AFTER_DRAIN = false;
  const Params* pp; int l;
  DEV void operator()(const pg8::f32x4 (&acc)[2][2][4][2], const pg8::Unit& u, int wr, int wc, int fr, int fq) const {
    const Params& p = *pp;
#pragma unroll
    for (int ai = 0; ai < 2; ++ai)
#pragma unroll
      for (int m = 0; m < 4; ++m) {
        const int row = u.pm * 256 + ai * 128 + wr * 64 + m * 16 + fr;
#pragma unroll
        for (int bj = 0; bj < 2; ++bj) {
          const int col = u.pn * 256 + bj * 128 + wc * 32 + fq * 8;
          const pg8::f32x4 v0 = acc[ai][bj][m][0], v1 = acc[ai][bj][m][1];
          if (MODE == 0) {
            if (col < DIN) {
              uint4 o; o.x = pk2(v0[0], v0[1]); o.y = pk2(v0[2], v0[3]); o.z = pk2(v1[0], v1[1]); o.w = pk2(v1[2], v1[3]);
              *(uint4*)((bf16_t*)(p.ws + OFF_P) + (size_t)row * DIN + col) = o;
              if (row < NCTX) {
                if (col >= C_NK && col < C_HQ) {
                  const int kv = col >= C_NV;
                  float* dst = p.out + O_NAT + (size_t)(((row >> 8) * 4 + l) * 2 + kv) * 65536 + (row & 255) * 256 + (col - (kv ? C_NV : C_NK));
                  *(pg8::f32x4*)dst = v0; *(pg8::f32x4*)(dst + 4) = v1;
                } else if (col >= C_SK) {
                  const int kv = col >= C_SV;
                  float* dst = p.out + O_SWA + (size_t)(((row >> 8) * 4 + l) * 2 + kv) * 32768 + (row & 255) * 128 + (col - (kv ? C_SV : C_SK));
                  *(pg8::f32x4*)dst = v0; *(pg8::f32x4*)(dst + 4) = v1;
                }
              }
            }
          } else if (MODE == 1) {
            uint4 o; o.x = pk2(v0[0], v0[1]); o.y = pk2(v0[2], v0[3]); o.z = pk2(v1[0], v1[1]); o.w = pk2(v1[2], v1[3]);
            *(uint4*)((bf16_t*)(p.ws + OFF_U) + (size_t)row * D + col) = o;
          } else {
            float r[8];
#pragma unroll
            for (int e = 0; e < 4; ++e) { const float a = fmaxf(v0[e], 0.f), b2 = fmaxf(v1[e], 0.f); r[e] = a * a; r[4 + e] = b2 * b2; }
            uint4 o; o.x = pk2(r[0], r[1]); o.y = pk2(r[2], r[3]); o.z = pk2(r[4], r[5]); o.w = pk2(r[6], r[7]);
            *(uint4*)((bf16_t*)(p.ws + OFF_HID) + (size_t)row * FF + col) = o;
          }
        }
      }
  }
};

template <int MODE>
DEV void gemm_run(const Params& p, int l, const bf16_t* A, const bf16_t* BT, int K, int N, char* lds) {
  pg8::Gemm g{A, BT, MT, N, K};
  pg8::StaticOrder S; S.init(MT, N, (int)gridDim.x, (int)blockIdx.x);
  EpiMK<MODE> E{&p, l};
  pg8::gemm_phase<EpiMK<MODE>, pg8::StaticOrder, true, true>((PG8_LAS unsigned char*)lds, g, S, E);
  if (MODE == 1 && l < 3 && (int)gridDim.x > 160 && (int)blockIdx.x >= 160) {
    if (K == D) layer_tiles(p, l + 1, 0, 640, (int)blockIdx.x - 160, (int)gridDim.x - 160, lds);
    else layer_tiles(p, l + 1, 640, NT_LAYER, (int)blockIdx.x - 160, (int)gridDim.x - 160, lds);
  }
}

constexpr int TOKT = 20;
DEV void prep_item(const Params& p, int l, int tile, char* lds) {
  const int t = tid(), r0 = tile * TOKT, c = t;
  bf16_t* sA = (bf16_t*)lds;
  float* swl = (float*)(lds + 32 * 136 * 2);
  float* sal = swl + TOKT * 256;
  const bf16_t* P = (const bf16_t*)(p.ws + OFF_P);
  bf16_t* PREP = (bf16_t*)(p.ws + OFF_PREP);
  bf16_t* BON = (bf16_t*)(p.ws + OFF_BONUS);
  for (int dir = 0; dir < 2; ++dir) {
    __syncthreads();
#pragma unroll
    for (int i = 0; i < TOKT / 2; ++i) {
      const int e = t + 256 * i, tk = e >> 7, j = e & 127, which = j >> 6, jj = j & 63;
      const int row = r0 + tk, prow = dir ? row + 1 : row - 1;
      const int tis = row < NCTX ? (row & 255) : ((row - NCTX) & 1023), Tm1 = row < NCTX ? 255 : 1023;
      const bool pv = dir ? (tis < Tm1) : (tis > 0);
      const int col = (dir ? C_WHB : C_WHF) + which * 64 + jj;
      const float cur = bf2f(P[(size_t)row * DIN + col]);
      const float prev = bf2f(P[(size_t)(pv ? prow : row) * DIN + col]) * (pv ? 1.f : 0.f);
      const float mu = p.in[I_MULORA][((l * 2 + dir) * 2 + which) * 64 + jj];
      const float val = cur + (prev - cur) * mu;
      sA[tk * 136 + j] = f2bf((which == 0) ? tanhf_(val) : val);
    }
    __syncthreads();
    {
      const int lane = t & 63, w = t >> 6, q = lane & 31, hh = lane >> 5;
#pragma unroll
      for (int mat = 0; mat < 2; ++mat) {
        bf16x8 af[4];
#pragma unroll
        for (int s = 0; s < 4; ++s) af[s] = *(const bf16x8*)(sA + q * 136 + mat * 64 + 16 * s + 8 * hh);
        const bf16_t* WT = (const bf16_t*)(p.ws + (mat ? OFF_A2T : OFF_W2T)) + (size_t)(l * 2 + dir) * 256 * 64;
        float* dst = mat ? sal : swl;
#pragma unroll
        for (int nt = 0; nt < 2; ++nt) {
          const int n = w * 64 + nt * 32 + q;
          f32x16 acc;
#pragma unroll
          for (int r = 0; r < 16; ++r) acc[r] = 0.f;
#pragma unroll
          for (int s = 0; s < 4; ++s) acc = MFMA32(af[s], *(const bf16x8*)(WT + (size_t)n * 64 + 16 * s + 8 * hh), acc);
#pragma unroll
          for (int r = 0; r < 8; ++r) dst[((r & 3) + 8 * (r >> 2) + 4 * hh) * 256 + n] = acc[r];
          if (hh == 0) {
#pragma unroll
            for (int r = 8; r < 12; ++r) dst[((r & 3) + 16) * 256 + n] = acc[r];
          }
        }
      }
    }
    __syncthreads();
    const float w0v = p.in[I_W0][(l * 2 + dir) * 256 + c], a0v = p.in[I_A0][(l * 2 + dir) * 256 + c];
    const float kkv = p.in[I_KK][l * 256 + c], kav = p.in[I_KA][l * 256 + c], rkv = p.in[I_RK][l * 256 + c];
    const float mur = p.in[I_MURKV][((l * 2 + dir) * 3 + 0) * 256 + c], muk = p.in[I_MURKV][((l * 2 + dir) * 3 + 1) * 256 + c],
                muv = p.in[I_MURKV][((l * 2 + dir) * 3 + 2) * 256 + c];
    bf16_t* pr = PREP + (size_t)dir * 6 * ARRF;
    for (int tb = 0; tb < TOKT; tb += 5) {
      float rc[5], kc[5], vc[5], rp[5], kq[5], vp[5], wlv[5], alv[5];
#pragma unroll
      for (int u = 0; u < 5; ++u) {
        const int tk = tb + u, row = r0 + tk, prow = dir ? row + 1 : row - 1;
        const int tis = row < NCTX ? (row & 255) : ((row - NCTX) & 1023), Tm1 = row < NCTX ? 255 : 1023;
        const bool pv = dir ? (tis < Tm1) : (tis > 0);
        const float pm = pv ? 1.f : 0.f;
        const bf16_t* pc = P + (size_t)row * DIN + c;
        const bf16_t* pp = P + (size_t)(pv ? prow : row) * DIN + c;
        rc[u] = bf2f(pc[C_R]); kc[u] = bf2f(pc[C_K]); vc[u] = bf2f(pc[C_V]);
        rp[u] = bf2f(pp[C_R]) * pm; kq[u] = bf2f(pp[C_K]) * pm; vp[u] = bf2f(pp[C_V]) * pm;
        wlv[u] = swl[tk * 256 + c]; alv[u] = sal[tk * 256 + c];
      }
      float bprev[5];
#pragma unroll
      for (int u = 0; u < 5; ++u) bprev[u] = (dir == 1) ? bf2f(BON[(size_t)(r0 + tb + u) * 256 + c]) : 0.f;
#pragma unroll
      for (int u = 0; u < 5; ++u) {
        const int row = r0 + tb + u;
        const float rs = rc[u] + (rp[u] - rc[u]) * mur, ks = kc[u] + (kq[u] - kc[u]) * muk, vs = vc[u] + (vp[u] - vc[u]) * muv;
        const float wl = w0v + wlv[u], al = a0v + alv[u];
        const float wv = __expf(-0.6065306597126334f * sigmoidf_(wl));
        const float av = sigmoidf_(al);
        const float kkr = ks * kkv;
        const float n2 = wave_sum(kkr * kkr);
        const float kk = kkr * rcpf_(fmaxf(__builtin_amdgcn_sqrtf(n2), 1e-12f));
        const float kp = ks * (1.0f + (av - 1.0f) * kav);
        const float bs = wave_sum(rs * kp * rkv);
        const float bon = bs * vs;
        const size_t idx = (size_t)row * 256 + c;
        pr[idx] = f2bf(rs); pr[ARRF + idx] = f2bf(wv); pr[2 * ARRF + idx] = f2bf(kp); pr[3 * ARRF + idx] = f2bf(vs); pr[4 * ARRF + idx] = f2bf(kk); pr[5 * ARRF + idx] = f2bf(kk * av);
        BON[idx] = f2bf(bprev[u] + bon);
      }
    }
  }
  __syncthreads();
}

DEV void rope_item(const Params& p, int item) {
  bf16_t* P = (bf16_t*)(p.ws + OFF_P);
  const int t = tid();
  for (int e = t; e < 8 * 192; e += 256) {
    const int tk = e / 192, r = e % 192, hs = r >> 5, pi = r & 31;
    const int lt = item * 8 + tk;
    const int tt = lt & 1023;
    const int grow = tt >> 6, gcol = tt & 63;
    const int fi = pi & 15;
    const float pos = (pi < 16) ? (float)grow : (float)gcol;
    const float inv = exp2f(-(float)fi * (13.287712379549449f / 16.0f));
    const float ang = pos * inv;
    const float cs = __cosf(ang), sn = __sinf(ang);
    const int d1 = (pi < 16) ? fi : 32 + fi;
    bf16_t* base = P + (size_t)(NCTX + lt) * DIN + C_SQ + hs * 64;
    const float x1 = bf2f(base[d1]), x2 = bf2f(base[d1 + 16]);
    base[d1] = f2bf(x1 * cs - x2 * sn);
    base[d1 + 16] = f2bf(x2 * cs + x1 * sn);
  }
}

constexpr int SC_BUF = 20480 + 4096;
typedef float f2 __attribute__((ext_vector_type(2)));
DEV float dot4(const float4& a, const float4& b) { return a.x * b.x + a.y * b.y + a.z * b.z + a.w * b.w; }
DEV float red8(float x) { x += dppf<0xB1>(x); x += dppf<0x4E>(x); x += dppf<0x141>(x); return x; }
DEV float dot8(const f2 (&S)[4], const float4& a, const float4& b) {
  f2 acc = S[0] * (f2){a.x, a.y};
  acc += S[1] * (f2){a.z, a.w}; acc += S[2] * (f2){b.x, b.y}; acc += S[3] * (f2){b.z, b.w};
  return acc.x + acc.y;
}

template <int NCH>
DEV void rwkv_scan(const Params& p, int l, int seq, int head, int dir, int rsel, char* lds) {
  const int t = tid(), rr = t >> 3, g = t & 7, rl = t >> 4, ks = t & 15;
  const int T = seq < 32 ? 256 : 1024;
  const int row0 = seq < 32 ? seq * 256 : NCTX + (seq - 32) * 1024;
  const bf16_t* prep = (const bf16_t*)(p.ws + OFF_PREP) + (size_t)dir * 6 * ARRF;
  float* ydir = (float*)(p.ws + OFF_YDIR) + (size_t)dir * ARRF;
  const int vbase = (NCH == 2) ? 0 : rsel * 32;
  f2 S[NCH][4];
#pragma unroll
  for (int c = 0; c < NCH; ++c)
#pragma unroll
    for (int j = 0; j < 4; ++j) S[c][j] = (f2){0.f, 0.f};
  if (seq >= 32) {
    const float* sp = p.in[I_SRW] + ((((size_t)(seq - 32) * 4 + l) * 2 + dir) * 4 + head) * 4096 + g * 8;
#pragma unroll
    for (int c = 0; c < NCH; ++c) {
      const float4 a = *(const float4*)(sp + (vbase + rr + 32 * c) * 64), b = *(const float4*)(sp + (vbase + rr + 32 * c) * 64 + 4);
      S[c][0] = (f2){a.x, a.y}; S[c][1] = (f2){a.z, a.w}; S[c][2] = (f2){b.x, b.y}; S[c][3] = (f2){b.z, b.w};
    }
  }
  const int nch = T >> 4;
  uint2 pre0, pre1, pre2, pre3, pre4, pvv;
#define RW_LOAD(cc) do { const int s_ = (cc) * 16 + rl; const int tok_ = dir ? (T - 1 - s_) : s_; \
    const size_t base_ = (size_t)(row0 + tok_) * 256 + head * 64; \
    pre0 = *(const uint2*)(prep + base_ + ks * 4); pre1 = *(const uint2*)(prep + ARRF + base_ + ks * 4); \
    pre2 = *(const uint2*)(prep + 2 * ARRF + base_ + ks * 4); pre3 = *(const uint2*)(prep + 4 * ARRF + base_ + ks * 4); \
    pre4 = *(const uint2*)(prep + 5 * ARRF + base_ + ks * 4); \
    if (NCH == 2) pvv = *(const uint2*)(prep + 3 * ARRF + base_ + ks * 4); \
    else pvv.x = *(const unsigned*)(prep + 3 * ARRF + base_ + vbase + ks * 2); } while (0)
#define RW_WRITE(bb) do { float4* sb_ = (float4*)(lds + (bb) * SC_BUF); float* vb_ = (float*)(lds + (bb) * SC_BUF + 20480); \
    sb_[(0 * 16 + rl) * 16 + ks] = bf4(pre0); sb_[(1 * 16 + rl) * 16 + ks] = bf4(pre1); sb_[(2 * 16 + rl) * 16 + ks] = bf4(pre2); \
    sb_[(3 * 16 + rl) * 16 + ks] = bf4(pre3); sb_[(4 * 16 + rl) * 16 + ks] = bf4(pre4); \
    if (NCH == 2) *(float4*)(vb_ + rl * 64 + ks * 4) = bf4(pvv); else *(f2*)(vb_ + rl * 64 + ks * 2) = (f2){bflo(pvv.x), bfhi(pvv.x)}; } while (0)
  __syncthreads();
  RW_LOAD(0); RW_WRITE(0);
  __syncthreads();
  for (int c = 0; c < nch; ++c) {
    if (c + 1 < nch) RW_LOAD(c + 1);
    const float4* sbuf = (const float4*)(lds + (c & 1) * SC_BUF);
    const float* vbuf = (const float*)(lds + (c & 1) * SC_BUF + 20480);
    float ym[NCH][2];
#pragma unroll
    for (int cc = 0; cc < NCH; ++cc) { ym[cc][0] = 0.f; ym[cc][1] = 0.f; }
#pragma unroll
    for (int i = 0; i < 16; ++i) {
      const float4 ra = sbuf[(0 * 16 + i) * 16 + g * 2], rb = sbuf[(0 * 16 + i) * 16 + g * 2 + 1];
      const float4 wa = sbuf[(1 * 16 + i) * 16 + g * 2], wb = sbuf[(1 * 16 + i) * 16 + g * 2 + 1];
      const float4 ka_ = sbuf[(2 * 16 + i) * 16 + g * 2], kb_ = sbuf[(2 * 16 + i) * 16 + g * 2 + 1];
      const float4 na = sbuf[(3 * 16 + i) * 16 + g * 2], nb = sbuf[(3 * 16 + i) * 16 + g * 2 + 1];
      const float4 aa = sbuf[(4 * 16 + i) * 16 + g * 2], ab = sbuf[(4 * 16 + i) * 16 + g * 2 + 1];
      const f2 w2[4] = {(f2){wa.x, wa.y}, (f2){wa.z, wa.w}, (f2){wb.x, wb.y}, (f2){wb.z, wb.w}};
      const f2 k2[4] = {(f2){ka_.x, ka_.y}, (f2){ka_.z, ka_.w}, (f2){kb_.x, kb_.y}, (f2){kb_.z, kb_.w}};
      const f2 a2[4] = {(f2){aa.x, aa.y}, (f2){aa.z, aa.w}, (f2){ab.x, ab.y}, (f2){ab.z, ab.w}};
#pragma unroll
      for (int cc = 0; cc < NCH; ++cc) {
        const float v = vbuf[i * 64 + rr + 32 * cc];
        const float sa = -red8(dot8(S[cc], na, nb));
#pragma unroll
        for (int j = 0; j < 4; ++j) S[cc][j] = S[cc][j] * w2[j] + a2[j] * sa + k2[j] * v;
        const float y = red8(dot8(S[cc], ra, rb));
        ym[cc][i >> 3] = (g == (i & 7)) ? y : ym[cc][i >> 3];
      }
    }
#pragma unroll
    for (int hh = 0; hh < 2; ++hh) {
      const int s = c * 16 + hh * 8 + g; const int tok = dir ? (T - 1 - s) : s;
      float* yo = ydir + (size_t)(row0 + tok) * 256 + head * 64 + vbase + rr;
#pragma unroll
      for (int cc = 0; cc < NCH; ++cc) yo[32 * cc] = ym[cc][hh];
    }
    if (c + 1 < nch) RW_WRITE((c + 1) & 1);
    __syncthreads();
  }
#undef RW_LOAD
#undef RW_WRITE
  if (seq < 32) {
    float* sp = p.out + O_RW + ((((size_t)seq * 4 + l) * 2 + dir) * 4 + head) * 4096 + g * 8;
#pragma unroll
    for (int c = 0; c < NCH; ++c) {
      *(float4*)(sp + (vbase + rr + 32 * c) * 64) = make_float4(S[c][0].x, S[c][0].y, S[c][1].x, S[c][1].y);
      *(float4*)(sp + (vbase + rr + 32 * c) * 64 + 4) = make_float4(S[c][2].x, S[c][2].y, S[c][3].x, S[c][3].y);
    }
  }
}

template <int NCH>
DEV void hgrn_scan(const Params& p, int l, int seq, int head, int dir, int rsel, char* lds) {
  const int t = tid(), rr = t >> 3, g = t & 7, rl = t >> 4, ks = t & 15;
  const int T = seq < 32 ? 256 : 1024;
  const int row0 = seq < 32 ? seq * 256 : NCTX + (seq - 32) * 1024;
  const bf16_t* P = (const bf16_t*)(p.ws + OFF_P);
  float* odir = (float*)(p.ws + OFF_HDIR) + (size_t)dir * ARRF;
  const float4 lb4 = *(const float4*)((const float*)(p.ws + OFF_HGLB) + (l * 2 + dir) * 256 + head * 64 + ks * 4);
  const int vbase = (NCH == 2) ? 0 : rsel * 32;
  f2 S[NCH][4];
#pragma unroll
  for (int c = 0; c < NCH; ++c)
#pragma unroll
    for (int j = 0; j < 4; ++j) S[c][j] = (f2){0.f, 0.f};
  if (seq >= 32) {
    const float* sp = p.in[I_SHG] + ((((size_t)(seq - 32) * 4 + l) * 2 + dir) * 4 + head) * 4096;
#pragma unroll
    for (int c = 0; c < NCH; ++c)
#pragma unroll
      for (int j = 0; j < 4; ++j) {
        const int v = vbase + rr + 32 * c;
        S[c][j] = (f2){sp[(g * 8 + 2 * j) * 64 + v], sp[(g * 8 + 2 * j + 1) * 64 + v]};
      }
  }
  const int nch = T >> 4;
  const int fcol = (dir ? C_HFB : C_HFF) + head * 64;
  uint2 pq, pf, pv2;
#define HG_LOAD(cc) do { const int s_ = (cc) * 16 + rl; const int tok_ = dir ? (T - 1 - s_) : s_; \
    const bf16_t* pr_ = P + (size_t)(row0 + tok_) * DIN; \
    pq = *(const uint2*)(pr_ + C_HQ + head * 64 + ks * 4); pf = *(const uint2*)(pr_ + fcol + ks * 4); \
    if (NCH == 2) pv2 = *(const uint2*)(pr_ + C_HI + head * 64 + ks * 4); else pv2.x = *(const unsigned*)(pr_ + C_HI + head * 64 + vbase + ks * 2); } while (0)
#define HG_WRITE(bb) do { float4* sb_ = (float4*)(lds + (bb) * SC_BUF); float* vb_ = (float*)(lds + (bb) * SC_BUF + 20480); \
    float4 q_, f_, k_; float a_, sg_; \
    a_ = bflo(pq.x); q_.x = a_ * sigmoidf_(a_); a_ = bfhi(pq.x); q_.y = a_ * sigmoidf_(a_); \
    a_ = bflo(pq.y); q_.z = a_ * sigmoidf_(a_); a_ = bfhi(pq.y); q_.w = a_ * sigmoidf_(a_); \
    sg_ = sigmoidf_(bflo(pf.x)); f_.x = lb4.x + (1.f - lb4.x) * sg_; k_.x = (1.f - lb4.x) * (1.f - sg_); \
    sg_ = sigmoidf_(bfhi(pf.x)); f_.y = lb4.y + (1.f - lb4.y) * sg_; k_.y = (1.f - lb4.y) * (1.f - sg_); \
    sg_ = sigmoidf_(bflo(pf.y)); f_.z = lb4.z + (1.f - lb4.z) * sg_; k_.z = (1.f - lb4.z) * (1.f - sg_); \
    sg_ = sigmoidf_(bfhi(pf.y)); f_.w = lb4.w + (1.f - lb4.w) * sg_; k_.w = (1.f - lb4.w) * (1.f - sg_); \
    sb_[(0 * 16 + rl) * 16 + ks] = q_; sb_[(1 * 16 + rl) * 16 + ks] = f_; sb_[(2 * 16 + rl) * 16 + ks] = k_; \
    if (NCH == 2) *(float4*)(vb_ + rl * 64 + ks * 4) = make_float4(bflo(pv2.x), bfhi(pv2.x), bflo(pv2.y), bfhi(pv2.y)); \
    else *(f2*)(vb_ + rl * 64 + ks * 2) = (f2){bflo(pv2.x), bfhi(pv2.x)}; } while (0)
  __syncthreads();
  HG_LOAD(0); HG_WRITE(0);
  __syncthreads();
  for (int c = 0; c < nch; ++c) {
    if (c + 1 < nch) HG_LOAD(c + 1);
    const float4* sbuf = (const float4*)(lds + (c & 1) * SC_BUF);
    const float* vbuf = (const float*)(lds + (c & 1) * SC_BUF + 20480);
    float ym[NCH][2];
#pragma unroll
    for (int cc = 0; cc < NCH; ++cc) { ym[cc][0] = 0.f; ym[cc][1] = 0.f; }
#pragma unroll
    for (int i = 0; i < 16; ++i) {
      const float4 qa = sbuf[(0 * 16 + i) * 16 + g * 2], qb = sbuf[(0 * 16 + i) * 16 + g * 2 + 1];
      const float4 fa = sbuf[(1 * 16 + i) * 16 + g * 2], fb = sbuf[(1 * 16 + i) * 16 + g * 2 + 1];
      const float4 ka_ = sbuf[(2 * 16 + i) * 16 + g * 2], kb_ = sbuf[(2 * 16 + i) * 16 + g * 2 + 1];
      const f2 f2v[4] = {(f2){fa.x, fa.y}, (f2){fa.z, fa.w}, (f2){fb.x, fb.y}, (f2){fb.z, fb.w}};
      const f2 k2[4] = {(f2){ka_.x, ka_.y}, (f2){ka_.z, ka_.w}, (f2){kb_.x, kb_.y}, (f2){kb_.z, kb_.w}};
#pragma unroll
      for (int cc = 0; cc < NCH; ++cc) {
        const float v = vbuf[i * 64 + rr + 32 * cc];
#pragma unroll
        for (int j = 0; j < 4; ++j) S[cc][j] = S[cc][j] * f2v[j] + k2[j] * v;
        const float y = red8(dot8(S[cc], qa, qb));
        ym[cc][i >> 3] = (g == (i & 7)) ? y : ym[cc][i >> 3];
      }
    }
#pragma unroll
    for (int hh = 0; hh < 2; ++hh) {
      const int s = c * 16 + hh * 8 + g; const int tok = dir ? (T - 1 - s) : s;
      float* yo = odir + (size_t)(row0 + tok) * 256 + head * 64 + vbase + rr;
#pragma unroll
      for (int cc = 0; cc < NCH; ++cc) yo[32 * cc] = ym[cc][hh];
    }
    if (c + 1 < nch) HG_WRITE((c + 1) & 1);
    __syncthreads();
  }
#undef HG_LOAD
#undef HG_WRITE
  if (seq < 32) {
    float* sp = p.out + O_HG + ((((size_t)seq * 4 + l) * 2 + dir) * 4 + head) * 4096;
#pragma unroll
    for (int c = 0; c < NCH; ++c)
#pragma unroll
      for (int j = 0; j < 4; ++j) {
        const int v = vbase + rr + 32 * c;
        sp[(g * 8 + 2 * j) * 64 + v] = S[c][j].x; sp[(g * 8 + 2 * j + 1) * 64 + v] = S[c][j].y;
      }
  }
}

DEV void rwkv_scan16(const Params& p, int l, int seq, int head, int dir, int rg, char* lds) {
  const int t = tid(), rl = t >> 4, ks = t & 15;
  const int T = seq < 32 ? 256 : 1024;
  const int row0 = seq < 32 ? seq * 256 : NCTX + (seq - 32) * 1024;
  const bf16_t* prep = (const bf16_t*)(p.ws + OFF_PREP) + (size_t)dir * 6 * ARRF;
  float* ydir = (float*)(p.ws + OFF_YDIR) + (size_t)dir * ARRF;
  const int v0 = rg * 16 + rl;
  float4 S0 = make_float4(0.f, 0.f, 0.f, 0.f);
  if (seq >= 32) S0 = *(const float4*)(p.in[I_SRW] + ((((size_t)(seq - 32) * 4 + l) * 2 + dir) * 4 + head) * 4096 + ks * 4 + v0 * 64);
  const int nch = T >> 4;
  uint2 pre0, pre1, pre2, pre3, pre4; bf16_t pv0;
#define RW_LOAD(cc) do { const int s_ = (cc) * 16 + rl; const int tok_ = dir ? (T - 1 - s_) : s_; \
    const size_t base_ = (size_t)(row0 + tok_) * 256 + head * 64; \
    pre0 = *(const uint2*)(prep + base_ + ks * 4); pre1 = *(const uint2*)(prep + ARRF + base_ + ks * 4); \
    pre2 = *(const uint2*)(prep + 2 * ARRF + base_ + ks * 4); pre3 = *(const uint2*)(prep + 4 * ARRF + base_ + ks * 4); \
    pre4 = *(const uint2*)(prep + 5 * ARRF + base_ + ks * 4); pv0 = prep[3 * ARRF + base_ + rg * 16 + ks]; } while (0)
#define RW_WRITE(bb) do { float4* sb_ = (float4*)(lds + (bb) * SC_BUF); float* vb_ = (float*)(lds + (bb) * SC_BUF + 20480); \
    sb_[(0 * 16 + rl) * 16 + ks] = bf4(pre0); sb_[(1 * 16 + rl) * 16 + ks] = bf4(pre1); sb_[(2 * 16 + rl) * 16 + ks] = bf4(pre2); \
    sb_[(3 * 16 + rl) * 16 + ks] = bf4(pre3); sb_[(4 * 16 + rl) * 16 + ks] = bf4(pre4); vb_[rl * 16 + ks] = bf2f(pv0); } while (0)
  __syncthreads();
  RW_LOAD(0); RW_WRITE(0);
  __syncthreads();
  for (int c = 0; c < nch; ++c) {
    if (c + 1 < nch) RW_LOAD(c + 1);
    const float4* sbuf = (const float4*)(lds + (c & 1) * SC_BUF);
    const float* vbuf = (const float*)(lds + (c & 1) * SC_BUF + 20480);
    float ym0 = 0.f;
#pragma unroll
    for (int i = 0; i < 16; ++i) {
      const float4 r = sbuf[(0 * 16 + i) * 16 + ks], wv = sbuf[(1 * 16 + i) * 16 + ks], kv = sbuf[(2 * 16 + i) * 16 + ks],
                   kk = sbuf[(3 * 16 + i) * 16 + ks], ka = sbuf[(4 * 16 + i) * 16 + ks];
      const float va = vbuf[i * 16 + rl];
      const float sa0 = -row16_sum(dot4(S0, kk));
      S0.x = S0.x * wv.x + sa0 * ka.x + va * kv.x; S0.y = S0.y * wv.y + sa0 * ka.y + va * kv.y;
      S0.z = S0.z * wv.z + sa0 * ka.z + va * kv.z; S0.w = S0.w * wv.w + sa0 * ka.w + va * kv.w;
      const float y0 = row16_sum(dot4(S0, r));
      ym0 = (ks == i) ? y0 : ym0;
    }
    {
      const int s = c * 16 + ks; const int tok = dir ? (T - 1 - s) : s;
      ydir[(size_t)(row0 + tok) * 256 + head * 64 + v0] = ym0;
    }
    if (c + 1 < nch) RW_WRITE((c + 1) & 1);
    __syncthreads();
  }
#undef RW_LOAD
#undef RW_WRITE
  if (seq < 32) *(float4*)(p.out + O_RW + ((((size_t)seq * 4 + l) * 2 + dir) * 4 + head) * 4096 + ks * 4 + v0 * 64) = S0;
}

DEV void hgrn_scan16(const Params& p, int l, int seq, int head, int dir, int rg, char* lds) {
  const int t = tid(), rl = t >> 4, ks = t & 15;
  const int T = seq < 32 ? 256 : 1024;
  const int row0 = seq < 32 ? seq * 256 : NCTX + (seq - 32) * 1024;
  const bf16_t* P = (const bf16_t*)(p.ws + OFF_P);
  float* odir = (float*)(p.ws + OFF_HDIR) + (size_t)dir * ARRF;
  const float4 lb4 = *(const float4*)((const float*)(p.ws + OFF_HGLB) + (l * 2 + dir) * 256 + head * 64 + ks * 4);
  const int v0 = rg * 16 + rl;
  float4 S0 = make_float4(0.f, 0.f, 0.f, 0.f);
  if (seq >= 32) {
    const float* sp = p.in[I_SHG] + ((((size_t)(seq - 32) * 4 + l) * 2 + dir) * 4 + head) * 4096;
    S0.x = sp[(ks * 4 + 0) * 64 + v0]; S0.y = sp[(ks * 4 + 1) * 64 + v0]; S0.z = sp[(ks * 4 + 2) * 64 + v0]; S0.w = sp[(ks * 4 + 3) * 64 + v0];
  }
  const int nch = T >> 4;
  const int fcol = (dir ? C_HFB : C_HFF) + head * 64;
  uint2 pq, pf; bf16_t pva;
#define HG_LOAD(cc) do { const int s_ = (cc) * 16 + rl; const int tok_ = dir ? (T - 1 - s_) : s_; \
    const bf16_t* pr_ = P + (size_t)(row0 + tok_) * DIN; \
    pq = *(const uint2*)(pr_ + C_HQ + head * 64 + ks * 4); pf = *(const uint2*)(pr_ + fcol + ks * 4); \
    pva = pr_[C_HI + head * 64 + rg * 16 + ks]; } while (0)
#define HG_WRITE(bb) do { float4* sb_ = (float4*)(lds + (bb) * SC_BUF); float* vb_ = (float*)(lds + (bb) * SC_BUF + 20480); \
    float4 q_, f_, k_; float a_, sg_; \
    a_ = bflo(pq.x); q_.x = a_ * sigmoidf_(a_); a_ = bfhi(pq.x); q_.y = a_ * sigmoidf_(a_); \
    a_ = bflo(pq.y); q_.z = a_ * sigmoidf_(a_); a_ = bfhi(pq.y); q_.w = a_ * sigmoidf_(a_); \
    sg_ = sigmoidf_(bflo(pf.x)); f_.x = lb4.x + (1.f - lb4.x) * sg_; k_.x = (1.f - lb4.x) * (1.f - sg_); \
    sg_ = sigmoidf_(bfhi(pf.x)); f_.y = lb4.y + (1.f - lb4.y) * sg_; k_.y = (1.f - lb4.y) * (1.f - sg_); \
    sg_ = sigmoidf_(bflo(pf.y)); f_.z = lb4.z + (1.f - lb4.z) * sg_; k_.z = (1.f - lb4.z) * (1.f - sg_); \
    sg_ = sigmoidf_(bfhi(pf.y)); f_.w = lb4.w + (1.f - lb4.w) * sg_; k_.w = (1.f - lb4.w) * (1.f - sg_); \
    sb_[(0 * 16 + rl) * 16 + ks] = q_; sb_[(1 * 16 + rl) * 16 + ks] = f_; sb_[(2 * 16 + rl) * 16 + ks] = k_; \
    vb_[rl * 16 + ks] = bf2f(pva); } while (0)
  __syncthreads();
  HG_LOAD(0); HG_WRITE(0);
  __syncthreads();
  for (int c = 0; c < nch; ++c) {
    if (c + 1 < nch) HG_LOAD(c + 1);
    const float4* sbuf = (const float4*)(lds + (c & 1) * SC_BUF);
    const float* vbuf = (const float*)(lds + (c & 1) * SC_BUF + 20480);
    float ym0 = 0.f;
#pragma unroll
    for (int i = 0; i < 16; ++i) {
      const float4 q = sbuf[(0 * 16 + i) * 16 + ks], f = sbuf[(1 * 16 + i) * 16 + ks], k = sbuf[(2 * 16 + i) * 16 + ks];
      const float va = vbuf[i * 16 + rl];
      S0.x = S0.x * f.x + k.x * va; S0.y = S0.y * f.y + k.y * va; S0.z = S0.z * f.z + k.z * va; S0.w = S0.w * f.w + k.w * va;
      const float y0 = row16_sum(dot4(S0, q));
      ym0 = (ks == i) ? y0 : ym0;
    }
    {
      const int s = c * 16 + ks; const int tok = dir ? (T - 1 - s) : s;
      odir[(size_t)(row0 + tok) * 256 + head * 64 + v0] = ym0;
    }
    if (c + 1 < nch) HG_WRITE((c + 1) & 1);
    __syncthreads();
  }
#undef HG_LOAD
#undef HG_WRITE
  if (seq < 32) {
    float* sp = p.out + O_HG + ((((size_t)seq * 4 + l) * 2 + dir) * 4 + head) * 4096;
    sp[(ks * 4 + 0) * 64 + v0] = S0.x; sp[(ks * 4 + 1) * 64 + v0] = S0.y; sp[(ks * 4 + 2) * 64 + v0] = S0.z; sp[(ks * 4 + 3) * 64 + v0] = S0.w;
  }
}

template <int MODE>
DEV void attn_item(const Params& p, int l, int item, char* lds) {
  const int t = tid(), lane = t & 63, w = t >> 6, q = lane & 31, hh = lane >> 5;
  const bf16_t* P = (const bf16_t*)(p.ws + OFF_P);
  bf16_t* Y = (bf16_t*)(p.ws + OFF_YMIX);
  char* sK = lds;
  char* sV = lds + 8192;
  float* sBias = (float*)(lds + 8192 + 8704);
  int head, qrow, qcol, kcol, vcol, ocol, nloc, nt, rowbaseP;
  int qr = 0, qc = 0, rlo = 0, qpos = 0, lo = 0, rsq = 0, wsq = 0;
  float sink = 0.f;
  const float* cache = nullptr; int cH = 1, cHead = 0;
  if (MODE == 0 || MODE == 1) {
    const int b = item >> 3; head = (item >> 1) & 3; const int half = item & 1;
    rowbaseP = b * 256; qrow = rowbaseP + half * 128 + w * 32 + q; nloc = 4; nt = 4;
  } else {
    const int b = item >> 5; head = (item >> 3) & 3; const int sub = item & 7;
    rowbaseP = NCTX + b * 1024;
    if (MODE == 2) {
      qr = 2 * sub + (w >> 1); qc = (w & 1) * 32 + q; qrow = rowbaseP + qr * 64 + qc;
      rlo = clampi(2 * sub - 4, 0, 8); const int rhi = clampi(2 * sub - 3, 0, 8) + 7; nloc = rhi - rlo + 1; nt = nloc + 4;
      rsq = clampi(qr - 4, 0, 8); wsq = clampi(qc - 8, 0, 48);
      cache = p.in[I_CNAT] + (size_t)((b * 4 + l) * 2) * 256 * 256; cH = 4; cHead = head;
      for (int i = t; i < 465; i += 256) sBias[i] = p.in[I_RPB][(size_t)(l * 4 + head) * 465 + i];
    } else {
      qpos = sub * 128 + w * 32 + q; qrow = rowbaseP + qpos;
      lo = (sub - 1) * 128;
      nloc = 6; nt = nloc + 4;
      cache = p.in[I_CSWA] + (size_t)((b * 4 + l) * 2) * 256 * 128; cH = 2; cHead = head >> 1;
    }
  }
  if (MODE == 0 || MODE == 2) { qcol = C_NQ + head * 64; kcol = C_NK + head * 64; vcol = C_NV + head * 64; ocol = 256 + head * 64; }
  else { qcol = C_SQ + head * 64; kcol = C_SK + (head >> 1) * 64; vcol = C_SV + (head >> 1) * 64; ocol = 768 + head * 64; sink = p.in[I_SINK][l * 4 + head]; }

  bf16x8 bq[4];
#pragma unroll
  for (int s = 0; s < 4; ++s) bq[s] = *(const bf16x8*)(P + (size_t)qrow * DIN + qcol + 16 * s + 8 * hh);
  f32x16 oacc[2];
#pragma unroll
  for (int r = 0; r < 16; ++r) { oacc[0][r] = 0.f; oacc[1][r] = 0.f; }
  float m_run = -1e30f, l_run = 0.f;
  const int key = t >> 2, dq = t & 3;
  const int kswz = (key >> 1) & 7;
  float4 raw[8];
#define ATT_ISSUE(jj) do { const int j_ = (jj); \
    if (j_ < nloc) { \
      int krow_; \
      if (MODE == 0 || MODE == 1) krow_ = rowbaseP + j_ * 64 + key; \
      else if (MODE == 2) krow_ = rowbaseP + (rlo + j_) * 64 + key; \
      else krow_ = rowbaseP + clampi(lo + j_ * 64 + key, 0, 1023); \
      const bf16_t* kp_ = P + (size_t)krow_ * DIN + kcol + dq * 16; \
      const bf16_t* vp_ = P + (size_t)krow_ * DIN + vcol + dq * 16; \
      raw[0] = *(const float4*)kp_; raw[1] = *(const float4*)(kp_ + 8); raw[2] = *(const float4*)vp_; raw[3] = *(const float4*)(vp_ + 8); \
    } else { \
      const int ct_ = (j_ - nloc) * 64 + key; \
      const float* kp_ = cache + ((size_t)ct_ * cH + cHead) * 64 + dq * 16; \
      const float* vp_ = kp_ + (size_t)256 * cH * 64; \
      raw[0] = *(const float4*)kp_; raw[1] = *(const float4*)(kp_ + 4); raw[2] = *(const float4*)(kp_ + 8); raw[3] = *(const float4*)(kp_ + 12); \
      raw[4] = *(const float4*)vp_; raw[5] = *(const float4*)(vp_ + 4); raw[6] = *(const float4*)(vp_ + 8); raw[7] = *(const float4*)(vp_ + 12); \
    } } while (0)
  ATT_ISSUE(0);
  for (int j = 0; j < nt; ++j) {
    uint4 kr[2], vr[2];
    const bool isP = j < nloc;
    if (isP) {
      kr[0] = __builtin_bit_cast(uint4, raw[0]); kr[1] = __builtin_bit_cast(uint4, raw[1]);
      vr[0] = __builtin_bit_cast(uint4, raw[2]); vr[1] = __builtin_bit_cast(uint4, raw[3]);
    } else {
      kr[0].x = pk2(raw[0].x, raw[0].y); kr[0].y = pk2(raw[0].z, raw[0].w); kr[0].z = pk2(raw[1].x, raw[1].y); kr[0].w = pk2(raw[1].z, raw[1].w);
      kr[1].x = pk2(raw[2].x, raw[2].y); kr[1].y = pk2(raw[2].z, raw[2].w); kr[1].z = pk2(raw[3].x, raw[3].y); kr[1].w = pk2(raw[3].z, raw[3].w);
      vr[0].x = pk2(raw[4].x, raw[4].y); vr[0].y = pk2(raw[4].z, raw[4].w); vr[0].z = pk2(raw[5].x, raw[5].y); vr[0].w = pk2(raw[5].z, raw[5].w);
      vr[1].x = pk2(raw[6].x, raw[6].y); vr[1].y = pk2(raw[6].z, raw[6].w); vr[1].z = pk2(raw[7].x, raw[7].y); vr[1].w = pk2(raw[7].z, raw[7].w);
    }
    if (j + 1 < nt) ATT_ISSUE(j + 1);
    __syncthreads();
    *(uint4*)(sK + key * 128 + (((dq * 2 + 0) ^ kswz) << 4)) = kr[0];
    *(uint4*)(sK + key * 128 + (((dq * 2 + 1) ^ kswz) << 4)) = kr[1];
    {
      bf16_t* vt = (bf16_t*)sV;
      const unsigned vv[8] = {vr[0].x, vr[0].y, vr[0].z, vr[0].w, vr[1].x, vr[1].y, vr[1].z, vr[1].w};
#pragma unroll
      for (int e = 0; e < 8; ++e) {
        vt[(dq * 16 + 2 * e) * 68 + key] = (bf16_t)(vv[e] & 0xffffu);
        vt[(dq * 16 + 2 * e + 1) * 68 + key] = (bf16_t)(vv[e] >> 16);
      }
    }
    __syncthreads();
    f32x16 sacc[2];
#pragma unroll
    for (int r = 0; r < 16; ++r) { sacc[0][r] = 0.f; sacc[1][r] = 0.f; }
    const int qswz = (q >> 1) & 7;
#pragma unroll
    for (int s = 0; s < 4; ++s) {
      const int co = (((s * 2 + hh) ^ qswz) << 4);
      const bf16x8 a0 = *(const bf16x8*)(sK + q * 128 + co);
      const bf16x8 a1 = *(const bf16x8*)(sK + (32 + q) * 128 + co);
      sacc[0] = MFMA32(a0, bq[s], sacc[0]);
      sacc[1] = MFMA32(a1, bq[s], sacc[1]);
    }
    float mx = -1e30f;
#pragma unroll
    for (int sub = 0; sub < 2; ++sub)
#pragma unroll
      for (int r = 0; r < 16; ++r) {
        const int kidx = sub * 32 + (r & 3) + 8 * (r >> 2) + 4 * hh;
        float v = sacc[sub][r] * 0.125f;
        bool ok = true;
        if (MODE == 2 && isP) {
          const int kr_ = rlo + j, kc_ = kidx;
          ok = (kr_ >= rsq) && (kr_ < rsq + 8) && (kc_ >= wsq) && (kc_ < wsq + 16);
          const int bi = ok ? ((kr_ - qr + 7) * 31 + (kc_ - qc + 15)) : 0;
          v += sBias[bi];
        }
        if (MODE == 3 && isP) {
          const int kpos = lo + j * 64 + kidx, dlt = kpos - qpos;
          ok = (dlt <= 128) && (dlt >= -128) && (kpos >= 0) && (kpos < 1024);
        }
        v = ok ? v : -1e30f;
        sacc[sub][r] = v;
        mx = fmaxf(mx, v);
      }
    mx = fmaxf(mx, __shfl_xor(mx, 32));
    const float m_new = fmaxf(m_run, mx);
    const float alpha = __expf(m_run - m_new);
    float rsum = 0.f;
#pragma unroll
    for (int sub = 0; sub < 2; ++sub)
#pragma unroll
      for (int r = 0; r < 16; ++r) {
        const float v = sacc[sub][r];
        const float pv = (v > -1e29f) ? __expf(v - m_new) : 0.f;
        sacc[sub][r] = pv; rsum += pv;
      }
    rsum += __shfl_xor(rsum, 32);
    l_run = l_run * alpha + rsum; m_run = m_new;
#pragma unroll
    for (int r = 0; r < 16; ++r) { oacc[0][r] *= alpha; oacc[1][r] *= alpha; }
#pragma unroll
    for (int k4 = 0; k4 < 4; ++k4) {
      const int sub = k4 >> 1, s2 = k4 & 1;
      uint4 pbu;
      pbu.x = pk2(sacc[sub][8 * s2 + 0], sacc[sub][8 * s2 + 1]); pbu.y = pk2(sacc[sub][8 * s2 + 2], sacc[sub][8 * s2 + 3]);
      pbu.z = pk2(sacc[sub][8 * s2 + 4], sacc[sub][8 * s2 + 5]); pbu.w = pk2(sacc[sub][8 * s2 + 6], sacc[sub][8 * s2 + 7]);
      const bf16x8 pb = __builtin_bit_cast(bf16x8, pbu);
#pragma unroll
      for (int dt = 0; dt < 2; ++dt) {
        const char* vp = sV + (dt * 32 + q) * 136 + (16 * k4 + 4 * hh) * 2;
        const uint2 lo8 = *(const uint2*)vp, hi8 = *(const uint2*)(vp + 16);
        uint4 avu; avu.x = lo8.x; avu.y = lo8.y; avu.z = hi8.x; avu.w = hi8.y;
        oacc[dt] = MFMA32(__builtin_bit_cast(bf16x8, avu), pb, oacc[dt]);
      }
    }
  }
#undef ATT_ISSUE
  float scale;
  if (MODE == 1 || MODE == 3) {
    const float m_f = fmaxf(m_run, sink);
    const float e = __expf(m_run - m_f);
    scale = e / (l_run * e + __expf(sink - m_f));
  } else scale = 1.0f / l_run;
#pragma unroll
  for (int dt = 0; dt < 2; ++dt)
#pragma unroll
    for (int g4 = 0; g4 < 4; ++g4) {
      const int d = dt * 32 + 8 * g4 + 4 * hh;
      uint2 o; o.x = pk2(oacc[dt][4 * g4] * scale, oacc[dt][4 * g4 + 1] * scale); o.y = pk2(oacc[dt][4 * g4 + 2] * scale, oacc[dt][4 * g4 + 3] * scale);
      *(uint2*)(Y + (size_t)qrow * D + ocol + d) = o;
    }
  __syncthreads();
}

DEV void post_item(const Params& p, int l, int tile, char* lds) {
  const int t = tid(), r0 = tile * TOKT, c = t;
  bf16_t* sA = (bf16_t*)lds;
  float* sgo = (float*)(lds + 32 * 136 * 2);
  const bf16_t* P = (const bf16_t*)(p.ws + OFF_P);
  bf16_t* Y = (bf16_t*)(p.ws + OFF_YMIX);
  const float* Y0 = (const float*)(p.ws + OFF_YDIR); const float* Y1 = Y0 + ARRF;
  const float* H0 = (const float*)(p.ws + OFF_HDIR); const float* H1 = H0 + ARRF;
  const bf16_t* BON = (const bf16_t*)(p.ws + OFF_BONUS);
  __syncthreads();
#pragma unroll
  for (int i = 0; i < TOKT / 2; ++i) {
    const int e = t + 256 * i, tk = e >> 7, j = e & 127;
    sA[tk * 136 + j] = f2bf(sigmoidf_(bf2f(P[(size_t)(r0 + tk) * DIN + C_GH + j])));
  }
  __syncthreads();
  {
    const int lane = t & 63, w = t >> 6, q = lane & 31, hh = lane >> 5;
    bf16x8 af[8];
#pragma unroll
    for (int s = 0; s < 8; ++s) af[s] = *(const bf16x8*)(sA + q * 136 + 16 * s + 8 * hh);
    const bf16_t* GT = (const bf16_t*)(p.ws + OFF_G2T) + (size_t)l * 256 * 128;
#pragma unroll
    for (int nt = 0; nt < 2; ++nt) {
      const int n = w * 64 + nt * 32 + q;
      f32x16 acc;
#pragma unroll
      for (int r = 0; r < 16; ++r) acc[r] = 0.f;
#pragma unroll
      for (int s = 0; s < 8; ++s) acc = MFMA32(af[s], *(const bf16x8*)(GT + (size_t)n * 128 + 16 * s + 8 * hh), acc);
#pragma unroll
      for (int r = 0; r < 8; ++r) sgo[((r & 3) + 8 * (r >> 2) + 4 * hh) * 256 + n] = acc[r];
      if (hh == 0) {
#pragma unroll
        for (int r = 8; r < 12; ++r) sgo[((r & 3) + 16) * 256 + n] = acc[r];
      }
    }
  }
  __syncthreads();
  const float lnw = p.in[I_LNW][l * 256 + c], lnb = p.in[I_LNB][l * 256 + c], hgn = p.in[I_HGN][l * 256 + c];
  float bA[5][5], bB[5][5];
#define POST_LOAD(B_, tbase) do { _Pragma("unroll") for (int u = 0; u < 5; ++u) { \
      const int row_ = r0 + (tbase) + u; const size_t idx_ = (size_t)row_ * 256 + c; \
      B_[0][u] = Y0[idx_] + Y1[idx_]; B_[1][u] = H0[idx_] + H1[idx_]; B_[2][u] = bf2f(BON[idx_]); \
      B_[3][u] = sgo[((tbase) + u) * 256 + c]; B_[4][u] = bf2f(P[(size_t)row_ * DIN + C_HG + c]); } } while (0)
#define POST_COMP(B_, tbase) do { _Pragma("unroll") for (int u = 0; u < 5; ++u) { \
      const int row = r0 + (tbase) + u; \
      const float mu = wave_sum(B_[0][u]) * (1.0f / 64.0f); \
      const float dy = B_[0][u] - mu; \
      const float var = wave_sum(dy * dy) * (1.0f / 64.0f); \
      const float yn = dy * __builtin_amdgcn_rsqf(var + 64e-5f) * lnw + lnb + B_[2][u]; \
      Y[(size_t)row * D + c] = f2bf(yn * B_[3][u]); \
      const float ms = wave_sum(B_[1][u] * B_[1][u]) * (1.0f / 64.0f); \
      Y[(size_t)row * D + 512 + c] = f2bf(B_[1][u] * __builtin_amdgcn_rsqf(ms + 1e-6f) * hgn * sigmoidf_(B_[4][u])); } } while (0)
  static_assert(TOKT == 20, "four batches of five tokens");
  POST_LOAD(bA, 0);
  POST_LOAD(bB, 5);  POST_COMP(bA, 0);
  POST_LOAD(bA, 10); POST_COMP(bB, 5);
  POST_LOAD(bB, 15); POST_COMP(bA, 10);
  POST_COMP(bB, 15);
#undef POST_LOAD
#undef POST_COMP
  __syncthreads();
}

constexpr int OFF_CTR_WORD = 3600;
DEV void mixer_phase(const Params& p, int l, char* lds0, volatile LAS unsigned* st, bool rerun) {
  const int hf = half_id(); char* lds = lds0 + hf * 65536;
  const int npairs = (256 + 512 + 512) / 2;
  unsigned* ctr = (unsigned*)(p.ws + OFF_BAR) + OFF_CTR_WORD + 64 * l + (rerun ? 32 : 0);
  bool first = true;
  for (;;) {
    int pair;
    if (first) { pair = (int)blockIdx.x; first = false; }
    else {
      if (threadIdx.x == 0) st[4] = gridDim.x + __hip_atomic_fetch_add(ctr, 1u, __ATOMIC_RELAXED, __HIP_MEMORY_SCOPE_AGENT);
      __syncthreads();
      pair = (int)st[4];
      __syncthreads();
    }
    if (pair >= npairs) break;
    const int it = pair * 2 + hf;
    const bool is_scan = it < 640;
    if (rerun && PROBE_SUB == 1 && !is_scan) continue;
    if (rerun && PROBE_SUB == 2 && is_scan) continue;
    if (rerun && PROBE_SUB == 3 && !(it < 128)) continue;
    if (rerun && PROBE_SUB == 4 && !(it >= 128 && it < 640)) continue;
    if (it < 128) {
      const int idx = it >> 1; const int seq = 32 + (idx >> 5), rem = idx & 31;
      if ((it & 1) == 0) rwkv_scan16(p, l, seq, rem >> 3, (rem >> 2) & 1, rem & 3, lds);
      else hgrn_scan16(p, l, seq, rem >> 3, (rem >> 2) & 1, rem & 3, lds);
    } else if (it < 640) {
      const int idx = (it - 128) & 255; const int seq = idx >> 3, rem = idx & 7;
      if (it < 384) rwkv_scan<2>(p, l, seq, rem >> 1, rem & 1, 0, lds);
      else hgrn_scan<2>(p, l, seq, rem >> 1, rem & 1, 0, lds);
    } else if (it < 704) attn_item<3>(p, l, it - 640, lds);
    else if (it < 768) attn_item<2>(p, l, it - 704, lds);
    else if (it < 1024) attn_item<0>(p, l, it - 768, lds);
    else attn_item<1>(p, l, it - 1024, lds);
  }
}

DEV void run_phase(const Params& p, int ph, char* lds, bool rerun, volatile LAS unsigned* st) {
  if (ph == 0) { phase0(p, lds); return; }
  if (ph == 1) { row_phase(p, 0, 0); return; }
  const int l = (ph - 2) / 9, s = (ph - 2) % 9;
  const bf16_t* H = (const bf16_t*)(p.ws + OFF_H);
  const int hf = half_id(); char* ldsh = lds + hf * 65536;
  switch (s) {
    case 0: gemm_run<0>(p, l, H, (const bf16_t*)(p.ws + OFF_WIN) + (size_t)l * DINP * D, D, DINP, lds); break;
    case 1:
      for (int it = blockIdx.x * 2 + hf; it < 512 + 256; it += gridDim.x * 2) { if (it < 512) prep_item(p, l, it, ldsh); else if (!rerun) rope_item(p, it - 512); }
      break;
    case 2: mixer_phase(p, l, lds, st, rerun); break;
    case 3: for (int it = blockIdx.x * 2 + hf; it < 512; it += gridDim.x * 2) post_item(p, l, it, ldsh); break;
    case 4: gemm_run<1>(p, l, (const bf16_t*)(p.ws + OFF_YMIX), (const bf16_t*)(p.ws + OFF_WOUT) + (size_t)l * D * D, D, D, lds); break;
    case 5: row_phase(p, 1, l); break;
    case 6: gemm_run<2>(p, l, H, (const bf16_t*)(p.ws + OFF_W1) + (size_t)l * FF * D, D, FF, lds); break;
    case 7: gemm_run<1>(p, l, (const bf16_t*)(p.ws + OFF_HID), (const bf16_t*)(p.ws + OFF_W2) + (size_t)l * D * FF, FF, D, lds); break;
    case 8: row_phase(p, 2, l); break;
  }
}

#define XB_TMO      128
#define XB_XCNT(j)  (256  + 64 * (j))
#define XB_XSUB(j)  (1280 + 64 * (j))
#define XB_XGEN(j)  (2304 + 64 * (j))
#define XB_TOP      3328
#define XB_TOPGEN   3392
#define XCD_BAR_WORDS 3456
#define XB_SPIN_CAP (1u << 18)
DEV unsigned xb_ld(unsigned* p) { return __hip_atomic_load(p, __ATOMIC_RELAXED, __HIP_MEMORY_SCOPE_AGENT); }
DEV unsigned xb_add(unsigned* p, unsigned v) { return __hip_atomic_fetch_add(p, v, __ATOMIC_RELAXED, __HIP_MEMORY_SCOPE_AGENT); }
DEV unsigned xb_xcc_id() { return (unsigned)__builtin_amdgcn_s_getreg((3 << 11) | 20) & 0xFu; }
#define XB_SPIN(cond, bar) do { unsigned _sp = 0; while (cond) { __builtin_amdgcn_s_sleep(1); \
    if ((++_sp & 255u) == 0u) { if (xb_ld(&(bar)[XB_TMO])) break; if (_sp > XB_SPIN_CAP) { atomicAdd(&(bar)[XB_TMO], 1u); break; } } } } while (0)
struct XcdBarrier { unsigned* bar; unsigned x; volatile LAS unsigned* st; };
DEV XcdBarrier xcd_barrier_post(unsigned* bar, volatile LAS unsigned* st) {
  XcdBarrier b; b.bar = bar; b.x = xb_xcc_id(); b.st = st;
  if (threadIdx.x == 0) (void)xb_add(&bar[XB_XCNT(b.x)], 1u);
  return b;
}
DEV void xcd_barrier_complete(unsigned* bar, unsigned x, unsigned& nloc, unsigned& nx) {
  const unsigned G = gridDim.x * gridDim.y * gridDim.z;
  unsigned sum, cnt, mine, sp = 0u;
  for (;;) {
    sum = 0u; cnt = 0u; mine = 0u;
#pragma unroll
    for (unsigned j = 0; j < 16; ++j) { const unsigned c = xb_ld(&bar[XB_XCNT(j)]); sum += c; cnt += (c > 0u) ? 1u : 0u; mine = (j == x) ? c : mine; }
    if (sum == G) break;
    __builtin_amdgcn_s_sleep(1);
    if ((++sp & 255u) == 0u) { if (xb_ld(&bar[XB_TMO])) break; if (sp > XB_SPIN_CAP) { atomicAdd(&bar[XB_TMO], 1u); break; } }
  }
  nloc = mine > 0u ? mine : 1u; nx = cnt > 0u ? cnt : 1u;
}
DEV void xcd_barrier(const XcdBarrier& b) {
  asm volatile("s_waitcnt vmcnt(0)" ::: "memory");
  __syncthreads();
  if (threadIdx.x == 0) {
    unsigned* bar = b.bar;
    { size_t zb_; asm volatile("s_mov_b64 %0, 0" : "=s"(zb_)); bar += zb_; }
    __builtin_amdgcn_s_waitcnt(0);
    unsigned nloc = b.st[0], nx = b.st[1];
    if (nloc == 0u) { xcd_barrier_complete(bar, b.x, nloc, nx); b.st[0] = nloc; b.st[1] = nx; }
    const unsigned old = xb_add(&bar[XB_XSUB(b.x)], 1u);
    const unsigned gen = old / nloc;
    if (old + 1u == (gen + 1u) * nloc) {
      __builtin_amdgcn_fence(__ATOMIC_RELEASE, "agent");
      asm volatile("s_waitcnt vmcnt(0)" ::: "memory");
      const unsigned og = xb_add(&bar[XB_TOP], 1u);
      const unsigned tg = og / nx;
      if (og + 1u == (tg + 1u) * nx) xb_add(&bar[XB_TOPGEN], 1u);
      else XB_SPIN(xb_ld(&bar[XB_TOPGEN]) == tg, bar);
      __builtin_amdgcn_fence(__ATOMIC_ACQUIRE, "agent");
      xb_add(&bar[XB_XGEN(b.x)], 1u);
      asm volatile("s_waitcnt vmcnt(0)" ::: "memory");
    } else {
      XB_SPIN(xb_ld(&bar[XB_XGEN(b.x)]) == gen, bar);
      __builtin_amdgcn_fence(__ATOMIC_ACQUIRE, "agent");
      asm volatile("s_waitcnt vmcnt(0)" ::: "memory");
    }
  }
  __syncthreads();
}

DEV int phase_kind(int ph) {
  if (ph == 0) return 0;
  if (ph == 1) return 1;
  const int s = (ph - 2) % 9;
  return s == 0 ? 2 : s == 1 ? 3 : s == 2 ? 4 : s == 3 ? 5 : s == 4 ? 6 : s == 5 ? 1 : s == 6 ? 7 : s == 7 ? 8 : 1;
}

constexpr int LDS_BYTES = 131072 + 64;

__global__ void __launch_bounds__(512, 2) mega(Params p, int ph_lo, int ph_hi) {
  extern __shared__ __attribute__((aligned(16))) unsigned char smem[];
  char* lds = (char*)smem;
  volatile LAS unsigned* st = (volatile LAS unsigned*)((LAS unsigned char*)smem + 131072);
  if (threadIdx.x == 0) { st[0] = 0u; st[1] = 0u; }
  __syncthreads();
  XcdBarrier xb = xcd_barrier_post((unsigned*)(p.ws + OFF_BAR), st);
  if (ph_hi < 0) cg::this_grid().sync();
  char* const ws0 = p.ws; float* const out0 = p.out;
  for (int ph = ph_lo; ph < ph_hi; ++ph) {
    { size_t z0_; asm volatile("s_mov_b64 %0, 0" : "=s"(z0_)); p.ws = ws0 + z0_; p.out = out0 + z0_; }
    run_phase(p, ph, lds, false, st);
    if (PROBE_KIND >= 0 && (PROBE_KIND == 9 || phase_kind(ph) == PROBE_KIND)) {
      xcd_barrier(xb);
      if (PROBE_KIND != 9) run_phase(p, ph, lds, true, st);
    }
    if (ph + 1 < ph_hi) xcd_barrier(xb);
  }
}

extern "C" void kernel_launch(void* const* d_in, const int* in_sizes, int n_in, void* d_out, int out_size, void* d_ws, size_t ws_size,
                              hipStream_t stream) {
  static int grid_blocks = 0;
  if (!grid_blocks) {
    int dev = 0, cus = 0, per_cu = 0;
    (void)hipGetDevice(&dev);
    (void)hipDeviceGetAttribute(&cus, hipDeviceAttributeMultiprocessorCount, dev);
    if (hipFuncSetAttribute((const void*)mega, hipFuncAttributeMaxDynamicSharedMemorySize, LDS_BYTES) != hipSuccess) fprintf(stderr, "hipFuncSetAttribute failed\n");
    (void)hipOccupancyMaxActiveBlocksPerMultiprocessor(&per_cu, mega, 512, LDS_BYTES);
    if (per_cu < 1) fprintf(stderr, "occupancy query reports %d blocks per CU\n", per_cu);
    (void)hipGetLastError();
    grid_blocks = cus;
  }
  if (ws_size < WS_TOTAL) { fprintf(stderr, "workspace too small: %zu < %zu\n", ws_size, (size_t)WS_TOTAL); return; }
  Params p{};
  for (int i = 0; i < 31; ++i) p.in[i] = (const float*)d_in[i];
  p.out = (float*)d_out;
  p.ws = (char*)d_ws;
  (void)hipMemsetAsync((char*)d_ws + OFF_BAR, 0, 16384, stream);
  int lo = 0, hi = NPH;
  void* args[] = {&p, &lo, &hi};
  hipError_t e = hipLaunchCooperativeKernel((void*)mega, dim3(grid_blocks), dim3(512), args, LDS_BYTES, stream);
  if (e != hipSuccess) fprintf(stderr, "cooperative launch failed: %s (grid %d)\n", hipGetErrorString(e), grid_blocks);
}
```

```cpp
#include <hip/hip_runtime.h>
#include <hip/hip_cooperative_groups.h>
#include <cstdio>
#include <cstdint>
namespace cg = cooperative_groups;

#ifndef ONE_LAUNCH
#define ONE_LAUNCH 1
#endif
#define PROBE_KIND -1
#define PROBE_SUB 0

#define DEV __device__ __forceinline__
#define LAS __attribute__((address_space(3)))
typedef unsigned short bf16_t;
typedef short bf16x8 __attribute__((ext_vector_type(8)));
typedef float f32x16 __attribute__((ext_vector_type(16)));
typedef __bf16 bf2_t __attribute__((ext_vector_type(2)));
typedef float f2_t __attribute__((ext_vector_type(2)));
typedef float f4n_t __attribute__((ext_vector_type(4)));
typedef unsigned u2n_t __attribute__((ext_vector_type(2)));

constexpr int D = 1024, DIN = 3712, FF = 4096, NCTX = 8192, MT = 10240;
constexpr int NPH = 38;
constexpr int DINP = 3840;
constexpr int C_R = 0, C_K = 256, C_V = 512, C_GH = 768, C_WHF = 896, C_WHB = 1024;
constexpr int C_NQ = 1152, C_NK = 1408, C_NV = 1664;
constexpr int C_HQ = 1920, C_HI = 2176, C_HG = 2432, C_HFF = 2688, C_HFB = 2944;
constexpr int C_SQ = 3200, C_SK = 3456, C_SV = 3584;
constexpr size_t O_NAT = 10485760, O_SWA = 27262976, O_RW = 35651584, O_HG = 39845888;
constexpr size_t ARRF = (size_t)MT * 256;
constexpr size_t ARR = ARRF * 4;
constexpr size_t OFF_WIN = 0;
constexpr size_t OFF_WOUT = OFF_WIN + (size_t)4 * DINP * D * 2;
constexpr size_t OFF_W1 = OFF_WOUT + (size_t)4 * D * D * 2;
constexpr size_t OFF_W2 = OFF_W1 + (size_t)4 * FF * D * 2;
constexpr size_t OFF_MOD = OFF_W2 + (size_t)4 * FF * D * 2;
constexpr size_t OFF_HGLB = OFF_MOD + (size_t)4 * 3 * 6144 * 4;
constexpr size_t OFF_P = OFF_HGLB + 8192;
constexpr size_t OFF_R1 = OFF_P + (size_t)MT * DIN * 2;
constexpr size_t OFF_H = OFF_R1;
constexpr size_t OFF_HID = OFF_H + (size_t)MT * D * 2;
constexpr size_t OFF_U = OFF_HID + (size_t)MT * FF * 2;
constexpr size_t OFF_PREP = OFF_R1;
constexpr size_t OFF_YDIR = OFF_PREP + 12 * ARR;
constexpr size_t OFF_BONUS = OFF_R1 + 14 * ARR;
constexpr size_t OFF_HDIR = OFF_BONUS + ARR / 2;
constexpr size_t OFF_YMIX = OFF_HDIR + 2 * ARR;
constexpr size_t OFF_X16 = OFF_YMIX + (size_t)MT * D * 2;
constexpr size_t OFF_BAR = OFF_X16 + (size_t)MT * D * 2;
constexpr size_t OFF_W2T = OFF_BAR + 16384;
constexpr size_t OFF_A2T = OFF_W2T + (size_t)4 * 2 * 256 * 64 * 2;
constexpr size_t OFF_G2T = OFF_A2T + (size_t)4 * 2 * 256 * 64 * 2;
constexpr size_t WS_TOTAL = OFF_G2T + (size_t)4 * 256 * 128 * 2;
static_assert(OFF_U + (size_t)MT * D * 4 == OFF_BONUS, "R1 layout");

struct Params {
  const float* in[31];
  float* out;
  char* ws;
};
enum { I_XP = 0, I_XS, I_CNAT, I_CSWA, I_SRW, I_SHG, I_C, I_CCTX, I_NORMG, I_MODW, I_MODB, I_WIN, I_WOUT, I_MURKV, I_MULORA,
       I_W0, I_W2, I_A0, I_A2, I_G2, I_KK, I_KA, I_RK, I_LNW, I_LNB, I_RPB, I_HGLB, I_HGN, I_SINK, I_FW1, I_FW2 };


DEV float bf2f(bf16_t h) { return __uint_as_float(((unsigned)h) << 16); }
DEV unsigned pk2(float a, float b) { f2_t v = {a, b}; bf2_t r = __builtin_convertvector(v, bf2_t); return __builtin_bit_cast(unsigned, r); }
DEV bf16_t f2bf(float f) { return (bf16_t)(pk2(f, f) & 0xffffu); }
DEV float4 bf4(uint2 u) { return make_float4(__uint_as_float(u.x << 16), __uint_as_float(u.x & 0xffff0000u), __uint_as_float(u.y << 16), __uint_as_float(u.y & 0xffff0000u)); }
DEV float bflo(unsigned u) { return __uint_as_float(u << 16); }
DEV float bfhi(unsigned u) { return __uint_as_float(u & 0xffff0000u); }
DEV float rcpf_(float x) { return __builtin_amdgcn_rcpf(x); }
DEV float sigmoidf_(float x) { return rcpf_(1.0f + __expf(-x)); }
DEV float tanhf_(float x) { return 1.0f - 2.0f * rcpf_(1.0f + __expf(2.0f * x)); }
template <int CTRL> DEV float dppf(float x) { return __int_as_float(__builtin_amdgcn_update_dpp(0, __float_as_int(x), CTRL, 0xF, 0xF, false)); }
DEV float row16_sum(float x) { x += dppf<0xB1>(x); x += dppf<0x4E>(x); x += dppf<0x141>(x); x += dppf<0x140>(x); return x; }
DEV float wave_sum(float x) { x = row16_sum(x); x += __shfl_xor(x, 16); x += __shfl_xor(x, 32); return x; }
DEV int clampi(int v, int lo, int hi) { return v < lo ? lo : (v > hi ? hi : v); }
#define MFMA32(a, b, c) __builtin_amdgcn_mfma_f32_32x32x16_bf16((a), (b), (c), 0, 0, 0)

DEV int tid() { int z; asm volatile("v_mov_b32 %0, 0" : "=v"(z)); return (int)(threadIdx.x & 255u) + z; }
DEV int half_id() { return __builtin_amdgcn_readfirstlane((int)(threadIdx.x >> 8)); }
DEV void transpose_item(const float* W, bf16_t* WT, int K, int N, int kt, int nt, char* lds) {
  bf16_t* s = (bf16_t*)lds;
  const int t = tid();
#pragma unroll
  for (int i = 0; i < 4; ++i) {
    const int k = (t >> 4) + 16 * i, n4 = (t & 15) * 4;
    const float4 v = *(const float4*)(W + (size_t)(kt * 64 + k) * N + nt * 64 + n4);
    s[(n4 + 0) * 72 + k] = f2bf(v.x); s[(n4 + 1) * 72 + k] = f2bf(v.y);
    s[(n4 + 2) * 72 + k] = f2bf(v.z); s[(n4 + 3) * 72 + k] = f2bf(v.w);
  }
  __syncthreads();
#pragma unroll
  for (int i = 0; i < 2; ++i) {
    const int n = (t >> 3) + 32 * i, kc = t & 7;
    const uint4 v = *(const uint4*)(s + n * 72 + kc * 8);
    *(uint4*)(WT + (size_t)(nt * 64 + n) * K + kt * 64 + kc * 8) = v;
  }
  __syncthreads();
}

DEV void mod_item(const Params& p, int l, int jb, char* lds) {
  float* sc = (float*)lds;
  float* red = (float*)(lds + 12288);
  const int t = tid();
  for (int i = t; i < 3072; i += 256) {
    const int c = i >> 10, k = i & 1023;
    const float x = (c == 0) ? p.in[I_CCTX][k] : p.in[I_C][(c - 1) * 1024 + k];
    sc[i] = x * rcpf_(1.0f + __expf(-x));
  }
  __syncthreads();
  const int c4 = t & 15, ks = t >> 4;
  const float* wp = p.in[I_MODW] + ((size_t)l * 1024 + ks * 64) * 6144 + jb * 64 + c4 * 4;
  float a00 = 0, a01 = 0, a02 = 0, a03 = 0, a10 = 0, a11 = 0, a12 = 0, a13 = 0, a20 = 0, a21 = 0, a22 = 0, a23 = 0;
#pragma unroll 16
  for (int ii = 0; ii < 64; ++ii) {
    const f4n_t w = __builtin_nontemporal_load((const f4n_t*)(wp + (size_t)ii * 6144));
    const int k = ks * 64 + ii;
    const float s0 = sc[k], s1 = sc[1024 + k], s2 = sc[2048 + k];
    a00 += s0 * w.x; a01 += s0 * w.y; a02 += s0 * w.z; a03 += s0 * w.w;
    a10 += s1 * w.x; a11 += s1 * w.y; a12 += s1 * w.z; a13 += s1 * w.w;
    a20 += s2 * w.x; a21 += s2 * w.y; a22 += s2 * w.z; a23 += s2 * w.w;
  }
  float* r0 = red + (ks * 3 + 0) * 64 + c4 * 4; r0[0] = a00; r0[1] = a01; r0[2] = a02; r0[3] = a03;
  float* r1 = red + (ks * 3 + 1) * 64 + c4 * 4; r1[0] = a10; r1[1] = a11; r1[2] = a12; r1[3] = a13;
  float* r2 = red + (ks * 3 + 2) * 64 + c4 * 4; r2[0] = a20; r2[1] = a21; r2[2] = a22; r2[3] = a23;
  __syncthreads();
  if (t < 192) {
    const int c = t >> 6, col = t & 63;
    float v = p.in[I_MODB][l * 6144 + jb * 64 + col];
#pragma unroll
    for (int k2 = 0; k2 < 16; ++k2) v += red[(k2 * 3 + c) * 64 + col];
    ((float*)(p.ws + OFF_MOD))[(size_t)(l * 3 + c) * 6144 + jb * 64 + col] = v;
  }
  __syncthreads();
}

DEV void hglb_item(const Params& p) {
  const int c = tid();
  float* HGLB = (float*)(p.ws + OFF_HGLB);
  for (int dir = 0; dir < 2; ++dir) {
    float x[4], mx = -1e30f;
    for (int l = 0; l < 4; ++l) { x[l] = p.in[I_HGLB][(dir * 4 + l) * 256 + c]; mx = fmaxf(mx, x[l]); }
    float s = 0;
    for (int l = 0; l < 4; ++l) { x[l] = __expf(x[l] - mx); s += x[l]; }
    float cum = 0; const float s0 = x[0] / s;
    for (int l = 0; l < 4; ++l) { cum += x[l] / s; HGLB[(l * 2 + dir) * 256 + c] = cum - s0; }
  }
}

constexpr int NT_LAYER = 928 + 256 + 1024 + 1024;
struct TileDesc { const float* W; bf16_t* WT; int K, N, kt, nt; };
DEV TileDesc layer_tile_desc(const Params& p, int l, int j) {
  TileDesc d;
  if (j < 928) { d.W = p.in[I_WIN] + (size_t)l * D * DIN; d.WT = (bf16_t*)(p.ws + OFF_WIN) + (size_t)l * DINP * D; d.K = D; d.N = DIN; d.kt = j / 58; d.nt = j % 58; return d; }
  j -= 928;
  if (j < 256) { d.W = p.in[I_WOUT] + (size_t)l * D * D; d.WT = (bf16_t*)(p.ws + OFF_WOUT) + (size_t)l * D * D; d.K = D; d.N = D; d.kt = j / 16; d.nt = j % 16; return d; }
  j -= 256;
  if (j < 1024) { d.W = p.in[I_FW1] + (size_t)l * D * FF; d.WT = (bf16_t*)(p.ws + OFF_W1) + (size_t)l * FF * D; d.K = D; d.N = FF; d.kt = j / 64; d.nt = j % 64; return d; }
  j -= 1024;
  d.W = p.in[I_FW2] + (size_t)l * FF * D; d.WT = (bf16_t*)(p.ws + OFF_W2) + (size_t)l * D * FF; d.K = FF; d.N = D; d.kt = j / 16; d.nt = j % 16; return d;
}
DEV void tile_load(const TileDesc& d, float4 (&v)[4]) {
  const int t = tid();
#pragma unroll
  for (int i = 0; i < 4; ++i) {
    const f4n_t w = __builtin_nontemporal_load((const f4n_t*)(d.W + (size_t)(d.kt * 64 + (t >> 4) + 16 * i) * d.N + d.nt * 64 + (t & 15) * 4));
    v[i] = make_float4(w.x, w.y, w.z, w.w);
  }
}
DEV void tile_store(const TileDesc& d, const float4 (&v)[4], char* lds) {
  bf16_t* s = (bf16_t*)lds;
  const int t = tid();
#pragma unroll
  for (int i = 0; i < 4; ++i) {
    const int k = (t >> 4) + 16 * i, n4 = (t & 15) * 4;
    s[(n4 + 0) * 72 + k] = f2bf(v[i].x); s[(n4 + 1) * 72 + k] = f2bf(v[i].y);
    s[(n4 + 2) * 72 + k] = f2bf(v[i].z); s[(n4 + 3) * 72 + k] = f2bf(v[i].w);
  }
  __syncthreads();
#pragma unroll
  for (int i = 0; i < 2; ++i) {
    const int n = (t >> 3) + 32 * i, kc = t & 7;
    const uint4 o = *(const uint4*)(s + n * 72 + kc * 8);
    *(uint4*)(d.WT + (size_t)(d.nt * 64 + n) * d.K + d.kt * 64 + kc * 8) = o;
  }
  __syncthreads();
}
DEV void layer_tiles(const Params& p, int l, int lo, int hi, int vb, int nvb, char* lds0) {
  const int hf = half_id(); char* lds = lds0 + hf * 65536;
  int it = lo + vb * 2 + hf;
  if (it >= hi) return;
  float4 vn[4];
  TileDesc dn = layer_tile_desc(p, l, it);
  tile_load(dn, vn);
  for (; it < hi; it += nvb * 2) {
    float4 vc[4] = {vn[0], vn[1], vn[2], vn[3]};
    const TileDesc dc = dn;
    if (it + nvb * 2 < hi) { dn = layer_tile_desc(p, l, it + nvb * 2); tile_load(dn, vn); }
    tile_store(dc, vc, lds);
  }
}

DEV void phase0(const Params& p, char* lds0) {
  const int hf = half_id(); char* lds = lds0 + hf * 65536;
  const int nitems = 386 + 4 + 20;
  for (int it = blockIdx.x * 2 + hf; it < nitems; it += gridDim.x * 2) {
    if (it < 384) { mod_item(p, it / 96, it % 96, lds); continue; }
    if (it == 384) { hglb_item(p); continue; }
    if (it == 385) continue;
    const int j = it - 386;
    if (j >= 4) {
      const int s = j - 4, n = tid();
      const float* src; bf16_t* dst; int KK;
      if (s < 8) { src = p.in[I_W2] + (size_t)s * 64 * 256; dst = (bf16_t*)(p.ws + OFF_W2T) + (size_t)s * 256 * 64; KK = 64; }
      else if (s < 16) { src = p.in[I_A2] + (size_t)(s - 8) * 64 * 256; dst = (bf16_t*)(p.ws + OFF_A2T) + (size_t)(s - 8) * 256 * 64; KK = 64; }
      else { src = p.in[I_G2] + (size_t)(s - 16) * 128 * 256; dst = (bf16_t*)(p.ws + OFF_G2T) + (size_t)(s - 16) * 256 * 128; KK = 128; }
      for (int k0 = 0; k0 < KK; k0 += 32) {
        float v[32];
#pragma unroll
        for (int e = 0; e < 32; ++e) v[e] = src[(size_t)(k0 + e) * 256 + n];
#pragma unroll
        for (int q4 = 0; q4 < 4; ++q4) {
          uint4 o; o.x = pk2(v[8 * q4], v[8 * q4 + 1]); o.y = pk2(v[8 * q4 + 2], v[8 * q4 + 3]); o.z = pk2(v[8 * q4 + 4], v[8 * q4 + 5]); o.w = pk2(v[8 * q4 + 6], v[8 * q4 + 7]);
          *(uint4*)(dst + (size_t)n * KK + k0 + 8 * q4) = o;
        }
      }
      continue;
    }
    {
      uint4* z = (uint4*)((bf16_t*)(p.ws + OFF_WIN) + ((size_t)j * DINP + DIN) * D);
      const int t = tid();
      for (int i = t; i < 128 * D * 2 / 16; i += 256) z[i] = make_uint4(0u, 0u, 0u, 0u);
    }
  }
  const int vb = ((int)blockIdx.x + (int)gridDim.x - 195 % (int)gridDim.x) % (int)gridDim.x;
  layer_tiles(p, 0, 0, NT_LAYER, vb, (int)gridDim.x, lds0);
  if ((int)gridDim.x <= 160) { for (int ll = 1; ll < 4; ++ll) layer_tiles(p, ll, 0, NT_LAYER, (int)blockIdx.x, (int)gridDim.x, lds0); }
}

constexpr int RPW = 5;
DEV void row_phase(const Params& p, int mode, int l) {
  const int lane = tid() & 63;
  const int nw = gridDim.x * 8;
  const float* MOD = (const float*)(p.ws + OFF_MOD);
  const float* NG = p.in[I_NORMG];
  const bf16_t* U = (const bf16_t*)(p.ws + OFF_U);
  bf16_t* H = (bf16_t*)(p.ws + OFF_H);
  bf16_t* X16 = (bf16_t*)(p.ws + OFF_X16);
  const bool has_next = !(mode == 2 && l == 3);
  const int ln = (mode == 0) ? 0 : (mode == 1 ? l : l + 1);
  const int gi = (mode == 1) ? 2 : 0, shi = (mode == 1) ? 3 : 0, sci = (mode == 1) ? 4 : 1;
  const float* ga = NG + (size_t)(l * 4 + (mode == 1 ? 1 : 3)) * 1024;
  const float* gb = NG + (size_t)((has_next ? ln : 0) * 4 + gi) * 1024;
  for (int rowa = blockIdx.x * 8 + half_id() * 4 + (tid() >> 6); rowa < MT; rowa += RPW * nw) {
    float4 x[RPW][4]; uint2 ub[RPW][4];
    int rows[RPW]; bool ok[RPW];
#pragma unroll
    for (int q = 0; q < RPW; ++q) {
      rows[q] = rowa + q * nw; ok[q] = rows[q] < MT;
      const int row = ok[q] ? rows[q] : rowa;
      if (mode == 0) {
        const float* src = row < NCTX ? p.in[I_XP] + (size_t)row * D : p.in[I_XS] + (size_t)(row - NCTX) * D;
#pragma unroll
        for (int i = 0; i < 4; ++i) { const f4n_t w = __builtin_nontemporal_load((const f4n_t*)(src + i * 256 + lane * 4)); x[q][i] = make_float4(w.x, w.y, w.z, w.w); }
      } else {
#pragma unroll
        for (int i = 0; i < 4; ++i) {
          const u2n_t xn = __builtin_nontemporal_load((const u2n_t*)(X16 + (size_t)row * D + i * 256 + lane * 4));
          uint2 xb; xb.x = xn.x; xb.y = xn.y;
          x[q][i] = make_float4(bflo(xb.x), bfhi(xb.x), bflo(xb.y), bfhi(xb.y));
          const u2n_t un = __builtin_nontemporal_load((const u2n_t*)(U + (size_t)row * D + i * 256 + lane * 4));
          ub[q][i].x = un.x; ub[q][i].y = un.y;
        }
      }
    }
#pragma unroll
    for (int q = 0; q < RPW; ++q) {
      const int row = ok[q] ? rows[q] : rowa;
      const int cond = row < NCTX ? 0 : 1 + ((row - NCTX) >> 10);
      if (mode != 0) {
        float4 u[4];
        float ss = 0;
#pragma unroll
        for (int i = 0; i < 4; ++i) {
          u[i] = make_float4(bflo(ub[q][i].x), bfhi(ub[q][i].x), bflo(ub[q][i].y), bfhi(ub[q][i].y));
          ss += u[i].x * u[i].x + u[i].y * u[i].y + u[i].z * u[i].z + u[i].w * u[i].w;
        }
        ss = wave_sum(ss);
        const float r = __builtin_amdgcn_rsqf(ss * (1.0f / 1024.0f) + 1e-6f);
        const float* gate = MOD + (size_t)(l * 3 + cond) * 6144 + (mode == 1 ? 2 : 5) * 1024;
#pragma unroll
        for (int i = 0; i < 4; ++i) {
          const float4 g4 = *(const float4*)(gate + i * 256 + lane * 4);
          const float4 a4 = *(const float4*)(ga + i * 256 + lane * 4);
          x[q][i].x += g4.x * (u[i].x * r * a4.x); x[q][i].y += g4.y * (u[i].y * r * a4.y);
          x[q][i].z += g4.z * (u[i].z * r * a4.z); x[q][i].w += g4.w * (u[i].w * r * a4.w);
        }
      }
      if (ok[q]) {
        if (has_next) {
#pragma unroll
          for (int i = 0; i < 4; ++i) { uint2 o; o.x = pk2(x[q][i].x, x[q][i].y); o.y = pk2(x[q][i].z, x[q][i].w); *(uint2*)(X16 + (size_t)row * D + i * 256 + lane * 4) = o; }
        } else {
#pragma unroll
          for (int i = 0; i < 4; ++i) *(float4*)(p.out + (size_t)row * D + i * 256 + lane * 4) = x[q][i];
        }
      }
      if (has_next) {
        float ss = 0;
#pragma unroll
        for (int i = 0; i < 4; ++i) ss += x[q][i].x * x[q][i].x + x[q][i].y * x[q][i].y + x[q][i].z * x[q][i].z + x[q][i].w * x[q][i].w;
        ss = wave_sum(ss);
        const float r2 = __builtin_amdgcn_rsqf(ss * (1.0f / 1024.0f) + 1e-6f);
        const float* sh = MOD + (size_t)(ln * 3 + cond) * 6144 + shi * 1024;
        const float* sc = MOD + (size_t)(ln * 3 + cond) * 6144 + sci * 1024;
        if (ok[q]) {
#pragma unroll
          for (int i = 0; i < 4; ++i) {
            const float4 g4 = *(const float4*)(gb + i * 256 + lane * 4);
            const float4 s4 = *(const float4*)(sc + i * 256 + lane * 4);
            const float4 h4 = *(const float4*)(sh + i * 256 + lane * 4);
            const float h0 = x[q][i].x * r2 * g4.x * (1.0f + s4.x) + h4.x;
            const float h1 = x[q][i].y * r2 * g4.y * (1.0f + s4.y) + h4.y;
            const float h2 = x[q][i].z * r2 * g4.z * (1.0f + s4.z) + h4.z;
            const float h3 = x[q][i].w * r2 * g4.w * (1.0f + s4.w) + h4.w;
            uint2 o; o.x = pk2(h0, h1); o.y = pk2(h2, h3);
            *(uint2*)(H + (size_t)row * D + i * 256 + lane * 4) = o;
          }
        }
      }
    }
  }
}

namespace pg8 {
#define PG8_LAS __attribute__((address_space(3)))
typedef unsigned short bf16_t;
typedef short bf16x8 __attribute__((ext_vector_type(8)));
typedef float f32x4 __attribute__((ext_vector_type(4)));
typedef unsigned u32x4 __attribute__((ext_vector_type(4)));
constexpr int BM = 256, BK = 64, HALF = 128, HTB = HALF * BK * 2  , STAGE_BYTES = 8 * HTB, NXCD = 8, WGM = 8;

__host__ __device__ __forceinline__ int lds_byte(int r, int c) { const int st = (r >> 4) * 2 + (c >> 5), rr = r & 15, cc = c & 31, ob = rr * 64 + cc * 2; return st * 1024 + (ob ^ (((ob >> 9) & 1) << 5)); }
__host__ __device__ __forceinline__ void stage_rc(int b, int& R, int& C) { const int st = b / 1024, sb = b % 1024, swz = sb ^ (((sb >> 9) & 1) << 5); R = (st >> 1) * 16 + swz / 64; C = (st & 1) * 32 + (swz % 64) / 2; }
__host__ __device__ __forceinline__ int perm32(int rho) { const int n = rho >> 4, i = rho & 15; return 8 * (i >> 2) + 4 * n + (i & 3); }

struct Unit { int pm, pn; };
struct Gemm { const bf16_t* A; const bf16_t* Bt; int M, N, K; };

struct StaticOrder {
    int nM, nN, nwg, G, c;
    __host__ __device__ void init(int M, int N, int G_, int c_) { nM = M / BM; nN = N / BM; nwg = nM * nN; G = G_; c = c_; }
    __host__ __device__ bool next(int i, Unit& u) const {
        const long L = (long)i * G + c; if (L >= nwg) return false;
        int wgid = (int)L; { const int q = nwg / NXCD, r = nwg % NXCD, xcd = wgid % NXCD, off = wgid / NXCD; wgid = (xcd < r ? xcd * (q + 1) : r * (q + 1) + (xcd - r) * q) + off; }
        const int nig = WGM * nN, gid = wgid / nig, fm = gid * WGM, gsz = (nM - fm) < WGM ? (nM - fm) : WGM;
        u.pm = fm + ((wgid % nig) % gsz); u.pn = (wgid % nig) / gsz; return true;
    }
    __device__ __forceinline__ void a_ready(const Unit&) const {}
    __device__ __forceinline__ void done(const Unit&) const {}
};

template <class Epi, class Sched, bool ALIGN_EPI = false, bool SP2 = false>
__device__ __forceinline__ void gemm_phase(PG8_LAS unsigned char* lds, const Gemm g, const Sched& S, const Epi& E) {
    int tid_z; asm volatile("v_mov_b32 %0, 0" : "=v"(tid_z)); const int tid = (int)threadIdx.x + tid_z, wid = __builtin_amdgcn_readfirstlane(tid >> 6), lane = tid & 63, wr = wid >> 2, wc = wid & 3, fr = lane & 15, fq = lane >> 4;
    const int K = g.K, nt = K / BK;
    unsigned voffA[2], voffB[2];
#pragma unroll
    for (int i = 0; i < 2; ++i) { int R, C; stage_rc(tid * 16 + i * 8192, R, C); const int Rb = Epi::PERM ? ((R & ~31) + perm32(R & 31)) : R;
        voffA[i] = (unsigned)(R * K + C) * 2u; voffB[i] = (unsigned)(Rb * K + C) * 2u; }
    const size_t kstep = (size_t)(BK * 2);
    const size_t hstep = (size_t)HALF * K * 2;
    const size_t tstep = 2 * hstep;
    const unsigned ldsw = (unsigned)wid * 1024u;
    const int aoff = lds_byte(wr * 64 + fr, fq * 8), boff = lds_byte(wc * 32 + fr, fq * 8);
#define PG8_SA(b, h) (((b) * 2 + (h)) * HTB)
#define PG8_SB(b, h) ((4 + (b) * 2 + (h)) * HTB)
#define PG8_STAGE(bufoff, gbase, voff) do { _Pragma("unroll") for (int _i = 0; _i < 2; ++_i) \
        __builtin_amdgcn_global_load_lds((const unsigned*)((const char*)(gbase) + (voff)[_i]), (PG8_LAS unsigned*)(lds + (bufoff) + ldsw + _i * 8192), 16, 0, 0); } while (0)
#define PG8_LDA(dst, b, h) do { _Pragma("unroll") for (int m = 0; m < 4; ++m) _Pragma("unroll") for (int k = 0; k < 2; ++k) dst[m][k] = *(const PG8_LAS bf16x8*)(lds + PG8_SA(b, h) + aoff + m * 2048 + k * 1024); } while (0)
#define PG8_LDB(dst, b, h) do { _Pragma("unroll") for (int n = 0; n < 2; ++n) _Pragma("unroll") for (int k = 0; k < 2; ++k) dst[n][k] = *(const PG8_LAS bf16x8*)(lds + PG8_SB(b, h) + boff + n * 2048 + k * 1024); } while (0)
#define PG8_MMA(ai, bj, At, Bt) do { __builtin_amdgcn_s_setprio(1); _Pragma("unroll") for (int m = 0; m < 4; ++m) _Pragma("unroll") for (int n = 0; n < 2; ++n) _Pragma("unroll") for (int k = 0; k < 2; ++k) \
        acc[ai][bj][m][n] = __builtin_amdgcn_mfma_f32_16x16x32_bf16(Bt[n][k], At[m][k], acc[ai][bj][m][n], 0, 0, 0); __builtin_amdgcn_s_setprio(0); } while (0)
#define PG8_WAIT_V(n) asm volatile("s_waitcnt vmcnt(" #n ")" ::: "memory")
#define PG8_WAIT_L(n) asm volatile("s_waitcnt lgkmcnt(" #n ")" ::: "memory")
#define PG8_BAR __builtin_amdgcn_s_barrier()
#define PG8_SCHED __builtin_amdgcn_sched_barrier(0)
    Unit cur, nxt; int ui = 0;
    if (!S.next(0, cur)) return;
    f32x4 acc[2][2][4][2];
#pragma unroll
    for (int a = 0; a < 2; ++a)
#pragma unroll
        for (int b = 0; b < 2; ++b)
#pragma unroll
            for (int m = 0; m < 4; ++m)
#pragma unroll
                for (int n = 0; n < 2; ++n) acc[a][b][m][n] = (f32x4){0.f, 0.f, 0.f, 0.f};
    bf16x8 At[4][2], B0[2][2], B1[2][2];
    const char* cA = (const char*)g.A + (size_t)cur.pm * tstep; const char* cB = (const char*)g.Bt + (size_t)cur.pn * tstep;
    S.a_ready(cur);
    if constexpr (SP2) {
        PG8_STAGE(PG8_SB(0, 0), cB, voffB); PG8_STAGE(PG8_SB(0, 1), cB + hstep, voffB); PG8_STAGE(PG8_SA(0, 0), cA, voffA); PG8_STAGE(PG8_SA(0, 1), cA + hstep, voffA);
        if (wr == 1) PG8_BAR;
        PG8_WAIT_V(2); PG8_BAR;
        PG8_STAGE(PG8_SB(1, 0), cB + kstep, voffB); PG8_STAGE(PG8_SA(1, 0), cA + kstep, voffA); PG8_STAGE(PG8_SB(1, 1), cB + hstep + kstep, voffB);
        PG8_WAIT_V(6); PG8_BAR;
    } else {
        PG8_STAGE(PG8_SB(0, 0), cB, voffB); PG8_STAGE(PG8_SA(0, 0), cA, voffA); PG8_STAGE(PG8_SB(0, 1), cB + hstep, voffB); PG8_STAGE(PG8_SA(0, 1), cA + hstep, voffA);
        if (wr == 1) PG8_BAR;
        PG8_WAIT_V(4); PG8_BAR;
        PG8_STAGE(PG8_SB(1, 0), cB + kstep, voffB); PG8_STAGE(PG8_SA(1, 0), cA + kstep, voffA); PG8_STAGE(PG8_SB(1, 1), cB + hstep + kstep, voffB);
        PG8_WAIT_V(6); PG8_BAR;
    }
    for (;;) {
        const bool has_next = S.next(ui + 1, nxt);
        const char* nA = has_next ? (const char*)g.A + (size_t)nxt.pm * tstep : cA; const char* nB = has_next ? (const char*)g.Bt + (size_t)nxt.pn * tstep : cB;
        for (int t = 0; t < nt; t += 2) {
            const bool last = (t == nt - 2);
            const char* a1 = cA + (size_t)(t + 1) * kstep;
            const char* a2 = last ? nA : cA + (size_t)(t + 2) * kstep; const char* b2 = last ? nB : cB + (size_t)(t + 2) * kstep;
            const char* a3 = a2 + kstep; const char* b3 = b2 + kstep;
            if (last && has_next) S.a_ready(nxt);
            if constexpr (SP2) {
            PG8_LDB(B0, 0, 0); PG8_LDB(B1, 0, 1); PG8_SCHED; PG8_LDA(At, 0, 0); PG8_STAGE(PG8_SA(1, 1), a1 + hstep, voffA);
            PG8_WAIT_V(8); PG8_WAIT_L(0); PG8_BAR; PG8_MMA(0, 0, At, B0); PG8_MMA(0, 1, At, B1); PG8_BAR; PG8_SCHED;
            PG8_LDA(At, 0, 1); PG8_STAGE(PG8_SB(0, 0), b2, voffB); PG8_STAGE(PG8_SB(0, 1), b2 + hstep, voffB); PG8_STAGE(PG8_SA(0, 0), a2, voffA);
            PG8_WAIT_V(8); PG8_WAIT_L(0); PG8_BAR; PG8_MMA(1, 0, At, B0); PG8_MMA(1, 1, At, B1); PG8_BAR; PG8_SCHED;
            PG8_LDB(B0, 1, 0); PG8_LDB(B1, 1, 1); PG8_SCHED; PG8_LDA(At, 1, 0); PG8_STAGE(PG8_SA(0, 1), a2 + hstep, voffA);
            PG8_WAIT_V(8); PG8_WAIT_L(0); PG8_BAR; PG8_MMA(0, 0, At, B0); PG8_MMA(0, 1, At, B1); PG8_BAR; PG8_SCHED;
            PG8_LDA(At, 1, 1); PG8_STAGE(PG8_SB(1, 0), b3, voffB); PG8_STAGE(PG8_SB(1, 1), b3 + hstep, voffB); PG8_STAGE(PG8_SA(1, 0), a3, voffA);
            PG8_WAIT_V(8); PG8_WAIT_L(0); PG8_BAR; PG8_MMA(1, 0, At, B0); PG8_MMA(1, 1, At, B1); PG8_BAR; PG8_SCHED;
            } else {
            PG8_LDB(B0, 0, 0); PG8_SCHED; PG8_LDA(At, 0, 0); PG8_STAGE(PG8_SA(1, 1), a1 + hstep, voffA);
            PG8_WAIT_L(8); PG8_BAR; PG8_WAIT_L(0); PG8_MMA(0, 0, At, B0); PG8_BAR; PG8_SCHED;
            PG8_LDB(B1, 0, 1); PG8_STAGE(PG8_SB(0, 0), b2, voffB);
            PG8_BAR; PG8_WAIT_L(0); PG8_MMA(0, 1, At, B1); PG8_BAR;
            PG8_LDA(At, 0, 1); PG8_STAGE(PG8_SA(0, 0), a2, voffA);
            PG8_BAR; PG8_WAIT_L(0); PG8_MMA(1, 0, At, B0); PG8_BAR; PG8_SCHED;
            PG8_STAGE(PG8_SB(0, 1), b2 + hstep, voffB);
            PG8_WAIT_V(6); PG8_BAR; PG8_MMA(1, 1, At, B1); PG8_BAR;
            PG8_LDB(B0, 1, 0); PG8_SCHED; PG8_LDA(At, 1, 0); PG8_STAGE(PG8_SA(0, 1), a2 + hstep, voffA);
            PG8_WAIT_L(8); PG8_BAR; PG8_WAIT_L(0); PG8_MMA(0, 0, At, B0); PG8_BAR; PG8_SCHED;
            PG8_LDB(B1, 1, 1); PG8_STAGE(PG8_SB(1, 0), b3, voffB);
            PG8_BAR; PG8_WAIT_L(0); PG8_MMA(0, 1, At, B1); PG8_BAR;
            PG8_LDA(At, 1, 1); PG8_STAGE(PG8_SA(1, 0), a3, voffA);
            PG8_BAR; PG8_WAIT_L(0); PG8_MMA(1, 0, At, B0); PG8_BAR; PG8_SCHED;
            PG8_STAGE(PG8_SB(1, 1), b3 + hstep, voffB);
            PG8_WAIT_V(6); PG8_BAR; PG8_MMA(1, 1, At, B1); PG8_BAR;
            }
        }
        if constexpr (ALIGN_EPI) { if (wr == 0) PG8_BAR; }
        if constexpr (!Epi::AFTER_DRAIN) { E(acc, cur, wr, wc, fr, fq); S.done(cur); }
        if (!has_next) break;
#pragma unroll
        for (int a = 0; a < 2; ++a)
#pragma unroll
            for (int b = 0; b < 2; ++b)
#pragma unroll
                for (int m = 0; m < 4; ++m)
#pragma unroll
                    for (int n = 0; n < 2; ++n) acc[a][b][m][n] = (f32x4){0.f, 0.f, 0.f, 0.f};
        cur = nxt; cA = nA; cB = nB; ++ui;
        if constexpr (ALIGN_EPI) { if (wr == 1) PG8_BAR; }
    }
    PG8_WAIT_V(0);
    if constexpr (!ALIGN_EPI) { if (wr == 0) PG8_BAR; }
    PG8_BAR;
    if constexpr (Epi::AFTER_DRAIN) { E.fused(acc, cur, wr, wc, fr, fq, lds, wid, lane); S.done(cur); }
#undef PG8_SA
#undef PG8_SB
#undef PG8_STAGE
#undef PG8_LDA
#undef PG8_LDB
#undef PG8_MMA
#undef PG8_WAIT_V
#undef PG8_WAIT_L
#undef PG8_BAR
#undef PG8_SCHED
}
}

template <int MODE> struct EpiMK {
  static constexpr bool PERM = true, AFTER_DRAIN = false;
  const Params* pp; int l;
  DEV void operator()(const pg8::f32x4 (&acc)[2][2][4][2], const pg8::Unit& u, int wr, int wc, int fr, int fq) const {
    const Params& p = *pp;
#pragma unroll
    for (int ai = 0; ai < 2; ++ai)
#pragma unroll
      for (int m = 0; m < 4; ++m) {
        const int row = u.pm * 256 + ai * 128 + wr * 64 + m * 16 + fr;
#pragma unroll
        for (int bj = 0; bj < 2; ++bj) {
          const int col = u.pn * 256 + bj * 128 + wc * 32 + fq * 8;
          const pg8::f32x4 v0 = acc[ai][bj][m][0], v1 = acc[ai][bj][m][1];
          if (MODE == 0) {
            if (col < DIN) {
              uint4 o; o.x = pk2(v0[0], v0[1]); o.y = pk2(v0[2], v0[3]); o.z = pk2(v1[0], v1[1]); o.w = pk2(v1[2], v1[3]);
              *(uint4*)((bf16_t*)(p.ws + OFF_P) + (size_t)row * DIN + col) = o;
              if (row < NCTX) {
                if (col >= C_NK && col < C_HQ) {
                  const int kv = col >= C_NV;
                  float* dst = p.out + O_NAT + (size_t)(((row >> 8) * 4 + l) * 2 + kv) * 65536 + (row & 255) * 256 + (col - (kv ? C_NV : C_NK));
                  *(pg8::f32x4*)dst = v0; *(pg8::f32x4*)(dst + 4) = v1;
                } else if (col >= C_SK) {
                  const int kv = col >= C_SV;
                  float* dst = p.out + O_SWA + (size_t)(((row >> 8) * 4 + l) * 2 + kv) * 32768 + (row & 255) * 128 + (col - (kv ? C_SV : C_SK));
                  *(pg8::f32x4*)dst = v0; *(pg8::f32x4*)(dst + 4) = v1;
                }
              }
            }
          } else if (MODE == 1) {
            uint4 o; o.x = pk2(v0[0], v0[1]); o.y = pk2(v0[2], v0[3]); o.z = pk2(v1[0], v1[1]); o.w = pk2(v1[2], v1[3]);
            *(uint4*)((bf16_t*)(p.ws + OFF_U) + (size_t)row * D + col) = o;
          } else {
            float r[8];
#pragma unroll
            for (int e = 0; e < 4; ++e) { const float a = fmaxf(v0[e], 0.f), b2 = fmaxf(v1[e], 0.f); r[e] = a * a; r[4 + e] = b2 * b2; }
            uint4 o; o.x = pk2(r[0], r[1]); o.y = pk2(r[2], r[3]); o.z = pk2(r[4], r[5]); o.w = pk2(r[6], r[7]);
            *(uint4*)((bf16_t*)(p.ws + OFF_HID) + (size_t)row * FF + col) = o;
          }
        }
      }
  }
};

template <int MODE>
DEV void gemm_run(const Params& p, int l, const bf16_t* A, const bf16_t* BT, int K, int N, char* lds) {
  pg8::Gemm g{A, BT, MT, N, K};
  pg8::StaticOrder S; S.init(MT, N, (int)gridDim.x, (int)blockIdx.x);
  EpiMK<MODE> E{&p, l};
  pg8::gemm_phase<EpiMK<MODE>, pg8::StaticOrder, true, true>((PG8_LAS unsigned char*)lds, g, S, E);
  if (MODE == 1 && l < 3 && (int)gridDim.x > 160 && (int)blockIdx.x >= 160) {
    if (K == D) layer_tiles(p, l + 1, 0, 640, (int)blockIdx.x - 160, (int)gridDim.x - 160, lds);
    else layer_tiles(p, l + 1, 640, NT_LAYER, (int)blockIdx.x - 160, (int)gridDim.x - 160, lds);
  }
}

constexpr int TOKT = 20;
DEV void prep_item(const Params& p, int l, int tile, char* lds) {
  const int t = tid(), r0 = tile * TOKT, c = t;
  bf16_t* sA = (bf16_t*)lds;
  float* swl = (float*)(lds + 32 * 136 * 2);
  float* sal = swl + TOKT * 256;
  const bf16_t* P = (const bf16_t*)(p.ws + OFF_P);
  bf16_t* PREP = (bf16_t*)(p.ws + OFF_PREP);
  bf16_t* BON = (bf16_t*)(p.ws + OFF_BONUS);
  for (int dir = 0; dir < 2; ++dir) {
    __syncthreads();
#pragma unroll
    for (int i = 0; i < TOKT / 2; ++i) {
      const int e = t + 256 * i, tk = e >> 7, j = e & 127, which = j >> 6, jj = j & 63;
      const int row = r0 + tk, prow = dir ? row + 1 : row - 1;
      const int tis = row < NCTX ? (row & 255) : ((row - NCTX) & 1023), Tm1 = row < NCTX ? 255 : 1023;
      const bool pv = dir ? (tis < Tm1) : (tis > 0);
      const int col = (dir ? C_WHB : C_WHF) + which * 64 + jj;
      const float cur = bf2f(P[(size_t)row * DIN + col]);
      const float prev = bf2f(P[(size_t)(pv ? prow : row) * DIN + col]) * (pv ? 1.f : 0.f);
      const float mu = p.in[I_MULORA][((l * 2 + dir) * 2 + which) * 64 + jj];
      const float val = cur + (prev - cur) * mu;
      sA[tk * 136 + j] = f2bf((which == 0) ? tanhf_(val) : val);
    }
    __syncthreads();
    {
      const int lane = t & 63, w = t >> 6, q = lane & 31, hh = lane >> 5;
#pragma unroll
      for (int mat = 0; mat < 2; ++mat) {
        bf16x8 af[4];
#pragma unroll
        for (int s = 0; s < 4; ++s) af[s] = *(const bf16x8*)(sA + q * 136 + mat * 64 + 16 * s + 8 * hh);
        const bf16_t* WT = (const bf16_t*)(p.ws + (mat ? OFF_A2T : OFF_W2T)) + (size_t)(l * 2 + dir) * 256 * 64;
        float* dst = mat ? sal : swl;
#pragma unroll
        for (int nt = 0; nt < 2; ++nt) {
          const int n = w * 64 + nt * 32 + q;
          f32x16 acc;
#pragma unroll
          for (int r = 0; r < 16; ++r) acc[r] = 0.f;
#pragma unroll
          for (int s = 0; s < 4; ++s) acc = MFMA32(af[s], *(const bf16x8*)(WT + (size_t)n * 64 + 16 * s + 8 * hh), acc);
#pragma unroll
          for (int r = 0; r < 8; ++r) dst[((r & 3) + 8 * (r >> 2) + 4 * hh) * 256 + n] = acc[r];
          if (hh == 0) {
#pragma unroll
            for (int r = 8; r < 12; ++r) dst[((r & 3) + 16) * 256 + n] = acc[r];
          }
        }
      }
    }
    __syncthreads();
    const float w0v = p.in[I_W0][(l * 2 + dir) * 256 + c], a0v = p.in[I_A0][(l * 2 + dir) * 256 + c];
    const float kkv = p.in[I_KK][l * 256 + c], kav = p.in[I_KA][l * 256 + c], rkv = p.in[I_RK][l * 256 + c];
    const float mur = p.in[I_MURKV][((l * 2 + dir) * 3 + 0) * 256 + c], muk = p.in[I_MURKV][((l * 2 + dir) * 3 + 1) * 256 + c],
                muv = p.in[I_MURKV][((l * 2 + dir) * 3 + 2) * 256 + c];
    bf16_t* pr = PREP + (size_t)dir * 6 * ARRF;
    for (int tb = 0; tb < TOKT; tb += 5) {
      float rc[5], kc[5], vc[5], rp[5], kq[5], vp[5], wlv[5], alv[5];
#pragma unroll
      for (int u = 0; u < 5; ++u) {
        const int tk = tb + u, row = r0 + tk, prow = dir ? row + 1 : row - 1;
        const int tis = row < NCTX ? (row & 255) : ((row - NCTX) & 1023), Tm1 = row < NCTX ? 255 : 1023;
        const bool pv = dir ? (tis < Tm1) : (tis > 0);
        const float pm = pv ? 1.f : 0.f;
        const bf16_t* pc = P + (size_t)row * DIN + c;
        const bf16_t* pp = P + (size_t)(pv ? prow : row) * DIN + c;
        rc[u] = bf2f(pc[C_R]); kc[u] = bf2f(pc[C_K]); vc[u] = bf2f(pc[C_V]);
        rp[u] = bf2f(pp[C_R]) * pm; kq[u] = bf2f(pp[C_K]) * pm; vp[u] = bf2f(pp[C_V]) * pm;
        wlv[u] = swl[tk * 256 + c]; alv[u] = sal[tk * 256 + c];
      }
      float bprev[5];
#pragma unroll
      for (int u = 0; u < 5; ++u) bprev[u] = (dir == 1) ? bf2f(BON[(size_t)(r0 + tb + u) * 256 + c]) : 0.f;
#pragma unroll
      for (int u = 0; u < 5; ++u) {
        const int row = r0 + tb + u;
        const float rs = rc[u] + (rp[u] - rc[u]) * mur, ks = kc[u] + (kq[u] - kc[u]) * muk, vs = vc[u] + (vp[u] - vc[u]) * muv;
        const float wl = w0v + wlv[u], al = a0v + alv[u];
        const float wv = __expf(-0.6065306597126334f * sigmoidf_(wl));
        const float av = sigmoidf_(al);
        const float kkr = ks * kkv;
        const float n2 = wave_sum(kkr * kkr);
        const float kk = kkr * rcpf_(fmaxf(__builtin_amdgcn_sqrtf(n2), 1e-12f));
        const float kp = ks * (1.0f + (av - 1.0f) * kav);
        const float bs = wave_sum(rs * kp * rkv);
        const float bon = bs * vs;
        const size_t idx = (size_t)row * 256 + c;
        pr[idx] = f2bf(rs); pr[ARRF + idx] = f2bf(wv); pr[2 * ARRF + idx] = f2bf(kp); pr[3 * ARRF + idx] = f2bf(vs); pr[4 * ARRF + idx] = f2bf(kk); pr[5 * ARRF + idx] = f2bf(kk * av);
        BON[idx] = f2bf(bprev[u] + bon);
      }
    }
  }
  __syncthreads();
}

DEV void rope_item(const Params& p, int item) {
  bf16_t* P = (bf16_t*)(p.ws + OFF_P);
  const int t = tid();
  for (int e = t; e < 8 * 192; e += 256) {
    const int tk = e / 192, r = e % 192, hs = r >> 5, pi = r & 31;
    const int lt = item * 8 + tk;
    const int tt = lt & 1023;
    const int grow = tt >> 6, gcol = tt & 63;
    const int fi = pi & 15;
    const float pos = (pi < 16) ? (float)grow : (float)gcol;
    const float inv = exp2f(-(float)fi * (13.287712379549449f / 16.0f));
    const float ang = pos * inv;
    const float cs = __cosf(ang), sn = __sinf(ang);
    const int d1 = (pi < 16) ? fi : 32 + fi;
    bf16_t* base = P + (size_t)(NCTX + lt) * DIN + C_SQ + hs * 64;
    const float x1 = bf2f(base[d1]), x2 = bf2f(base[d1 + 16]);
    base[d1] = f2bf(x1 * cs - x2 * sn);
    base[d1 + 16] = f2bf(x2 * cs + x1 * sn);
  }
}

constexpr int SC_BUF = 20480 + 4096;
typedef float f2 __attribute__((ext_vector_type(2)));
DEV float dot4(const float4& a, const float4& b) { return a.x * b.x + a.y * b.y + a.z * b.z + a.w * b.w; }
DEV float red8(float x) { x += dppf<0xB1>(x); x += dppf<0x4E>(x); x += dppf<0x141>(x); return x; }
DEV float dot8(const f2 (&S)[4], const float4& a, const float4& b) {
  f2 acc = S[0] * (f2){a.x, a.y};
  acc += S[1] * (f2){a.z, a.w}; acc += S[2] * (f2){b.x, b.y}; acc += S[3] * (f2){b.z, b.w};
  return acc.x + acc.y;
}

template <int NCH>
DEV void rwkv_scan(const Params& p, int l, int seq, int head, int dir, int rsel, char* lds) {
  const int t = tid(), rr = t >> 3, g = t & 7, rl = t >> 4, ks = t & 15;
  const int T = seq < 32 ? 256 : 1024;
  const int row0 = seq < 32 ? seq * 256 : NCTX + (seq - 32) * 1024;
  const bf16_t* prep = (const bf16_t*)(p.ws + OFF_PREP) + (size_t)dir * 6 * ARRF;
  float* ydir = (float*)(p.ws + OFF_YDIR) + (size_t)dir * ARRF;
  const int vbase = (NCH == 2) ? 0 : rsel * 32;
  f2 S[NCH][4];
#pragma unroll
  for (int c = 0; c < NCH; ++c)
#pragma unroll
    for (int j = 0; j < 4; ++j) S[c][j] = (f2){0.f, 0.f};
  if (seq >= 32) {
    const float* sp = p.in[I_SRW] + ((((size_t)(seq - 32) * 4 + l) * 2 + dir) * 4 + head) * 4096 + g * 8;
#pragma unroll
    for (int c = 0; c < NCH; ++c) {
      const float4 a = *(const float4*)(sp + (vbase + rr + 32 * c) * 64), b = *(const float4*)(sp + (vbase + rr + 32 * c) * 64 + 4);
      S[c][0] = (f2){a.x, a.y}; S[c][1] = (f2){a.z, a.w}; S[c][2] = (f2){b.x, b.y}; S[c][3] = (f2){b.z, b.w};
    }
  }
  const int nch = T >> 4;
  uint2 pre0, pre1, pre2, pre3, pre4, pvv;
#define RW_LOAD(cc) do { const int s_ = (cc) * 16 + rl; const int tok_ = dir ? (T - 1 - s_) : s_; \
    const size_t base_ = (size_t)(row0 + tok_) * 256 + head * 64; \
    pre0 = *(const uint2*)(prep + base_ + ks * 4); pre1 = *(const uint2*)(prep + ARRF + base_ + ks * 4); \
    pre2 = *(const uint2*)(prep + 2 * ARRF + base_ + ks * 4); pre3 = *(const uint2*)(prep + 4 * ARRF + base_ + ks * 4); \
    pre4 = *(const uint2*)(prep + 5 * ARRF + base_ + ks * 4); \
    if (NCH == 2) pvv = *(const uint2*)(prep + 3 * ARRF + base_ + ks * 4); \
    else pvv.x = *(const unsigned*)(prep + 3 * ARRF + base_ + vbase + ks * 2); } while (0)
#define RW_WRITE(bb) do { float4* sb_ = (float4*)(lds + (bb) * SC_BUF); float* vb_ = (float*)(lds + (bb) * SC_BUF + 20480); \
    sb_[(0 * 16 + rl) * 16 + ks] = bf4(pre0); sb_[(1 * 16 + rl) * 16 + ks] = bf4(pre1); sb_[(2 * 16 + rl) * 16 + ks] = bf4(pre2); \
    sb_[(3 * 16 + rl) * 16 + ks] = bf4(pre3); sb_[(4 * 16 + rl) * 16 + ks] = bf4(pre4); \
    if (NCH == 2) *(float4*)(vb_ + rl * 64 + ks * 4) = bf4(pvv); else *(f2*)(vb_ + rl * 64 + ks * 2) = (f2){bflo(pvv.x), bfhi(pvv.x)}; } while (0)
  __syncthreads();
  RW_LOAD(0); RW_WRITE(0);
  __syncthreads();
  for (int c = 0; c < nch; ++c) {
    if (c + 1 < nch) RW_LOAD(c + 1);
    const float4* sbuf = (const float4*)(lds + (c & 1) * SC_BUF);
    const float* vbuf = (const float*)(lds + (c & 1) * SC_BUF + 20480);
    float ym[NCH][2];
#pragma unroll
    for (int cc = 0; cc < NCH; ++cc) { ym[cc][0] = 0.f; ym[cc][1] = 0.f; }
#pragma unroll
    for (int i = 0; i < 16; ++i) {
      const float4 ra = sbuf[(0 * 16 + i) * 16 + g * 2], rb = sbuf[(0 * 16 + i) * 16 + g * 2 + 1];
      const float4 wa = sbuf[(1 * 16 + i) * 16 + g * 2], wb = sbuf[(1 * 16 + i) * 16 + g * 2 + 1];
      const float4 ka_ = sbuf[(2 * 16 + i) * 16 + g * 2], kb_ = sbuf[(2 * 16 + i) * 16 + g * 2 + 1];
      const float4 na = sbuf[(3 * 16 + i) * 16 + g * 2], nb = sbuf[(3 * 16 + i) * 16 + g * 2 + 1];
      const float4 aa = sbuf[(4 * 16 + i) * 16 + g * 2], ab = sbuf[(4 * 16 + i) * 16 + g * 2 + 1];
      const f2 w2[4] = {(f2){wa.x, wa.y}, (f2){wa.z, wa.w}, (f2){wb.x, wb.y}, (f2){wb.z, wb.w}};
      const f2 k2[4] = {(f2){ka_.x, ka_.y}, (f2){ka_.z, ka_.w}, (f2){kb_.x, kb_.y}, (f2){kb_.z, kb_.w}};
      const f2 a2[4] = {(f2){aa.x, aa.y}, (f2){aa.z, aa.w}, (f2){ab.x, ab.y}, (f2){ab.z, ab.w}};
#pragma unroll
      for (int cc = 0; cc < NCH; ++cc) {
        const float v = vbuf[i * 64 + rr + 32 * cc];
        const float sa = -red8(dot8(S[cc], na, nb));
#pragma unroll
        for (int j = 0; j < 4; ++j) S[cc][j] = S[cc][j] * w2[j] + a2[j] * sa + k2[j] * v;
        const float y = red8(dot8(S[cc], ra, rb));
        ym[cc][i >> 3] = (g == (i & 7)) ? y : ym[cc][i >> 3];
      }
    }
#pragma unroll
    for (int hh = 0; hh < 2; ++hh) {
      const int s = c * 16 + hh * 8 + g; const int tok = dir ? (T - 1 - s) : s;
      float* yo = ydir + (size_t)(row0 + tok) * 256 + head * 64 + vbase + rr;
#pragma unroll
      for (int cc = 0; cc < NCH; ++cc) yo[32 * cc] = ym[cc][hh];
    }
    if (c + 1 < nch) RW_WRITE((c + 1) & 1);
    __syncthreads();
  }
#undef RW_LOAD
#undef RW_WRITE
  if (seq < 32) {
    float* sp = p.out + O_RW + ((((size_t)seq * 4 + l) * 2 + dir) * 4 + head) * 4096 + g * 8;
#pragma unroll
    for (int c = 0; c < NCH; ++c) {
      *(float4*)(sp + (vbase + rr + 32 * c) * 64) = make_float4(S[c][0].x, S[c][0].y, S[c][1].x, S[c][1].y);
      *(float4*)(sp + (vbase + rr + 32 * c) * 64 + 4) = make_float4(S[c][2].x, S[c][2].y, S[c][3].x, S[c][3].y);
    }
  }
}

template <int NCH>
DEV void hgrn_scan(const Params& p, int l, int seq, int head, int dir, int rsel, char* lds) {
  const int t = tid(), rr = t >> 3, g = t & 7, rl = t >> 4, ks = t & 15;
  const int T = seq < 32 ? 256 : 1024;
  const int row0 = seq < 32 ? seq * 256 : NCTX + (seq - 32) * 1024;
  const bf16_t* P = (const bf16_t*)(p.ws + OFF_P);
  float* odir = (float*)(p.ws + OFF_HDIR) + (size_t)dir * ARRF;
  const float4 lb4 = *(const float4*)((const float*)(p.ws + OFF_HGLB) + (l * 2 + dir) * 256 + head * 64 + ks * 4);
  const int vbase = (NCH == 2) ? 0 : rsel * 32;
  f2 S[NCH][4];
#pragma unroll
  for (int c = 0; c < NCH; ++c)
#pragma unroll
    for (int j = 0; j < 4; ++j) S[c][j] = (f2){0.f, 0.f};
  if (seq >= 32) {
    const float* sp = p.in[I_SHG] + ((((size_t)(seq - 32) * 4 + l) * 2 + dir) * 4 + head) * 4096;
#pragma unroll
    for (int c = 0; c < NCH; ++c)
#pragma unroll
      for (int j = 0; j < 4; ++j) {
        const int v = vbase + rr + 32 * c;
        S[c][j] = (f2){sp[(g * 8 + 2 * j) * 64 + v], sp[(g * 8 + 2 * j + 1) * 64 + v]};
      }
  }
  const int nch = T >> 4;
  const int fcol = (dir ? C_HFB : C_HFF) + head * 64;
  uint2 pq, pf, pv2;
#define HG_LOAD(cc) do { const int s_ = (cc) * 16 + rl; const int tok_ = dir ? (T - 1 - s_) : s_; \
    const bf16_t* pr_ = P + (size_t)(row0 + tok_) * DIN; \
    pq = *(const uint2*)(pr_ + C_HQ + head * 64 + ks * 4); pf = *(const uint2*)(pr_ + fcol + ks * 4); \
    if (NCH == 2) pv2 = *(const uint2*)(pr_ + C_HI + head * 64 + ks * 4); else pv2.x = *(const unsigned*)(pr_ + C_HI + head * 64 + vbase + ks * 2); } while (0)
#define HG_WRITE(bb) do { float4* sb_ = (float4*)(lds + (bb) * SC_BUF); float* vb_ = (float*)(lds + (bb) * SC_BUF + 20480); \
    float4 q_, f_, k_; float a_, sg_; \
    a_ = bflo(pq.x); q_.x = a_ * sigmoidf_(a_); a_ = bfhi(pq.x); q_.y = a_ * sigmoidf_(a_); \
    a_ = bflo(pq.y); q_.z = a_ * sigmoidf_(a_); a_ = bfhi(pq.y); q_.w = a_ * sigmoidf_(a_); \
    sg_ = sigmoidf_(bflo(pf.x)); f_.x = lb4.x + (1.f - lb4.x) * sg_; k_.x = (1.f - lb4.x) * (1.f - sg_); \
    sg_ = sigmoidf_(bfhi(pf.x)); f_.y = lb4.y + (1.f - lb4.y) * sg_; k_.y = (1.f - lb4.y) * (1.f - sg_); \
    sg_ = sigmoidf_(bflo(pf.y)); f_.z = lb4.z + (1.f - lb4.z) * sg_; k_.z = (1.f - lb4.z) * (1.f - sg_); \
    sg_ = sigmoidf_(bfhi(pf.y)); f_.w = lb4.w + (1.f - lb4.w) * sg_; k_.w = (1.f - lb4.w) * (1.f - sg_); \
    sb_[(0 * 16 + rl) * 16 + ks] = q_; sb_[(1 * 16 + rl) * 16 + ks] = f_; sb_[(2 * 16 + rl) * 16 + ks] = k_; \
    if (NCH == 2) *(float4*)(vb_ + rl * 64 + ks * 4) = make_float4(bflo(pv2.x), bfhi(pv2.x), bflo(pv2.y), bfhi(pv2.y)); \
    else *(f2*)(vb_ + rl * 64 + ks * 2) = (f2){bflo(pv2.x), bfhi(pv2.x)}; } while (0)
  __syncthreads();
  HG_LOAD(0); HG_WRITE(0);
  __syncthreads();
  for (int c = 0; c < nch; ++c) {
    if (c + 1 < nch) HG_LOAD(c + 1);
    const float4* sbuf = (const float4*)(lds + (c & 1) * SC_BUF);
    const float* vbuf = (const float*)(lds + (c & 1) * SC_BUF + 20480);
    float ym[NCH][2];
#pragma unroll
    for (int cc = 0; cc < NCH; ++cc) { ym[cc][0] = 0.f; ym[cc][1] = 0.f; }
#pragma unroll
    for (int i = 0; i < 16; ++i) {
      const float4 qa = sbuf[(0 * 16 + i) * 16 + g * 2], qb = sbuf[(0 * 16 + i) * 16 + g * 2 + 1];
      const float4 fa = sbuf[(1 * 16 + i) * 16 + g * 2], fb = sbuf[(1 * 16 + i) * 16 + g * 2 + 1];
      const float4 ka_ = sbuf[(2 * 16 + i) * 16 + g * 2], kb_ = sbuf[(2 * 16 + i) * 16 + g * 2 + 1];
      const f2 f2v[4] = {(f2){fa.x, fa.y}, (f2){fa.z, fa.w}, (f2){fb.x, fb.y}, (f2){fb.z, fb.w}};
      const f2 k2[4] = {(f2){ka_.x, ka_.y}, (f2){ka_.z, ka_.w}, (f2){kb_.x, kb_.y}, (f2){kb_.z, kb_.w}};
#pragma unroll
      for (int cc = 0; cc < NCH; ++cc) {
        const float v = vbuf[i * 64 + rr + 32 * cc];
#pragma unroll
        for (int j = 0; j < 4; ++j) S[cc][j] = S[cc][j] * f2v[j] + k2[j] * v;
        const float y = red8(dot8(S[cc], qa, qb));
        ym[cc][i >> 3] = (g == (i & 7)) ? y : ym[cc][i >> 3];
      }
    }
#pragma unroll
    for (int hh = 0; hh < 2; ++hh) {
      const int s = c * 16 + hh * 8 + g; const int tok = dir ? (T - 1 - s) : s;
      float* yo = odir + (size_t)(row0 + tok) * 256 + head * 64 + vbase + rr;
#pragma unroll
      for (int cc = 0; cc < NCH; ++cc) yo[32 * cc] = ym[cc][hh];
    }
    if (c + 1 < nch) HG_WRITE((c + 1) & 1);
    __syncthreads();
  }
#undef HG_LOAD
#undef HG_WRITE
  if (seq < 32) {
    float* sp = p.out + O_HG + ((((size_t)seq * 4 + l) * 2 + dir) * 4 + head) * 4096;
#pragma unroll
    for (int c = 0; c < NCH; ++c)
#pragma unroll
      for (int j = 0; j < 4; ++j) {
        const int v = vbase + rr + 32 * c;
        sp[(g * 8 + 2 * j) * 64 + v] = S[c][j].x; sp[(g * 8 + 2 * j + 1) * 64 + v] = S[c][j].y;
      }
  }
}

DEV void rwkv_scan16(const Params& p, int l, int seq, int head, int dir, int rg, char* lds) {
  const int t = tid(), rl = t >> 4, ks = t & 15;
  const int T = seq < 32 ? 256 : 1024;
  const int row0 = seq < 32 ? seq * 256 : NCTX + (seq - 32) * 1024;
  const bf16_t* prep = (const bf16_t*)(p.ws + OFF_PREP) + (size_t)dir * 6 * ARRF;
  float* ydir = (float*)(p.ws + OFF_YDIR) + (size_t)dir * ARRF;
  const int v0 = rg * 16 + rl;
  float4 S0 = make_float4(0.f, 0.f, 0.f, 0.f);
  if (seq >= 32) S0 = *(const float4*)(p.in[I_SRW] + ((((size_t)(seq - 32) * 4 + l) * 2 + dir) * 4 + head) * 4096 + ks * 4 + v0 * 64);
  const int nch = T >> 4;
  uint2 pre0, pre1, pre2, pre3, pre4; bf16_t pv0;
#define RW_LOAD(cc) do { const int s_ = (cc) * 16 + rl; const int tok_ = dir ? (T - 1 - s_) : s_; \
    const size_t base_ = (size_t)(row0 + tok_) * 256 + head * 64; \
    pre0 = *(const uint2*)(prep + base_ + ks * 4); pre1 = *(const uint2*)(prep + ARRF + base_ + ks * 4); \
    pre2 = *(const uint2*)(prep + 2 * ARRF + base_ + ks * 4); pre3 = *(const uint2*)(prep + 4 * ARRF + base_ + ks * 4); \
    pre4 = *(const uint2*)(prep + 5 * ARRF + base_ + ks * 4); pv0 = prep[3 * ARRF + base_ + rg * 16 + ks]; } while (0)
#define RW_WRITE(bb) do { float4* sb_ = (float4*)(lds + (bb) * SC_BUF); float* vb_ = (float*)(lds + (bb) * SC_BUF + 20480); \
    sb_[(0 * 16 + rl) * 16 + ks] = bf4(pre0); sb_[(1 * 16 + rl) * 16 + ks] = bf4(pre1); sb_[(2 * 16 + rl) * 16 + ks] = bf4(pre2); \
    sb_[(3 * 16 + rl) * 16 + ks] = bf4(pre3); sb_[(4 * 16 + rl) * 16 + ks] = bf4(pre4); vb_[rl * 16 + ks] = bf2f(pv0); } while (0)
  __syncthreads();
  RW_LOAD(0); RW_WRITE(0);
  __syncthreads();
  for (int c = 0; c < nch; ++c) {
    if (c + 1 < nch) RW_LOAD(c + 1);
    const float4* sbuf = (const float4*)(lds + (c & 1) * SC_BUF);
    const float* vbuf = (const float*)(lds + (c & 1) * SC_BUF + 20480);
    float ym0 = 0.f;
#pragma unroll
    for (int i = 0; i < 16; ++i) {
      const float4 r = sbuf[(0 * 16 + i) * 16 + ks], wv = sbuf[(1 * 16 + i) * 16 + ks], kv = sbuf[(2 * 16 + i) * 16 + ks],
                   kk = sbuf[(3 * 16 + i) * 16 + ks], ka = sbuf[(4 * 16 + i) * 16 + ks];
      const float va = vbuf[i * 16 + rl];
      const float sa0 = -row16_sum(dot4(S0, kk));
      S0.x = S0.x * wv.x + sa0 * ka.x + va * kv.x; S0.y = S0.y * wv.y + sa0 * ka.y + va * kv.y;
      S0.z = S0.z * wv.z + sa0 * ka.z + va * kv.z; S0.w = S0.w * wv.w + sa0 * ka.w + va * kv.w;
      const float y0 = row16_sum(dot4(S0, r));
      ym0 = (ks == i) ? y0 : ym0;
    }
    {
      const int s = c * 16 + ks; const int tok = dir ? (T - 1 - s) : s;
      ydir[(size_t)(row0 + tok) * 256 + head * 64 + v0] = ym0;
    }
    if (c + 1 < nch) RW_WRITE((c + 1) & 1);
    __syncthreads();
  }
#undef RW_LOAD
#undef RW_WRITE
  if (seq < 32) *(float4*)(p.out + O_RW + ((((size_t)seq * 4 + l) * 2 + dir) * 4 + head) * 4096 + ks * 4 + v0 * 64) = S0;
}

DEV void hgrn_scan16(const Params& p, int l, int seq, int head, int dir, int rg, char* lds) {
  const int t = tid(), rl = t >> 4, ks = t & 15;
  const int T = seq < 32 ? 256 : 1024;
  const int row0 = seq < 32 ? seq * 256 : NCTX + (seq - 32) * 1024;
  const bf16_t* P = (const bf16_t*)(p.ws + OFF_P);
  float* odir = (float*)(p.ws + OFF_HDIR) + (size_t)dir * ARRF;
  const float4 lb4 = *(const float4*)((const float*)(p.ws + OFF_HGLB) + (l * 2 + dir) * 256 + head * 64 + ks * 4);
  const int v0 = rg * 16 + rl;
  float4 S0 = make_float4(0.f, 0.f, 0.f, 0.f);
  if (seq >= 32) {
    const float* sp = p.in[I_SHG] + ((((size_t)(seq - 32) * 4 + l) * 2 + dir) * 4 + head) * 4096;
    S0.x = sp[(ks * 4 + 0) * 64 + v0]; S0.y = sp[(ks * 4 + 1) * 64 + v0]; S0.z = sp[(ks * 4 + 2) * 64 + v0]; S0.w = sp[(ks * 4 + 3) * 64 + v0];
  }
  const int nch = T >> 4;
  const int fcol = (dir ? C_HFB : C_HFF) + head * 64;
  uint2 pq, pf; bf16_t pva;
#define HG_LOAD(cc) do { const int s_ = (cc) * 16 + rl; const int tok_ = dir ? (T - 1 - s_) : s_; \
    const bf16_t* pr_ = P + (size_t)(row0 + tok_) * DIN; \
    pq = *(const uint2*)(pr_ + C_HQ + head * 64 + ks * 4); pf = *(const uint2*)(pr_ + fcol + ks * 4); \
    pva = pr_[C_HI + head * 64 + rg * 16 + ks]; } while (0)
#define HG_WRITE(bb) do { float4* sb_ = (float4*)(lds + (bb) * SC_BUF); float* vb_ = (float*)(lds + (bb) * SC_BUF + 20480); \
    float4 q_, f_, k_; float a_, sg_; \
    a_ = bflo(pq.x); q_.x = a_ * sigmoidf_(a_); a_ = bfhi(pq.x); q_.y = a_ * sigmoidf_(a_); \
    a_ = bflo(pq.y); q_.z = a_ * sigmoidf_(a_); a_ = bfhi(pq.y); q_.w = a_ * sigmoidf_(a_); \
    sg_ = sigmoidf_(bflo(pf.x)); f_.x = lb4.x + (1.f - lb4.x) * sg_; k_.x = (1.f - lb4.x) * (1.f - sg_); \
    sg_ = sigmoidf_(bfhi(pf.x)); f_.y = lb4.y + (1.f - lb4.y) * sg_; k_.y = (1.f - lb4.y) * (1.f - sg_); \
    sg_ = sigmoidf_(bflo(pf.y)); f_.z = lb4.z + (1.f - lb4.z) * sg_; k_.z = (1.f - lb4.z) * (1.f - sg_); \
    sg_ = sigmoidf_(bfhi(pf.y)); f_.w = lb4.w + (1.f - lb4.w) * sg_; k_.w = (1.f - lb4.w) * (1.f - sg_); \
    sb_[(0 * 16 + rl) * 16 + ks] = q_; sb_[(1 * 16 + rl) * 16 + ks] = f_; sb_[(2 * 16 + rl) * 16 + ks] = k_; \
    vb_[rl * 16 + ks] = bf2f(pva); } while (0)
  __syncthreads();
  HG_LOAD(0); HG_WRITE(0);
  __syncthreads();
  for (int c = 0; c < nch; ++c) {
    if (c + 1 < nch) HG_LOAD(c + 1);
    const float4* sbuf = (const float4*)(lds + (c & 1) * SC_BUF);
    const float* vbuf = (const float*)(lds + (c & 1) * SC_BUF + 20480);
    float ym0 = 0.f;
#pragma unroll
    for (int i = 0; i < 16; ++i) {
      const float4 q = sbuf[(0 * 16 + i) * 16 + ks], f = sbuf[(1 * 16 + i) * 16 + ks], k = sbuf[(2 * 16 + i) * 16 + ks];
      const float va = vbuf[i * 16 + rl];
      S0.x = S0.x * f.x + k.x * va; S0.y = S0.y * f.y + k.y * va; S0.z = S0.z * f.z + k.z * va; S0.w = S0.w * f.w + k.w * va;
      const float y0 = row16_sum(dot4(S0, q));
      ym0 = (ks == i) ? y0 : ym0;
    }
    {
      const int s = c * 16 + ks; const int tok = dir ? (T - 1 - s) : s;
      odir[(size_t)(row0 + tok) * 256 + head * 64 + v0] = ym0;
    }
    if (c + 1 < nch) HG_WRITE((c + 1) & 1);
    __syncthreads();
  }
#undef HG_LOAD
#undef HG_WRITE
  if (seq < 32) {
    float* sp = p.out + O_HG + ((((size_t)seq * 4 + l) * 2 + dir) * 4 + head) * 4096;
    sp[(ks * 4 + 0) * 64 + v0] = S0.x; sp[(ks * 4 + 1) * 64 + v0] = S0.y; sp[(ks * 4 + 2) * 64 + v0] = S0.z; sp[(ks * 4 + 3) * 64 + v0] = S0.w;
  }
}

template <int MODE>
DEV void attn_item(const Params& p, int l, int item, char* lds) {
  const int t = tid(), lane = t & 63, w = t >> 6, q = lane & 31, hh = lane >> 5;
  const bf16_t* P = (const bf16_t*)(p.ws + OFF_P);
  bf16_t* Y = (bf16_t*)(p.ws + OFF_YMIX);
  char* sK = lds;
  char* sV = lds + 8192;
  float* sBias = (float*)(lds + 8192 + 8704);
  int head, qrow, qcol, kcol, vcol, ocol, nloc, nt, rowbaseP;
  int qr = 0, qc = 0, rlo = 0, qpos = 0, lo = 0, rsq = 0, wsq = 0;
  float sink = 0.f;
  const float* cache = nullptr; int cH = 1, cHead = 0;
  if (MODE == 0 || MODE == 1) {
    const int b = item >> 3; head = (item >> 1) & 3; const int half = item & 1;
    rowbaseP = b * 256; qrow = rowbaseP + half * 128 + w * 32 + q; nloc = 4; nt = 4;
  } else {
    const int b = item >> 5; head = (item >> 3) & 3; const int sub = item & 7;
    rowbaseP = NCTX + b * 1024;
    if (MODE == 2) {
      qr = 2 * sub + (w >> 1); qc = (w & 1) * 32 + q; qrow = rowbaseP + qr * 64 + qc;
      rlo = clampi(2 * sub - 4, 0, 8); const int rhi = clampi(2 * sub - 3, 0, 8) + 7; nloc = rhi - rlo + 1; nt = nloc + 4;
      rsq = clampi(qr - 4, 0, 8); wsq = clampi(qc - 8, 0, 48);
      cache = p.in[I_CNAT] + (size_t)((b * 4 + l) * 2) * 256 * 256; cH = 4; cHead = head;
      for (int i = t; i < 465; i += 256) sBias[i] = p.in[I_RPB][(size_t)(l * 4 + head) * 465 + i];
    } else {
      qpos = sub * 128 + w * 32 + q; qrow = rowbaseP + qpos;
      lo = (sub - 1) * 128;
      nloc = 6; nt = nloc + 4;
      cache = p.in[I_CSWA] + (size_t)((b * 4 + l) * 2) * 256 * 128; cH = 2; cHead = head >> 1;
    }
  }
  if (MODE == 0 || MODE == 2) { qcol = C_NQ + head * 64; kcol = C_NK + head * 64; vcol = C_NV + head * 64; ocol = 256 + head * 64; }
  else { qcol = C_SQ + head * 64; kcol = C_SK + (head >> 1) * 64; vcol = C_SV + (head >> 1) * 64; ocol = 768 + head * 64; sink = p.in[I_SINK][l * 4 + head]; }

  bf16x8 bq[4];
#pragma unroll
  for (int s = 0; s < 4; ++s) bq[s] = *(const bf16x8*)(P + (size_t)qrow * DIN + qcol + 16 * s + 8 * hh);
  f32x16 oacc[2];
#pragma unroll
  for (int r = 0; r < 16; ++r) { oacc[0][r] = 0.f; oacc[1][r] = 0.f; }
  float m_run = -1e30f, l_run = 0.f;
  const int key = t >> 2, dq = t & 3;
  const int kswz = (key >> 1) & 7;
  float4 raw[8];
#define ATT_ISSUE(jj) do { const int j_ = (jj); \
    if (j_ < nloc) { \
      int krow_; \
      if (MODE == 0 || MODE == 1) krow_ = rowbaseP + j_ * 64 + key; \
      else if (MODE == 2) krow_ = rowbaseP + (rlo + j_) * 64 + key; \
      else krow_ = rowbaseP + clampi(lo + j_ * 64 + key, 0, 1023); \
      const bf16_t* kp_ = P + (size_t)krow_ * DIN + kcol + dq * 16; \
      const bf16_t* vp_ = P + (size_t)krow_ * DIN + vcol + dq * 16; \
      raw[0] = *(const float4*)kp_; raw[1] = *(const float4*)(kp_ + 8); raw[2] = *(const float4*)vp_; raw[3] = *(const float4*)(vp_ + 8); \
    } else { \
      const int ct_ = (j_ - nloc) * 64 + key; \
      const float* kp_ = cache + ((size_t)ct_ * cH + cHead) * 64 + dq * 16; \
      const float* vp_ = kp_ + (size_t)256 * cH * 64; \
      raw[0] = *(const float4*)kp_; raw[1] = *(const float4*)(kp_ + 4); raw[2] = *(const float4*)(kp_ + 8); raw[3] = *(const float4*)(kp_ + 12); \
      raw[4] = *(const float4*)vp_; raw[5] = *(const float4*)(vp_ + 4); raw[6] = *(const float4*)(vp_ + 8); raw[7] = *(const float4*)(vp_ + 12); \
    } } while (0)
  ATT_ISSUE(0);
  for (int j = 0; j < nt; ++j) {
    uint4 kr[2], vr[2];
    const bool isP = j < nloc;
    if (isP) {
      kr[0] = __builtin_bit_cast(uint4, raw[0]); kr[1] = __builtin_bit_cast(uint4, raw[1]);
      vr[0] = __builtin_bit_cast(uint4, raw[2]); vr[1] = __builtin_bit_cast(uint4, raw[3]);
    } else {
      kr[0].x = pk2(raw[0].x, raw[0].y); kr[0].y = pk2(raw[0].z, raw[0].w); kr[0].z = pk2(raw[1].x, raw[1].y); kr[0].w = pk2(raw[1].z, raw[1].w);
      kr[1].x = pk2(raw[2].x, raw[2].y); kr[1].y = pk2(raw[2].z, raw[2].w); kr[1].z = pk2(raw[3].x, raw[3].y); kr[1].w = pk2(raw[3].z, raw[3].w);
      vr[0].x = pk2(raw[4].x, raw[4].y); vr[0].y = pk2(raw[4].z, raw[4].w); vr[0].z = pk2(raw[5].x, raw[5].y); vr[0].w = pk2(raw[5].z, raw[5].w);
      vr[1].x = pk2(raw[6].x, raw[6].y); vr[1].y = pk2(raw[6].z, raw[6].w); vr[1].z = pk2(raw[7].x, raw[7].y); vr[1].w = pk2(raw[7].z, raw[7].w);
    }
    if (j + 1 < nt) ATT_ISSUE(j + 1);
    __syncthreads();
    *(uint4*)(sK + key * 128 + (((dq * 2 + 0) ^ kswz) << 4)) = kr[0];
    *(uint4*)(sK + key * 128 + (((dq * 2 + 1) ^ kswz) << 4)) = kr[1];
    {
      bf16_t* vt = (bf16_t*)sV;
      const unsigned vv[8] = {vr[0].x, vr[0].y, vr[0].z, vr[0].w, vr[1].x, vr[1].y, vr[1].z, vr[1].w};
#pragma unroll
      for (int e = 0; e < 8; ++e) {
        vt[(dq * 16 + 2 * e) * 68 + key] = (bf16_t)(vv[e] & 0xffffu);
        vt[(dq * 16 + 2 * e + 1) * 68 + key] = (bf16_t)(vv[e] >> 16);
      }
    }
    __syncthreads();
    f32x16 sacc[2];
#pragma unroll
    for (int r = 0; r < 16; ++r) { sacc[0][r] = 0.f; sacc[1][r] = 0.f; }
    const int qswz = (q >> 1) & 7;
#pragma unroll
    for (int s = 0; s < 4; ++s) {
      const int co = (((s * 2 + hh) ^ qswz) << 4);
      const bf16x8 a0 = *(const bf16x8*)(sK + q * 128 + co);
      const bf16x8 a1 = *(const bf16x8*)(sK + (32 + q) * 128 + co);
      sacc[0] = MFMA32(a0, bq[s], sacc[0]);
      sacc[1] = MFMA32(a1, bq[s], sacc[1]);
    }
    float mx = -1e30f;
#pragma unroll
    for (int sub = 0; sub < 2; ++sub)
#pragma unroll
      for (int r = 0; r < 16; ++r) {
        const int kidx = sub * 32 + (r & 3) + 8 * (r >> 2) + 4 * hh;
        float v = sacc[sub][r] * 0.125f;
        bool ok = true;
        if (MODE == 2 && isP) {
          const int kr_ = rlo + j, kc_ = kidx;
          ok = (kr_ >= rsq) && (kr_ < rsq + 8) && (kc_ >= wsq) && (kc_ < wsq + 16);
          const int bi = ok ? ((kr_ - qr + 7) * 31 + (kc_ - qc + 15)) : 0;
          v += sBias[bi];
        }
        if (MODE == 3 && isP) {
          const int kpos = lo + j * 64 + kidx, dlt = kpos - qpos;
          ok = (dlt <= 128) && (dlt >= -128) && (kpos >= 0) && (kpos < 1024);
        }
        v = ok ? v : -1e30f;
        sacc[sub][r] = v;
        mx = fmaxf(mx, v);
      }
    mx = fmaxf(mx, __shfl_xor(mx, 32));
    const float m_new = fmaxf(m_run, mx);
    const float alpha = __expf(m_run - m_new);
    float rsum = 0.f;
#pragma unroll
    for (int sub = 0; sub < 2; ++sub)
#pragma unroll
      for (int r = 0; r < 16; ++r) {
        const float v = sacc[sub][r];
        const float pv = (v > -1e29f) ? __expf(v - m_new) : 0.f;
        sacc[sub][r] = pv; rsum += pv;
      }
    rsum += __shfl_xor(rsum, 32);
    l_run = l_run * alpha + rsum; m_run = m_new;
#pragma unroll
    for (int r = 0; r < 16; ++r) { oacc[0][r] *= alpha; oacc[1][r] *= alpha; }
#pragma unroll
    for (int k4 = 0; k4 < 4; ++k4) {
      const int sub = k4 >> 1, s2 = k4 & 1;
      uint4 pbu;
      pbu.x = pk2(sacc[sub][8 * s2 + 0], sacc[sub][8 * s2 + 1]); pbu.y = pk2(sacc[sub][8 * s2 + 2], sacc[sub][8 * s2 + 3]);
      pbu.z = pk2(sacc[sub][8 * s2 + 4], sacc[sub][8 * s2 + 5]); pbu.w = pk2(sacc[sub][8 * s2 + 6], sacc[sub][8 * s2 + 7]);
      const bf16x8 pb = __builtin_bit_cast(bf16x8, pbu);
#pragma unroll
      for (int dt = 0; dt < 2; ++dt) {
        const char* vp = sV + (dt * 32 + q) * 136 + (16 * k4 + 4 * hh) * 2;
        const uint2 lo8 = *(const uint2*)vp, hi8 = *(const uint2*)(vp + 16);
        uint4 avu; avu.x = lo8.x; avu.y = lo8.y; avu.z = hi8.x; avu.w = hi8.y;
        oacc[dt] = MFMA32(__builtin_bit_cast(bf16x8, avu), pb, oacc[dt]);
      }
    }
  }
#undef ATT_ISSUE
  float scale;
  if (MODE == 1 || MODE == 3) {
    const float m_f = fmaxf(m_run, sink);
    const float e = __expf(m_run - m_f);
    scale = e / (l_run * e + __expf(sink - m_f));
  } else scale = 1.0f / l_run;
#pragma unroll
  for (int dt = 0; dt < 2; ++dt)
#pragma unroll
    for (int g4 = 0; g4 < 4; ++g4) {
      const int d = dt * 32 + 8 * g4 + 4 * hh;
      uint2 o; o.x = pk2(oacc[dt][4 * g4] * scale, oacc[dt][4 * g4 + 1] * scale); o.y = pk2(oacc[dt][4 * g4 + 2] * scale, oacc[dt][4 * g4 + 3] * scale);
      *(uint2*)(Y + (size_t)qrow * D + ocol + d) = o;
    }
  __syncthreads();
}

DEV void post_item(const Params& p, int l, int tile, char* lds) {
  const int t = tid(), r0 = tile * TOKT, c = t;
  bf16_t* sA = (bf16_t*)lds;
  float* sgo = (float*)(lds + 32 * 136 * 2);
  const bf16_t* P = (const bf16_t*)(p.ws + OFF_P);
  bf16_t* Y = (bf16_t*)(p.ws + OFF_YMIX);
  const float* Y0 = (const float*)(p.ws + OFF_YDIR); const float* Y1 = Y0 + ARRF;
  const float* H0 = (const float*)(p.ws + OFF_HDIR); const float* H1 = H0 + ARRF;
  const bf16_t* BON = (const bf16_t*)(p.ws + OFF_BONUS);
  __syncthreads();
#pragma unroll
  for (int i = 0; i < TOKT / 2; ++i) {
    const int e = t + 256 * i, tk = e >> 7, j = e & 127;
    sA[tk * 136 + j] = f2bf(sigmoidf_(bf2f(P[(size_t)(r0 + tk) * DIN + C_GH + j])));
  }
  __syncthreads();
  {
    const int lane = t & 63, w = t >> 6, q = lane & 31, hh = lane >> 5;
    bf16x8 af[8];
#pragma unroll
    for (int s = 0; s < 8; ++s) af[s] = *(const bf16x8*)(sA + q * 136 + 16 * s + 8 * hh);
    const bf16_t* GT = (const bf16_t*)(p.ws + OFF_G2T) + (size_t)l * 256 * 128;
#pragma unroll
    for (int nt = 0; nt < 2; ++nt) {
      const int n = w * 64 + nt * 32 + q;
      f32x16 acc;
#pragma unroll
      for (int r = 0; r < 16; ++r) acc[r] = 0.f;
#pragma unroll
      for (int s = 0; s < 8; ++s) acc = MFMA32(af[s], *(const bf16x8*)(GT + (size_t)n * 128 + 16 * s + 8 * hh), acc);
#pragma unroll
      for (int r = 0; r < 8; ++r) sgo[((r & 3) + 8 * (r >> 2) + 4 * hh) * 256 + n] = acc[r];
      if (hh == 0) {
#pragma unroll
        for (int r = 8; r < 12; ++r) sgo[((r & 3) + 16) * 256 + n] = acc[r];
      }
    }
  }
  __syncthreads();
  const float lnw = p.in[I_LNW][l * 256 + c], lnb = p.in[I_LNB][l * 256 + c], hgn = p.in[I_HGN][l * 256 + c];
  float bA[5][5], bB[5][5];
#define POST_LOAD(B_, tbase) do { _Pragma("unroll") for (int u = 0; u < 5; ++u) { \
      const int row_ = r0 + (tbase) + u; const size_t idx_ = (size_t)row_ * 256 + c; \
      B_[0][u] = Y0[idx_] + Y1[idx_]; B_[1][u] = H0[idx_] + H1[idx_]; B_[2][u] = bf2f(BON[idx_]); \
      B_[3][u] = sgo[((tbase) + u) * 256 + c]; B_[4][u] = bf2f(P[(size_t)row_ * DIN + C_HG + c]); } } while (0)
#define POST_COMP(B_, tbase) do { _Pragma("unroll") for (int u = 0; u < 5; ++u) { \
      const int row = r0 + (tbase) + u; \
      const float mu = wave_sum(B_[0][u]) * (1.0f / 64.0f); \
      const float dy = B_[0][u] - mu; \
      const float var = wave_sum(dy * dy) * (1.0f / 64.0f); \
      const float yn = dy * __builtin_amdgcn_rsqf(var + 64e-5f) * lnw + lnb + B_[2][u]; \
      Y[(size_t)row * D + c] = f2bf(yn * B_[3][u]); \
      const float ms = wave_sum(B_[1][u] * B_[1][u]) * (1.0f / 64.0f); \
      Y[(size_t)row * D + 512 + c] = f2bf(B_[1][u] * __builtin_amdgcn_rsqf(ms + 1e-6f) * hgn * sigmoidf_(B_[4][u])); } } while (0)
  static_assert(TOKT == 20, "four batches of five tokens");
  POST_LOAD(bA, 0);
  POST_LOAD(bB, 5);  POST_COMP(bA, 0);
  POST_LOAD(bA, 10); POST_COMP(bB, 5);
  POST_LOAD(bB, 15); POST_COMP(bA, 10);
  POST_COMP(bB, 15);
#undef POST_LOAD
#undef POST_COMP
  __syncthreads();
}

constexpr int OFF_CTR_WORD = 3600;
DEV void mixer_phase(const Params& p, int l, char* lds0, volatile LAS unsigned* st, bool rerun) {
  const int hf = half_id(); char* lds = lds0 + hf * 65536;
  const int npairs = (256 + 512 + 512) / 2;
  unsigned* ctr = (unsigned*)(p.ws + OFF_BAR) + OFF_CTR_WORD + 64 * l + (rerun ? 32 : 0);
  bool first = true;
  for (;;) {
    int pair;
    if (first) { pair = (int)blockIdx.x; first = false; }
    else {
      if (threadIdx.x == 0) st[4] = gridDim.x + __hip_atomic_fetch_add(ctr, 1u, __ATOMIC_RELAXED, __HIP_MEMORY_SCOPE_AGENT);
      __syncthreads();
      pair = (int)st[4];
      __syncthreads();
    }
    if (pair >= npairs) break;
    const int it = pair * 2 + hf;
    const bool is_scan = it < 640;
    if (rerun && PROBE_SUB == 1 && !is_scan) continue;
    if (rerun && PROBE_SUB == 2 && is_scan) continue;
    if (rerun && PROBE_SUB == 3 && !(it < 128)) continue;
    if (rerun && PROBE_SUB == 4 && !(it >= 128 && it < 640)) continue;
    if (it < 128) {
      const int idx = it >> 1; const int seq = 32 + (idx >> 5), rem = idx & 31;
      if ((it & 1) == 0) rwkv_scan16(p, l, seq, rem >> 3, (rem >> 2) & 1, rem & 3, lds);
      else hgrn_scan16(p, l, seq, rem >> 3, (rem >> 2) & 1, rem & 3, lds);
    } else if (it < 640) {
      const int idx = (it - 128) & 255; const int seq = idx >> 3, rem = idx & 7;
      if (it < 384) rwkv_scan<2>(p, l, seq, rem >> 1, rem & 1, 0, lds);
      else hgrn_scan<2>(p, l, seq, rem >> 1, rem & 1, 0, lds);
    } else if (it < 704) attn_item<3>(p, l, it - 640, lds);
    else if (it < 768) attn_item<2>(p, l, it - 704, lds);
    else if (it < 1024) attn_item<0>(p, l, it - 768, lds);
    else attn_item<1>(p, l, it - 1024, lds);
  }
}

DEV void run_phase(const Params& p, int ph, char* lds, bool rerun, volatile LAS unsigned* st) {
  if (ph == 0) { phase0(p, lds); return; }
  if (ph == 1) { row_phase(p, 0, 0); return; }
  const int l = (ph - 2) / 9, s = (ph - 2) % 9;
  const bf16_t* H = (const bf16_t*)(p.ws + OFF_H);
  const int hf = half_id(); char* ldsh = lds + hf * 65536;
  switch (s) {
    case 0: gemm_run<0>(p, l, H, (const bf16_t*)(p.ws + OFF_WIN) + (size_t)l * DINP * D, D, DINP, lds); break;
    case 1:
      for (int it = blockIdx.x * 2 + hf; it < 512 + 256; it += gridDim.x * 2) { if (it < 512) prep_item(p, l, it, ldsh); else if (!rerun) rope_item(p, it - 512); }
      break;
    case 2: mixer_phase(p, l, lds, st, rerun); break;
    case 3: for (int it = blockIdx.x * 2 + hf; it < 512; it += gridDim.x * 2) post_item(p, l, it, ldsh); break;
    case 4: gemm_run<1>(p, l, (const bf16_t*)(p.ws + OFF_YMIX), (const bf16_t*)(p.ws + OFF_WOUT) + (size_t)l * D * D, D, D, lds); break;
    case 5: row_phase(p, 1, l); break;
    case 6: gemm_run<2>(p, l, H, (const bf16_t*)(p.ws + OFF_W1) + (size_t)l * FF * D, D, FF, lds); break;
    case 7: gemm_run<1>(p, l, (const bf16_t*)(p.ws + OFF_HID), (const bf16_t*)(p.ws + OFF_W2) + (size_t)l * D * FF, FF, D, lds); break;
    case 8: row_phase(p, 2, l); break;
  }
}

#define XB_TMO      128
#define XB_XCNT(j)  (256  + 64 * (j))
#define XB_XSUB(j)  (1280 + 64 * (j))
#define XB_XGEN(j)  (2304 + 64 * (j))
#define XB_TOP      3328
#define XB_TOPGEN   3392
#define XCD_BAR_WORDS 3456
#define XB_SPIN_CAP (1u << 18)
DEV unsigned xb_ld(unsigned* p) { return __hip_atomic_load(p, __ATOMIC_RELAXED, __HIP_MEMORY_SCOPE_AGENT); }
DEV unsigned xb_add(unsigned* p, unsigned v) { return __hip_atomic_fetch_add(p, v, __ATOMIC_RELAXED, __HIP_MEMORY_SCOPE_AGENT); }
DEV unsigned xb_xcc_id() { return (unsigned)__builtin_amdgcn_s_getreg((3 << 11) | 20) & 0xFu; }
#define XB_SPIN(cond, bar) do { unsigned _sp = 0; while (cond) { __builtin_amdgcn_s_sleep(1); \
    if ((++_sp & 255u) == 0u) { if (xb_ld(&(bar)[XB_TMO])) break; if (_sp > XB_SPIN_CAP) { atomicAdd(&(bar)[XB_TMO], 1u); break; } } } } while (0)
struct XcdBarrier { unsigned* bar; unsigned x; volatile LAS unsigned* st; };
DEV XcdBarrier xcd_barrier_post(unsigned* bar, volatile LAS unsigned* st) {
  XcdBarrier b; b.bar = bar; b.x = xb_xcc_id(); b.st = st;
  if (threadIdx.x == 0) (void)xb_add(&bar[XB_XCNT(b.x)], 1u);
  return b;
}
DEV void xcd_barrier_complete(unsigned* bar, unsigned x, unsigned& nloc, unsigned& nx) {
  const unsigned G = gridDim.x * gridDim.y * gridDim.z;
  unsigned sum, cnt, mine, sp = 0u;
  for (;;) {
    sum = 0u; cnt = 0u; mine = 0u;
#pragma unroll
    for (unsigned j = 0; j < 16; ++j) { const unsigned c = xb_ld(&bar[XB_XCNT(j)]); sum += c; cnt += (c > 0u) ? 1u : 0u; mine = (j == x) ? c : mine; }
    if (sum == G) break;
    __builtin_amdgcn_s_sleep(1);
    if ((++sp & 255u) == 0u) { if (xb_ld(&bar[XB_TMO])) break; if (sp > XB_SPIN_CAP) { atomicAdd(&bar[XB_TMO], 1u); break; } }
  }
  nloc = mine > 0u ? mine : 1u; nx = cnt > 0u ? cnt : 1u;
}
DEV void xcd_barrier(const XcdBarrier& b) {
  asm volatile("s_waitcnt vmcnt(0)" ::: "memory");
  __syncthreads();
  if (threadIdx.x == 0) {
    unsigned* bar = b.bar;
    { size_t zb_; asm volatile("s_mov_b64 %0, 0" : "=s"(zb_)); bar += zb_; }
    __builtin_amdgcn_s_waitcnt(0);
    unsigned nloc = b.st[0], nx = b.st[1];
    if (nloc == 0u) { xcd_barrier_complete(bar, b.x, nloc, nx); b.st[0] = nloc; b.st[1] = nx; }
    const unsigned old = xb_add(&bar[XB_XSUB(b.x)], 1u);
    const unsigned gen = old / nloc;
    if (old + 1u == (gen + 1u) * nloc) {
      __builtin_amdgcn_fence(__ATOMIC_RELEASE, "agent");
      asm volatile("s_waitcnt vmcnt(0)" ::: "memory");
      const unsigned og = xb_add(&bar[XB_TOP], 1u);
      const unsigned tg = og / nx;
      if (og + 1u == (tg + 1u) * nx) xb_add(&bar[XB_TOPGEN], 1u);
      else XB_SPIN(xb_ld(&bar[XB_TOPGEN]) == tg, bar);
      __builtin_amdgcn_fence(__ATOMIC_ACQUIRE, "agent");
      xb_add(&bar[XB_XGEN(b.x)], 1u);
      asm volatile("s_waitcnt vmcnt(0)" ::: "memory");
    } else {
      XB_SPIN(xb_ld(&bar[XB_XGEN(b.x)]) == gen, bar);
      __builtin_amdgcn_fence(__ATOMIC_ACQUIRE, "agent");
      asm volatile("s_waitcnt vmcnt(0)" ::: "memory");
    }
  }
  __syncthreads();
}

DEV int phase_kind(int ph) {
  if (ph == 0) return 0;
  if (ph == 1) return 1;
  const int s = (ph - 2) % 9;
  return s == 0 ? 2 : s == 1 ? 3 : s == 2 ? 4 : s == 3 ? 5 : s == 4 ? 6 : s == 5 ? 1 : s == 6 ? 7 : s == 7 ? 8 : 1;
}

constexpr int LDS_BYTES = 131072 + 64;

__global__ void __launch_bounds__(512, 2) mega(Params p, int ph_lo, int ph_hi) {
  extern __shared__ __attribute__((aligned(16))) unsigned char smem[];
  char* lds = (char*)smem;
  volatile LAS unsigned* st = (volatile LAS unsigned*)((LAS unsigned char*)smem + 131072);
  if (threadIdx.x == 0) { st[0] = 0u; st[1] = 0u; }
  __syncthreads();
  XcdBarrier xb = xcd_barrier_post((unsigned*)(p.ws + OFF_BAR), st);
  if (ph_hi < 0) cg::this_grid().sync();
  char* const ws0 = p.ws; float* const out0 = p.out;
  for (int ph = ph_lo; ph < ph_hi; ++ph) {
    { size_t z0_; asm volatile("s_mov_b64 %0, 0" : "=s"(z0_)); p.ws = ws0 + z0_; p.out = out0 + z0_; }
    run_phase(p, ph, lds, false, st);
    if (PROBE_KIND >= 0 && (PROBE_KIND == 9 || phase_kind(ph) == PROBE_KIND)) {
      xcd_barrier(xb);
      if (PROBE_KIND != 9) run_phase(p, ph, lds, true, st);
    }
    if (ph + 1 < ph_hi) xcd_barrier(xb);
  }
}

extern "C" void kernel_launch(void* const* d_in, const int* in_sizes, int n_in, void* d_out, int out_size, void* d_ws, size_t ws_size,
                              hipStream_t stream) {
  static int grid_blocks = 0;
  if (!grid_blocks) {
    int dev = 0, cus = 0, per_cu = 0;
    (void)hipGetDevice(&dev);
    (void)hipDeviceGetAttribute(&cus, hipDeviceAttributeMultiprocessorCount, dev);
    if (hipFuncSetAttribute((const void*)mega, hipFuncAttributeMaxDynamicSharedMemorySize, LDS_BYTES) != hipSuccess) fprintf(stderr, "hipFuncSetAttribute failed\n");
    (void)hipOccupancyMaxActiveBlocksPerMultiprocessor(&per_cu, mega, 512, LDS_BYTES);
    if (per_cu < 1) fprintf(stderr, "occupancy query reports %d blocks per CU\n", per_cu);
    (void)hipGetLastError();
    grid_blocks = cus;
  }
  if (ws_size < WS_TOTAL) { fprintf(stderr, "workspace too small: %zu < %zu\n", ws_size, (size_t)WS_TOTAL); return; }
  Params p{};
  for (int i = 0; i < 31; ++i) p.in[i] = (const float*)d_in[i];
  p.out = (float*)d_out;
  p.ws = (char*)d_ws;
  (void)hipMemsetAsync((char*)d_ws + OFF_BAR, 0, 16384, stream);
  int lo = 0, hi = NPH;
  void* args[] = {&p, &lo, &hi};
  hipError_t e = hipLaunchCooperativeKernel((void*)mega, dim3(grid_blocks), dim3(512), args, LDS_BYTES, stream);
  if (e != hipSuccess) fprintf(stderr, "cooperative launch failed: %s (grid %d)\n", hipGetErrorString(e), grid_blocks);
}
```
